# Optimizing an MI355X kernel written in HIP

```python
import math
import jax, jax.numpy as jnp
from jax import lax
import numpy as np

D_MODEL = 1024
BATCH = 4
SEQ = 4096
DEPTH = 4

EXPAND = 2
D_INNER = EXPAND * D_MODEL
HEAD_DIM = 64
ROPE_THETA = 500000.0
ROPE_DIM = HEAD_DIM // 4
BLOCK = 128
EPS = 1e-6

DA_WIDTH = D_INNER // 2
DA_VDIM = 2 * HEAD_DIM
DA_HEADS = DA_WIDTH // DA_VDIM
HG_WIDTH = D_INNER - DA_WIDTH
HG_EXPAND = 128
HG_HEADS = HG_WIDTH // HG_EXPAND
HG_CHUNK = 64
SW_HEADS = D_INNER // HEAD_DIM
SW_KV_HEADS = SW_HEADS // 8
SW_WINDOW = 128

N_EVEN = (DEPTH + 1) // 2
N_ODD = DEPTH // 2
EVEN_SIZES = (DA_WIDTH, DA_WIDTH, DA_WIDTH, DA_WIDTH,
              HG_WIDTH, HG_WIDTH, HG_WIDTH, HG_WIDTH, HG_WIDTH)
ODD_SIZES = (D_INNER, SW_KV_HEADS * HEAD_DIM, SW_KV_HEADS * HEAD_DIM, D_INNER)
EVEN_IN = sum(EVEN_SIZES)
ODD_IN = sum(ODD_SIZES)

kernel_name = "hybrid_diffattn_hgrn2_swa_encoder"


def rmsnorm(x, w):
    xf = x.astype(jnp.float32)
    y = xf * lax.rsqrt(jnp.mean(xf * xf, axis=-1, keepdims=True) + EPS)
    return (y * w.astype(jnp.float32)).astype(x.dtype)


def split_cols(t, sizes):
    idx = [int(v) for v in np.cumsum(sizes)[:-1]]
    return jnp.split(t, idx, axis=-1)


def rope_tables(seq):
    inv = ROPE_THETA ** (-jnp.arange(0, ROPE_DIM, 2, dtype=jnp.float32) / ROPE_DIM)
    ang = jnp.arange(seq, dtype=jnp.float32)[:, None] * inv[None, :]
    return jnp.cos(ang), jnp.sin(ang)


def partial_rope(x, cos, sin):
    c = cos[None, :, None, :].astype(x.dtype)
    s = sin[None, :, None, :].astype(x.dtype)
    x1 = x[..., :ROPE_DIM // 2]
    x2 = x[..., ROPE_DIM // 2:ROPE_DIM]
    return jnp.concatenate([x1 * c - x2 * s, x2 * c + x1 * s, x[..., ROPE_DIM:]], axis=-1)


def differential_attention(q, k, v, lam_p, lam_init, subln_w, cos, sin):
    B, S, _ = q.shape
    H = DA_HEADS
    n = S // BLOCK
    q = partial_rope(q.reshape(B, S, 2 * H, HEAD_DIM), cos, sin).reshape(B, S, H, 2, HEAD_DIM)
    k = partial_rope(k.reshape(B, S, 2 * H, HEAD_DIM), cos, sin).reshape(B, S, H, 2, HEAD_DIM)
    v = v.reshape(B, S, H, DA_VDIM)
    lp = lam_p.astype(jnp.float32)
    lam = jnp.exp(jnp.sum(lp[0] * lp[1])) - jnp.exp(jnp.sum(lp[2] * lp[3])) + lam_init
    scale = HEAD_DIM ** -0.5
    qb = q.reshape(B, n, BLOCK, H, 2, HEAD_DIM).transpose(1, 0, 2, 3, 4, 5)

    def one_block(qx):
        s = jnp.einsum('bqhcd,bkhcd->bhcqk', qx, k, preferred_element_type=jnp.float32) * scale
        p = jax.nn.softmax(s, axis=-1)
        a = p[:, :, 0] - lam * p[:, :, 1]
        return jnp.einsum('bhqk,bkhv->bqhv', a.astype(v.dtype), v)

    o = lax.map(one_block, qb).transpose(1, 0, 2, 3, 4).reshape(B, S, H, DA_VDIM)
    o = rmsnorm(o, subln_w) * (1.0 - lam_init)
    return o.reshape(B, S, DA_WIDTH)


def hgrn2_chunk_scan(q, log_f, k, v):
    B, S, H, dk = q.shape
    dv = v.shape[-1]
    C = HG_CHUNK
    n = S // C

    def to_chunks(t):
        return t.reshape(B, n, C, H, t.shape[-1]).transpose(1, 0, 3, 2, 4)

    qc, gc, kc, vc = to_chunks(q), to_chunks(log_f), to_chunks(k), to_chunks(v)
    G = jnp.cumsum(gc, axis=3)
    tril = jnp.tril(jnp.ones((C, C), dtype=bool))[None, None, :, :, None]

    def step(state, xs):
        qb, Gb, kb, vb = xs
        diff = Gb[:, :, :, None, :] - Gb[:, :, None, :, :]
        decay = jnp.exp(jnp.where(tril, diff, -jnp.inf))
        A = jnp.einsum('bhtd,bhsd,bhtsd->bhts', qb, kb, decay)
        o = jnp.einsum('bhts,bhsv->bhtv', A, vb)
        o = o + jnp.einsum('bhtd,bhdv->bhtv', qb * jnp.exp(Gb), state)
        g_last = Gb[:, :, -1]
        k_dec = kb * jnp.exp(g_last[:, :, None, :] - Gb)
        new_state = jnp.exp(g_last)[..., None] * state + jnp.einsum('bhsd,bhsv->bhdv', k_dec, vb)
        return new_state, o

    s0 = jnp.zeros((B, H, dk, dv), jnp.float32)
    _, o = lax.scan(step, s0, (qc, G, kc, vc))
    return o.transpose(1, 0, 3, 2, 4).reshape(B, S, H, dv)


def hgrn2_bidirectional(q, f_fwd, f_bwd, i, lb, norm_w):
    B, S, _ = q.shape
    shp = (B, S, HG_HEADS, HG_EXPAND)
    qf = jax.nn.silu(q.astype(jnp.float32)).reshape(shp)
    vf = i.astype(jnp.float32).reshape(shp)

    def gates(z, lb_d):
        z = z.astype(jnp.float32).reshape(shp)
        lb_d = lb_d.reshape(HG_HEADS, HG_EXPAND)
        log_f = jnp.logaddexp(jnp.log(lb_d), jnp.log1p(-lb_d) + jax.nn.log_sigmoid(z))
        key = (1.0 - lb_d) * jax.nn.sigmoid(-z)
        return log_f, key

    lf_f, k_f = gates(f_fwd, lb[0])
    o_f = hgrn2_chunk_scan(qf, lf_f, k_f, vf)
    lf_b, k_b = gates(f_bwd, lb[1])
    rev = lambda t: jnp.flip(t, axis=1)
    o_b = rev(hgrn2_chunk_scan(rev(qf), rev(lf_b), rev(k_b), rev(vf)))
    o = rmsnorm(o_f + o_b, norm_w)
    return o.reshape(B, S, HG_WIDTH).astype(q.dtype)


def window_gqa_with_sink(q, k, v, sink, cos, sin):
    B, S, _ = q.shape
    Hkv = SW_KV_HEADS
    G = SW_HEADS // Hkv
    n = S // BLOCK
    q = partial_rope(q.reshape(B, S, SW_HEADS, HEAD_DIM), cos, sin)
    k = partial_rope(k.reshape(B, S, Hkv, HEAD_DIM), cos, sin)
    v = v.reshape(B, S, Hkv, HEAD_DIM)

    def banded(t):
        tp = jnp.pad(t, ((0, 0), (BLOCK, BLOCK), (0, 0), (0, 0))).reshape(B, n + 2, BLOCK, Hkv, HEAD_DIM)
        band = jnp.concatenate([tp[:, :-2], tp[:, 1:-1], tp[:, 2:]], axis=2)
        return band.transpose(1, 0, 2, 3, 4)

    qb = q.reshape(B, n, BLOCK, Hkv, G, HEAD_DIM).transpose(1, 0, 2, 3, 4, 5)
    kb, vb = banded(k), banded(v)
    sink_g = sink.astype(jnp.float32).reshape(Hkv, G)[None, :, :, None, None]
    q_idx = jnp.arange(BLOCK)[:, None]
    k_off = jnp.arange(3 * BLOCK)[None, :] - BLOCK
    in_window = jnp.abs(k_off - q_idx) <= SW_WINDOW
    scale = HEAD_DIM ** -0.5

    def one_block(args):
        blk, qx, kx, vx = args
        s = jnp.einsum('bqhgd,bkhd->bhgqk', qx, kx, preferred_element_type=jnp.float32) * scale
        key_pos = blk * BLOCK + k_off
        valid = in_window & (key_pos >= 0) & (key_pos < S)
        s = jnp.where(valid, s, -jnp.inf)
        m = jnp.maximum(jnp.max(s, axis=-1, keepdims=True), sink_g)
        p = jnp.exp(s - m)
        p = p / (jnp.sum(p, axis=-1, keepdims=True) + jnp.exp(sink_g - m))
        return jnp.einsum('bhgqk,bkhd->bqhgd', p.astype(vx.dtype), vx)

    o = lax.map(one_block, (jnp.arange(n), qb, kb, vb))
    return o.transpose(1, 0, 2, 3, 4, 5).reshape(B, S, SW_HEADS * HEAD_DIM)


def even_layer(x, norm_w, w_in, w_out, lam_p, lam_init, subln_w, hg_norm_w, lb, cos, sin):
    h = rmsnorm(x, norm_w)
    proj = jnp.einsum('bsd,de->bse', h, w_in)
    qa, ka, va, ga, qh, ffw, fbw, ih, gh = split_cols(proj, EVEN_SIZES)
    oa = differential_attention(qa, ka, va, lam_p, lam_init, subln_w, cos, sin) * jax.nn.silu(ga)
    ob = hgrn2_bidirectional(qh, ffw, fbw, ih, lb, hg_norm_w) * jax.nn.silu(gh)
    return jnp.einsum('bse,ed->bsd', jnp.concatenate([oa, ob], axis=-1), w_out)


def odd_layer(x, norm_w, w_in, w_out, sink, cos, sin):
    h = rmsnorm(x, norm_w)
    proj = jnp.einsum('bsd,de->bse', h, w_in)
    qc, kc, vc, gc = split_cols(proj, ODD_SIZES)
    oc = window_gqa_with_sink(qc, kc, vc, sink, cos, sin) * jax.nn.silu(gc)
    return jnp.einsum('bse,ed->bsd', oc, w_out)


def setup_inputs(seed: int = 0) -> dict:
    key = jax.random.key(seed)
    ks = jax.random.split(key, 16)
    f32 = jnp.float32
    nrm = lambda k, shp, sc: jax.random.normal(k, shp, f32) * sc
    return {
        "x": nrm(ks[0], (BATCH, SEQ, D_MODEL), 1.0),
        "norm_even": 1.0 + nrm(ks[1], (N_EVEN, D_MODEL), 0.02),
        "w_in_even": nrm(ks[2], (N_EVEN, D_MODEL, EVEN_IN), D_MODEL ** -0.5),
        "lambda_qk": nrm(ks[3], (N_EVEN, 4, HEAD_DIM), 0.1),
        "subln_w": 1.0 + nrm(ks[4], (N_EVEN, DA_VDIM), 0.02),
        "hgrn_norm_w": 1.0 + nrm(ks[5], (N_EVEN, HG_EXPAND), 0.02),
        "hgrn_lb_logits": nrm(ks[6], (2, N_EVEN, HG_WIDTH), 0.5),
        "w_out_even": nrm(ks[7], (N_EVEN, D_INNER, D_MODEL), D_INNER ** -0.5),
        "norm_odd": 1.0 + nrm(ks[8], (N_ODD, D_MODEL), 0.02),
        "w_in_odd": nrm(ks[9], (N_ODD, D_MODEL, ODD_IN), D_MODEL ** -0.5),
        "sink_logits": nrm(ks[10], (N_ODD, SW_HEADS), 0.5),
        "w_out_odd": nrm(ks[11], (N_ODD, D_INNER, D_MODEL), D_INNER ** -0.5),
        "final_norm": 1.0 + nrm(ks[12], (D_MODEL,), 0.02),
    }


def reference(x, norm_even, w_in_even, lambda_qk, subln_w, hgrn_norm_w, hgrn_lb_logits,
              w_out_even, norm_odd, w_in_odd, sink_logits, w_out_odd, final_norm):
    S = x.shape[1]
    cos, sin = rope_tables(S)
    lb_cum = jnp.cumsum(jax.nn.softmax(hgrn_lb_logits.astype(jnp.float32), axis=1), axis=1)
    lb_all = lb_cum - lb_cum[:, :1]
    for layer in range(DEPTH):
        j = layer // 2
        if layer % 2 == 0:
            lam_init = 0.8 - 0.6 * math.exp(-0.3 * layer)
            x = x + even_layer(x, norm_even[j], w_in_even[j], w_out_even[j], lambda_qk[j],
                               lam_init, subln_w[j], hgrn_norm_w[j], lb_all[:, j], cos, sin)
        else:
            x = x + odd_layer(x, norm_odd[j], w_in_odd[j], w_out_odd[j], sink_logits[j], cos, sin)
    return rmsnorm(x, final_norm)
```

```cpp
#include <hip/hip_runtime.h>
#include <hip/hip_bf16.h>
#include <cstdio>
#include <cstdint>

constexpr int NB = 4, SEQ = 4096, DM = 1024, T = NB * SEQ;
constexpr int EVEN_IN = 9216, ODD_IN = 4608, DIN = 2048;
constexpr float EPS = 1e-6f;
constexpr float C2 = 0.125f * 1.4426950408889634f;
constexpr float LOG2E = 1.4426950408889634f;

namespace pg8 {
#define PG8_LAS __attribute__((address_space(3)))
typedef unsigned short bf16_t;
typedef short bf16x8 __attribute__((ext_vector_type(8)));
typedef float f32x4 __attribute__((ext_vector_type(4)));
typedef unsigned u32x4 __attribute__((ext_vector_type(4)));
constexpr int BM = 256, BK = 64, HALF = 128, HTB = HALF * BK * 2, STAGE_BYTES = 8 * HTB, NXCD = 8, WGM = 8;

__host__ __device__ __forceinline__ int lds_byte(int r, int c) { const int st = (r >> 4) * 2 + (c >> 5), rr = r & 15, cc = c & 31, ob = rr * 64 + cc * 2; return st * 1024 + (ob ^ (((ob >> 9) & 1) << 5)); }
__host__ __device__ __forceinline__ void stage_rc(int b, int& R, int& C) { const int st = b / 1024, sb = b % 1024, swz = sb ^ (((sb >> 9) & 1) << 5); R = (st >> 1) * 16 + swz / 64; C = (st & 1) * 32 + (swz % 64) / 2; }
__host__ __device__ __forceinline__ int perm32(int rho) { const int n = rho >> 4, i = rho & 15; return 8 * (i >> 2) + 4 * n + (i & 3); }

struct Unit { int pm, pn; };
struct Gemm { const bf16_t* A; const bf16_t* Bt; int M, N, K, lda, ksplit; long jump; };

struct StaticOrder {
    int nM, nN, nwg, G, c;
    __host__ __device__ void init(int M, int N, int G_, int c_) { nM = M / BM; nN = N / BM; nwg = nM * nN; G = G_; c = c_; }
    __host__ __device__ bool next(int i, Unit& u) const {
        const long L = (long)i * G + c; if (L >= nwg) return false;
        int wgid = (int)L; { const int q = nwg / NXCD, r = nwg % NXCD, xcd = wgid % NXCD, off = wgid / NXCD; wgid = (xcd < r ? xcd * (q + 1) : r * (q + 1) + (xcd - r) * q) + off; }
        const int nig = WGM * nN, gid = wgid / nig, fm = gid * WGM, gsz = (nM - fm) < WGM ? (nM - fm) : WGM;
        u.pm = fm + ((wgid % nig) % gsz); u.pn = (wgid % nig) / gsz; return true;
    }
};

__device__ __forceinline__ unsigned cvt_pk_bf16(float lo, float hi) { unsigned r; asm volatile("v_cvt_pk_bf16_f32 %0, %1, %2" : "=v"(r) : "v"(lo), "v"(hi)); return r; }

template <class Epi>
__device__ __forceinline__ void gemm_phase(PG8_LAS unsigned char* lds, const Gemm g, const StaticOrder& S, const Epi& E) {
    int tid = threadIdx.x; asm volatile("" : "+v"(tid));
    const int wid = __builtin_amdgcn_readfirstlane(tid >> 6), lane = tid & 63, wr = wid >> 2, wc = wid & 3, fr = lane & 15, fq = lane >> 4;
    const int K = g.K, nt = K / BK, lda = g.lda;
    unsigned voffA[2], voffB[2];
#pragma unroll
    for (int i = 0; i < 2; ++i) { int R, C; stage_rc(tid * 16 + i * 8192, R, C); const int Rb = Epi::PERM ? ((R & ~31) + perm32(R & 31)) : R;
        voffA[i] = (unsigned)(R * lda + C) * 2u; voffB[i] = (unsigned)(Rb * K + C) * 2u; }
    const size_t kstep = (size_t)(BK * 2);
    const size_t hstepA = (size_t)HALF * lda * 2, tstepA = 2 * hstepA;
    const size_t hstepB = (size_t)HALF * K * 2, tstepB = 2 * hstepB;
    const unsigned ldsw = (unsigned)wid * 1024u;
    const int aoff = lds_byte(wr * 64 + fr, fq * 8), boff = lds_byte(wc * 32 + fr, fq * 8);
    const int ksplit = g.ksplit; const long jump = g.jump;
#define PG8_AP(base, t) ((base) + (size_t)(t) * kstep + (((t) >= ksplit) ? jump : 0l))
#define PG8_SA(b, h) (((b) * 2 + (h)) * HTB)
#define PG8_SB(b, h) ((4 + (b) * 2 + (h)) * HTB)
#define PG8_STAGE(bufoff, gbase, voff) do { _Pragma("unroll") for (int _i = 0; _i < 2; ++_i) \
        __builtin_amdgcn_global_load_lds((const unsigned*)((const char*)(gbase) + (voff)[_i]), (PG8_LAS unsigned*)(lds + (bufoff) + ldsw + _i * 8192), 16, 0, 0); } while (0)
#define PG8_LDA(dst, b, h) do { _Pragma("unroll") for (int m = 0; m < 4; ++m) _Pragma("unroll") for (int k = 0; k < 2; ++k) dst[m][k] = *(const PG8_LAS bf16x8*)(lds + PG8_SA(b, h) + aoff + m * 2048 + k * 1024); } while (0)
#define PG8_LDB(dst, b, h) do { _Pragma("unroll") for (int n = 0; n < 2; ++n) _Pragma("unroll") for (int k = 0; k < 2; ++k) dst[n][k] = *(const PG8_LAS bf16x8*)(lds + PG8_SB(b, h) + boff + n * 2048 + k * 1024); } while (0)
#define PG8_MMA(ai, bj, At, Bt) do { __builtin_amdgcn_s_setprio(1); _Pragma("unroll") for (int m = 0; m < 4; ++m) _Pragma("unroll") for (int n = 0; n < 2; ++n) _Pragma("unroll") for (int k = 0; k < 2; ++k) \
        acc[ai][bj][m][n] = __builtin_amdgcn_mfma_f32_16x16x32_bf16(Bt[n][k], At[m][k], acc[ai][bj][m][n], 0, 0, 0); __builtin_amdgcn_s_setprio(0); } while (0)
#define PG8_WAIT_V(n) asm volatile("s_waitcnt vmcnt(" #n ")" ::: "memory")
#define PG8_WAIT_L(n) asm volatile("s_waitcnt lgkmcnt(" #n ")" ::: "memory")
#define PG8_BAR __builtin_amdgcn_s_barrier()
#define PG8_SCHED __builtin_amdgcn_sched_barrier(0)
    Unit cur, nxt; int ui = 0;
    if (!S.next(0, cur)) return;
    f32x4 acc[2][2][4][2];
#pragma unroll
    for (int a = 0; a < 2; ++a)
#pragma unroll
        for (int b = 0; b < 2; ++b)
#pragma unroll
            for (int m = 0; m < 4; ++m)
#pragma unroll
                for (int n = 0; n < 2; ++n) acc[a][b][m][n] = (f32x4){0.f, 0.f, 0.f, 0.f};
    bf16x8 At[4][2], B0[2][2], B1[2][2];
    const char* cA = (const char*)g.A + (size_t)cur.pm * tstepA; const char* cB = (const char*)g.Bt + (size_t)cur.pn * tstepB;
    {
        PG8_STAGE(PG8_SB(0, 0), cB, voffB); PG8_STAGE(PG8_SB(0, 1), cB + hstepB, voffB); PG8_STAGE(PG8_SA(0, 0), cA, voffA); PG8_STAGE(PG8_SA(0, 1), cA + hstepA, voffA);
        if (wr == 1) PG8_BAR;
        PG8_WAIT_V(2); PG8_BAR;
        PG8_STAGE(PG8_SB(1, 0), cB + kstep, voffB); PG8_STAGE(PG8_SA(1, 0), PG8_AP(cA, 1), voffA); PG8_STAGE(PG8_SB(1, 1), cB + hstepB + kstep, voffB);
        PG8_WAIT_V(6); PG8_BAR;
    }
    for (;;) {
        const bool has_next = S.next(ui + 1, nxt);
        const char* nA = has_next ? (const char*)g.A + (size_t)nxt.pm * tstepA : cA; const char* nB = has_next ? (const char*)g.Bt + (size_t)nxt.pn * tstepB : cB;
        for (int t = 0; t < nt; t += 2) {
            const bool last = (t == nt - 2);
            const char* a1 = PG8_AP(cA, t + 1);
            const char* a2 = last ? nA : PG8_AP(cA, t + 2); const char* b2 = last ? nB : cB + (size_t)(t + 2) * kstep;
            const char* a3 = a2 + kstep; const char* b3 = b2 + kstep;
            PG8_LDB(B0, 0, 0); PG8_LDB(B1, 0, 1); PG8_SCHED; PG8_LDA(At, 0, 0); PG8_STAGE(PG8_SA(1, 1), a1 + hstepA, voffA);
            PG8_WAIT_V(8); PG8_WAIT_L(0); PG8_BAR; PG8_MMA(0, 0, At, B0); PG8_MMA(0, 1, At, B1); PG8_BAR; PG8_SCHED;
            PG8_LDA(At, 0, 1); PG8_STAGE(PG8_SB(0, 0), b2, voffB); PG8_STAGE(PG8_SB(0, 1), b2 + hstepB, voffB); PG8_STAGE(PG8_SA(0, 0), a2, voffA);
            PG8_WAIT_V(8); PG8_WAIT_L(0); PG8_BAR; PG8_MMA(1, 0, At, B0); PG8_MMA(1, 1, At, B1); PG8_BAR; PG8_SCHED;
            PG8_LDB(B0, 1, 0); PG8_LDB(B1, 1, 1); PG8_SCHED; PG8_LDA(At, 1, 0); PG8_STAGE(PG8_SA(0, 1), a2 + hstepA, voffA);
            PG8_WAIT_V(8); PG8_WAIT_L(0); PG8_BAR; PG8_MMA(0, 0, At, B0); PG8_MMA(0, 1, At, B1); PG8_BAR; PG8_SCHED;
            PG8_LDA(At, 1, 1); PG8_STAGE(PG8_SB(1, 0), b3, voffB); PG8_STAGE(PG8_SB(1, 1), b3 + hstepB, voffB); PG8_STAGE(PG8_SA(1, 0), a3, voffA);
            PG8_WAIT_V(8); PG8_WAIT_L(0); PG8_BAR; PG8_MMA(1, 0, At, B0); PG8_MMA(1, 1, At, B1); PG8_BAR; PG8_SCHED;
        }
        if (wr == 0) PG8_BAR;
        E(acc, cur, wr, wc, fr, fq);
        if (!has_next) break;
#pragma unroll
        for (int a = 0; a < 2; ++a)
#pragma unroll
            for (int b = 0; b < 2; ++b)
#pragma unroll
                for (int m = 0; m < 4; ++m)
#pragma unroll
                    for (int n = 0; n < 2; ++n) acc[a][b][m][n] = (f32x4){0.f, 0.f, 0.f, 0.f};
        cur = nxt; cA = nA; cB = nB; ++ui;
        if (wr == 1) PG8_BAR;
    }
    PG8_WAIT_V(0);
    PG8_BAR;
#undef PG8_AP
#undef PG8_SA
#undef PG8_SB
#undef PG8_STAGE
#undef PG8_LDA
#undef PG8_LDB
#undef PG8_MMA
#undef PG8_WAIT_V
#undef PG8_WAIT_L
#undef PG8_BAR
#undef PG8_SCHED
}
}
namespace pg8 {
typedef unsigned short u16;
__device__ __forceinline__ float fsigmoid(float v) { return __builtin_amdgcn_rcpf(1.0f + __expf(-v)); }
__device__ __forceinline__ unsigned pk_f16(float lo, float hi) { _Float16 a = (_Float16)lo, b = (_Float16)hi; return (unsigned)__builtin_bit_cast(unsigned short, a) | ((unsigned)__builtin_bit_cast(unsigned short, b) << 16); }

enum { K_PLAIN = 0, K_SILU = 1, K_ROPEQ = 2, K_ROPEK = 3, K_LOGF = 4 };

template <bool EVEN> struct EpiIn {
    static constexpr bool PERM = true;
    const float* ssq;
    const float* rope;
    const float* lb;
    unsigned char* r0; unsigned char* r1; unsigned char* r2; unsigned char* r3; unsigned char* r4; unsigned char* r5;
    int pn_off;
    __device__ __forceinline__ void operator()(const f32x4 (&acc)[2][2][4][2], const Unit& u, int wr, int wc, int fr, int fq) const {
        const int gpn = u.pn + pn_off;
        int kind, pitch, colt, dir = 0; u16* outp;
        if (EVEN) {
            const int grp = gpn >> 2; colt = (gpn & 3) * 256; pitch = 1024;
            switch (grp) {
                case 0: kind = K_ROPEQ; outp = (u16*)r0; break;
                case 1: kind = K_ROPEK; outp = (u16*)r1; break;
                case 2: kind = K_PLAIN; outp = (u16*)r2; break;
                case 3: kind = K_SILU;  outp = (u16*)r3; break;
                case 4: kind = K_SILU;  outp = (u16*)r1; break;
                case 5: kind = K_LOGF;  outp = (u16*)r4; dir = 0; break;
                case 6: kind = K_LOGF;  outp = (u16*)r5; dir = 1; break;
                case 7: kind = K_PLAIN; outp = (u16*)r2; break;
                default: kind = K_SILU; outp = (u16*)r3; break;
            }
        } else {
            if (gpn < 8)       { kind = K_ROPEQ; outp = (u16*)r0; pitch = 2048; colt = gpn * 256; }
            else if (gpn == 8) { kind = K_ROPEK; outp = (u16*)r2; pitch = 256;  colt = 0; }
            else if (gpn == 9) { kind = K_PLAIN; outp = (u16*)(r2 + (size_t)T * 256 * 2); pitch = 256; colt = 0; }
            else               { kind = K_SILU;  outp = (u16*)r3; pitch = 2048; colt = (gpn - 10) * 256; }
        }
        int row0 = u.pm * BM + wr * 64 + fr; asm volatile("" : "+v"(row0));
        const bool roped = (kind == K_ROPEQ || kind == K_ROPEK) && ((wc & 1) == 0);
        const float qs = (kind == K_ROPEQ) ? C2 : 1.0f;
#pragma unroll
        for (int ai = 0; ai < 2; ++ai)
#pragma unroll
            for (int m = 0; m < 4; ++m) {
                const int row = row0 + ai * HALF + m * 16;
                const f32x4* sp = (const f32x4*)(ssq + (size_t)row * 16);
                const f32x4 s0 = sp[0], s1 = sp[1], s2 = sp[2], s3 = sp[3];
                const float tot = ((s0[0] + s0[1]) + (s0[2] + s0[3])) + ((s1[0] + s1[1]) + (s1[2] + s1[3])) + ((s2[0] + s2[1]) + (s2[2] + s2[3])) + ((s3[0] + s3[1]) + (s3[2] + s3[3]));
                const float rs = __builtin_amdgcn_rsqf(tot * (1.0f / DM) + EPS);
                f32x4 cs0, cs1, sn0, sn1;
                if (roped) { const int pos = row & (SEQ - 1); const f32x4* cp = (const f32x4*)(rope + (size_t)pos * 8); const f32x4* spn = (const f32x4*)(rope + (size_t)SEQ * 8 + (size_t)pos * 8);
                    cs0 = cp[0]; cs1 = cp[1]; sn0 = spn[0]; sn1 = spn[1]; }
#pragma unroll
                for (int bj = 0; bj < 2; ++bj) {
                    f32x4 v0 = acc[ai][bj][m][0] * rs, v1 = acc[ai][bj][m][1] * rs;
                    const int c0 = colt + bj * HALF + wc * 32 + 8 * fq;
                    u32x4 w;
                    if (kind == K_LOGF) {
                        const f32x4 l0 = *(const f32x4*)(lb + dir * 1024 + c0), l1 = *(const f32x4*)(lb + dir * 1024 + c0 + 4);
                        float o[8];
#pragma unroll
                        for (int e = 0; e < 4; ++e) { const float f0 = l0[e] + (1.0f - l0[e]) * fsigmoid(v0[e]), f1 = l1[e] + (1.0f - l1[e]) * fsigmoid(v1[e]);
                            o[e] = fmaxf(__logf(f0), -30.0f); o[4 + e] = fmaxf(__logf(f1), -30.0f); }
                        w.x = pk_f16(o[0], o[1]); w.y = pk_f16(o[2], o[3]); w.z = pk_f16(o[4], o[5]); w.w = pk_f16(o[6], o[7]);
                    } else {
                        if (kind == K_SILU) {
#pragma unroll
                            for (int e = 0; e < 4; ++e) { v0[e] = v0[e] * fsigmoid(v0[e]); v1[e] = v1[e] * fsigmoid(v1[e]); }
                        } else if (roped) {
                            f32x4 o0, o1;
#pragma unroll
                            for (int e = 0; e < 4; ++e) { o0[e] = __shfl_xor(v0[e], 16); o1[e] = __shfl_xor(v1[e], 16); }
                            if (fq < 2) {
                                const float sg = (fq == 0) ? -1.0f : 1.0f;
                                v0 = v0 * cs0 + (o0 * sn0) * sg; v1 = v1 * cs1 + (o1 * sn1) * sg;
                            }
                        }
                        v0 = v0 * qs; v1 = v1 * qs;
                        w.x = cvt_pk_bf16(v0[0], v0[1]); w.y = cvt_pk_bf16(v0[2], v0[3]); w.z = cvt_pk_bf16(v1[0], v1[1]); w.w = cvt_pk_bf16(v1[2], v1[3]);
                    }
                    *(u32x4*)(outp + (size_t)row * pitch + c0) = w;
                }
                asm volatile("" ::: "memory");
            }
    }
};

struct EpiOut {
    static constexpr bool PERM = true;
    const float* xold; float* xnew; u16* xb; float* ssq;
    __device__ __forceinline__ void operator()(const f32x4 (&acc)[2][2][4][2], const Unit& u, int wr, int wc, int fr, int fq) const {
        int row0 = u.pm * BM + wr * 64 + fr; asm volatile("" : "+v"(row0));
#pragma unroll
        for (int ai = 0; ai < 2; ++ai)
#pragma unroll
            for (int m = 0; m < 4; ++m) {
                const int row = row0 + ai * HALF + m * 16; float part = 0.f;
#pragma unroll
                for (int bj = 0; bj < 2; ++bj) {
                    const int c0 = u.pn * BM + bj * HALF + wc * 32 + 8 * fq; const size_t off = (size_t)row * DM + c0;
                    const f32x4 n0 = *(const f32x4*)(xold + off) + acc[ai][bj][m][0], n1 = *(const f32x4*)(xold + off + 4) + acc[ai][bj][m][1];
                    *(f32x4*)(xnew + off) = n0; *(f32x4*)(xnew + off + 4) = n1;
                    u32x4 w; w.x = cvt_pk_bf16(n0[0], n0[1]); w.y = cvt_pk_bf16(n0[2], n0[3]); w.z = cvt_pk_bf16(n1[0], n1[1]); w.w = cvt_pk_bf16(n1[2], n1[3]);
                    *(u32x4*)(xb + off) = w;
                    part += (n0[0] * n0[0] + n0[1] * n0[1]) + (n0[2] * n0[2] + n0[3] * n0[3]) + (n1[0] * n1[0] + n1[1] * n1[1]) + (n1[2] * n1[2] + n1[3] * n1[3]);
                }
                part += __shfl_xor(part, 16); part += __shfl_xor(part, 32);
                if (fq == 0) ssq[(size_t)row * 16 + u.pn * 4 + wc] = part;
                asm volatile("" ::: "memory");
            }
    }
};
}
namespace att {
typedef unsigned short u16;
using bf16x8 = __attribute__((ext_vector_type(8))) short;
using s16x4  = __attribute__((ext_vector_type(4))) short;
using f32x16 = __attribute__((ext_vector_type(16))) float;
using f32x4  = __attribute__((ext_vector_type(4))) float;
using u32x4  = __attribute__((ext_vector_type(4))) unsigned;
#define KSWZ(row, colB) ((row) * 256 + ((colB) ^ (((row) & 7) << 4)))
#define KSWZ128(row, colB) ((row) * 128 + ((colB) ^ (((row) & 7) << 4)))
#define SBAR() __builtin_amdgcn_sched_barrier(0)
constexpr float THRL = 8.0f;
__device__ __forceinline__ int crow(int r, int hi) { return (r & 3) + 8 * (r >> 2) + 4 * hi; }
__device__ __forceinline__ unsigned cvtpk(float lo, float hi) { unsigned r; asm volatile("v_cvt_pk_bf16_f32 %0, %1, %2" : "=v"(r) : "v"(lo), "v"(hi)); return r; }
__device__ __forceinline__ bf16x8 ld8(const u16* p) { return *reinterpret_cast<const bf16x8*>(p); }
__device__ __forceinline__ float bf2f(unsigned short h) { return __uint_as_float((unsigned)h << 16); }

__device__ __forceinline__ void partialSM(f32x16& p0, f32x16& p1, float& m_reg, float& alpha) {
    float pmax = p0[0];
#pragma unroll
    for (int r = 1; r < 16; ++r) pmax = fmaxf(pmax, p0[r]);
#pragma unroll
    for (int r = 0; r < 16; ++r) pmax = fmaxf(pmax, p1[r]);
    { auto rr = __builtin_amdgcn_permlane32_swap(__float_as_uint(pmax), __float_as_uint(pmax), false, false);
      pmax = fmaxf(__uint_as_float(rr[0]), __uint_as_float(rr[1])); }
    float mn;
    if (__builtin_expect(__all(pmax - m_reg <= THRL), 1)) { mn = m_reg; alpha = 1.f; }
    else { mn = fmaxf(m_reg, pmax); alpha = __builtin_amdgcn_exp2f(m_reg - mn); m_reg = mn; }
#pragma unroll
    for (int r = 0; r < 16; ++r) { p0[r] -= mn; p1[r] -= mn; }
#pragma unroll
    for (int r = 0; r < 16; ++r) p0[r] = __builtin_amdgcn_exp2f(p0[r]);
}
__device__ __forceinline__ void finishSM(f32x16& p0, f32x16& p1, float alpha, float& l_reg, bf16x8& pa0, bf16x8& pa1, bf16x8& pa2, bf16x8& pa3) {
#pragma unroll
    for (int r = 0; r < 16; ++r) p1[r] = __builtin_amdgcn_exp2f(p1[r]);
    float ps = 0;
#pragma unroll
    for (int r = 0; r < 16; ++r) ps += p0[r];
#pragma unroll
    for (int r = 0; r < 16; ++r) ps += p1[r];
    { auto rr = __builtin_amdgcn_permlane32_swap(__float_as_uint(ps), __float_as_uint(ps), false, false);
      ps = __uint_as_float(rr[0]) + __uint_as_float(rr[1]); }
    l_reg = l_reg * alpha + ps;
#define PK4(P, BASE, OUT) do { unsigned a0 = cvtpk(P[BASE + 0], P[BASE + 1]), a1 = cvtpk(P[BASE + 2], P[BASE + 3]);   \
    unsigned b0 = cvtpk(P[BASE + 4], P[BASE + 5]), b1 = cvtpk(P[BASE + 6], P[BASE + 7]);                              \
    auto r0 = __builtin_amdgcn_permlane32_swap(a0, b0, false, false); auto r1 = __builtin_amdgcn_permlane32_swap(a1, b1, false, false); \
    u32x4 w = {r0[0], r1[0], r0[1], r1[1]}; OUT = *reinterpret_cast<bf16x8*>(&w); } while (0)
    PK4(p0, 0, pa0); PK4(p0, 8, pa1); PK4(p1, 0, pa2); PK4(p1, 8, pa3);
}
__device__ __forceinline__ void pack4(const f32x16& p0, const f32x16& p1, bf16x8& pa0, bf16x8& pa1, bf16x8& pa2, bf16x8& pa3) {
    PK4(p0, 0, pa0); PK4(p0, 8, pa1); PK4(p1, 0, pa2); PK4(p1, 8, pa3);
}
#undef PK4

template <int NCB> __device__ __forceinline__ int v_st(int k, int c) { const int kk = (k & ~0xC) | ((k & 4) << 1) | ((k & 8) >> 1); return ((kk >> 3) * NCB + (c >> 5)) * 512 + ((kk & 7) * 32 + (c & 31)) * 2; }
__device__ __forceinline__ int v_rd_base(int lane) { return ((lane & 3) << 3) | (((lane >> 2) & 3) << 6) | (((lane >> 4) & 1) << 5) | (((lane >> 5) & 1) << 8); }
template <int OFF> __device__ __forceinline__ s16x4 tr_read(int vb) { s16x4 r; asm volatile("ds_read_b64_tr_b16 %0, %1 offset:%2" : "=&v"(r) : "v"(vb), "i"(OFF) : "memory"); return r; }
#define PKF(L, H) (bf16x8){L[0], L[1], L[2], L[3], H[0], H[1], H[2], H[3]}
template <int NCB> __device__ __forceinline__ void pv_blk(f32x16& od, int vb, bf16x8 pa0, bf16x8 pa1, bf16x8 pa2, bf16x8 pa3) {
    constexpr int KS = NCB * 1024, HF = NCB * 512;
    const s16x4 l0 = tr_read<0 * KS>(vb), h0 = tr_read<0 * KS + HF>(vb), l1 = tr_read<1 * KS>(vb), h1 = tr_read<1 * KS + HF>(vb);
    const s16x4 l2 = tr_read<2 * KS>(vb), h2 = tr_read<2 * KS + HF>(vb), l3 = tr_read<3 * KS>(vb), h3 = tr_read<3 * KS + HF>(vb);
    asm volatile("s_waitcnt lgkmcnt(0)" ::: "memory"); SBAR();
    od = __builtin_amdgcn_mfma_f32_32x32x16_bf16(pa0, PKF(l0, h0), od, 0, 0, 0);
    od = __builtin_amdgcn_mfma_f32_32x32x16_bf16(pa1, PKF(l1, h1), od, 0, 0, 0);
    od = __builtin_amdgcn_mfma_f32_32x32x16_bf16(pa2, PKF(l2, h2), od, 0, 0, 0);
    od = __builtin_amdgcn_mfma_f32_32x32x16_bf16(pa3, PKF(l3, h3), od, 0, 0, 0);
}

constexpr int DA_SHM_V = 16384, DA_SHM_K = 16384, DA_WS = 65536, DA_STG = 67584, DA_STG_LD = 132;
__device__ __forceinline__ void qkt_da(f32x16& p0, f32x16& p1, const char* Ks, const bf16x8* qr, int r32, int hi, int cb0) {
    p0 = f32x16{}; p1 = f32x16{};
#pragma unroll
    for (int d0 = 0; d0 < 4; ++d0) { const int cb = cb0 + (d0 * 16 + hi * 8) * 2;
        const bf16x8 b0 = *reinterpret_cast<const bf16x8*>(Ks + KSWZ(r32, cb));
        const bf16x8 b1 = *reinterpret_cast<const bf16x8*>(Ks + KSWZ(32 + r32, cb));
        p0 = __builtin_amdgcn_mfma_f32_32x32x16_bf16(b0, qr[d0], p0, 0, 0, 0);
        p1 = __builtin_amdgcn_mfma_f32_32x32x16_bf16(b1, qr[d0], p1, 0, 0, 0); }
}
__device__ __forceinline__ void pv_da(f32x16* o, int vb, bf16x8 pa0, bf16x8 pa1, bf16x8 pa2, bf16x8 pa3) {
    pv_blk<4>(o[0], vb, pa0, pa1, pa2, pa3); pv_blk<4>(o[1], vb + 512, pa0, pa1, pa2, pa3); pv_blk<4>(o[2], vb + 1024, pa0, pa1, pa2, pa3); pv_blk<4>(o[3], vb + 1536, pa0, pa1, pa2, pa3);
}
__device__ __forceinline__ void diff_attn_unit(int b, int h, int qb, const u16* Qa, const u16* __restrict__ Ka, const u16* __restrict__ Va, const u16* __restrict__ Ga,
                                               u16* Y, const float* __restrict__ subw, float lam, float one_m_li, char* lds) {
    int tid = threadIdx.x; asm volatile("" : "+v"(tid)); const int lane = tid & 63, r32 = lane & 31, hi = lane >> 5; const int wid = __builtin_amdgcn_readfirstlane(tid >> 6);
    const int map = wid >> 2, wq = wid & 3;
    const long rowbase = (long)b * SEQ; const int q0 = qb * 128;
    char* V_lds = lds; char* K_lds = lds + 2 * DA_SHM_V;
    float* wsf = (float*)(lds + DA_WS) + wid * 64; float* li_l = wsf; float* al_l = wsf + 32;
    float m_reg = -1e30f, l_reg = 0; f32x16 o[4] = {}; bf16x8 qr[4];
    const u16* Qw = Qa + (rowbase + q0 + wq * 32 + r32) * DM + h * 128 + map * 64 + hi * 8;
#pragma unroll
    for (int d0 = 0; d0 < 4; ++d0) qr[d0] = ld8(Qw + d0 * 16);
    const u16* Kh = Ka + rowbase * DM + h * 128; const u16* Vh = Va + rowbase * DM + h * 128;
    const int sr = tid >> 4, sc = (tid & 15) * 8, vst0 = v_st<4>(sr, sc), vst1 = v_st<4>(32 + sr, sc);
    const int vb0 = (int)(uintptr_t)V_lds + v_rd_base(lane);
    const int cb0 = map * 128;
    struct { bf16x8 vs0, vs1, ks0, ks1; } sr_[2];
#define SLOAD(i, k0) do { sr_[i].vs0 = ld8(&Vh[(long)((k0) + sr) * DM + sc]); sr_[i].vs1 = ld8(&Vh[(long)((k0) + 32 + sr) * DM + sc]); \
    sr_[i].ks0 = ld8(&Kh[(long)((k0) + sr) * DM + sc]); sr_[i].ks1 = ld8(&Kh[(long)((k0) + 32 + sr) * DM + sc]); } while (0)
#define SWRITE(bb, i) do { *(bf16x8*)(V_lds + (bb) * DA_SHM_V + vst0) = sr_[i].vs0; *(bf16x8*)(V_lds + (bb) * DA_SHM_V + vst1) = sr_[i].vs1; const int kc = sc * 2; \
    *(bf16x8*)(K_lds + (bb) * DA_SHM_K + KSWZ(sr, kc)) = sr_[i].ks0; *(bf16x8*)(K_lds + (bb) * DA_SHM_K + KSWZ(32 + sr, kc)) = sr_[i].ks1; } while (0)
#define SWAIT() asm volatile("s_waitcnt vmcnt(4)" ::: "memory")
#define RESC(a) do { if (__any((a) < 1.f)) { if (hi == 0) al_l[r32] = (a); asm volatile("s_waitcnt lgkmcnt(0)" ::: "memory"); \
    _Pragma("unroll") for (int d = 0; d < 4; ++d) _Pragma("unroll") for (int r = 0; r < 16; ++r) o[d][r] *= al_l[crow(r, hi)]; } } while (0)
    f32x16 pA0, pA1, pB0, pB1; float alA, alB; bf16x8 pa0, pa1, pa2, pa3; constexpr int NT = SEQ / 64;
    constexpr int SE = 0, SO = 1;
    SLOAD(SE, 0); asm volatile("s_waitcnt vmcnt(0)" ::: "memory"); SWRITE(0, SE); __syncthreads();
    qkt_da(pA0, pA1, K_lds, qr, r32, hi, cb0); partialSM(pA0, pA1, m_reg, alA);
    SLOAD(SO, 64); SLOAD(SE, 128);
    SWAIT(); SWRITE(1, SO); __syncthreads();
    for (int j = 1; j + 1 < NT; j += 2) {
        SBAR(); qkt_da(pB0, pB1, K_lds + DA_SHM_K, qr, r32, hi, cb0);
        finishSM(pA0, pA1, alA, l_reg, pa0, pa1, pa2, pa3); SBAR();
        SLOAD(SO, (j + 2) * 64); SBAR();
        pv_da(o, vb0, pa0, pa1, pa2, pa3); partialSM(pB0, pB1, m_reg, alB);
        __syncthreads(); SWAIT(); SWRITE(0, SE);
        RESC(alB); __syncthreads();
        SBAR(); qkt_da(pA0, pA1, K_lds, qr, r32, hi, cb0);
        finishSM(pB0, pB1, alB, l_reg, pa0, pa1, pa2, pa3); SBAR();
        if (j + 3 < NT) SLOAD(SE, (j + 3) * 64); SBAR();
        pv_da(o, vb0 + DA_SHM_V, pa0, pa1, pa2, pa3); partialSM(pA0, pA1, m_reg, alA);
        __syncthreads(); SWAIT(); SWRITE(1, SO);
        RESC(alA); __syncthreads();
    }
    SBAR(); qkt_da(pB0, pB1, K_lds + DA_SHM_K, qr, r32, hi, cb0);
    finishSM(pA0, pA1, alA, l_reg, pa0, pa1, pa2, pa3); SBAR();
    pv_da(o, vb0, pa0, pa1, pa2, pa3); partialSM(pB0, pB1, m_reg, alB);
    __syncthreads(); RESC(alB);
    finishSM(pB0, pB1, alB, l_reg, pa0, pa1, pa2, pa3); SBAR();
    pv_da(o, vb0 + DA_SHM_V, pa0, pa1, pa2, pa3);
#undef SLOAD
#undef SWRITE
#undef SWAIT
#undef RESC
    if (hi == 0) li_l[r32] = l_reg; asm volatile("s_waitcnt lgkmcnt(0)" ::: "memory");
    float rli[16];
#pragma unroll
    for (int r = 0; r < 16; ++r) rli[r] = __builtin_amdgcn_rcpf(li_l[crow(r, hi)]) * (map ? lam : 1.0f);
    __syncthreads();
    float* xch = (float*)lds;
    if (map == 1) {
#pragma unroll
        for (int d0 = 0; d0 < 4; ++d0)
#pragma unroll
            for (int r = 0; r < 16; ++r) xch[((wq * 4 + d0) * 16 + r) * 64 + lane] = o[d0][r] * rli[r];
    }
    __syncthreads();
    float* stg = (float*)(lds + DA_STG);
    if (map == 0) {
#pragma unroll
        for (int d0 = 0; d0 < 4; ++d0)
#pragma unroll
            for (int r = 0; r < 16; ++r) { const float dv = o[d0][r] * rli[r] - xch[((wq * 4 + d0) * 16 + r) * 64 + lane];
                stg[(wq * 32 + crow(r, hi)) * DA_STG_LD + d0 * 32 + r32] = dv; }
    }
    __syncthreads();
    {
        const int row = tid >> 2, qt = tid & 3; const float* sp = stg + row * DA_STG_LD + qt * 32;
        f32x4 dv[8]; float ss = 0.f;
#pragma unroll
        for (int g = 0; g < 8; ++g) { dv[g] = *(const f32x4*)(sp + g * 4); ss += (dv[g][0] * dv[g][0] + dv[g][1] * dv[g][1]) + (dv[g][2] * dv[g][2] + dv[g][3] * dv[g][3]); }
        ss += __shfl_xor(ss, 1); ss += __shfl_xor(ss, 2);
        const float sc2 = __builtin_amdgcn_rsqf(ss * (1.0f / 128.0f) + EPS) * one_m_li;
        const size_t goff = (size_t)(rowbase + q0 + row) * DM + h * 128 + qt * 32;
#pragma unroll
        for (int g = 0; g < 4; ++g) {
            const bf16x8 gt = ld8(Ga + goff + g * 8);
            const f32x4 w0 = *(const f32x4*)(subw + qt * 32 + g * 8), w1 = *(const f32x4*)(subw + qt * 32 + g * 8 + 4);
            const f32x4 a = dv[2 * g], c = dv[2 * g + 1];
            u32x4 w;
            w.x = cvtpk(a[0] * sc2 * w0[0] * bf2f((u16)gt[0]), a[1] * sc2 * w0[1] * bf2f((u16)gt[1]));
            w.y = cvtpk(a[2] * sc2 * w0[2] * bf2f((u16)gt[2]), a[3] * sc2 * w0[3] * bf2f((u16)gt[3]));
            w.z = cvtpk(c[0] * sc2 * w1[0] * bf2f((u16)gt[4]), c[1] * sc2 * w1[1] * bf2f((u16)gt[5]));
            w.w = cvtpk(c[2] * sc2 * w1[2] * bf2f((u16)gt[6]), c[3] * sc2 * w1[3] * bf2f((u16)gt[7]));
            *(u32x4*)(Y + goff + g * 8) = w;
        }
    }
    __syncthreads();
}

constexpr int SW_SHM = 8192, SW_WS = 32768, SW_STG = 34816, SW_STG_LD = 68;
__device__ __forceinline__ void swa_unit(int b, int kvh, int qb, const u16* Q, const u16* __restrict__ Kb, const u16* __restrict__ Vb, const u16* __restrict__ Gt, u16* Y,
                                         const float* __restrict__ sink, char* lds) {
    int tid = threadIdx.x; asm volatile("" : "+v"(tid)); const int lane = tid & 63, r32 = lane & 31, hi = lane >> 5; const int wid = __builtin_amdgcn_readfirstlane(tid >> 6);
    const int hq = kvh * 8 + wid; const long rowbase = (long)b * SEQ; const int q0 = qb * 32;
    char* V_lds = lds; char* K_lds = lds + 2 * SW_SHM;
    float* wsf = (float*)(lds + SW_WS) + wid * 64; float* li_l = wsf; float* al_l = wsf + 32;
    float m_reg = sink[hq] * LOG2E, l_reg = 1.0f; f32x16 o[2] = {}; bf16x8 qr[4];
    const u16* Qw = Q + (rowbase + q0 + r32) * DIN + hq * 64 + hi * 8;
#pragma unroll
    for (int d0 = 0; d0 < 4; ++d0) qr[d0] = ld8(Qw + d0 * 16);
    const int t_lo = (q0 >= 128 ? q0 - 128 : 0) >> 6, t_hi = ((q0 + 159 < SEQ ? q0 + 159 : SEQ - 1)) >> 6, NT = t_hi - t_lo + 1;
    const u16* Kh = Kb + rowbase * 256 + kvh * 64; const u16* Vh = Vb + rowbase * 256 + kvh * 64;
    const int sr = tid >> 3, sc = (tid & 7) * 8, vst0 = v_st<2>(sr, sc), kst0 = KSWZ128(sr, sc * 2);
    const int vb0 = (int)(uintptr_t)V_lds + v_rd_base(lane);
    bf16x8 sv, sk;
    sv = ld8(&Vh[(long)(t_lo * 64 + sr) * 256 + sc]); sk = ld8(&Kh[(long)(t_lo * 64 + sr) * 256 + sc]);
    *(bf16x8*)(V_lds + vst0) = sv; *(bf16x8*)(K_lds + kst0) = sk;
    __syncthreads();
    for (int j = 0; j < NT; ++j) {
        const int bb = j & 1; const int k0 = (t_lo + j) * 64;
        if (j + 1 < NT) { sv = ld8(&Vh[(long)(k0 + 64 + sr) * 256 + sc]); sk = ld8(&Kh[(long)(k0 + 64 + sr) * 256 + sc]); }
        f32x16 p0 = f32x16{}, p1 = f32x16{};
        const char* Ks = K_lds + bb * SW_SHM;
#pragma unroll
        for (int d0 = 0; d0 < 4; ++d0) { const int cb = (d0 * 16 + hi * 8) * 2;
            const bf16x8 b0 = *reinterpret_cast<const bf16x8*>(Ks + KSWZ128(r32, cb));
            const bf16x8 b1 = *reinterpret_cast<const bf16x8*>(Ks + KSWZ128(32 + r32, cb));
            p0 = __builtin_amdgcn_mfma_f32_32x32x16_bf16(b0, qr[d0], p0, 0, 0, 0);
            p1 = __builtin_amdgcn_mfma_f32_32x32x16_bf16(b1, qr[d0], p1, 0, 0, 0); }
        {
            const int qi = q0 + r32;
#pragma unroll
            for (int r = 0; r < 16; ++r) { const int kk = k0 + crow(r, hi); int dd = kk - qi; if (dd < 0) dd = -dd; if (dd > 128) p0[r] = -1e30f; int d2 = kk + 32 - qi; if (d2 < 0) d2 = -d2; if (d2 > 128) p1[r] = -1e30f; }
        }
        float alpha; bf16x8 pa0, pa1, pa2, pa3;
        partialSM(p0, p1, m_reg, alpha);
        if (__any(alpha < 1.f)) { if (hi == 0) al_l[r32] = alpha; asm volatile("s_waitcnt lgkmcnt(0)" ::: "memory");
#pragma unroll
            for (int d = 0; d < 2; ++d)
#pragma unroll
                for (int r = 0; r < 16; ++r) o[d][r] *= al_l[crow(r, hi)]; }
        finishSM(p0, p1, alpha, l_reg, pa0, pa1, pa2, pa3); SBAR();
        pv_blk<2>(o[0], vb0 + bb * SW_SHM, pa0, pa1, pa2, pa3); pv_blk<2>(o[1], vb0 + bb * SW_SHM + 512, pa0, pa1, pa2, pa3);
        if (j + 1 < NT) { *(bf16x8*)(V_lds + (bb ^ 1) * SW_SHM + vst0) = sv; *(bf16x8*)(K_lds + (bb ^ 1) * SW_SHM + kst0) = sk; }
        __syncthreads();
    }
    if (hi == 0) li_l[r32] = l_reg; asm volatile("s_waitcnt lgkmcnt(0)" ::: "memory");
    float* stg = (float*)(lds + SW_STG) + wid * (32 * SW_STG_LD);
#pragma unroll
    for (int r = 0; r < 16; ++r) { const float rl = __builtin_amdgcn_rcpf(li_l[crow(r, hi)]);
        stg[crow(r, hi) * SW_STG_LD + r32] = o[0][r] * rl; stg[crow(r, hi) * SW_STG_LD + 32 + r32] = o[1][r] * rl; }
    asm volatile("s_waitcnt lgkmcnt(0)" ::: "memory");
#pragma unroll
    for (int i = 0; i < 4; ++i) { const int row = i * 8 + (lane >> 3), ch = lane & 7;
        const f32x4 a = *(const f32x4*)(stg + row * SW_STG_LD + ch * 8), c = *(const f32x4*)(stg + row * SW_STG_LD + ch * 8 + 4);
        const size_t goff = (size_t)(rowbase + q0 + row) * DIN + hq * 64 + ch * 8;
        const bf16x8 gt = ld8(Gt + goff);
        u32x4 w;
        w.x = cvtpk(a[0] * bf2f((u16)gt[0]), a[1] * bf2f((u16)gt[1])); w.y = cvtpk(a[2] * bf2f((u16)gt[2]), a[3] * bf2f((u16)gt[3]));
        w.z = cvtpk(c[0] * bf2f((u16)gt[4]), c[1] * bf2f((u16)gt[5])); w.w = cvtpk(c[2] * bf2f((u16)gt[6]), c[3] * bf2f((u16)gt[7]));
        *(u32x4*)(Y + goff) = w; }
    __syncthreads();
}
}
namespace hg {
using namespace att;
typedef _Float16 f16;
constexpr int L_QT = 0, L_KT = 16384, L_QIN = 32768, L_KDEC = 49152, L_V = 65536, L_S = 81920, L_CUM = 114688, L_EDEC = 118784, L_STG = 0, STG_LD = 132;

struct ChunkRegs { unsigned q[8], v[8], lf[8]; };

__device__ __forceinline__ int chunk_pos(int c, int i, int dir) { return dir ? (c * 64 + 63 - i) : (c * 64 + i); }

template <bool NEEDQ>
__device__ __forceinline__ void load_chunk(ChunkRegs& R, const u16* Qh, const u16* Vh, const u16* LF, long rowbase, int colbase, int c, int dir, int wid, int lane) {
#pragma unroll
    for (int i = 0; i < 8; ++i) {
        const long pos = rowbase + chunk_pos(c, wid * 8 + i, dir);
        const size_t off = (size_t)pos * DM + colbase + 2 * lane;
        if (NEEDQ) R.q[i] = *(const unsigned*)(Qh + off);
        R.v[i] = *(const unsigned*)(Vh + off);
        R.lf[i] = *(const unsigned*)(LF + off);
    }
}
__device__ __forceinline__ float h2f(unsigned short h) { return (float)__builtin_bit_cast(f16, h); }

template <bool FULL>
__device__ __forceinline__ void prep_chunk(const ChunkRegs& R, char* lds, int wid, int lane, float (&gtot)[2]) {
    float g[8][2]; float run0 = 0.f, run1 = 0.f;
#pragma unroll
    for (int i = 0; i < 8; ++i) { run0 += h2f((unsigned short)(R.lf[i] & 0xffff)); run1 += h2f((unsigned short)(R.lf[i] >> 16)); g[i][0] = run0; g[i][1] = run1; }
    float* cum = (float*)(lds + L_CUM);
    *(float2*)(cum + wid * 128 + 2 * lane) = make_float2(run0, run1);
    __syncthreads();
    float pre0 = 0.f, pre1 = 0.f, gm0 = 0.f, gm1 = 0.f, gl0 = 0.f, gl1 = 0.f;
#pragma unroll
    for (int w2 = 0; w2 < 8; ++w2) { const float2 t = *(const float2*)(cum + w2 * 128 + 2 * lane);
        if (w2 < wid) { pre0 += t.x; pre1 += t.y; } if (w2 < 4) { gm0 += t.x; gm1 += t.y; } gl0 += t.x; gl1 += t.y; }
    gtot[0] += gl0; gtot[1] += gl1;
    const float egm0 = __expf(gm0), egm1 = __expf(gm1), elm0 = __expf(gl0 - gm0), elm1 = __expf(gl1 - gm1);
    if (wid == 0) *(float2*)((float*)(lds + L_EDEC) + 2 * lane) = make_float2(__expf(gl0), __expf(gl1));
#pragma unroll
    for (int i = 0; i < 8; ++i) {
        const int row = wid * 8 + i;
        const float G0 = pre0 + g[i][0], G1 = pre1 + g[i][1];
        const float e0 = __expf(G0 - gm0), e1 = __expf(G1 - gm1);
        const float r0 = __builtin_amdgcn_rcpf(e0), r1 = __builtin_amdgcn_rcpf(e1);
        const float lf0 = h2f((unsigned short)(R.lf[i] & 0xffff)), lf1 = h2f((unsigned short)(R.lf[i] >> 16));
        const float k0 = 1.0f - __expf(lf0), k1 = 1.0f - __expf(lf1);
        const float kt0 = k0 * r0, kt1 = k1 * r1;
        const int vo = v_st<4>(row, 2 * lane);
        *(unsigned*)(lds + L_KDEC + vo) = cvtpk(kt0 * elm0, kt1 * elm1);
        *(unsigned*)(lds + L_V + vo) = R.v[i];
        if (FULL) {
            const float q0 = bf2f((u16)(R.q[i] & 0xffff)), q1 = bf2f((u16)(R.q[i] >> 16));
            const float qt0 = q0 * e0, qt1 = q1 * e1;
            const int ko = KSWZ(row, 4 * lane);
            *(unsigned*)(lds + L_QT + ko) = cvtpk(qt0, qt1);
            *(unsigned*)(lds + L_KT + ko) = cvtpk(kt0, kt1);
            *(unsigned*)(lds + L_QIN + ko) = cvtpk(qt0 * egm0, qt1 * egm1);
        }
    }
}

template <int KS> __device__ __forceinline__ bf16x8 tr_frag(int vb) {
    const s16x4 l = tr_read<KS * 4096>(vb), h = tr_read<KS * 4096 + 2048>(vb);
    asm volatile("s_waitcnt lgkmcnt(0)" ::: "memory"); SBAR();
    return PKF(l, h);
}

__device__ __forceinline__ void state_update(f32x16 (&sacc)[2], const char* lds, int ldsbase, int wid, int lane) {
    const int r32 = lane & 31, hi = lane >> 5, j = wid >> 1, ib = 2 * (wid & 1);
    const float* edec = (const float*)(lds + L_EDEC);
#pragma unroll
    for (int i2 = 0; i2 < 2; ++i2)
#pragma unroll
        for (int r = 0; r < 16; ++r) sacc[i2][r] *= edec[32 * (ib + i2) + crow(r, hi)];
    const int vbV = ldsbase + L_V + v_rd_base(lane) + j * 512;
    const int vbK0 = ldsbase + L_KDEC + v_rd_base(lane) + ib * 512, vbK1 = vbK0 + 512;
    { const bf16x8 bv = tr_frag<0>(vbV), a0 = tr_frag<0>(vbK0), a1 = tr_frag<0>(vbK1);
      sacc[0] = __builtin_amdgcn_mfma_f32_32x32x16_bf16(a0, bv, sacc[0], 0, 0, 0); sacc[1] = __builtin_amdgcn_mfma_f32_32x32x16_bf16(a1, bv, sacc[1], 0, 0, 0); }
    { const bf16x8 bv = tr_frag<1>(vbV), a0 = tr_frag<1>(vbK0), a1 = tr_frag<1>(vbK1);
      sacc[0] = __builtin_amdgcn_mfma_f32_32x32x16_bf16(a0, bv, sacc[0], 0, 0, 0); sacc[1] = __builtin_amdgcn_mfma_f32_32x32x16_bf16(a1, bv, sacc[1], 0, 0, 0); }
    { const bf16x8 bv = tr_frag<2>(vbV), a0 = tr_frag<2>(vbK0), a1 = tr_frag<2>(vbK1);
      sacc[0] = __builtin_amdgcn_mfma_f32_32x32x16_bf16(a0, bv, sacc[0], 0, 0, 0); sacc[1] = __builtin_amdgcn_mfma_f32_32x32x16_bf16(a1, bv, sacc[1], 0, 0, 0); }
    { const bf16x8 bv = tr_frag<3>(vbV), a0 = tr_frag<3>(vbK0), a1 = tr_frag<3>(vbK1);
      sacc[0] = __builtin_amdgcn_mfma_f32_32x32x16_bf16(a0, bv, sacc[0], 0, 0, 0); sacc[1] = __builtin_amdgcn_mfma_f32_32x32x16_bf16(a1, bv, sacc[1], 0, 0, 0); }
}
__device__ __forceinline__ void write_simg(const f32x16 (&sacc)[2], char* lds, int wid, int lane) {
    const int r32 = lane & 31, hi = lane >> 5, j = wid >> 1, ib = 2 * (wid & 1);
#pragma unroll
    for (int i2 = 0; i2 < 2; ++i2)
#pragma unroll
        for (int r = 0; r < 16; ++r) { const int d = 32 * (ib + i2) + crow(r, hi);
            *(__hip_bfloat16*)(lds + L_S + (d >> 6) * 16384 + v_st<4>(d & 63, 32 * j + r32)) = __float2bfloat16(sacc[i2][r]); }
}
__device__ __forceinline__ f32x16 chunk_output(const char* lds, int ldsbase, int wid, int lane) {
    const int r32 = lane & 31, hi = lane >> 5, tb = wid & 1, j = wid >> 1;
    const char* QT = lds + L_QT; const char* KT = lds + L_KT; const char* QIN = lds + L_QIN;
    f32x16 p0 = f32x16{}, p1 = f32x16{};
#pragma unroll
    for (int d0 = 0; d0 < 8; ++d0) { const int cb = (d0 * 16 + hi * 8) * 2;
        const bf16x8 qf = *reinterpret_cast<const bf16x8*>(QT + KSWZ(32 * tb + r32, cb));
        const bf16x8 k0 = *reinterpret_cast<const bf16x8*>(KT + KSWZ(r32, cb));
        p0 = __builtin_amdgcn_mfma_f32_32x32x16_bf16(k0, qf, p0, 0, 0, 0);
        if (tb) { const bf16x8 k1 = *reinterpret_cast<const bf16x8*>(KT + KSWZ(32 + r32, cb)); p1 = __builtin_amdgcn_mfma_f32_32x32x16_bf16(k1, qf, p1, 0, 0, 0); } }
#pragma unroll
    for (int r = 0; r < 16; ++r) { const bool keep = crow(r, hi) <= r32; if (tb == 0) { p0[r] = keep ? p0[r] : 0.f; p1[r] = 0.f; } else { p1[r] = keep ? p1[r] : 0.f; } }
    bf16x8 pa0, pa1, pa2, pa3; pack4(p0, p1, pa0, pa1, pa2, pa3);
    f32x16 oacc = f32x16{};
    pv_blk<4>(oacc, ldsbase + L_V + v_rd_base(lane) + j * 512, pa0, pa1, pa2, pa3);
    const int vbS = ldsbase + L_S + v_rd_base(lane) + j * 512;
#define QINF(kd) (*reinterpret_cast<const bf16x8*>(QIN + KSWZ(32 * tb + r32, ((kd) * 16 + hi * 8) * 2)))
    { const bf16x8 b = tr_frag<0>(vbS); oacc = __builtin_amdgcn_mfma_f32_32x32x16_bf16(QINF(0), b, oacc, 0, 0, 0); }
    { const bf16x8 b = tr_frag<1>(vbS); oacc = __builtin_amdgcn_mfma_f32_32x32x16_bf16(QINF(1), b, oacc, 0, 0, 0); }
    { const bf16x8 b = tr_frag<2>(vbS); oacc = __builtin_amdgcn_mfma_f32_32x32x16_bf16(QINF(2), b, oacc, 0, 0, 0); }
    { const bf16x8 b = tr_frag<3>(vbS); oacc = __builtin_amdgcn_mfma_f32_32x32x16_bf16(QINF(3), b, oacc, 0, 0, 0); }
    { const bf16x8 b = tr_frag<0>(vbS + 16384); oacc = __builtin_amdgcn_mfma_f32_32x32x16_bf16(QINF(4), b, oacc, 0, 0, 0); }
    { const bf16x8 b = tr_frag<1>(vbS + 16384); oacc = __builtin_amdgcn_mfma_f32_32x32x16_bf16(QINF(5), b, oacc, 0, 0, 0); }
    { const bf16x8 b = tr_frag<2>(vbS + 16384); oacc = __builtin_amdgcn_mfma_f32_32x32x16_bf16(QINF(6), b, oacc, 0, 0, 0); }
    { const bf16x8 b = tr_frag<3>(vbS + 16384); oacc = __builtin_amdgcn_mfma_f32_32x32x16_bf16(QINF(7), b, oacc, 0, 0, 0); }
#undef QINF
    return oacc;
}

__device__ __forceinline__ void hgrn_pass1(int item, const u16* Vt, const u16* LF0, const u16* LF1, float* ust, float* dst, char* lds) {
    int tid = threadIdx.x; asm volatile("" : "+v"(tid)); const int lane = tid & 63; const int wid = __builtin_amdgcn_readfirstlane(tid >> 6);
    const int seg = item & 7, dir = (item >> 3) & 1, bh = item >> 4, b = bh >> 3, h = bh & 7;
    const long rowbase = (long)b * SEQ; const int colbase = h * 128; const u16* LF = dir ? LF1 : LF0;
    const int ldsbase = (int)(uintptr_t)lds;
    f32x16 sacc[2] = {}; float gtot[2] = {0.f, 0.f};
    ChunkRegs R;
    for (int cc = 0; cc < 8; ++cc) {
        const int c = dir ? (seg * 8 + 7 - cc) : (seg * 8 + cc);
        load_chunk<false>(R, nullptr, Vt, LF, rowbase, colbase, c, dir, wid, lane);
        prep_chunk<false>(R, lds, wid, lane, gtot);
        __syncthreads();
        state_update(sacc, lds, ldsbase, wid, lane);
        __syncthreads();
    }
    float* up = ust + (size_t)item * 16384 + wid * 2048;
#pragma unroll
    for (int i2 = 0; i2 < 2; ++i2)
#pragma unroll
        for (int r = 0; r < 16; ++r) up[(i2 * 16 + r) * 64 + lane] = sacc[i2][r];
    if (wid == 0) *(float2*)(dst + (size_t)item * 128 + 2 * lane) = make_float2(__expf(gtot[0]), __expf(gtot[1]));
}

__device__ __forceinline__ void hgrn_pass2(int item, const u16* Qh, const u16* Vt, const u16* LF0, const u16* LF1, const u16* Gt, u16* OF, u16* Y,
                                           const float* ust, const float* dst, const float* __restrict__ nw, char* lds) {
    int tid = threadIdx.x; asm volatile("" : "+v"(tid)); const int lane = tid & 63, r32 = lane & 31, hi = lane >> 5; const int wid = __builtin_amdgcn_readfirstlane(tid >> 6);
    const int seg = item & 7, bh = item >> 3, b = bh >> 3, h = bh & 7;
    const long rowbase = (long)b * SEQ; const int colbase = h * 128;
    const int ldsbase = (int)(uintptr_t)lds; const int tb = wid & 1, j = wid >> 1, ib = 2 * (wid & 1);
    float* stg = (float*)(lds + L_STG);
    ChunkRegs R;
#pragma unroll 1
    for (int dir = 0; dir < 2; ++dir) {
        const u16* LF = dir ? LF1 : LF0;
        f32x16 sacc[2] = {}; float gtot[2] = {0.f, 0.f};
        const int nseg = dir ? (7 - seg) : seg;
        for (int n = 0; n < nseg; ++n) {
            const int sg = dir ? (7 - n) : n; const int it = ((bh * 2 + dir) * 8 + sg);
            const float* up = ust + (size_t)it * 16384 + wid * 2048; const float* dp = dst + (size_t)it * 128;
#pragma unroll
            for (int i2 = 0; i2 < 2; ++i2)
#pragma unroll
                for (int r = 0; r < 16; ++r) sacc[i2][r] = sacc[i2][r] * dp[32 * (ib + i2) + crow(r, hi)] + up[(i2 * 16 + r) * 64 + lane];
        }
        write_simg(sacc, lds, wid, lane);
        for (int cc = 0; cc < 8; ++cc) {
            const int c = dir ? (seg * 8 + 7 - cc) : (seg * 8 + cc);
            load_chunk<true>(R, Qh, Vt, LF, rowbase, colbase, c, dir, wid, lane);
            prep_chunk<true>(R, lds, wid, lane, gtot);
            __syncthreads();
            f32x16 oacc = chunk_output(lds, ldsbase, wid, lane);
            state_update(sacc, lds, ldsbase, wid, lane);
            __syncthreads();
            write_simg(sacc, lds, wid, lane);
#pragma unroll
            for (int r = 0; r < 16; ++r) stg[(32 * tb + crow(r, hi)) * STG_LD + 32 * j + r32] = oacc[r];
            __syncthreads();
            {
                const int i = tid >> 3, cg = tid & 7; const float* sp = stg + i * STG_LD + cg * 16;
                f32x4 ov[4];
#pragma unroll
                for (int g = 0; g < 4; ++g) ov[g] = *(const f32x4*)(sp + g * 4);
                const size_t goff = (size_t)(rowbase + chunk_pos(c, i, dir)) * DM + colbase + cg * 16;
                if (dir == 0) {
                    u32x4 w0, w1;
                    w0.x = pg8::pk_f16(ov[0][0], ov[0][1]); w0.y = pg8::pk_f16(ov[0][2], ov[0][3]); w0.z = pg8::pk_f16(ov[1][0], ov[1][1]); w0.w = pg8::pk_f16(ov[1][2], ov[1][3]);
                    w1.x = pg8::pk_f16(ov[2][0], ov[2][1]); w1.y = pg8::pk_f16(ov[2][2], ov[2][3]); w1.z = pg8::pk_f16(ov[3][0], ov[3][1]); w1.w = pg8::pk_f16(ov[3][2], ov[3][3]);
                    *(u32x4*)(OF + goff) = w0; *(u32x4*)(OF + goff + 8) = w1;
                } else {
                    const u32x4 f0 = *(const u32x4*)(OF + goff), f1 = *(const u32x4*)(OF + goff + 8);
                    float tv[16];
#pragma unroll
                    for (int e = 0; e < 4; ++e) { tv[2 * e] = h2f((unsigned short)(f0[e] & 0xffff)); tv[2 * e + 1] = h2f((unsigned short)(f0[e] >> 16));
                                                  tv[8 + 2 * e] = h2f((unsigned short)(f1[e] & 0xffff)); tv[8 + 2 * e + 1] = h2f((unsigned short)(f1[e] >> 16)); }
                    float ss = 0.f;
#pragma unroll
                    for (int e = 0; e < 16; ++e) { tv[e] += ov[e >> 2][e & 3]; ss += tv[e] * tv[e]; }
                    ss += __shfl_xor(ss, 1); ss += __shfl_xor(ss, 2); ss += __shfl_xor(ss, 4);
                    const float rs = __builtin_amdgcn_rsqf(ss * (1.0f / 128.0f) + EPS);
                    const bf16x8 g0 = ld8(Gt + goff), g1 = ld8(Gt + goff + 8);
                    float yv[16];
#pragma unroll
                    for (int e = 0; e < 8; ++e) { yv[e] = tv[e] * rs * nw[cg * 16 + e] * bf2f((u16)g0[e]); yv[8 + e] = tv[8 + e] * rs * nw[cg * 16 + 8 + e] * bf2f((u16)g1[e]); }
                    u32x4 w0, w1;
                    w0.x = cvtpk(yv[0], yv[1]); w0.y = cvtpk(yv[2], yv[3]); w0.z = cvtpk(yv[4], yv[5]); w0.w = cvtpk(yv[6], yv[7]);
                    w1.x = cvtpk(yv[8], yv[9]); w1.y = cvtpk(yv[10], yv[11]); w1.z = cvtpk(yv[12], yv[13]); w1.w = cvtpk(yv[14], yv[15]);
                    *(u32x4*)(Y + goff) = w0; *(u32x4*)(Y + goff + 8) = w1;
                }
            }
            __syncthreads();
        }
    }
}
}
#define GAS __attribute__((address_space(1)))
#define LAS __attribute__((address_space(3)))
typedef unsigned short bf16;
typedef unsigned v4u __attribute__((ext_vector_type(4)));
typedef float f32x4 __attribute__((ext_vector_type(4)));
typedef short bf16x8 __attribute__((ext_vector_type(8)));
typedef GAS unsigned gu32;
typedef GAS unsigned long long gu64;
#define RLX_AGENT __ATOMIC_RELAXED, __HIP_MEMORY_SCOPE_AGENT
#define LDS_WAIT() asm volatile("s_waitcnt lgkmcnt(0)" ::: "memory")
#define VM_WAIT() asm volatile("s_waitcnt vmcnt(0)" ::: "memory")
__device__ __forceinline__ unsigned long long rt() { return __builtin_amdgcn_s_memrealtime(); }
__device__ __forceinline__ unsigned f2bf(float f) { unsigned u = __builtin_bit_cast(unsigned, f); return (u + 0x7fffu + ((u >> 16) & 1u)) >> 16; }
__device__ __forceinline__ unsigned pk2(float lo, float hi) { return f2bf(lo) | (f2bf(hi) << 16); }

#define XB_TMO      128
#define XB_XCNT(j)  (256  + 64 * (j))
#define XB_XSUB(j)  (1280 + 64 * (j))
#define XB_XGEN(j)  (2304 + 64 * (j))
#define XB_TOP      3328
#define XB_TOPGEN   3392
#define XCD_BAR_WORDS 3456
#define XB_SPIN_CAP (1u << 18)

__device__ __forceinline__ unsigned xb_ld(unsigned* p)              { return __hip_atomic_load(p, __ATOMIC_RELAXED, __HIP_MEMORY_SCOPE_AGENT); }
__device__ __forceinline__ unsigned xb_add(unsigned* p, unsigned v) { return __hip_atomic_fetch_add(p, v, __ATOMIC_RELAXED, __HIP_MEMORY_SCOPE_AGENT); }
__device__ __forceinline__ unsigned xb_xcc_id() { return (unsigned)__builtin_amdgcn_s_getreg((3 << 11) | 20) & 0xFu; }
#define XB_SPIN(cond, bar) do { unsigned _sp = 0; while (cond) { __builtin_amdgcn_s_sleep(1); \
    if ((++_sp & 255u) == 0u) { if (xb_ld(&(bar)[XB_TMO])) break; if (_sp > XB_SPIN_CAP) { atomicAdd(&(bar)[XB_TMO], 1u); break; } } } } while (0)

struct XcdBarrier {
    unsigned* bar; unsigned x;
    volatile LAS unsigned* st;
};

__device__ __forceinline__ XcdBarrier xcd_barrier_post(unsigned* bar, volatile LAS unsigned* st) {
    XcdBarrier b; b.bar = bar; b.x = xb_xcc_id(); b.st = st;
    if (threadIdx.x == 0) (void)xb_add(&bar[XB_XCNT(b.x)], 1u);
    return b;
}
__device__ __forceinline__ void xcd_barrier_complete(unsigned* bar, unsigned x, unsigned& nloc, unsigned& nx) {
    const unsigned G = gridDim.x * gridDim.y * gridDim.z;
    unsigned sum, cnt, mine, sp = 0u;
    for (;;) {
        sum = 0u; cnt = 0u; mine = 0u;
#pragma unroll
        for (unsigned j = 0; j < 16; ++j) { const unsigned c = xb_ld(&bar[XB_XCNT(j)]); sum += c; cnt += (c > 0u) ? 1u : 0u; mine = (j == x) ? c : mine; }
        if (sum == G) break;
        __builtin_amdgcn_s_sleep(1);
        if ((++sp & 255u) == 0u) { if (xb_ld(&bar[XB_TMO])) break; if (sp > XB_SPIN_CAP) { atomicAdd(&bar[XB_TMO], 1u); break; } }
    }
    nloc = mine > 0u ? mine : 1u; nx = cnt > 0u ? cnt : 1u;
}

__device__ __forceinline__ void xcd_barrier(const XcdBarrier& b) {
    asm volatile("s_waitcnt vmcnt(0)" ::: "memory");
    __syncthreads();
    if (threadIdx.x == 0) {
        unsigned* bar = b.bar; asm volatile("" : "+s"(bar)); unsigned bx = __builtin_amdgcn_readfirstlane(b.x); asm volatile("" : "+s"(bx));
        __builtin_amdgcn_s_waitcnt(0);
        unsigned nloc = b.st[0], nx = b.st[1];
        if (nloc == 0u) { xcd_barrier_complete(bar, bx, nloc, nx); b.st[0] = nloc; b.st[1] = nx; }
        const unsigned old = xb_add(&bar[XB_XSUB(bx)], 1u);
        const unsigned gen = old / nloc;
        if (old + 1u == (gen + 1u) * nloc) {
            __builtin_amdgcn_fence(__ATOMIC_RELEASE, "agent");
            asm volatile("s_waitcnt vmcnt(0)" ::: "memory");
            const unsigned og = xb_add(&bar[XB_TOP], 1u);
            const unsigned tg = og / nx;
            if (og + 1u == (tg + 1u) * nx) xb_add(&bar[XB_TOPGEN], 1u);
            else XB_SPIN(xb_ld(&bar[XB_TOPGEN]) == tg, bar);
            __builtin_amdgcn_fence(__ATOMIC_ACQUIRE, "agent");
            xb_add(&bar[XB_XGEN(bx)], 1u);
            asm volatile("s_waitcnt vmcnt(0)" ::: "memory");
        } else {
            XB_SPIN(xb_ld(&bar[XB_XGEN(bx)]) == gen, bar);
            __builtin_amdgcn_fence(__ATOMIC_ACQUIRE, "agent");
            asm volatile("s_waitcnt vmcnt(0)" ::: "memory");
        }
    }
    __syncthreads();
}
#ifndef MK_PER_PHASE
#define MK_PER_PHASE 0
#endif

constexpr size_t MiB = 1u << 20;
constexpr size_t WS_CTL = 0, CTL_ZERO_BYTES = 1 * MiB;
constexpr size_t WS_ROPE = 1 * MiB;
constexpr size_t WS_LB = 1 * MiB + 256 * 1024;
constexpr size_t WS_DST = 1 * MiB + 512 * 1024;
constexpr size_t WS_SSQ = 2 * MiB;
constexpr size_t WS_WTE = 3 * MiB;
constexpr size_t WS_WTO = 25 * MiB;
constexpr size_t WS_XB = 38 * MiB;
constexpr size_t WS_R0 = 70 * MiB, RSZ = 32 * MiB;
constexpr size_t WS_END = WS_R0 + 6 * RSZ;
constexpr int CW_BAR = 4096;

constexpr int RING_BYTES = 139264;
constexpr int LDSCTL_OFF = RING_BYTES, MISC_OFF = LDSCTL_OFF + 320;
constexpr int LDS_BYTES = 147456;
constexpr int NWAVES = 8, GRID = 256;
constexpr int NPH = 20;

struct Frame {
    LAS unsigned char* lds; volatile LAS unsigned* MISC; gu32* ctl;
    int tid, lane, wave, vcu, G;
};

__device__ __forceinline__ void transpose_item(const float* W, const float* sc, int K, int N, bf16* WT, LAS float* scr, int item, int lane) {
    const int nblk = N / 32, kb = item / nblk, nb = item % nblk, k0 = 64 * kb, n0 = 32 * nb;
#pragma unroll 8
    for (int i = 0; i < 32; ++i) { const int kk = 2 * i + (lane >> 5); const float s = sc ? sc[k0 + kk] : 1.0f; scr[kk * 33 + (lane & 31)] = W[(size_t)(k0 + kk) * N + n0 + (lane & 31)] * s; }
    LDS_WAIT(); asm volatile("" ::: "memory");
    const int c = lane & 7;
#pragma unroll
    for (int j = 0; j < 4; ++j) { const int n = (lane >> 3) + 8 * j; const LAS float* s = scr + (8 * c) * 33 + n;
        v4u o; o.x = pk2(s[0 * 33], s[1 * 33]); o.y = pk2(s[2 * 33], s[3 * 33]); o.z = pk2(s[4 * 33], s[5 * 33]); o.w = pk2(s[6 * 33], s[7 * 33]);
        *(GAS v4u*)(WT + (size_t)(n0 + n) * K + k0 + 8 * c) = o; }
    LDS_WAIT(); asm volatile("" ::: "memory");
}
__device__ __forceinline__ void convert_layer(Frame& F, const float* Win, const float* nrm, int Nin, const float* Wout, bf16* dstbuf) {
    int lane = F.lane; asm volatile("" : "+v"(lane));
    LAS float* scr = (LAS float*)(F.lds + F.wave * 16384);
    const int gw = F.vcu * NWAVES + F.wave, NGW = F.G * NWAVES;
    const int I_in = (DM / 64) * (Nin / 32), I_out = (DIN / 64) * (DM / 32);
    bf16* wout_t = dstbuf + (size_t)Nin * DM;
    for (int it = gw; it < I_in + I_out; it += NGW) {
        if (it < I_in) transpose_item(Win, nrm, DM, Nin, dstbuf, scr, it, lane);
        else transpose_item(Wout, nullptr, DIN, DM, wout_t, scr, it - I_in, lane);
    }
}
__device__ __forceinline__ float wave_sum(float v) {
#pragma unroll
    for (int o = 1; o < 64; o <<= 1) v += __shfl_xor(v, o);
    return v;
}

struct Args { const float* in[13]; float* out; unsigned char* ws; int ph_lo, ph_hi; };

__global__ void __launch_bounds__(NWAVES * 64, 2) mk_fwd(Args args) {
    extern __shared__ __attribute__((aligned(16))) unsigned char lds[];
    Frame F;
    F.lds = (LAS unsigned char*)lds;
    F.MISC = (volatile LAS unsigned*)(F.lds + MISC_OFF);
    F.tid = threadIdx.x; F.lane = F.tid & 63; F.wave = __builtin_amdgcn_readfirstlane(F.tid >> 6);
    F.G = gridDim.x; { const int bx = blockIdx.x; F.vcu = (F.G % 8 == 0) ? (bx % 8) * (F.G / 8) + bx / 8 : bx; }
    unsigned char* ws = args.ws;
    F.ctl = (gu32*)(ws + WS_CTL);
    for (int u = F.tid; u < (LDS_BYTES - LDSCTL_OFF) / 4; u += NWAVES * 64) ((LAS unsigned*)(F.lds + LDSCTL_OFF))[u] = 0u;
    __syncthreads();
    const int lo = args.ph_lo, hi = args.ph_hi; (void)lo; (void)hi;
    const bool multi = MK_PER_PHASE ? ((hi - lo) > 1) : true;
    XcdBarrier bar; bar.bar = (unsigned*)(F.ctl + CW_BAR); bar.x = 0; bar.st = nullptr;
    if (multi) bar = xcd_barrier_post((unsigned*)(F.ctl + CW_BAR), F.MISC + 8);
#ifndef PHASE_MASK
#define PHASE_MASK 0xFFFF
#endif
#if MK_PER_PHASE
#define INK(kind, k) ((((PHASE_MASK) >> (kind)) & 1) && lo <= (k) && (k) < hi)
#define IN(k) (lo <= (k) && (k) < hi)
#else
#define INK(kind, k) (((PHASE_MASK) >> (kind)) & 1)
#define IN(k) true
#endif
#if MK_PER_PHASE
#define SEAM(k) do { if (IN(k) && IN((k) + 1)) xcd_barrier(bar); } while (0)
#else
#define SEAM(k) xcd_barrier(bar)
#endif

#define PTRS() size_t wz_ = 0; asm volatile("" : "+s"(wz_)); unsigned char* wsl = args.ws + wz_; \
    const float* x_in = args.in[0]; float* xres = args.out; \
    float* rope = (float*)(wsl + WS_ROPE); float* lbt = (float*)(wsl + WS_LB); float* dstv = (float*)(wsl + WS_DST); float* ssq = (float*)(wsl + WS_SSQ); \
    bf16* wte = (bf16*)(wsl + WS_WTE); bf16* wto = (bf16*)(wsl + WS_WTO); bf16* xb = (bf16*)(wsl + WS_XB); float* ust = (float*)(wsl + WS_XB); \
    unsigned char* R0 = wsl + WS_R0; unsigned char* R1 = R0 + RSZ; unsigned char* R2 = R1 + RSZ; unsigned char* R3 = R2 + RSZ; unsigned char* R4 = R3 + RSZ; unsigned char* R5 = R4 + RSZ; \
    const int gw = F.vcu * NWAVES + F.wave, NGW = F.G * NWAVES; int tidl = threadIdx.x; asm volatile("" : "+v"(tidl)); const int lanel = tidl & 63; (void)lanel; \
    (void)x_in; (void)xres; (void)rope; (void)lbt; (void)dstv; (void)ssq; (void)wte; (void)wto; (void)xb; (void)ust; (void)R0; (void)R1; (void)R2; (void)R3; (void)R4; (void)R5; (void)gw; (void)NGW;

    if (INK(0, 0)) {
        PTRS();
        convert_layer(F, args.in[2], args.in[1], EVEN_IN, args.in[7], wte);
        convert_layer(F, args.in[9], args.in[8], ODD_IN, args.in[11], wto);
        {
            const int gt = F.vcu * (NWAVES * 64) + tidl, NGT = F.G * NWAVES * 64;
            for (int e = gt; e < SEQ * 8; e += NGT) { const int pos = e >> 3, i = e & 7; const double inv = pow(500000.0, -(double)i / 8.0); const double ang = (double)pos * inv;
                rope[e] = (float)cos(ang); rope[SEQ * 8 + e] = (float)sin(ang); }
            const float* lg = args.in[6];
            for (int e = gt; e < 2 * 1024; e += NGT) { const int dir = e >> 10, c = e & 1023; const float l0 = lg[(dir * 2 + 0) * 1024 + c], l1 = lg[(dir * 2 + 1) * 1024 + c];
                lbt[e] = 0.0f; lbt[2048 + e] = 1.0f / (1.0f + expf(l0 - l1)); }
        }
        for (int m = gw; m < T; m += NGW) {
            const GAS f32x4* xr = (const GAS f32x4*)(x_in + (size_t)m * DM) + lanel; f32x4 v[4]; float s = 0.f;
#pragma unroll
            for (int j = 0; j < 4; ++j) { v[j] = xr[64 * j]; s += (v[j].x * v[j].x + v[j].y * v[j].y) + (v[j].z * v[j].z + v[j].w * v[j].w); }
            s = wave_sum(s);
            GAS unsigned long long* o8 = (GAS unsigned long long*)(xb + (size_t)m * DM) + lanel;
#pragma unroll
            for (int j = 0; j < 4; ++j) o8[64 * j] = (unsigned long long)pk2(v[j].x, v[j].y) | ((unsigned long long)pk2(v[j].z, v[j].w) << 32);
            if (lanel < 16) ssq[(size_t)m * 16 + lanel] = (lanel == 0) ? s : 0.0f;
        }
    }
    SEAM(0);

#pragma unroll 1
    for (int layer = 0; layer < 4; ++layer) {
        const int j = layer >> 1; const bool even = (layer & 1) == 0;
        const int pb = 1 + (layer >> 1) * 9 + (even ? 0 : 6);
        if (even) {
            const float lam_init = (j == 0) ? 0.2f : 0.470713018f;
            if (INK(1, pb + 0)) {
        PTRS();
                pg8::Gemm g{xb, wte, T, 4096, DM, DM, 1 << 30, 0l}; pg8::StaticOrder S; S.init(T, 4096, F.G, (int)blockIdx.x);
                pg8::EpiIn<true> E{ssq, rope, lbt + j * 2048, R0, R1, R2, R3, R4, R5, 0};
                pg8::gemm_phase(F.lds, g, S, E);
            }
            SEAM(pb + 0);
            if (INK(2, pb + 1)) {
        PTRS();
                if (layer == 2) { convert_layer(F, args.in[9] + (size_t)DM * ODD_IN, args.in[8] + DM, ODD_IN, args.in[11] + (size_t)DIN * DM, wto); __syncthreads(); }
                const float* lq = args.in[3] + j * 256; float s1 = 0.f, s2 = 0.f;
                for (int i = 0; i < 64; ++i) { s1 += lq[i] * lq[64 + i]; s2 += lq[128 + i] * lq[192 + i]; }
                const float lam = expf(s1) - expf(s2) + lam_init;
                for (int i = 0; i < 4; ++i) { const int bh = (F.vcu >> 5) * 4 + i, qb = F.vcu & 31;
                    att::diff_attn_unit(bh >> 3, bh & 7, qb, (const att::u16*)R0, (const att::u16*)R1, (const att::u16*)R2, (const att::u16*)R3, (att::u16*)R0,
                                        args.in[4] + j * 128, lam, 1.0f - lam_init, (char*)lds); }
            }
            SEAM(pb + 1);
            if (INK(1, pb + 2)) {
        PTRS();
                pg8::Gemm g{xb, wte + (size_t)4096 * DM, T, 5120, DM, DM, 1 << 30, 0l}; pg8::StaticOrder S; S.init(T, 5120, F.G, (int)blockIdx.x);
                pg8::EpiIn<true> E{ssq, rope, lbt + j * 2048, R0, R1, R2, R3, R4, R5, 16};
                pg8::gemm_phase(F.lds, g, S, E);
            }
            SEAM(pb + 2);
            if (INK(3, pb + 3)) {
        PTRS();
                for (int it = F.vcu; it < 512; it += F.G) hg::hgrn_pass1(it, (const att::u16*)R2, (const att::u16*)R4, (const att::u16*)R5, ust, dstv, (char*)lds);
            }
            SEAM(pb + 3);
            if (INK(4, pb + 4)) {
        PTRS();
                for (int it = F.vcu; it < 256; it += F.G) hg::hgrn_pass2(it, (const att::u16*)R1, (const att::u16*)R2, (const att::u16*)R4, (const att::u16*)R5, (const att::u16*)R3,
                                                                        (att::u16*)R4, (att::u16*)R1, ust, dstv, args.in[5] + j * 128, (char*)lds);
            }
            SEAM(pb + 4);
            if (INK(5, pb + 5)) {
        PTRS();
                pg8::Gemm g{(const bf16*)R0, wte + (size_t)EVEN_IN * DM, T, DM, DIN, DM, 16, (long)RSZ - 2048l}; pg8::StaticOrder S; S.init(T, DM, F.G, (int)blockIdx.x);
                pg8::EpiOut E{(layer == 0) ? x_in : (const float*)xres, xres, xb, ssq};
                pg8::gemm_phase(F.lds, g, S, E);
            }
            SEAM(pb + 5);
        } else {
            if (INK(6, pb + 0)) {
        PTRS();
                pg8::Gemm g{xb, wto, T, ODD_IN, DM, DM, 1 << 30, 0l}; pg8::StaticOrder S; S.init(T, ODD_IN, F.G, (int)blockIdx.x);
                pg8::EpiIn<false> E{ssq, rope, nullptr, R0, R1, R2, R3, R4, R5, 0};
                pg8::gemm_phase(F.lds, g, S, E);
            }
            SEAM(pb + 0);
            if (INK(7, pb + 1)) {
        PTRS();
                if (layer == 1) { convert_layer(F, args.in[2] + (size_t)DM * EVEN_IN, args.in[1] + DM, EVEN_IN, args.in[7] + (size_t)DIN * DM, wte); __syncthreads(); }
                for (int i = 0; i < 8; ++i) { const int bk = (F.vcu >> 5) * 2 + (i >> 2), qb = (F.vcu & 31) * 4 + (i & 3);
                    att::swa_unit(bk >> 2, bk & 3, qb, (const att::u16*)R0, (const att::u16*)R2, (const att::u16*)(R2 + (size_t)T * 256 * 2), (const att::u16*)R3, (att::u16*)R0,
                                  args.in[10] + j * 32, (char*)lds); }
            }
            SEAM(pb + 1);
            if (INK(5, pb + 2)) {
        PTRS();
                pg8::Gemm g{(const bf16*)R0, wto + (size_t)ODD_IN * DM, T, DM, DIN, DIN, 1 << 30, 0l}; pg8::StaticOrder S; S.init(T, DM, F.G, (int)blockIdx.x);
                pg8::EpiOut E{(layer == 0) ? x_in : (const float*)xres, xres, xb, ssq};
                pg8::gemm_phase(F.lds, g, S, E);
            }
            SEAM(pb + 2);
        }
    }
    if (INK(8, 19)) {
        PTRS();
        const float* fw = args.in[12];
        for (int m = gw; m < T; m += NGW) {
            GAS f32x4* xr = (GAS f32x4*)(xres + (size_t)m * DM) + lanel; f32x4 v[4]; float s = 0.f;
#pragma unroll
            for (int jj = 0; jj < 4; ++jj) { v[jj] = xr[64 * jj]; s += (v[jj].x * v[jj].x + v[jj].y * v[jj].y) + (v[jj].z * v[jj].z + v[jj].w * v[jj].w); }
            s = wave_sum(s); const float rs = 1.0f / sqrtf(s * (1.0f / DM) + EPS);
#pragma unroll
            for (int jj = 0; jj < 4; ++jj) { const f32x4 w = *((const f32x4*)fw + lanel + 64 * jj); xr[64 * jj] = v[jj] * rs * w; }
        }
    }
#undef IN
#undef INK
#undef SEAM
}

extern "C" void kernel_launch(void* const* d_in, const int* in_sizes, int n_in, void* d_out, int out_size, void* d_ws, size_t ws_size, hipStream_t stream) {
    static int ok = 0;
    if (ok == 0) {
        if (n_in != 13 || in_sizes[0] != T * DM || out_size != T * DM || ws_size < WS_END) { fprintf(stderr, "kernel_launch: shape/workspace mismatch (n_in %d, ws %zu, need %zu)\n", n_in, ws_size, (size_t)WS_END); ok = -1; return; }
        if (hipFuncSetAttribute((const void*)mk_fwd, hipFuncAttributeMaxDynamicSharedMemorySize, LDS_BYTES) != hipSuccess) { fprintf(stderr, "kernel_launch: hipFuncSetAttribute failed\n"); ok = -1; return; }
        int per_cu = 0;
        if (hipOccupancyMaxActiveBlocksPerMultiprocessor(&per_cu, (const void*)mk_fwd, NWAVES * 64, LDS_BYTES) != hipSuccess || per_cu < 1) fprintf(stderr, "kernel_launch: occupancy query reports %d\n", per_cu);
        (void)hipGetLastError();
        ok = 1;
    }
    if (ok < 0) return;
    (void)hipMemsetAsync((char*)d_ws + WS_CTL, 0, CTL_ZERO_BYTES, stream);
    Args a{};
    for (int i = 0; i < 13; ++i) a.in[i] = (const float*)d_in[i];
    a.out = (float*)d_out; a.ws = (unsigned char*)d_ws;
#if MK_PER_PHASE
    for (int p = 0; p < NPH; ++p) { a.ph_lo = p; a.ph_hi = p + 1; hipLaunchKernelGGL(mk_fwd, dim3(GRID), dim3(NWAVES * 64), LDS_BYTES, stream, a); }
#else
    a.ph_lo = 0; a.ph_hi = NPH;
    hipLaunchKernelGGL(mk_fwd, dim3(GRID), dim3(NWAVES * 64), LDS_BYTES, stream, a);
#endif
    const hipError_t le = hipPeekAtLastError();
    if (le != hipSuccess) fprintf(stderr, "kernel_launch: launch failed: %s\n", hipGetErrorName(le));
}
```

```cpp
#include <hip/hip_runtime.h>
#include <hip/hip_bf16.h>
#include <cstdio>
#include <cstdint>

constexpr int NB = 4, SEQ = 4096, DM = 1024, T = NB * SEQ;
constexpr int EVEN_IN = 9216, ODD_IN = 4608, DIN = 2048;
constexpr float EPS = 1e-6f;
constexpr float C2 = 0.125f * 1.4426950408889634f;
constexpr float LOG2E = 1.4426950408889634f;

namespace pg8 {
#define PG8_LAS __attribute__((address_space(3)))
typedef unsigned short bf16_t;
typedef short bf16x8 __attribute__((ext_vector_type(8)));
typedef float f32x4 __attribute__((ext_vector_type(4)));
typedef unsigned u32x4 __attribute__((ext_vector_type(4)));
constexpr int BM = 256, BK = 64, HALF = 128, HTB = HALF * BK * 2, STAGE_BYTES = 8 * HTB, NXCD = 8, WGM = 8;
constexpr int EPI_STG_OFF = 139264, EPI_STG_RS = 144, EPI_STG_WAVE = 16 * EPI_STG_RS;

__host__ __device__ __forceinline__ int lds_byte(int r, int c) { const int st = (r >> 4) * 2 + (c >> 5), rr = r & 15, cc = c & 31, ob = rr * 64 + cc * 2; return st * 1024 + (ob ^ (((ob >> 9) & 1) << 5)); }
__host__ __device__ __forceinline__ void stage_rc(int b, int& R, int& C) { const int st = b / 1024, sb = b % 1024, swz = sb ^ (((sb >> 9) & 1) << 5); R = (st >> 1) * 16 + swz / 64; C = (st & 1) * 32 + (swz % 64) / 2; }
__host__ __device__ __forceinline__ int perm32(int rho) { const int n = rho >> 4, i = rho & 15; return 8 * (i >> 2) + 4 * n + (i & 3); }

struct Unit { int pm, pn; };
struct Gemm { const bf16_t* A; const bf16_t* Bt; int M, N, K, lda, ksplit; long jump; };

struct StaticOrder {
    int nM, nN, nwg, G, c;
    __host__ __device__ void init(int M, int N, int G_, int c_) { nM = M / BM; nN = N / BM; nwg = nM * nN; G = G_; c = c_; }
    __host__ __device__ bool next(int i, Unit& u) const {
        const long L = (long)i * G + c; if (L >= nwg) return false;
        int wgid = (int)L; { const int q = nwg / NXCD, r = nwg % NXCD, xcd = wgid % NXCD, off = wgid / NXCD; wgid = (xcd < r ? xcd * (q + 1) : r * (q + 1) + (xcd - r) * q) + off; }
        const int nig = WGM * nN, gid = wgid / nig, fm = gid * WGM, gsz = (nM - fm) < WGM ? (nM - fm) : WGM;
        u.pm = fm + ((wgid % nig) % gsz); u.pn = (wgid % nig) / gsz; return true;
    }
};

__device__ __forceinline__ unsigned cvt_pk_bf16(float lo, float hi) { unsigned r; asm volatile("v_cvt_pk_bf16_f32 %0, %1, %2" : "=v"(r) : "v"(lo), "v"(hi)); return r; }

template <class Epi>
__device__ __forceinline__ void gemm_phase(PG8_LAS unsigned char* lds, const Gemm g, const StaticOrder& S, const Epi& E) {
    int tid = threadIdx.x; asm volatile("" : "+v"(tid));
    const int wid = __builtin_amdgcn_readfirstlane(tid >> 6), lane = tid & 63, wr = wid >> 2, wc = wid & 3, fr = lane & 15, fq = lane >> 4;
    const int K = g.K, nt = K / BK, lda = g.lda;
    unsigned voffA[2], voffB[2];
#pragma unroll
    for (int i = 0; i < 2; ++i) { int R, C; stage_rc(tid * 16 + i * 8192, R, C); const int Rb = 64 * (R >> 5) + perm32(R & 31);
        voffA[i] = (unsigned)(R * lda + C) * 2u; voffB[i] = (unsigned)(Rb * K + C) * 2u; }
    const size_t kstep = (size_t)(BK * 2);
    const size_t hstepA = (size_t)HALF * lda * 2, tstepA = 2 * hstepA;
    const size_t hstepB = (size_t)32 * K * 2, tstepB = (size_t)BM * K * 2;
    const unsigned ldsw = (unsigned)wid * 1024u;
    const int aoff = lds_byte(wr * 64 + fr, fq * 8), boff = lds_byte(wc * 32 + fr, fq * 8);
    const int ksplit = g.ksplit; const long jump = g.jump;
#define PG8_AP(base, t) ((base) + (size_t)(t) * kstep + (((t) >= ksplit) ? jump : 0l))
#define PG8_SA(b, h) (((b) * 2 + (h)) * HTB)
#define PG8_SB(b, h) ((4 + (b) * 2 + (h)) * HTB)
#define PG8_STAGE(bufoff, gbase, voff) do { _Pragma("unroll") for (int _i = 0; _i < 2; ++_i) \
        __builtin_amdgcn_global_load_lds((const unsigned*)((const char*)(gbase) + (voff)[_i]), (PG8_LAS unsigned*)(lds + (bufoff) + ldsw + _i * 8192), 16, 0, 0); } while (0)
#define PG8_LDA(dst, b, h) do { _Pragma("unroll") for (int m = 0; m < 4; ++m) _Pragma("unroll") for (int k = 0; k < 2; ++k) dst[m][k] = *(const PG8_LAS bf16x8*)(lds + PG8_SA(b, h) + aoff + m * 2048 + k * 1024); } while (0)
#define PG8_LDB(dst, b, h) do { _Pragma("unroll") for (int n = 0; n < 2; ++n) _Pragma("unroll") for (int k = 0; k < 2; ++k) dst[n][k] = *(const PG8_LAS bf16x8*)(lds + PG8_SB(b, h) + boff + n * 2048 + k * 1024); } while (0)
#define PG8_MMA(ai, bj, At, Bt) do { __builtin_amdgcn_s_setprio(1); _Pragma("unroll") for (int m = 0; m < 4; ++m) _Pragma("unroll") for (int n = 0; n < 2; ++n) _Pragma("unroll") for (int k = 0; k < 2; ++k) \
        acc[ai][bj][m][n] = __builtin_amdgcn_mfma_f32_16x16x32_bf16(Bt[n][k], At[m][k], acc[ai][bj][m][n], 0, 0, 0); __builtin_amdgcn_s_setprio(0); } while (0)
#define PG8_WAIT_V(n) asm volatile("s_waitcnt vmcnt(" #n ")" ::: "memory")
#define PG8_WAIT_L(n) asm volatile("s_waitcnt lgkmcnt(" #n ")" ::: "memory")
#define PG8_BAR __builtin_amdgcn_s_barrier()
#define PG8_SCHED __builtin_amdgcn_sched_barrier(0)
    Unit cur, nxt; int ui = 0;
    if (!S.next(0, cur)) return;
    f32x4 acc[2][2][4][2];
#pragma unroll
    for (int a = 0; a < 2; ++a)
#pragma unroll
        for (int b = 0; b < 2; ++b)
#pragma unroll
            for (int m = 0; m < 4; ++m)
#pragma unroll
                for (int n = 0; n < 2; ++n) acc[a][b][m][n] = (f32x4){0.f, 0.f, 0.f, 0.f};
    bf16x8 At[4][2], B0[2][2], B1[2][2];
    const char* cA = (const char*)g.A + (size_t)cur.pm * tstepA; const char* cB = (const char*)g.Bt + (size_t)cur.pn * tstepB;
    {
        PG8_STAGE(PG8_SB(0, 0), cB, voffB); PG8_STAGE(PG8_SB(0, 1), cB + hstepB, voffB); PG8_STAGE(PG8_SA(0, 0), cA, voffA); PG8_STAGE(PG8_SA(0, 1), cA + hstepA, voffA);
        if (wr == 1) PG8_BAR;
        PG8_WAIT_V(2); PG8_BAR;
        PG8_STAGE(PG8_SB(1, 0), cB + kstep, voffB); PG8_STAGE(PG8_SA(1, 0), PG8_AP(cA, 1), voffA); PG8_STAGE(PG8_SB(1, 1), cB + hstepB + kstep, voffB);
        PG8_WAIT_V(6); PG8_BAR;
    }
    for (;;) {
        const bool has_next = S.next(ui + 1, nxt);
        const char* nA = has_next ? (const char*)g.A + (size_t)nxt.pm * tstepA : cA; const char* nB = has_next ? (const char*)g.Bt + (size_t)nxt.pn * tstepB : cB;
        for (int t = 0; t < nt; t += 2) {
            const bool last = (t == nt - 2);
            const char* a1 = PG8_AP(cA, t + 1);
            const char* a2 = last ? nA : PG8_AP(cA, t + 2); const char* b2 = last ? nB : cB + (size_t)(t + 2) * kstep;
            const char* a3 = a2 + kstep; const char* b3 = b2 + kstep;
            PG8_LDB(B0, 0, 0); PG8_LDB(B1, 0, 1); PG8_SCHED; PG8_LDA(At, 0, 0); PG8_STAGE(PG8_SA(1, 1), a1 + hstepA, voffA);
            PG8_WAIT_V(8); PG8_WAIT_L(0); PG8_BAR; PG8_MMA(0, 0, At, B0); PG8_MMA(0, 1, At, B1); PG8_BAR; PG8_SCHED;
            PG8_LDA(At, 0, 1); PG8_STAGE(PG8_SB(0, 0), b2, voffB); PG8_STAGE(PG8_SB(0, 1), b2 + hstepB, voffB); PG8_STAGE(PG8_SA(0, 0), a2, voffA);
            PG8_WAIT_V(8); PG8_WAIT_L(0); PG8_BAR; PG8_MMA(1, 0, At, B0); PG8_MMA(1, 1, At, B1); PG8_BAR; PG8_SCHED;
            PG8_LDB(B0, 1, 0); PG8_LDB(B1, 1, 1); PG8_SCHED; PG8_LDA(At, 1, 0); PG8_STAGE(PG8_SA(0, 1), a2 + hstepA, voffA);
            PG8_WAIT_V(8); PG8_WAIT_L(0); PG8_BAR; PG8_MMA(0, 0, At, B0); PG8_MMA(0, 1, At, B1); PG8_BAR; PG8_SCHED;
            PG8_LDA(At, 1, 1); PG8_STAGE(PG8_SB(1, 0), b3, voffB); PG8_STAGE(PG8_SB(1, 1), b3 + hstepB, voffB); PG8_STAGE(PG8_SA(1, 0), a3, voffA);
            PG8_WAIT_V(8); PG8_WAIT_L(0); PG8_BAR; PG8_MMA(1, 0, At, B0); PG8_MMA(1, 1, At, B1); PG8_BAR; PG8_SCHED;
        }
        if (wr == 0) PG8_BAR;
        E(acc, cur, wr, wc, fr, fq, lds + EPI_STG_OFF + wid * EPI_STG_WAVE, lane);
        if (!has_next) break;
#pragma unroll
        for (int a = 0; a < 2; ++a)
#pragma unroll
            for (int b = 0; b < 2; ++b)
#pragma unroll
                for (int m = 0; m < 4; ++m)
#pragma unroll
                    for (int n = 0; n < 2; ++n) acc[a][b][m][n] = (f32x4){0.f, 0.f, 0.f, 0.f};
        cur = nxt; cA = nA; cB = nB; ++ui;
        if (wr == 1) PG8_BAR;
    }
    PG8_WAIT_V(0);
    PG8_BAR;
#undef PG8_AP
#undef PG8_SA
#undef PG8_SB
#undef PG8_STAGE
#undef PG8_LDA
#undef PG8_LDB
#undef PG8_MMA
#undef PG8_WAIT_V
#undef PG8_WAIT_L
#undef PG8_BAR
#undef PG8_SCHED
}
}
namespace pg8 {
typedef unsigned short u16;
__device__ __forceinline__ float fsigmoid(float v) { return __builtin_amdgcn_rcpf(1.0f + __expf(-v)); }
__device__ __forceinline__ unsigned pk_f16(float lo, float hi) { _Float16 a = (_Float16)lo, b = (_Float16)hi; return (unsigned)__builtin_bit_cast(unsigned short, a) | ((unsigned)__builtin_bit_cast(unsigned short, b) << 16); }


__device__ __forceinline__ void store_rows128(PG8_LAS unsigned char* stg, u16* blk  , size_t pitch, u32x4 w0, u32x4 w1, int fr, int fq, int lane) {
    *(PG8_LAS u32x4*)(stg + fr * EPI_STG_RS + fq * 16) = w0; *(PG8_LAS u32x4*)(stg + fr * EPI_STG_RS + 64 + fq * 16) = w1;
    const int rr = lane >> 3, ch = lane & 7;
    const u32x4 a = *(const PG8_LAS u32x4*)(stg + rr * EPI_STG_RS + ch * 16), b = *(const PG8_LAS u32x4*)(stg + (8 + rr) * EPI_STG_RS + ch * 16);
    *(u32x4*)(blk + (size_t)rr * pitch + ch * 8) = a; *(u32x4*)(blk + (size_t)(8 + rr) * pitch + ch * 8) = b;
}

enum { K_PLAIN = 0, K_SILU = 1, K_ROPEQ = 2, K_ROPEK = 3, K_LOGF = 4 };

template <bool EVEN, int MODE = 0> struct EpiIn {
    static constexpr bool PERM = true;
    const float* ssq;
    const float* rope;
    const float* lb;
    unsigned char* r0; unsigned char* r1; unsigned char* r2; unsigned char* r3; unsigned char* r4; unsigned char* r5;
    int pn_off;
    __device__ __forceinline__ void operator()(const f32x4 (&acc)[2][2][4][2], const Unit& u, int wr, int wc, int fr, int fq, PG8_LAS unsigned char* stg, int lane) const {
        const int gpn = u.pn + pn_off;
        int kind, pitch, colt, dir = 0; u16* outp;
        if (EVEN) {
            const int grp = gpn >> 2; colt = (gpn & 3) * 256; pitch = 1024;
            switch (grp) {
                case 0: kind = K_ROPEQ; outp = (u16*)r0; break;
                case 1: kind = K_ROPEK; outp = (u16*)r1; break;
                case 2: kind = K_PLAIN; outp = (u16*)r2; break;
                case 3: kind = K_SILU;  outp = (u16*)r3; break;
                case 4: kind = K_SILU;  outp = (u16*)r1; break;
                case 5: kind = K_LOGF;  outp = (u16*)r4; dir = 0; break;
                case 6: kind = K_LOGF;  outp = (u16*)r5; dir = 1; break;
                case 7: kind = K_PLAIN; outp = (u16*)r2; break;
                default: kind = K_SILU; outp = (u16*)r3; break;
            }
        } else {
            if (gpn < 8)       { kind = K_ROPEQ; outp = (u16*)r0; pitch = 2048; colt = gpn * 256; }
            else if (gpn == 8) { kind = K_ROPEK; outp = (u16*)r2; pitch = 256;  colt = 0; }
            else if (gpn == 9) { kind = K_PLAIN; outp = (u16*)(r2 + (size_t)T * 256 * 2); pitch = 256; colt = 0; }
            else               { kind = K_SILU;  outp = (u16*)r3; pitch = 2048; colt = (gpn - 10) * 256; }
        }
        int row0 = u.pm * BM + wr * 64 + fr; asm volatile("" : "+v"(row0));
        if (MODE == 2) kind = K_PLAIN;
        float rsv[8];
#pragma unroll
        for (int hb = 0; hb < 2; ++hb) { f32x4 sq[4];
#pragma unroll
          for (int i = 0; i < 4; ++i) sq[i] = *((const f32x4*)(ssq + (size_t)(row0 + hb * HALF + i * 16) * 16) + fq);
#pragma unroll
          for (int i = 0; i < 4; ++i) { float tot = (sq[i][0] + sq[i][1]) + (sq[i][2] + sq[i][3]); tot += __shfl_xor(tot, 16); tot += __shfl_xor(tot, 32); rsv[hb * 4 + i] = __builtin_amdgcn_rsqf(tot * (1.0f / DM) + EPS); }
          asm volatile("" ::: "memory"); }
        u16* const blk0 = outp + (size_t)(row0 - fr) * pitch + colt + wc * 64;
        if (kind == K_LOGF)        rows<K_LOGF>(acc, rsv, blk0, pitch, colt + wc * 64, dir, row0, 1.0f, fr, fq, stg, lane);
        else if (kind == K_SILU)   rows<K_SILU>(acc, rsv, blk0, pitch, 0, 0, row0, 1.0f, fr, fq, stg, lane);
        else if (kind == K_PLAIN)  rows<K_PLAIN>(acc, rsv, blk0, pitch, 0, 0, row0, 1.0f, fr, fq, stg, lane);
        else                       rows<K_ROPEQ>(acc, rsv, blk0, pitch, 0, 0, row0, (kind == K_ROPEQ) ? C2 : 1.0f, fr, fq, stg, lane);
    }
    template <int KIND>
    __device__ __forceinline__ void rows(const f32x4 (&acc)[2][2][4][2], const float (&rsv)[8], u16* blk0, int pitch, int ccol, int dir, int row0, float qs, int fr, int fq, PG8_LAS unsigned char* stg, int lane) const {
        f32x4 lbv[2][2];
        if (KIND == K_LOGF) {
#pragma unroll
            for (int bj = 0; bj < 2; ++bj) { const int c0 = ccol + bj * 32 + 8 * fq; lbv[bj][0] = *(const f32x4*)(lb + dir * 1024 + c0); lbv[bj][1] = *(const f32x4*)(lb + dir * 1024 + c0 + 4); }
        }
        f32x4 cs0, cs1, sn0, sn1, ncs0, ncs1, nsn0, nsn1;
        if (KIND == K_ROPEQ) { const int pos = row0 & (SEQ - 1); const f32x4* cp = (const f32x4*)(rope + (size_t)pos * 8); const f32x4* spn = (const f32x4*)(rope + (size_t)SEQ * 8 + (size_t)pos * 8);
            ncs0 = cp[0]; ncs1 = cp[1]; nsn0 = spn[0]; nsn1 = spn[1]; }
#pragma unroll
        for (int ai = 0; ai < 2; ++ai)
#pragma unroll
            for (int m = 0; m < 4; ++m) {
                const float rs = rsv[ai * 4 + m];
                if (KIND == K_ROPEQ) { cs0 = ncs0; cs1 = ncs1; sn0 = nsn0; sn1 = nsn1;
                    if (ai * 4 + m < 7) { const int i2 = ai * 4 + m + 1; const int pos = (row0 + (i2 >> 2) * HALF + (i2 & 3) * 16) & (SEQ - 1);
                        const f32x4* cp = (const f32x4*)(rope + (size_t)pos * 8); const f32x4* spn = (const f32x4*)(rope + (size_t)SEQ * 8 + (size_t)pos * 8);
                        ncs0 = cp[0]; ncs1 = cp[1]; nsn0 = spn[0]; nsn1 = spn[1]; } }
                u32x4 wst[2];
#pragma unroll
                for (int bj = 0; bj < 2; ++bj) {
                    f32x4 v0 = acc[ai][bj][m][0] * rs, v1 = acc[ai][bj][m][1] * rs;
                    u32x4 w;
                    if (KIND == K_LOGF) {
                        const f32x4 l0 = lbv[bj][0], l1 = lbv[bj][1];
                        float o[8];
#pragma unroll
                        for (int e = 0; e < 4; ++e) { const float f0 = l0[e] + (1.0f - l0[e]) * fsigmoid(v0[e]), f1 = l1[e] + (1.0f - l1[e]) * fsigmoid(v1[e]);
                            o[e] = fmaxf(__builtin_amdgcn_logf(f0) * 0.6931471805599453f, -30.0f); o[4 + e] = fmaxf(__builtin_amdgcn_logf(f1) * 0.6931471805599453f, -30.0f); }
                        w.x = pk_f16(o[0], o[1]); w.y = pk_f16(o[2], o[3]); w.z = pk_f16(o[4], o[5]); w.w = pk_f16(o[6], o[7]);
                    } else {
                        if (KIND == K_SILU) {
#pragma unroll
                            for (int e = 0; e < 4; ++e) { v0[e] = v0[e] * fsigmoid(v0[e]); v1[e] = v1[e] * fsigmoid(v1[e]); }
                        } else if (KIND == K_ROPEQ && bj == 0) {
                            f32x4 o0, o1;
#pragma unroll
                            for (int e = 0; e < 4; ++e) { o0[e] = __shfl_xor(v0[e], 16); o1[e] = __shfl_xor(v1[e], 16); }
                            if (fq < 2) {
                                const float sg = (fq == 0) ? -1.0f : 1.0f;
                                v0 = v0 * cs0 + (o0 * sn0) * sg; v1 = v1 * cs1 + (o1 * sn1) * sg;
                            }
                        }
                        if (KIND == K_ROPEQ) { v0 = v0 * qs; v1 = v1 * qs; }
                        w.x = cvt_pk_bf16(v0[0], v0[1]); w.y = cvt_pk_bf16(v0[2], v0[3]); w.z = cvt_pk_bf16(v1[0], v1[1]); w.w = cvt_pk_bf16(v1[2], v1[3]);
                    }
                    wst[bj] = w;
                }
                if (MODE != 1) store_rows128(stg, blk0 + (size_t)(ai * HALF + m * 16) * pitch, (size_t)pitch, wst[0], wst[1], fr, fq, lane); else asm volatile("" :: "v"(wst[0]), "v"(wst[1]));
            }
    }
};

__device__ __forceinline__ float bf_lo(unsigned w) { return __uint_as_float(w << 16); }
__device__ __forceinline__ float bf_hi(unsigned w) { return __uint_as_float(w & 0xffff0000u); }
template <bool FIRST, bool LAST> struct EpiOut {
    static constexpr bool PERM = true;
    const float* xin; float* xout; u16* xb; float* ssq;
    __device__ __forceinline__ void operator()(const f32x4 (&acc)[2][2][4][2], const Unit& u, int wr, int wc, int fr, int fq, PG8_LAS unsigned char* stg, int lane) const {
        int row0 = u.pm * BM + wr * 64 + fr; asm volatile("" : "+v"(row0));
        const int cb = u.pn * BM + wc * 64 + 8 * fq;
        f32x4 nx[2][2];
#define LOADX(dst, rw) do { _Pragma("unroll") for (int bj = 0; bj < 2; ++bj) { const size_t off = (size_t)(rw) * DM + cb + bj * 32; \
            if (FIRST) { dst[bj][0] = *(const f32x4*)(xin + off); dst[bj][1] = *(const f32x4*)(xin + off + 4); } \
            else { const u32x4 w = *(const u32x4*)(xb + off); dst[bj][0] = (f32x4){bf_lo(w.x), bf_hi(w.x), bf_lo(w.y), bf_hi(w.y)}; dst[bj][1] = (f32x4){bf_lo(w.z), bf_hi(w.z), bf_lo(w.w), bf_hi(w.w)}; } } } while (0)
        LOADX(nx, row0);
#pragma unroll
        for (int ai = 0; ai < 2; ++ai)
#pragma unroll
            for (int m = 0; m < 4; ++m) {
                const int row = row0 + ai * HALF + m * 16; float part = 0.f; u32x4 wst[2];
                f32x4 ox[2][2];
#pragma unroll
                for (int bj = 0; bj < 2; ++bj) { ox[bj][0] = nx[bj][0]; ox[bj][1] = nx[bj][1]; }
                if (ai * 4 + m < 7) { const int i2 = ai * 4 + m + 1; LOADX(nx, row0 + (i2 >> 2) * HALF + (i2 & 3) * 16); }
#pragma unroll
                for (int bj = 0; bj < 2; ++bj) {
                    const size_t off = (size_t)row * DM + cb + bj * 32;
                    const f32x4 n0 = ox[bj][0] + acc[ai][bj][m][0], n1 = ox[bj][1] + acc[ai][bj][m][1];
                    if (LAST) { *(f32x4*)(xout + off) = n0; *(f32x4*)(xout + off + 4) = n1; }
                    else {
                        u32x4 w; w.x = cvt_pk_bf16(n0[0], n0[1]); w.y = cvt_pk_bf16(n0[2], n0[3]); w.z = cvt_pk_bf16(n1[0], n1[1]); w.w = cvt_pk_bf16(n1[2], n1[3]);
                        wst[bj] = w;
                        const f32x4 r0 = (f32x4){bf_lo(w.x), bf_hi(w.x), bf_lo(w.y), bf_hi(w.y)}, r1 = (f32x4){bf_lo(w.z), bf_hi(w.z), bf_lo(w.w), bf_hi(w.w)};
                        part += (r0[0] * r0[0] + r0[1] * r0[1]) + (r0[2] * r0[2] + r0[3] * r0[3]) + (r1[0] * r1[0] + r1[1] * r1[1]) + (r1[2] * r1[2] + r1[3] * r1[3]);
                    }
                }
                if (!LAST) { part += __shfl_xor(part, 16); part += __shfl_xor(part, 32);
                    if (fq == 0) ssq[(size_t)row * 16 + u.pn * 4 + wc] = part;
                    store_rows128(stg, xb + (size_t)(row - fr) * DM + u.pn * BM + wc * 64, (size_t)DM, wst[0], wst[1], fr, fq, lane); }
            }
#undef LOADX
    }
};
struct EpiDry {
    static constexpr bool PERM = true;
    __device__ __forceinline__ void operator()(const f32x4 (&acc)[2][2][4][2], const Unit&, int, int, int, int, PG8_LAS unsigned char*, int) const {
#pragma unroll
        for (int a = 0; a < 2; ++a)
#pragma unroll
            for (int b = 0; b < 2; ++b)
#pragma unroll
                for (int m = 0; m < 4; ++m) asm volatile("" :: "v"(acc[a][b][m][0]), "v"(acc[a][b][m][1]));
    }
};
}
namespace att {
typedef unsigned short u16;
using bf16x8 = __attribute__((ext_vector_type(8))) short;
using s16x4  = __attribute__((ext_vector_type(4))) short;
using f32x16 = __attribute__((ext_vector_type(16))) float;
using f32x4  = __attribute__((ext_vector_type(4))) float;
using u32x4  = __attribute__((ext_vector_type(4))) unsigned;
#define KSWZ(row, colB) ((row) * 256 + ((colB) ^ (((row) & 7) << 4)))
#define KSWZ128(row, colB) ((row) * 128 + ((colB) ^ (((row) & 7) << 4)))
#define SBAR() __builtin_amdgcn_sched_barrier(0)
constexpr float THRL = 8.0f;
__device__ __forceinline__ int crow(int r, int hi) { return (r & 3) + 8 * (r >> 2) + 4 * hi; }
__device__ __forceinline__ unsigned cvtpk(float lo, float hi) { unsigned r; asm volatile("v_cvt_pk_bf16_f32 %0, %1, %2" : "=v"(r) : "v"(lo), "v"(hi)); return r; }
__device__ __forceinline__ bf16x8 ld8(const u16* p) { return *reinterpret_cast<const bf16x8*>(p); }
__device__ __forceinline__ float bf2f(unsigned short h) { return __uint_as_float((unsigned)h << 16); }

__device__ __forceinline__ void partialSM(f32x16& p0, f32x16& p1, float& m_reg, float& alpha) {
    float pmax = p0[0];
#pragma unroll
    for (int r = 1; r < 16; ++r) pmax = fmaxf(pmax, p0[r]);
#pragma unroll
    for (int r = 0; r < 16; ++r) pmax = fmaxf(pmax, p1[r]);
    { auto rr = __builtin_amdgcn_permlane32_swap(__float_as_uint(pmax), __float_as_uint(pmax), false, false);
      pmax = fmaxf(__uint_as_float(rr[0]), __uint_as_float(rr[1])); }
    float mn;
    if (__builtin_expect(__all(pmax - m_reg <= THRL), 1)) { mn = m_reg; alpha = 1.f; }
    else { mn = fmaxf(m_reg, pmax); alpha = __builtin_amdgcn_exp2f(m_reg - mn); m_reg = mn; }
#pragma unroll
    for (int r = 0; r < 16; ++r) { p0[r] -= mn; p1[r] -= mn; }
#pragma unroll
    for (int r = 0; r < 16; ++r) p0[r] = __builtin_amdgcn_exp2f(p0[r]);
}
__device__ __forceinline__ void finishSM(f32x16& p0, f32x16& p1, float alpha, float& l_reg, bf16x8& pa0, bf16x8& pa1, bf16x8& pa2, bf16x8& pa3) {
#pragma unroll
    for (int r = 0; r < 16; ++r) p1[r] = __builtin_amdgcn_exp2f(p1[r]);
    float ps = 0;
#pragma unroll
    for (int r = 0; r < 16; ++r) ps += p0[r];
#pragma unroll
    for (int r = 0; r < 16; ++r) ps += p1[r];
    { auto rr = __builtin_amdgcn_permlane32_swap(__float_as_uint(ps), __float_as_uint(ps), false, false);
      ps = __uint_as_float(rr[0]) + __uint_as_float(rr[1]); }
    l_reg = l_reg * alpha + ps;
#define PK4(P, BASE, OUT) do { unsigned a0 = cvtpk(P[BASE + 0], P[BASE + 1]), a1 = cvtpk(P[BASE + 2], P[BASE + 3]);   \
    unsigned b0 = cvtpk(P[BASE + 4], P[BASE + 5]), b1 = cvtpk(P[BASE + 6], P[BASE + 7]);                              \
    auto r0 = __builtin_amdgcn_permlane32_swap(a0, b0, false, false); auto r1 = __builtin_amdgcn_permlane32_swap(a1, b1, false, false); \
    u32x4 w = {r0[0], r1[0], r0[1], r1[1]}; OUT = *reinterpret_cast<bf16x8*>(&w); } while (0)
    PK4(p0, 0, pa0); PK4(p0, 8, pa1); PK4(p1, 0, pa2); PK4(p1, 8, pa3);
}
__device__ __forceinline__ void pack4(const f32x16& p0, const f32x16& p1, bf16x8& pa0, bf16x8& pa1, bf16x8& pa2, bf16x8& pa3) {
    PK4(p0, 0, pa0); PK4(p0, 8, pa1); PK4(p1, 0, pa2); PK4(p1, 8, pa3);
}
#undef PK4

template <int NCB> __device__ __forceinline__ int v_st(int k, int c) { const int kk = (k & ~0xC) | ((k & 4) << 1) | ((k & 8) >> 1); return ((kk >> 3) * NCB + (c >> 5)) * 512 + ((kk & 7) * 32 + (c & 31)) * 2; }
__device__ __forceinline__ int v_rd_base(int lane) { return ((lane & 3) << 3) | (((lane >> 2) & 3) << 6) | (((lane >> 4) & 1) << 5) | (((lane >> 5) & 1) << 8); }
template <int OFF> __device__ __forceinline__ s16x4 tr_read(int vb) { s16x4 r; asm volatile("ds_read_b64_tr_b16 %0, %1 offset:%2" : "=&v"(r) : "v"(vb), "i"(OFF) : "memory"); return r; }
#define PKF(L, H) (bf16x8){L[0], L[1], L[2], L[3], H[0], H[1], H[2], H[3]}
template <int NCB> __device__ __forceinline__ void pv_blk(f32x16& od, int vb, bf16x8 pa0, bf16x8 pa1, bf16x8 pa2, bf16x8 pa3) {
    constexpr int KS = NCB * 1024, HF = NCB * 512;
    const s16x4 l0 = tr_read<0 * KS>(vb), h0 = tr_read<0 * KS + HF>(vb), l1 = tr_read<1 * KS>(vb), h1 = tr_read<1 * KS + HF>(vb);
    const s16x4 l2 = tr_read<2 * KS>(vb), h2 = tr_read<2 * KS + HF>(vb), l3 = tr_read<3 * KS>(vb), h3 = tr_read<3 * KS + HF>(vb);
    asm volatile("s_waitcnt lgkmcnt(0)" ::: "memory"); SBAR();
    od = __builtin_amdgcn_mfma_f32_32x32x16_bf16(pa0, PKF(l0, h0), od, 0, 0, 0);
    od = __builtin_amdgcn_mfma_f32_32x32x16_bf16(pa1, PKF(l1, h1), od, 0, 0, 0);
    od = __builtin_amdgcn_mfma_f32_32x32x16_bf16(pa2, PKF(l2, h2), od, 0, 0, 0);
    od = __builtin_amdgcn_mfma_f32_32x32x16_bf16(pa3, PKF(l3, h3), od, 0, 0, 0);
}


template <int NCB> __device__ __forceinline__ int v_stn(int k, int c) { return ((k >> 3) * NCB + (c >> 5)) * 512 + ((k & 7) * 32 + (c & 31)) * 2; }
__device__ __forceinline__ float max3f(float a, float b, float c) { return fmaxf(fmaxf(a, b), c); }
__device__ __forceinline__ void fill16(f32x16& v, float x) {
#pragma unroll
    for (int r = 0; r < 16; ++r) v[r] = x;
}
template <bool FIRST>
__device__ __forceinline__ void partialSM_n(f32x16& p0, f32x16& p1, float& m_reg, f32x16& negm, float& alpha) {
    float a = max3f(p0[0], p0[1], p0[2]), b = max3f(p0[3], p0[4], p0[5]), c = max3f(p1[0], p1[1], p1[2]), d = max3f(p1[3], p1[4], p1[5]);
    a = max3f(a, p0[6], p0[7]); b = max3f(b, p0[8], p0[9]); c = max3f(c, p1[6], p1[7]); d = max3f(d, p1[8], p1[9]);
    a = max3f(a, p0[10], p0[11]); b = max3f(b, p0[12], p0[13]); c = max3f(c, p1[10], p1[11]); d = max3f(d, p1[12], p1[13]);
    a = max3f(a, p0[14], p0[15]); c = max3f(c, p1[14], p1[15]);
    float pmax = fmaxf(fmaxf(a, b), fmaxf(c, d));
    { auto rr = __builtin_amdgcn_permlane32_swap(__float_as_uint(pmax), __float_as_uint(pmax), false, false);
      pmax = fmaxf(__uint_as_float(rr[0]), __uint_as_float(rr[1])); }
    if (!FIRST && __builtin_expect(__all(pmax <= THRL), 1)) { alpha = 1.f; }
    else { const float dl = FIRST ? pmax : fmaxf(pmax, 0.f); m_reg += dl; alpha = FIRST ? 0.f : __builtin_amdgcn_exp2f(-dl);
#pragma unroll
        for (int r = 0; r < 16; ++r) { p0[r] -= dl; p1[r] -= dl; }
        fill16(negm, -m_reg); asm volatile("" : "+v"(negm)); }
#pragma unroll
    for (int r = 0; r < 16; ++r) p0[r] = __builtin_amdgcn_exp2f(p0[r]);
}
#define PKN(P, B) (u32x4){cvtpk(P[B + 0], P[B + 1]), cvtpk(P[B + 2], P[B + 3]), cvtpk(P[B + 4], P[B + 5]), cvtpk(P[B + 6], P[B + 7])}
template <bool SUM>
__device__ __forceinline__ void finishSM_n(f32x16& p0, f32x16& p1, float alpha, float& l_reg, bf16x8& pa0, bf16x8& pa1, bf16x8& pa2, bf16x8& pa3) {
#pragma unroll
    for (int r = 0; r < 16; ++r) p1[r] = __builtin_amdgcn_exp2f(p1[r]);
    if (SUM) {
        float s0 = (p0[0] + p0[1]) + (p0[2] + p0[3]), s1 = (p0[4] + p0[5]) + (p0[6] + p0[7]), s2 = (p0[8] + p0[9]) + (p0[10] + p0[11]), s3 = (p0[12] + p0[13]) + (p0[14] + p0[15]);
        float t0 = (p1[0] + p1[1]) + (p1[2] + p1[3]), t1 = (p1[4] + p1[5]) + (p1[6] + p1[7]), t2 = (p1[8] + p1[9]) + (p1[10] + p1[11]), t3 = (p1[12] + p1[13]) + (p1[14] + p1[15]);
        float ps = ((s0 + s1) + (s2 + s3)) + ((t0 + t1) + (t2 + t3));
        { auto rr = __builtin_amdgcn_permlane32_swap(__float_as_uint(ps), __float_as_uint(ps), false, false);
          ps = __uint_as_float(rr[0]) + __uint_as_float(rr[1]); }
        l_reg = l_reg * alpha + ps;
    }
    { u32x4 w = PKN(p0, 0); pa0 = *reinterpret_cast<bf16x8*>(&w); } { u32x4 w = PKN(p0, 8); pa1 = *reinterpret_cast<bf16x8*>(&w); }
    { u32x4 w = PKN(p1, 0); pa2 = *reinterpret_cast<bf16x8*>(&w); } { u32x4 w = PKN(p1, 8); pa3 = *reinterpret_cast<bf16x8*>(&w); }
}

constexpr int DA_SLOT = 32768, DA_VOFF = 16384, DA_WS = 133120, DA_STG = 65536, DA_STG_LD = 132;
__device__ __forceinline__ void qkt_da(f32x16& p0, f32x16& p1, const char* Ks, const bf16x8* qr, const f32x16& negm, int r32, int hi, int cb0) {
#pragma unroll
    for (int d0 = 0; d0 < 4; ++d0) { const int cb = cb0 + (d0 * 16 + hi * 8) * 2;
        const bf16x8 b0 = *reinterpret_cast<const bf16x8*>(Ks + KSWZ(r32, cb));
        const bf16x8 b1 = *reinterpret_cast<const bf16x8*>(Ks + KSWZ(32 + r32, cb));
        if (d0 == 0) { p0 = __builtin_amdgcn_mfma_f32_32x32x16_bf16(b0, qr[0], negm, 0, 0, 0); p1 = __builtin_amdgcn_mfma_f32_32x32x16_bf16(b1, qr[0], negm, 0, 0, 0); }
        else { p0 = __builtin_amdgcn_mfma_f32_32x32x16_bf16(b0, qr[d0], p0, 0, 0, 0); p1 = __builtin_amdgcn_mfma_f32_32x32x16_bf16(b1, qr[d0], p1, 0, 0, 0); } }
}
typedef short v4i16_t __attribute__((ext_vector_type(4)));
__device__ __forceinline__ s16x4 vtr(int addr) { return __builtin_bit_cast(s16x4, __builtin_amdgcn_ds_read_tr16_b64_v4i16((__attribute__((address_space(3))) v4i16_t*)(unsigned)addr)); }
__device__ __forceinline__ void pv_da(f32x16* o, int vb, bf16x8 pa0, bf16x8 pa1, bf16x8 pa2, bf16x8 pa3) {
    s16x4 lo[4], hi[4];
#define VADDR(i) (vb + ((i) & 3) * 512 + ((i) >> 2) * 4096)
#pragma unroll
    for (int i = 0; i < 4; ++i) { lo[i] = vtr(VADDR(i)); hi[i] = vtr(VADDR(i) + 2048); }
#pragma unroll
    for (int i = 0; i < 16; ++i) {
        const bf16x8 vf = PKF(lo[i & 3], hi[i & 3]);
        const bf16x8 pa = ((i >> 2) == 0) ? pa0 : ((i >> 2) == 1) ? pa1 : ((i >> 2) == 2) ? pa2 : pa3;
        o[i & 3] = __builtin_amdgcn_mfma_f32_32x32x16_bf16(pa, vf, o[i & 3], 0, 0, 0);
        if (i + 4 < 16) { lo[i & 3] = vtr(VADDR(i + 4)); hi[i & 3] = vtr(VADDR(i + 4) + 2048); }
    }
#undef VADDR
    __builtin_amdgcn_sched_group_barrier(0x100, 8, 0);
#pragma unroll
    for (int i = 0; i < 12; ++i) { __builtin_amdgcn_sched_group_barrier(0x008, 1, 0); __builtin_amdgcn_sched_group_barrier(0x100, 2, 0); __builtin_amdgcn_sched_group_barrier(0x002, 4, 0); }
#pragma unroll
    for (int i = 0; i < 4; ++i) { __builtin_amdgcn_sched_group_barrier(0x008, 1, 0); __builtin_amdgcn_sched_group_barrier(0x002, 4, 0); }
}
template <bool DRY, int PVAR = 0>
__device__ __forceinline__ void diff_attn_unit(int b, int h, int qb, const u16* Qa, const u16* __restrict__ Ka, const u16* __restrict__ Va, const u16* __restrict__ Ga,
                                               u16* Y, const float* __restrict__ subw, float lam, float one_m_li, char* lds) {
    int tid = threadIdx.x; asm volatile("" : "+v"(tid)); const int lane = tid & 63, r32 = lane & 31, hi = lane >> 5; const int wid = __builtin_amdgcn_readfirstlane(tid >> 6);
    const int map = wid >> 2, wq = wid & 3;
    const long rowbase = (long)b * SEQ; const int q0 = qb * 128;
    float* wsf = (float*)(lds + DA_WS) + wid * 64; float* li_l = wsf; float* al_l = wsf + 32;
    float m_reg = 0.f, l_reg = 0; f32x16 o[4] = {}; bf16x8 qr[4]; f32x16 negm = f32x16{}; asm volatile("" : "+v"(negm));
    const u16* Qw = Qa + (rowbase + q0 + wq * 32 + r32) * DM + h * 128 + map * 64 + hi * 8;
#pragma unroll
    for (int d0 = 0; d0 < 4; ++d0) qr[d0] = ld8(Qw + d0 * 16);
    const u16* Kh = Ka + rowbase * DM + h * 128; const u16* Vh = Va + rowbase * DM + h * 128;
    const int vb0 = (int)(uintptr_t)lds + DA_VOFF + v_rd_base(lane);
    const int cb0 = map * 128;
    unsigned kofs[2], vofs[2];
#pragma unroll
    for (int i = 0; i < 2; ++i) { const int pk = 2 * wid + i;
        const int row = 4 * pk + (lane >> 4), cp = lane & 15; kofs[i] = (unsigned)(row * DM + ((cp ^ (row & 7)) * 8)) * 2u;
        const int st = 2 * pk + (lane >> 5), kk = 8 * (st >> 2) + ((lane & 31) >> 2), cc = 32 * (st & 3) + 8 * (lane & 3); vofs[i] = (unsigned)(kk * DM + cc) * 2u; }
    typedef __attribute__((address_space(3))) unsigned lds_u32;
#define DMA_TILE(t, soff) do { const char* kb_ = (const char*)(Kh + (long)(t) * 64 * DM); const char* vb_ = (const char*)(Vh + (long)(t) * 64 * DM); \
    _Pragma("unroll") for (int i_ = 0; i_ < 2; ++i_) { \
        __builtin_amdgcn_global_load_lds((const unsigned*)(kb_ + kofs[i_]), (lds_u32*)(lds + (soff) + (2 * wid + i_) * 1024), 16, 0, 0); \
        __builtin_amdgcn_global_load_lds((const unsigned*)(vb_ + vofs[i_]), (lds_u32*)(lds + (soff) + DA_VOFF + (2 * wid + i_) * 1024), 16, 0, 0); } } while (0)
#define RESC(a) do { if (__any((a) < 1.f)) { if (hi == 0) al_l[r32] = (a); asm volatile("s_waitcnt lgkmcnt(0)" ::: "memory"); \
    _Pragma("unroll") for (int d = 0; d < 4; ++d) _Pragma("unroll") for (int r = 0; r < 16; ++r) o[d][r] *= al_l[crow(r, hi)]; } } while (0)
    f32x16 pA0, pA1, pB0, pB1; float alA, alB; bf16x8 pa0, pa1, pa2, pa3; constexpr int NT = SEQ / 64;
    DMA_TILE(0, 0); DMA_TILE(1, DA_SLOT); __syncthreads();
    qkt_da(pA0, pA1, lds, qr, negm, r32, hi, cb0); partialSM_n<true>(pA0, pA1, m_reg, negm, alA);
    int sp = 0, sc = DA_SLOT, sn = 2 * DA_SLOT;
#define ROT() do { const int t_ = sp; sp = sc; sc = sn; sn = t_; } while (0)
    for (int j = 1; j + 1 < NT; j += 2) {
        DMA_TILE(j + 1, sn);
        SBAR(); qkt_da(pB0, pB1, lds + sc, qr, negm, r32, hi, cb0);
        finishSM_n<true>(pA0, pA1, alA, l_reg, pa0, pa1, pa2, pa3); SBAR();
        pv_da(o, vb0 + sp, pa0, pa1, pa2, pa3); partialSM_n<false>(pB0, pB1, m_reg, negm, alB);
        RESC(alB); __syncthreads(); ROT();
        DMA_TILE(j + 2, sn);
        SBAR(); qkt_da(pA0, pA1, lds + sc, qr, negm, r32, hi, cb0);
        finishSM_n<true>(pB0, pB1, alB, l_reg, pa0, pa1, pa2, pa3); SBAR();
        pv_da(o, vb0 + sp, pa0, pa1, pa2, pa3); partialSM_n<false>(pA0, pA1, m_reg, negm, alA);
        RESC(alA); __syncthreads(); ROT();
    }
    SBAR(); qkt_da(pB0, pB1, lds + sc, qr, negm, r32, hi, cb0);
    finishSM_n<true>(pA0, pA1, alA, l_reg, pa0, pa1, pa2, pa3); SBAR();
    pv_da(o, vb0 + sp, pa0, pa1, pa2, pa3); partialSM_n<false>(pB0, pB1, m_reg, negm, alB);
    RESC(alB);
    finishSM_n<true>(pB0, pB1, alB, l_reg, pa0, pa1, pa2, pa3); SBAR();
    pv_da(o, vb0 + sc, pa0, pa1, pa2, pa3);
#undef DMA_TILE
#undef ROT
#undef RESC
    if (hi == 0) li_l[r32] = l_reg; asm volatile("s_waitcnt lgkmcnt(0)" ::: "memory");
    float rli[16];
#pragma unroll
    for (int r = 0; r < 16; ++r) rli[r] = __builtin_amdgcn_rcpf(li_l[crow(r, hi)]) * (map ? lam : 1.0f);
    __syncthreads();
    float* xch = (float*)lds;
    if (map == 1) {
#pragma unroll
        for (int d0 = 0; d0 < 4; ++d0)
#pragma unroll
            for (int r = 0; r < 16; ++r) xch[((wq * 4 + d0) * 16 + r) * 64 + lane] = o[d0][r] * rli[r];
    }
    __syncthreads();
    float* stg = (float*)(lds + DA_STG);
    if (map == 0) {
#pragma unroll
        for (int d0 = 0; d0 < 4; ++d0)
#pragma unroll
            for (int r = 0; r < 16; ++r) { const float dv = o[d0][r] * rli[r] - xch[((wq * 4 + d0) * 16 + r) * 64 + lane];
                stg[(wq * 32 + crow(r, hi)) * DA_STG_LD + d0 * 32 + r32] = dv; }
    }
    __syncthreads();
    {
        const int row = tid >> 2, qt = tid & 3; const float* sp = stg + row * DA_STG_LD + qt * 32;
        f32x4 dv[8]; float ss = 0.f;
#pragma unroll
        for (int g = 0; g < 8; ++g) { dv[g] = *(const f32x4*)(sp + g * 4); ss += (dv[g][0] * dv[g][0] + dv[g][1] * dv[g][1]) + (dv[g][2] * dv[g][2] + dv[g][3] * dv[g][3]); }
        ss += __shfl_xor(ss, 1); ss += __shfl_xor(ss, 2);
        const float sc2 = __builtin_amdgcn_rsqf(ss * (1.0f / 128.0f) + EPS) * one_m_li;
        const size_t goff = (size_t)(rowbase + q0 + row) * DM + h * 128 + qt * 32;
#pragma unroll
        for (int g = 0; g < 4; ++g) {
            const bf16x8 gt = ld8(Ga + goff + g * 8);
            const f32x4 w0 = *(const f32x4*)(subw + qt * 32 + g * 8), w1 = *(const f32x4*)(subw + qt * 32 + g * 8 + 4);
            const f32x4 a = dv[2 * g], c = dv[2 * g + 1];
            u32x4 w;
            w.x = cvtpk(a[0] * sc2 * w0[0] * bf2f((u16)gt[0]), a[1] * sc2 * w0[1] * bf2f((u16)gt[1]));
            w.y = cvtpk(a[2] * sc2 * w0[2] * bf2f((u16)gt[2]), a[3] * sc2 * w0[3] * bf2f((u16)gt[3]));
            w.z = cvtpk(c[0] * sc2 * w1[0] * bf2f((u16)gt[4]), c[1] * sc2 * w1[1] * bf2f((u16)gt[5]));
            w.w = cvtpk(c[2] * sc2 * w1[2] * bf2f((u16)gt[6]), c[3] * sc2 * w1[3] * bf2f((u16)gt[7]));
            if (!DRY) *(u32x4*)(Y + goff + g * 8) = w; else asm volatile("" :: "v"(w));
        }
    }
    __syncthreads();
}

constexpr int SWB_K = 0, SWB_V = 49152, SWB_WS = 98304, SWB_STG = 100352, SWB_STG_LD = 36;
__device__ __forceinline__ void swa_block_geom(int qb, int& t_lo, int& t_hi) { const int q0 = qb * 128; t_lo = (q0 >= 128 ? q0 - 128 : 0) >> 6; t_hi = (q0 + 255 < SEQ ? q0 + 255 : SEQ - 1) >> 6; }
template <int N> struct SwaRegs { bf16x8 k[N], v[N]; };
template <int N> __device__ __forceinline__ void swa_tiles_load(SwaRegs<N>& R, int b, int kvh, int t0, int nt, const u16* __restrict__ Kb, const u16* __restrict__ Vb, int tid) {
    const int sr = tid >> 3, sc = (tid & 7) * 8; const long rowbase = (long)b * SEQ;
    const u16* Kh = Kb + (rowbase + t0 * 64 + sr) * 256 + kvh * 64 + sc; const u16* Vh = Vb + (rowbase + t0 * 64 + sr) * 256 + kvh * 64 + sc;
#pragma unroll
    for (int tt = 0; tt < N; ++tt) if (tt < nt) { R.k[tt] = ld8(Kh + (long)tt * 64 * 256); R.v[tt] = ld8(Vh + (long)tt * 64 * 256); }
}
template <int N> __device__ __forceinline__ void swa_tiles_store_lds(const SwaRegs<N>& R, int t0, int nt, char* lds, int tid) {
    const int sr = tid >> 3, sc = (tid & 7) * 8, vst0 = v_stn<2>(sr, sc), kst0 = KSWZ128(sr, sc * 2);
#pragma unroll
    for (int tt = 0; tt < N; ++tt) if (tt < nt) { const int sl = (t0 + tt) % 6; *(bf16x8*)(lds + SWB_K + sl * 8192 + kst0) = R.k[tt]; *(bf16x8*)(lds + SWB_V + sl * 8192 + vst0) = R.v[tt]; }
}
template <bool DRY>
__device__ __forceinline__ void swa_block_compute(int b, int kvh, int qb, const u16* Q, const u16* __restrict__ Gt, u16* Y, const float* __restrict__ sink, char* lds, int tid) {
    const int lane = tid & 63, r32 = lane & 31, hi = lane >> 5; const int wid = __builtin_amdgcn_readfirstlane(tid >> 6);
    const int hq = kvh * 8 + wid; const long rowbase = (long)b * SEQ; const int q0 = qb * 128;
    int t_lo, t_hib; swa_block_geom(qb, t_lo, t_hib); (void)t_hib;
    float* wsf = (float*)(lds + SWB_WS) + wid * 64; float* al_l = wsf + 32;
    float* stg = (float*)(lds + SWB_STG) + wid * (32 * SWB_STG_LD);
    const int vb0 = (int)(uintptr_t)(lds + SWB_V) + v_rd_base(lane);
    const float sink2 = sink[hq] * LOG2E;
    bf16x8 qn[4];
    { const u16* Qw = Q + (rowbase + q0 + r32) * DIN + hq * 64 + hi * 8;
#pragma unroll
      for (int d0 = 0; d0 < 4; ++d0) qn[d0] = ld8(Qw + d0 * 16); }
#pragma unroll 1
    for (int sub = 0; sub < 4; ++sub) {
        const int qs = q0 + 32 * sub;
        bf16x8 qr[4];
#pragma unroll
        for (int d0 = 0; d0 < 4; ++d0) qr[d0] = qn[d0];
        if (sub < 3) { const u16* Qw = Q + (rowbase + qs + 32 + r32) * DIN + hq * 64 + hi * 8;
#pragma unroll
            for (int d0 = 0; d0 < 4; ++d0) qn[d0] = ld8(Qw + d0 * 16); }
        const int ta = ((qs >= 128 ? qs - 128 : 0) >> 6) - t_lo, tb = ((qs + 159 < SEQ ? qs + 159 : SEQ - 1) >> 6) - t_lo;
        float m_reg = sink2, l_dummy = 0.f; f32x16 o[2] = {}; f32x16 lacc, negm; fill16(lacc, 1.0f); fill16(negm, -sink2);
        const bf16x8 ones = {0x3F80, 0x3F80, 0x3F80, 0x3F80, 0x3F80, 0x3F80, 0x3F80, 0x3F80};
        bf16x8 gpre[2][2];
        { const size_t gb = (size_t)(rowbase + qs + (lane >> 1)) * DIN + hq * 64 + (lane & 1) * 16;
#pragma unroll
          for (int cbk = 0; cbk < 2; ++cbk) { gpre[cbk][0] = ld8(Gt + gb + cbk * 32); gpre[cbk][1] = ld8(Gt + gb + cbk * 32 + 8); } }
        for (int tt = ta; tt <= tb; ++tt) {
            const int k0 = (t_lo + tt) * 64, sl = (t_lo + tt) % 6;
            f32x16 p0, p1;
            const char* Ks = lds + SWB_K + sl * 8192;
#pragma unroll
            for (int d0 = 0; d0 < 4; ++d0) { const int cb = (d0 * 16 + hi * 8) * 2;
                const bf16x8 b0 = *reinterpret_cast<const bf16x8*>(Ks + KSWZ128(r32, cb));
                const bf16x8 b1 = *reinterpret_cast<const bf16x8*>(Ks + KSWZ128(32 + r32, cb));
                if (d0 == 0) { p0 = __builtin_amdgcn_mfma_f32_32x32x16_bf16(b0, qr[0], negm, 0, 0, 0); p1 = __builtin_amdgcn_mfma_f32_32x32x16_bf16(b1, qr[0], negm, 0, 0, 0); }
                else { p0 = __builtin_amdgcn_mfma_f32_32x32x16_bf16(b0, qr[d0], p0, 0, 0, 0); p1 = __builtin_amdgcn_mfma_f32_32x32x16_bf16(b1, qr[d0], p1, 0, 0, 0); } }
            if (k0 < qs - 97 || k0 + 63 > qs + 128) {
                const int base = k0 - qs - r32 + 4 * hi + 128;
#pragma unroll
                for (int r = 0; r < 16; ++r) { const int c = (r & 3) + 8 * (r >> 2); if ((unsigned)(base + c) > 256u) p0[r] = -1e30f; if ((unsigned)(base + c + 32) > 256u) p1[r] = -1e30f; }
            }
            float alpha; bf16x8 pa0, pa1, pa2, pa3;
            partialSM_n<false>(p0, p1, m_reg, negm, alpha);
            if (__any(alpha < 1.f)) { if (hi == 0) al_l[r32] = alpha; asm volatile("s_waitcnt lgkmcnt(0)" ::: "memory");
#pragma unroll
                for (int r = 0; r < 16; ++r) { const float al = al_l[crow(r, hi)]; o[0][r] *= al; o[1][r] *= al; lacc[r] *= al; } }
            finishSM_n<false>(p0, p1, alpha, l_dummy, pa0, pa1, pa2, pa3); SBAR();
            {
                const int vbt = vb0 + sl * 8192; s16x4 lo[4], hi4[4];
#define VADDR2(i) (vbt + ((i) & 1) * 512 + ((i) >> 1) * 2048)
#pragma unroll
                for (int i = 0; i < 4; ++i) { lo[i] = vtr(VADDR2(i)); hi4[i] = vtr(VADDR2(i) + 1024); }
#pragma unroll
                for (int i = 0; i < 8; ++i) {
                    const bf16x8 vf = PKF(lo[i & 3], hi4[i & 3]);
                    const bf16x8 pa = ((i >> 1) == 0) ? pa0 : ((i >> 1) == 1) ? pa1 : ((i >> 1) == 2) ? pa2 : pa3;
                    o[i & 1] = __builtin_amdgcn_mfma_f32_32x32x16_bf16(pa, vf, o[i & 1], 0, 0, 0);
                    if ((i & 1) == 1) lacc = __builtin_amdgcn_mfma_f32_32x32x16_bf16(pa, ones, lacc, 0, 0, 0);
                    if (i + 4 < 8) { lo[i & 3] = vtr(VADDR2(i + 4)); hi4[i & 3] = vtr(VADDR2(i + 4) + 1024); }
                }
#undef VADDR2
            }
        }
        float rl[16];
#pragma unroll
        for (int r = 0; r < 16; ++r) rl[r] = __builtin_amdgcn_rcpf(lacc[r]);
#pragma unroll
        for (int cbk = 0; cbk < 2; ++cbk) {
#pragma unroll
            for (int r = 0; r < 16; ++r) stg[crow(r, hi) * SWB_STG_LD + r32] = o[cbk][r] * rl[r];
            asm volatile("s_waitcnt lgkmcnt(0)" ::: "memory");
            const int row = lane >> 1, hf = lane & 1; const float* sp = stg + row * SWB_STG_LD + hf * 16;
            const f32x4 a0 = *(const f32x4*)(sp), a1 = *(const f32x4*)(sp + 4), a2 = *(const f32x4*)(sp + 8), a3 = *(const f32x4*)(sp + 12);
            const size_t goff = (size_t)(rowbase + qs + row) * DIN + hq * 64 + cbk * 32 + hf * 16;
            const bf16x8 g0 = gpre[cbk][0], g1 = gpre[cbk][1];
            u32x4 w0, w1;
            w0.x = cvtpk(a0[0] * bf2f((u16)g0[0]), a0[1] * bf2f((u16)g0[1])); w0.y = cvtpk(a0[2] * bf2f((u16)g0[2]), a0[3] * bf2f((u16)g0[3]));
            w0.z = cvtpk(a1[0] * bf2f((u16)g0[4]), a1[1] * bf2f((u16)g0[5])); w0.w = cvtpk(a1[2] * bf2f((u16)g0[6]), a1[3] * bf2f((u16)g0[7]));
            w1.x = cvtpk(a2[0] * bf2f((u16)g1[0]), a2[1] * bf2f((u16)g1[1])); w1.y = cvtpk(a2[2] * bf2f((u16)g1[2]), a2[3] * bf2f((u16)g1[3]));
            w1.z = cvtpk(a3[0] * bf2f((u16)g1[4]), a3[1] * bf2f((u16)g1[5])); w1.w = cvtpk(a3[2] * bf2f((u16)g1[6]), a3[3] * bf2f((u16)g1[7]));
            if (!DRY) { *(u32x4*)(Y + goff) = w0; *(u32x4*)(Y + goff + 8) = w1; } else asm volatile("" :: "v"(w0), "v"(w1));
            asm volatile("s_waitcnt lgkmcnt(0)" ::: "memory");
        }
    }
}
template <bool DRY>
__device__ __forceinline__ void swa_phase(int u0, const u16* Q, const u16* Kb, const u16* Vb, const u16* Gt, u16* Y, const float* sink, char* lds) {
    int tid = threadIdx.x; asm volatile("" : "+v"(tid));
    const int bk = u0 >> 5, b = bk >> 2, kvh = bk & 3, qbA = u0 & 31, qbB = qbA + 1;
    int tloA, thiA, tloB, thiB; swa_block_geom(qbA, tloA, thiA); swa_block_geom(qbB, tloB, thiB);
    { SwaRegs<6> R; swa_tiles_load<6>(R, b, kvh, tloA, thiA - tloA + 1, Kb, Vb, tid); swa_tiles_store_lds<6>(R, tloA, thiA - tloA + 1, lds, tid); }
    __syncthreads();
    SwaRegs<2> N; const int nnew = thiB - thiA;
    swa_tiles_load<2>(N, b, kvh, thiA + 1, nnew, Kb, Vb, tid);
    swa_block_compute<DRY>(b, kvh, qbA, Q, Gt, Y, sink, lds, tid);
    __syncthreads();
    swa_tiles_store_lds<2>(N, thiA + 1, nnew, lds, tid);
    __syncthreads();
    swa_block_compute<DRY>(b, kvh, qbB, Q, Gt, Y, sink, lds, tid);
    __syncthreads();
}
}
namespace hg {
using namespace att;
typedef _Float16 f16;
constexpr int L_QT = 0, L_KT = 16384, L_QIN = 32768, L_KDEC = 49152, L_V = 65536, L_S = 81920, L_CUM = 114688, L_EDEC = 118784, L_STG = 0, STG_LD = 132;

struct ChunkRegs { unsigned q[8], v[8], lf[8]; };

__device__ __forceinline__ int chunk_pos(int c, int i, int dir) { return dir ? (c * 64 + 63 - i) : (c * 64 + i); }

template <bool NEEDQ>
__device__ __forceinline__ void load_chunk(ChunkRegs& R, const u16* Qh, const u16* Vh, const u16* LF, long rowbase, int colbase, int c, int dir, int wid, int lane) {
#pragma unroll
    for (int i = 0; i < 8; ++i) {
        const long pos = rowbase + chunk_pos(c, wid * 8 + i, dir);
        const size_t off = (size_t)pos * DM + colbase + 2 * lane;
        if (NEEDQ) R.q[i] = *(const unsigned*)(Qh + off);
        R.v[i] = *(const unsigned*)(Vh + off);
        R.lf[i] = *(const unsigned*)(LF + off);
    }
}
__device__ __forceinline__ float h2f(unsigned short h) { return (float)__builtin_bit_cast(f16, h); }

template <bool FULL>
__device__ __forceinline__ void prep_chunk(const ChunkRegs& R, char* lds, int wid, int lane, float (&gtot)[2]) {
    float g[8][2]; float run0 = 0.f, run1 = 0.f;
#pragma unroll
    for (int i = 0; i < 8; ++i) { run0 += h2f((unsigned short)(R.lf[i] & 0xffff)); run1 += h2f((unsigned short)(R.lf[i] >> 16)); g[i][0] = run0; g[i][1] = run1; }
    float* cum = (float*)(lds + L_CUM);
    *(float2*)(cum + wid * 128 + 2 * lane) = make_float2(run0, run1);
    __syncthreads();
    float pre0 = 0.f, pre1 = 0.f, gm0 = 0.f, gm1 = 0.f, gl0 = 0.f, gl1 = 0.f;
#pragma unroll
    for (int w2 = 0; w2 < 8; ++w2) { const float2 t = *(const float2*)(cum + w2 * 128 + 2 * lane);
        if (w2 < wid) { pre0 += t.x; pre1 += t.y; } if (w2 < 4) { gm0 += t.x; gm1 += t.y; } gl0 += t.x; gl1 += t.y; }
    gtot[0] += gl0; gtot[1] += gl1;
    const float egm0 = __expf(gm0), egm1 = __expf(gm1), elm0 = __expf(gl0 - gm0), elm1 = __expf(gl1 - gm1);
    if (wid == 0) *(float2*)((float*)(lds + L_EDEC) + 2 * lane) = make_float2(__expf(gl0), __expf(gl1));
#pragma unroll
    for (int i = 0; i < 8; ++i) {
        const int row = wid * 8 + i;
        const float G0 = pre0 + g[i][0], G1 = pre1 + g[i][1];
        const float e0 = __expf(G0 - gm0), e1 = __expf(G1 - gm1);
        const float r0 = __builtin_amdgcn_rcpf(e0), r1 = __builtin_amdgcn_rcpf(e1);
        const float lf0 = h2f((unsigned short)(R.lf[i] & 0xffff)), lf1 = h2f((unsigned short)(R.lf[i] >> 16));
        const float k0 = 1.0f - __expf(lf0), k1 = 1.0f - __expf(lf1);
        const float kt0 = k0 * r0, kt1 = k1 * r1;
        const int vo = v_st<4>(row, 2 * lane);
        *(unsigned*)(lds + L_KDEC + vo) = cvtpk(kt0 * elm0, kt1 * elm1);
        *(unsigned*)(lds + L_V + vo) = R.v[i];
        if (FULL) {
            const float q0 = bf2f((u16)(R.q[i] & 0xffff)), q1 = bf2f((u16)(R.q[i] >> 16));
            const float qt0 = q0 * e0, qt1 = q1 * e1;
            const int ko = KSWZ(row, 4 * lane);
            *(unsigned*)(lds + L_QT + ko) = cvtpk(qt0, qt1);
            *(unsigned*)(lds + L_KT + ko) = cvtpk(kt0, kt1);
            *(unsigned*)(lds + L_QIN + ko) = cvtpk(qt0 * egm0, qt1 * egm1);
        }
    }
}

template <int KS> __device__ __forceinline__ bf16x8 tr_frag(int vb) {
    const s16x4 l = tr_read<KS * 4096>(vb), h = tr_read<KS * 4096 + 2048>(vb);
    asm volatile("s_waitcnt lgkmcnt(0)" ::: "memory"); SBAR();
    return PKF(l, h);
}

struct SuFrag { s16x4 lv, hv, l0, h0, l1, h1; };
__device__ __forceinline__ void su_read(SuFrag& f, int vbV, int vbK0, int vbK1, int off) {
    f.lv = vtr(vbV + off); f.hv = vtr(vbV + off + 2048); f.l0 = vtr(vbK0 + off); f.h0 = vtr(vbK0 + off + 2048); f.l1 = vtr(vbK1 + off); f.h1 = vtr(vbK1 + off + 2048);
}
__device__ __forceinline__ void su_mma(f32x16 (&sacc)[2], const SuFrag& f) {
    const bf16x8 bv = PKF(f.lv, f.hv), a0 = PKF(f.l0, f.h0), a1 = PKF(f.l1, f.h1);
    sacc[0] = __builtin_amdgcn_mfma_f32_32x32x16_bf16(a0, bv, sacc[0], 0, 0, 0); sacc[1] = __builtin_amdgcn_mfma_f32_32x32x16_bf16(a1, bv, sacc[1], 0, 0, 0);
}
template <int NIMG>
__device__ __forceinline__ void state_update_t(f32x16 (&sacc)[2], const char* lds, int ldsbase, int offK, int offV, int offE, int wid, int lane) {
    const int hi = lane >> 5, j = wid >> 1, ib = 2 * (wid & 1);
    const float* edec = (const float*)(lds + offE);
    const int vbV = ldsbase + offV + v_rd_base(lane) + j * 512;
    const int vbK0 = ldsbase + offK + v_rd_base(lane) + ib * 512, vbK1 = vbK0 + 512;
#pragma unroll
    for (int i2 = 0; i2 < 2; ++i2)
#pragma unroll
        for (int r = 0; r < 16; ++r) sacc[i2][r] *= edec[32 * (ib + i2) + crow(r, hi)];
    SBAR();
    SuFrag fa, fb; su_read(fa, vbV, vbK0, vbK1, 0);
#pragma unroll
    for (int s = 0; s < 4 * NIMG; s += 2) {
        su_read(fb, vbV, vbK0, vbK1, ((s + 1) >> 2) * 16384 + ((s + 1) & 3) * 4096);
        su_mma(sacc, fa);
        if (s + 2 < 4 * NIMG) su_read(fa, vbV, vbK0, vbK1, ((s + 2) >> 2) * 16384 + ((s + 2) & 3) * 4096);
        su_mma(sacc, fb);
    }
    __builtin_amdgcn_sched_group_barrier(0x100, 6, 0);
#pragma unroll
    for (int s = 0; s < 4 * NIMG - 1; ++s) { __builtin_amdgcn_sched_group_barrier(0x100, 6, 0); __builtin_amdgcn_sched_group_barrier(0x008, 2, 0); }
    __builtin_amdgcn_sched_group_barrier(0x008, 2, 0);
    SBAR();
}
__device__ __forceinline__ void state_update(f32x16 (&sacc)[2], const char* lds, int ldsbase, int wid, int lane) { state_update_t<1>(sacc, lds, ldsbase, L_KDEC, L_V, L_EDEC, wid, lane); }
__device__ __forceinline__ void write_simg(const f32x16 (&sacc)[2], char* lds, int wid, int lane) {
    const int r32 = lane & 31, hi = lane >> 5, j = wid >> 1, ib = 2 * (wid & 1);
#pragma unroll
    for (int i2 = 0; i2 < 2; ++i2)
#pragma unroll
        for (int r = 0; r < 16; ++r) { const int d = 32 * (ib + i2) + crow(r, hi);
            *(__hip_bfloat16*)(lds + L_S + (d >> 6) * 16384 + v_st<4>(d & 63, 32 * j + r32)) = __float2bfloat16(sacc[i2][r]); }
}
__device__ __forceinline__ f32x16 chunk_output(const char* lds, int ldsbase, int wid, int lane) {
    const int r32 = lane & 31, hi = lane >> 5, tb = wid & 1, j = wid >> 1;
    const char* QT = lds + L_QT; const char* KT = lds + L_KT; const char* QIN = lds + L_QIN;
    f32x16 p0 = f32x16{}, p1 = f32x16{};
#pragma unroll
    for (int d0 = 0; d0 < 8; ++d0) { const int cb = (d0 * 16 + hi * 8) * 2;
        const bf16x8 qf = *reinterpret_cast<const bf16x8*>(QT + KSWZ(32 * tb + r32, cb));
        const bf16x8 k0 = *reinterpret_cast<const bf16x8*>(KT + KSWZ(r32, cb));
        p0 = __builtin_amdgcn_mfma_f32_32x32x16_bf16(k0, qf, p0, 0, 0, 0);
        if (tb) { const bf16x8 k1 = *reinterpret_cast<const bf16x8*>(KT + KSWZ(32 + r32, cb)); p1 = __builtin_amdgcn_mfma_f32_32x32x16_bf16(k1, qf, p1, 0, 0, 0); } }
#pragma unroll
    for (int r = 0; r < 16; ++r) { const bool keep = crow(r, hi) <= r32; if (tb == 0) { p0[r] = keep ? p0[r] : 0.f; p1[r] = 0.f; } else { p1[r] = keep ? p1[r] : 0.f; } }
    bf16x8 pa0, pa1, pa2, pa3; pack4(p0, p1, pa0, pa1, pa2, pa3);
    f32x16 oacc = f32x16{};
    pv_blk<4>(oacc, ldsbase + L_V + v_rd_base(lane) + j * 512, pa0, pa1, pa2, pa3);
    const int vbS = ldsbase + L_S + v_rd_base(lane) + j * 512;
#define QINF(kd) (*reinterpret_cast<const bf16x8*>(QIN + KSWZ(32 * tb + r32, ((kd) * 16 + hi * 8) * 2)))
    {
        s16x4 lo[2], hh[2];
#define SADDR(kd) (vbS + ((kd) >> 2) * 16384 + ((kd) & 3) * 4096)
        lo[0] = vtr(SADDR(0)); hh[0] = vtr(SADDR(0) + 2048); lo[1] = vtr(SADDR(1)); hh[1] = vtr(SADDR(1) + 2048);
#pragma unroll
        for (int kd = 0; kd < 8; ++kd) {
            const bf16x8 b = PKF(lo[kd & 1], hh[kd & 1]); const bf16x8 q = QINF(kd);
            oacc = __builtin_amdgcn_mfma_f32_32x32x16_bf16(q, b, oacc, 0, 0, 0);
            if (kd + 2 < 8) { lo[kd & 1] = vtr(SADDR(kd + 2)); hh[kd & 1] = vtr(SADDR(kd + 2) + 2048); }
        }
#undef SADDR
    }
#undef QINF
    return oacc;
}

constexpr int P1_KDEC = 0, P1_V = 65536, P1_CUM = 131072, P1_EDEC = 135168;
struct BlockRegs { unsigned v[32], lf[32]; };
__device__ __forceinline__ void load_block(BlockRegs& R, const u16* Vh, const u16* LF, long rowbase, int colbase, int seg, int blk, int dir, int wid, int lane) {
    unsigned voff = (unsigned)lane * 4u; asm volatile("" : "+v"(voff));
#pragma unroll
    for (int i = 0; i < 32; ++i) {
        const int p = blk * 256 + wid * 32 + i;
        const long pos = rowbase + seg * 512 + (dir ? 511 - p : p);
        const size_t roff = ((size_t)pos * DM + colbase) * 2;
        R.v[i] = *(const unsigned*)((const char*)Vh + roff + voff); R.lf[i] = *(const unsigned*)((const char*)LF + roff + voff);
    }
}
__device__ __forceinline__ void prep_block(const BlockRegs& R, char* lds, int wid, int lane, float (&gtot)[2]) {
    float run0 = 0.f, run1 = 0.f;
#pragma unroll
    for (int i = 0; i < 32; ++i) { run0 += h2f((unsigned short)(R.lf[i] & 0xffff)); run1 += h2f((unsigned short)(R.lf[i] >> 16)); }
    float* cum = (float*)(lds + P1_CUM);
    *(float2*)(cum + wid * 128 + 2 * lane) = make_float2(run0, run1);
    __syncthreads();
    float pre0 = 0.f, pre1 = 0.f, gl0 = 0.f, gl1 = 0.f;
#pragma unroll
    for (int w2 = 0; w2 < 8; ++w2) { const float2 t = *(const float2*)(cum + w2 * 128 + 2 * lane); if (w2 < wid) { pre0 += t.x; pre1 += t.y; } gl0 += t.x; gl1 += t.y; }
    gtot[0] += gl0; gtot[1] += gl1;
    if (wid == 0) *(float2*)((float*)(lds + P1_EDEC) + 2 * lane) = make_float2(__expf(gl0), __expf(gl1));
    float G0 = pre0 - gl0, G1 = pre1 - gl1;
    char* base = lds + (wid >> 1) * 16384 + (wid & 1) * 8192 + v_st<4>(0, 2 * lane);
#pragma unroll
    for (int i = 0; i < 32; ++i) {
        const float lf0 = h2f((unsigned short)(R.lf[i] & 0xffff)), lf1 = h2f((unsigned short)(R.lf[i] >> 16));
        G0 += lf0; G1 += lf1;
        const float k0 = 1.0f - __expf(lf0), k1 = 1.0f - __expf(lf1);
        const int vo = v_st<4>(i, 0);
        *(unsigned*)(base + P1_KDEC + vo) = cvtpk(k0 * __expf(-G0), k1 * __expf(-G1));
        *(unsigned*)(base + P1_V + vo) = R.v[i];
    }
}
__device__ __forceinline__ void state_update_block(f32x16 (&sacc)[2], const char* lds, int ldsbase, int wid, int lane) { state_update_t<4>(sacc, lds, ldsbase, P1_KDEC, P1_V, P1_EDEC, wid, lane); }
__device__ __forceinline__ void hgrn_pass1(int item, const u16* Vt, const u16* LF0, const u16* LF1, float* ust, float* dst, char* lds) {
    int tid = threadIdx.x; asm volatile("" : "+v"(tid)); const int lane = tid & 63; const int wid = __builtin_amdgcn_readfirstlane(tid >> 6);
    const int seg = item & 7, dir = (item >> 3) & 1, bh = item >> 4, b = bh >> 3, h = bh & 7;
    const long rowbase = (long)b * SEQ; const int colbase = h * 128; const u16* LF = dir ? LF1 : LF0;
    const int ldsbase = (int)(uintptr_t)lds;
    f32x16 sacc[2] = {}; float gtot[2] = {0.f, 0.f};
    BlockRegs R;
    load_block(R, Vt, LF, rowbase, colbase, seg, 0, dir, wid, lane);
#pragma unroll 1
    for (int blk = 0; blk < 2; ++blk) {
        prep_block(R, lds, wid, lane, gtot);
        asm volatile("" ::: "memory");
        if (blk == 0) load_block(R, Vt, LF, rowbase, colbase, seg, 1, dir, wid, lane);
        __syncthreads();
        state_update_block(sacc, lds, ldsbase, wid, lane);
    }
    float* up = ust + (size_t)item * 16384 + wid * 2048;
#pragma unroll
    for (int i2 = 0; i2 < 2; ++i2)
#pragma unroll
        for (int g = 0; g < 4; ++g) *((f32x4*)up + (i2 * 4 + g) * 64 + lane) = (f32x4){sacc[i2][4 * g], sacc[i2][4 * g + 1], sacc[i2][4 * g + 2], sacc[i2][4 * g + 3]};
    if (wid == 0) *(float2*)(dst + (size_t)item * 128 + 2 * lane) = make_float2(__expf(gtot[0]), __expf(gtot[1]));
    __syncthreads();
}

template <bool DRY, int PVAR = 0>
__device__ __forceinline__ void hgrn_pass2(int item, const u16* Qh, const u16* Vt, const u16* LF0, const u16* LF1, const u16* Gt, u16* OF, u16* Y,
                                           const float* ust, const float* dst, const float* __restrict__ nw, char* lds) {
    int tid = threadIdx.x; asm volatile("" : "+v"(tid)); const int lane = tid & 63, r32 = lane & 31, hi = lane >> 5; const int wid = __builtin_amdgcn_readfirstlane(tid >> 6);
    const int seg = item & 7, bh = item >> 3, b = bh >> 3, h = bh & 7;
    const long rowbase = (long)b * SEQ; const int colbase = h * 128;
    const int ldsbase = (int)(uintptr_t)lds; const int tb = wid & 1, j = wid >> 1, ib = 2 * (wid & 1);
    float* stg = (float*)(lds + L_STG);
    ChunkRegs R;
#pragma unroll 1
    for (int dir = 0; dir < 2; ++dir) {
        const u16* LF = dir ? LF1 : LF0;
        f32x16 sacc[2] = {}; float gtot[2] = {0.f, 0.f};
        const int nseg = dir ? (7 - seg) : seg;
        for (int n = 0; n < nseg; ++n) {
            const int sg = dir ? (7 - n) : n; const int it = ((bh * 2 + dir) * 8 + sg);
            const float* up = ust + (size_t)it * 16384 + wid * 2048; const float* dp = dst + (size_t)it * 128;
#pragma unroll
            for (int i2 = 0; i2 < 2; ++i2)
#pragma unroll
                for (int g = 0; g < 4; ++g) { const f32x4 uv = *((const f32x4*)up + (i2 * 4 + g) * 64 + lane), dv = *(const f32x4*)(dp + 32 * (ib + i2) + 8 * g + 4 * hi);
#pragma unroll
                    for (int e = 0; e < 4; ++e) sacc[i2][4 * g + e] = sacc[i2][4 * g + e] * dv[e] + uv[e]; }
        }
        write_simg(sacc, lds, wid, lane);
        load_chunk<true>(R, Qh, Vt, LF, rowbase, colbase, dir ? (seg * 8 + 7) : (seg * 8), dir, wid, lane);
        for (int cc = 0; cc < 8; ++cc) {
            const int c = dir ? (seg * 8 + 7 - cc) : (seg * 8 + cc);
            const int ri = tid >> 3, rcg = tid & 7; const size_t goff = (size_t)(rowbase + chunk_pos(c, ri, dir)) * DM + colbase + rcg * 16;
            u32x4 pf0 = {}, pf1 = {}; bf16x8 pg0 = {}, pg1 = {};
            if (dir) { pf0 = *(const u32x4*)(OF + goff); pf1 = *(const u32x4*)(OF + goff + 8); pg0 = ld8(Gt + goff); pg1 = ld8(Gt + goff + 8); }
            if (PVAR != 1) prep_chunk<true>(R, lds, wid, lane, gtot); else { asm volatile("" :: "v"(R.q[0]), "v"(R.v[7]), "v"(R.lf[3])); __syncthreads(); }
            if (cc + 1 < 8) load_chunk<true>(R, Qh, Vt, LF, rowbase, colbase, dir ? (seg * 8 + 6 - cc) : (seg * 8 + cc + 1), dir, wid, lane);
            __syncthreads();
            f32x16 oacc = f32x16{};
            if (PVAR != 2) { oacc = chunk_output(lds, ldsbase, wid, lane); state_update(sacc, lds, ldsbase, wid, lane); }
            __syncthreads();
            if (PVAR != 3) {
            write_simg(sacc, lds, wid, lane);
#pragma unroll
            for (int r = 0; r < 16; ++r) stg[(32 * tb + crow(r, hi)) * STG_LD + 32 * j + r32] = oacc[r];
            __syncthreads();
            {
                const int i = ri, cg = rcg; const float* sp = stg + i * STG_LD + cg * 16;
                f32x4 ov[4];
#pragma unroll
                for (int g = 0; g < 4; ++g) ov[g] = *(const f32x4*)(sp + g * 4);
                if (dir == 0) {
                    u32x4 w0, w1;
                    w0.x = pg8::pk_f16(ov[0][0], ov[0][1]); w0.y = pg8::pk_f16(ov[0][2], ov[0][3]); w0.z = pg8::pk_f16(ov[1][0], ov[1][1]); w0.w = pg8::pk_f16(ov[1][2], ov[1][3]);
                    w1.x = pg8::pk_f16(ov[2][0], ov[2][1]); w1.y = pg8::pk_f16(ov[2][2], ov[2][3]); w1.z = pg8::pk_f16(ov[3][0], ov[3][1]); w1.w = pg8::pk_f16(ov[3][2], ov[3][3]);
                    if (!DRY) { *(u32x4*)(OF + goff) = w0; *(u32x4*)(OF + goff + 8) = w1; } else asm volatile("" :: "v"(w0), "v"(w1));
                } else {
                    const u32x4 f0 = pf0, f1 = pf1;
                    float tv[16];
#pragma unroll
                    for (int e = 0; e < 4; ++e) { tv[2 * e] = h2f((unsigned short)(f0[e] & 0xffff)); tv[2 * e + 1] = h2f((unsigned short)(f0[e] >> 16));
                                                  tv[8 + 2 * e] = h2f((unsigned short)(f1[e] & 0xffff)); tv[8 + 2 * e + 1] = h2f((unsigned short)(f1[e] >> 16)); }
                    float ss = 0.f;
#pragma unroll
                    for (int e = 0; e < 16; ++e) { tv[e] += ov[e >> 2][e & 3]; ss += tv[e] * tv[e]; }
                    ss += __shfl_xor(ss, 1); ss += __shfl_xor(ss, 2); ss += __shfl_xor(ss, 4);
                    const float rs = __builtin_amdgcn_rsqf(ss * (1.0f / 128.0f) + EPS);
                    const bf16x8 g0 = pg0, g1 = pg1;
                    float yv[16];
#pragma unroll
                    for (int e = 0; e < 8; ++e) { yv[e] = tv[e] * rs * nw[cg * 16 + e] * bf2f((u16)g0[e]); yv[8 + e] = tv[8 + e] * rs * nw[cg * 16 + 8 + e] * bf2f((u16)g1[e]); }
                    u32x4 w0, w1;
                    w0.x = cvtpk(yv[0], yv[1]); w0.y = cvtpk(yv[2], yv[3]); w0.z = cvtpk(yv[4], yv[5]); w0.w = cvtpk(yv[6], yv[7]);
                    w1.x = cvtpk(yv[8], yv[9]); w1.y = cvtpk(yv[10], yv[11]); w1.z = cvtpk(yv[12], yv[13]); w1.w = cvtpk(yv[14], yv[15]);
                    if (!DRY) { *(u32x4*)(Y + goff) = w0; *(u32x4*)(Y + goff + 8) = w1; } else asm volatile("" :: "v"(w0), "v"(w1));
                }
            }
            } else { asm volatile("" :: "v"(oacc), "v"(sacc[0]), "v"(sacc[1]), "v"(pf0), "v"(pg0)); __syncthreads(); }
        }
        __syncthreads();
    }
}
}
#define GAS __attribute__((address_space(1)))
#define LAS __attribute__((address_space(3)))
typedef unsigned short bf16;
typedef unsigned v4u __attribute__((ext_vector_type(4)));
typedef float f32x4 __attribute__((ext_vector_type(4)));
typedef short bf16x8 __attribute__((ext_vector_type(8)));
typedef GAS unsigned gu32;
typedef GAS unsigned long long gu64;
#define RLX_AGENT __ATOMIC_RELAXED, __HIP_MEMORY_SCOPE_AGENT
#define LDS_WAIT() asm volatile("s_waitcnt lgkmcnt(0)" ::: "memory")
#define VM_WAIT() asm volatile("s_waitcnt vmcnt(0)" ::: "memory")
__device__ __forceinline__ unsigned long long rt() { return __builtin_amdgcn_s_memrealtime(); }
__device__ __forceinline__ unsigned f2bf(float f) { unsigned u = __builtin_bit_cast(unsigned, f); return (u + 0x7fffu + ((u >> 16) & 1u)) >> 16; }
__device__ __forceinline__ unsigned pk2(float lo, float hi) { return f2bf(lo) | (f2bf(hi) << 16); }

#define XB_TMO      128
#define XB_XCNT(j)  (256  + 64 * (j))
#define XB_XSUB(j)  (1280 + 64 * (j))
#define XB_XGEN(j)  (2304 + 64 * (j))
#define XB_TOP      3328
#define XB_TOPGEN   3392
#define XCD_BAR_WORDS 3456
#define XB_SPIN_CAP (1u << 18)

__device__ __forceinline__ unsigned xb_ld(unsigned* p)              { return __hip_atomic_load(p, __ATOMIC_RELAXED, __HIP_MEMORY_SCOPE_AGENT); }
__device__ __forceinline__ unsigned xb_add(unsigned* p, unsigned v) { return __hip_atomic_fetch_add(p, v, __ATOMIC_RELAXED, __HIP_MEMORY_SCOPE_AGENT); }
__device__ __forceinline__ unsigned xb_xcc_id() { return (unsigned)__builtin_amdgcn_s_getreg((3 << 11) | 20) & 0xFu; }
#define XB_SPIN(cond, bar) do { unsigned _sp = 0; while (cond) { __builtin_amdgcn_s_sleep(1); \
    if ((++_sp & 255u) == 0u) { if (xb_ld(&(bar)[XB_TMO])) break; if (_sp > XB_SPIN_CAP) { atomicAdd(&(bar)[XB_TMO], 1u); break; } } } } while (0)

struct XcdBarrier {
    unsigned* bar; unsigned x;
    volatile LAS unsigned* st;
};

__device__ __forceinline__ XcdBarrier xcd_barrier_post(unsigned* bar, volatile LAS unsigned* st) {
    XcdBarrier b; b.bar = bar; b.x = xb_xcc_id(); b.st = st;
    if (threadIdx.x == 0) (void)xb_add(&bar[XB_XCNT(b.x)], 1u);
    return b;
}
__device__ __forceinline__ void xcd_barrier_complete(unsigned* bar, unsigned x, unsigned& nloc, unsigned& nx) {
    const unsigned G = gridDim.x * gridDim.y * gridDim.z;
    unsigned sum, cnt, mine, sp = 0u;
    for (;;) {
        sum = 0u; cnt = 0u; mine = 0u;
#pragma unroll
        for (unsigned j = 0; j < 16; ++j) { const unsigned c = xb_ld(&bar[XB_XCNT(j)]); sum += c; cnt += (c > 0u) ? 1u : 0u; mine = (j == x) ? c : mine; }
        if (sum == G) break;
        __builtin_amdgcn_s_sleep(1);
        if ((++sp & 255u) == 0u) { if (xb_ld(&bar[XB_TMO])) break; if (sp > XB_SPIN_CAP) { atomicAdd(&bar[XB_TMO], 1u); break; } }
    }
    nloc = mine > 0u ? mine : 1u; nx = cnt > 0u ? cnt : 1u;
}

__device__ __forceinline__ void xcd_barrier(const XcdBarrier& b) {
    asm volatile("s_waitcnt vmcnt(0)" ::: "memory");
    __syncthreads();
    if (threadIdx.x == 0) {
        unsigned* bar = b.bar; asm volatile("" : "+s"(bar)); unsigned bx = __builtin_amdgcn_readfirstlane(b.x); asm volatile("" : "+s"(bx));
        __builtin_amdgcn_s_waitcnt(0);
        unsigned nloc = b.st[0], nx = b.st[1];
        if (nloc == 0u) { xcd_barrier_complete(bar, bx, nloc, nx); b.st[0] = nloc; b.st[1] = nx; }
        const unsigned old = xb_add(&bar[XB_XSUB(bx)], 1u);
        const unsigned gen = old / nloc;
        if (old + 1u == (gen + 1u) * nloc) {
            __builtin_amdgcn_fence(__ATOMIC_RELEASE, "agent");
            asm volatile("s_waitcnt vmcnt(0)" ::: "memory");
            const unsigned og = xb_add(&bar[XB_TOP], 1u);
            const unsigned tg = og / nx;
            if (og + 1u == (tg + 1u) * nx) xb_add(&bar[XB_TOPGEN], 1u);
            else XB_SPIN(xb_ld(&bar[XB_TOPGEN]) == tg, bar);
            __builtin_amdgcn_fence(__ATOMIC_ACQUIRE, "agent");
            xb_add(&bar[XB_XGEN(bx)], 1u);
            asm volatile("s_waitcnt vmcnt(0)" ::: "memory");
        } else {
            XB_SPIN(xb_ld(&bar[XB_XGEN(bx)]) == gen, bar);
            __builtin_amdgcn_fence(__ATOMIC_ACQUIRE, "agent");
            asm volatile("s_waitcnt vmcnt(0)" ::: "memory");
        }
    }
    __syncthreads();
}
#ifndef DUP_MASK
#define DUP_MASK 0
#endif
#define DUP(kind) (((DUP_MASK) >> (kind)) & 1)
#ifndef DUPR_MASK
#define DUPR_MASK 0
#endif
#define DUPR(kind) (((DUPR_MASK) >> (kind)) & 1)
#ifndef DUPR_MODE
#define DUPR_MODE 0
#endif
#ifndef MK_PER_PHASE
#define MK_PER_PHASE 0
#endif

constexpr size_t MiB = 1u << 20;
constexpr size_t WS_CTL = 0, CTL_ZERO_BYTES = 1 * MiB;
constexpr size_t WS_ROPE = 1 * MiB;
constexpr size_t WS_LB = 1 * MiB + 256 * 1024;
constexpr size_t WS_DST = 1 * MiB + 512 * 1024;
constexpr size_t WS_SSQ = 2 * MiB;
constexpr size_t WS_WTE = 3 * MiB;
constexpr size_t WS_WTO = 25 * MiB;
constexpr size_t WS_XB = 38 * MiB;
constexpr size_t WS_R0 = 70 * MiB, RSZ = 32 * MiB;
constexpr size_t WS_END = WS_R0 + 6 * RSZ;
constexpr int CW_BAR = 4096;

constexpr int RING_BYTES = 139264;
constexpr int LDSCTL_OFF = RING_BYTES + 8 * pg8::EPI_STG_WAVE, MISC_OFF = LDSCTL_OFF + 320;
constexpr int LDS_BYTES = 163840;
constexpr int NWAVES = 8, GRID = 256;
constexpr int NPH = 20;

struct Frame {
    LAS unsigned char* lds; volatile LAS unsigned* MISC; gu32* ctl;
    int tid, lane, wave, vcu, G;
};

__device__ __forceinline__ void transpose_item(const float* W, const float* sc, int K, int N, bf16* WT, LAS float* scr, int item, int lane) {
    const int nblk = N / 32, kb = item / nblk, nb = item % nblk, k0 = 64 * kb, n0 = 32 * nb;
    const int c4 = lane & 7, rk = lane >> 3;
#pragma unroll
    for (int i = 0; i < 8; ++i) { const int kk = 8 * i + rk; const float s = sc ? sc[k0 + kk] : 1.0f;
        f32x4 v = *(const GAS f32x4*)(W + (size_t)(k0 + kk) * N + n0 + 4 * c4); v = v * s; *(LAS f32x4*)(scr + kk * 36 + 4 * c4) = v; }
    LDS_WAIT(); asm volatile("" ::: "memory");
    const int c = lane & 7;
#pragma unroll
    for (int j = 0; j < 4; ++j) { const int n = (lane >> 3) + 8 * j; const LAS float* s = scr + (8 * c) * 36 + n;
        v4u o; o.x = pk2(s[0 * 36], s[1 * 36]); o.y = pk2(s[2 * 36], s[3 * 36]); o.z = pk2(s[4 * 36], s[5 * 36]); o.w = pk2(s[6 * 36], s[7 * 36]);
        *(GAS v4u*)(WT + (size_t)(n0 + n) * K + k0 + 8 * c) = o; }
    LDS_WAIT(); asm volatile("" ::: "memory");
}
__device__ __forceinline__ void convert_layer(Frame& F, const float* Win, const float* nrm, int Nin, const float* Wout, bf16* dstbuf) {
    int lane = F.lane; asm volatile("" : "+v"(lane));
    LAS float* scr = (LAS float*)(F.lds + F.wave * 16384);
    const int gw = F.vcu * NWAVES + F.wave, NGW = F.G * NWAVES;
    const int I_in = (DM / 64) * (Nin / 32), I_out = (DIN / 64) * (DM / 32);
    bf16* wout_t = dstbuf + (size_t)Nin * DM;
    for (int it = gw; it < I_in + I_out; it += NGW) {
        if (it < I_in) transpose_item(Win, nrm, DM, Nin, dstbuf, scr, it, lane);
        else transpose_item(Wout, nullptr, DIN, DM, wout_t, scr, it - I_in, lane);
    }
}
__device__ __forceinline__ float wave_sum(float v) {
#pragma unroll
    for (int o = 1; o < 64; o <<= 1) v += __shfl_xor(v, o);
    return v;
}

__device__ __forceinline__ void stagger(int vcu, unsigned ticks) {
    if (vcu & 1) { const unsigned long long t0 = __builtin_amdgcn_s_memrealtime(); while (__builtin_amdgcn_s_memrealtime() - t0 < ticks) __builtin_amdgcn_s_sleep(8); }
}
#ifndef STAG_EVEN
#define STAG_EVEN 0
#endif
#ifndef STAG_ODD
#define STAG_ODD 0
#endif
struct Args { const float* in[13]; float* out; unsigned char* ws; int ph_lo, ph_hi; };

__global__ void __launch_bounds__(NWAVES * 64, 2) mk_fwd(Args args) {
    extern __shared__ __attribute__((aligned(16))) unsigned char lds[];
    Frame F;
    F.lds = (LAS unsigned char*)lds;
    F.MISC = (volatile LAS unsigned*)(F.lds + MISC_OFF);
    F.tid = threadIdx.x; F.lane = F.tid & 63; F.wave = __builtin_amdgcn_readfirstlane(F.tid >> 6);
    F.G = gridDim.x; { const int bx = blockIdx.x; F.vcu = (F.G % 8 == 0) ? (bx % 8) * (F.G / 8) + bx / 8 : bx; }
    unsigned char* ws = args.ws;
    F.ctl = (gu32*)(ws + WS_CTL);
    for (int u = F.tid; u < (LDS_BYTES - LDSCTL_OFF) / 4; u += NWAVES * 64) ((LAS unsigned*)(F.lds + LDSCTL_OFF))[u] = 0u;
    __syncthreads();
    const int lo = args.ph_lo, hi = args.ph_hi; (void)lo; (void)hi;
    const bool multi = MK_PER_PHASE ? ((hi - lo) > 1) : true;
    XcdBarrier bar; bar.bar = (unsigned*)(F.ctl + CW_BAR); bar.x = 0; bar.st = nullptr;
    if (multi) bar = xcd_barrier_post((unsigned*)(F.ctl + CW_BAR), F.MISC + 8);
#ifndef PHASE_MASK
#define PHASE_MASK 0xFFFF
#endif
#if MK_PER_PHASE
#define INK(kind, k) ((((PHASE_MASK) >> (kind)) & 1) && lo <= (k) && (k) < hi)
#define IN(k) (lo <= (k) && (k) < hi)
#else
#define INK(kind, k) (((PHASE_MASK) >> (kind)) & 1)
#define IN(k) true
#endif
#if MK_PER_PHASE
#define SEAM(k) do { if (IN(k) && IN((k) + 1)) xcd_barrier(bar); } while (0)
#else
#define SEAM(k) do { xcd_barrier(bar); if (DUP(9)) xcd_barrier(bar); } while (0)
#endif

#define PTRS() size_t wz_ = 0; asm volatile("" : "+s"(wz_)); unsigned char* wsl = args.ws + wz_; \
    const float* x_in = args.in[0]; float* xres = args.out; \
    float* rope = (float*)(wsl + WS_ROPE); float* lbt = (float*)(wsl + WS_LB); float* dstv = (float*)(wsl + WS_DST); float* ssq = (float*)(wsl + WS_SSQ); \
    bf16* wte = (bf16*)(wsl + WS_WTE); bf16* wto = (bf16*)(wsl + WS_WTO); bf16* xb = (bf16*)(wsl + WS_XB); float* ust = args.out;     \
    unsigned char* R0 = wsl + WS_R0; unsigned char* R1 = R0 + RSZ; unsigned char* R2 = R1 + RSZ; unsigned char* R3 = R2 + RSZ; unsigned char* R4 = R3 + RSZ; unsigned char* R5 = R4 + RSZ; \
    const int gw = F.vcu * NWAVES + F.wave, NGW = F.G * NWAVES; int tidl = threadIdx.x; asm volatile("" : "+v"(tidl)); const int lanel = tidl & 63; (void)lanel; \
    (void)x_in; (void)xres; (void)rope; (void)lbt; (void)dstv; (void)ssq; (void)wte; (void)wto; (void)xb; (void)ust; (void)R0; (void)R1; (void)R2; (void)R3; (void)R4; (void)R5; (void)gw; (void)NGW;

    for (int rep_ = 0; rep_ < (DUP(0) ? 2 : 1); ++rep_)
    if (INK(0, 0)) {
        PTRS();
        convert_layer(F, args.in[2], args.in[1], EVEN_IN, args.in[7], wte);
        convert_layer(F, args.in[9], args.in[8], ODD_IN, args.in[11], wto);
        {
            const int gt = F.vcu * (NWAVES * 64) + tidl, NGT = F.G * NWAVES * 64;
            for (int e = gt; e < SEQ * 8; e += NGT) { const int pos = e >> 3, i = e & 7; const double inv = pow(500000.0, -(double)i / 8.0); const double ang = (double)pos * inv;
                rope[e] = (float)cos(ang); rope[SEQ * 8 + e] = (float)sin(ang); }
            const float* lg = args.in[6];
            for (int e = gt; e < 2 * 1024; e += NGT) { const int dir = e >> 10, c = e & 1023; const float l0 = lg[(dir * 2 + 0) * 1024 + c], l1 = lg[(dir * 2 + 1) * 1024 + c];
                lbt[e] = 0.0f; lbt[2048 + e] = 1.0f / (1.0f + expf(l0 - l1)); }
        }
        for (int m = gw; m < T; m += NGW) {
            const GAS f32x4* xr = (const GAS f32x4*)(x_in + (size_t)m * DM) + lanel; f32x4 v[4]; float s = 0.f;
#pragma unroll
            for (int j = 0; j < 4; ++j) { v[j] = xr[64 * j]; s += (v[j].x * v[j].x + v[j].y * v[j].y) + (v[j].z * v[j].z + v[j].w * v[j].w); }
            s = wave_sum(s);
            GAS unsigned long long* o8 = (GAS unsigned long long*)(xb + (size_t)m * DM) + lanel;
#pragma unroll
            for (int j = 0; j < 4; ++j) o8[64 * j] = (unsigned long long)pk2(v[j].x, v[j].y) | ((unsigned long long)pk2(v[j].z, v[j].w) << 32);
            if (lanel < 16) ssq[(size_t)m * 16 + lanel] = (lanel == 0) ? s : 0.0f;
        }
    }
    SEAM(0);

#pragma unroll 1
    for (int layer = 0; layer < 4; ++layer) {
        const int j = layer >> 1; const bool even = (layer & 1) == 0;
        const int pb = 1 + (layer >> 1) * 9 + (even ? 0 : 6);
        if (even) {
            const float lam_init = (j == 0) ? 0.2f : 0.470713018f;
            if (INK(1, pb + 0)) {
        PTRS();
                pg8::Gemm g{xb, wte, T, 4096, DM, DM, 1 << 30, 0l}; pg8::StaticOrder S; S.init(T, 4096, F.G, (int)blockIdx.x);
                pg8::EpiIn<true> E{ssq, rope, lbt + j * 2048, R0, R1, R2, R3, R4, R5, 0};
                if (DUP(1)) { pg8::EpiDry ED; pg8::gemm_phase(F.lds, g, S, ED); }
                if (DUPR(1)) { pg8::EpiIn<true, DUPR_MODE> E2{ssq, rope, lbt + j * 2048, R0, R1, R2, R3, R4, R5, 0}; pg8::gemm_phase(F.lds, g, S, E2); }
                if (STAG_EVEN) stagger(F.vcu, STAG_EVEN);
                pg8::gemm_phase(F.lds, g, S, E);
            }
            SEAM(pb + 0);
            if (INK(2, pb + 1)) {
        PTRS();
                if (layer == 2) { convert_layer(F, args.in[9] + (size_t)DM * ODD_IN, args.in[8] + DM, ODD_IN, args.in[11] + (size_t)DIN * DM, wto); __syncthreads(); }
                const float* lq = args.in[3] + j * 256; float s1 = 0.f, s2 = 0.f;
                for (int i = 0; i < 64; ++i) { s1 += lq[i] * lq[64 + i]; s2 += lq[128 + i] * lq[192 + i]; }
                const float lam = expf(s1) - expf(s2) + lam_init;
                if (DUP(2)) for (int i = 0; i < 4; ++i) { const int bh = (F.vcu >> 5) * 4 + i, qb = F.vcu & 31;
                    att::diff_attn_unit<true, DUPR_MODE>(bh >> 3, bh & 7, qb, (const att::u16*)R0, (const att::u16*)R1, (const att::u16*)R2, (const att::u16*)R3, (att::u16*)R0,
                                        args.in[4] + j * 128, lam, 1.0f - lam_init, (char*)lds); }
                for (int i = 0; i < 4; ++i) { const int bh = (F.vcu >> 5) * 4 + i, qb = F.vcu & 31;
                    att::diff_attn_unit<false>(bh >> 3, bh & 7, qb, (const att::u16*)R0, (const att::u16*)R1, (const att::u16*)R2, (const att::u16*)R3, (att::u16*)R0,
                                        args.in[4] + j * 128, lam, 1.0f - lam_init, (char*)lds); }
            }
            SEAM(pb + 1);
            if (INK(1, pb + 2)) {
        PTRS();
                pg8::Gemm g{xb, wte + (size_t)4096 * DM, T, 5120, DM, DM, 1 << 30, 0l}; pg8::StaticOrder S; S.init(T, 5120, F.G, (int)blockIdx.x);
                pg8::EpiIn<true> E{ssq, rope, lbt + j * 2048, R0, R1, R2, R3, R4, R5, 16};
                if (DUP(1)) { pg8::EpiDry ED; pg8::gemm_phase(F.lds, g, S, ED); }
                if (DUPR(1)) { pg8::EpiIn<true, DUPR_MODE> E2{ssq, rope, lbt + j * 2048, R0, R1, R2, R3, R4, R5, 16}; pg8::gemm_phase(F.lds, g, S, E2); }
                if (STAG_EVEN) stagger(F.vcu, STAG_EVEN);
                pg8::gemm_phase(F.lds, g, S, E);
            }
            SEAM(pb + 2);
            if (INK(3, pb + 3)) {
        PTRS();
                if (DUP(3)) for (int it = F.vcu; it < 512; it += F.G) hg::hgrn_pass1(it, (const att::u16*)R2, (const att::u16*)R4, (const att::u16*)R5, ust, dstv, (char*)lds);
                for (int it = F.vcu; it < 512; it += F.G) hg::hgrn_pass1(it, (const att::u16*)R2, (const att::u16*)R4, (const att::u16*)R5, ust, dstv, (char*)lds);
            }
            SEAM(pb + 3);
            if (INK(4, pb + 4)) {
        PTRS();
                if (DUP(4)) for (int it = F.vcu; it < 256; it += F.G) hg::hgrn_pass2<true, DUPR_MODE>(it, (const att::u16*)R1, (const att::u16*)R2, (const att::u16*)R4, (const att::u16*)R5, (const att::u16*)R3,
                                                                        (att::u16*)R4, (att::u16*)R1, ust, dstv, args.in[5] + j * 128, (char*)lds);
                for (int it = F.vcu; it < 256; it += F.G) hg::hgrn_pass2<false>(it, (const att::u16*)R1, (const att::u16*)R2, (const att::u16*)R4, (const att::u16*)R5, (const att::u16*)R3,
                                                                        (att::u16*)R4, (att::u16*)R1, ust, dstv, args.in[5] + j * 128, (char*)lds);
            }
            SEAM(pb + 4);
            if (INK(5, pb + 5)) {
        PTRS();
                pg8::Gemm g{(const bf16*)R0, wte + (size_t)EVEN_IN * DM, T, DM, DIN, DM, 16, (long)RSZ - 2048l}; pg8::StaticOrder S; S.init(T, DM, F.G, (int)blockIdx.x);
                if (DUP(5)) { pg8::EpiDry ED; pg8::gemm_phase(F.lds, g, S, ED); }
                if (layer == 0) { pg8::EpiOut<true, false> E{x_in, xres, xb, ssq}; pg8::gemm_phase(F.lds, g, S, E); }
                else            { pg8::EpiOut<false, false> E{x_in, xres, xb, ssq}; pg8::gemm_phase(F.lds, g, S, E); }
            }
            SEAM(pb + 5);
        } else {
            if (INK(6, pb + 0)) {
        PTRS();
                pg8::Gemm g{xb, wto, T, ODD_IN, DM, DM, 1 << 30, 0l}; pg8::StaticOrder S; S.init(T, ODD_IN, F.G, (int)blockIdx.x);
                pg8::EpiIn<false> E{ssq, rope, nullptr, R0, R1, R2, R3, R4, R5, 0};
                if (DUP(6)) { pg8::EpiDry ED; pg8::gemm_phase(F.lds, g, S, ED); }
                if (DUPR(6)) pg8::gemm_phase(F.lds, g, S, E);
                if (STAG_ODD) stagger(F.vcu, STAG_ODD);
                pg8::gemm_phase(F.lds, g, S, E);
            }
            SEAM(pb + 0);
            if (INK(7, pb + 1)) {
        PTRS();
                if (layer == 1) { convert_layer(F, args.in[2] + (size_t)DM * EVEN_IN, args.in[1] + DM, EVEN_IN, args.in[7] + (size_t)DIN * DM, wte); __syncthreads(); }
                if (DUP(7)) att::swa_phase<true>(2 * F.vcu, (const att::u16*)R0, (const att::u16*)R2, (const att::u16*)(R2 + (size_t)T * 256 * 2), (const att::u16*)R3, (att::u16*)R0, args.in[10] + j * 32, (char*)lds);
                att::swa_phase<false>(2 * F.vcu, (const att::u16*)R0, (const att::u16*)R2, (const att::u16*)(R2 + (size_t)T * 256 * 2), (const att::u16*)R3, (att::u16*)R0, args.in[10] + j * 32, (char*)lds);
            }
            SEAM(pb + 1);
            if (INK(5, pb + 2)) {
        PTRS();
                pg8::Gemm g{(const bf16*)R0, wto + (size_t)ODD_IN * DM, T, DM, DIN, DIN, 1 << 30, 0l}; pg8::StaticOrder S; S.init(T, DM, F.G, (int)blockIdx.x);
                if (DUP(5)) { pg8::EpiDry ED; pg8::gemm_phase(F.lds, g, S, ED); }
                if (layer == 3) { pg8::EpiOut<false, true> E{x_in, xres, xb, ssq}; pg8::gemm_phase(F.lds, g, S, E); }
                else            { pg8::EpiOut<false, false> E{x_in, xres, xb, ssq}; pg8::gemm_phase(F.lds, g, S, E); }
            }
            SEAM(pb + 2);
        }
    }
    if (INK(8, 19)) {
        PTRS();
        const float* fw = args.in[12];
        for (int m = gw; m < T; m += NGW) {
            GAS f32x4* xr = (GAS f32x4*)(xres + (size_t)m * DM) + lanel; f32x4 v[4]; float s = 0.f;
#pragma unroll
            for (int jj = 0; jj < 4; ++jj) { v[jj] = xr[64 * jj]; s += (v[jj].x * v[jj].x + v[jj].y * v[jj].y) + (v[jj].z * v[jj].z + v[jj].w * v[jj].w); }
            s = wave_sum(s); const float rs = 1.0f / sqrtf(s * (1.0f / DM) + EPS);
#pragma unroll
            for (int jj = 0; jj < 4; ++jj) { const f32x4 w = *((const f32x4*)fw + lanel + 64 * jj); xr[64 * jj] = v[jj] * rs * w; }
        }
    }
#undef IN
#undef INK
#undef SEAM
}

extern "C" void kernel_launch(void* const* d_in, const int* in_sizes, int n_in, void* d_out, int out_size, void* d_ws, size_t ws_size, hipStream_t stream) {
    static int ok = 0;
    if (ok == 0) {
        if (n_in != 13 || in_sizes[0] != T * DM || out_size != T * DM || ws_size < WS_END) { fprintf(stderr, "kernel_launch: shape/workspace mismatch (n_in %d, ws %zu, need %zu)\n", n_in, ws_size, (size_t)WS_END); ok = -1; return; }
        if (hipFuncSetAttribute((const void*)mk_fwd, hipFuncAttributeMaxDynamicSharedMemorySize, LDS_BYTES) != hipSuccess) { fprintf(stderr, "kernel_launch: hipFuncSetAttribute failed\n"); ok = -1; return; }
        int per_cu = 0;
        if (hipOccupancyMaxActiveBlocksPerMultiprocessor(&per_cu, (const void*)mk_fwd, NWAVES * 64, LDS_BYTES) != hipSuccess || per_cu < 1) fprintf(stderr, "kernel_launch: occupancy query reports %d\n", per_cu);
        (void)hipGetLastError();
        ok = 1;
    }
    if (ok < 0) return;
    (void)hipMemsetAsync((char*)d_ws + WS_CTL, 0, CTL_ZERO_BYTES, stream);
    Args a{};
    for (int i = 0; i < 13; ++i) a.in[i] = (const float*)d_in[i];
    a.out = (float*)d_out; a.ws = (unsigned char*)d_ws;
#if MK_PER_PHASE
    for (int p = 0; p < NPH; ++p) { a.ph_lo = p; a.ph_hi = p + 1; hipLaunchKernelGGL(mk_fwd, dim3(GRID), dim3(NWAVES * 64), LDS_BYTES, stream, a); }
#else
    a.ph_lo = 0; a.ph_hi = NPH;
    hipLaunchKernelGGL(mk_fwd, dim3(GRID), dim3(NWAVES * 64), LDS_BYTES, stream, a);
#endif
    const hipError_t le = hipPeekAtLastError();
    if (le != hipSuccess) fprintf(stderr, "kernel_launch: launch failed: %s\n", hipGetErrorName(le));
}
```

```cpp
#define DUP_MASK 0
#define DUPR_MASK 0
#define STAG_EVEN 0
#define STAG_ODD 0
#define DUPR_MODE 0
#include <hip/hip_runtime.h>
#include <hip/hip_bf16.h>
#include <cstdio>
#include <cstdint>

constexpr int NB = 4, SEQ = 4096, DM = 1024, T = NB * SEQ;
constexpr int EVEN_IN = 9216, ODD_IN = 4608, DIN = 2048;
constexpr float EPS = 1e-6f;
constexpr float C2 = 0.125f * 1.4426950408889634f;
constexpr float LOG2E = 1.4426950408889634f;

namespace pg8 {
#define PG8_LAS __attribute__((address_space(3)))
typedef unsigned short bf16_t;
typedef short bf16x8 __attribute__((ext_vector_type(8)));
typedef float f32x4 __attribute__((ext_vector_type(4)));
typedef unsigned u32x4 __attribute__((ext_vector_type(4)));
constexpr int BM = 256, BK = 64, HALF = 128, HTB = HALF * BK * 2, STAGE_BYTES = 8 * HTB, NXCD = 8, WGM = 8;
constexpr int EPI_STG_OFF = 139264, EPI_STG_RS = 144, EPI_STG_WAVE = 16 * EPI_STG_RS;

__host__ __device__ __forceinline__ int lds_byte(int r, int c) { const int st = (r >> 4) * 2 + (c >> 5), rr = r & 15, cc = c & 31, ob = rr * 64 + cc * 2; return st * 1024 + (ob ^ (((ob >> 9) & 1) << 5)); }
__host__ __device__ __forceinline__ void stage_rc(int b, int& R, int& C) { const int st = b / 1024, sb = b % 1024, swz = sb ^ (((sb >> 9) & 1) << 5); R = (st >> 1) * 16 + swz / 64; C = (st & 1) * 32 + (swz % 64) / 2; }
__host__ __device__ __forceinline__ int perm32(int rho) { const int n = rho >> 4, i = rho & 15; return 8 * (i >> 2) + 4 * n + (i & 3); }

struct Unit { int pm, pn; };
struct Gemm { const bf16_t* A; const bf16_t* Bt; int M, N, K, lda, ksplit; long jump; };

struct StaticOrder {
    int nM, nN, nwg, G, c;
    __host__ __device__ void init(int M, int N, int G_, int c_) { nM = M / BM; nN = N / BM; nwg = nM * nN; G = G_; c = c_; }
    __host__ __device__ bool next(int i, Unit& u) const {
        const long L = (long)i * G + c; if (L >= nwg) return false;
        int wgid = (int)L; { const int q = nwg / NXCD, r = nwg % NXCD, xcd = wgid % NXCD, off = wgid / NXCD; wgid = (xcd < r ? xcd * (q + 1) : r * (q + 1) + (xcd - r) * q) + off; }
        const int nig = WGM * nN, gid = wgid / nig, fm = gid * WGM, gsz = (nM - fm) < WGM ? (nM - fm) : WGM;
        u.pm = fm + ((wgid % nig) % gsz); u.pn = (wgid % nig) / gsz; return true;
    }
};

__device__ __forceinline__ unsigned cvt_pk_bf16(float lo, float hi) { unsigned r; asm volatile("v_cvt_pk_bf16_f32 %0, %1, %2" : "=v"(r) : "v"(lo), "v"(hi)); return r; }

template <class Epi>
__device__ __forceinline__ void gemm_phase(PG8_LAS unsigned char* lds, const Gemm g, const StaticOrder& S, const Epi& E) {
    int tid = threadIdx.x; asm volatile("" : "+v"(tid));
    const int wid = __builtin_amdgcn_readfirstlane(tid >> 6), lane = tid & 63, wr = wid >> 2, wc = wid & 3, fr = lane & 15, fq = lane >> 4;
    const int K = g.K, nt = K / BK, lda = g.lda;
    unsigned voffA[2], voffB[2];
#pragma unroll
    for (int i = 0; i < 2; ++i) { int R, C; stage_rc(tid * 16 + i * 8192, R, C); const int Rb = 64 * (R >> 5) + perm32(R & 31);
        voffA[i] = (unsigned)(R * lda + C) * 2u; voffB[i] = (unsigned)(Rb * K + C) * 2u; }
    const size_t kstep = (size_t)(BK * 2);
    const size_t hstepA = (size_t)HALF * lda * 2, tstepA = 2 * hstepA;
    const size_t hstepB = (size_t)32 * K * 2, tstepB = (size_t)BM * K * 2;
    const unsigned ldsw = (unsigned)wid * 1024u;
    const int aoff = lds_byte(wr * 64 + fr, fq * 8), boff = lds_byte(wc * 32 + fr, fq * 8);
    const int ksplit = g.ksplit; const long jump = g.jump;
#define PG8_AP(base, t) ((base) + (size_t)(t) * kstep + (((t) >= ksplit) ? jump : 0l))
#define PG8_SA(b, h) (((b) * 2 + (h)) * HTB)
#define PG8_SB(b, h) ((4 + (b) * 2 + (h)) * HTB)
#define PG8_STAGE(bufoff, gbase, voff) do { _Pragma("unroll") for (int _i = 0; _i < 2; ++_i) \
        __builtin_amdgcn_global_load_lds((const unsigned*)((const char*)(gbase) + (voff)[_i]), (PG8_LAS unsigned*)(lds + (bufoff) + ldsw + _i * 8192), 16, 0, 0); } while (0)
#define PG8_LDA(dst, b, h) do { _Pragma("unroll") for (int m = 0; m < 4; ++m) _Pragma("unroll") for (int k = 0; k < 2; ++k) dst[m][k] = *(const PG8_LAS bf16x8*)(lds + PG8_SA(b, h) + aoff + m * 2048 + k * 1024); } while (0)
#define PG8_LDB(dst, b, h) do { _Pragma("unroll") for (int n = 0; n < 2; ++n) _Pragma("unroll") for (int k = 0; k < 2; ++k) dst[n][k] = *(const PG8_LAS bf16x8*)(lds + PG8_SB(b, h) + boff + n * 2048 + k * 1024); } while (0)
#define PG8_MMA(ai, bj, At, Bt) do { __builtin_amdgcn_s_setprio(1); _Pragma("unroll") for (int m = 0; m < 4; ++m) _Pragma("unroll") for (int n = 0; n < 2; ++n) _Pragma("unroll") for (int k = 0; k < 2; ++k) \
        acc[ai][bj][m][n] = __builtin_amdgcn_mfma_f32_16x16x32_bf16(Bt[n][k], At[m][k], acc[ai][bj][m][n], 0, 0, 0); __builtin_amdgcn_s_setprio(0); } while (0)
#define PG8_WAIT_V(n) asm volatile("s_waitcnt vmcnt(" #n ")" ::: "memory")
#define PG8_WAIT_L(n) asm volatile("s_waitcnt lgkmcnt(" #n ")" ::: "memory")
#define PG8_BAR __builtin_amdgcn_s_barrier()
#define PG8_SCHED __builtin_amdgcn_sched_barrier(0)
    Unit cur, nxt; int ui = 0;
    if (!S.next(0, cur)) return;
    f32x4 acc[2][2][4][2];
#pragma unroll
    for (int a = 0; a < 2; ++a)
#pragma unroll
        for (int b = 0; b < 2; ++b)
#pragma unroll
            for (int m = 0; m < 4; ++m)
#pragma unroll
                for (int n = 0; n < 2; ++n) acc[a][b][m][n] = (f32x4){0.f, 0.f, 0.f, 0.f};
    bf16x8 At[4][2], B0[2][2], B1[2][2];
    const char* cA = (const char*)g.A + (size_t)cur.pm * tstepA; const char* cB = (const char*)g.Bt + (size_t)cur.pn * tstepB;
    {
        PG8_STAGE(PG8_SB(0, 0), cB, voffB); PG8_STAGE(PG8_SB(0, 1), cB + hstepB, voffB); PG8_STAGE(PG8_SA(0, 0), cA, voffA); PG8_STAGE(PG8_SA(0, 1), cA + hstepA, voffA);
        if (wr == 1) PG8_BAR;
        PG8_WAIT_V(2); PG8_BAR;
        PG8_STAGE(PG8_SB(1, 0), cB + kstep, voffB); PG8_STAGE(PG8_SA(1, 0), PG8_AP(cA, 1), voffA); PG8_STAGE(PG8_SB(1, 1), cB + hstepB + kstep, voffB);
        PG8_WAIT_V(6); PG8_BAR;
    }
    for (;;) {
        const bool has_next = S.next(ui + 1, nxt);
        const char* nA = has_next ? (const char*)g.A + (size_t)nxt.pm * tstepA : cA; const char* nB = has_next ? (const char*)g.Bt + (size_t)nxt.pn * tstepB : cB;
        for (int t = 0; t < nt; t += 2) {
            const bool last = (t == nt - 2);
            const char* a1 = PG8_AP(cA, t + 1);
            const char* a2 = last ? nA : PG8_AP(cA, t + 2); const char* b2 = last ? nB : cB + (size_t)(t + 2) * kstep;
            const char* a3 = a2 + kstep; const char* b3 = b2 + kstep;
            PG8_LDB(B0, 0, 0); PG8_LDB(B1, 0, 1); PG8_SCHED; PG8_LDA(At, 0, 0); PG8_STAGE(PG8_SA(1, 1), a1 + hstepA, voffA);
            PG8_WAIT_V(8); PG8_WAIT_L(0); PG8_BAR; PG8_MMA(0, 0, At, B0); PG8_MMA(0, 1, At, B1); PG8_BAR; PG8_SCHED;
            PG8_LDA(At, 0, 1); PG8_STAGE(PG8_SB(0, 0), b2, voffB); PG8_STAGE(PG8_SB(0, 1), b2 + hstepB, voffB); PG8_STAGE(PG8_SA(0, 0), a2, voffA);
            PG8_WAIT_V(8); PG8_WAIT_L(0); PG8_BAR; PG8_MMA(1, 0, At, B0); PG8_MMA(1, 1, At, B1); PG8_BAR; PG8_SCHED;
            PG8_LDB(B0, 1, 0); PG8_LDB(B1, 1, 1); PG8_SCHED; PG8_LDA(At, 1, 0); PG8_STAGE(PG8_SA(0, 1), a2 + hstepA, voffA);
            PG8_WAIT_V(8); PG8_WAIT_L(0); PG8_BAR; PG8_MMA(0, 0, At, B0); PG8_MMA(0, 1, At, B1); PG8_BAR; PG8_SCHED;
            PG8_LDA(At, 1, 1); PG8_STAGE(PG8_SB(1, 0), b3, voffB); PG8_STAGE(PG8_SB(1, 1), b3 + hstepB, voffB); PG8_STAGE(PG8_SA(1, 0), a3, voffA);
            PG8_WAIT_V(8); PG8_WAIT_L(0); PG8_BAR; PG8_MMA(1, 0, At, B0); PG8_MMA(1, 1, At, B1); PG8_BAR; PG8_SCHED;
        }
        if (wr == 0) PG8_BAR;
        E(acc, cur, wr, wc, fr, fq, lds + EPI_STG_OFF + wid * EPI_STG_WAVE, lane);
        if (!has_next) break;
#pragma unroll
        for (int a = 0; a < 2; ++a)
#pragma unroll
            for (int b = 0; b < 2; ++b)
#pragma unroll
                for (int m = 0; m < 4; ++m)
#pragma unroll
                    for (int n = 0; n < 2; ++n) acc[a][b][m][n] = (f32x4){0.f, 0.f, 0.f, 0.f};
        cur = nxt; cA = nA; cB = nB; ++ui;
        if (wr == 1) PG8_BAR;
    }
    PG8_WAIT_V(0);
    PG8_BAR;
#undef PG8_AP
#undef PG8_SA
#undef PG8_SB
#undef PG8_STAGE
#undef PG8_LDA
#undef PG8_LDB
#undef PG8_MMA
#undef PG8_WAIT_V
#undef PG8_WAIT_L
#undef PG8_BAR
#undef PG8_SCHED
}
}
namespace pg8 {
typedef unsigned short u16;
__device__ __forceinline__ float fsigmoid(float v) { return __builtin_amdgcn_rcpf(1.0f + __expf(-v)); }
__device__ __forceinline__ unsigned pk_f16(float lo, float hi) { _Float16 a = (_Float16)lo, b = (_Float16)hi; return (unsigned)__builtin_bit_cast(unsigned short, a) | ((unsigned)__builtin_bit_cast(unsigned short, b) << 16); }


__device__ __forceinline__ void store_rows128(PG8_LAS unsigned char* stg, u16* blk  , size_t pitch, u32x4 w0, u32x4 w1, int fr, int fq, int lane) {
    *(PG8_LAS u32x4*)(stg + fr * EPI_STG_RS + fq * 16) = w0; *(PG8_LAS u32x4*)(stg + fr * EPI_STG_RS + 64 + fq * 16) = w1;
    const int rr = lane >> 3, ch = lane & 7;
    const u32x4 a = *(const PG8_LAS u32x4*)(stg + rr * EPI_STG_RS + ch * 16), b = *(const PG8_LAS u32x4*)(stg + (8 + rr) * EPI_STG_RS + ch * 16);
    *(u32x4*)(blk + (size_t)rr * pitch + ch * 8) = a; *(u32x4*)(blk + (size_t)(8 + rr) * pitch + ch * 8) = b;
}

enum { K_PLAIN = 0, K_SILU = 1, K_ROPEQ = 2, K_ROPEK = 3, K_LOGF = 4 };

template <bool EVEN, int MODE = 0> struct EpiIn {
    static constexpr bool PERM = true;
    const float* ssq;
    const float* rope;
    const float* lb;
    unsigned char* r0; unsigned char* r1; unsigned char* r2; unsigned char* r3; unsigned char* r4; unsigned char* r5;
    int pn_off;
    __device__ __forceinline__ void operator()(const f32x4 (&acc)[2][2][4][2], const Unit& u, int wr, int wc, int fr, int fq, PG8_LAS unsigned char* stg, int lane) const {
        const int gpn = u.pn + pn_off;
        int kind, pitch, colt, dir = 0; u16* outp;
        if (EVEN) {
            const int grp = gpn >> 2; colt = (gpn & 3) * 256; pitch = 1024;
            switch (grp) {
                case 0: kind = K_ROPEQ; outp = (u16*)r0; break;
                case 1: kind = K_ROPEK; outp = (u16*)r1; break;
                case 2: kind = K_PLAIN; outp = (u16*)r2; break;
                case 3: kind = K_SILU;  outp = (u16*)r3; break;
                case 4: kind = K_SILU;  outp = (u16*)r1; break;
                case 5: kind = K_LOGF;  outp = (u16*)r4; dir = 0; break;
                case 6: kind = K_LOGF;  outp = (u16*)r5; dir = 1; break;
                case 7: kind = K_PLAIN; outp = (u16*)r2; break;
                default: kind = K_SILU; outp = (u16*)r3; break;
            }
        } else {
            if (gpn < 8)       { kind = K_ROPEQ; outp = (u16*)r0; pitch = 2048; colt = gpn * 256; }
            else if (gpn == 8) { kind = K_ROPEK; outp = (u16*)r2; pitch = 256;  colt = 0; }
            else if (gpn == 9) { kind = K_PLAIN; outp = (u16*)(r2 + (size_t)T * 256 * 2); pitch = 256; colt = 0; }
            else               { kind = K_SILU;  outp = (u16*)r3; pitch = 2048; colt = (gpn - 10) * 256; }
        }
        int row0 = u.pm * BM + wr * 64 + fr; asm volatile("" : "+v"(row0));
        if (MODE == 2) kind = K_PLAIN;
        float rsv[8];
#pragma unroll
        for (int hb = 0; hb < 2; ++hb) { f32x4 sq[4];
#pragma unroll
          for (int i = 0; i < 4; ++i) sq[i] = *((const f32x4*)(ssq + (size_t)(row0 + hb * HALF + i * 16) * 16) + fq);
#pragma unroll
          for (int i = 0; i < 4; ++i) { float tot = (sq[i][0] + sq[i][1]) + (sq[i][2] + sq[i][3]); tot += __shfl_xor(tot, 16); tot += __shfl_xor(tot, 32); rsv[hb * 4 + i] = __builtin_amdgcn_rsqf(tot * (1.0f / DM) + EPS); }
          asm volatile("" ::: "memory"); }
        u16* const blk0 = outp + (size_t)(row0 - fr) * pitch + colt + wc * 64;
        if (kind == K_LOGF)        rows<K_LOGF>(acc, rsv, blk0, pitch, colt + wc * 64, dir, row0, 1.0f, fr, fq, stg, lane);
        else if (kind == K_SILU)   rows<K_SILU>(acc, rsv, blk0, pitch, 0, 0, row0, 1.0f, fr, fq, stg, lane);
        else if (kind == K_PLAIN)  rows<K_PLAIN>(acc, rsv, blk0, pitch, 0, 0, row0, 1.0f, fr, fq, stg, lane);
        else                       rows<K_ROPEQ>(acc, rsv, blk0, pitch, 0, 0, row0, (kind == K_ROPEQ) ? C2 : 1.0f, fr, fq, stg, lane);
    }
    template <int KIND>
    __device__ __forceinline__ void rows(const f32x4 (&acc)[2][2][4][2], const float (&rsv)[8], u16* blk0, int pitch, int ccol, int dir, int row0, float qs, int fr, int fq, PG8_LAS unsigned char* stg, int lane) const {
        f32x4 lbv[2][2];
        if (KIND == K_LOGF) {
#pragma unroll
            for (int bj = 0; bj < 2; ++bj) { const int c0 = ccol + bj * 32 + 8 * fq; lbv[bj][0] = *(const f32x4*)(lb + dir * 1024 + c0); lbv[bj][1] = *(const f32x4*)(lb + dir * 1024 + c0 + 4); }
        }
        f32x4 cs0, cs1, sn0, sn1, ncs0, ncs1, nsn0, nsn1;
        if (KIND == K_ROPEQ) { const int pos = row0 & (SEQ - 1); const f32x4* cp = (const f32x4*)(rope + (size_t)pos * 8); const f32x4* spn = (const f32x4*)(rope + (size_t)SEQ * 8 + (size_t)pos * 8);
            ncs0 = cp[0]; ncs1 = cp[1]; nsn0 = spn[0]; nsn1 = spn[1]; }
#pragma unroll
        for (int ai = 0; ai < 2; ++ai)
#pragma unroll
            for (int m = 0; m < 4; ++m) {
                const float rs = rsv[ai * 4 + m];
                if (KIND == K_ROPEQ) { cs0 = ncs0; cs1 = ncs1; sn0 = nsn0; sn1 = nsn1;
                    if (ai * 4 + m < 7) { const int i2 = ai * 4 + m + 1; const int pos = (row0 + (i2 >> 2) * HALF + (i2 & 3) * 16) & (SEQ - 1);
                        const f32x4* cp = (const f32x4*)(rope + (size_t)pos * 8); const f32x4* spn = (const f32x4*)(rope + (size_t)SEQ * 8 + (size_t)pos * 8);
                        ncs0 = cp[0]; ncs1 = cp[1]; nsn0 = spn[0]; nsn1 = spn[1]; } }
                u32x4 wst[2];
#pragma unroll
                for (int bj = 0; bj < 2; ++bj) {
                    f32x4 v0 = acc[ai][bj][m][0] * rs, v1 = acc[ai][bj][m][1] * rs;
                    u32x4 w;
                    if (KIND == K_LOGF) {
                        const f32x4 l0 = lbv[bj][0], l1 = lbv[bj][1];
                        float o[8];
#pragma unroll
                        for (int e = 0; e < 4; ++e) { const float f0 = l0[e] + (1.0f - l0[e]) * fsigmoid(v0[e]), f1 = l1[e] + (1.0f - l1[e]) * fsigmoid(v1[e]);
                            o[e] = fmaxf(__builtin_amdgcn_logf(f0) * 0.6931471805599453f, -30.0f); o[4 + e] = fmaxf(__builtin_amdgcn_logf(f1) * 0.6931471805599453f, -30.0f); }
                        w.x = pk_f16(o[0], o[1]); w.y = pk_f16(o[2], o[3]); w.z = pk_f16(o[4], o[5]); w.w = pk_f16(o[6], o[7]);
                    } else {
                        if (KIND == K_SILU) {
#pragma unroll
                            for (int e = 0; e < 4; ++e) { v0[e] = v0[e] * fsigmoid(v0[e]); v1[e] = v1[e] * fsigmoid(v1[e]); }
                        } else if (KIND == K_ROPEQ && bj == 0) {
                            f32x4 o0, o1;
#pragma unroll
                            for (int e = 0; e < 4; ++e) { o0[e] = __shfl_xor(v0[e], 16); o1[e] = __shfl_xor(v1[e], 16); }
                            if (fq < 2) {
                                const float sg = (fq == 0) ? -1.0f : 1.0f;
                                v0 = v0 * cs0 + (o0 * sn0) * sg; v1 = v1 * cs1 + (o1 * sn1) * sg;
                            }
                        }
                        if (KIND == K_ROPEQ) { v0 = v0 * qs; v1 = v1 * qs; }
                        w.x = cvt_pk_bf16(v0[0], v0[1]); w.y = cvt_pk_bf16(v0[2], v0[3]); w.z = cvt_pk_bf16(v1[0], v1[1]); w.w = cvt_pk_bf16(v1[2], v1[3]);
                    }
                    wst[bj] = w;
                }
                if (MODE != 1) store_rows128(stg, blk0 + (size_t)(ai * HALF + m * 16) * pitch, (size_t)pitch, wst[0], wst[1], fr, fq, lane); else asm volatile("" :: "v"(wst[0]), "v"(wst[1]));
            }
    }
};

__device__ __forceinline__ float bf_lo(unsigned w) { return __uint_as_float(w << 16); }
__device__ __forceinline__ float bf_hi(unsigned w) { return __uint_as_float(w & 0xffff0000u); }
template <bool FIRST, bool LAST> struct EpiOut {
    static constexpr bool PERM = true;
    const float* xin; float* xout; u16* xb; float* ssq;
    __device__ __forceinline__ void operator()(const f32x4 (&acc)[2][2][4][2], const Unit& u, int wr, int wc, int fr, int fq, PG8_LAS unsigned char* stg, int lane) const {
        int row0 = u.pm * BM + wr * 64 + fr; asm volatile("" : "+v"(row0));
        const int cb = u.pn * BM + wc * 64 + 8 * fq;
        f32x4 nx[2][2];
#define LOADX(dst, rw) do { _Pragma("unroll") for (int bj = 0; bj < 2; ++bj) { const size_t off = (size_t)(rw) * DM + cb + bj * 32; \
            if (FIRST) { dst[bj][0] = *(const f32x4*)(xin + off); dst[bj][1] = *(const f32x4*)(xin + off + 4); } \
            else { const u32x4 w = *(const u32x4*)(xb + off); dst[bj][0] = (f32x4){bf_lo(w.x), bf_hi(w.x), bf_lo(w.y), bf_hi(w.y)}; dst[bj][1] = (f32x4){bf_lo(w.z), bf_hi(w.z), bf_lo(w.w), bf_hi(w.w)}; } } } while (0)
        LOADX(nx, row0);
#pragma unroll
        for (int ai = 0; ai < 2; ++ai)
#pragma unroll
            for (int m = 0; m < 4; ++m) {
                const int row = row0 + ai * HALF + m * 16; float part = 0.f; u32x4 wst[2];
                f32x4 ox[2][2];
#pragma unroll
                for (int bj = 0; bj < 2; ++bj) { ox[bj][0] = nx[bj][0]; ox[bj][1] = nx[bj][1]; }
                if (ai * 4 + m < 7) { const int i2 = ai * 4 + m + 1; LOADX(nx, row0 + (i2 >> 2) * HALF + (i2 & 3) * 16); }
#pragma unroll
                for (int bj = 0; bj < 2; ++bj) {
                    const size_t off = (size_t)row * DM + cb + bj * 32;
                    const f32x4 n0 = ox[bj][0] + acc[ai][bj][m][0], n1 = ox[bj][1] + acc[ai][bj][m][1];
                    if (LAST) { *(f32x4*)(xout + off) = n0; *(f32x4*)(xout + off + 4) = n1; }
                    else {
                        u32x4 w; w.x = cvt_pk_bf16(n0[0], n0[1]); w.y = cvt_pk_bf16(n0[2], n0[3]); w.z = cvt_pk_bf16(n1[0], n1[1]); w.w = cvt_pk_bf16(n1[2], n1[3]);
                        wst[bj] = w;
                        const f32x4 r0 = (f32x4){bf_lo(w.x), bf_hi(w.x), bf_lo(w.y), bf_hi(w.y)}, r1 = (f32x4){bf_lo(w.z), bf_hi(w.z), bf_lo(w.w), bf_hi(w.w)};
                        part += (r0[0] * r0[0] + r0[1] * r0[1]) + (r0[2] * r0[2] + r0[3] * r0[3]) + (r1[0] * r1[0] + r1[1] * r1[1]) + (r1[2] * r1[2] + r1[3] * r1[3]);
                    }
                }
                if (!LAST) { part += __shfl_xor(part, 16); part += __shfl_xor(part, 32);
                    if (fq == 0) ssq[(size_t)row * 16 + u.pn * 4 + wc] = part;
                    store_rows128(stg, xb + (size_t)(row - fr) * DM + u.pn * BM + wc * 64, (size_t)DM, wst[0], wst[1], fr, fq, lane); }
            }
#undef LOADX
    }
};
struct EpiDry {
    static constexpr bool PERM = true;
    __device__ __forceinline__ void operator()(const f32x4 (&acc)[2][2][4][2], const Unit&, int, int, int, int, PG8_LAS unsigned char*, int) const {
#pragma unroll
        for (int a = 0; a < 2; ++a)
#pragma unroll
            for (int b = 0; b < 2; ++b)
#pragma unroll
                for (int m = 0; m < 4; ++m) asm volatile("" :: "v"(acc[a][b][m][0]), "v"(acc[a][b][m][1]));
    }
};
}
namespace att {
typedef unsigned short u16;
using bf16x8 = __attribute__((ext_vector_type(8))) short;
using s16x4  = __attribute__((ext_vector_type(4))) short;
using f32x16 = __attribute__((ext_vector_type(16))) float;
using f32x4  = __attribute__((ext_vector_type(4))) float;
using u32x4  = __attribute__((ext_vector_type(4))) unsigned;
#define KSWZ(row, colB) ((row) * 256 + ((colB) ^ (((row) & 7) << 4)))
#define KSWZ128(row, colB) ((row) * 128 + ((colB) ^ (((row) & 7) << 4)))
#define SBAR() __builtin_amdgcn_sched_barrier(0)
constexpr float THRL = 8.0f;
__device__ __forceinline__ int crow(int r, int hi) { return (r & 3) + 8 * (r >> 2) + 4 * hi; }
__device__ __forceinline__ unsigned cvtpk(float lo, float hi) { unsigned r; asm volatile("v_cvt_pk_bf16_f32 %0, %1, %2" : "=v"(r) : "v"(lo), "v"(hi)); return r; }
__device__ __forceinline__ bf16x8 ld8(const u16* p) { return *reinterpret_cast<const bf16x8*>(p); }
__device__ __forceinline__ float bf2f(unsigned short h) { return __uint_as_float((unsigned)h << 16); }

__device__ __forceinline__ void partialSM(f32x16& p0, f32x16& p1, float& m_reg, float& alpha) {
    float pmax = p0[0];
#pragma unroll
    for (int r = 1; r < 16; ++r) pmax = fmaxf(pmax, p0[r]);
#pragma unroll
    for (int r = 0; r < 16; ++r) pmax = fmaxf(pmax, p1[r]);
    { auto rr = __builtin_amdgcn_permlane32_swap(__float_as_uint(pmax), __float_as_uint(pmax), false, false);
      pmax = fmaxf(__uint_as_float(rr[0]), __uint_as_float(rr[1])); }
    float mn;
    if (__builtin_expect(__all(pmax - m_reg <= THRL), 1)) { mn = m_reg; alpha = 1.f; }
    else { mn = fmaxf(m_reg, pmax); alpha = __builtin_amdgcn_exp2f(m_reg - mn); m_reg = mn; }
#pragma unroll
    for (int r = 0; r < 16; ++r) { p0[r] -= mn; p1[r] -= mn; }
#pragma unroll
    for (int r = 0; r < 16; ++r) p0[r] = __builtin_amdgcn_exp2f(p0[r]);
}
__device__ __forceinline__ void finishSM(f32x16& p0, f32x16& p1, float alpha, float& l_reg, bf16x8& pa0, bf16x8& pa1, bf16x8& pa2, bf16x8& pa3) {
#pragma unroll
    for (int r = 0; r < 16; ++r) p1[r] = __builtin_amdgcn_exp2f(p1[r]);
    float ps = 0;
#pragma unroll
    for (int r = 0; r < 16; ++r) ps += p0[r];
#pragma unroll
    for (int r = 0; r < 16; ++r) ps += p1[r];
    { auto rr = __builtin_amdgcn_permlane32_swap(__float_as_uint(ps), __float_as_uint(ps), false, false);
      ps = __uint_as_float(rr[0]) + __uint_as_float(rr[1]); }
    l_reg = l_reg * alpha + ps;
#define PK4(P, BASE, OUT) do { unsigned a0 = cvtpk(P[BASE + 0], P[BASE + 1]), a1 = cvtpk(P[BASE + 2], P[BASE + 3]);   \
    unsigned b0 = cvtpk(P[BASE + 4], P[BASE + 5]), b1 = cvtpk(P[BASE + 6], P[BASE + 7]);                              \
    auto r0 = __builtin_amdgcn_permlane32_swap(a0, b0, false, false); auto r1 = __builtin_amdgcn_permlane32_swap(a1, b1, false, false); \
    u32x4 w = {r0[0], r1[0], r0[1], r1[1]}; OUT = *reinterpret_cast<bf16x8*>(&w); } while (0)
    PK4(p0, 0, pa0); PK4(p0, 8, pa1); PK4(p1, 0, pa2); PK4(p1, 8, pa3);
}
__device__ __forceinline__ void pack4(const f32x16& p0, const f32x16& p1, bf16x8& pa0, bf16x8& pa1, bf16x8& pa2, bf16x8& pa3) {
    PK4(p0, 0, pa0); PK4(p0, 8, pa1); PK4(p1, 0, pa2); PK4(p1, 8, pa3);
}
#undef PK4

template <int NCB> __device__ __forceinline__ int v_st(int k, int c) { const int kk = (k & ~0xC) | ((k & 4) << 1) | ((k & 8) >> 1); return ((kk >> 3) * NCB + (c >> 5)) * 512 + ((kk & 7) * 32 + (c & 31)) * 2; }
__device__ __forceinline__ int v_rd_base(int lane) { return ((lane & 3) << 3) | (((lane >> 2) & 3) << 6) | (((lane >> 4) & 1) << 5) | (((lane >> 5) & 1) << 8); }
template <int OFF> __device__ __forceinline__ s16x4 tr_read(int vb) { s16x4 r; asm volatile("ds_read_b64_tr_b16 %0, %1 offset:%2" : "=&v"(r) : "v"(vb), "i"(OFF) : "memory"); return r; }
#define PKF(L, H) (bf16x8){L[0], L[1], L[2], L[3], H[0], H[1], H[2], H[3]}
template <int NCB> __device__ __forceinline__ void pv_blk(f32x16& od, int vb, bf16x8 pa0, bf16x8 pa1, bf16x8 pa2, bf16x8 pa3) {
    constexpr int KS = NCB * 1024, HF = NCB * 512;
    const s16x4 l0 = tr_read<0 * KS>(vb), h0 = tr_read<0 * KS + HF>(vb), l1 = tr_read<1 * KS>(vb), h1 = tr_read<1 * KS + HF>(vb);
    const s16x4 l2 = tr_read<2 * KS>(vb), h2 = tr_read<2 * KS + HF>(vb), l3 = tr_read<3 * KS>(vb), h3 = tr_read<3 * KS + HF>(vb);
    asm volatile("s_waitcnt lgkmcnt(0)" ::: "memory"); SBAR();
    od = __builtin_amdgcn_mfma_f32_32x32x16_bf16(pa0, PKF(l0, h0), od, 0, 0, 0);
    od = __builtin_amdgcn_mfma_f32_32x32x16_bf16(pa1, PKF(l1, h1), od, 0, 0, 0);
    od = __builtin_amdgcn_mfma_f32_32x32x16_bf16(pa2, PKF(l2, h2), od, 0, 0, 0);
    od = __builtin_amdgcn_mfma_f32_32x32x16_bf16(pa3, PKF(l3, h3), od, 0, 0, 0);
}


template <int NCB> __device__ __forceinline__ int v_stn(int k, int c) { return ((k >> 3) * NCB + (c >> 5)) * 512 + ((k & 7) * 32 + (c & 31)) * 2; }
__device__ __forceinline__ float max3f(float a, float b, float c) { return fmaxf(fmaxf(a, b), c); }
__device__ __forceinline__ void fill16(f32x16& v, float x) {
#pragma unroll
    for (int r = 0; r < 16; ++r) v[r] = x;
}
template <bool FIRST>
__device__ __forceinline__ void partialSM_n(f32x16& p0, f32x16& p1, float& m_reg, f32x16& negm, float& alpha) {
    float a = max3f(p0[0], p0[1], p0[2]), b = max3f(p0[3], p0[4], p0[5]), c = max3f(p1[0], p1[1], p1[2]), d = max3f(p1[3], p1[4], p1[5]);
    a = max3f(a, p0[6], p0[7]); b = max3f(b, p0[8], p0[9]); c = max3f(c, p1[6], p1[7]); d = max3f(d, p1[8], p1[9]);
    a = max3f(a, p0[10], p0[11]); b = max3f(b, p0[12], p0[13]); c = max3f(c, p1[10], p1[11]); d = max3f(d, p1[12], p1[13]);
    a = max3f(a, p0[14], p0[15]); c = max3f(c, p1[14], p1[15]);
    float pmax = fmaxf(fmaxf(a, b), fmaxf(c, d));
    { auto rr = __builtin_amdgcn_permlane32_swap(__float_as_uint(pmax), __float_as_uint(pmax), false, false);
      pmax = fmaxf(__uint_as_float(rr[0]), __uint_as_float(rr[1])); }
    if (!FIRST && __builtin_expect(__all(pmax <= THRL), 1)) { alpha = 1.f; }
    else { const float dl = FIRST ? pmax : fmaxf(pmax, 0.f); m_reg += dl; alpha = FIRST ? 0.f : __builtin_amdgcn_exp2f(-dl);
#pragma unroll
        for (int r = 0; r < 16; ++r) { p0[r] -= dl; p1[r] -= dl; }
        fill16(negm, -m_reg); asm volatile("" : "+v"(negm)); }
#pragma unroll
    for (int r = 0; r < 16; ++r) p0[r] = __builtin_amdgcn_exp2f(p0[r]);
}
#define PKN(P, B) (u32x4){cvtpk(P[B + 0], P[B + 1]), cvtpk(P[B + 2], P[B + 3]), cvtpk(P[B + 4], P[B + 5]), cvtpk(P[B + 6], P[B + 7])}
template <bool SUM>
__device__ __forceinline__ void finishSM_n(f32x16& p0, f32x16& p1, float alpha, float& l_reg, bf16x8& pa0, bf16x8& pa1, bf16x8& pa2, bf16x8& pa3) {
#pragma unroll
    for (int r = 0; r < 16; ++r) p1[r] = __builtin_amdgcn_exp2f(p1[r]);
    if (SUM) {
        float s0 = (p0[0] + p0[1]) + (p0[2] + p0[3]), s1 = (p0[4] + p0[5]) + (p0[6] + p0[7]), s2 = (p0[8] + p0[9]) + (p0[10] + p0[11]), s3 = (p0[12] + p0[13]) + (p0[14] + p0[15]);
        float t0 = (p1[0] + p1[1]) + (p1[2] + p1[3]), t1 = (p1[4] + p1[5]) + (p1[6] + p1[7]), t2 = (p1[8] + p1[9]) + (p1[10] + p1[11]), t3 = (p1[12] + p1[13]) + (p1[14] + p1[15]);
        float ps = ((s0 + s1) + (s2 + s3)) + ((t0 + t1) + (t2 + t3));
        { auto rr = __builtin_amdgcn_permlane32_swap(__float_as_uint(ps), __float_as_uint(ps), false, false);
          ps = __uint_as_float(rr[0]) + __uint_as_float(rr[1]); }
        l_reg = l_reg * alpha + ps;
    }
    { u32x4 w = PKN(p0, 0); pa0 = *reinterpret_cast<bf16x8*>(&w); } { u32x4 w = PKN(p0, 8); pa1 = *reinterpret_cast<bf16x8*>(&w); }
    { u32x4 w = PKN(p1, 0); pa2 = *reinterpret_cast<bf16x8*>(&w); } { u32x4 w = PKN(p1, 8); pa3 = *reinterpret_cast<bf16x8*>(&w); }
}

constexpr int DA_SLOT = 32768, DA_VOFF = 16384, DA_WS = 133120, DA_STG = 65536, DA_STG_LD = 132;
__device__ __forceinline__ void qkt_da(f32x16& p0, f32x16& p1, const char* Ks, const bf16x8* qr, const f32x16& negm, int r32, int hi, int cb0) {
#pragma unroll
    for (int d0 = 0; d0 < 4; ++d0) { const int cb = cb0 + (d0 * 16 + hi * 8) * 2;
        const bf16x8 b0 = *reinterpret_cast<const bf16x8*>(Ks + KSWZ(r32, cb));
        const bf16x8 b1 = *reinterpret_cast<const bf16x8*>(Ks + KSWZ(32 + r32, cb));
        if (d0 == 0) { p0 = __builtin_amdgcn_mfma_f32_32x32x16_bf16(b0, qr[0], negm, 0, 0, 0); p1 = __builtin_amdgcn_mfma_f32_32x32x16_bf16(b1, qr[0], negm, 0, 0, 0); }
        else { p0 = __builtin_amdgcn_mfma_f32_32x32x16_bf16(b0, qr[d0], p0, 0, 0, 0); p1 = __builtin_amdgcn_mfma_f32_32x32x16_bf16(b1, qr[d0], p1, 0, 0, 0); } }
}
typedef short v4i16_t __attribute__((ext_vector_type(4)));
__device__ __forceinline__ s16x4 vtr(int addr) { return __builtin_bit_cast(s16x4, __builtin_amdgcn_ds_read_tr16_b64_v4i16((__attribute__((address_space(3))) v4i16_t*)(unsigned)addr)); }
__device__ __forceinline__ void pv_da(f32x16* o, int vb, bf16x8 pa0, bf16x8 pa1, bf16x8 pa2, bf16x8 pa3) {
    s16x4 lo[4], hi[4];
#define VADDR(i) (vb + ((i) & 3) * 512 + ((i) >> 2) * 4096)
#pragma unroll
    for (int i = 0; i < 4; ++i) { lo[i] = vtr(VADDR(i)); hi[i] = vtr(VADDR(i) + 2048); }
#pragma unroll
    for (int i = 0; i < 16; ++i) {
        const bf16x8 vf = PKF(lo[i & 3], hi[i & 3]);
        const bf16x8 pa = ((i >> 2) == 0) ? pa0 : ((i >> 2) == 1) ? pa1 : ((i >> 2) == 2) ? pa2 : pa3;
        o[i & 3] = __builtin_amdgcn_mfma_f32_32x32x16_bf16(pa, vf, o[i & 3], 0, 0, 0);
        if (i + 4 < 16) { lo[i & 3] = vtr(VADDR(i + 4)); hi[i & 3] = vtr(VADDR(i + 4) + 2048); }
    }
#undef VADDR
    __builtin_amdgcn_sched_group_barrier(0x100, 8, 0);
#pragma unroll
    for (int i = 0; i < 12; ++i) { __builtin_amdgcn_sched_group_barrier(0x008, 1, 0); __builtin_amdgcn_sched_group_barrier(0x100, 2, 0); __builtin_amdgcn_sched_group_barrier(0x002, 4, 0); }
#pragma unroll
    for (int i = 0; i < 4; ++i) { __builtin_amdgcn_sched_group_barrier(0x008, 1, 0); __builtin_amdgcn_sched_group_barrier(0x002, 4, 0); }
}
template <bool DRY, int PVAR = 0>
__device__ __forceinline__ void diff_attn_unit(int b, int h, int qb, const u16* Qa, const u16* __restrict__ Ka, const u16* __restrict__ Va, const u16* __restrict__ Ga,
                                               u16* Y, const float* __restrict__ subw, float lam, float one_m_li, char* lds) {
    int tid = threadIdx.x; asm volatile("" : "+v"(tid)); const int lane = tid & 63, r32 = lane & 31, hi = lane >> 5; const int wid = __builtin_amdgcn_readfirstlane(tid >> 6);
    const int map = wid >> 2, wq = wid & 3;
    const long rowbase = (long)b * SEQ; const int q0 = qb * 128;
    float* wsf = (float*)(lds + DA_WS) + wid * 64; float* li_l = wsf; float* al_l = wsf + 32;
    float m_reg = 0.f, l_reg = 0; f32x16 o[4] = {}; bf16x8 qr[4]; f32x16 negm = f32x16{}; asm volatile("" : "+v"(negm));
    const u16* Qw = Qa + (rowbase + q0 + wq * 32 + r32) * DM + h * 128 + map * 64 + hi * 8;
#pragma unroll
    for (int d0 = 0; d0 < 4; ++d0) qr[d0] = ld8(Qw + d0 * 16);
    const u16* Kh = Ka + rowbase * DM + h * 128; const u16* Vh = Va + rowbase * DM + h * 128;
    const int vb0 = (int)(uintptr_t)lds + DA_VOFF + v_rd_base(lane);
    const int cb0 = map * 128;
    unsigned kofs[2], vofs[2];
#pragma unroll
    for (int i = 0; i < 2; ++i) { const int pk = 2 * wid + i;
        const int row = 4 * pk + (lane >> 4), cp = lane & 15; kofs[i] = (unsigned)(row * DM + ((cp ^ (row & 7)) * 8)) * 2u;
        const int st = 2 * pk + (lane >> 5), kk = 8 * (st >> 2) + ((lane & 31) >> 2), cc = 32 * (st & 3) + 8 * (lane & 3); vofs[i] = (unsigned)(kk * DM + cc) * 2u; }
    typedef __attribute__((address_space(3))) unsigned lds_u32;
#define DMA_TILE(t, soff) do { const char* kb_ = (const char*)(Kh + (long)(t) * 64 * DM); const char* vb_ = (const char*)(Vh + (long)(t) * 64 * DM); \
    _Pragma("unroll") for (int i_ = 0; i_ < 2; ++i_) { \
        __builtin_amdgcn_global_load_lds((const unsigned*)(kb_ + kofs[i_]), (lds_u32*)(lds + (soff) + (2 * wid + i_) * 1024), 16, 0, 0); \
        __builtin_amdgcn_global_load_lds((const unsigned*)(vb_ + vofs[i_]), (lds_u32*)(lds + (soff) + DA_VOFF + (2 * wid + i_) * 1024), 16, 0, 0); } } while (0)
#define RESC(a) do { if (__any((a) < 1.f)) { if (hi == 0) al_l[r32] = (a); asm volatile("s_waitcnt lgkmcnt(0)" ::: "memory"); \
    _Pragma("unroll") for (int d = 0; d < 4; ++d) _Pragma("unroll") for (int r = 0; r < 16; ++r) o[d][r] *= al_l[crow(r, hi)]; } } while (0)
    f32x16 pA0, pA1, pB0, pB1; float alA, alB; bf16x8 pa0, pa1, pa2, pa3; constexpr int NT = SEQ / 64;
    DMA_TILE(0, 0); DMA_TILE(1, DA_SLOT); __syncthreads();
    qkt_da(pA0, pA1, lds, qr, negm, r32, hi, cb0); partialSM_n<true>(pA0, pA1, m_reg, negm, alA);
    int sp = 0, sc = DA_SLOT, sn = 2 * DA_SLOT;
#define ROT() do { const int t_ = sp; sp = sc; sc = sn; sn = t_; } while (0)
    for (int j = 1; j + 1 < NT; j += 2) {
        DMA_TILE(j + 1, sn);
        qkt_da(pB0, pB1, lds + sc, qr, negm, r32, hi, cb0);
        finishSM_n<true>(pA0, pA1, alA, l_reg, pa0, pa1, pa2, pa3);
        pv_da(o, vb0 + sp, pa0, pa1, pa2, pa3); partialSM_n<false>(pB0, pB1, m_reg, negm, alB);
        RESC(alB); __syncthreads(); ROT();
        DMA_TILE(j + 2, sn);
        qkt_da(pA0, pA1, lds + sc, qr, negm, r32, hi, cb0);
        finishSM_n<true>(pB0, pB1, alB, l_reg, pa0, pa1, pa2, pa3);
        pv_da(o, vb0 + sp, pa0, pa1, pa2, pa3); partialSM_n<false>(pA0, pA1, m_reg, negm, alA);
        RESC(alA); __syncthreads(); ROT();
    }
    SBAR(); qkt_da(pB0, pB1, lds + sc, qr, negm, r32, hi, cb0);
    finishSM_n<true>(pA0, pA1, alA, l_reg, pa0, pa1, pa2, pa3); SBAR();
    pv_da(o, vb0 + sp, pa0, pa1, pa2, pa3); partialSM_n<false>(pB0, pB1, m_reg, negm, alB);
    RESC(alB);
    finishSM_n<true>(pB0, pB1, alB, l_reg, pa0, pa1, pa2, pa3); SBAR();
    pv_da(o, vb0 + sc, pa0, pa1, pa2, pa3);
#undef DMA_TILE
#undef ROT
#undef RESC
    if (hi == 0) li_l[r32] = l_reg; asm volatile("s_waitcnt lgkmcnt(0)" ::: "memory");
    float rli[16];
#pragma unroll
    for (int r = 0; r < 16; ++r) rli[r] = __builtin_amdgcn_rcpf(li_l[crow(r, hi)]) * (map ? lam : 1.0f);
    __syncthreads();
    float* xch = (float*)lds;
    if (map == 1) {
#pragma unroll
        for (int d0 = 0; d0 < 4; ++d0)
#pragma unroll
            for (int r = 0; r < 16; ++r) xch[((wq * 4 + d0) * 16 + r) * 64 + lane] = o[d0][r] * rli[r];
    }
    __syncthreads();
    float* stg = (float*)(lds + DA_STG);
    if (map == 0) {
#pragma unroll
        for (int d0 = 0; d0 < 4; ++d0)
#pragma unroll
            for (int r = 0; r < 16; ++r) { const float dv = o[d0][r] * rli[r] - xch[((wq * 4 + d0) * 16 + r) * 64 + lane];
                stg[(wq * 32 + crow(r, hi)) * DA_STG_LD + d0 * 32 + r32] = dv; }
    }
    __syncthreads();
    {
        const int row = tid >> 2, qt = tid & 3; const float* sp = stg + row * DA_STG_LD + qt * 32;
        f32x4 dv[8]; float ss = 0.f;
#pragma unroll
        for (int g = 0; g < 8; ++g) { dv[g] = *(const f32x4*)(sp + g * 4); ss += (dv[g][0] * dv[g][0] + dv[g][1] * dv[g][1]) + (dv[g][2] * dv[g][2] + dv[g][3] * dv[g][3]); }
        ss += __shfl_xor(ss, 1); ss += __shfl_xor(ss, 2);
        const float sc2 = __builtin_amdgcn_rsqf(ss * (1.0f / 128.0f) + EPS) * one_m_li;
        const size_t goff = (size_t)(rowbase + q0 + row) * DM + h * 128 + qt * 32;
#pragma unroll
        for (int g = 0; g < 4; ++g) {
            const bf16x8 gt = ld8(Ga + goff + g * 8);
            const f32x4 w0 = *(const f32x4*)(subw + qt * 32 + g * 8), w1 = *(const f32x4*)(subw + qt * 32 + g * 8 + 4);
            const f32x4 a = dv[2 * g], c = dv[2 * g + 1];
            u32x4 w;
            w.x = cvtpk(a[0] * sc2 * w0[0] * bf2f((u16)gt[0]), a[1] * sc2 * w0[1] * bf2f((u16)gt[1]));
            w.y = cvtpk(a[2] * sc2 * w0[2] * bf2f((u16)gt[2]), a[3] * sc2 * w0[3] * bf2f((u16)gt[3]));
            w.z = cvtpk(c[0] * sc2 * w1[0] * bf2f((u16)gt[4]), c[1] * sc2 * w1[1] * bf2f((u16)gt[5]));
            w.w = cvtpk(c[2] * sc2 * w1[2] * bf2f((u16)gt[6]), c[3] * sc2 * w1[3] * bf2f((u16)gt[7]));
            if (!DRY) *(u32x4*)(Y + goff + g * 8) = w; else asm volatile("" :: "v"(w));
        }
    }
    __syncthreads();
}

constexpr int SWB_K = 0, SWB_V = 49152, SWB_WS = 98304, SWB_STG = 100352, SWB_STG_LD = 36;
__device__ __forceinline__ void swa_block_geom(int qb, int& t_lo, int& t_hi) { const int q0 = qb * 128; t_lo = (q0 >= 128 ? q0 - 128 : 0) >> 6; t_hi = (q0 + 255 < SEQ ? q0 + 255 : SEQ - 1) >> 6; }
template <int N> struct SwaRegs { bf16x8 k[N], v[N]; };
template <int N> __device__ __forceinline__ void swa_tiles_load(SwaRegs<N>& R, int b, int kvh, int t0, int nt, const u16* __restrict__ Kb, const u16* __restrict__ Vb, int tid) {
    const int sr = tid >> 3, sc = (tid & 7) * 8; const long rowbase = (long)b * SEQ;
    const u16* Kh = Kb + (rowbase + t0 * 64 + sr) * 256 + kvh * 64 + sc; const u16* Vh = Vb + (rowbase + t0 * 64 + sr) * 256 + kvh * 64 + sc;
#pragma unroll
    for (int tt = 0; tt < N; ++tt) if (tt < nt) { R.k[tt] = ld8(Kh + (long)tt * 64 * 256); R.v[tt] = ld8(Vh + (long)tt * 64 * 256); }
}
template <int N> __device__ __forceinline__ void swa_tiles_store_lds(const SwaRegs<N>& R, int t0, int nt, char* lds, int tid) {
    const int sr = tid >> 3, sc = (tid & 7) * 8, vst0 = v_stn<2>(sr, sc), kst0 = KSWZ128(sr, sc * 2);
#pragma unroll
    for (int tt = 0; tt < N; ++tt) if (tt < nt) { const int sl = (t0 + tt) % 6; *(bf16x8*)(lds + SWB_K + sl * 8192 + kst0) = R.k[tt]; *(bf16x8*)(lds + SWB_V + sl * 8192 + vst0) = R.v[tt]; }
}
template <bool DRY>
__device__ __forceinline__ void swa_block_compute(int b, int kvh, int qb, const u16* Q, const u16* __restrict__ Gt, u16* Y, const float* __restrict__ sink, char* lds, int tid) {
    const int lane = tid & 63, r32 = lane & 31, hi = lane >> 5; const int wid = __builtin_amdgcn_readfirstlane(tid >> 6);
    const int hq = kvh * 8 + wid; const long rowbase = (long)b * SEQ; const int q0 = qb * 128;
    int t_lo, t_hib; swa_block_geom(qb, t_lo, t_hib); (void)t_hib;
    float* wsf = (float*)(lds + SWB_WS) + wid * 64; float* al_l = wsf + 32;
    float* stg = (float*)(lds + SWB_STG) + wid * (32 * SWB_STG_LD);
    const int vb0 = (int)(uintptr_t)(lds + SWB_V) + v_rd_base(lane);
    const float sink2 = sink[hq] * LOG2E;
    bf16x8 qn[4];
    { const u16* Qw = Q + (rowbase + q0 + r32) * DIN + hq * 64 + hi * 8;
#pragma unroll
      for (int d0 = 0; d0 < 4; ++d0) qn[d0] = ld8(Qw + d0 * 16); }
#pragma unroll 1
    for (int sub = 0; sub < 4; ++sub) {
        const int qs = q0 + 32 * sub;
        bf16x8 qr[4];
#pragma unroll
        for (int d0 = 0; d0 < 4; ++d0) qr[d0] = qn[d0];
        if (sub < 3) { const u16* Qw = Q + (rowbase + qs + 32 + r32) * DIN + hq * 64 + hi * 8;
#pragma unroll
            for (int d0 = 0; d0 < 4; ++d0) qn[d0] = ld8(Qw + d0 * 16); }
        const int ta = ((qs >= 128 ? qs - 128 : 0) >> 6) - t_lo, tb = ((qs + 159 < SEQ ? qs + 159 : SEQ - 1) >> 6) - t_lo;
        float m_reg = sink2, l_dummy = 0.f; f32x16 o[2] = {}; f32x16 lacc, negm; fill16(lacc, 1.0f); fill16(negm, -sink2);
        const bf16x8 ones = {0x3F80, 0x3F80, 0x3F80, 0x3F80, 0x3F80, 0x3F80, 0x3F80, 0x3F80};
        bf16x8 gpre[2][2];
        { const size_t gb = (size_t)(rowbase + qs + (lane >> 1)) * DIN + hq * 64 + (lane & 1) * 16;
#pragma unroll
          for (int cbk = 0; cbk < 2; ++cbk) { gpre[cbk][0] = ld8(Gt + gb + cbk * 32); gpre[cbk][1] = ld8(Gt + gb + cbk * 32 + 8); } }
        for (int tt = ta; tt <= tb; ++tt) {
            const int k0 = (t_lo + tt) * 64, sl = (t_lo + tt) % 6;
            f32x16 p0, p1;
            const char* Ks = lds + SWB_K + sl * 8192;
#pragma unroll
            for (int d0 = 0; d0 < 4; ++d0) { const int cb = (d0 * 16 + hi * 8) * 2;
                const bf16x8 b0 = *reinterpret_cast<const bf16x8*>(Ks + KSWZ128(r32, cb));
                const bf16x8 b1 = *reinterpret_cast<const bf16x8*>(Ks + KSWZ128(32 + r32, cb));
                if (d0 == 0) { p0 = __builtin_amdgcn_mfma_f32_32x32x16_bf16(b0, qr[0], negm, 0, 0, 0); p1 = __builtin_amdgcn_mfma_f32_32x32x16_bf16(b1, qr[0], negm, 0, 0, 0); }
                else { p0 = __builtin_amdgcn_mfma_f32_32x32x16_bf16(b0, qr[d0], p0, 0, 0, 0); p1 = __builtin_amdgcn_mfma_f32_32x32x16_bf16(b1, qr[d0], p1, 0, 0, 0); } }
            if (k0 < qs - 97 || k0 + 63 > qs + 128) {
                const int base = k0 - qs - r32 + 4 * hi + 128;
#pragma unroll
                for (int r = 0; r < 16; ++r) { const int c = (r & 3) + 8 * (r >> 2); if ((unsigned)(base + c) > 256u) p0[r] = -1e30f; if ((unsigned)(base + c + 32) > 256u) p1[r] = -1e30f; }
            }
            float alpha; bf16x8 pa0, pa1, pa2, pa3;
            partialSM_n<false>(p0, p1, m_reg, negm, alpha);
            if (__any(alpha < 1.f)) { if (hi == 0) al_l[r32] = alpha; asm volatile("s_waitcnt lgkmcnt(0)" ::: "memory");
#pragma unroll
                for (int r = 0; r < 16; ++r) { const float al = al_l[crow(r, hi)]; o[0][r] *= al; o[1][r] *= al; lacc[r] *= al; } }
            finishSM_n<false>(p0, p1, alpha, l_dummy, pa0, pa1, pa2, pa3); SBAR();
            {
                const int vbt = vb0 + sl * 8192; s16x4 lo[4], hi4[4];
#define VADDR2(i) (vbt + ((i) & 1) * 512 + ((i) >> 1) * 2048)
#pragma unroll
                for (int i = 0; i < 4; ++i) { lo[i] = vtr(VADDR2(i)); hi4[i] = vtr(VADDR2(i) + 1024); }
#pragma unroll
                for (int i = 0; i < 8; ++i) {
                    const bf16x8 vf = PKF(lo[i & 3], hi4[i & 3]);
                    const bf16x8 pa = ((i >> 1) == 0) ? pa0 : ((i >> 1) == 1) ? pa1 : ((i >> 1) == 2) ? pa2 : pa3;
                    o[i & 1] = __builtin_amdgcn_mfma_f32_32x32x16_bf16(pa, vf, o[i & 1], 0, 0, 0);
                    if ((i & 1) == 1) lacc = __builtin_amdgcn_mfma_f32_32x32x16_bf16(pa, ones, lacc, 0, 0, 0);
                    if (i + 4 < 8) { lo[i & 3] = vtr(VADDR2(i + 4)); hi4[i & 3] = vtr(VADDR2(i + 4) + 1024); }
                }
#undef VADDR2
            }
        }
        float rl[16];
#pragma unroll
        for (int r = 0; r < 16; ++r) rl[r] = __builtin_amdgcn_rcpf(lacc[r]);
#pragma unroll
        for (int cbk = 0; cbk < 2; ++cbk) {
#pragma unroll
            for (int r = 0; r < 16; ++r) stg[crow(r, hi) * SWB_STG_LD + r32] = o[cbk][r] * rl[r];
            asm volatile("s_waitcnt lgkmcnt(0)" ::: "memory");
            const int row = lane >> 1, hf = lane & 1; const float* sp = stg + row * SWB_STG_LD + hf * 16;
            const f32x4 a0 = *(const f32x4*)(sp), a1 = *(const f32x4*)(sp + 4), a2 = *(const f32x4*)(sp + 8), a3 = *(const f32x4*)(sp + 12);
            const size_t goff = (size_t)(rowbase + qs + row) * DIN + hq * 64 + cbk * 32 + hf * 16;
            const bf16x8 g0 = gpre[cbk][0], g1 = gpre[cbk][1];
            u32x4 w0, w1;
            w0.x = cvtpk(a0[0] * bf2f((u16)g0[0]), a0[1] * bf2f((u16)g0[1])); w0.y = cvtpk(a0[2] * bf2f((u16)g0[2]), a0[3] * bf2f((u16)g0[3]));
            w0.z = cvtpk(a1[0] * bf2f((u16)g0[4]), a1[1] * bf2f((u16)g0[5])); w0.w = cvtpk(a1[2] * bf2f((u16)g0[6]), a1[3] * bf2f((u16)g0[7]));
            w1.x = cvtpk(a2[0] * bf2f((u16)g1[0]), a2[1] * bf2f((u16)g1[1])); w1.y = cvtpk(a2[2] * bf2f((u16)g1[2]), a2[3] * bf2f((u16)g1[3]));
            w1.z = cvtpk(a3[0] * bf2f((u16)g1[4]), a3[1] * bf2f((u16)g1[5])); w1.w = cvtpk(a3[2] * bf2f((u16)g1[6]), a3[3] * bf2f((u16)g1[7]));
            if (!DRY) { *(u32x4*)(Y + goff) = w0; *(u32x4*)(Y + goff + 8) = w1; } else asm volatile("" :: "v"(w0), "v"(w1));
            asm volatile("s_waitcnt lgkmcnt(0)" ::: "memory");
        }
    }
}
template <bool DRY>
__device__ __forceinline__ void swa_phase(int u0, const u16* Q, const u16* Kb, const u16* Vb, const u16* Gt, u16* Y, const float* sink, char* lds) {
    int tid = threadIdx.x; asm volatile("" : "+v"(tid));
    const int bk = u0 >> 5, b = bk >> 2, kvh = bk & 3, qbA = u0 & 31, qbB = qbA + 1;
    int tloA, thiA, tloB, thiB; swa_block_geom(qbA, tloA, thiA); swa_block_geom(qbB, tloB, thiB);
    { SwaRegs<6> R; swa_tiles_load<6>(R, b, kvh, tloA, thiA - tloA + 1, Kb, Vb, tid); swa_tiles_store_lds<6>(R, tloA, thiA - tloA + 1, lds, tid); }
    __syncthreads();
    SwaRegs<2> N; const int nnew = thiB - thiA;
    swa_tiles_load<2>(N, b, kvh, thiA + 1, nnew, Kb, Vb, tid);
    swa_block_compute<DRY>(b, kvh, qbA, Q, Gt, Y, sink, lds, tid);
    __syncthreads();
    swa_tiles_store_lds<2>(N, thiA + 1, nnew, lds, tid);
    __syncthreads();
    swa_block_compute<DRY>(b, kvh, qbB, Q, Gt, Y, sink, lds, tid);
    __syncthreads();
}
}
namespace hg {
using namespace att;
typedef _Float16 f16;
constexpr int L_QT = 0, L_KT = 16384, L_QIN = 32768, L_KDEC = 49152, L_V = 65536, L_S = 81920, L_CUM = 114688, L_EDEC = 118784, L_STG = 0, STG_LD = 132;

struct ChunkRegs { unsigned q[8], v[8], lf[8]; };

__device__ __forceinline__ int chunk_pos(int c, int i, int dir) { return dir ? (c * 64 + 63 - i) : (c * 64 + i); }

template <bool NEEDQ>
__device__ __forceinline__ void load_chunk(ChunkRegs& R, const u16* Qh, const u16* Vh, const u16* LF, long rowbase, int colbase, int c, int dir, int wid, int lane) {
#pragma unroll
    for (int i = 0; i < 8; ++i) {
        const long pos = rowbase + chunk_pos(c, wid * 8 + i, dir);
        const size_t off = (size_t)pos * DM + colbase + 2 * lane;
        if (NEEDQ) R.q[i] = *(const unsigned*)(Qh + off);
        R.v[i] = *(const unsigned*)(Vh + off);
        R.lf[i] = *(const unsigned*)(LF + off);
    }
}
__device__ __forceinline__ float h2f(unsigned short h) { return (float)__builtin_bit_cast(f16, h); }

template <bool FULL>
__device__ __forceinline__ void prep_chunk(const ChunkRegs& R, char* lds, int wid, int lane, float (&gtot)[2]) {
    float g[8][2]; float run0 = 0.f, run1 = 0.f;
#pragma unroll
    for (int i = 0; i < 8; ++i) { run0 += h2f((unsigned short)(R.lf[i] & 0xffff)); run1 += h2f((unsigned short)(R.lf[i] >> 16)); g[i][0] = run0; g[i][1] = run1; }
    float* cum = (float*)(lds + L_CUM);
    *(float2*)(cum + wid * 128 + 2 * lane) = make_float2(run0, run1);
    __syncthreads();
    float pre0 = 0.f, pre1 = 0.f, gm0 = 0.f, gm1 = 0.f, gl0 = 0.f, gl1 = 0.f;
#pragma unroll
    for (int w2 = 0; w2 < 8; ++w2) { const float2 t = *(const float2*)(cum + w2 * 128 + 2 * lane);
        if (w2 < wid) { pre0 += t.x; pre1 += t.y; } if (w2 < 4) { gm0 += t.x; gm1 += t.y; } gl0 += t.x; gl1 += t.y; }
    gtot[0] += gl0; gtot[1] += gl1;
    const float egm0 = __expf(gm0), egm1 = __expf(gm1), elm0 = __expf(gl0 - gm0), elm1 = __expf(gl1 - gm1);
    if (wid == 0) *(float2*)((float*)(lds + L_EDEC) + 2 * lane) = make_float2(__expf(gl0), __expf(gl1));
#pragma unroll
    for (int i = 0; i < 8; ++i) {
        const int row = wid * 8 + i;
        const float G0 = pre0 + g[i][0], G1 = pre1 + g[i][1];
        const float e0 = __expf(G0 - gm0), e1 = __expf(G1 - gm1);
        const float r0 = __builtin_amdgcn_rcpf(e0), r1 = __builtin_amdgcn_rcpf(e1);
        const float lf0 = h2f((unsigned short)(R.lf[i] & 0xffff)), lf1 = h2f((unsigned short)(R.lf[i] >> 16));
        const float k0 = 1.0f - __expf(lf0), k1 = 1.0f - __expf(lf1);
        const float kt0 = k0 * r0, kt1 = k1 * r1;
        const int vo = v_st<4>(row, 2 * lane);
        *(unsigned*)(lds + L_KDEC + vo) = cvtpk(kt0 * elm0, kt1 * elm1);
        *(unsigned*)(lds + L_V + vo) = R.v[i];
        if (FULL) {
            const float q0 = bf2f((u16)(R.q[i] & 0xffff)), q1 = bf2f((u16)(R.q[i] >> 16));
            const float qt0 = q0 * e0, qt1 = q1 * e1;
            const int ko = KSWZ(row, 4 * lane);
            *(unsigned*)(lds + L_QT + ko) = cvtpk(qt0, qt1);
            *(unsigned*)(lds + L_KT + ko) = cvtpk(kt0, kt1);
            *(unsigned*)(lds + L_QIN + ko) = cvtpk(qt0 * egm0, qt1 * egm1);
        }
    }
}

template <int KS> __device__ __forceinline__ bf16x8 tr_frag(int vb) {
    const s16x4 l = tr_read<KS * 4096>(vb), h = tr_read<KS * 4096 + 2048>(vb);
    asm volatile("s_waitcnt lgkmcnt(0)" ::: "memory"); SBAR();
    return PKF(l, h);
}

struct SuFrag { s16x4 lv, hv, l0, h0, l1, h1; };
__device__ __forceinline__ void su_read(SuFrag& f, int vbV, int vbK0, int vbK1, int off) {
    f.lv = vtr(vbV + off); f.hv = vtr(vbV + off + 2048); f.l0 = vtr(vbK0 + off); f.h0 = vtr(vbK0 + off + 2048); f.l1 = vtr(vbK1 + off); f.h1 = vtr(vbK1 + off + 2048);
}
__device__ __forceinline__ void su_mma(f32x16 (&sacc)[2], const SuFrag& f) {
    const bf16x8 bv = PKF(f.lv, f.hv), a0 = PKF(f.l0, f.h0), a1 = PKF(f.l1, f.h1);
    sacc[0] = __builtin_amdgcn_mfma_f32_32x32x16_bf16(a0, bv, sacc[0], 0, 0, 0); sacc[1] = __builtin_amdgcn_mfma_f32_32x32x16_bf16(a1, bv, sacc[1], 0, 0, 0);
}
template <int NIMG>
__device__ __forceinline__ void state_update_t(f32x16 (&sacc)[2], const char* lds, int ldsbase, int offK, int offV, int offE, int wid, int lane) {
    const int hi = lane >> 5, j = wid >> 1, ib = 2 * (wid & 1);
    const float* edec = (const float*)(lds + offE);
    const int vbV = ldsbase + offV + v_rd_base(lane) + j * 512;
    const int vbK0 = ldsbase + offK + v_rd_base(lane) + ib * 512, vbK1 = vbK0 + 512;
#pragma unroll
    for (int i2 = 0; i2 < 2; ++i2)
#pragma unroll
        for (int r = 0; r < 16; ++r) sacc[i2][r] *= edec[32 * (ib + i2) + crow(r, hi)];
    SBAR();
    SuFrag fa, fb; su_read(fa, vbV, vbK0, vbK1, 0);
#pragma unroll
    for (int s = 0; s < 4 * NIMG; s += 2) {
        su_read(fb, vbV, vbK0, vbK1, ((s + 1) >> 2) * 16384 + ((s + 1) & 3) * 4096);
        su_mma(sacc, fa);
        if (s + 2 < 4 * NIMG) su_read(fa, vbV, vbK0, vbK1, ((s + 2) >> 2) * 16384 + ((s + 2) & 3) * 4096);
        su_mma(sacc, fb);
    }
    __builtin_amdgcn_sched_group_barrier(0x100, 6, 0);
#pragma unroll
    for (int s = 0; s < 4 * NIMG - 1; ++s) { __builtin_amdgcn_sched_group_barrier(0x100, 6, 0); __builtin_amdgcn_sched_group_barrier(0x008, 2, 0); }
    __builtin_amdgcn_sched_group_barrier(0x008, 2, 0);
    SBAR();
}
__device__ __forceinline__ void state_update(f32x16 (&sacc)[2], const char* lds, int ldsbase, int wid, int lane) { state_update_t<1>(sacc, lds, ldsbase, L_KDEC, L_V, L_EDEC, wid, lane); }
__device__ __forceinline__ void write_simg(const f32x16 (&sacc)[2], char* lds, int wid, int lane) {
    const int r32 = lane & 31, hi = lane >> 5, j = wid >> 1, ib = 2 * (wid & 1);
#pragma unroll
    for (int i2 = 0; i2 < 2; ++i2)
#pragma unroll
        for (int r = 0; r < 16; ++r) { const int d = 32 * (ib + i2) + crow(r, hi);
            *(__hip_bfloat16*)(lds + L_S + (d >> 6) * 16384 + v_st<4>(d & 63, 32 * j + r32)) = __float2bfloat16(sacc[i2][r]); }
}
__device__ __forceinline__ f32x16 chunk_output(const char* lds, int ldsbase, int wid, int lane) {
    const int r32 = lane & 31, hi = lane >> 5, tb = wid & 1, j = wid >> 1;
    const char* QT = lds + L_QT; const char* KT = lds + L_KT; const char* QIN = lds + L_QIN;
    f32x16 p0 = f32x16{}, p1 = f32x16{};
#pragma unroll
    for (int d0 = 0; d0 < 8; ++d0) { const int cb = (d0 * 16 + hi * 8) * 2;
        const bf16x8 qf = *reinterpret_cast<const bf16x8*>(QT + KSWZ(32 * tb + r32, cb));
        const bf16x8 k0 = *reinterpret_cast<const bf16x8*>(KT + KSWZ(r32, cb));
        p0 = __builtin_amdgcn_mfma_f32_32x32x16_bf16(k0, qf, p0, 0, 0, 0);
        if (tb) { const bf16x8 k1 = *reinterpret_cast<const bf16x8*>(KT + KSWZ(32 + r32, cb)); p1 = __builtin_amdgcn_mfma_f32_32x32x16_bf16(k1, qf, p1, 0, 0, 0); } }
#pragma unroll
    for (int r = 0; r < 16; ++r) { const bool keep = crow(r, hi) <= r32; if (tb == 0) { p0[r] = keep ? p0[r] : 0.f; p1[r] = 0.f; } else { p1[r] = keep ? p1[r] : 0.f; } }
    bf16x8 pa0, pa1, pa2, pa3; pack4(p0, p1, pa0, pa1, pa2, pa3);
    f32x16 oacc = f32x16{};
    pv_blk<4>(oacc, ldsbase + L_V + v_rd_base(lane) + j * 512, pa0, pa1, pa2, pa3);
    const int vbS = ldsbase + L_S + v_rd_base(lane) + j * 512;
#define QINF(kd) (*reinterpret_cast<const bf16x8*>(QIN + KSWZ(32 * tb + r32, ((kd) * 16 + hi * 8) * 2)))
    {
        s16x4 lo[2], hh[2];
#define SADDR(kd) (vbS + ((kd) >> 2) * 16384 + ((kd) & 3) * 4096)
        lo[0] = vtr(SADDR(0)); hh[0] = vtr(SADDR(0) + 2048); lo[1] = vtr(SADDR(1)); hh[1] = vtr(SADDR(1) + 2048);
#pragma unroll
        for (int kd = 0; kd < 8; ++kd) {
            const bf16x8 b = PKF(lo[kd & 1], hh[kd & 1]); const bf16x8 q = QINF(kd);
            oacc = __builtin_amdgcn_mfma_f32_32x32x16_bf16(q, b, oacc, 0, 0, 0);
            if (kd + 2 < 8) { lo[kd & 1] = vtr(SADDR(kd + 2)); hh[kd & 1] = vtr(SADDR(kd + 2) + 2048); }
        }
#undef SADDR
    }
#undef QINF
    return oacc;
}

constexpr int P1_KDEC = 0, P1_V = 65536, P1_CUM = 131072, P1_EDEC = 135168;
struct BlockRegs { unsigned v[32], lf[32]; };
__device__ __forceinline__ void load_block(BlockRegs& R, const u16* Vh, const u16* LF, long rowbase, int colbase, int seg, int blk, int dir, int wid, int lane) {
    unsigned voff = (unsigned)lane * 4u; asm volatile("" : "+v"(voff));
#pragma unroll
    for (int i = 0; i < 32; ++i) {
        const int p = blk * 256 + wid * 32 + i;
        const long pos = rowbase + seg * 512 + (dir ? 511 - p : p);
        const size_t roff = ((size_t)pos * DM + colbase) * 2;
        R.v[i] = *(const unsigned*)((const char*)Vh + roff + voff); R.lf[i] = *(const unsigned*)((const char*)LF + roff + voff);
    }
}
__device__ __forceinline__ void prep_block(const BlockRegs& R, char* lds, int wid, int lane, float (&gtot)[2]) {
    float run0 = 0.f, run1 = 0.f;
#pragma unroll
    for (int i = 0; i < 32; ++i) { run0 += h2f((unsigned short)(R.lf[i] & 0xffff)); run1 += h2f((unsigned short)(R.lf[i] >> 16)); }
    float* cum = (float*)(lds + P1_CUM);
    *(float2*)(cum + wid * 128 + 2 * lane) = make_float2(run0, run1);
    __syncthreads();
    float pre0 = 0.f, pre1 = 0.f, gl0 = 0.f, gl1 = 0.f;
#pragma unroll
    for (int w2 = 0; w2 < 8; ++w2) { const float2 t = *(const float2*)(cum + w2 * 128 + 2 * lane); if (w2 < wid) { pre0 += t.x; pre1 += t.y; } gl0 += t.x; gl1 += t.y; }
    gtot[0] += gl0; gtot[1] += gl1;
    if (wid == 0) *(float2*)((float*)(lds + P1_EDEC) + 2 * lane) = make_float2(__expf(gl0), __expf(gl1));
    float G0 = pre0 - gl0, G1 = pre1 - gl1;
    char* base = lds + (wid >> 1) * 16384 + (wid & 1) * 8192 + v_st<4>(0, 2 * lane);
#pragma unroll
    for (int i = 0; i < 32; ++i) {
        const float lf0 = h2f((unsigned short)(R.lf[i] & 0xffff)), lf1 = h2f((unsigned short)(R.lf[i] >> 16));
        G0 += lf0; G1 += lf1;
        const float k0 = 1.0f - __expf(lf0), k1 = 1.0f - __expf(lf1);
        const int vo = v_st<4>(i, 0);
        *(unsigned*)(base + P1_KDEC + vo) = cvtpk(k0 * __expf(-G0), k1 * __expf(-G1));
        *(unsigned*)(base + P1_V + vo) = R.v[i];
    }
}
__device__ __forceinline__ void state_update_block(f32x16 (&sacc)[2], const char* lds, int ldsbase, int wid, int lane) { state_update_t<4>(sacc, lds, ldsbase, P1_KDEC, P1_V, P1_EDEC, wid, lane); }
__device__ __forceinline__ void hgrn_pass1(int item, const u16* Vt, const u16* LF0, const u16* LF1, float* ust, float* dst, char* lds) {
    int tid = threadIdx.x; asm volatile("" : "+v"(tid)); const int lane = tid & 63; const int wid = __builtin_amdgcn_readfirstlane(tid >> 6);
    const int seg = item & 7, dir = (item >> 3) & 1, bh = item >> 4, b = bh >> 3, h = bh & 7;
    const long rowbase = (long)b * SEQ; const int colbase = h * 128; const u16* LF = dir ? LF1 : LF0;
    const int ldsbase = (int)(uintptr_t)lds;
    f32x16 sacc[2] = {}; float gtot[2] = {0.f, 0.f};
    BlockRegs R;
    load_block(R, Vt, LF, rowbase, colbase, seg, 0, dir, wid, lane);
#pragma unroll 1
    for (int blk = 0; blk < 2; ++blk) {
        prep_block(R, lds, wid, lane, gtot);
        asm volatile("" ::: "memory");
        if (blk == 0) load_block(R, Vt, LF, rowbase, colbase, seg, 1, dir, wid, lane);
        __syncthreads();
        state_update_block(sacc, lds, ldsbase, wid, lane);
    }
    float* up = ust + (size_t)item * 16384 + wid * 2048;
#pragma unroll
    for (int i2 = 0; i2 < 2; ++i2)
#pragma unroll
        for (int r = 0; r < 16; ++r) up[(i2 * 16 + r) * 64 + lane] = sacc[i2][r];
    if (wid == 0) *(float2*)(dst + (size_t)item * 128 + 2 * lane) = make_float2(__expf(gtot[0]), __expf(gtot[1]));
    __syncthreads();
}

template <bool DRY, int PVAR = 0>
__device__ __forceinline__ void hgrn_pass2(int item, const u16* Qh, const u16* Vt, const u16* LF0, const u16* LF1, const u16* Gt, u16* OF, u16* Y,
                                           const float* ust, const float* dst, const float* __restrict__ nw, char* lds) {
    int tid = threadIdx.x; asm volatile("" : "+v"(tid)); const int lane = tid & 63, r32 = lane & 31, hi = lane >> 5; const int wid = __builtin_amdgcn_readfirstlane(tid >> 6);
    const int seg = item & 7, bh = item >> 3, b = bh >> 3, h = bh & 7;
    const long rowbase = (long)b * SEQ; const int colbase = h * 128;
    const int ldsbase = (int)(uintptr_t)lds; const int tb = wid & 1, j = wid >> 1, ib = 2 * (wid & 1);
    float* stg = (float*)(lds + L_STG);
    ChunkRegs R;
#pragma unroll 1
    for (int dir = 0; dir < 2; ++dir) {
        const u16* LF = dir ? LF1 : LF0;
        f32x16 sacc[2] = {}; float gtot[2] = {0.f, 0.f};
        const int nseg = dir ? (7 - seg) : seg;
        for (int n = 0; n < nseg; ++n) {
            const int sg = dir ? (7 - n) : n; const int it = ((bh * 2 + dir) * 8 + sg);
            const float* up = ust + (size_t)it * 16384 + wid * 2048; const float* dp = dst + (size_t)it * 128;
#pragma unroll
            for (int i2 = 0; i2 < 2; ++i2)
#pragma unroll
                for (int r = 0; r < 16; ++r) sacc[i2][r] = sacc[i2][r] * dp[32 * (ib + i2) + crow(r, hi)] + up[(i2 * 16 + r) * 64 + lane];
        }
        write_simg(sacc, lds, wid, lane);
        load_chunk<true>(R, Qh, Vt, LF, rowbase, colbase, dir ? (seg * 8 + 7) : (seg * 8), dir, wid, lane);
        for (int cc = 0; cc < 8; ++cc) {
            const int c = dir ? (seg * 8 + 7 - cc) : (seg * 8 + cc);
            const int ri = tid >> 3, rcg = tid & 7; const size_t goff = (size_t)(rowbase + chunk_pos(c, ri, dir)) * DM + colbase + rcg * 16;
            u32x4 pf0 = {}, pf1 = {}; bf16x8 pg0 = {}, pg1 = {};
            if (dir) { pf0 = *(const u32x4*)(OF + goff); pf1 = *(const u32x4*)(OF + goff + 8); pg0 = ld8(Gt + goff); pg1 = ld8(Gt + goff + 8); }
            if (PVAR != 1) prep_chunk<true>(R, lds, wid, lane, gtot); else { asm volatile("" :: "v"(R.q[0]), "v"(R.v[7]), "v"(R.lf[3])); __syncthreads(); }
            if (cc + 1 < 8) load_chunk<true>(R, Qh, Vt, LF, rowbase, colbase, dir ? (seg * 8 + 6 - cc) : (seg * 8 + cc + 1), dir, wid, lane);
            __syncthreads();
            f32x16 oacc = f32x16{};
            if (PVAR != 2) { oacc = chunk_output(lds, ldsbase, wid, lane); state_update(sacc, lds, ldsbase, wid, lane); }
            __syncthreads();
            if (PVAR != 3) {
            write_simg(sacc, lds, wid, lane);
#pragma unroll
            for (int r = 0; r < 16; ++r) stg[(32 * tb + crow(r, hi)) * STG_LD + 32 * j + r32] = oacc[r];
            __syncthreads();
            {
                const int i = ri, cg = rcg; const float* sp = stg + i * STG_LD + cg * 16;
                f32x4 ov[4];
#pragma unroll
                for (int g = 0; g < 4; ++g) ov[g] = *(const f32x4*)(sp + g * 4);
                if (dir == 0) {
                    u32x4 w0, w1;
                    w0.x = pg8::pk_f16(ov[0][0], ov[0][1]); w0.y = pg8::pk_f16(ov[0][2], ov[0][3]); w0.z = pg8::pk_f16(ov[1][0], ov[1][1]); w0.w = pg8::pk_f16(ov[1][2], ov[1][3]);
                    w1.x = pg8::pk_f16(ov[2][0], ov[2][1]); w1.y = pg8::pk_f16(ov[2][2], ov[2][3]); w1.z = pg8::pk_f16(ov[3][0], ov[3][1]); w1.w = pg8::pk_f16(ov[3][2], ov[3][3]);
                    if (!DRY) { *(u32x4*)(OF + goff) = w0; *(u32x4*)(OF + goff + 8) = w1; } else asm volatile("" :: "v"(w0), "v"(w1));
                } else {
                    const u32x4 f0 = pf0, f1 = pf1;
                    float tv[16];
#pragma unroll
                    for (int e = 0; e < 4; ++e) { tv[2 * e] = h2f((unsigned short)(f0[e] & 0xffff)); tv[2 * e + 1] = h2f((unsigned short)(f0[e] >> 16));
                                                  tv[8 + 2 * e] = h2f((unsigned short)(f1[e] & 0xffff)); tv[8 + 2 * e + 1] = h2f((unsigned short)(f1[e] >> 16)); }
                    float ss = 0.f;
#pragma unroll
                    for (int e = 0; e < 16; ++e) { tv[e] += ov[e >> 2][e & 3]; ss += tv[e] * tv[e]; }
                    ss += __shfl_xor(ss, 1); ss += __shfl_xor(ss, 2); ss += __shfl_xor(ss, 4);
                    const float rs = __builtin_amdgcn_rsqf(ss * (1.0f / 128.0f) + EPS);
                    const bf16x8 g0 = pg0, g1 = pg1;
                    float yv[16];
#pragma unroll
                    for (int e = 0; e < 8; ++e) { yv[e] = tv[e] * rs * nw[cg * 16 + e] * bf2f((u16)g0[e]); yv[8 + e] = tv[8 + e] * rs * nw[cg * 16 + 8 + e] * bf2f((u16)g1[e]); }
                    u32x4 w0, w1;
                    w0.x = cvtpk(yv[0], yv[1]); w0.y = cvtpk(yv[2], yv[3]); w0.z = cvtpk(yv[4], yv[5]); w0.w = cvtpk(yv[6], yv[7]);
                    w1.x = cvtpk(yv[8], yv[9]); w1.y = cvtpk(yv[10], yv[11]); w1.z = cvtpk(yv[12], yv[13]); w1.w = cvtpk(yv[14], yv[15]);
                    if (!DRY) { *(u32x4*)(Y + goff) = w0; *(u32x4*)(Y + goff + 8) = w1; } else asm volatile("" :: "v"(w0), "v"(w1));
                }
            }
            } else { asm volatile("" :: "v"(oacc), "v"(sacc[0]), "v"(sacc[1]), "v"(pf0), "v"(pg0)); __syncthreads(); }
        }
        __syncthreads();
    }
}
}
#define GAS __attribute__((address_space(1)))
#define LAS __attribute__((address_space(3)))
typedef unsigned short bf16;
typedef unsigned v4u __attribute__((ext_vector_type(4)));
typedef float f32x4 __attribute__((ext_vector_type(4)));
typedef short bf16x8 __attribute__((ext_vector_type(8)));
typedef GAS unsigned gu32;
typedef GAS unsigned long long gu64;
#define RLX_AGENT __ATOMIC_RELAXED, __HIP_MEMORY_SCOPE_AGENT
#define LDS_WAIT() asm volatile("s_waitcnt lgkmcnt(0)" ::: "memory")
#define VM_WAIT() asm volatile("s_waitcnt vmcnt(0)" ::: "memory")
__device__ __forceinline__ unsigned long long rt() { return __builtin_amdgcn_s_memrealtime(); }
__device__ __forceinline__ unsigned f2bf(float f) { unsigned u = __builtin_bit_cast(unsigned, f); return (u + 0x7fffu + ((u >> 16) & 1u)) >> 16; }
__device__ __forceinline__ unsigned pk2(float lo, float hi) { return f2bf(lo) | (f2bf(hi) << 16); }

#define XB_TMO      128
#define XB_XCNT(j)  (256  + 64 * (j))
#define XB_XSUB(j)  (1280 + 64 * (j))
#define XB_XGEN(j)  (2304 + 64 * (j))
#define XB_TOP      3328
#define XB_TOPGEN   3392
#define XCD_BAR_WORDS 3456
#define XB_SPIN_CAP (1u << 18)

__device__ __forceinline__ unsigned xb_ld(unsigned* p)              { return __hip_atomic_load(p, __ATOMIC_RELAXED, __HIP_MEMORY_SCOPE_AGENT); }
__device__ __forceinline__ unsigned xb_add(unsigned* p, unsigned v) { return __hip_atomic_fetch_add(p, v, __ATOMIC_RELAXED, __HIP_MEMORY_SCOPE_AGENT); }
__device__ __forceinline__ unsigned xb_xcc_id() { return (unsigned)__builtin_amdgcn_s_getreg((3 << 11) | 20) & 0xFu; }
#define XB_SPIN(cond, bar) do { unsigned _sp = 0; while (cond) { __builtin_amdgcn_s_sleep(1); \
    if ((++_sp & 255u) == 0u) { if (xb_ld(&(bar)[XB_TMO])) break; if (_sp > XB_SPIN_CAP) { atomicAdd(&(bar)[XB_TMO], 1u); break; } } } } while (0)

struct XcdBarrier {
    unsigned* bar; unsigned x;
    volatile LAS unsigned* st;
};

__device__ __forceinline__ XcdBarrier xcd_barrier_post(unsigned* bar, volatile LAS unsigned* st) {
    XcdBarrier b; b.bar = bar; b.x = xb_xcc_id(); b.st = st;
    if (threadIdx.x == 0) (void)xb_add(&bar[XB_XCNT(b.x)], 1u);
    return b;
}
__device__ __forceinline__ void xcd_barrier_complete(unsigned* bar, unsigned x, unsigned& nloc, unsigned& nx) {
    const unsigned G = gridDim.x * gridDim.y * gridDim.z;
    unsigned sum, cnt, mine, sp = 0u;
    for (;;) {
        sum = 0u; cnt = 0u; mine = 0u;
#pragma unroll
        for (unsigned j = 0; j < 16; ++j) { const unsigned c = xb_ld(&bar[XB_XCNT(j)]); sum += c; cnt += (c > 0u) ? 1u : 0u; mine = (j == x) ? c : mine; }
        if (sum == G) break;
        __builtin_amdgcn_s_sleep(1);
        if ((++sp & 255u) == 0u) { if (xb_ld(&bar[XB_TMO])) break; if (sp > XB_SPIN_CAP) { atomicAdd(&bar[XB_TMO], 1u); break; } }
    }
    nloc = mine > 0u ? mine : 1u; nx = cnt > 0u ? cnt : 1u;
}

__device__ __forceinline__ void xcd_barrier(const XcdBarrier& b) {
    asm volatile("s_waitcnt vmcnt(0)" ::: "memory");
    __syncthreads();
    if (threadIdx.x == 0) {
        unsigned* bar = b.bar; asm volatile("" : "+s"(bar)); unsigned bx = __builtin_amdgcn_readfirstlane(b.x); asm volatile("" : "+s"(bx));
        __builtin_amdgcn_s_waitcnt(0);
        unsigned nloc = b.st[0], nx = b.st[1];
        if (nloc == 0u) { xcd_barrier_complete(bar, bx, nloc, nx); b.st[0] = nloc; b.st[1] = nx; }
        const unsigned old = xb_add(&bar[XB_XSUB(bx)], 1u);
        const unsigned gen = old / nloc;
        if (old + 1u == (gen + 1u) * nloc) {
            __builtin_amdgcn_fence(__ATOMIC_RELEASE, "agent");
            asm volatile("s_waitcnt vmcnt(0)" ::: "memory");
            const unsigned og = xb_add(&bar[XB_TOP], 1u);
            const unsigned tg = og / nx;
            if (og + 1u == (tg + 1u) * nx) xb_add(&bar[XB_TOPGEN], 1u);
            else XB_SPIN(xb_ld(&bar[XB_TOPGEN]) == tg, bar);
            __builtin_amdgcn_fence(__ATOMIC_ACQUIRE, "agent");
            xb_add(&bar[XB_XGEN(bx)], 1u);
            asm volatile("s_waitcnt vmcnt(0)" ::: "memory");
        } else {
            XB_SPIN(xb_ld(&bar[XB_XGEN(bx)]) == gen, bar);
            __builtin_amdgcn_fence(__ATOMIC_ACQUIRE, "agent");
            asm volatile("s_waitcnt vmcnt(0)" ::: "memory");
        }
    }
    __syncthreads();
}
#ifndef DUP_MASK
#define DUP_MASK 0
#endif
#define DUP(kind) (((DUP_MASK) >> (kind)) & 1)
#ifndef DUPR_MASK
#define DUPR_MASK 0
#endif
#define DUPR(kind) (((DUPR_MASK) >> (kind)) & 1)
#ifndef DUPR_MODE
#define DUPR_MODE 0
#endif
#ifndef MK_PER_PHASE
#define MK_PER_PHASE 0
#endif

constexpr size_t MiB = 1u << 20;
constexpr size_t WS_CTL = 0, CTL_ZERO_BYTES = 1 * MiB;
constexpr size_t WS_ROPE = 1 * MiB;
constexpr size_t WS_LB = 1 * MiB + 256 * 1024;
constexpr size_t WS_DST = 1 * MiB + 512 * 1024;
constexpr size_t WS_SSQ = 2 * MiB;
constexpr size_t WS_WTE = 3 * MiB;
constexpr size_t WS_WTO = 25 * MiB;
constexpr size_t WS_XB = 38 * MiB;
constexpr size_t WS_R0 = 70 * MiB, RSZ = 32 * MiB;
constexpr size_t WS_END = WS_R0 + 6 * RSZ;
constexpr int CW_BAR = 4096;

constexpr int RING_BYTES = 139264;
constexpr int LDSCTL_OFF = RING_BYTES + 8 * pg8::EPI_STG_WAVE, MISC_OFF = LDSCTL_OFF + 320;
constexpr int LDS_BYTES = 163840;
constexpr int NWAVES = 8, GRID = 256;
constexpr int NPH = 20;

struct Frame {
    LAS unsigned char* lds; volatile LAS unsigned* MISC; gu32* ctl;
    int tid, lane, wave, vcu, G;
};

__device__ __forceinline__ void transpose_item(const float* W, const float* sc, int K, int N, bf16* WT, LAS float* scr, int item, int lane) {
    const int nblk = N / 32, kb = item / nblk, nb = item % nblk, k0 = 64 * kb, n0 = 32 * nb;
    const int c4 = lane & 7, rk = lane >> 3;
#pragma unroll
    for (int i = 0; i < 8; ++i) { const int kk = 8 * i + rk; const float s = sc ? sc[k0 + kk] : 1.0f;
        f32x4 v = *(const GAS f32x4*)(W + (size_t)(k0 + kk) * N + n0 + 4 * c4); v = v * s; *(LAS f32x4*)(scr + kk * 36 + 4 * c4) = v; }
    LDS_WAIT(); asm volatile("" ::: "memory");
    const int c = lane & 7;
#pragma unroll
    for (int j = 0; j < 4; ++j) { const int n = (lane >> 3) + 8 * j; const LAS float* s = scr + (8 * c) * 36 + n;
        v4u o; o.x = pk2(s[0 * 36], s[1 * 36]); o.y = pk2(s[2 * 36], s[3 * 36]); o.z = pk2(s[4 * 36], s[5 * 36]); o.w = pk2(s[6 * 36], s[7 * 36]);
        *(GAS v4u*)(WT + (size_t)(n0 + n) * K + k0 + 8 * c) = o; }
    LDS_WAIT(); asm volatile("" ::: "memory");
}
__device__ __forceinline__ void convert_layer(Frame& F, const float* Win, const float* nrm, int Nin, const float* Wout, bf16* dstbuf) {
    int lane = F.lane; asm volatile("" : "+v"(lane));
    LAS float* scr = (LAS float*)(F.lds + F.wave * 16384);
    const int gw = F.vcu * NWAVES + F.wave, NGW = F.G * NWAVES;
    const int I_in = (DM / 64) * (Nin / 32), I_out = (DIN / 64) * (DM / 32);
    bf16* wout_t = dstbuf + (size_t)Nin * DM;
    for (int it = gw; it < I_in + I_out; it += NGW) {
        if (it < I_in) transpose_item(Win, nrm, DM, Nin, dstbuf, scr, it, lane);
        else transpose_item(Wout, nullptr, DIN, DM, wout_t, scr, it - I_in, lane);
    }
}
__device__ __forceinline__ float wave_sum(float v) {
#pragma unroll
    for (int o = 1; o < 64; o <<= 1) v += __shfl_xor(v, o);
    return v;
}

__device__ __forceinline__ void stagger(int vcu, unsigned ticks) {
    if (vcu & 1) { const unsigned long long t0 = __builtin_amdgcn_s_memrealtime(); while (__builtin_amdgcn_s_memrealtime() - t0 < ticks) __builtin_amdgcn_s_sleep(8); }
}
#ifndef STAG_EVEN
#define STAG_EVEN 0
#endif
#ifndef STAG_ODD
#define STAG_ODD 0
#endif
struct Args { const float* in[13]; float* out; unsigned char* ws; int ph_lo, ph_hi; };

__global__ void __launch_bounds__(NWAVES * 64, 2) mk_fwd(Args args) {
    extern __shared__ __attribute__((aligned(16))) unsigned char lds[];
    Frame F;
    F.lds = (LAS unsigned char*)lds;
    F.MISC = (volatile LAS unsigned*)(F.lds + MISC_OFF);
    F.tid = threadIdx.x; F.lane = F.tid & 63; F.wave = __builtin_amdgcn_readfirstlane(F.tid >> 6);
    F.G = gridDim.x; { const int bx = blockIdx.x; F.vcu = (F.G % 8 == 0) ? (bx % 8) * (F.G / 8) + bx / 8 : bx; }
    unsigned char* ws = args.ws;
    F.ctl = (gu32*)(ws + WS_CTL);
    for (int u = F.tid; u < (LDS_BYTES - LDSCTL_OFF) / 4; u += NWAVES * 64) ((LAS unsigned*)(F.lds + LDSCTL_OFF))[u] = 0u;
    __syncthreads();
    const int lo = args.ph_lo, hi = args.ph_hi; (void)lo; (void)hi;
    const bool multi = MK_PER_PHASE ? ((hi - lo) > 1) : true;
    XcdBarrier bar; bar.bar = (unsigned*)(F.ctl + CW_BAR); bar.x = 0; bar.st = nullptr;
    if (multi) bar = xcd_barrier_post((unsigned*)(F.ctl + CW_BAR), F.MISC + 8);
#ifndef PHASE_MASK
#define PHASE_MASK 0xFFFF
#endif
#if MK_PER_PHASE
#define INK(kind, k) ((((PHASE_MASK) >> (kind)) & 1) && lo <= (k) && (k) < hi)
#define IN(k) (lo <= (k) && (k) < hi)
#else
#define INK(kind, k) (((PHASE_MASK) >> (kind)) & 1)
#define IN(k) true
#endif
#if MK_PER_PHASE
#define SEAM(k) do { if (IN(k) && IN((k) + 1)) xcd_barrier(bar); } while (0)
#else
#define SEAM(k) do { xcd_barrier(bar); if (DUP(9)) xcd_barrier(bar); } while (0)
#endif

#define PTRS() size_t wz_ = 0; asm volatile("" : "+s"(wz_)); unsigned char* wsl = args.ws + wz_; \
    const float* x_in = args.in[0]; float* xres = args.out; \
    float* rope = (float*)(wsl + WS_ROPE); float* lbt = (float*)(wsl + WS_LB); float* dstv = (float*)(wsl + WS_DST); float* ssq = (float*)(wsl + WS_SSQ); \
    bf16* wte = (bf16*)(wsl + WS_WTE); bf16* wto = (bf16*)(wsl + WS_WTO); bf16* xb = (bf16*)(wsl + WS_XB); float* ust = args.out;     \
    unsigned char* R0 = wsl + WS_R0; unsigned char* R1 = R0 + RSZ; unsigned char* R2 = R1 + RSZ; unsigned char* R3 = R2 + RSZ; unsigned char* R4 = R3 + RSZ; unsigned char* R5 = R4 + RSZ; \
    const int gw = F.vcu * NWAVES + F.wave, NGW = F.G * NWAVES; int tidl = threadIdx.x; asm volatile("" : "+v"(tidl)); const int lanel = tidl & 63; (void)lanel; \
    (void)x_in; (void)xres; (void)rope; (void)lbt; (void)dstv; (void)ssq; (void)wte; (void)wto; (void)xb; (void)ust; (void)R0; (void)R1; (void)R2; (void)R3; (void)R4; (void)R5; (void)gw; (void)NGW;

    for (int rep_ = 0; rep_ < (DUP(0) ? 2 : 1); ++rep_)
    if (INK(0, 0)) {
        PTRS();
        convert_layer(F, args.in[2], args.in[1], EVEN_IN, args.in[7], wte);
        convert_layer(F, args.in[9], args.in[8], ODD_IN, args.in[11], wto);
        {
            const int gt = F.vcu * (NWAVES * 64) + tidl, NGT = F.G * NWAVES * 64;
            for (int e = gt; e < SEQ * 8; e += NGT) { const int pos = e >> 3, i = e & 7; const double inv = pow(500000.0, -(double)i / 8.0); const double ang = (double)pos * inv;
                rope[e] = (float)cos(ang); rope[SEQ * 8 + e] = (float)sin(ang); }
            const float* lg = args.in[6];
            for (int e = gt; e < 2 * 1024; e += NGT) { const int dir = e >> 10, c = e & 1023; const float l0 = lg[(dir * 2 + 0) * 1024 + c], l1 = lg[(dir * 2 + 1) * 1024 + c];
                lbt[e] = 0.0f; lbt[2048 + e] = 1.0f / (1.0f + expf(l0 - l1)); }
        }
        for (int m = gw; m < T; m += NGW) {
            const GAS f32x4* xr = (const GAS f32x4*)(x_in + (size_t)m * DM) + lanel; f32x4 v[4]; float s = 0.f;
#pragma unroll
            for (int j = 0; j < 4; ++j) { v[j] = xr[64 * j]; s += (v[j].x * v[j].x + v[j].y * v[j].y) + (v[j].z * v[j].z + v[j].w * v[j].w); }
            s = wave_sum(s);
            GAS unsigned long long* o8 = (GAS unsigned long long*)(xb + (size_t)m * DM) + lanel;
#pragma unroll
            for (int j = 0; j < 4; ++j) o8[64 * j] = (unsigned long long)pk2(v[j].x, v[j].y) | ((unsigned long long)pk2(v[j].z, v[j].w) << 32);
            if (lanel < 16) ssq[(size_t)m * 16 + lanel] = (lanel == 0) ? s : 0.0f;
        }
    }
    SEAM(0);

#pragma unroll 1
    for (int layer = 0; layer < 4; ++layer) {
        const int j = layer >> 1; const bool even = (layer & 1) == 0;
        const int pb = 1 + (layer >> 1) * 9 + (even ? 0 : 6);
        if (even) {
            const float lam_init = (j == 0) ? 0.2f : 0.470713018f;
            if (INK(1, pb + 0)) {
        PTRS();
                pg8::Gemm g{xb, wte, T, 4096, DM, DM, 1 << 30, 0l}; pg8::StaticOrder S; S.init(T, 4096, F.G, (int)blockIdx.x);
                pg8::EpiIn<true> E{ssq, rope, lbt + j * 2048, R0, R1, R2, R3, R4, R5, 0};
                if (DUP(1)) { pg8::EpiDry ED; pg8::gemm_phase(F.lds, g, S, ED); }
                if (DUPR(1)) { pg8::EpiIn<true, DUPR_MODE> E2{ssq, rope, lbt + j * 2048, R0, R1, R2, R3, R4, R5, 0}; pg8::gemm_phase(F.lds, g, S, E2); }
                if (STAG_EVEN) stagger(F.vcu, STAG_EVEN);
                pg8::gemm_phase(F.lds, g, S, E);
            }
            SEAM(pb + 0);
            if (INK(2, pb + 1)) {
        PTRS();
                if (layer == 2) { convert_layer(F, args.in[9] + (size_t)DM * ODD_IN, args.in[8] + DM, ODD_IN, args.in[11] + (size_t)DIN * DM, wto); __syncthreads(); }
                const float* lq = args.in[3] + j * 256; float s1 = 0.f, s2 = 0.f;
                for (int i = 0; i < 64; ++i) { s1 += lq[i] * lq[64 + i]; s2 += lq[128 + i] * lq[192 + i]; }
                const float lam = expf(s1) - expf(s2) + lam_init;
                if (DUP(2)) for (int i = 0; i < 4; ++i) { const int bh = (F.vcu >> 5) * 4 + i, qb = F.vcu & 31;
                    att::diff_attn_unit<true, DUPR_MODE>(bh >> 3, bh & 7, qb, (const att::u16*)R0, (const att::u16*)R1, (const att::u16*)R2, (const att::u16*)R3, (att::u16*)R0,
                                        args.in[4] + j * 128, lam, 1.0f - lam_init, (char*)lds); }
                for (int i = 0; i < 4; ++i) { const int bh = (F.vcu >> 5) * 4 + i, qb = F.vcu & 31;
                    att::diff_attn_unit<false>(bh >> 3, bh & 7, qb, (const att::u16*)R0, (const att::u16*)R1, (const att::u16*)R2, (const att::u16*)R3, (att::u16*)R0,
                                        args.in[4] + j * 128, lam, 1.0f - lam_init, (char*)lds); }
            }
            SEAM(pb + 1);
            if (INK(1, pb + 2)) {
        PTRS();
                pg8::Gemm g{xb, wte + (size_t)4096 * DM, T, 5120, DM, DM, 1 << 30, 0l}; pg8::StaticOrder S; S.init(T, 5120, F.G, (int)blockIdx.x);
                pg8::EpiIn<true> E{ssq, rope, lbt + j * 2048, R0, R1, R2, R3, R4, R5, 16};
                if (DUP(1)) { pg8::EpiDry ED; pg8::gemm_phase(F.lds, g, S, ED); }
                if (DUPR(1)) { pg8::EpiIn<true, DUPR_MODE> E2{ssq, rope, lbt + j * 2048, R0, R1, R2, R3, R4, R5, 16}; pg8::gemm_phase(F.lds, g, S, E2); }
                if (STAG_EVEN) stagger(F.vcu, STAG_EVEN);
                pg8::gemm_phase(F.lds, g, S, E);
            }
            SEAM(pb + 2);
            if (INK(3, pb + 3)) {
        PTRS();
                if (DUP(3)) for (int it = F.vcu; it < 512; it += F.G) hg::hgrn_pass1(it, (const att::u16*)R2, (const att::u16*)R4, (const att::u16*)R5, ust, dstv, (char*)lds);
                for (int it = F.vcu; it < 512; it += F.G) hg::hgrn_pass1(it, (const att::u16*)R2, (const att::u16*)R4, (const att::u16*)R5, ust, dstv, (char*)lds);
            }
            SEAM(pb + 3);
            if (INK(4, pb + 4)) {
        PTRS();
                if (DUP(4)) for (int it = F.vcu; it < 256; it += F.G) hg::hgrn_pass2<true, DUPR_MODE>(it, (const att::u16*)R1, (const att::u16*)R2, (const att::u16*)R4, (const att::u16*)R5, (const att::u16*)R3,
                                                                        (att::u16*)R4, (att::u16*)R1, ust, dstv, args.in[5] + j * 128, (char*)lds);
                for (int it = F.vcu; it < 256; it += F.G) hg::hgrn_pass2<false>(it, (const att::u16*)R1, (const att::u16*)R2, (const att::u16*)R4, (const att::u16*)R5, (const att::u16*)R3,
                                                                        (att::u16*)R4, (att::u16*)R1, ust, dstv, args.in[5] + j * 128, (char*)lds);
            }
            SEAM(pb + 4);
            if (INK(5, pb + 5)) {
        PTRS();
                pg8::Gemm g{(const bf16*)R0, wte + (size_t)EVEN_IN * DM, T, DM, DIN, DM, 16, (long)RSZ - 2048l}; pg8::StaticOrder S; S.init(T, DM, F.G, (int)blockIdx.x);
                if (DUP(5)) { pg8::EpiDry ED; pg8::gemm_phase(F.lds, g, S, ED); }
                if (layer == 0) { pg8::EpiOut<true, false> E{x_in, xres, xb, ssq}; pg8::gemm_phase(F.lds, g, S, E); }
                else            { pg8::EpiOut<false, false> E{x_in, xres, xb, ssq}; pg8::gemm_phase(F.lds, g, S, E); }
            }
            SEAM(pb + 5);
        } else {
            if (INK(6, pb + 0)) {
        PTRS();
                pg8::Gemm g{xb, wto, T, ODD_IN, DM, DM, 1 << 30, 0l}; pg8::StaticOrder S; S.init(T, ODD_IN, F.G, (int)blockIdx.x);
                pg8::EpiIn<false> E{ssq, rope, nullptr, R0, R1, R2, R3, R4, R5, 0};
                if (DUP(6)) { pg8::EpiDry ED; pg8::gemm_phase(F.lds, g, S, ED); }
                if (DUPR(6)) pg8::gemm_phase(F.lds, g, S, E);
                if (STAG_ODD) stagger(F.vcu, STAG_ODD);
                pg8::gemm_phase(F.lds, g, S, E);
            }
            SEAM(pb + 0);
            if (INK(7, pb + 1)) {
        PTRS();
                if (layer == 1) { convert_layer(F, args.in[2] + (size_t)DM * EVEN_IN, args.in[1] + DM, EVEN_IN, args.in[7] + (size_t)DIN * DM, wte); __syncthreads(); }
                if (DUP(7)) att::swa_phase<true>(2 * F.vcu, (const att::u16*)R0, (const att::u16*)R2, (const att::u16*)(R2 + (size_t)T * 256 * 2), (const att::u16*)R3, (att::u16*)R0, args.in[10] + j * 32, (char*)lds);
                att::swa_phase<false>(2 * F.vcu, (const att::u16*)R0, (const att::u16*)R2, (const att::u16*)(R2 + (size_t)T * 256 * 2), (const att::u16*)R3, (att::u16*)R0, args.in[10] + j * 32, (char*)lds);
            }
            SEAM(pb + 1);
            if (INK(5, pb + 2)) {
        PTRS();
                pg8::Gemm g{(const bf16*)R0, wto + (size_t)ODD_IN * DM, T, DM, DIN, DIN, 1 << 30, 0l}; pg8::StaticOrder S; S.init(T, DM, F.G, (int)blockIdx.x);
                if (DUP(5)) { pg8::EpiDry ED; pg8::gemm_phase(F.lds, g, S, ED); }
                if (layer == 3) { pg8::EpiOut<false, true> E{x_in, xres, xb, ssq}; pg8::gemm_phase(F.lds, g, S, E); }
                else            { pg8::EpiOut<false, false> E{x_in, xres, xb, ssq}; pg8::gemm_phase(F.lds, g, S, E); }
            }
            SEAM(pb + 2);
        }
    }
    if (INK(8, 19)) {
        PTRS();
        const float* fw = args.in[12];
        for (int m = gw; m < T; m += NGW) {
            GAS f32x4* xr = (GAS f32x4*)(xres + (size_t)m * DM) + lanel; f32x4 v[4]; float s = 0.f;
#pragma unroll
            for (int jj = 0; jj < 4; ++jj) { v[jj] = xr[64 * jj]; s += (v[jj].x * v[jj].x + v[jj].y * v[jj].y) + (v[jj].z * v[jj].z + v[jj].w * v[jj].w); }
            s = wave_sum(s); const float rs = 1.0f / sqrtf(s * (1.0f / DM) + EPS);
#pragma unroll
            for (int jj = 0; jj < 4; ++jj) { const f32x4 w = *((const f32x4*)fw + lanel + 64 * jj); xr[64 * jj] = v[jj] * rs * w; }
        }
    }
#undef IN
#undef INK
#undef SEAM
}

extern "C" void kernel_launch(void* const* d_in, const int* in_sizes, int n_in, void* d_out, int out_size, void* d_ws, size_t ws_size, hipStream_t stream) {
    static int ok = 0;
    if (ok == 0) {
        if (n_in != 13 || in_sizes[0] != T * DM || out_size != T * DM || ws_size < WS_END) { fprintf(stderr, "kernel_launch: shape/workspace mismatch (n_in %d, ws %zu, need %zu)\n", n_in, ws_size, (size_t)WS_END); ok = -1; return; }
        if (hipFuncSetAttribute((const void*)mk_fwd, hipFuncAttributeMaxDynamicSharedMemorySize, LDS_BYTES) != hipSuccess) { fprintf(stderr, "kernel_launch: hipFuncSetAttribute failed\n"); ok = -1; return; }
        int per_cu = 0;
        if (hipOccupancyMaxActiveBlocksPerMultiprocessor(&per_cu, (const void*)mk_fwd, NWAVES * 64, LDS_BYTES) != hipSuccess || per_cu < 1) fprintf(stderr, "kernel_launch: occupancy query reports %d\n", per_cu);
        (void)hipGetLastError();
        ok = 1;
    }
    if (ok < 0) return;
    (void)hipMemsetAsync((char*)d_ws + WS_CTL, 0, CTL_ZERO_BYTES, stream);
    Args a{};
    for (int i = 0; i < 13; ++i) a.in[i] = (const float*)d_in[i];
    a.out = (float*)d_out; a.ws = (unsigned char*)d_ws;
#if MK_PER_PHASE
    for (int p = 0; p < NPH; ++p) { a.ph_lo = p; a.ph_hi = p + 1; hipLaunchKernelGGL(mk_fwd, dim3(GRID), dim3(NWAVES * 64), LDS_BYTES, stream, a); }
#else
    a.ph_lo = 0; a.ph_hi = NPH;
    hipLaunchKernelGGL(mk_fwd, dim3(GRID), dim3(NWAVES * 64), LDS_BYTES, stream, a);
#endif
    const hipError_t le = hipPeekAtLastError();
    if (le != hipSuccess) fprintf(stderr, "kernel_launch: launch failed: %s\n", hipGetErrorName(le));
}
```

```cpp
#define DUP_MASK 0
#define DUPR_MASK 0
#define STAG_EVEN 0
#define STAG_ODD 0
#define DUPR_MODE 0
#include <hip/hip_runtime.h>
#include <hip/hip_bf16.h>
#include <cstdio>
#include <cstdint>

constexpr int NB = 4, SEQ = 4096, DM = 1024, T = NB * SEQ;
constexpr int EVEN_IN = 9216, ODD_IN = 4608, DIN = 2048;
constexpr float EPS = 1e-6f;
constexpr float C2 = 0.125f * 1.4426950408889634f;
constexpr float LOG2E = 1.4426950408889634f;

namespace pg8 {
#define PG8_LAS __attribute__((address_space(3)))
typedef unsigned short bf16_t;
typedef short bf16x8 __attribute__((ext_vector_type(8)));
typedef float f32x4 __attribute__((ext_vector_type(4)));
typedef unsigned u32x4 __attribute__((ext_vector_type(4)));
constexpr int BM = 256, BK = 64, HALF = 128, HTB = HALF * BK * 2, STAGE_BYTES = 8 * HTB, NXCD = 8, WGM = 8;
constexpr int EPI_STG_OFF = 139264, EPI_STG_RS = 144, EPI_STG_WAVE = 16 * EPI_STG_RS;

__host__ __device__ __forceinline__ int lds_byte(int r, int c) { const int st = (r >> 4) * 2 + (c >> 5), rr = r & 15, cc = c & 31, ob = rr * 64 + cc * 2; return st * 1024 + (ob ^ (((ob >> 9) & 1) << 5)); }
__host__ __device__ __forceinline__ void stage_rc(int b, int& R, int& C) { const int st = b / 1024, sb = b % 1024, swz = sb ^ (((sb >> 9) & 1) << 5); R = (st >> 1) * 16 + swz / 64; C = (st & 1) * 32 + (swz % 64) / 2; }
__host__ __device__ __forceinline__ int perm32(int rho) { const int n = rho >> 4, i = rho & 15; return 8 * (i >> 2) + 4 * n + (i & 3); }

struct Unit { int pm, pn; };
struct Gemm { const bf16_t* A; const bf16_t* Bt; int M, N, K, lda, ksplit; long jump; };

struct StaticOrder {
    int nM, nN, nwg, G, c;
    __host__ __device__ void init(int M, int N, int G_, int c_) { nM = M / BM; nN = N / BM; nwg = nM * nN; G = G_; c = c_; }
    __host__ __device__ bool next(int i, Unit& u) const {
        const long L = (long)i * G + c; if (L >= nwg) return false;
        int wgid = (int)L; { const int q = nwg / NXCD, r = nwg % NXCD, xcd = wgid % NXCD, off = wgid / NXCD; wgid = (xcd < r ? xcd * (q + 1) : r * (q + 1) + (xcd - r) * q) + off; }
        const int nig = WGM * nN, gid = wgid / nig, fm = gid * WGM, gsz = (nM - fm) < WGM ? (nM - fm) : WGM;
        u.pm = fm + ((wgid % nig) % gsz); u.pn = (wgid % nig) / gsz; return true;
    }
};

__device__ __forceinline__ unsigned cvt_pk_bf16(float lo, float hi) { unsigned r; asm volatile("v_cvt_pk_bf16_f32 %0, %1, %2" : "=v"(r) : "v"(lo), "v"(hi)); return r; }

template <class Epi>
__device__ __forceinline__ void gemm_phase(PG8_LAS unsigned char* lds, const Gemm g, const StaticOrder& S, const Epi& E) {
    int tid = threadIdx.x; asm volatile("" : "+v"(tid));
    const int wid = __builtin_amdgcn_readfirstlane(tid >> 6), lane = tid & 63, wr = wid >> 2, wc = wid & 3, fr = lane & 15, fq = lane >> 4;
    const int K = g.K, nt = K / BK, lda = g.lda;
    unsigned voffA[2], voffB[2];
#pragma unroll
    for (int i = 0; i < 2; ++i) { int R, C; stage_rc(tid * 16 + i * 8192, R, C); const int Rb = 64 * (R >> 5) + perm32(R & 31);
        voffA[i] = (unsigned)(R * lda + C) * 2u; voffB[i] = (unsigned)(Rb * K + C) * 2u; }
    const size_t kstep = (size_t)(BK * 2);
    const size_t hstepA = (size_t)HALF * lda * 2, tstepA = 2 * hstepA;
    const size_t hstepB = (size_t)32 * K * 2, tstepB = (size_t)BM * K * 2;
    const unsigned ldsw = (unsigned)wid * 1024u;
    const int aoff = lds_byte(wr * 64 + fr, fq * 8), boff = lds_byte(wc * 32 + fr, fq * 8);
    const int ksplit = g.ksplit; const long jump = g.jump;
#define PG8_AP(base, t) ((base) + (size_t)(t) * kstep + (((t) >= ksplit) ? jump : 0l))
#define PG8_SA(b, h) (((b) * 2 + (h)) * HTB)
#define PG8_SB(b, h) ((4 + (b) * 2 + (h)) * HTB)
#define PG8_STAGE(bufoff, gbase, voff) do { _Pragma("unroll") for (int _i = 0; _i < 2; ++_i) \
        __builtin_amdgcn_global_load_lds((const unsigned*)((const char*)(gbase) + (voff)[_i]), (PG8_LAS unsigned*)(lds + (bufoff) + ldsw + _i * 8192), 16, 0, 0); } while (0)
#define PG8_LDA(dst, b, h) do { _Pragma("unroll") for (int m = 0; m < 4; ++m) _Pragma("unroll") for (int k = 0; k < 2; ++k) dst[m][k] = *(const PG8_LAS bf16x8*)(lds + PG8_SA(b, h) + aoff + m * 2048 + k * 1024); } while (0)
#define PG8_LDB(dst, b, h) do { _Pragma("unroll") for (int n = 0; n < 2; ++n) _Pragma("unroll") for (int k = 0; k < 2; ++k) dst[n][k] = *(const PG8_LAS bf16x8*)(lds + PG8_SB(b, h) + boff + n * 2048 + k * 1024); } while (0)
#define PG8_MMA(ai, bj, At, Bt) do { __builtin_amdgcn_s_setprio(1); _Pragma("unroll") for (int m = 0; m < 4; ++m) _Pragma("unroll") for (int n = 0; n < 2; ++n) _Pragma("unroll") for (int k = 0; k < 2; ++k) \
        acc[ai][bj][m][n] = __builtin_amdgcn_mfma_f32_16x16x32_bf16(Bt[n][k], At[m][k], acc[ai][bj][m][n], 0, 0, 0); __builtin_amdgcn_s_setprio(0); } while (0)
#define PG8_WAIT_V(n) asm volatile("s_waitcnt vmcnt(" #n ")" ::: "memory")
#define PG8_WAIT_L(n) asm volatile("s_waitcnt lgkmcnt(" #n ")" ::: "memory")
#define PG8_BAR __builtin_amdgcn_s_barrier()
#define PG8_SCHED __builtin_amdgcn_sched_barrier(0)
    Unit cur, nxt; int ui = 0;
    if (!S.next(0, cur)) return;
    f32x4 acc[2][2][4][2];
#pragma unroll
    for (int a = 0; a < 2; ++a)
#pragma unroll
        for (int b = 0; b < 2; ++b)
#pragma unroll
            for (int m = 0; m < 4; ++m)
#pragma unroll
                for (int n = 0; n < 2; ++n) acc[a][b][m][n] = (f32x4){0.f, 0.f, 0.f, 0.f};
    bf16x8 At[4][2], B0[2][2], B1[2][2];
    const char* cA = (const char*)g.A + (size_t)cur.pm * tstepA; const char* cB = (const char*)g.Bt + (size_t)cur.pn * tstepB;
    {
        PG8_STAGE(PG8_SB(0, 0), cB, voffB); PG8_STAGE(PG8_SB(0, 1), cB + hstepB, voffB); PG8_STAGE(PG8_SA(0, 0), cA, voffA); PG8_STAGE(PG8_SA(0, 1), cA + hstepA, voffA);
        if (wr == 1) PG8_BAR;
        PG8_WAIT_V(2); PG8_BAR;
        PG8_STAGE(PG8_SB(1, 0), cB + kstep, voffB); PG8_STAGE(PG8_SA(1, 0), PG8_AP(cA, 1), voffA); PG8_STAGE(PG8_SB(1, 1), cB + hstepB + kstep, voffB);
        PG8_WAIT_V(6); PG8_BAR;
    }
    for (;;) {
        const bool has_next = S.next(ui + 1, nxt);
        const char* nA = has_next ? (const char*)g.A + (size_t)nxt.pm * tstepA : cA; const char* nB = has_next ? (const char*)g.Bt + (size_t)nxt.pn * tstepB : cB;
        for (int t = 0; t < nt; t += 2) {
            const bool last = (t == nt - 2);
            const char* a1 = PG8_AP(cA, t + 1);
            const char* a2 = last ? nA : PG8_AP(cA, t + 2); const char* b2 = last ? nB : cB + (size_t)(t + 2) * kstep;
            const char* a3 = a2 + kstep; const char* b3 = b2 + kstep;
            PG8_LDB(B0, 0, 0); PG8_LDB(B1, 0, 1); PG8_SCHED; PG8_LDA(At, 0, 0); PG8_STAGE(PG8_SA(1, 1), a1 + hstepA, voffA);
            PG8_WAIT_V(8); PG8_WAIT_L(0); PG8_BAR; PG8_MMA(0, 0, At, B0); PG8_MMA(0, 1, At, B1); PG8_BAR; PG8_SCHED;
            PG8_LDA(At, 0, 1); PG8_STAGE(PG8_SB(0, 0), b2, voffB); PG8_STAGE(PG8_SB(0, 1), b2 + hstepB, voffB); PG8_STAGE(PG8_SA(0, 0), a2, voffA);
            PG8_WAIT_V(8); PG8_WAIT_L(0); PG8_BAR; PG8_MMA(1, 0, At, B0); PG8_MMA(1, 1, At, B1); PG8_BAR; PG8_SCHED;
            PG8_LDB(B0, 1, 0); PG8_LDB(B1, 1, 1); PG8_SCHED; PG8_LDA(At, 1, 0); PG8_STAGE(PG8_SA(0, 1), a2 + hstepA, voffA);
            PG8_WAIT_V(8); PG8_WAIT_L(0); PG8_BAR; PG8_MMA(0, 0, At, B0); PG8_MMA(0, 1, At, B1); PG8_BAR; PG8_SCHED;
            PG8_LDA(At, 1, 1); PG8_STAGE(PG8_SB(1, 0), b3, voffB); PG8_STAGE(PG8_SB(1, 1), b3 + hstepB, voffB); PG8_STAGE(PG8_SA(1, 0), a3, voffA);
            PG8_WAIT_V(8); PG8_WAIT_L(0); PG8_BAR; PG8_MMA(1, 0, At, B0); PG8_MMA(1, 1, At, B1); PG8_BAR; PG8_SCHED;
        }
        if (wr == 0) PG8_BAR;
        E(acc, cur, wr, wc, fr, fq, lds + EPI_STG_OFF + wid * EPI_STG_WAVE, lane);
        if (!has_next) break;
#pragma unroll
        for (int a = 0; a < 2; ++a)
#pragma unroll
            for (int b = 0; b < 2; ++b)
#pragma unroll
                for (int m = 0; m < 4; ++m)
#pragma unroll
                    for (int n = 0; n < 2; ++n) acc[a][b][m][n] = (f32x4){0.f, 0.f, 0.f, 0.f};
        cur = nxt; cA = nA; cB = nB; ++ui;
        if (wr == 1) PG8_BAR;
    }
    PG8_WAIT_V(0);
    PG8_BAR;
#undef PG8_AP
#undef PG8_SA
#undef PG8_SB
#undef PG8_STAGE
#undef PG8_LDA
#undef PG8_LDB
#undef PG8_MMA
#undef PG8_WAIT_V
#undef PG8_WAIT_L
#undef PG8_BAR
#undef PG8_SCHED
}
}
namespace pg8 {
typedef unsigned short u16;
__device__ __forceinline__ float fsigmoid(float v) { return __builtin_amdgcn_rcpf(1.0f + __expf(-v)); }
__device__ __forceinline__ unsigned pk_f16(float lo, float hi) { _Float16 a = (_Float16)lo, b = (_Float16)hi; return (unsigned)__builtin_bit_cast(unsigned short, a) | ((unsigned)__builtin_bit_cast(unsigned short, b) << 16); }


__device__ __forceinline__ void store_rows128(PG8_LAS unsigned char* stg, u16* blk  , size_t pitch, u32x4 w0, u32x4 w1, int fr, int fq, int lane) {
    *(PG8_LAS u32x4*)(stg + fr * EPI_STG_RS + fq * 16) = w0; *(PG8_LAS u32x4*)(stg + fr * EPI_STG_RS + 64 + fq * 16) = w1;
    const int rr = lane >> 3, ch = lane & 7;
    const u32x4 a = *(const PG8_LAS u32x4*)(stg + rr * EPI_STG_RS + ch * 16), b = *(const PG8_LAS u32x4*)(stg + (8 + rr) * EPI_STG_RS + ch * 16);
    *(u32x4*)(blk + (size_t)rr * pitch + ch * 8) = a; *(u32x4*)(blk + (size_t)(8 + rr) * pitch + ch * 8) = b;
}

enum { K_PLAIN = 0, K_SILU = 1, K_ROPEQ = 2, K_ROPEK = 3, K_LOGF = 4 };

template <bool EVEN, int MODE = 0> struct EpiIn {
    static constexpr bool PERM = true;
    const float* ssq;
    const float* rope;
    const float* lb;
    unsigned char* r0; unsigned char* r1; unsigned char* r2; unsigned char* r3; unsigned char* r4; unsigned char* r5;
    int pn_off;
    __device__ __forceinline__ void operator()(const f32x4 (&acc)[2][2][4][2], const Unit& u, int wr, int wc, int fr, int fq, PG8_LAS unsigned char* stg, int lane) const {
        const int gpn = u.pn + pn_off;
        int kind, pitch, colt, dir = 0; u16* outp;
        if (EVEN) {
            const int grp = gpn >> 2; colt = (gpn & 3) * 256; pitch = 1024;
            switch (grp) {
                case 0: kind = K_ROPEQ; outp = (u16*)r0; break;
                case 1: kind = K_ROPEK; outp = (u16*)r1; break;
                case 2: kind = K_PLAIN; outp = (u16*)r2; break;
                case 3: kind = K_SILU;  outp = (u16*)r3; break;
                case 4: kind = K_SILU;  outp = (u16*)r1; break;
                case 5: kind = K_LOGF;  outp = (u16*)r4; dir = 0; break;
                case 6: kind = K_LOGF;  outp = (u16*)r5; dir = 1; break;
                case 7: kind = K_PLAIN; outp = (u16*)r2; break;
                default: kind = K_SILU; outp = (u16*)r3; break;
            }
        } else {
            if (gpn < 8)       { kind = K_ROPEQ; outp = (u16*)r0; pitch = 2048; colt = gpn * 256; }
            else if (gpn == 8) { kind = K_ROPEK; outp = (u16*)r2; pitch = 256;  colt = 0; }
            else if (gpn == 9) { kind = K_PLAIN; outp = (u16*)(r2 + (size_t)T * 256 * 2); pitch = 256; colt = 0; }
            else               { kind = K_SILU;  outp = (u16*)r3; pitch = 2048; colt = (gpn - 10) * 256; }
        }
        int row0 = u.pm * BM + wr * 64 + fr; asm volatile("" : "+v"(row0));
        if (MODE == 2) kind = K_PLAIN;
        float rsv[8];
#pragma unroll
        for (int hb = 0; hb < 2; ++hb) { f32x4 sq[4];
#pragma unroll
          for (int i = 0; i < 4; ++i) sq[i] = *((const f32x4*)(ssq + (size_t)(row0 + hb * HALF + i * 16) * 16) + fq);
#pragma unroll
          for (int i = 0; i < 4; ++i) { float tot = (sq[i][0] + sq[i][1]) + (sq[i][2] + sq[i][3]); tot += __shfl_xor(tot, 16); tot += __shfl_xor(tot, 32); rsv[hb * 4 + i] = __builtin_amdgcn_rsqf(tot * (1.0f / DM) + EPS); }
          asm volatile("" ::: "memory"); }
        u16* const blk0 = outp + (size_t)(row0 - fr) * pitch + colt + wc * 64;
        if (kind == K_LOGF)        rows<K_LOGF>(acc, rsv, blk0, pitch, colt + wc * 64, dir, row0, 1.0f, fr, fq, stg, lane);
        else if (kind == K_SILU)   rows<K_SILU>(acc, rsv, blk0, pitch, 0, 0, row0, 1.0f, fr, fq, stg, lane);
        else if (kind == K_PLAIN)  rows<K_PLAIN>(acc, rsv, blk0, pitch, 0, 0, row0, 1.0f, fr, fq, stg, lane);
        else                       rows<K_ROPEQ>(acc, rsv, blk0, pitch, 0, 0, row0, (kind == K_ROPEQ) ? C2 : 1.0f, fr, fq, stg, lane);
    }
    template <int KIND>
    __device__ __forceinline__ void rows(const f32x4 (&acc)[2][2][4][2], const float (&rsv)[8], u16* blk0, int pitch, int ccol, int dir, int row0, float qs, int fr, int fq, PG8_LAS unsigned char* stg, int lane) const {
        f32x4 lbv[2][2];
        if (KIND == K_LOGF) {
#pragma unroll
            for (int bj = 0; bj < 2; ++bj) { const int c0 = ccol + bj * 32 + 8 * fq; lbv[bj][0] = *(const f32x4*)(lb + dir * 1024 + c0); lbv[bj][1] = *(const f32x4*)(lb + dir * 1024 + c0 + 4); }
        }
        f32x4 cs0, cs1, sn0, sn1, ncs0, ncs1, nsn0, nsn1;
        if (KIND == K_ROPEQ) { const int pos = row0 & (SEQ - 1); const f32x4* cp = (const f32x4*)(rope + (size_t)pos * 8); const f32x4* spn = (const f32x4*)(rope + (size_t)SEQ * 8 + (size_t)pos * 8);
            ncs0 = cp[0]; ncs1 = cp[1]; nsn0 = spn[0]; nsn1 = spn[1]; }
#pragma unroll
        for (int ai = 0; ai < 2; ++ai)
#pragma unroll
            for (int m = 0; m < 4; ++m) {
                const float rs = rsv[ai * 4 + m];
                if (KIND == K_ROPEQ) { cs0 = ncs0; cs1 = ncs1; sn0 = nsn0; sn1 = nsn1;
                    if (ai * 4 + m < 7) { const int i2 = ai * 4 + m + 1; const int pos = (row0 + (i2 >> 2) * HALF + (i2 & 3) * 16) & (SEQ - 1);
                        const f32x4* cp = (const f32x4*)(rope + (size_t)pos * 8); const f32x4* spn = (const f32x4*)(rope + (size_t)SEQ * 8 + (size_t)pos * 8);
                        ncs0 = cp[0]; ncs1 = cp[1]; nsn0 = spn[0]; nsn1 = spn[1]; } }
                u32x4 wst[2];
#pragma unroll
                for (int bj = 0; bj < 2; ++bj) {
                    f32x4 v0 = acc[ai][bj][m][0] * rs, v1 = acc[ai][bj][m][1] * rs;
                    u32x4 w;
                    if (KIND == K_LOGF) {
                        const f32x4 l0 = lbv[bj][0], l1 = lbv[bj][1];
                        float o[8];
#pragma unroll
                        for (int e = 0; e < 4; ++e) { const float f0 = l0[e] + (1.0f - l0[e]) * fsigmoid(v0[e]), f1 = l1[e] + (1.0f - l1[e]) * fsigmoid(v1[e]);
                            o[e] = fmaxf(__builtin_amdgcn_logf(f0) * 0.6931471805599453f, -30.0f); o[4 + e] = fmaxf(__builtin_amdgcn_logf(f1) * 0.6931471805599453f, -30.0f); }
                        w.x = pk_f16(o[0], o[1]); w.y = pk_f16(o[2], o[3]); w.z = pk_f16(o[4], o[5]); w.w = pk_f16(o[6], o[7]);
                    } else {
                        if (KIND == K_SILU) {
#pragma unroll
                            for (int e = 0; e < 4; ++e) { v0[e] = v0[e] * fsigmoid(v0[e]); v1[e] = v1[e] * fsigmoid(v1[e]); }
                        } else if (KIND == K_ROPEQ && bj == 0) {
                            f32x4 o0, o1;
#pragma unroll
                            for (int e = 0; e < 4; ++e) { o0[e] = __shfl_xor(v0[e], 16); o1[e] = __shfl_xor(v1[e], 16); }
                            if (fq < 2) {
                                const float sg = (fq == 0) ? -1.0f : 1.0f;
                                v0 = v0 * cs0 + (o0 * sn0) * sg; v1 = v1 * cs1 + (o1 * sn1) * sg;
                            }
                        }
                        if (KIND == K_ROPEQ) { v0 = v0 * qs; v1 = v1 * qs; }
                        w.x = cvt_pk_bf16(v0[0], v0[1]); w.y = cvt_pk_bf16(v0[2], v0[3]); w.z = cvt_pk_bf16(v1[0], v1[1]); w.w = cvt_pk_bf16(v1[2], v1[3]);
                    }
                    wst[bj] = w;
                }
                if (MODE != 1) store_rows128(stg, blk0 + (size_t)(ai * HALF + m * 16) * pitch, (size_t)pitch, wst[0], wst[1], fr, fq, lane); else asm volatile("" :: "v"(wst[0]), "v"(wst[1]));
            }
    }
};

__device__ __forceinline__ float bf_lo(unsigned w) { return __uint_as_float(w << 16); }
__device__ __forceinline__ float bf_hi(unsigned w) { return __uint_as_float(w & 0xffff0000u); }
template <bool FIRST, bool LAST> struct EpiOut {
    static constexpr bool PERM = true;
    const float* xin; float* xout; u16* xb; float* ssq;
    __device__ __forceinline__ void operator()(const f32x4 (&acc)[2][2][4][2], const Unit& u, int wr, int wc, int fr, int fq, PG8_LAS unsigned char* stg, int lane) const {
        int row0 = u.pm * BM + wr * 64 + fr; asm volatile("" : "+v"(row0));
        const int cb = u.pn * BM + wc * 64 + 8 * fq;
        f32x4 nx[2][2];
#define LOADX(dst, rw) do { _Pragma("unroll") for (int bj = 0; bj < 2; ++bj) { const size_t off = (size_t)(rw) * DM + cb + bj * 32; \
            if (FIRST) { dst[bj][0] = *(const f32x4*)(xin + off); dst[bj][1] = *(const f32x4*)(xin + off + 4); } \
            else { const u32x4 w = *(const u32x4*)(xb + off); dst[bj][0] = (f32x4){bf_lo(w.x), bf_hi(w.x), bf_lo(w.y), bf_hi(w.y)}; dst[bj][1] = (f32x4){bf_lo(w.z), bf_hi(w.z), bf_lo(w.w), bf_hi(w.w)}; } } } while (0)
        LOADX(nx, row0);
#pragma unroll
        for (int ai = 0; ai < 2; ++ai)
#pragma unroll
            for (int m = 0; m < 4; ++m) {
                const int row = row0 + ai * HALF + m * 16; float part = 0.f; u32x4 wst[2];
                f32x4 ox[2][2];
#pragma unroll
                for (int bj = 0; bj < 2; ++bj) { ox[bj][0] = nx[bj][0]; ox[bj][1] = nx[bj][1]; }
                if (ai * 4 + m < 7) { const int i2 = ai * 4 + m + 1; LOADX(nx, row0 + (i2 >> 2) * HALF + (i2 & 3) * 16); }
#pragma unroll
                for (int bj = 0; bj < 2; ++bj) {
                    const size_t off = (size_t)row * DM + cb + bj * 32;
                    const f32x4 n0 = ox[bj][0] + acc[ai][bj][m][0], n1 = ox[bj][1] + acc[ai][bj][m][1];
                    if (LAST) { *(f32x4*)(xout + off) = n0; *(f32x4*)(xout + off + 4) = n1; }
                    else {
                        u32x4 w; w.x = cvt_pk_bf16(n0[0], n0[1]); w.y = cvt_pk_bf16(n0[2], n0[3]); w.z = cvt_pk_bf16(n1[0], n1[1]); w.w = cvt_pk_bf16(n1[2], n1[3]);
                        wst[bj] = w;
                        const f32x4 r0 = (f32x4){bf_lo(w.x), bf_hi(w.x), bf_lo(w.y), bf_hi(w.y)}, r1 = (f32x4){bf_lo(w.z), bf_hi(w.z), bf_lo(w.w), bf_hi(w.w)};
                        part += (r0[0] * r0[0] + r0[1] * r0[1]) + (r0[2] * r0[2] + r0[3] * r0[3]) + (r1[0] * r1[0] + r1[1] * r1[1]) + (r1[2] * r1[2] + r1[3] * r1[3]);
                    }
                }
                if (!LAST) { part += __shfl_xor(part, 16); part += __shfl_xor(part, 32);
                    if (fq == 0) ssq[(size_t)row * 16 + u.pn * 4 + wc] = part;
                    store_rows128(stg, xb + (size_t)(row - fr) * DM + u.pn * BM + wc * 64, (size_t)DM, wst[0], wst[1], fr, fq, lane); }
            }
#undef LOADX
    }
};
struct EpiDry {
    static constexpr bool PERM = true;
    __device__ __forceinline__ void operator()(const f32x4 (&acc)[2][2][4][2], const Unit&, int, int, int, int, PG8_LAS unsigned char*, int) const {
#pragma unroll
        for (int a = 0; a < 2; ++a)
#pragma unroll
            for (int b = 0; b < 2; ++b)
#pragma unroll
                for (int m = 0; m < 4; ++m) asm volatile("" :: "v"(acc[a][b][m][0]), "v"(acc[a][b][m][1]));
    }
};
}
namespace att {
typedef unsigned short u16;
using bf16x8 = __attribute__((ext_vector_type(8))) short;
using s16x4  = __attribute__((ext_vector_type(4))) short;
using f32x16 = __attribute__((ext_vector_type(16))) float;
using f32x4  = __attribute__((ext_vector_type(4))) float;
using u32x4  = __attribute__((ext_vector_type(4))) unsigned;
#define KSWZ(row, colB) ((row) * 256 + ((colB) ^ (((row) & 7) << 4)))
#define KSWZ128(row, colB) ((row) * 128 + ((colB) ^ (((row) & 7) << 4)))
#define SBAR() __builtin_amdgcn_sched_barrier(0)
constexpr float THRL = 8.0f;
__device__ __forceinline__ int crow(int r, int hi) { return (r & 3) + 8 * (r >> 2) + 4 * hi; }
__device__ __forceinline__ unsigned cvtpk(float lo, float hi) { unsigned r; asm volatile("v_cvt_pk_bf16_f32 %0, %1, %2" : "=v"(r) : "v"(lo), "v"(hi)); return r; }
__device__ __forceinline__ bf16x8 ld8(const u16* p) { return *reinterpret_cast<const bf16x8*>(p); }
__device__ __forceinline__ float bf2f(unsigned short h) { return __uint_as_float((unsigned)h << 16); }

__device__ __forceinline__ void partialSM(f32x16& p0, f32x16& p1, float& m_reg, float& alpha) {
    float pmax = p0[0];
#pragma unroll
    for (int r = 1; r < 16; ++r) pmax = fmaxf(pmax, p0[r]);
#pragma unroll
    for (int r = 0; r < 16; ++r) pmax = fmaxf(pmax, p1[r]);
    { auto rr = __builtin_amdgcn_permlane32_swap(__float_as_uint(pmax), __float_as_uint(pmax), false, false);
      pmax = fmaxf(__uint_as_float(rr[0]), __uint_as_float(rr[1])); }
    float mn;
    if (__builtin_expect(__all(pmax - m_reg <= THRL), 1)) { mn = m_reg; alpha = 1.f; }
    else { mn = fmaxf(m_reg, pmax); alpha = __builtin_amdgcn_exp2f(m_reg - mn); m_reg = mn; }
#pragma unroll
    for (int r = 0; r < 16; ++r) { p0[r] -= mn; p1[r] -= mn; }
#pragma unroll
    for (int r = 0; r < 16; ++r) p0[r] = __builtin_amdgcn_exp2f(p0[r]);
}
__device__ __forceinline__ void finishSM(f32x16& p0, f32x16& p1, float alpha, float& l_reg, bf16x8& pa0, bf16x8& pa1, bf16x8& pa2, bf16x8& pa3) {
#pragma unroll
    for (int r = 0; r < 16; ++r) p1[r] = __builtin_amdgcn_exp2f(p1[r]);
    float ps = 0;
#pragma unroll
    for (int r = 0; r < 16; ++r) ps += p0[r];
#pragma unroll
    for (int r = 0; r < 16; ++r) ps += p1[r];
    { auto rr = __builtin_amdgcn_permlane32_swap(__float_as_uint(ps), __float_as_uint(ps), false, false);
      ps = __uint_as_float(rr[0]) + __uint_as_float(rr[1]); }
    l_reg = l_reg * alpha + ps;
#define PK4(P, BASE, OUT) do { unsigned a0 = cvtpk(P[BASE + 0], P[BASE + 1]), a1 = cvtpk(P[BASE + 2], P[BASE + 3]);   \
    unsigned b0 = cvtpk(P[BASE + 4], P[BASE + 5]), b1 = cvtpk(P[BASE + 6], P[BASE + 7]);                              \
    auto r0 = __builtin_amdgcn_permlane32_swap(a0, b0, false, false); auto r1 = __builtin_amdgcn_permlane32_swap(a1, b1, false, false); \
    u32x4 w = {r0[0], r1[0], r0[1], r1[1]}; OUT = *reinterpret_cast<bf16x8*>(&w); } while (0)
    PK4(p0, 0, pa0); PK4(p0, 8, pa1); PK4(p1, 0, pa2); PK4(p1, 8, pa3);
}
__device__ __forceinline__ void pack4(const f32x16& p0, const f32x16& p1, bf16x8& pa0, bf16x8& pa1, bf16x8& pa2, bf16x8& pa3) {
    PK4(p0, 0, pa0); PK4(p0, 8, pa1); PK4(p1, 0, pa2); PK4(p1, 8, pa3);
}
#undef PK4

template <int NCB> __device__ __forceinline__ int v_st(int k, int c) { const int kk = (k & ~0xC) | ((k & 4) << 1) | ((k & 8) >> 1); return ((kk >> 3) * NCB + (c >> 5)) * 512 + ((kk & 7) * 32 + (c & 31)) * 2; }
__device__ __forceinline__ int v_rd_base(int lane) { return ((lane & 3) << 3) | (((lane >> 2) & 3) << 6) | (((lane >> 4) & 1) << 5) | (((lane >> 5) & 1) << 8); }
template <int OFF> __device__ __forceinline__ s16x4 tr_read(int vb) { s16x4 r; asm volatile("ds_read_b64_tr_b16 %0, %1 offset:%2" : "=&v"(r) : "v"(vb), "i"(OFF) : "memory"); return r; }
#define PKF(L, H) (bf16x8){L[0], L[1], L[2], L[3], H[0], H[1], H[2], H[3]}
template <int NCB> __device__ __forceinline__ void pv_blk(f32x16& od, int vb, bf16x8 pa0, bf16x8 pa1, bf16x8 pa2, bf16x8 pa3) {
    constexpr int KS = NCB * 1024, HF = NCB * 512;
    const s16x4 l0 = tr_read<0 * KS>(vb), h0 = tr_read<0 * KS + HF>(vb), l1 = tr_read<1 * KS>(vb), h1 = tr_read<1 * KS + HF>(vb);
    const s16x4 l2 = tr_read<2 * KS>(vb), h2 = tr_read<2 * KS + HF>(vb), l3 = tr_read<3 * KS>(vb), h3 = tr_read<3 * KS + HF>(vb);
    asm volatile("s_waitcnt lgkmcnt(0)" ::: "memory"); SBAR();
    od = __builtin_amdgcn_mfma_f32_32x32x16_bf16(pa0, PKF(l0, h0), od, 0, 0, 0);
    od = __builtin_amdgcn_mfma_f32_32x32x16_bf16(pa1, PKF(l1, h1), od, 0, 0, 0);
    od = __builtin_amdgcn_mfma_f32_32x32x16_bf16(pa2, PKF(l2, h2), od, 0, 0, 0);
    od = __builtin_amdgcn_mfma_f32_32x32x16_bf16(pa3, PKF(l3, h3), od, 0, 0, 0);
}


template <int NCB> __device__ __forceinline__ int v_stn(int k, int c) { return ((k >> 3) * NCB + (c >> 5)) * 512 + ((k & 7) * 32 + (c & 31)) * 2; }
__device__ __forceinline__ float max3f(float a, float b, float c) { return fmaxf(fmaxf(a, b), c); }
__device__ __forceinline__ void fill16(f32x16& v, float x) {
#pragma unroll
    for (int r = 0; r < 16; ++r) v[r] = x;
}
template <bool FIRST>
__device__ __forceinline__ void partialSM_n(f32x16& p0, f32x16& p1, float& m_reg, f32x16& negm, float& alpha) {
    float a = max3f(p0[0], p0[1], p0[2]), b = max3f(p0[3], p0[4], p0[5]), c = max3f(p1[0], p1[1], p1[2]), d = max3f(p1[3], p1[4], p1[5]);
    a = max3f(a, p0[6], p0[7]); b = max3f(b, p0[8], p0[9]); c = max3f(c, p1[6], p1[7]); d = max3f(d, p1[8], p1[9]);
    a = max3f(a, p0[10], p0[11]); b = max3f(b, p0[12], p0[13]); c = max3f(c, p1[10], p1[11]); d = max3f(d, p1[12], p1[13]);
    a = max3f(a, p0[14], p0[15]); c = max3f(c, p1[14], p1[15]);
    float pmax = fmaxf(fmaxf(a, b), fmaxf(c, d));
    { auto rr = __builtin_amdgcn_permlane32_swap(__float_as_uint(pmax), __float_as_uint(pmax), false, false);
      pmax = fmaxf(__uint_as_float(rr[0]), __uint_as_float(rr[1])); }
    if (!FIRST && __builtin_expect(__all(pmax <= THRL), 1)) { alpha = 1.f; }
    else { const float dl = FIRST ? pmax : fmaxf(pmax, 0.f); m_reg += dl; alpha = FIRST ? 0.f : __builtin_amdgcn_exp2f(-dl);
#pragma unroll
        for (int r = 0; r < 16; ++r) { p0[r] -= dl; p1[r] -= dl; }
        fill16(negm, -m_reg); asm volatile("" : "+v"(negm)); }
#pragma unroll
    for (int r = 0; r < 16; ++r) p0[r] = __builtin_amdgcn_exp2f(p0[r]);
}
#define PKN(P, B) (u32x4){cvtpk(P[B + 0], P[B + 1]), cvtpk(P[B + 2], P[B + 3]), cvtpk(P[B + 4], P[B + 5]), cvtpk(P[B + 6], P[B + 7])}
template <bool SUM>
__device__ __forceinline__ void finishSM_n(f32x16& p0, f32x16& p1, float alpha, float& l_reg, bf16x8& pa0, bf16x8& pa1, bf16x8& pa2, bf16x8& pa3) {
#pragma unroll
    for (int r = 0; r < 16; ++r) p1[r] = __builtin_amdgcn_exp2f(p1[r]);
    if (SUM) {
        float s0 = (p0[0] + p0[1]) + (p0[2] + p0[3]), s1 = (p0[4] + p0[5]) + (p0[6] + p0[7]), s2 = (p0[8] + p0[9]) + (p0[10] + p0[11]), s3 = (p0[12] + p0[13]) + (p0[14] + p0[15]);
        float t0 = (p1[0] + p1[1]) + (p1[2] + p1[3]), t1 = (p1[4] + p1[5]) + (p1[6] + p1[7]), t2 = (p1[8] + p1[9]) + (p1[10] + p1[11]), t3 = (p1[12] + p1[13]) + (p1[14] + p1[15]);
        float ps = ((s0 + s1) + (s2 + s3)) + ((t0 + t1) + (t2 + t3));
        { auto rr = __builtin_amdgcn_permlane32_swap(__float_as_uint(ps), __float_as_uint(ps), false, false);
          ps = __uint_as_float(rr[0]) + __uint_as_float(rr[1]); }
        l_reg = l_reg * alpha + ps;
    }
    { u32x4 w = PKN(p0, 0); pa0 = *reinterpret_cast<bf16x8*>(&w); } { u32x4 w = PKN(p0, 8); pa1 = *reinterpret_cast<bf16x8*>(&w); }
    { u32x4 w = PKN(p1, 0); pa2 = *reinterpret_cast<bf16x8*>(&w); } { u32x4 w = PKN(p1, 8); pa3 = *reinterpret_cast<bf16x8*>(&w); }
}

constexpr int DA_SLOT = 32768, DA_VOFF = 16384, DA_WS = 133120, DA_STG = 65536, DA_STG_LD = 132;
__device__ __forceinline__ void qkt_da(f32x16& p0, f32x16& p1, const char* Ks, const bf16x8* qr, const f32x16& negm, int r32, int hi, int cb0) {
#pragma unroll
    for (int d0 = 0; d0 < 4; ++d0) { const int cb = cb0 + (d0 * 16 + hi * 8) * 2;
        const bf16x8 b0 = *reinterpret_cast<const bf16x8*>(Ks + KSWZ(r32, cb));
        const bf16x8 b1 = *reinterpret_cast<const bf16x8*>(Ks + KSWZ(32 + r32, cb));
        if (d0 == 0) { p0 = __builtin_amdgcn_mfma_f32_32x32x16_bf16(b0, qr[0], negm, 0, 0, 0); p1 = __builtin_amdgcn_mfma_f32_32x32x16_bf16(b1, qr[0], negm, 0, 0, 0); }
        else { p0 = __builtin_amdgcn_mfma_f32_32x32x16_bf16(b0, qr[d0], p0, 0, 0, 0); p1 = __builtin_amdgcn_mfma_f32_32x32x16_bf16(b1, qr[d0], p1, 0, 0, 0); } }
}
typedef short v4i16_t __attribute__((ext_vector_type(4)));
__device__ __forceinline__ s16x4 vtr(int addr) { return __builtin_bit_cast(s16x4, __builtin_amdgcn_ds_read_tr16_b64_v4i16((__attribute__((address_space(3))) v4i16_t*)(unsigned)addr)); }
__device__ __forceinline__ void pv_da(f32x16* o, int vb, bf16x8 pa0, bf16x8 pa1, bf16x8 pa2, bf16x8 pa3) {
    s16x4 lo[4], hi[4];
#define VADDR(i) (vb + ((i) & 3) * 512 + ((i) >> 2) * 4096)
#pragma unroll
    for (int i = 0; i < 4; ++i) { lo[i] = vtr(VADDR(i)); hi[i] = vtr(VADDR(i) + 2048); }
#pragma unroll
    for (int i = 0; i < 16; ++i) {
        const bf16x8 vf = PKF(lo[i & 3], hi[i & 3]);
        const bf16x8 pa = ((i >> 2) == 0) ? pa0 : ((i >> 2) == 1) ? pa1 : ((i >> 2) == 2) ? pa2 : pa3;
        o[i & 3] = __builtin_amdgcn_mfma_f32_32x32x16_bf16(pa, vf, o[i & 3], 0, 0, 0);
        if (i + 4 < 16) { lo[i & 3] = vtr(VADDR(i + 4)); hi[i & 3] = vtr(VADDR(i + 4) + 2048); }
    }
#undef VADDR
    __builtin_amdgcn_sched_group_barrier(0x100, 8, 0);
#pragma unroll
    for (int i = 0; i < 12; ++i) { __builtin_amdgcn_sched_group_barrier(0x008, 1, 0); __builtin_amdgcn_sched_group_barrier(0x100, 2, 0); __builtin_amdgcn_sched_group_barrier(0x002, 4, 0); }
#pragma unroll
    for (int i = 0; i < 4; ++i) { __builtin_amdgcn_sched_group_barrier(0x008, 1, 0); __builtin_amdgcn_sched_group_barrier(0x002, 4, 0); }
}
template <bool DRY, int PVAR = 0>
__device__ __forceinline__ void diff_attn_unit(int b, int h, int qb, const u16* Qa, const u16* __restrict__ Ka, const u16* __restrict__ Va, const u16* __restrict__ Ga,
                                               u16* Y, const float* __restrict__ subw, float lam, float one_m_li, char* lds) {
    int tid = threadIdx.x; asm volatile("" : "+v"(tid)); const int lane = tid & 63, r32 = lane & 31, hi = lane >> 5; const int wid = __builtin_amdgcn_readfirstlane(tid >> 6);
    const int map = wid >> 2, wq = wid & 3;
    const long rowbase = (long)b * SEQ; const int q0 = qb * 128;
    float* wsf = (float*)(lds + DA_WS) + wid * 64; float* li_l = wsf; float* al_l = wsf + 32;
    float m_reg = 0.f, l_reg = 0; f32x16 o[4] = {}; bf16x8 qr[4]; f32x16 negm = f32x16{}; asm volatile("" : "+v"(negm));
    const u16* Qw = Qa + (rowbase + q0 + wq * 32 + r32) * DM + h * 128 + map * 64 + hi * 8;
#pragma unroll
    for (int d0 = 0; d0 < 4; ++d0) qr[d0] = ld8(Qw + d0 * 16);
    const u16* Kh = Ka + rowbase * DM + h * 128; const u16* Vh = Va + rowbase * DM + h * 128;
    const int vb0 = (int)(uintptr_t)lds + DA_VOFF + v_rd_base(lane);
    const int cb0 = map * 128;
    unsigned kofs[2], vofs[2];
#pragma unroll
    for (int i = 0; i < 2; ++i) { const int pk = 2 * wid + i;
        const int row = 4 * pk + (lane >> 4), cp = lane & 15; kofs[i] = (unsigned)(row * DM + ((cp ^ (row & 7)) * 8)) * 2u;
        const int st = 2 * pk + (lane >> 5), kk = 8 * (st >> 2) + ((lane & 31) >> 2), cc = 32 * (st & 3) + 8 * (lane & 3); vofs[i] = (unsigned)(kk * DM + cc) * 2u; }
    typedef __attribute__((address_space(3))) unsigned lds_u32;
#define DMA_TILE(t, soff) do { const char* kb_ = (const char*)(Kh + (long)(t) * 64 * DM); const char* vb_ = (const char*)(Vh + (long)(t) * 64 * DM); \
    _Pragma("unroll") for (int i_ = 0; i_ < 2; ++i_) { \
        __builtin_amdgcn_global_load_lds((const unsigned*)(kb_ + kofs[i_]), (lds_u32*)(lds + (soff) + (2 * wid + i_) * 1024), 16, 0, 0); \
        __builtin_amdgcn_global_load_lds((const unsigned*)(vb_ + vofs[i_]), (lds_u32*)(lds + (soff) + DA_VOFF + (2 * wid + i_) * 1024), 16, 0, 0); } } while (0)
#define RESC(a) do { if (__any((a) < 1.f)) { if (hi == 0) al_l[r32] = (a); asm volatile("s_waitcnt lgkmcnt(0)" ::: "memory"); \
    _Pragma("unroll") for (int d = 0; d < 4; ++d) _Pragma("unroll") for (int r = 0; r < 16; ++r) o[d][r] *= al_l[crow(r, hi)]; } } while (0)
    f32x16 pA0, pA1, pB0, pB1; float alA, alB; bf16x8 pa0, pa1, pa2, pa3; constexpr int NT = SEQ / 64;
    DMA_TILE(0, 0); DMA_TILE(1, DA_SLOT); __syncthreads();
    qkt_da(pA0, pA1, lds, qr, negm, r32, hi, cb0); partialSM_n<true>(pA0, pA1, m_reg, negm, alA);
    int sp = 0, sc = DA_SLOT, sn = 2 * DA_SLOT;
#define ROT() do { const int t_ = sp; sp = sc; sc = sn; sn = t_; } while (0)
    for (int j = 1; j + 1 < NT; j += 2) {
        DMA_TILE(j + 1, sn);
        qkt_da(pB0, pB1, lds + sc, qr, negm, r32, hi, cb0);
        finishSM_n<true>(pA0, pA1, alA, l_reg, pa0, pa1, pa2, pa3);
        pv_da(o, vb0 + sp, pa0, pa1, pa2, pa3); partialSM_n<false>(pB0, pB1, m_reg, negm, alB);
        RESC(alB); __syncthreads(); ROT();
        DMA_TILE(j + 2, sn);
        qkt_da(pA0, pA1, lds + sc, qr, negm, r32, hi, cb0);
        finishSM_n<true>(pB0, pB1, alB, l_reg, pa0, pa1, pa2, pa3);
        pv_da(o, vb0 + sp, pa0, pa1, pa2, pa3); partialSM_n<false>(pA0, pA1, m_reg, negm, alA);
        RESC(alA); __syncthreads(); ROT();
    }
    qkt_da(pB0, pB1, lds + sc, qr, negm, r32, hi, cb0);
    finishSM_n<true>(pA0, pA1, alA, l_reg, pa0, pa1, pa2, pa3);
    pv_da(o, vb0 + sp, pa0, pa1, pa2, pa3); partialSM_n<false>(pB0, pB1, m_reg, negm, alB);
    RESC(alB);
    finishSM_n<true>(pB0, pB1, alB, l_reg, pa0, pa1, pa2, pa3);
    pv_da(o, vb0 + sc, pa0, pa1, pa2, pa3);
#undef DMA_TILE
#undef ROT
#undef RESC
    if (hi == 0) li_l[r32] = l_reg; asm volatile("s_waitcnt lgkmcnt(0)" ::: "memory");
    float rli[16];
#pragma unroll
    for (int r = 0; r < 16; ++r) rli[r] = __builtin_amdgcn_rcpf(li_l[crow(r, hi)]) * (map ? lam : 1.0f);
    __syncthreads();
    float* xch = (float*)lds;
    if (map == 1) {
#pragma unroll
        for (int d0 = 0; d0 < 4; ++d0)
#pragma unroll
            for (int r = 0; r < 16; ++r) xch[((wq * 4 + d0) * 16 + r) * 64 + lane] = o[d0][r] * rli[r];
    }
    __syncthreads();
    float* stg = (float*)(lds + DA_STG);
    if (map == 0) {
#pragma unroll
        for (int d0 = 0; d0 < 4; ++d0)
#pragma unroll
            for (int r = 0; r < 16; ++r) { const float dv = o[d0][r] * rli[r] - xch[((wq * 4 + d0) * 16 + r) * 64 + lane];
                stg[(wq * 32 + crow(r, hi)) * DA_STG_LD + d0 * 32 + r32] = dv; }
    }
    __syncthreads();
    {
        const int row = tid >> 2, qt = tid & 3; const float* sp = stg + row * DA_STG_LD + qt * 32;
        f32x4 dv[8]; float ss = 0.f;
#pragma unroll
        for (int g = 0; g < 8; ++g) { dv[g] = *(const f32x4*)(sp + g * 4); ss += (dv[g][0] * dv[g][0] + dv[g][1] * dv[g][1]) + (dv[g][2] * dv[g][2] + dv[g][3] * dv[g][3]); }
        ss += __shfl_xor(ss, 1); ss += __shfl_xor(ss, 2);
        const float sc2 = __builtin_amdgcn_rsqf(ss * (1.0f / 128.0f) + EPS) * one_m_li;
        const size_t goff = (size_t)(rowbase + q0 + row) * DM + h * 128 + qt * 32;
#pragma unroll
        for (int g = 0; g < 4; ++g) {
            const bf16x8 gt = ld8(Ga + goff + g * 8);
            const f32x4 w0 = *(const f32x4*)(subw + qt * 32 + g * 8), w1 = *(const f32x4*)(subw + qt * 32 + g * 8 + 4);
            const f32x4 a = dv[2 * g], c = dv[2 * g + 1];
            u32x4 w;
            w.x = cvtpk(a[0] * sc2 * w0[0] * bf2f((u16)gt[0]), a[1] * sc2 * w0[1] * bf2f((u16)gt[1]));
            w.y = cvtpk(a[2] * sc2 * w0[2] * bf2f((u16)gt[2]), a[3] * sc2 * w0[3] * bf2f((u16)gt[3]));
            w.z = cvtpk(c[0] * sc2 * w1[0] * bf2f((u16)gt[4]), c[1] * sc2 * w1[1] * bf2f((u16)gt[5]));
            w.w = cvtpk(c[2] * sc2 * w1[2] * bf2f((u16)gt[6]), c[3] * sc2 * w1[3] * bf2f((u16)gt[7]));
            if (!DRY) *(u32x4*)(Y + goff + g * 8) = w; else asm volatile("" :: "v"(w));
        }
    }
    __syncthreads();
}

constexpr int SWB_K = 0, SWB_V = 49152, SWB_WS = 98304, SWB_STG = 100352, SWB_STG_LD = 36;
__device__ __forceinline__ void swa_block_geom(int qb, int& t_lo, int& t_hi) { const int q0 = qb * 128; t_lo = (q0 >= 128 ? q0 - 128 : 0) >> 6; t_hi = (q0 + 255 < SEQ ? q0 + 255 : SEQ - 1) >> 6; }
template <int N> struct SwaRegs { bf16x8 k[N], v[N]; };
template <int N> __device__ __forceinline__ void swa_tiles_load(SwaRegs<N>& R, int b, int kvh, int t0, int nt, const u16* __restrict__ Kb, const u16* __restrict__ Vb, int tid) {
    const int sr = tid >> 3, sc = (tid & 7) * 8; const long rowbase = (long)b * SEQ;
    const u16* Kh = Kb + (rowbase + t0 * 64 + sr) * 256 + kvh * 64 + sc; const u16* Vh = Vb + (rowbase + t0 * 64 + sr) * 256 + kvh * 64 + sc;
#pragma unroll
    for (int tt = 0; tt < N; ++tt) if (tt < nt) { R.k[tt] = ld8(Kh + (long)tt * 64 * 256); R.v[tt] = ld8(Vh + (long)tt * 64 * 256); }
}
template <int N> __device__ __forceinline__ void swa_tiles_store_lds(const SwaRegs<N>& R, int t0, int nt, char* lds, int tid) {
    const int sr = tid >> 3, sc = (tid & 7) * 8, vst0 = v_stn<2>(sr, sc), kst0 = KSWZ128(sr, sc * 2);
#pragma unroll
    for (int tt = 0; tt < N; ++tt) if (tt < nt) { const int sl = (t0 + tt) % 6; *(bf16x8*)(lds + SWB_K + sl * 8192 + kst0) = R.k[tt]; *(bf16x8*)(lds + SWB_V + sl * 8192 + vst0) = R.v[tt]; }
}
template <bool DRY>
__device__ __forceinline__ void swa_block_compute(int b, int kvh, int qb, const u16* Q, const u16* __restrict__ Gt, u16* Y, const float* __restrict__ sink, char* lds, int tid) {
    const int lane = tid & 63, r32 = lane & 31, hi = lane >> 5; const int wid = __builtin_amdgcn_readfirstlane(tid >> 6);
    const int hq = kvh * 8 + wid; const long rowbase = (long)b * SEQ; const int q0 = qb * 128;
    int t_lo, t_hib; swa_block_geom(qb, t_lo, t_hib); (void)t_hib;
    float* wsf = (float*)(lds + SWB_WS) + wid * 64; float* al_l = wsf + 32;
    float* stg = (float*)(lds + SWB_STG) + wid * (32 * SWB_STG_LD);
    const int vb0 = (int)(uintptr_t)(lds + SWB_V) + v_rd_base(lane);
    const float sink2 = sink[hq] * LOG2E;
    bf16x8 qn[4];
    { const u16* Qw = Q + (rowbase + q0 + r32) * DIN + hq * 64 + hi * 8;
#pragma unroll
      for (int d0 = 0; d0 < 4; ++d0) qn[d0] = ld8(Qw + d0 * 16); }
#pragma unroll 1
    for (int sub = 0; sub < 4; ++sub) {
        const int qs = q0 + 32 * sub;
        bf16x8 qr[4];
#pragma unroll
        for (int d0 = 0; d0 < 4; ++d0) qr[d0] = qn[d0];
        if (sub < 3) { const u16* Qw = Q + (rowbase + qs + 32 + r32) * DIN + hq * 64 + hi * 8;
#pragma unroll
            for (int d0 = 0; d0 < 4; ++d0) qn[d0] = ld8(Qw + d0 * 16); }
        const int ta = ((qs >= 128 ? qs - 128 : 0) >> 6) - t_lo, tb = ((qs + 159 < SEQ ? qs + 159 : SEQ - 1) >> 6) - t_lo;
        float m_reg = sink2, l_dummy = 0.f; f32x16 o[2] = {}; f32x16 lacc, negm; fill16(lacc, 1.0f); fill16(negm, -sink2);
        const bf16x8 ones = {0x3F80, 0x3F80, 0x3F80, 0x3F80, 0x3F80, 0x3F80, 0x3F80, 0x3F80};
        bf16x8 gpre[2][2];
        { const size_t gb = (size_t)(rowbase + qs + (lane >> 1)) * DIN + hq * 64 + (lane & 1) * 16;
#pragma unroll
          for (int cbk = 0; cbk < 2; ++cbk) { gpre[cbk][0] = ld8(Gt + gb + cbk * 32); gpre[cbk][1] = ld8(Gt + gb + cbk * 32 + 8); } }
        for (int tt = ta; tt <= tb; ++tt) {
            const int k0 = (t_lo + tt) * 64, sl = (t_lo + tt) % 6;
            f32x16 p0, p1;
            const char* Ks = lds + SWB_K + sl * 8192;
#pragma unroll
            for (int d0 = 0; d0 < 4; ++d0) { const int cb = (d0 * 16 + hi * 8) * 2;
                const bf16x8 b0 = *reinterpret_cast<const bf16x8*>(Ks + KSWZ128(r32, cb));
                const bf16x8 b1 = *reinterpret_cast<const bf16x8*>(Ks + KSWZ128(32 + r32, cb));
                if (d0 == 0) { p0 = __builtin_amdgcn_mfma_f32_32x32x16_bf16(b0, qr[0], negm, 0, 0, 0); p1 = __builtin_amdgcn_mfma_f32_32x32x16_bf16(b1, qr[0], negm, 0, 0, 0); }
                else { p0 = __builtin_amdgcn_mfma_f32_32x32x16_bf16(b0, qr[d0], p0, 0, 0, 0); p1 = __builtin_amdgcn_mfma_f32_32x32x16_bf16(b1, qr[d0], p1, 0, 0, 0); } }
            if (k0 < qs - 97 || k0 + 63 > qs + 128) {
                const int base = k0 - qs - r32 + 4 * hi + 128;
#pragma unroll
                for (int r = 0; r < 16; ++r) { const int c = (r & 3) + 8 * (r >> 2); if ((unsigned)(base + c) > 256u) p0[r] = -1e30f; if ((unsigned)(base + c + 32) > 256u) p1[r] = -1e30f; }
            }
            float alpha; bf16x8 pa0, pa1, pa2, pa3;
            partialSM_n<false>(p0, p1, m_reg, negm, alpha);
            if (__any(alpha < 1.f)) { if (hi == 0) al_l[r32] = alpha; asm volatile("s_waitcnt lgkmcnt(0)" ::: "memory");
#pragma unroll
                for (int r = 0; r < 16; ++r) { const float al = al_l[crow(r, hi)]; o[0][r] *= al; o[1][r] *= al; lacc[r] *= al; } }
            finishSM_n<false>(p0, p1, alpha, l_dummy, pa0, pa1, pa2, pa3);
            {
                const int vbt = vb0 + sl * 8192; s16x4 lo[4], hi4[4];
#define VADDR2(i) (vbt + ((i) & 1) * 512 + ((i) >> 1) * 2048)
#pragma unroll
                for (int i = 0; i < 4; ++i) { lo[i] = vtr(VADDR2(i)); hi4[i] = vtr(VADDR2(i) + 1024); }
#pragma unroll
                for (int i = 0; i < 8; ++i) {
                    const bf16x8 vf = PKF(lo[i & 3], hi4[i & 3]);
                    const bf16x8 pa = ((i >> 1) == 0) ? pa0 : ((i >> 1) == 1) ? pa1 : ((i >> 1) == 2) ? pa2 : pa3;
                    o[i & 1] = __builtin_amdgcn_mfma_f32_32x32x16_bf16(pa, vf, o[i & 1], 0, 0, 0);
                    if ((i & 1) == 1) lacc = __builtin_amdgcn_mfma_f32_32x32x16_bf16(pa, ones, lacc, 0, 0, 0);
                    if (i + 4 < 8) { lo[i & 3] = vtr(VADDR2(i + 4)); hi4[i & 3] = vtr(VADDR2(i + 4) + 1024); }
                }
#undef VADDR2
            }
        }
        float rl[16];
#pragma unroll
        for (int r = 0; r < 16; ++r) rl[r] = __builtin_amdgcn_rcpf(lacc[r]);
#pragma unroll
        for (int cbk = 0; cbk < 2; ++cbk) {
#pragma unroll
            for (int r = 0; r < 16; ++r) stg[crow(r, hi) * SWB_STG_LD + r32] = o[cbk][r] * rl[r];
            asm volatile("s_waitcnt lgkmcnt(0)" ::: "memory");
            const int row = lane >> 1, hf = lane & 1; const float* sp = stg + row * SWB_STG_LD + hf * 16;
            const f32x4 a0 = *(const f32x4*)(sp), a1 = *(const f32x4*)(sp + 4), a2 = *(const f32x4*)(sp + 8), a3 = *(const f32x4*)(sp + 12);
            const size_t goff = (size_t)(rowbase + qs + row) * DIN + hq * 64 + cbk * 32 + hf * 16;
            const bf16x8 g0 = gpre[cbk][0], g1 = gpre[cbk][1];
            u32x4 w0, w1;
            w0.x = cvtpk(a0[0] * bf2f((u16)g0[0]), a0[1] * bf2f((u16)g0[1])); w0.y = cvtpk(a0[2] * bf2f((u16)g0[2]), a0[3] * bf2f((u16)g0[3]));
            w0.z = cvtpk(a1[0] * bf2f((u16)g0[4]), a1[1] * bf2f((u16)g0[5])); w0.w = cvtpk(a1[2] * bf2f((u16)g0[6]), a1[3] * bf2f((u16)g0[7]));
            w1.x = cvtpk(a2[0] * bf2f((u16)g1[0]), a2[1] * bf2f((u16)g1[1])); w1.y = cvtpk(a2[2] * bf2f((u16)g1[2]), a2[3] * bf2f((u16)g1[3]));
            w1.z = cvtpk(a3[0] * bf2f((u16)g1[4]), a3[1] * bf2f((u16)g1[5])); w1.w = cvtpk(a3[2] * bf2f((u16)g1[6]), a3[3] * bf2f((u16)g1[7]));
            if (!DRY) { *(u32x4*)(Y + goff) = w0; *(u32x4*)(Y + goff + 8) = w1; } else asm volatile("" :: "v"(w0), "v"(w1));
            asm volatile("s_waitcnt lgkmcnt(0)" ::: "memory");
        }
    }
}
template <bool DRY>
__device__ __forceinline__ void swa_phase(int u0, const u16* Q, const u16* Kb, const u16* Vb, const u16* Gt, u16* Y, const float* sink, char* lds) {
    int tid = threadIdx.x; asm volatile("" : "+v"(tid));
    const int bk = u0 >> 5, b = bk >> 2, kvh = bk & 3, qbA = u0 & 31, qbB = qbA + 1;
    int tloA, thiA, tloB, thiB; swa_block_geom(qbA, tloA, thiA); swa_block_geom(qbB, tloB, thiB);
    { SwaRegs<6> R; swa_tiles_load<6>(R, b, kvh, tloA, thiA - tloA + 1, Kb, Vb, tid); swa_tiles_store_lds<6>(R, tloA, thiA - tloA + 1, lds, tid); }
    __syncthreads();
    SwaRegs<2> N; const int nnew = thiB - thiA;
    swa_tiles_load<2>(N, b, kvh, thiA + 1, nnew, Kb, Vb, tid);
    swa_block_compute<DRY>(b, kvh, qbA, Q, Gt, Y, sink, lds, tid);
    __syncthreads();
    swa_tiles_store_lds<2>(N, thiA + 1, nnew, lds, tid);
    __syncthreads();
    swa_block_compute<DRY>(b, kvh, qbB, Q, Gt, Y, sink, lds, tid);
    __syncthreads();
}
}
namespace hg {
using namespace att;
typedef _Float16 f16;
constexpr int L_QT = 0, L_KT = 16384, L_QIN = 32768, L_KDEC = 49152, L_V = 65536, L_S = 81920, L_CUM = 114688, L_EDEC = 118784, L_STG = 0, STG_LD = 132;

struct ChunkRegs { unsigned q[8], v[8], lf[8]; };

__device__ __forceinline__ int chunk_pos(int c, int i, int dir) { return dir ? (c * 64 + 63 - i) : (c * 64 + i); }

template <bool NEEDQ>
__device__ __forceinline__ void load_chunk(ChunkRegs& R, const u16* Qh, const u16* Vh, const u16* LF, long rowbase, int colbase, int c, int dir, int wid, int lane) {
#pragma unroll
    for (int i = 0; i < 8; ++i) {
        const long pos = rowbase + chunk_pos(c, wid * 8 + i, dir);
        const size_t off = (size_t)pos * DM + colbase + 2 * lane;
        if (NEEDQ) R.q[i] = *(const unsigned*)(Qh + off);
        R.v[i] = *(const unsigned*)(Vh + off);
        R.lf[i] = *(const unsigned*)(LF + off);
    }
}
__device__ __forceinline__ float h2f(unsigned short h) { return (float)__builtin_bit_cast(f16, h); }

template <bool FULL>
__device__ __forceinline__ void prep_chunk(const ChunkRegs& R, char* lds, int wid, int lane, float (&gtot)[2]) {
    float g[8][2]; float run0 = 0.f, run1 = 0.f;
#pragma unroll
    for (int i = 0; i < 8; ++i) { run0 += h2f((unsigned short)(R.lf[i] & 0xffff)); run1 += h2f((unsigned short)(R.lf[i] >> 16)); g[i][0] = run0; g[i][1] = run1; }
    float* cum = (float*)(lds + L_CUM);
    *(float2*)(cum + wid * 128 + 2 * lane) = make_float2(run0, run1);
    __syncthreads();
    float pre0 = 0.f, pre1 = 0.f, gm0 = 0.f, gm1 = 0.f, gl0 = 0.f, gl1 = 0.f;
#pragma unroll
    for (int w2 = 0; w2 < 8; ++w2) { const float2 t = *(const float2*)(cum + w2 * 128 + 2 * lane);
        if (w2 < wid) { pre0 += t.x; pre1 += t.y; } if (w2 < 4) { gm0 += t.x; gm1 += t.y; } gl0 += t.x; gl1 += t.y; }
    gtot[0] += gl0; gtot[1] += gl1;
    const float egm0 = __expf(gm0), egm1 = __expf(gm1), elm0 = __expf(gl0 - gm0), elm1 = __expf(gl1 - gm1);
    if (wid == 0) *(float2*)((float*)(lds + L_EDEC) + 2 * lane) = make_float2(__expf(gl0), __expf(gl1));
#pragma unroll
    for (int i = 0; i < 8; ++i) {
        const int row = wid * 8 + i;
        const float G0 = pre0 + g[i][0], G1 = pre1 + g[i][1];
        const float e0 = __expf(G0 - gm0), e1 = __expf(G1 - gm1);
        const float r0 = __builtin_amdgcn_rcpf(e0), r1 = __builtin_amdgcn_rcpf(e1);
        const float lf0 = h2f((unsigned short)(R.lf[i] & 0xffff)), lf1 = h2f((unsigned short)(R.lf[i] >> 16));
        const float k0 = 1.0f - __expf(lf0), k1 = 1.0f - __expf(lf1);
        const float kt0 = k0 * r0, kt1 = k1 * r1;
        const int vo = v_st<4>(row, 2 * lane);
        *(unsigned*)(lds + L_KDEC + vo) = cvtpk(kt0 * elm0, kt1 * elm1);
        *(unsigned*)(lds + L_V + vo) = R.v[i];
        if (FULL) {
            const float q0 = bf2f((u16)(R.q[i] & 0xffff)), q1 = bf2f((u16)(R.q[i] >> 16));
            const float qt0 = q0 * e0, qt1 = q1 * e1;
            const int ko = KSWZ(row, 4 * lane);
            *(unsigned*)(lds + L_QT + ko) = cvtpk(qt0, qt1);
            *(unsigned*)(lds + L_KT + ko) = cvtpk(kt0, kt1);
            *(unsigned*)(lds + L_QIN + ko) = cvtpk(qt0 * egm0, qt1 * egm1);
        }
    }
}

template <int KS> __device__ __forceinline__ bf16x8 tr_frag(int vb) {
    const s16x4 l = tr_read<KS * 4096>(vb), h = tr_read<KS * 4096 + 2048>(vb);
    asm volatile("s_waitcnt lgkmcnt(0)" ::: "memory"); SBAR();
    return PKF(l, h);
}

struct SuFrag { s16x4 lv, hv, l0, h0, l1, h1; };
__device__ __forceinline__ void su_read(SuFrag& f, int vbV, int vbK0, int vbK1, int off) {
    f.lv = vtr(vbV + off); f.hv = vtr(vbV + off + 2048); f.l0 = vtr(vbK0 + off); f.h0 = vtr(vbK0 + off + 2048); f.l1 = vtr(vbK1 + off); f.h1 = vtr(vbK1 + off + 2048);
}
__device__ __forceinline__ void su_mma(f32x16 (&sacc)[2], const SuFrag& f) {
    const bf16x8 bv = PKF(f.lv, f.hv), a0 = PKF(f.l0, f.h0), a1 = PKF(f.l1, f.h1);
    sacc[0] = __builtin_amdgcn_mfma_f32_32x32x16_bf16(a0, bv, sacc[0], 0, 0, 0); sacc[1] = __builtin_amdgcn_mfma_f32_32x32x16_bf16(a1, bv, sacc[1], 0, 0, 0);
}
template <int NIMG>
__device__ __forceinline__ void state_update_t(f32x16 (&sacc)[2], const char* lds, int ldsbase, int offK, int offV, int offE, int wid, int lane) {
    const int hi = lane >> 5, j = wid >> 1, ib = 2 * (wid & 1);
    const float* edec = (const float*)(lds + offE);
    const int vbV = ldsbase + offV + v_rd_base(lane) + j * 512;
    const int vbK0 = ldsbase + offK + v_rd_base(lane) + ib * 512, vbK1 = vbK0 + 512;
#pragma unroll
    for (int i2 = 0; i2 < 2; ++i2)
#pragma unroll
        for (int r = 0; r < 16; ++r) sacc[i2][r] *= edec[32 * (ib + i2) + crow(r, hi)];
    SBAR();
    SuFrag fa, fb; su_read(fa, vbV, vbK0, vbK1, 0);
#pragma unroll
    for (int s = 0; s < 4 * NIMG; s += 2) {
        su_read(fb, vbV, vbK0, vbK1, ((s + 1) >> 2) * 16384 + ((s + 1) & 3) * 4096);
        su_mma(sacc, fa);
        if (s + 2 < 4 * NIMG) su_read(fa, vbV, vbK0, vbK1, ((s + 2) >> 2) * 16384 + ((s + 2) & 3) * 4096);
        su_mma(sacc, fb);
    }
    __builtin_amdgcn_sched_group_barrier(0x100, 6, 0);
#pragma unroll
    for (int s = 0; s < 4 * NIMG - 1; ++s) { __builtin_amdgcn_sched_group_barrier(0x100, 6, 0); __builtin_amdgcn_sched_group_barrier(0x008, 2, 0); }
    __builtin_amdgcn_sched_group_barrier(0x008, 2, 0);
    SBAR();
}
__device__ __forceinline__ void state_update(f32x16 (&sacc)[2], const char* lds, int ldsbase, int wid, int lane) { state_update_t<1>(sacc, lds, ldsbase, L_KDEC, L_V, L_EDEC, wid, lane); }
__device__ __forceinline__ void write_simg(const f32x16 (&sacc)[2], char* lds, int wid, int lane) {
    const int r32 = lane & 31, hi = lane >> 5, j = wid >> 1, ib = 2 * (wid & 1);
#pragma unroll
    for (int i2 = 0; i2 < 2; ++i2)
#pragma unroll
        for (int r = 0; r < 16; ++r) { const int d = 32 * (ib + i2) + crow(r, hi);
            *(__hip_bfloat16*)(lds + L_S + (d >> 6) * 16384 + v_st<4>(d & 63, 32 * j + r32)) = __float2bfloat16(sacc[i2][r]); }
}
__device__ __forceinline__ f32x16 chunk_output(const char* lds, int ldsbase, int wid, int lane) {
    const int r32 = lane & 31, hi = lane >> 5, tb = wid & 1, j = wid >> 1;
    const char* QT = lds + L_QT; const char* KT = lds + L_KT; const char* QIN = lds + L_QIN;
    f32x16 p0 = f32x16{}, p1 = f32x16{};
#pragma unroll
    for (int d0 = 0; d0 < 8; ++d0) { const int cb = (d0 * 16 + hi * 8) * 2;
        const bf16x8 qf = *reinterpret_cast<const bf16x8*>(QT + KSWZ(32 * tb + r32, cb));
        const bf16x8 k0 = *reinterpret_cast<const bf16x8*>(KT + KSWZ(r32, cb));
        p0 = __builtin_amdgcn_mfma_f32_32x32x16_bf16(k0, qf, p0, 0, 0, 0);
        if (tb) { const bf16x8 k1 = *reinterpret_cast<const bf16x8*>(KT + KSWZ(32 + r32, cb)); p1 = __builtin_amdgcn_mfma_f32_32x32x16_bf16(k1, qf, p1, 0, 0, 0); } }
#pragma unroll
    for (int r = 0; r < 16; ++r) { const bool keep = crow(r, hi) <= r32; if (tb == 0) { p0[r] = keep ? p0[r] : 0.f; p1[r] = 0.f; } else { p1[r] = keep ? p1[r] : 0.f; } }
    bf16x8 pa0, pa1, pa2, pa3; pack4(p0, p1, pa0, pa1, pa2, pa3);
    f32x16 oacc = f32x16{};
    pv_blk<4>(oacc, ldsbase + L_V + v_rd_base(lane) + j * 512, pa0, pa1, pa2, pa3);
    const int vbS = ldsbase + L_S + v_rd_base(lane) + j * 512;
#define QINF(kd) (*reinterpret_cast<const bf16x8*>(QIN + KSWZ(32 * tb + r32, ((kd) * 16 + hi * 8) * 2)))
    {
        s16x4 lo[2], hh[2];
#define SADDR(kd) (vbS + ((kd) >> 2) * 16384 + ((kd) & 3) * 4096)
        lo[0] = vtr(SADDR(0)); hh[0] = vtr(SADDR(0) + 2048); lo[1] = vtr(SADDR(1)); hh[1] = vtr(SADDR(1) + 2048);
#pragma unroll
        for (int kd = 0; kd < 8; ++kd) {
            const bf16x8 b = PKF(lo[kd & 1], hh[kd & 1]); const bf16x8 q = QINF(kd);
            oacc = __builtin_amdgcn_mfma_f32_32x32x16_bf16(q, b, oacc, 0, 0, 0);
            if (kd + 2 < 8) { lo[kd & 1] = vtr(SADDR(kd + 2)); hh[kd & 1] = vtr(SADDR(kd + 2) + 2048); }
        }
#undef SADDR
    }
#undef QINF
    return oacc;
}

constexpr int P1_KDEC = 0, P1_V = 65536, P1_CUM = 131072, P1_EDEC = 135168;
struct BlockRegs { unsigned v[32], lf[32]; };
__device__ __forceinline__ void load_block(BlockRegs& R, const u16* Vh, const u16* LF, long rowbase, int colbase, int seg, int blk, int dir, int wid, int lane) {
    unsigned voff = (unsigned)lane * 4u; asm volatile("" : "+v"(voff));
#pragma unroll
    for (int i = 0; i < 32; ++i) {
        const int p = blk * 256 + wid * 32 + i;
        const long pos = rowbase + seg * 512 + (dir ? 511 - p : p);
        const size_t roff = ((size_t)pos * DM + colbase) * 2;
        R.v[i] = *(const unsigned*)((const char*)Vh + roff + voff); R.lf[i] = *(const unsigned*)((const char*)LF + roff + voff);
    }
}
__device__ __forceinline__ void prep_block(const BlockRegs& R, char* lds, int wid, int lane, float (&gtot)[2]) {
    float run0 = 0.f, run1 = 0.f;
#pragma unroll
    for (int i = 0; i < 32; ++i) { run0 += h2f((unsigned short)(R.lf[i] & 0xffff)); run1 += h2f((unsigned short)(R.lf[i] >> 16)); }
    float* cum = (float*)(lds + P1_CUM);
    *(float2*)(cum + wid * 128 + 2 * lane) = make_float2(run0, run1);
    __syncthreads();
    float pre0 = 0.f, pre1 = 0.f, gl0 = 0.f, gl1 = 0.f;
#pragma unroll
    for (int w2 = 0; w2 < 8; ++w2) { const float2 t = *(const float2*)(cum + w2 * 128 + 2 * lane); if (w2 < wid) { pre0 += t.x; pre1 += t.y; } gl0 += t.x; gl1 += t.y; }
    gtot[0] += gl0; gtot[1] += gl1;
    if (wid == 0) *(float2*)((float*)(lds + P1_EDEC) + 2 * lane) = make_float2(__expf(gl0), __expf(gl1));
    float G0 = pre0 - gl0, G1 = pre1 - gl1;
    char* base = lds + (wid >> 1) * 16384 + (wid & 1) * 8192 + v_st<4>(0, 2 * lane);
#pragma unroll
    for (int i = 0; i < 32; ++i) {
        const float lf0 = h2f((unsigned short)(R.lf[i] & 0xffff)), lf1 = h2f((unsigned short)(R.lf[i] >> 16));
        G0 += lf0; G1 += lf1;
        const float k0 = 1.0f - __expf(lf0), k1 = 1.0f - __expf(lf1);
        const int vo = v_st<4>(i, 0);
        *(unsigned*)(base + P1_KDEC + vo) = cvtpk(k0 * __expf(-G0), k1 * __expf(-G1));
        *(unsigned*)(base + P1_V + vo) = R.v[i];
    }
}
__device__ __forceinline__ void state_update_block(f32x16 (&sacc)[2], const char* lds, int ldsbase, int wid, int lane) { state_update_t<4>(sacc, lds, ldsbase, P1_KDEC, P1_V, P1_EDEC, wid, lane); }
__device__ __forceinline__ void hgrn_pass1(int item, const u16* Vt, const u16* LF0, const u16* LF1, float* ust, float* dst, char* lds) {
    int tid = threadIdx.x; asm volatile("" : "+v"(tid)); const int lane = tid & 63; const int wid = __builtin_amdgcn_readfirstlane(tid >> 6);
    const int seg = item & 7, dir = (item >> 3) & 1, bh = item >> 4, b = bh >> 3, h = bh & 7;
    const long rowbase = (long)b * SEQ; const int colbase = h * 128; const u16* LF = dir ? LF1 : LF0;
    const int ldsbase = (int)(uintptr_t)lds;
    f32x16 sacc[2] = {}; float gtot[2] = {0.f, 0.f};
    BlockRegs R;
    load_block(R, Vt, LF, rowbase, colbase, seg, 0, dir, wid, lane);
#pragma unroll 1
    for (int blk = 0; blk < 2; ++blk) {
        prep_block(R, lds, wid, lane, gtot);
        asm volatile("" ::: "memory");
        if (blk == 0) load_block(R, Vt, LF, rowbase, colbase, seg, 1, dir, wid, lane);
        __syncthreads();
        state_update_block(sacc, lds, ldsbase, wid, lane);
    }
    float* up = ust + (size_t)item * 16384 + wid * 2048;
#pragma unroll
    for (int i2 = 0; i2 < 2; ++i2)
#pragma unroll
        for (int r = 0; r < 16; ++r) up[(i2 * 16 + r) * 64 + lane] = sacc[i2][r];
    if (wid == 0) *(float2*)(dst + (size_t)item * 128 + 2 * lane) = make_float2(__expf(gtot[0]), __expf(gtot[1]));
    __syncthreads();
}

template <bool DRY, int PVAR = 0>
__device__ __forceinline__ void hgrn_pass2(int item, const u16* Qh, const u16* Vt, const u16* LF0, const u16* LF1, const u16* Gt, u16* OF, u16* Y,
                                           const float* ust, const float* dst, const float* __restrict__ nw, char* lds) {
    int tid = threadIdx.x; asm volatile("" : "+v"(tid)); const int lane = tid & 63, r32 = lane & 31, hi = lane >> 5; const int wid = __builtin_amdgcn_readfirstlane(tid >> 6);
    const int seg = item & 7, bh = item >> 3, b = bh >> 3, h = bh & 7;
    const long rowbase = (long)b * SEQ; const int colbase = h * 128;
    const int ldsbase = (int)(uintptr_t)lds; const int tb = wid & 1, j = wid >> 1, ib = 2 * (wid & 1);
    float* stg = (float*)(lds + L_STG);
    ChunkRegs R;
#pragma unroll 1
    for (int dir = 0; dir < 2; ++dir) {
        const u16* LF = dir ? LF1 : LF0;
        f32x16 sacc[2] = {}; float gtot[2] = {0.f, 0.f};
        const int nseg = dir ? (7 - seg) : seg;
        for (int n = 0; n < nseg; ++n) {
            const int sg = dir ? (7 - n) : n; const int it = ((bh * 2 + dir) * 8 + sg);
            const float* up = ust + (size_t)it * 16384 + wid * 2048; const float* dp = dst + (size_t)it * 128;
#pragma unroll
            for (int i2 = 0; i2 < 2; ++i2)
#pragma unroll
                for (int r = 0; r < 16; ++r) sacc[i2][r] = sacc[i2][r] * dp[32 * (ib + i2) + crow(r, hi)] + up[(i2 * 16 + r) * 64 + lane];
        }
        write_simg(sacc, lds, wid, lane);
        load_chunk<true>(R, Qh, Vt, LF, rowbase, colbase, dir ? (seg * 8 + 7) : (seg * 8), dir, wid, lane);
        for (int cc = 0; cc < 8; ++cc) {
            const int c = dir ? (seg * 8 + 7 - cc) : (seg * 8 + cc);
            const int ri = tid >> 3, rcg = tid & 7; const size_t goff = (size_t)(rowbase + chunk_pos(c, ri, dir)) * DM + colbase + rcg * 16;
            u32x4 pf0 = {}, pf1 = {}; bf16x8 pg0 = {}, pg1 = {};
            if (dir) { pf0 = *(const u32x4*)(OF + goff); pf1 = *(const u32x4*)(OF + goff + 8); pg0 = ld8(Gt + goff); pg1 = ld8(Gt + goff + 8); }
            if (PVAR != 1) prep_chunk<true>(R, lds, wid, lane, gtot); else { asm volatile("" :: "v"(R.q[0]), "v"(R.v[7]), "v"(R.lf[3])); __syncthreads(); }
            if (cc + 1 < 8) load_chunk<true>(R, Qh, Vt, LF, rowbase, colbase, dir ? (seg * 8 + 6 - cc) : (seg * 8 + cc + 1), dir, wid, lane);
            __syncthreads();
            f32x16 oacc = f32x16{};
            if (PVAR != 2) { oacc = chunk_output(lds, ldsbase, wid, lane); state_update(sacc, lds, ldsbase, wid, lane); }
            __syncthreads();
            if (PVAR != 3) {
            write_simg(sacc, lds, wid, lane);
#pragma unroll
            for (int r = 0; r < 16; ++r) stg[(32 * tb + crow(r, hi)) * STG_LD + 32 * j + r32] = oacc[r];
            __syncthreads();
            {
                const int i = ri, cg = rcg; const float* sp = stg + i * STG_LD + cg * 16;
                f32x4 ov[4];
#pragma unroll
                for (int g = 0; g < 4; ++g) ov[g] = *(const f32x4*)(sp + g * 4);
                if (dir == 0) {
                    u32x4 w0, w1;
                    w0.x = pg8::pk_f16(ov[0][0], ov[0][1]); w0.y = pg8::pk_f16(ov[0][2], ov[0][3]); w0.z = pg8::pk_f16(ov[1][0], ov[1][1]); w0.w = pg8::pk_f16(ov[1][2], ov[1][3]);
                    w1.x = pg8::pk_f16(ov[2][0], ov[2][1]); w1.y = pg8::pk_f16(ov[2][2], ov[2][3]); w1.z = pg8::pk_f16(ov[3][0], ov[3][1]); w1.w = pg8::pk_f16(ov[3][2], ov[3][3]);
                    if (!DRY) { *(u32x4*)(OF + goff) = w0; *(u32x4*)(OF + goff + 8) = w1; } else asm volatile("" :: "v"(w0), "v"(w1));
                } else {
                    const u32x4 f0 = pf0, f1 = pf1;
                    float tv[16];
#pragma unroll
                    for (int e = 0; e < 4; ++e) { tv[2 * e] = h2f((unsigned short)(f0[e] & 0xffff)); tv[2 * e + 1] = h2f((unsigned short)(f0[e] >> 16));
                                                  tv[8 + 2 * e] = h2f((unsigned short)(f1[e] & 0xffff)); tv[8 + 2 * e + 1] = h2f((unsigned short)(f1[e] >> 16)); }
                    float ss = 0.f;
#pragma unroll
                    for (int e = 0; e < 16; ++e) { tv[e] += ov[e >> 2][e & 3]; ss += tv[e] * tv[e]; }
                    ss += __shfl_xor(ss, 1); ss += __shfl_xor(ss, 2); ss += __shfl_xor(ss, 4);
                    const float rs = __builtin_amdgcn_rsqf(ss * (1.0f / 128.0f) + EPS);
                    const bf16x8 g0 = pg0, g1 = pg1;
                    float yv[16];
#pragma unroll
                    for (int e = 0; e < 8; ++e) { yv[e] = tv[e] * rs * nw[cg * 16 + e] * bf2f((u16)g0[e]); yv[8 + e] = tv[8 + e] * rs * nw[cg * 16 + 8 + e] * bf2f((u16)g1[e]); }
                    u32x4 w0, w1;
                    w0.x = cvtpk(yv[0], yv[1]); w0.y = cvtpk(yv[2], yv[3]); w0.z = cvtpk(yv[4], yv[5]); w0.w = cvtpk(yv[6], yv[7]);
                    w1.x = cvtpk(yv[8], yv[9]); w1.y = cvtpk(yv[10], yv[11]); w1.z = cvtpk(yv[12], yv[13]); w1.w = cvtpk(yv[14], yv[15]);
                    if (!DRY) { *(u32x4*)(Y + goff) = w0; *(u32x4*)(Y + goff + 8) = w1; } else asm volatile("" :: "v"(w0), "v"(w1));
                }
            }
            } else { asm volatile("" :: "v"(oacc), "v"(sacc[0]), "v"(sacc[1]), "v"(pf0), "v"(pg0)); __syncthreads(); }
        }
        __syncthreads();
    }
}
}
#define GAS __attribute__((address_space(1)))
#define LAS __attribute__((address_space(3)))
typedef unsigned short bf16;
typedef unsigned v4u __attribute__((ext_vector_type(4)));
typedef float f32x4 __attribute__((ext_vector_type(4)));
typedef short bf16x8 __attribute__((ext_vector_type(8)));
typedef GAS unsigned gu32;
typedef GAS unsigned long long gu64;
#define RLX_AGENT __ATOMIC_RELAXED, __HIP_MEMORY_SCOPE_AGENT
#define LDS_WAIT() asm volatile("s_waitcnt lgkmcnt(0)" ::: "memory")
#define VM_WAIT() asm volatile("s_waitcnt vmcnt(0)" ::: "memory")
__device__ __forceinline__ unsigned long long rt() { return __builtin_amdgcn_s_memrealtime(); }
__device__ __forceinline__ unsigned f2bf(float f) { unsigned u = __builtin_bit_cast(unsigned, f); return (u + 0x7fffu + ((u >> 16) & 1u)) >> 16; }
__device__ __forceinline__ unsigned pk2(float lo, float hi) { return f2bf(lo) | (f2bf(hi) << 16); }

#define XB_TMO      128
#define XB_XCNT(j)  (256  + 64 * (j))
#define XB_XSUB(j)  (1280 + 64 * (j))
#define XB_XGEN(j)  (2304 + 64 * (j))
#define XB_TOP      3328
#define XB_TOPGEN   3392
#define XCD_BAR_WORDS 3456
#define XB_SPIN_CAP (1u << 18)

__device__ __forceinline__ unsigned xb_ld(unsigned* p)              { return __hip_atomic_load(p, __ATOMIC_RELAXED, __HIP_MEMORY_SCOPE_AGENT); }
__device__ __forceinline__ unsigned xb_add(unsigned* p, unsigned v) { return __hip_atomic_fetch_add(p, v, __ATOMIC_RELAXED, __HIP_MEMORY_SCOPE_AGENT); }
__device__ __forceinline__ unsigned xb_xcc_id() { return (unsigned)__builtin_amdgcn_s_getreg((3 << 11) | 20) & 0xFu; }
#define XB_SPIN(cond, bar) do { unsigned _sp = 0; while (cond) { __builtin_amdgcn_s_sleep(1); \
    if ((++_sp & 255u) == 0u) { if (xb_ld(&(bar)[XB_TMO])) break; if (_sp > XB_SPIN_CAP) { atomicAdd(&(bar)[XB_TMO], 1u); break; } } } } while (0)

struct XcdBarrier {
    unsigned* bar; unsigned x;
    volatile LAS unsigned* st;
};

__device__ __forceinline__ XcdBarrier xcd_barrier_post(unsigned* bar, volatile LAS unsigned* st) {
    XcdBarrier b; b.bar = bar; b.x = xb_xcc_id(); b.st = st;
    if (threadIdx.x == 0) (void)xb_add(&bar[XB_XCNT(b.x)], 1u);
    return b;
}
__device__ __forceinline__ void xcd_barrier_complete(unsigned* bar, unsigned x, unsigned& nloc, unsigned& nx) {
    const unsigned G = gridDim.x * gridDim.y * gridDim.z;
    unsigned sum, cnt, mine, sp = 0u;
    for (;;) {
        sum = 0u; cnt = 0u; mine = 0u;
#pragma unroll
        for (unsigned j = 0; j < 16; ++j) { const unsigned c = xb_ld(&bar[XB_XCNT(j)]); sum += c; cnt += (c > 0u) ? 1u : 0u; mine = (j == x) ? c : mine; }
        if (sum == G) break;
        __builtin_amdgcn_s_sleep(1);
        if ((++sp & 255u) == 0u) { if (xb_ld(&bar[XB_TMO])) break; if (sp > XB_SPIN_CAP) { atomicAdd(&bar[XB_TMO], 1u); break; } }
    }
    nloc = mine > 0u ? mine : 1u; nx = cnt > 0u ? cnt : 1u;
}

__device__ __forceinline__ void xcd_barrier(const XcdBarrier& b) {
    asm volatile("s_waitcnt vmcnt(0)" ::: "memory");
    __syncthreads();
    if (threadIdx.x == 0) {
        unsigned* bar = b.bar; asm volatile("" : "+s"(bar)); unsigned bx = __builtin_amdgcn_readfirstlane(b.x); asm volatile("" : "+s"(bx));
        __builtin_amdgcn_s_waitcnt(0);
        unsigned nloc = b.st[0], nx = b.st[1];
        if (nloc == 0u) { xcd_barrier_complete(bar, bx, nloc, nx); b.st[0] = nloc; b.st[1] = nx; }
        const unsigned old = xb_add(&bar[XB_XSUB(bx)], 1u);
        const unsigned gen = old / nloc;
        if (old + 1u == (gen + 1u) * nloc) {
            __builtin_amdgcn_fence(__ATOMIC_RELEASE, "agent");
            asm volatile("s_waitcnt vmcnt(0)" ::: "memory");
            const unsigned og = xb_add(&bar[XB_TOP], 1u);
            const unsigned tg = og / nx;
            if (og + 1u == (tg + 1u) * nx) xb_add(&bar[XB_TOPGEN], 1u);
            else XB_SPIN(xb_ld(&bar[XB_TOPGEN]) == tg, bar);
            __builtin_amdgcn_fence(__ATOMIC_ACQUIRE, "agent");
            xb_add(&bar[XB_XGEN(bx)], 1u);
            asm volatile("s_waitcnt vmcnt(0)" ::: "memory");
        } else {
            XB_SPIN(xb_ld(&bar[XB_XGEN(bx)]) == gen, bar);
            __builtin_amdgcn_fence(__ATOMIC_ACQUIRE, "agent");
            asm volatile("s_waitcnt vmcnt(0)" ::: "memory");
        }
    }
    __syncthreads();
}
#ifndef DUP_MASK
#define DUP_MASK 0
#endif
#define DUP(kind) (((DUP_MASK) >> (kind)) & 1)
#ifndef DUPR_MASK
#define DUPR_MASK 0
#endif
#define DUPR(kind) (((DUPR_MASK) >> (kind)) & 1)
#ifndef DUPR_MODE
#define DUPR_MODE 0
#endif
#ifndef MK_PER_PHASE
#define MK_PER_PHASE 0
#endif

constexpr size_t MiB = 1u << 20;
constexpr size_t WS_CTL = 0, CTL_ZERO_BYTES = 1 * MiB;
constexpr size_t WS_ROPE = 1 * MiB;
constexpr size_t WS_LB = 1 * MiB + 256 * 1024;
constexpr size_t WS_DST = 1 * MiB + 512 * 1024;
constexpr size_t WS_SSQ = 2 * MiB;
constexpr size_t WS_WTE = 3 * MiB;
constexpr size_t WS_WTO = 25 * MiB;
constexpr size_t WS_XB = 38 * MiB;
constexpr size_t WS_R0 = 70 * MiB, RSZ = 32 * MiB;
constexpr size_t WS_END = WS_R0 + 6 * RSZ;
constexpr int CW_BAR = 4096;

constexpr int RING_BYTES = 139264;
constexpr int LDSCTL_OFF = RING_BYTES + 8 * pg8::EPI_STG_WAVE, MISC_OFF = LDSCTL_OFF + 320;
constexpr int LDS_BYTES = 163840;
constexpr int NWAVES = 8, GRID = 256;
constexpr int NPH = 20;

struct Frame {
    LAS unsigned char* lds; volatile LAS unsigned* MISC; gu32* ctl;
    int tid, lane, wave, vcu, G;
};

__device__ __forceinline__ void transpose_item(const float* W, const float* sc, int K, int N, bf16* WT, LAS float* scr, int item, int lane) {
    const int nblk = N / 32, kb = item / nblk, nb = item % nblk, k0 = 64 * kb, n0 = 32 * nb;
    const int c4 = lane & 7, rk = lane >> 3;
#pragma unroll
    for (int i = 0; i < 8; ++i) { const int kk = 8 * i + rk; const float s = sc ? sc[k0 + kk] : 1.0f;
        f32x4 v = *(const GAS f32x4*)(W + (size_t)(k0 + kk) * N + n0 + 4 * c4); v = v * s; *(LAS f32x4*)(scr + kk * 36 + 4 * c4) = v; }
    LDS_WAIT(); asm volatile("" ::: "memory");
    const int c = lane & 7;
#pragma unroll
    for (int j = 0; j < 4; ++j) { const int n = (lane >> 3) + 8 * j; const LAS float* s = scr + (8 * c) * 36 + n;
        v4u o; o.x = pk2(s[0 * 36], s[1 * 36]); o.y = pk2(s[2 * 36], s[3 * 36]); o.z = pk2(s[4 * 36], s[5 * 36]); o.w = pk2(s[6 * 36], s[7 * 36]);
        *(GAS v4u*)(WT + (size_t)(n0 + n) * K + k0 + 8 * c) = o; }
    LDS_WAIT(); asm volatile("" ::: "memory");
}
__device__ __forceinline__ void convert_layer(Frame& F, const float* Win, const float* nrm, int Nin, const float* Wout, bf16* dstbuf) {
    int lane = F.lane; asm volatile("" : "+v"(lane));
    LAS float* scr = (LAS float*)(F.lds + F.wave * 16384);
    const int gw = F.vcu * NWAVES + F.wave, NGW = F.G * NWAVES;
    const int I_in = (DM / 64) * (Nin / 32), I_out = (DIN / 64) * (DM / 32);
    bf16* wout_t = dstbuf + (size_t)Nin * DM;
    for (int it = gw; it < I_in + I_out; it += NGW) {
        if (it < I_in) transpose_item(Win, nrm, DM, Nin, dstbuf, scr, it, lane);
        else transpose_item(Wout, nullptr, DIN, DM, wout_t, scr, it - I_in, lane);
    }
}
__device__ __forceinline__ float wave_sum(float v) {
#pragma unroll
    for (int o = 1; o < 64; o <<= 1) v += __shfl_xor(v, o);
    return v;
}

__device__ __forceinline__ void stagger(int vcu, unsigned ticks) {
    if (vcu & 1) { const unsigned long long t0 = __builtin_amdgcn_s_memrealtime(); while (__builtin_amdgcn_s_memrealtime() - t0 < ticks) __builtin_amdgcn_s_sleep(8); }
}
#ifndef STAG_EVEN
#define STAG_EVEN 0
#endif
#ifndef STAG_ODD
#define STAG_ODD 0
#endif
struct Args { const float* in[13]; float* out; unsigned char* ws; int ph_lo, ph_hi; };

__global__ void __launch_bounds__(NWAVES * 64, 2) mk_fwd(Args args) {
    extern __shared__ __attribute__((aligned(16))) unsigned char lds[];
    Frame F;
    F.lds = (LAS unsigned char*)lds;
    F.MISC = (volatile LAS unsigned*)(F.lds + MISC_OFF);
    F.tid = threadIdx.x; F.lane = F.tid & 63; F.wave = __builtin_amdgcn_readfirstlane(F.tid >> 6);
    F.G = gridDim.x; { const int bx = blockIdx.x; F.vcu = (F.G % 8 == 0) ? (bx % 8) * (F.G / 8) + bx / 8 : bx; }
    unsigned char* ws = args.ws;
    F.ctl = (gu32*)(ws + WS_CTL);
    for (int u = F.tid; u < (LDS_BYTES - LDSCTL_OFF) / 4; u += NWAVES * 64) ((LAS unsigned*)(F.lds + LDSCTL_OFF))[u] = 0u;
    __syncthreads();
    const int lo = args.ph_lo, hi = args.ph_hi; (void)lo; (void)hi;
    const bool multi = MK_PER_PHASE ? ((hi - lo) > 1) : true;
    XcdBarrier bar; bar.bar = (unsigned*)(F.ctl + CW_BAR); bar.x = 0; bar.st = nullptr;
    if (multi) bar = xcd_barrier_post((unsigned*)(F.ctl + CW_BAR), F.MISC + 8);
#ifndef PHASE_MASK
#define PHASE_MASK 0xFFFF
#endif
#if MK_PER_PHASE
#define INK(kind, k) ((((PHASE_MASK) >> (kind)) & 1) && lo <= (k) && (k) < hi)
#define IN(k) (lo <= (k) && (k) < hi)
#else
#define INK(kind, k) (((PHASE_MASK) >> (kind)) & 1)
#define IN(k) true
#endif
#if MK_PER_PHASE
#define SEAM(k) do { if (IN(k) && IN((k) + 1)) xcd_barrier(bar); } while (0)
#else
#define SEAM(k) do { xcd_barrier(bar); if (DUP(9)) xcd_barrier(bar); } while (0)
#endif

#define PTRS() size_t wz_ = 0; asm volatile("" : "+s"(wz_)); unsigned char* wsl = args.ws + wz_; \
    const float* x_in = args.in[0]; float* xres = args.out; \
    float* rope = (float*)(wsl + WS_ROPE); float* lbt = (float*)(wsl + WS_LB); float* dstv = (float*)(wsl + WS_DST); float* ssq = (float*)(wsl + WS_SSQ); \
    bf16* wte = (bf16*)(wsl + WS_WTE); bf16* wto = (bf16*)(wsl + WS_WTO); bf16* xb = (bf16*)(wsl + WS_XB); float* ust = args.out;     \
    unsigned char* R0 = wsl + WS_R0; unsigned char* R1 = R0 + RSZ; unsigned char* R2 = R1 + RSZ; unsigned char* R3 = R2 + RSZ; unsigned char* R4 = R3 + RSZ; unsigned char* R5 = R4 + RSZ; \
    const int gw = F.vcu * NWAVES + F.wave, NGW = F.G * NWAVES; int tidl = threadIdx.x; asm volatile("" : "+v"(tidl)); const int lanel = tidl & 63; (void)lanel; \
    (void)x_in; (void)xres; (void)rope; (void)lbt; (void)dstv; (void)ssq; (void)wte; (void)wto; (void)xb; (void)ust; (void)R0; (void)R1; (void)R2; (void)R3; (void)R4; (void)R5; (void)gw; (void)NGW;

    for (int rep_ = 0; rep_ < (DUP(0) ? 2 : 1); ++rep_)
    if (INK(0, 0)) {
        PTRS();
        convert_layer(F, args.in[2], args.in[1], EVEN_IN, args.in[7], wte);
        convert_layer(F, args.in[9], args.in[8], ODD_IN, args.in[11], wto);
        {
            const int gt = F.vcu * (NWAVES * 64) + tidl, NGT = F.G * NWAVES * 64;
            for (int e = gt; e < SEQ * 8; e += NGT) { const int pos = e >> 3, i = e & 7; const double inv = pow(500000.0, -(double)i / 8.0); const double ang = (double)pos * inv;
                rope[e] = (float)cos(ang); rope[SEQ * 8 + e] = (float)sin(ang); }
            const float* lg = args.in[6];
            for (int e = gt; e < 2 * 1024; e += NGT) { const int dir = e >> 10, c = e & 1023; const float l0 = lg[(dir * 2 + 0) * 1024 + c], l1 = lg[(dir * 2 + 1) * 1024 + c];
                lbt[e] = 0.0f; lbt[2048 + e] = 1.0f / (1.0f + expf(l0 - l1)); }
        }
        for (int m = gw; m < T; m += NGW) {
            const GAS f32x4* xr = (const GAS f32x4*)(x_in + (size_t)m * DM) + lanel; f32x4 v[4]; float s = 0.f;
#pragma unroll
            for (int j = 0; j < 4; ++j) { v[j] = xr[64 * j]; s += (v[j].x * v[j].x + v[j].y * v[j].y) + (v[j].z * v[j].z + v[j].w * v[j].w); }
            s = wave_sum(s);
            GAS unsigned long long* o8 = (GAS unsigned long long*)(xb + (size_t)m * DM) + lanel;
#pragma unroll
            for (int j = 0; j < 4; ++j) o8[64 * j] = (unsigned long long)pk2(v[j].x, v[j].y) | ((unsigned long long)pk2(v[j].z, v[j].w) << 32);
            if (lanel < 16) ssq[(size_t)m * 16 + lanel] = (lanel == 0) ? s : 0.0f;
        }
    }
    SEAM(0);

#pragma unroll 1
    for (int layer = 0; layer < 4; ++layer) {
        const int j = layer >> 1; const bool even = (layer & 1) == 0;
        const int pb = 1 + (layer >> 1) * 9 + (even ? 0 : 6);
        if (even) {
            const float lam_init = (j == 0) ? 0.2f : 0.470713018f;
            if (INK(1, pb + 0)) {
        PTRS();
                pg8::Gemm g{xb, wte, T, 4096, DM, DM, 1 << 30, 0l}; pg8::StaticOrder S; S.init(T, 4096, F.G, (int)blockIdx.x);
                pg8::EpiIn<true> E{ssq, rope, lbt + j * 2048, R0, R1, R2, R3, R4, R5, 0};
                if (DUP(1)) { pg8::EpiDry ED; pg8::gemm_phase(F.lds, g, S, ED); }
                if (DUPR(1)) { pg8::EpiIn<true, DUPR_MODE> E2{ssq, rope, lbt + j * 2048, R0, R1, R2, R3, R4, R5, 0}; pg8::gemm_phase(F.lds, g, S, E2); }
                if (STAG_EVEN) stagger(F.vcu, STAG_EVEN);
                pg8::gemm_phase(F.lds, g, S, E);
            }
            SEAM(pb + 0);
            if (INK(2, pb + 1)) {
        PTRS();
                if (layer == 2) { convert_layer(F, args.in[9] + (size_t)DM * ODD_IN, args.in[8] + DM, ODD_IN, args.in[11] + (size_t)DIN * DM, wto); __syncthreads(); }
                const float* lq = args.in[3] + j * 256; float s1 = 0.f, s2 = 0.f;
                for (int i = 0; i < 64; ++i) { s1 += lq[i] * lq[64 + i]; s2 += lq[128 + i] * lq[192 + i]; }
                const float lam = expf(s1) - expf(s2) + lam_init;
                if (DUP(2)) for (int i = 0; i < 4; ++i) { const int bh = (F.vcu >> 5) * 4 + i, qb = F.vcu & 31;
                    att::diff_attn_unit<true, DUPR_MODE>(bh >> 3, bh & 7, qb, (const att::u16*)R0, (const att::u16*)R1, (const att::u16*)R2, (const att::u16*)R3, (att::u16*)R0,
                                        args.in[4] + j * 128, lam, 1.0f - lam_init, (char*)lds); }
                for (int i = 0; i < 4; ++i) { const int bh = (F.vcu >> 5) * 4 + i, qb = F.vcu & 31;
                    att::diff_attn_unit<false>(bh >> 3, bh & 7, qb, (const att::u16*)R0, (const att::u16*)R1, (const att::u16*)R2, (const att::u16*)R3, (att::u16*)R0,
                                        args.in[4] + j * 128, lam, 1.0f - lam_init, (char*)lds); }
            }
            SEAM(pb + 1);
            if (INK(1, pb + 2)) {
        PTRS();
                pg8::Gemm g{xb, wte + (size_t)4096 * DM, T, 5120, DM, DM, 1 << 30, 0l}; pg8::StaticOrder S; S.init(T, 5120, F.G, (int)blockIdx.x);
                pg8::EpiIn<true> E{ssq, rope, lbt + j * 2048, R0, R1, R2, R3, R4, R5, 16};
                if (DUP(1)) { pg8::EpiDry ED; pg8::gemm_phase(F.lds, g, S, ED); }
                if (DUPR(1)) { pg8::EpiIn<true, DUPR_MODE> E2{ssq, rope, lbt + j * 2048, R0, R1, R2, R3, R4, R5, 16}; pg8::gemm_phase(F.lds, g, S, E2); }
                if (STAG_EVEN) stagger(F.vcu, STAG_EVEN);
                pg8::gemm_phase(F.lds, g, S, E);
            }
            SEAM(pb + 2);
            if (INK(3, pb + 3)) {
        PTRS();
                if (DUP(3)) for (int it = F.vcu; it < 512; it += F.G) hg::hgrn_pass1(it, (const att::u16*)R2, (const att::u16*)R4, (const att::u16*)R5, ust, dstv, (char*)lds);
                for (int it = F.vcu; it < 512; it += F.G) hg::hgrn_pass1(it, (const att::u16*)R2, (const att::u16*)R4, (const att::u16*)R5, ust, dstv, (char*)lds);
            }
            SEAM(pb + 3);
            if (INK(4, pb + 4)) {
        PTRS();
                if (DUP(4)) for (int it = F.vcu; it < 256; it += F.G) hg::hgrn_pass2<true, DUPR_MODE>(it, (const att::u16*)R1, (const att::u16*)R2, (const att::u16*)R4, (const att::u16*)R5, (const att::u16*)R3,
                                                                        (att::u16*)R4, (att::u16*)R1, ust, dstv, args.in[5] + j * 128, (char*)lds);
                for (int it = F.vcu; it < 256; it += F.G) hg::hgrn_pass2<false>(it, (const att::u16*)R1, (const att::u16*)R2, (const att::u16*)R4, (const att::u16*)R5, (const att::u16*)R3,
                                                                        (att::u16*)R4, (att::u16*)R1, ust, dstv, args.in[5] + j * 128, (char*)lds);
            }
            SEAM(pb + 4);
            if (INK(5, pb + 5)) {
        PTRS();
                pg8::Gemm g{(const bf16*)R0, wte + (size_t)EVEN_IN * DM, T, DM, DIN, DM, 16, (long)RSZ - 2048l}; pg8::StaticOrder S; S.init(T, DM, F.G, (int)blockIdx.x);
                if (DUP(5)) { pg8::EpiDry ED; pg8::gemm_phase(F.lds, g, S, ED); }
                if (layer == 0) { pg8::EpiOut<true, false> E{x_in, xres, xb, ssq}; pg8::gemm_phase(F.lds, g, S, E); }
                else            { pg8::EpiOut<false, false> E{x_in, xres, xb, ssq}; pg8::gemm_phase(F.lds, g, S, E); }
            }
            SEAM(pb + 5);
        } else {
            if (INK(6, pb + 0)) {
        PTRS();
                pg8::Gemm g{xb, wto, T, ODD_IN, DM, DM, 1 << 30, 0l}; pg8::StaticOrder S; S.init(T, ODD_IN, F.G, (int)blockIdx.x);
                pg8::EpiIn<false> E{ssq, rope, nullptr, R0, R1, R2, R3, R4, R5, 0};
                if (DUP(6)) { pg8::EpiDry ED; pg8::gemm_phase(F.lds, g, S, ED); }
                if (DUPR(6)) pg8::gemm_phase(F.lds, g, S, E);
                if (STAG_ODD) stagger(F.vcu, STAG_ODD);
                pg8::gemm_phase(F.lds, g, S, E);
            }
            SEAM(pb + 0);
            if (INK(7, pb + 1)) {
        PTRS();
                if (layer == 1) { convert_layer(F, args.in[2] + (size_t)DM * EVEN_IN, args.in[1] + DM, EVEN_IN, args.in[7] + (size_t)DIN * DM, wte); __syncthreads(); }
                if (DUP(7)) att::swa_phase<true>(2 * F.vcu, (const att::u16*)R0, (const att::u16*)R2, (const att::u16*)(R2 + (size_t)T * 256 * 2), (const att::u16*)R3, (att::u16*)R0, args.in[10] + j * 32, (char*)lds);
                att::swa_phase<false>(2 * F.vcu, (const att::u16*)R0, (const att::u16*)R2, (const att::u16*)(R2 + (size_t)T * 256 * 2), (const att::u16*)R3, (att::u16*)R0, args.in[10] + j * 32, (char*)lds);
            }
            SEAM(pb + 1);
            if (INK(5, pb + 2)) {
        PTRS();
                pg8::Gemm g{(const bf16*)R0, wto + (size_t)ODD_IN * DM, T, DM, DIN, DIN, 1 << 30, 0l}; pg8::StaticOrder S; S.init(T, DM, F.G, (int)blockIdx.x);
                if (DUP(5)) { pg8::EpiDry ED; pg8::gemm_phase(F.lds, g, S, ED); }
                if (layer == 3) { pg8::EpiOut<false, true> E{x_in, xres, xb, ssq}; pg8::gemm_phase(F.lds, g, S, E); }
                else            { pg8::EpiOut<false, false> E{x_in, xres, xb, ssq}; pg8::gemm_phase(F.lds, g, S, E); }
            }
            SEAM(pb + 2);
        }
    }
    if (INK(8, 19)) {
        PTRS();
        const float* fw = args.in[12];
        for (int m = gw; m < T; m += NGW) {
            GAS f32x4* xr = (GAS f32x4*)(xres + (size_t)m * DM) + lanel; f32x4 v[4]; float s = 0.f;
#pragma unroll
            for (int jj = 0; jj < 4; ++jj) { v[jj] = xr[64 * jj]; s += (v[jj].x * v[jj].x + v[jj].y * v[jj].y) + (v[jj].z * v[jj].z + v[jj].w * v[jj].w); }
            s = wave_sum(s); const float rs = 1.0f / sqrtf(s * (1.0f / DM) + EPS);
#pragma unroll
            for (int jj = 0; jj < 4; ++jj) { const f32x4 w = *((const f32x4*)fw + lanel + 64 * jj); xr[64 * jj] = v[jj] * rs * w; }
        }
    }
#undef IN
#undef INK
#undef SEAM
}

extern "C" void kernel_launch(void* const* d_in, const int* in_sizes, int n_in, void* d_out, int out_size, void* d_ws, size_t ws_size, hipStream_t stream) {
    static int ok = 0;
    if (ok == 0) {
        if (n_in != 13 || in_sizes[0] != T * DM || out_size != T * DM || ws_size < WS_END) { fprintf(stderr, "kernel_launch: shape/workspace mismatch (n_in %d, ws %zu, need %zu)\n", n_in, ws_size, (size_t)WS_END); ok = -1; return; }
        if (hipFuncSetAttribute((const void*)mk_fwd, hipFuncAttributeMaxDynamicSharedMemorySize, LDS_BYTES) != hipSuccess) { fprintf(stderr, "kernel_launch: hipFuncSetAttribute failed\n"); ok = -1; return; }
        int per_cu = 0;
        if (hipOccupancyMaxActiveBlocksPerMultiprocessor(&per_cu, (const void*)mk_fwd, NWAVES * 64, LDS_BYTES) != hipSuccess || per_cu < 1) fprintf(stderr, "kernel_launch: occupancy query reports %d\n", per_cu);
        (void)hipGetLastError();
        ok = 1;
    }
    if (ok < 0) return;
    (void)hipMemsetAsync((char*)d_ws + WS_CTL, 0, CTL_ZERO_BYTES, stream);
    Args a{};
    for (int i = 0; i < 13; ++i) a.in[i] = (const float*)d_in[i];
    a.out = (float*)d_out; a.ws = (unsigned char*)d_ws;
#if MK_PER_PHASE
    for (int p = 0; p < NPH; ++p) { a.ph_lo = p; a.ph_hi = p + 1; hipLaunchKernelGGL(mk_fwd, dim3(GRID), dim3(NWAVES * 64), LDS_BYTES, stream, a); }
#else
    a.ph_lo = 0; a.ph_hi = NPH;
    hipLaunchKernelGGL(mk_fwd, dim3(GRID), dim3(NWAVES * 64), LDS_BYTES, stream, a);
#endif
    const hipError_t le = hipPeekAtLastError();
    if (le != hipSuccess) fprintf(stderr, "kernel_launch: launch failed: %s\n", hipGetErrorName(le));
}
```

```cpp
#include <hip/hip_runtime.h>
#include <hip/hip_bf16.h>
#include <cstdio>
#include <cstdint>

constexpr int NB = 4, SEQ = 4096, DM = 1024, T = NB * SEQ;
constexpr int EVEN_IN = 9216, ODD_IN = 4608, DIN = 2048;
constexpr float EPS = 1e-6f;
constexpr float C2 = 0.125f * 1.4426950408889634f;
constexpr float LOG2E = 1.4426950408889634f;

namespace pg8 {
#define PG8_LAS __attribute__((address_space(3)))
typedef unsigned short bf16_t;
typedef short bf16x8 __attribute__((ext_vector_type(8)));
typedef float f32x4 __attribute__((ext_vector_type(4)));
typedef unsigned u32x4 __attribute__((ext_vector_type(4)));
constexpr int BM = 256, BK = 64, HALF = 128, HTB = HALF * BK * 2, STAGE_BYTES = 8 * HTB, NXCD = 8, WGM = 8;
constexpr int EPI_STG_OFF = 139264, EPI_STG_RS = 144, EPI_STG_WAVE = 16 * EPI_STG_RS;

__host__ __device__ __forceinline__ int lds_byte(int r, int c) { const int st = (r >> 4) * 2 + (c >> 5), rr = r & 15, cc = c & 31, ob = rr * 64 + cc * 2; return st * 1024 + (ob ^ (((ob >> 9) & 1) << 5)); }
__host__ __device__ __forceinline__ void stage_rc(int b, int& R, int& C) { const int st = b / 1024, sb = b % 1024, swz = sb ^ (((sb >> 9) & 1) << 5); R = (st >> 1) * 16 + swz / 64; C = (st & 1) * 32 + (swz % 64) / 2; }
__host__ __device__ __forceinline__ int perm32(int rho) { const int n = rho >> 4, i = rho & 15; return 8 * (i >> 2) + 4 * n + (i & 3); }

struct Unit { int pm, pn; };
struct Gemm { const bf16_t* A; const bf16_t* Bt; int M, N, K, lda, ksplit; long jump; };

struct StaticOrder {
    int nM, nN, nwg, G, c;
    __host__ __device__ void init(int M, int N, int G_, int c_) { nM = M / BM; nN = N / BM; nwg = nM * nN; G = G_; c = c_; }
    __host__ __device__ bool next(int i, Unit& u) const {
        const long L = (long)i * G + c; if (L >= nwg) return false;
        int wgid = (int)L; { const int q = nwg / NXCD, r = nwg % NXCD, xcd = wgid % NXCD, off = wgid / NXCD; wgid = (xcd < r ? xcd * (q + 1) : r * (q + 1) + (xcd - r) * q) + off; }
        const int nig = WGM * nN, gid = wgid / nig, fm = gid * WGM, gsz = (nM - fm) < WGM ? (nM - fm) : WGM;
        u.pm = fm + ((wgid % nig) % gsz); u.pn = (wgid % nig) / gsz; return true;
    }
};

__device__ __forceinline__ unsigned cvt_pk_bf16(float lo, float hi) { unsigned r; asm volatile("v_cvt_pk_bf16_f32 %0, %1, %2" : "=v"(r) : "v"(lo), "v"(hi)); return r; }

template <class Epi>
__device__ __forceinline__ void gemm_phase(PG8_LAS unsigned char* lds, const Gemm g, const StaticOrder& S, const Epi& E) {
    int tid = threadIdx.x; asm volatile("" : "+v"(tid));
    const int wid = __builtin_amdgcn_readfirstlane(tid >> 6), lane = tid & 63, wr = wid >> 2, wc = wid & 3, fr = lane & 15, fq = lane >> 4;
    const int K = g.K, nt = K / BK, lda = g.lda;
    unsigned voffA[2], voffB[2];
#pragma unroll
    for (int i = 0; i < 2; ++i) { int R, C; stage_rc(tid * 16 + i * 8192, R, C); const int Rb = 64 * (R >> 5) + perm32(R & 31);
        voffA[i] = (unsigned)(R * lda + C) * 2u; voffB[i] = (unsigned)(Rb * K + C) * 2u; }
    const size_t kstep = (size_t)(BK * 2);
    const size_t hstepA = (size_t)HALF * lda * 2, tstepA = 2 * hstepA;
    const size_t hstepB = (size_t)32 * K * 2, tstepB = (size_t)BM * K * 2;
    const unsigned ldsw = (unsigned)wid * 1024u;
    const int aoff = lds_byte(wr * 64 + fr, fq * 8), boff = lds_byte(wc * 32 + fr, fq * 8);
    const int ksplit = g.ksplit; const long jump = g.jump;
#define PG8_AP(base, t) ((base) + (size_t)(t) * kstep + (((t) >= ksplit) ? jump : 0l))
#define PG8_SA(b, h) (((b) * 2 + (h)) * HTB)
#define PG8_SB(b, h) ((4 + (b) * 2 + (h)) * HTB)
#define PG8_STAGE(bufoff, gbase, voff) do { _Pragma("unroll") for (int _i = 0; _i < 2; ++_i) \
        __builtin_amdgcn_global_load_lds((const unsigned*)((const char*)(gbase) + (voff)[_i]), (PG8_LAS unsigned*)(lds + (bufoff) + ldsw + _i * 8192), 16, 0, 0); } while (0)
#define PG8_LDA(dst, b, h) do { _Pragma("unroll") for (int m = 0; m < 4; ++m) _Pragma("unroll") for (int k = 0; k < 2; ++k) dst[m][k] = *(const PG8_LAS bf16x8*)(lds + PG8_SA(b, h) + aoff + m * 2048 + k * 1024); } while (0)
#define PG8_LDB(dst, b, h) do { _Pragma("unroll") for (int n = 0; n < 2; ++n) _Pragma("unroll") for (int k = 0; k < 2; ++k) dst[n][k] = *(const PG8_LAS bf16x8*)(lds + PG8_SB(b, h) + boff + n * 2048 + k * 1024); } while (0)
#define PG8_MMA(ai, bj, At, Bt) do { __builtin_amdgcn_s_setprio(1); _Pragma("unroll") for (int m = 0; m < 4; ++m) _Pragma("unroll") for (int n = 0; n < 2; ++n) _Pragma("unroll") for (int k = 0; k < 2; ++k) \
        acc[ai][bj][m][n] = __builtin_amdgcn_mfma_f32_16x16x32_bf16(Bt[n][k], At[m][k], acc[ai][bj][m][n], 0, 0, 0); __builtin_amdgcn_s_setprio(0); } while (0)
#define PG8_WAIT_V(n) asm volatile("s_waitcnt vmcnt(" #n ")" ::: "memory")
#define PG8_WAIT_L(n) asm volatile("s_waitcnt lgkmcnt(" #n ")" ::: "memory")
#define PG8_BAR __builtin_amdgcn_s_barrier()
#define PG8_SCHED __builtin_amdgcn_sched_barrier(0)
    Unit cur, nxt; int ui = 0;
    if (!S.next(0, cur)) return;
    f32x4 acc[2][2][4][2];
#pragma unroll
    for (int a = 0; a < 2; ++a)
#pragma unroll
        for (int b = 0; b < 2; ++b)
#pragma unroll
            for (int m = 0; m < 4; ++m)
#pragma unroll
                for (int n = 0; n < 2; ++n) acc[a][b][m][n] = (f32x4){0.f, 0.f, 0.f, 0.f};
    bf16x8 At[4][2], B0[2][2], B1[2][2];
    const char* cA = (const char*)g.A + (size_t)cur.pm * tstepA; const char* cB = (const char*)g.Bt + (size_t)cur.pn * tstepB;
    {
        PG8_STAGE(PG8_SB(0, 0), cB, voffB); PG8_STAGE(PG8_SB(0, 1), cB + hstepB, voffB); PG8_STAGE(PG8_SA(0, 0), cA, voffA); PG8_STAGE(PG8_SA(0, 1), cA + hstepA, voffA);
        if (wr == 1) PG8_BAR;
        PG8_WAIT_V(2); PG8_BAR;
        PG8_STAGE(PG8_SB(1, 0), cB + kstep, voffB); PG8_STAGE(PG8_SA(1, 0), PG8_AP(cA, 1), voffA); PG8_STAGE(PG8_SB(1, 1), cB + hstepB + kstep, voffB);
        PG8_WAIT_V(6); PG8_BAR;
    }
    for (;;) {
        const bool has_next = S.next(ui + 1, nxt);
        const char* nA = has_next ? (const char*)g.A + (size_t)nxt.pm * tstepA : cA; const char* nB = has_next ? (const char*)g.Bt + (size_t)nxt.pn * tstepB : cB;
        for (int t = 0; t < nt; t += 2) {
            const bool last = (t == nt - 2);
            const char* a1 = PG8_AP(cA, t + 1);
            const char* a2 = last ? nA : PG8_AP(cA, t + 2); const char* b2 = last ? nB : cB + (size_t)(t + 2) * kstep;
            const char* a3 = a2 + kstep; const char* b3 = b2 + kstep;
            PG8_LDB(B0, 0, 0); PG8_LDB(B1, 0, 1); PG8_SCHED; PG8_LDA(At, 0, 0); PG8_STAGE(PG8_SA(1, 1), a1 + hstepA, voffA);
            PG8_WAIT_V(8); PG8_WAIT_L(0); PG8_BAR; PG8_MMA(0, 0, At, B0); PG8_MMA(0, 1, At, B1); PG8_BAR; PG8_SCHED;
            PG8_LDA(At, 0, 1); PG8_STAGE(PG8_SB(0, 0), b2, voffB); PG8_STAGE(PG8_SB(0, 1), b2 + hstepB, voffB); PG8_STAGE(PG8_SA(0, 0), a2, voffA);
            PG8_WAIT_V(8); PG8_WAIT_L(0); PG8_BAR; PG8_MMA(1, 0, At, B0); PG8_MMA(1, 1, At, B1); PG8_BAR; PG8_SCHED;
            PG8_LDB(B0, 1, 0); PG8_LDB(B1, 1, 1); PG8_SCHED; PG8_LDA(At, 1, 0); PG8_STAGE(PG8_SA(0, 1), a2 + hstepA, voffA);
            PG8_WAIT_V(8); PG8_WAIT_L(0); PG8_BAR; PG8_MMA(0, 0, At, B0); PG8_MMA(0, 1, At, B1); PG8_BAR; PG8_SCHED;
            PG8_LDA(At, 1, 1); PG8_STAGE(PG8_SB(1, 0), b3, voffB); PG8_STAGE(PG8_SB(1, 1), b3 + hstepB, voffB); PG8_STAGE(PG8_SA(1, 0), a3, voffA);
            PG8_WAIT_V(8); PG8_WAIT_L(0); PG8_BAR; PG8_MMA(1, 0, At, B0); PG8_MMA(1, 1, At, B1); PG8_BAR; PG8_SCHED;
        }
        if (wr == 0) PG8_BAR;
        E(acc, cur, wr, wc, fr, fq, lds + EPI_STG_OFF + wid * EPI_STG_WAVE, lane);
        if (!has_next) break;
#pragma unroll
        for (int a = 0; a < 2; ++a)
#pragma unroll
            for (int b = 0; b < 2; ++b)
#pragma unroll
                for (int m = 0; m < 4; ++m)
#pragma unroll
                    for (int n = 0; n < 2; ++n) acc[a][b][m][n] = (f32x4){0.f, 0.f, 0.f, 0.f};
        cur = nxt; cA = nA; cB = nB; ++ui;
        if (wr == 1) PG8_BAR;
    }
    PG8_WAIT_V(0);
    PG8_BAR;
#undef PG8_AP
#undef PG8_SA
#undef PG8_SB
#undef PG8_STAGE
#undef PG8_LDA
#undef PG8_LDB
#undef PG8_MMA
#undef PG8_WAIT_V
#undef PG8_WAIT_L
#undef PG8_BAR
#undef PG8_SCHED
}
}
namespace pg8 {
typedef unsigned short u16;
__device__ __forceinline__ float fsigmoid(float v) { return __builtin_amdgcn_rcpf(1.0f + __expf(-v)); }
__device__ __forceinline__ unsigned pk_f16(float lo, float hi) { _Float16 a = (_Float16)lo, b = (_Float16)hi; return (unsigned)__builtin_bit_cast(unsigned short, a) | ((unsigned)__builtin_bit_cast(unsigned short, b) << 16); }


__device__ __forceinline__ void store_rows128(PG8_LAS unsigned char* stg, u16* blk  , size_t pitch, u32x4 w0, u32x4 w1, int fr, int fq, int lane) {
    *(PG8_LAS u32x4*)(stg + fr * EPI_STG_RS + fq * 16) = w0; *(PG8_LAS u32x4*)(stg + fr * EPI_STG_RS + 64 + fq * 16) = w1;
    const int rr = lane >> 3, ch = lane & 7;
    const u32x4 a = *(const PG8_LAS u32x4*)(stg + rr * EPI_STG_RS + ch * 16), b = *(const PG8_LAS u32x4*)(stg + (8 + rr) * EPI_STG_RS + ch * 16);
    *(u32x4*)(blk + (size_t)rr * pitch + ch * 8) = a; *(u32x4*)(blk + (size_t)(8 + rr) * pitch + ch * 8) = b;
}

enum { K_PLAIN = 0, K_SILU = 1, K_ROPEQ = 2, K_ROPEK = 3, K_LOGF = 4 };

template <bool EVEN, int MODE = 0> struct EpiIn {
    static constexpr bool PERM = true;
    const float* ssq;
    const float* rope;
    const float* lb;
    unsigned char* r0; unsigned char* r1; unsigned char* r2; unsigned char* r3; unsigned char* r4; unsigned char* r5;
    int pn_off;
    __device__ __forceinline__ void operator()(const f32x4 (&acc)[2][2][4][2], const Unit& u, int wr, int wc, int fr, int fq, PG8_LAS unsigned char* stg, int lane) const {
        const int gpn = u.pn + pn_off;
        int kind, pitch, colt, dir = 0; u16* outp;
        if (EVEN) {
            const int grp = gpn >> 2; colt = (gpn & 3) * 256; pitch = 1024;
            switch (grp) {
                case 0: kind = K_ROPEQ; outp = (u16*)r0; break;
                case 1: kind = K_ROPEK; outp = (u16*)r1; break;
                case 2: kind = K_PLAIN; outp = (u16*)r2; break;
                case 3: kind = K_SILU;  outp = (u16*)r3; break;
                case 4: kind = K_SILU;  outp = (u16*)r1; break;
                case 5: kind = K_LOGF;  outp = (u16*)r4; dir = 0; break;
                case 6: kind = K_LOGF;  outp = (u16*)r5; dir = 1; break;
                case 7: kind = K_PLAIN; outp = (u16*)r2; break;
                default: kind = K_SILU; outp = (u16*)r3; break;
            }
        } else {
            if (gpn < 8)       { kind = K_ROPEQ; outp = (u16*)r0; pitch = 2048; colt = gpn * 256; }
            else if (gpn == 8) { kind = K_ROPEK; outp = (u16*)r2; pitch = 256;  colt = 0; }
            else if (gpn == 9) { kind = K_PLAIN; outp = (u16*)(r2 + (size_t)T * 256 * 2); pitch = 256; colt = 0; }
            else               { kind = K_SILU;  outp = (u16*)r3; pitch = 2048; colt = (gpn - 10) * 256; }
        }
        int row0 = u.pm * BM + wr * 64 + fr; asm volatile("" : "+v"(row0));
        if (MODE == 2) kind = K_PLAIN;
        float rsv[8];
#pragma unroll
        for (int hb = 0; hb < 2; ++hb) { f32x4 sq[4];
#pragma unroll
          for (int i = 0; i < 4; ++i) sq[i] = *((const f32x4*)(ssq + (size_t)(row0 + hb * HALF + i * 16) * 16) + fq);
#pragma unroll
          for (int i = 0; i < 4; ++i) { float tot = (sq[i][0] + sq[i][1]) + (sq[i][2] + sq[i][3]); tot += __shfl_xor(tot, 16); tot += __shfl_xor(tot, 32); rsv[hb * 4 + i] = __builtin_amdgcn_rsqf(tot * (1.0f / DM) + EPS); }
          asm volatile("" ::: "memory"); }
        u16* const blk0 = outp + (size_t)(row0 - fr) * pitch + colt + wc * 64;
        if (kind == K_LOGF)        rows<K_LOGF>(acc, rsv, blk0, pitch, colt + wc * 64, dir, row0, 1.0f, fr, fq, stg, lane);
        else if (kind == K_SILU)   rows<K_SILU>(acc, rsv, blk0, pitch, 0, 0, row0, 1.0f, fr, fq, stg, lane);
        else if (kind == K_PLAIN)  rows<K_PLAIN>(acc, rsv, blk0, pitch, 0, 0, row0, 1.0f, fr, fq, stg, lane);
        else                       rows<K_ROPEQ>(acc, rsv, blk0, pitch, 0, 0, row0, (kind == K_ROPEQ) ? C2 : 1.0f, fr, fq, stg, lane);
    }
    template <int KIND>
    __device__ __forceinline__ void rows(const f32x4 (&acc)[2][2][4][2], const float (&rsv)[8], u16* blk0, int pitch, int ccol, int dir, int row0, float qs, int fr, int fq, PG8_LAS unsigned char* stg, int lane) const {
        f32x4 lbv[2][2];
        if (KIND == K_LOGF) {
#pragma unroll
            for (int bj = 0; bj < 2; ++bj) { const int c0 = ccol + bj * 32 + 8 * fq; lbv[bj][0] = *(const f32x4*)(lb + dir * 1024 + c0); lbv[bj][1] = *(const f32x4*)(lb + dir * 1024 + c0 + 4); }
        }
        f32x4 cs0, cs1, sn0, sn1, ncs0, ncs1, nsn0, nsn1;
        if (KIND == K_ROPEQ) { const int pos = row0 & (SEQ - 1); const f32x4* cp = (const f32x4*)(rope + (size_t)pos * 8); const f32x4* spn = (const f32x4*)(rope + (size_t)SEQ * 8 + (size_t)pos * 8);
            ncs0 = cp[0]; ncs1 = cp[1]; nsn0 = spn[0]; nsn1 = spn[1]; }
#pragma unroll
        for (int ai = 0; ai < 2; ++ai)
#pragma unroll
            for (int m = 0; m < 4; ++m) {
                const float rs = rsv[ai * 4 + m];
                if (KIND == K_ROPEQ) { cs0 = ncs0; cs1 = ncs1; sn0 = nsn0; sn1 = nsn1;
                    if (ai * 4 + m < 7) { const int i2 = ai * 4 + m + 1; const int pos = (row0 + (i2 >> 2) * HALF + (i2 & 3) * 16) & (SEQ - 1);
                        const f32x4* cp = (const f32x4*)(rope + (size_t)pos * 8); const f32x4* spn = (const f32x4*)(rope + (size_t)SEQ * 8 + (size_t)pos * 8);
                        ncs0 = cp[0]; ncs1 = cp[1]; nsn0 = spn[0]; nsn1 = spn[1]; } }
                u32x4 wst[2];
#pragma unroll
                for (int bj = 0; bj < 2; ++bj) {
                    f32x4 v0 = acc[ai][bj][m][0] * rs, v1 = acc[ai][bj][m][1] * rs;
                    u32x4 w;
                    if (KIND == K_LOGF) {
                        const f32x4 l0 = lbv[bj][0], l1 = lbv[bj][1];
                        float o[8];
#pragma unroll
                        for (int e = 0; e < 4; ++e) { const float f0 = l0[e] + (1.0f - l0[e]) * fsigmoid(v0[e]), f1 = l1[e] + (1.0f - l1[e]) * fsigmoid(v1[e]);
                            o[e] = fmaxf(__builtin_amdgcn_logf(f0) * 0.6931471805599453f, -30.0f); o[4 + e] = fmaxf(__builtin_amdgcn_logf(f1) * 0.6931471805599453f, -30.0f); }
                        w.x = pk_f16(o[0], o[1]); w.y = pk_f16(o[2], o[3]); w.z = pk_f16(o[4], o[5]); w.w = pk_f16(o[6], o[7]);
                    } else {
                        if (KIND == K_SILU) {
#pragma unroll
                            for (int e = 0; e < 4; ++e) { v0[e] = v0[e] * fsigmoid(v0[e]); v1[e] = v1[e] * fsigmoid(v1[e]); }
                        } else if (KIND == K_ROPEQ && bj == 0) {
                            f32x4 o0, o1;
#pragma unroll
                            for (int e = 0; e < 4; ++e) { o0[e] = __shfl_xor(v0[e], 16); o1[e] = __shfl_xor(v1[e], 16); }
                            if (fq < 2) {
                                const float sg = (fq == 0) ? -1.0f : 1.0f;
                                v0 = v0 * cs0 + (o0 * sn0) * sg; v1 = v1 * cs1 + (o1 * sn1) * sg;
                            }
                        }
                        if (KIND == K_ROPEQ) { v0 = v0 * qs; v1 = v1 * qs; }
                        w.x = cvt_pk_bf16(v0[0], v0[1]); w.y = cvt_pk_bf16(v0[2], v0[3]); w.z = cvt_pk_bf16(v1[0], v1[1]); w.w = cvt_pk_bf16(v1[2], v1[3]);
                    }
                    wst[bj] = w;
                }
                if (MODE != 1) store_rows128(stg, blk0 + (size_t)(ai * HALF + m * 16) * pitch, (size_t)pitch, wst[0], wst[1], fr, fq, lane); else asm volatile("" :: "v"(wst[0]), "v"(wst[1]));
            }
    }
};

__device__ __forceinline__ float bf_lo(unsigned w) { return __uint_as_float(w << 16); }
__device__ __forceinline__ float bf_hi(unsigned w) { return __uint_as_float(w & 0xffff0000u); }
template <bool FIRST, bool LAST> struct EpiOut {
    static constexpr bool PERM = true;
    const float* xin; float* xout; u16* xb; float* ssq;
    __device__ __forceinline__ void operator()(const f32x4 (&acc)[2][2][4][2], const Unit& u, int wr, int wc, int fr, int fq, PG8_LAS unsigned char* stg, int lane) const {
        int row0 = u.pm * BM + wr * 64 + fr; asm volatile("" : "+v"(row0));
        const int cb = u.pn * BM + wc * 64 + 8 * fq;
        f32x4 nx[2][2];
#define LOADX(dst, rw) do { _Pragma("unroll") for (int bj = 0; bj < 2; ++bj) { const size_t off = (size_t)(rw) * DM + cb + bj * 32; \
            if (FIRST) { dst[bj][0] = *(const f32x4*)(xin + off); dst[bj][1] = *(const f32x4*)(xin + off + 4); } \
            else { const u32x4 w = *(const u32x4*)(xb + off); dst[bj][0] = (f32x4){bf_lo(w.x), bf_hi(w.x), bf_lo(w.y), bf_hi(w.y)}; dst[bj][1] = (f32x4){bf_lo(w.z), bf_hi(w.z), bf_lo(w.w), bf_hi(w.w)}; } } } while (0)
        LOADX(nx, row0);
#pragma unroll
        for (int ai = 0; ai < 2; ++ai)
#pragma unroll
            for (int m = 0; m < 4; ++m) {
                const int row = row0 + ai * HALF + m * 16; float part = 0.f; u32x4 wst[2];
                f32x4 ox[2][2];
#pragma unroll
                for (int bj = 0; bj < 2; ++bj) { ox[bj][0] = nx[bj][0]; ox[bj][1] = nx[bj][1]; }
                if (ai * 4 + m < 7) { const int i2 = ai * 4 + m + 1; LOADX(nx, row0 + (i2 >> 2) * HALF + (i2 & 3) * 16); }
#pragma unroll
                for (int bj = 0; bj < 2; ++bj) {
                    const size_t off = (size_t)row * DM + cb + bj * 32;
                    const f32x4 n0 = ox[bj][0] + acc[ai][bj][m][0], n1 = ox[bj][1] + acc[ai][bj][m][1];
                    if (LAST) { *(f32x4*)(xout + off) = n0; *(f32x4*)(xout + off + 4) = n1; }
                    else {
                        u32x4 w; w.x = cvt_pk_bf16(n0[0], n0[1]); w.y = cvt_pk_bf16(n0[2], n0[3]); w.z = cvt_pk_bf16(n1[0], n1[1]); w.w = cvt_pk_bf16(n1[2], n1[3]);
                        wst[bj] = w;
                        const f32x4 r0 = (f32x4){bf_lo(w.x), bf_hi(w.x), bf_lo(w.y), bf_hi(w.y)}, r1 = (f32x4){bf_lo(w.z), bf_hi(w.z), bf_lo(w.w), bf_hi(w.w)};
                        part += (r0[0] * r0[0] + r0[1] * r0[1]) + (r0[2] * r0[2] + r0[3] * r0[3]) + (r1[0] * r1[0] + r1[1] * r1[1]) + (r1[2] * r1[2] + r1[3] * r1[3]);
                    }
                }
                if (!LAST) { part += __shfl_xor(part, 16); part += __shfl_xor(part, 32);
                    if (fq == 0) ssq[(size_t)row * 16 + u.pn * 4 + wc] = part;
                    store_rows128(stg, xb + (size_t)(row - fr) * DM + u.pn * BM + wc * 64, (size_t)DM, wst[0], wst[1], fr, fq, lane); }
            }
#undef LOADX
    }
};
struct EpiDry {
    static constexpr bool PERM = true;
    __device__ __forceinline__ void operator()(const f32x4 (&acc)[2][2][4][2], const Unit&, int, int, int, int, PG8_LAS unsigned char*, int) const {
#pragma unroll
        for (int a = 0; a < 2; ++a)
#pragma unroll
            for (int b = 0; b < 2; ++b)
#pragma unroll
                for (int m = 0; m < 4; ++m) asm volatile("" :: "v"(acc[a][b][m][0]), "v"(acc[a][b][m][1]));
    }
};
}
namespace att {
typedef unsigned short u16;
using bf16x8 = __attribute__((ext_vector_type(8))) short;
using s16x4  = __attribute__((ext_vector_type(4))) short;
using f32x16 = __attribute__((ext_vector_type(16))) float;
using f32x4  = __attribute__((ext_vector_type(4))) float;
using u32x4  = __attribute__((ext_vector_type(4))) unsigned;
#define KSWZ(row, colB) ((row) * 256 + ((colB) ^ (((row) & 7) << 4)))
#define KSWZ128(row, colB) ((row) * 128 + ((colB) ^ (((row) & 7) << 4)))
#define SBAR() __builtin_amdgcn_sched_barrier(0)
constexpr float THRL = 8.0f;
__device__ __forceinline__ int crow(int r, int hi) { return (r & 3) + 8 * (r >> 2) + 4 * hi; }
__device__ __forceinline__ unsigned cvtpk(float lo, float hi) { unsigned r; asm volatile("v_cvt_pk_bf16_f32 %0, %1, %2" : "=v"(r) : "v"(lo), "v"(hi)); return r; }
__device__ __forceinline__ bf16x8 ld8(const u16* p) { return *reinterpret_cast<const bf16x8*>(p); }
__device__ __forceinline__ float bf2f(unsigned short h) { return __uint_as_float((unsigned)h << 16); }

__device__ __forceinline__ void partialSM(f32x16& p0, f32x16& p1, float& m_reg, float& alpha) {
    float pmax = p0[0];
#pragma unroll
    for (int r = 1; r < 16; ++r) pmax = fmaxf(pmax, p0[r]);
#pragma unroll
    for (int r = 0; r < 16; ++r) pmax = fmaxf(pmax, p1[r]);
    { auto rr = __builtin_amdgcn_permlane32_swap(__float_as_uint(pmax), __float_as_uint(pmax), false, false);
      pmax = fmaxf(__uint_as_float(rr[0]), __uint_as_float(rr[1])); }
    float mn;
    if (__builtin_expect(__all(pmax - m_reg <= THRL), 1)) { mn = m_reg; alpha = 1.f; }
    else { mn = fmaxf(m_reg, pmax); alpha = __builtin_amdgcn_exp2f(m_reg - mn); m_reg = mn; }
#pragma unroll
    for (int r = 0; r < 16; ++r) { p0[r] -= mn; p1[r] -= mn; }
#pragma unroll
    for (int r = 0; r < 16; ++r) p0[r] = __builtin_amdgcn_exp2f(p0[r]);
}
__device__ __forceinline__ void finishSM(f32x16& p0, f32x16& p1, float alpha, float& l_reg, bf16x8& pa0, bf16x8& pa1, bf16x8& pa2, bf16x8& pa3) {
#pragma unroll
    for (int r = 0; r < 16; ++r) p1[r] = __builtin_amdgcn_exp2f(p1[r]);
    float ps = 0;
#pragma unroll
    for (int r = 0; r < 16; ++r) ps += p0[r];
#pragma unroll
    for (int r = 0; r < 16; ++r) ps += p1[r];
    { auto rr = __builtin_amdgcn_permlane32_swap(__float_as_uint(ps), __float_as_uint(ps), false, false);
      ps = __uint_as_float(rr[0]) + __uint_as_float(rr[1]); }
    l_reg = l_reg * alpha + ps;
#define PK4(P, BASE, OUT) do { unsigned a0 = cvtpk(P[BASE + 0], P[BASE + 1]), a1 = cvtpk(P[BASE + 2], P[BASE + 3]);   \
    unsigned b0 = cvtpk(P[BASE + 4], P[BASE + 5]), b1 = cvtpk(P[BASE + 6], P[BASE + 7]);                              \
    auto r0 = __builtin_amdgcn_permlane32_swap(a0, b0, false, false); auto r1 = __builtin_amdgcn_permlane32_swap(a1, b1, false, false); \
    u32x4 w = {r0[0], r1[0], r0[1], r1[1]}; OUT = *reinterpret_cast<bf16x8*>(&w); } while (0)
    PK4(p0, 0, pa0); PK4(p0, 8, pa1); PK4(p1, 0, pa2); PK4(p1, 8, pa3);
}
__device__ __forceinline__ void pack4(const f32x16& p0, const f32x16& p1, bf16x8& pa0, bf16x8& pa1, bf16x8& pa2, bf16x8& pa3) {
    PK4(p0, 0, pa0); PK4(p0, 8, pa1); PK4(p1, 0, pa2); PK4(p1, 8, pa3);
}
#undef PK4

template <int NCB> __device__ __forceinline__ int v_st(int k, int c) { const int kk = (k & ~0xC) | ((k & 4) << 1) | ((k & 8) >> 1); return ((kk >> 3) * NCB + (c >> 5)) * 512 + ((kk & 7) * 32 + (c & 31)) * 2; }
__device__ __forceinline__ int v_rd_base(int lane) { return ((lane & 3) << 3) | (((lane >> 2) & 3) << 6) | (((lane >> 4) & 1) << 5) | (((lane >> 5) & 1) << 8); }
template <int OFF> __device__ __forceinline__ s16x4 tr_read(int vb) { s16x4 r; asm volatile("ds_read_b64_tr_b16 %0, %1 offset:%2" : "=&v"(r) : "v"(vb), "i"(OFF) : "memory"); return r; }
#define PKF(L, H) (bf16x8){L[0], L[1], L[2], L[3], H[0], H[1], H[2], H[3]}
template <int NCB> __device__ __forceinline__ void pv_blk(f32x16& od, int vb, bf16x8 pa0, bf16x8 pa1, bf16x8 pa2, bf16x8 pa3) {
    constexpr int KS = NCB * 1024, HF = NCB * 512;
    const s16x4 l0 = tr_read<0 * KS>(vb), h0 = tr_read<0 * KS + HF>(vb), l1 = tr_read<1 * KS>(vb), h1 = tr_read<1 * KS + HF>(vb);
    const s16x4 l2 = tr_read<2 * KS>(vb), h2 = tr_read<2 * KS + HF>(vb), l3 = tr_read<3 * KS>(vb), h3 = tr_read<3 * KS + HF>(vb);
    asm volatile("s_waitcnt lgkmcnt(0)" ::: "memory"); SBAR();
    od = __builtin_amdgcn_mfma_f32_32x32x16_bf16(pa0, PKF(l0, h0), od, 0, 0, 0);
    od = __builtin_amdgcn_mfma_f32_32x32x16_bf16(pa1, PKF(l1, h1), od, 0, 0, 0);
    od = __builtin_amdgcn_mfma_f32_32x32x16_bf16(pa2, PKF(l2, h2), od, 0, 0, 0);
    od = __builtin_amdgcn_mfma_f32_32x32x16_bf16(pa3, PKF(l3, h3), od, 0, 0, 0);
}


template <int NCB> __device__ __forceinline__ int v_stn(int k, int c) { return ((k >> 3) * NCB + (c >> 5)) * 512 + ((k & 7) * 32 + (c & 31)) * 2; }
__device__ __forceinline__ float max3f(float a, float b, float c) { return fmaxf(fmaxf(a, b), c); }
__device__ __forceinline__ void fill16(f32x16& v, float x) {
#pragma unroll
    for (int r = 0; r < 16; ++r) v[r] = x;
}
template <bool FIRST>
__device__ __forceinline__ void partialSM_n(f32x16& p0, f32x16& p1, float& m_reg, f32x16& negm, float& alpha) {
    float a = max3f(p0[0], p0[1], p0[2]), b = max3f(p0[3], p0[4], p0[5]), c = max3f(p1[0], p1[1], p1[2]), d = max3f(p1[3], p1[4], p1[5]);
    a = max3f(a, p0[6], p0[7]); b = max3f(b, p0[8], p0[9]); c = max3f(c, p1[6], p1[7]); d = max3f(d, p1[8], p1[9]);
    a = max3f(a, p0[10], p0[11]); b = max3f(b, p0[12], p0[13]); c = max3f(c, p1[10], p1[11]); d = max3f(d, p1[12], p1[13]);
    a = max3f(a, p0[14], p0[15]); c = max3f(c, p1[14], p1[15]);
    float pmax = fmaxf(fmaxf(a, b), fmaxf(c, d));
    { auto rr = __builtin_amdgcn_permlane32_swap(__float_as_uint(pmax), __float_as_uint(pmax), false, false);
      pmax = fmaxf(__uint_as_float(rr[0]), __uint_as_float(rr[1])); }
    if (!FIRST && __builtin_expect(__all(pmax <= THRL), 1)) { alpha = 1.f; }
    else { const float dl = FIRST ? pmax : fmaxf(pmax, 0.f); m_reg += dl; alpha = FIRST ? 0.f : __builtin_amdgcn_exp2f(-dl);
#pragma unroll
        for (int r = 0; r < 16; ++r) { p0[r] -= dl; p1[r] -= dl; }
        fill16(negm, -m_reg); asm volatile("" : "+v"(negm)); }
#pragma unroll
    for (int r = 0; r < 16; ++r) p0[r] = __builtin_amdgcn_exp2f(p0[r]);
}
#define PKN(P, B) (u32x4){cvtpk(P[B + 0], P[B + 1]), cvtpk(P[B + 2], P[B + 3]), cvtpk(P[B + 4], P[B + 5]), cvtpk(P[B + 6], P[B + 7])}
template <bool SUM>
__device__ __forceinline__ void finishSM_n(f32x16& p0, f32x16& p1, float alpha, float& l_reg, bf16x8& pa0, bf16x8& pa1, bf16x8& pa2, bf16x8& pa3) {
#pragma unroll
    for (int r = 0; r < 16; ++r) p1[r] = __builtin_amdgcn_exp2f(p1[r]);
    if (SUM) {
        float s0 = (p0[0] + p0[1]) + (p0[2] + p0[3]), s1 = (p0[4] + p0[5]) + (p0[6] + p0[7]), s2 = (p0[8] + p0[9]) + (p0[10] + p0[11]), s3 = (p0[12] + p0[13]) + (p0[14] + p0[15]);
        float t0 = (p1[0] + p1[1]) + (p1[2] + p1[3]), t1 = (p1[4] + p1[5]) + (p1[6] + p1[7]), t2 = (p1[8] + p1[9]) + (p1[10] + p1[11]), t3 = (p1[12] + p1[13]) + (p1[14] + p1[15]);
        float ps = ((s0 + s1) + (s2 + s3)) + ((t0 + t1) + (t2 + t3));
        { auto rr = __builtin_amdgcn_permlane32_swap(__float_as_uint(ps), __float_as_uint(ps), false, false);
          ps = __uint_as_float(rr[0]) + __uint_as_float(rr[1]); }
        l_reg = l_reg * alpha + ps;
    }
    { u32x4 w = PKN(p0, 0); pa0 = *reinterpret_cast<bf16x8*>(&w); } { u32x4 w = PKN(p0, 8); pa1 = *reinterpret_cast<bf16x8*>(&w); }
    { u32x4 w = PKN(p1, 0); pa2 = *reinterpret_cast<bf16x8*>(&w); } { u32x4 w = PKN(p1, 8); pa3 = *reinterpret_cast<bf16x8*>(&w); }
}

__device__ __forceinline__ void qkt_da(f32x16& p0, f32x16& p1, const char* Ks, const bf16x8* qr, const f32x16& negm, int r32, int hi, int cb0) {
#pragma unroll
    for (int d0 = 0; d0 < 4; ++d0) { const int cb = cb0 + (d0 * 16 + hi * 8) * 2;
        const bf16x8 b0 = *reinterpret_cast<const bf16x8*>(Ks + KSWZ(r32, cb));
        const bf16x8 b1 = *reinterpret_cast<const bf16x8*>(Ks + KSWZ(32 + r32, cb));
        if (d0 == 0) { p0 = __builtin_amdgcn_mfma_f32_32x32x16_bf16(b0, qr[0], negm, 0, 0, 0); p1 = __builtin_amdgcn_mfma_f32_32x32x16_bf16(b1, qr[0], negm, 0, 0, 0); }
        else { p0 = __builtin_amdgcn_mfma_f32_32x32x16_bf16(b0, qr[d0], p0, 0, 0, 0); p1 = __builtin_amdgcn_mfma_f32_32x32x16_bf16(b1, qr[d0], p1, 0, 0, 0); } }
}
typedef short v4i16_t __attribute__((ext_vector_type(4)));
__device__ __forceinline__ s16x4 vtr(int addr) { return __builtin_bit_cast(s16x4, __builtin_amdgcn_ds_read_tr16_b64_v4i16((__attribute__((address_space(3))) v4i16_t*)(unsigned)addr)); }
__device__ __forceinline__ void pv_da(f32x16* o, int vb, bf16x8 pa0, bf16x8 pa1, bf16x8 pa2, bf16x8 pa3) {
    s16x4 lo[4], hi[4];
#define VADDR(i) (vb + ((i) & 3) * 512 + ((i) >> 2) * 4096)
#pragma unroll
    for (int i = 0; i < 4; ++i) { lo[i] = vtr(VADDR(i)); hi[i] = vtr(VADDR(i) + 2048); }
#pragma unroll
    for (int i = 0; i < 16; ++i) {
        const bf16x8 vf = PKF(lo[i & 3], hi[i & 3]);
        const bf16x8 pa = ((i >> 2) == 0) ? pa0 : ((i >> 2) == 1) ? pa1 : ((i >> 2) == 2) ? pa2 : pa3;
        o[i & 3] = __builtin_amdgcn_mfma_f32_32x32x16_bf16(pa, vf, o[i & 3], 0, 0, 0);
        if (i + 4 < 16) { lo[i & 3] = vtr(VADDR(i + 4)); hi[i & 3] = vtr(VADDR(i + 4) + 2048); }
    }
#undef VADDR
    __builtin_amdgcn_sched_group_barrier(0x100, 8, 0);
#pragma unroll
    for (int i = 0; i < 12; ++i) { __builtin_amdgcn_sched_group_barrier(0x008, 1, 0); __builtin_amdgcn_sched_group_barrier(0x100, 2, 0); __builtin_amdgcn_sched_group_barrier(0x002, 4, 0); }
#pragma unroll
    for (int i = 0; i < 4; ++i) { __builtin_amdgcn_sched_group_barrier(0x008, 1, 0); __builtin_amdgcn_sched_group_barrier(0x002, 4, 0); }
}
#define DA_PIN(x) asm volatile("" : "+v"(x))
#define DA_MFMA(a, b, c) __builtin_amdgcn_mfma_f32_32x32x16_bf16(a, b, c, 0, 0, 0)
#define DA_WAIT_BAR(N) asm volatile("s_waitcnt vmcnt(" #N ") lgkmcnt(0)\n\ts_barrier" ::: "memory")
__device__ __forceinline__ void glds16(const void* g, unsigned lds_base) {
    unsigned sv; asm volatile("s_mov_b32 %0, m0\n\ts_mov_b32 m0, %2\n\ts_nop 0\n\tglobal_load_lds_dwordx4 %1, off\n\ts_mov_b32 m0, %0" : "=&s"(sv) : "v"(g), "s"(lds_base) : "memory"); }
__device__ __forceinline__ bf16x8 kld(int addr) { return *(const __attribute__((address_space(3))) bf16x8*)(unsigned)addr; }
__device__ __forceinline__ float rowmax32(const f32x16& p0, const f32x16& p1) {
    float a = max3f(p0[0], p0[1], p0[2]), b = max3f(p0[3], p0[4], p0[5]), c = max3f(p1[0], p1[1], p1[2]), d = max3f(p1[3], p1[4], p1[5]);
    a = max3f(a, p0[6], p0[7]); b = max3f(b, p0[8], p0[9]); c = max3f(c, p1[6], p1[7]); d = max3f(d, p1[8], p1[9]);
    a = max3f(a, p0[10], p0[11]); b = max3f(b, p0[12], p0[13]); c = max3f(c, p1[10], p1[11]); d = max3f(d, p1[12], p1[13]);
    a = max3f(a, p0[14], p0[15]); c = max3f(c, p1[14], p1[15]);
    const float pmax = fmaxf(fmaxf(a, b), fmaxf(c, d));
    auto rr = __builtin_amdgcn_permlane32_swap(__float_as_uint(pmax), __float_as_uint(pmax), false, false);
    return fmaxf(__uint_as_float(rr[0]), __uint_as_float(rr[1]));
}
constexpr int DA_KSL = 16384, DA_VRING = 49152, DA_WS = 133120, DA_STG = 65536, DA_STG_LD = 132;
template <bool DRY, int PVAR = 0>
__device__ __forceinline__ void diff_attn_unit(int b, int h, int qb, const u16* Qa, const u16* __restrict__ Ka, const u16* __restrict__ Va, const u16* __restrict__ Ga,
                                               u16* Y, const float* __restrict__ subw, float lam, float one_m_li, char* lds) {
    int tid = threadIdx.x; asm volatile("" : "+v"(tid)); const int lane = tid & 63, r32 = lane & 31, hi = lane >> 5; const int wid = __builtin_amdgcn_readfirstlane(tid >> 6);
    const int map = wid >> 2, wq = wid & 3;
    const long rowbase = (long)b * SEQ; const int q0 = qb * 128;
    float* wsf = (float*)(lds + DA_WS) + wid * 64; float* li_l = wsf; float* al_l = wsf + 32;
    float m_reg = 0.f, l_reg = 0; f32x16 o[4] = {}; bf16x8 qr[4]; f32x16 negm = f32x16{}; asm volatile("" : "+v"(negm));
    const unsigned lds0 = (unsigned)(uintptr_t)lds;
    const u16* Kh = Ka + rowbase * DM + h * 128; const u16* Vh = Va + rowbase * DM + h * 128;
    const int cb0 = map * 128;
    unsigned kofs[2], vofs[2];
#pragma unroll
    for (int i = 0; i < 2; ++i) { const int pk = 2 * wid + i;
        const int row = 4 * pk + (lane >> 4), cp = lane & 15; kofs[i] = (unsigned)(row * DM + ((cp ^ (row & 7)) * 8)) * 2u;
        const int st = 2 * pk + (lane >> 5), kk = 8 * (st >> 2) + ((lane & 31) >> 2), cc = 32 * (st & 3) + 8 * (lane & 3); vofs[i] = (unsigned)(kk * DM + cc) * 2u; }
    const char* Kg = (const char*)Kh; const char* Vg = (const char*)Vh;
#define DMA_K(t, slot) do { _Pragma("unroll") for (int i_ = 0; i_ < 2; ++i_) glds16(Kg + (size_t)(t) * (64 * DM * 2) + kofs[i_], (unsigned)__builtin_amdgcn_readfirstlane(lds0 + (slot) + (2 * wid + i_) * 1024)); } while (0)
#define DMA_V(t, slot) do { _Pragma("unroll") for (int i_ = 0; i_ < 2; ++i_) glds16(Vg + (size_t)(t) * (64 * DM * 2) + vofs[i_], (unsigned)__builtin_amdgcn_readfirstlane(lds0 + DA_VRING + (slot) + (2 * wid + i_) * 1024)); } while (0)
    DMA_K(0, 0); DMA_V(0, 0); DMA_K(1, DA_KSL);
    const u16* Qw = Qa + (rowbase + q0 + wq * 32 + r32) * DM + h * 128 + map * 64 + hi * 8;
#pragma unroll
    for (int d0 = 0; d0 < 4; ++d0) qr[d0] = ld8(Qw + d0 * 16);
    DMA_K(2, 2 * DA_KSL);
    int ka[4];
#pragma unroll
    for (int d0 = 0; d0 < 4; ++d0) ka[d0] = (int)lds0 + KSWZ(r32, cb0 + (d0 * 16 + hi * 8) * 2);
    const int vb0 = (int)lds0 + DA_VRING + v_rd_base(lane);
    constexpr int NT = SEQ / 64;
    f32x16 pA0, pA1, pB0, pB1; bf16x8 kf[8]; s16x4 vlo[4], vhi[4]; u32x4 pw0, pw1, pw2, pw3; bool resc = false;
    int sl_prev = 0, sl_cur = 0, sl_next = DA_KSL;
#define ROT() do { sl_prev = sl_cur; sl_cur = sl_next; sl_next = (sl_next == 2 * DA_KSL) ? 0 : sl_next + DA_KSL; } while (0)
#define RESC() do { if (resc) { _Pragma("unroll") for (int d_ = 0; d_ < 4; ++d_) _Pragma("unroll") for (int r = 0; r < 16; ++r) o[d_][r] *= al_l[crow(r, hi)]; } } while (0)
#define KLOAD(slot) do { _Pragma("unroll") for (int d0 = 0; d0 < 4; ++d0) { kf[2 * d0] = kld(ka[d0] + (slot)); kf[2 * d0 + 1] = kld(ka[d0] + (slot) + 8192); } } while (0)
    DA_WAIT_BAR(6);
    KLOAD(0);
    pA0 = DA_MFMA(kf[0], qr[0], negm); pA1 = DA_MFMA(kf[1], qr[0], negm); pA0 = DA_MFMA(kf[2], qr[1], pA0); pA1 = DA_MFMA(kf[3], qr[1], pA1);
    pA0 = DA_MFMA(kf[4], qr[2], pA0); pA1 = DA_MFMA(kf[5], qr[2], pA1); pA0 = DA_MFMA(kf[6], qr[3], pA0); pA1 = DA_MFMA(kf[7], qr[3], pA1);
    { const float rm = rowmax32(pA0, pA1); m_reg = rm;
#pragma unroll
      for (int r = 0; r < 16; ++r) { pA0[r] = __builtin_amdgcn_exp2f(pA0[r] - rm); pA1[r] = __builtin_amdgcn_exp2f(pA1[r] - rm); }
      fill16(negm, -m_reg); asm volatile("" : "+v"(negm)); }
    DA_WAIT_BAR(0);
    DMA_K(3, 0); DMA_V(1, DA_KSL); ROT();
    KLOAD(sl_cur);
    DA_WAIT_BAR(4);
#define PKW(P, i) cvtpk(P[i], P[(i) + 1])
#define PAF(w) __builtin_bit_cast(bf16x8, w)
#define VOFF(i) ((((i) & 3) * 512) + (((i) >> 2) * 4096))
#define VRD(s, i) do { vlo[s] = vtr(vp_ + VOFF(i)); vhi[s] = vtr(vp_ + VOFF(i) + 2048); } while (0)
#define VFR(s) PKF(vlo[s], vhi[s])
#define KRD(G, d0) do { if (G) { kf[2 * (d0)] = kld(ka[d0] + sl_next); kf[2 * (d0) + 1] = kld(ka[d0] + sl_next + 8192); SBAR(); } } while (0)
#define GAPA(CT, MF, a0, a1, a2, a3, W0, W1, PW) do { MF; DA_PIN(CT); sacc += a0; sacc += a1; sacc += a2; sacc += a3; W0; W1; DA_PIN(PW); DA_PIN(sacc); SBAR(); } while (0)
#define GAPB(MF, X, i, VR) do { MF; VR; X[i] = __builtin_amdgcn_exp2f(X[i]); X[(i) + 1] = __builtin_amdgcn_exp2f(X[(i) + 1]); DA_PIN(X); SBAR(); } while (0)
#define STEP(C0, C1, P0, P1, t, GK, GV, GL) do { SBAR(); \
    const int vp_ = vb0 + sl_prev; \
    float sacc = P0[0] + P0[1]; \
    GAPA(C0, C0 = DA_MFMA(kf[0], qr[0], negm), P0[2], P0[3], P0[4], P0[5],     pw0[0] = PKW(P0, 0),  pw0[1] = PKW(P0, 2),  pw0); \
    GAPA(C1, C1 = DA_MFMA(kf[1], qr[0], negm), P0[6], P0[7], P0[8], P0[9],     pw0[2] = PKW(P0, 4),  pw0[3] = PKW(P0, 6),  pw0); \
    GAPA(C0, C0 = DA_MFMA(kf[2], qr[1], C0),   P0[10], P0[11], P0[12], P0[13], pw1[0] = PKW(P0, 8),  pw1[1] = PKW(P0, 10), pw1); \
    GAPA(C1, C1 = DA_MFMA(kf[3], qr[1], C1),   P0[14], P0[15], P1[0], P1[1],   pw1[2] = PKW(P0, 12), pw1[3] = PKW(P0, 14), pw1); \
    VRD(0, 0); SBAR(); GAPA(C0, C0 = DA_MFMA(kf[4], qr[2], C0), P1[2], P1[3], P1[4], P1[5],     pw2[0] = PKW(P1, 0),  pw2[1] = PKW(P1, 2),  pw2); \
    VRD(1, 1); SBAR(); GAPA(C1, C1 = DA_MFMA(kf[5], qr[2], C1), P1[6], P1[7], P1[8], P1[9],     pw2[2] = PKW(P1, 4),  pw2[3] = PKW(P1, 6),  pw2); \
    VRD(2, 2); SBAR(); GAPA(C0, C0 = DA_MFMA(kf[6], qr[3], C0), P1[10], P1[11], P1[12], P1[13], pw3[0] = PKW(P1, 8),  pw3[1] = PKW(P1, 10), pw3); \
    VRD(3, 3); SBAR(); GAPA(C1, C1 = DA_MFMA(kf[7], qr[3], C1), P1[14], P1[15], 0.f, 0.f,       pw3[2] = PKW(P1, 12), pw3[3] = PKW(P1, 14), pw3); \
    l_reg += sacc; \
    if (GK) DMA_K((t) + 3, sl_cur); if (GV) DMA_V((t) + 1, sl_next);                            \
    { const float rm = rowmax32(C0, C1); resc = false;                                          \
      if (__builtin_expect(__any(rm > THRL), 0)) { const float dl = fmaxf(rm, 0.f); m_reg += dl;    \
          const float f_ = __builtin_amdgcn_exp2f(-dl); l_reg *= f_; if (hi == 0) al_l[r32] = f_; resc = true; \
          _Pragma("unroll") for (int r = 0; r < 16; ++r) { C0[r] -= dl; C1[r] -= dl; } \
          fill16(negm, -m_reg); asm volatile("" : "+v"(negm)); } } \
    SBAR(); \
    GAPB(o[0] = DA_MFMA(PAF(pw0), VFR(0), o[0]), C0, 0, VRD(0, 4));  GAPB(o[1] = DA_MFMA(PAF(pw0), VFR(1), o[1]), C0, 2, VRD(1, 5)); \
    KRD(GL, 0); GAPB(o[2] = DA_MFMA(PAF(pw0), VFR(2), o[2]), C0, 4, VRD(2, 6));  KRD(GL, 1); GAPB(o[3] = DA_MFMA(PAF(pw0), VFR(3), o[3]), C0, 6, VRD(3, 7)); \
    KRD(GL, 2); GAPB(o[0] = DA_MFMA(PAF(pw1), VFR(0), o[0]), C0, 8, VRD(0, 8));  KRD(GL, 3); GAPB(o[1] = DA_MFMA(PAF(pw1), VFR(1), o[1]), C0, 10, VRD(1, 9)); \
    GAPB(o[2] = DA_MFMA(PAF(pw1), VFR(2), o[2]), C0, 12, VRD(2, 10)); GAPB(o[3] = DA_MFMA(PAF(pw1), VFR(3), o[3]), C0, 14, VRD(3, 11)); \
    GAPB(o[0] = DA_MFMA(PAF(pw2), VFR(0), o[0]), C1, 0, VRD(0, 12));  GAPB(o[1] = DA_MFMA(PAF(pw2), VFR(1), o[1]), C1, 2, VRD(1, 13)); \
    GAPB(o[2] = DA_MFMA(PAF(pw2), VFR(2), o[2]), C1, 4, VRD(2, 14));  GAPB(o[3] = DA_MFMA(PAF(pw2), VFR(3), o[3]), C1, 6, VRD(3, 15)); \
    GAPB(o[0] = DA_MFMA(PAF(pw3), VFR(0), o[0]), C1, 8, (void)0);     GAPB(o[1] = DA_MFMA(PAF(pw3), VFR(1), o[1]), C1, 10, (void)0); \
    GAPB(o[2] = DA_MFMA(PAF(pw3), VFR(2), o[2]), C1, 12, (void)0);    GAPB(o[3] = DA_MFMA(PAF(pw3), VFR(3), o[3]), C1, 14, (void)0); \
    } while (0)
    int t = 1;
    for (; t + 5 < NT; t += 2) {
        STEP(pB0, pB1, pA0, pA1, t, true, true, true);     DA_WAIT_BAR(4); RESC(); ROT();
        STEP(pA0, pA1, pB0, pB1, t + 1, true, true, true); DA_WAIT_BAR(4); RESC(); ROT();
    }
#define ENDW(tt) do { if ((tt) + 3 < NT) { DA_WAIT_BAR(4); } else if ((tt) + 2 < NT) { DA_WAIT_BAR(2); } else { DA_WAIT_BAR(0); } } while (0)
    for (; t + 1 < NT; t += 2) {
        STEP(pB0, pB1, pA0, pA1, t, (t + 3 < NT), (t + 1 < NT), (t + 1 < NT));         ENDW(t);     RESC(); ROT();
        STEP(pA0, pA1, pB0, pB1, t + 1, (t + 4 < NT), (t + 2 < NT), (t + 2 < NT));     ENDW(t + 1); RESC(); ROT();
    }
    STEP(pB0, pB1, pA0, pA1, NT - 1, false, false, false); RESC();
    { float sacc = pB0[0] + pB0[1];
#pragma unroll
      for (int r = 2; r < 16; ++r) sacc += pB0[r];
#pragma unroll
      for (int r = 0; r < 16; ++r) sacc += pB1[r];
      l_reg += sacc;
      pw0 = (u32x4){PKW(pB0, 0), PKW(pB0, 2), PKW(pB0, 4), PKW(pB0, 6)}; pw1 = (u32x4){PKW(pB0, 8), PKW(pB0, 10), PKW(pB0, 12), PKW(pB0, 14)};
      pw2 = (u32x4){PKW(pB1, 0), PKW(pB1, 2), PKW(pB1, 4), PKW(pB1, 6)}; pw3 = (u32x4){PKW(pB1, 8), PKW(pB1, 10), PKW(pB1, 12), PKW(pB1, 14)};
      pv_da(o, vb0 + sl_cur, PAF(pw0), PAF(pw1), PAF(pw2), PAF(pw3)); }
    { auto rr = __builtin_amdgcn_permlane32_swap(__float_as_uint(l_reg), __float_as_uint(l_reg), false, false); l_reg = __uint_as_float(rr[0]) + __uint_as_float(rr[1]); }
#undef DMA_K
#undef DMA_V
#undef ROT
#undef RESC
#undef KLOAD
#undef PKW
#undef PAF
#undef VOFF
#undef VRD
#undef VFR
#undef KRD
#undef GAPA
#undef GAPB
#undef STEP
#undef ENDW
    if (hi == 0) li_l[r32] = l_reg; asm volatile("s_waitcnt lgkmcnt(0)" ::: "memory");
    float rli[16];
#pragma unroll
    for (int r = 0; r < 16; ++r) rli[r] = __builtin_amdgcn_rcpf(li_l[crow(r, hi)]) * (map ? lam : 1.0f);
    __syncthreads();
    float* xch = (float*)lds;
    if (map == 1) {
#pragma unroll
        for (int d0 = 0; d0 < 4; ++d0)
#pragma unroll
            for (int r = 0; r < 16; ++r) xch[((wq * 4 + d0) * 16 + r) * 64 + lane] = o[d0][r] * rli[r];
    }
    __syncthreads();
    float* stg = (float*)(lds + DA_STG);
    if (map == 0) {
#pragma unroll
        for (int d0 = 0; d0 < 4; ++d0)
#pragma unroll
            for (int r = 0; r < 16; ++r) { const float dv = o[d0][r] * rli[r] - xch[((wq * 4 + d0) * 16 + r) * 64 + lane];
                stg[(wq * 32 + crow(r, hi)) * DA_STG_LD + d0 * 32 + r32] = dv; }
    }
    __syncthreads();
    {
        const int row = tid >> 2, qt = tid & 3; const float* sp = stg + row * DA_STG_LD + qt * 32;
        f32x4 dv[8]; float ss = 0.f;
#pragma unroll
        for (int g = 0; g < 8; ++g) { dv[g] = *(const f32x4*)(sp + g * 4); ss += (dv[g][0] * dv[g][0] + dv[g][1] * dv[g][1]) + (dv[g][2] * dv[g][2] + dv[g][3] * dv[g][3]); }
        ss += __shfl_xor(ss, 1); ss += __shfl_xor(ss, 2);
        const float sc2 = __builtin_amdgcn_rsqf(ss * (1.0f / 128.0f) + EPS) * one_m_li;
        const size_t goff = (size_t)(rowbase + q0 + row) * DM + h * 128 + qt * 32;
#pragma unroll
        for (int g = 0; g < 4; ++g) {
            const bf16x8 gt = ld8(Ga + goff + g * 8);
            const f32x4 w0 = *(const f32x4*)(subw + qt * 32 + g * 8), w1 = *(const f32x4*)(subw + qt * 32 + g * 8 + 4);
            const f32x4 a = dv[2 * g], c = dv[2 * g + 1];
            u32x4 w;
            w.x = cvtpk(a[0] * sc2 * w0[0] * bf2f((u16)gt[0]), a[1] * sc2 * w0[1] * bf2f((u16)gt[1]));
            w.y = cvtpk(a[2] * sc2 * w0[2] * bf2f((u16)gt[2]), a[3] * sc2 * w0[3] * bf2f((u16)gt[3]));
            w.z = cvtpk(c[0] * sc2 * w1[0] * bf2f((u16)gt[4]), c[1] * sc2 * w1[1] * bf2f((u16)gt[5]));
            w.w = cvtpk(c[2] * sc2 * w1[2] * bf2f((u16)gt[6]), c[3] * sc2 * w1[3] * bf2f((u16)gt[7]));
            if (!DRY) *(u32x4*)(Y + goff + g * 8) = w; else asm volatile("" :: "v"(w));
        }
    }
    __syncthreads();
}

constexpr int SWB_K = 0, SWB_V = 49152, SWB_WS = 98304, SWB_STG = 100352, SWB_STG_LD = 36;
__device__ __forceinline__ void swa_block_geom(int qb, int& t_lo, int& t_hi) { const int q0 = qb * 128; t_lo = (q0 >= 128 ? q0 - 128 : 0) >> 6; t_hi = (q0 + 255 < SEQ ? q0 + 255 : SEQ - 1) >> 6; }
template <int N> struct SwaRegs { bf16x8 k[N], v[N]; };
template <int N> __device__ __forceinline__ void swa_tiles_load(SwaRegs<N>& R, int b, int kvh, int t0, int nt, const u16* __restrict__ Kb, const u16* __restrict__ Vb, int tid) {
    const int sr = tid >> 3, sc = (tid & 7) * 8; const long rowbase = (long)b * SEQ;
    const u16* Kh = Kb + (rowbase + t0 * 64 + sr) * 256 + kvh * 64 + sc; const u16* Vh = Vb + (rowbase + t0 * 64 + sr) * 256 + kvh * 64 + sc;
#pragma unroll
    for (int tt = 0; tt < N; ++tt) if (tt < nt) { R.k[tt] = ld8(Kh + (long)tt * 64 * 256); R.v[tt] = ld8(Vh + (long)tt * 64 * 256); }
}
template <int N> __device__ __forceinline__ void swa_tiles_store_lds(const SwaRegs<N>& R, int t0, int nt, char* lds, int tid) {
    const int sr = tid >> 3, sc = (tid & 7) * 8, vst0 = v_stn<2>(sr, sc), kst0 = KSWZ128(sr, sc * 2);
#pragma unroll
    for (int tt = 0; tt < N; ++tt) if (tt < nt) { const int sl = (t0 + tt) % 6; *(bf16x8*)(lds + SWB_K + sl * 8192 + kst0) = R.k[tt]; *(bf16x8*)(lds + SWB_V + sl * 8192 + vst0) = R.v[tt]; }
}
template <bool DRY>
__device__ __forceinline__ void swa_block_compute(int b, int kvh, int qb, const u16* Q, const u16* __restrict__ Gt, u16* Y, const float* __restrict__ sink, char* lds, int tid) {
    const int lane = tid & 63, r32 = lane & 31, hi = lane >> 5; const int wid = __builtin_amdgcn_readfirstlane(tid >> 6);
    const int hq = kvh * 8 + wid; const long rowbase = (long)b * SEQ; const int q0 = qb * 128;
    int t_lo, t_hib; swa_block_geom(qb, t_lo, t_hib); (void)t_hib;
    float* wsf = (float*)(lds + SWB_WS) + wid * 64; float* al_l = wsf + 32;
    float* stg = (float*)(lds + SWB_STG) + wid * (32 * SWB_STG_LD);
    const int vb0 = (int)(uintptr_t)(lds + SWB_V) + v_rd_base(lane);
    const float sink2 = sink[hq] * LOG2E;
    bf16x8 qn[4];
    { const u16* Qw = Q + (rowbase + q0 + r32) * DIN + hq * 64 + hi * 8;
#pragma unroll
      for (int d0 = 0; d0 < 4; ++d0) qn[d0] = ld8(Qw + d0 * 16); }
#pragma unroll 1
    for (int sub = 0; sub < 4; ++sub) {
        const int qs = q0 + 32 * sub;
        bf16x8 qr[4];
#pragma unroll
        for (int d0 = 0; d0 < 4; ++d0) qr[d0] = qn[d0];
        if (sub < 3) { const u16* Qw = Q + (rowbase + qs + 32 + r32) * DIN + hq * 64 + hi * 8;
#pragma unroll
            for (int d0 = 0; d0 < 4; ++d0) qn[d0] = ld8(Qw + d0 * 16); }
        const int ta = ((qs >= 128 ? qs - 128 : 0) >> 6) - t_lo, tb = ((qs + 159 < SEQ ? qs + 159 : SEQ - 1) >> 6) - t_lo;
        float m_reg = sink2, l_dummy = 0.f; f32x16 o[2] = {}; f32x16 lacc, negm; fill16(lacc, 1.0f); fill16(negm, -sink2);
        const bf16x8 ones = {0x3F80, 0x3F80, 0x3F80, 0x3F80, 0x3F80, 0x3F80, 0x3F80, 0x3F80};
        bf16x8 gpre[2][2];
        { const size_t gb = (size_t)(rowbase + qs + (lane >> 1)) * DIN + hq * 64 + (lane & 1) * 16;
#pragma unroll
          for (int cbk = 0; cbk < 2; ++cbk) { gpre[cbk][0] = ld8(Gt + gb + cbk * 32); gpre[cbk][1] = ld8(Gt + gb + cbk * 32 + 8); } }
        for (int tt = ta; tt <= tb; ++tt) {
            const int k0 = (t_lo + tt) * 64, sl = (t_lo + tt) % 6;
            f32x16 p0, p1;
            const char* Ks = lds + SWB_K + sl * 8192;
#pragma unroll
            for (int d0 = 0; d0 < 4; ++d0) { const int cb = (d0 * 16 + hi * 8) * 2;
                const bf16x8 b0 = *reinterpret_cast<const bf16x8*>(Ks + KSWZ128(r32, cb));
                const bf16x8 b1 = *reinterpret_cast<const bf16x8*>(Ks + KSWZ128(32 + r32, cb));
                if (d0 == 0) { p0 = __builtin_amdgcn_mfma_f32_32x32x16_bf16(b0, qr[0], negm, 0, 0, 0); p1 = __builtin_amdgcn_mfma_f32_32x32x16_bf16(b1, qr[0], negm, 0, 0, 0); }
                else { p0 = __builtin_amdgcn_mfma_f32_32x32x16_bf16(b0, qr[d0], p0, 0, 0, 0); p1 = __builtin_amdgcn_mfma_f32_32x32x16_bf16(b1, qr[d0], p1, 0, 0, 0); } }
            if (k0 < qs - 97 || k0 + 63 > qs + 128) {
                const int base = k0 - qs - r32 + 4 * hi + 128;
#pragma unroll
                for (int r = 0; r < 16; ++r) { const int c = (r & 3) + 8 * (r >> 2); if ((unsigned)(base + c) > 256u) p0[r] = -1e30f; if ((unsigned)(base + c + 32) > 256u) p1[r] = -1e30f; }
            }
            float alpha; bf16x8 pa0, pa1, pa2, pa3;
            partialSM_n<false>(p0, p1, m_reg, negm, alpha);
            if (__any(alpha < 1.f)) { if (hi == 0) al_l[r32] = alpha; asm volatile("s_waitcnt lgkmcnt(0)" ::: "memory");
#pragma unroll
                for (int r = 0; r < 16; ++r) { const float al = al_l[crow(r, hi)]; o[0][r] *= al; o[1][r] *= al; lacc[r] *= al; } }
            finishSM_n<false>(p0, p1, alpha, l_dummy, pa0, pa1, pa2, pa3);
            {
                const int vbt = vb0 + sl * 8192; s16x4 lo[4], hi4[4];
#define VADDR2(i) (vbt + ((i) & 1) * 512 + ((i) >> 1) * 2048)
#pragma unroll
                for (int i = 0; i < 4; ++i) { lo[i] = vtr(VADDR2(i)); hi4[i] = vtr(VADDR2(i) + 1024); }
#pragma unroll
                for (int i = 0; i < 8; ++i) {
                    const bf16x8 vf = PKF(lo[i & 3], hi4[i & 3]);
                    const bf16x8 pa = ((i >> 1) == 0) ? pa0 : ((i >> 1) == 1) ? pa1 : ((i >> 1) == 2) ? pa2 : pa3;
                    o[i & 1] = __builtin_amdgcn_mfma_f32_32x32x16_bf16(pa, vf, o[i & 1], 0, 0, 0);
                    if ((i & 1) == 1) lacc = __builtin_amdgcn_mfma_f32_32x32x16_bf16(pa, ones, lacc, 0, 0, 0);
                    if (i + 4 < 8) { lo[i & 3] = vtr(VADDR2(i + 4)); hi4[i & 3] = vtr(VADDR2(i + 4) + 1024); }
                }
#undef VADDR2
            }
        }
        float rl[16];
#pragma unroll
        for (int r = 0; r < 16; ++r) rl[r] = __builtin_amdgcn_rcpf(lacc[r]);
#pragma unroll
        for (int cbk = 0; cbk < 2; ++cbk) {
#pragma unroll
            for (int r = 0; r < 16; ++r) stg[crow(r, hi) * SWB_STG_LD + r32] = o[cbk][r] * rl[r];
            asm volatile("s_waitcnt lgkmcnt(0)" ::: "memory");
            const int row = lane >> 1, hf = lane & 1; const float* sp = stg + row * SWB_STG_LD + hf * 16;
            const f32x4 a0 = *(const f32x4*)(sp), a1 = *(const f32x4*)(sp + 4), a2 = *(const f32x4*)(sp + 8), a3 = *(const f32x4*)(sp + 12);
            const size_t goff = (size_t)(rowbase + qs + row) * DIN + hq * 64 + cbk * 32 + hf * 16;
            const bf16x8 g0 = gpre[cbk][0], g1 = gpre[cbk][1];
            u32x4 w0, w1;
            w0.x = cvtpk(a0[0] * bf2f((u16)g0[0]), a0[1] * bf2f((u16)g0[1])); w0.y = cvtpk(a0[2] * bf2f((u16)g0[2]), a0[3] * bf2f((u16)g0[3]));
            w0.z = cvtpk(a1[0] * bf2f((u16)g0[4]), a1[1] * bf2f((u16)g0[5])); w0.w = cvtpk(a1[2] * bf2f((u16)g0[6]), a1[3] * bf2f((u16)g0[7]));
            w1.x = cvtpk(a2[0] * bf2f((u16)g1[0]), a2[1] * bf2f((u16)g1[1])); w1.y = cvtpk(a2[2] * bf2f((u16)g1[2]), a2[3] * bf2f((u16)g1[3]));
            w1.z = cvtpk(a3[0] * bf2f((u16)g1[4]), a3[1] * bf2f((u16)g1[5])); w1.w = cvtpk(a3[2] * bf2f((u16)g1[6]), a3[3] * bf2f((u16)g1[7]));
            if (!DRY) { *(u32x4*)(Y + goff) = w0; *(u32x4*)(Y + goff + 8) = w1; } else asm volatile("" :: "v"(w0), "v"(w1));
            asm volatile("s_waitcnt lgkmcnt(0)" ::: "memory");
        }
    }
}
template <bool DRY>
__device__ __forceinline__ void swa_phase(int u0, const u16* Q, const u16* Kb, const u16* Vb, const u16* Gt, u16* Y, const float* sink, char* lds) {
    int tid = threadIdx.x; asm volatile("" : "+v"(tid));
    const int bk = u0 >> 5, b = bk >> 2, kvh = bk & 3, qbA = u0 & 31, qbB = qbA + 1;
    int tloA, thiA, tloB, thiB; swa_block_geom(qbA, tloA, thiA); swa_block_geom(qbB, tloB, thiB);
    { SwaRegs<6> R; swa_tiles_load<6>(R, b, kvh, tloA, thiA - tloA + 1, Kb, Vb, tid); swa_tiles_store_lds<6>(R, tloA, thiA - tloA + 1, lds, tid); }
    __syncthreads();
    SwaRegs<2> N; const int nnew = thiB - thiA;
    swa_tiles_load<2>(N, b, kvh, thiA + 1, nnew, Kb, Vb, tid);
    swa_block_compute<DRY>(b, kvh, qbA, Q, Gt, Y, sink, lds, tid);
    __syncthreads();
    swa_tiles_store_lds<2>(N, thiA + 1, nnew, lds, tid);
    __syncthreads();
    swa_block_compute<DRY>(b, kvh, qbB, Q, Gt, Y, sink, lds, tid);
    __syncthreads();
}
}
namespace hg {
using namespace att;
typedef _Float16 f16;
constexpr int L_QT = 0, L_KT = 16384, L_QIN = 32768, L_KDEC = 49152, L_V = 65536, L_S = 81920, L_CUM = 114688, L_EDEC = 118784, L_STG = 0, STG_LD = 132;

struct ChunkRegs { unsigned q[8], v[8], lf[8]; };

__device__ __forceinline__ int chunk_pos(int c, int i, int dir) { return dir ? (c * 64 + 63 - i) : (c * 64 + i); }

template <bool NEEDQ>
__device__ __forceinline__ void load_chunk(ChunkRegs& R, const u16* Qh, const u16* Vh, const u16* LF, long rowbase, int colbase, int c, int dir, int wid, int lane) {
#pragma unroll
    for (int i = 0; i < 8; ++i) {
        const long pos = rowbase + chunk_pos(c, wid * 8 + i, dir);
        const size_t off = (size_t)pos * DM + colbase + 2 * lane;
        if (NEEDQ) R.q[i] = *(const unsigned*)(Qh + off);
        R.v[i] = *(const unsigned*)(Vh + off);
        R.lf[i] = *(const unsigned*)(LF + off);
    }
}
__device__ __forceinline__ float h2f(unsigned short h) { return (float)__builtin_bit_cast(f16, h); }

template <bool FULL>
__device__ __forceinline__ void prep_chunk(const ChunkRegs& R, char* lds, int wid, int lane, float (&gtot)[2]) {
    float g[8][2]; float run0 = 0.f, run1 = 0.f;
#pragma unroll
    for (int i = 0; i < 8; ++i) { run0 += h2f((unsigned short)(R.lf[i] & 0xffff)); run1 += h2f((unsigned short)(R.lf[i] >> 16)); g[i][0] = run0; g[i][1] = run1; }
    float* cum = (float*)(lds + L_CUM);
    *(float2*)(cum + wid * 128 + 2 * lane) = make_float2(run0, run1);
    __syncthreads();
    float pre0 = 0.f, pre1 = 0.f, gm0 = 0.f, gm1 = 0.f, gl0 = 0.f, gl1 = 0.f;
#pragma unroll
    for (int w2 = 0; w2 < 8; ++w2) { const float2 t = *(const float2*)(cum + w2 * 128 + 2 * lane);
        if (w2 < wid) { pre0 += t.x; pre1 += t.y; } if (w2 < 4) { gm0 += t.x; gm1 += t.y; } gl0 += t.x; gl1 += t.y; }
    gtot[0] += gl0; gtot[1] += gl1;
    const float egm0 = __expf(gm0), egm1 = __expf(gm1), elm0 = __expf(gl0 - gm0), elm1 = __expf(gl1 - gm1);
    if (wid == 0) *(float2*)((float*)(lds + L_EDEC) + 2 * lane) = make_float2(__expf(gl0), __expf(gl1));
#pragma unroll
    for (int i = 0; i < 8; ++i) {
        const int row = wid * 8 + i;
        const float G0 = pre0 + g[i][0], G1 = pre1 + g[i][1];
        const float e0 = __expf(G0 - gm0), e1 = __expf(G1 - gm1);
        const float r0 = __builtin_amdgcn_rcpf(e0), r1 = __builtin_amdgcn_rcpf(e1);
        const float lf0 = h2f((unsigned short)(R.lf[i] & 0xffff)), lf1 = h2f((unsigned short)(R.lf[i] >> 16));
        const float k0 = 1.0f - __expf(lf0), k1 = 1.0f - __expf(lf1);
        const float kt0 = k0 * r0, kt1 = k1 * r1;
        const int vo = v_st<4>(row, 2 * lane);
        *(unsigned*)(lds + L_KDEC + vo) = cvtpk(kt0 * elm0, kt1 * elm1);
        *(unsigned*)(lds + L_V + vo) = R.v[i];
        if (FULL) {
            const float q0 = bf2f((u16)(R.q[i] & 0xffff)), q1 = bf2f((u16)(R.q[i] >> 16));
            const float qt0 = q0 * e0, qt1 = q1 * e1;
            const int ko = KSWZ(row, 4 * lane);
            *(unsigned*)(lds + L_QT + ko) = cvtpk(qt0, qt1);
            *(unsigned*)(lds + L_KT + ko) = cvtpk(kt0, kt1);
            *(unsigned*)(lds + L_QIN + ko) = cvtpk(qt0 * egm0, qt1 * egm1);
        }
    }
}

template <int KS> __device__ __forceinline__ bf16x8 tr_frag(int vb) {
    const s16x4 l = tr_read<KS * 4096>(vb), h = tr_read<KS * 4096 + 2048>(vb);
    asm volatile("s_waitcnt lgkmcnt(0)" ::: "memory"); SBAR();
    return PKF(l, h);
}

struct SuFrag { s16x4 lv, hv, l0, h0, l1, h1; };
__device__ __forceinline__ void su_read(SuFrag& f, int vbV, int vbK0, int vbK1, int off) {
    f.lv = vtr(vbV + off); f.hv = vtr(vbV + off + 2048); f.l0 = vtr(vbK0 + off); f.h0 = vtr(vbK0 + off + 2048); f.l1 = vtr(vbK1 + off); f.h1 = vtr(vbK1 + off + 2048);
}
__device__ __forceinline__ void su_mma(f32x16 (&sacc)[2], const SuFrag& f) {
    const bf16x8 bv = PKF(f.lv, f.hv), a0 = PKF(f.l0, f.h0), a1 = PKF(f.l1, f.h1);
    sacc[0] = __builtin_amdgcn_mfma_f32_32x32x16_bf16(a0, bv, sacc[0], 0, 0, 0); sacc[1] = __builtin_amdgcn_mfma_f32_32x32x16_bf16(a1, bv, sacc[1], 0, 0, 0);
}
template <int NIMG>
__device__ __forceinline__ void state_update_t(f32x16 (&sacc)[2], const char* lds, int ldsbase, int offK, int offV, int offE, int wid, int lane) {
    const int hi = lane >> 5, j = wid >> 1, ib = 2 * (wid & 1);
    const float* edec = (const float*)(lds + offE);
    const int vbV = ldsbase + offV + v_rd_base(lane) + j * 512;
    const int vbK0 = ldsbase + offK + v_rd_base(lane) + ib * 512, vbK1 = vbK0 + 512;
#pragma unroll
    for (int i2 = 0; i2 < 2; ++i2)
#pragma unroll
        for (int r = 0; r < 16; ++r) sacc[i2][r] *= edec[32 * (ib + i2) + crow(r, hi)];
    SBAR();
    SuFrag fa, fb; su_read(fa, vbV, vbK0, vbK1, 0);
#pragma unroll
    for (int s = 0; s < 4 * NIMG; s += 2) {
        su_read(fb, vbV, vbK0, vbK1, ((s + 1) >> 2) * 16384 + ((s + 1) & 3) * 4096);
        su_mma(sacc, fa);
        if (s + 2 < 4 * NIMG) su_read(fa, vbV, vbK0, vbK1, ((s + 2) >> 2) * 16384 + ((s + 2) & 3) * 4096);
        su_mma(sacc, fb);
    }
    __builtin_amdgcn_sched_group_barrier(0x100, 6, 0);
#pragma unroll
    for (int s = 0; s < 4 * NIMG - 1; ++s) { __builtin_amdgcn_sched_group_barrier(0x100, 6, 0); __builtin_amdgcn_sched_group_barrier(0x008, 2, 0); }
    __builtin_amdgcn_sched_group_barrier(0x008, 2, 0);
    SBAR();
}
__device__ __forceinline__ void state_update(f32x16 (&sacc)[2], const char* lds, int ldsbase, int wid, int lane) { state_update_t<1>(sacc, lds, ldsbase, L_KDEC, L_V, L_EDEC, wid, lane); }
__device__ __forceinline__ void write_simg(const f32x16 (&sacc)[2], char* lds, int wid, int lane) {
    const int r32 = lane & 31, hi = lane >> 5, j = wid >> 1, ib = 2 * (wid & 1);
#pragma unroll
    for (int i2 = 0; i2 < 2; ++i2)
#pragma unroll
        for (int r = 0; r < 16; ++r) { const int d = 32 * (ib + i2) + crow(r, hi);
            *(__hip_bfloat16*)(lds + L_S + (d >> 6) * 16384 + v_st<4>(d & 63, 32 * j + r32)) = __float2bfloat16(sacc[i2][r]); }
}
__device__ __forceinline__ f32x16 chunk_output(const char* lds, int ldsbase, int wid, int lane) {
    const int r32 = lane & 31, hi = lane >> 5, tb = wid & 1, j = wid >> 1;
    const char* QT = lds + L_QT; const char* KT = lds + L_KT; const char* QIN = lds + L_QIN;
    f32x16 p0 = f32x16{}, p1 = f32x16{};
#pragma unroll
    for (int d0 = 0; d0 < 8; ++d0) { const int cb = (d0 * 16 + hi * 8) * 2;
        const bf16x8 qf = *reinterpret_cast<const bf16x8*>(QT + KSWZ(32 * tb + r32, cb));
        const bf16x8 k0 = *reinterpret_cast<const bf16x8*>(KT + KSWZ(r32, cb));
        p0 = __builtin_amdgcn_mfma_f32_32x32x16_bf16(k0, qf, p0, 0, 0, 0);
        if (tb) { const bf16x8 k1 = *reinterpret_cast<const bf16x8*>(KT + KSWZ(32 + r32, cb)); p1 = __builtin_amdgcn_mfma_f32_32x32x16_bf16(k1, qf, p1, 0, 0, 0); } }
#pragma unroll
    for (int r = 0; r < 16; ++r) { const bool keep = crow(r, hi) <= r32; if (tb == 0) { p0[r] = keep ? p0[r] : 0.f; p1[r] = 0.f; } else { p1[r] = keep ? p1[r] : 0.f; } }
    bf16x8 pa0, pa1, pa2, pa3; pack4(p0, p1, pa0, pa1, pa2, pa3);
    f32x16 oacc = f32x16{};
    pv_blk<4>(oacc, ldsbase + L_V + v_rd_base(lane) + j * 512, pa0, pa1, pa2, pa3);
    const int vbS = ldsbase + L_S + v_rd_base(lane) + j * 512;
#define QINF(kd) (*reinterpret_cast<const bf16x8*>(QIN + KSWZ(32 * tb + r32, ((kd) * 16 + hi * 8) * 2)))
    {
        s16x4 lo[2], hh[2];
#define SADDR(kd) (vbS + ((kd) >> 2) * 16384 + ((kd) & 3) * 4096)
        lo[0] = vtr(SADDR(0)); hh[0] = vtr(SADDR(0) + 2048); lo[1] = vtr(SADDR(1)); hh[1] = vtr(SADDR(1) + 2048);
#pragma unroll
        for (int kd = 0; kd < 8; ++kd) {
            const bf16x8 b = PKF(lo[kd & 1], hh[kd & 1]); const bf16x8 q = QINF(kd);
            oacc = __builtin_amdgcn_mfma_f32_32x32x16_bf16(q, b, oacc, 0, 0, 0);
            if (kd + 2 < 8) { lo[kd & 1] = vtr(SADDR(kd + 2)); hh[kd & 1] = vtr(SADDR(kd + 2) + 2048); }
        }
#undef SADDR
    }
#undef QINF
    return oacc;
}

constexpr int P1_KDEC = 0, P1_V = 65536, P1_CUM = 131072, P1_EDEC = 135168;
struct BlockRegs { unsigned v[32], lf[32]; };
__device__ __forceinline__ void load_block(BlockRegs& R, const u16* Vh, const u16* LF, long rowbase, int colbase, int seg, int blk, int dir, int wid, int lane) {
    unsigned voff = (unsigned)lane * 4u; asm volatile("" : "+v"(voff));
#pragma unroll
    for (int i = 0; i < 32; ++i) {
        const int p = blk * 256 + wid * 32 + i;
        const long pos = rowbase + seg * 512 + (dir ? 511 - p : p);
        const size_t roff = ((size_t)pos * DM + colbase) * 2;
        R.v[i] = *(const unsigned*)((const char*)Vh + roff + voff); R.lf[i] = *(const unsigned*)((const char*)LF + roff + voff);
    }
}
__device__ __forceinline__ void prep_block(const BlockRegs& R, char* lds, int wid, int lane, float (&gtot)[2]) {
    float run0 = 0.f, run1 = 0.f;
#pragma unroll
    for (int i = 0; i < 32; ++i) { run0 += h2f((unsigned short)(R.lf[i] & 0xffff)); run1 += h2f((unsigned short)(R.lf[i] >> 16)); }
    float* cum = (float*)(lds + P1_CUM);
    *(float2*)(cum + wid * 128 + 2 * lane) = make_float2(run0, run1);
    __syncthreads();
    float pre0 = 0.f, pre1 = 0.f, gl0 = 0.f, gl1 = 0.f;
#pragma unroll
    for (int w2 = 0; w2 < 8; ++w2) { const float2 t = *(const float2*)(cum + w2 * 128 + 2 * lane); if (w2 < wid) { pre0 += t.x; pre1 += t.y; } gl0 += t.x; gl1 += t.y; }
    gtot[0] += gl0; gtot[1] += gl1;
    if (wid == 0) *(float2*)((float*)(lds + P1_EDEC) + 2 * lane) = make_float2(__expf(gl0), __expf(gl1));
    float G0 = pre0 - gl0, G1 = pre1 - gl1;
    char* base = lds + (wid >> 1) * 16384 + (wid & 1) * 8192 + v_st<4>(0, 2 * lane);
#pragma unroll
    for (int i = 0; i < 32; ++i) {
        const float lf0 = h2f((unsigned short)(R.lf[i] & 0xffff)), lf1 = h2f((unsigned short)(R.lf[i] >> 16));
        G0 += lf0; G1 += lf1;
        const float k0 = 1.0f - __expf(lf0), k1 = 1.0f - __expf(lf1);
        const int vo = v_st<4>(i, 0);
        *(unsigned*)(base + P1_KDEC + vo) = cvtpk(k0 * __expf(-G0), k1 * __expf(-G1));
        *(unsigned*)(base + P1_V + vo) = R.v[i];
    }
}
__device__ __forceinline__ void state_update_block(f32x16 (&sacc)[2], const char* lds, int ldsbase, int wid, int lane) { state_update_t<4>(sacc, lds, ldsbase, P1_KDEC, P1_V, P1_EDEC, wid, lane); }
__device__ __forceinline__ void hgrn_pass1(int item, const u16* Vt, const u16* LF0, const u16* LF1, float* ust, float* dst, char* lds) {
    int tid = threadIdx.x; asm volatile("" : "+v"(tid)); const int lane = tid & 63; const int wid = __builtin_amdgcn_readfirstlane(tid >> 6);
    const int seg = item & 7, dir = (item >> 3) & 1, bh = item >> 4, b = bh >> 3, h = bh & 7;
    const long rowbase = (long)b * SEQ; const int colbase = h * 128; const u16* LF = dir ? LF1 : LF0;
    const int ldsbase = (int)(uintptr_t)lds;
    f32x16 sacc[2] = {}; float gtot[2] = {0.f, 0.f};
    BlockRegs R;
    load_block(R, Vt, LF, rowbase, colbase, seg, 0, dir, wid, lane);
#pragma unroll 1
    for (int blk = 0; blk < 2; ++blk) {
        prep_block(R, lds, wid, lane, gtot);
        asm volatile("" ::: "memory");
        if (blk == 0) load_block(R, Vt, LF, rowbase, colbase, seg, 1, dir, wid, lane);
        __syncthreads();
        state_update_block(sacc, lds, ldsbase, wid, lane);
    }
    float* up = ust + (size_t)item * 16384 + wid * 2048;
#pragma unroll
    for (int i2 = 0; i2 < 2; ++i2)
#pragma unroll
        for (int r = 0; r < 16; ++r) up[(i2 * 16 + r) * 64 + lane] = sacc[i2][r];
    if (wid == 0) *(float2*)(dst + (size_t)item * 128 + 2 * lane) = make_float2(__expf(gtot[0]), __expf(gtot[1]));
    __syncthreads();
}

template <bool DRY, int PVAR = 0>
__device__ __forceinline__ void hgrn_pass2(int item, const u16* Qh, const u16* Vt, const u16* LF0, const u16* LF1, const u16* Gt, u16* OF, u16* Y,
                                           const float* ust, const float* dst, const float* __restrict__ nw, char* lds) {
    int tid = threadIdx.x; asm volatile("" : "+v"(tid)); const int lane = tid & 63, r32 = lane & 31, hi = lane >> 5; const int wid = __builtin_amdgcn_readfirstlane(tid >> 6);
    const int seg = item & 7, bh = item >> 3, b = bh >> 3, h = bh & 7;
    const long rowbase = (long)b * SEQ; const int colbase = h * 128;
    const int ldsbase = (int)(uintptr_t)lds; const int tb = wid & 1, j = wid >> 1, ib = 2 * (wid & 1);
    float* stg = (float*)(lds + L_STG);
    ChunkRegs R;
#pragma unroll 1
    for (int dir = 0; dir < 2; ++dir) {
        const u16* LF = dir ? LF1 : LF0;
        f32x16 sacc[2] = {}; float gtot[2] = {0.f, 0.f};
        const int nseg = dir ? (7 - seg) : seg;
        for (int n = 0; n < nseg; ++n) {
            const int sg = dir ? (7 - n) : n; const int it = ((bh * 2 + dir) * 8 + sg);
            const float* up = ust + (size_t)it * 16384 + wid * 2048; const float* dp = dst + (size_t)it * 128;
#pragma unroll
            for (int i2 = 0; i2 < 2; ++i2)
#pragma unroll
                for (int r = 0; r < 16; ++r) sacc[i2][r] = sacc[i2][r] * dp[32 * (ib + i2) + crow(r, hi)] + up[(i2 * 16 + r) * 64 + lane];
        }
        write_simg(sacc, lds, wid, lane);
        load_chunk<true>(R, Qh, Vt, LF, rowbase, colbase, dir ? (seg * 8 + 7) : (seg * 8), dir, wid, lane);
        for (int cc = 0; cc < 8; ++cc) {
            const int c = dir ? (seg * 8 + 7 - cc) : (seg * 8 + cc);
            const int ri = tid >> 3, rcg = tid & 7; const size_t goff = (size_t)(rowbase + chunk_pos(c, ri, dir)) * DM + colbase + rcg * 16;
            u32x4 pf0 = {}, pf1 = {}; bf16x8 pg0 = {}, pg1 = {};
            if (dir) { pf0 = *(const u32x4*)(OF + goff); pf1 = *(const u32x4*)(OF + goff + 8); pg0 = ld8(Gt + goff); pg1 = ld8(Gt + goff + 8); }
            if (PVAR != 1) prep_chunk<true>(R, lds, wid, lane, gtot); else { asm volatile("" :: "v"(R.q[0]), "v"(R.v[7]), "v"(R.lf[3])); __syncthreads(); }
            if (cc + 1 < 8) load_chunk<true>(R, Qh, Vt, LF, rowbase, colbase, dir ? (seg * 8 + 6 - cc) : (seg * 8 + cc + 1), dir, wid, lane);
            __syncthreads();
            f32x16 oacc = f32x16{};
            if (PVAR != 2) { oacc = chunk_output(lds, ldsbase, wid, lane); state_update(sacc, lds, ldsbase, wid, lane); }
            __syncthreads();
            if (PVAR != 3) {
            write_simg(sacc, lds, wid, lane);
#pragma unroll
            for (int r = 0; r < 16; ++r) stg[(32 * tb + crow(r, hi)) * STG_LD + 32 * j + r32] = oacc[r];
            __syncthreads();
            {
                const int i = ri, cg = rcg; const float* sp = stg + i * STG_LD + cg * 16;
                f32x4 ov[4];
#pragma unroll
                for (int g = 0; g < 4; ++g) ov[g] = *(const f32x4*)(sp + g * 4);
                if (dir == 0) {
                    u32x4 w0, w1;
                    w0.x = pg8::pk_f16(ov[0][0], ov[0][1]); w0.y = pg8::pk_f16(ov[0][2], ov[0][3]); w0.z = pg8::pk_f16(ov[1][0], ov[1][1]); w0.w = pg8::pk_f16(ov[1][2], ov[1][3]);
                    w1.x = pg8::pk_f16(ov[2][0], ov[2][1]); w1.y = pg8::pk_f16(ov[2][2], ov[2][3]); w1.z = pg8::pk_f16(ov[3][0], ov[3][1]); w1.w = pg8::pk_f16(ov[3][2], ov[3][3]);
                    if (!DRY) { *(u32x4*)(OF + goff) = w0; *(u32x4*)(OF + goff + 8) = w1; } else asm volatile("" :: "v"(w0), "v"(w1));
                } else {
                    const u32x4 f0 = pf0, f1 = pf1;
                    float tv[16];
#pragma unroll
                    for (int e = 0; e < 4; ++e) { tv[2 * e] = h2f((unsigned short)(f0[e] & 0xffff)); tv[2 * e + 1] = h2f((unsigned short)(f0[e] >> 16));
                                                  tv[8 + 2 * e] = h2f((unsigned short)(f1[e] & 0xffff)); tv[8 + 2 * e + 1] = h2f((unsigned short)(f1[e] >> 16)); }
                    float ss = 0.f;
#pragma unroll
                    for (int e = 0; e < 16; ++e) { tv[e] += ov[e >> 2][e & 3]; ss += tv[e] * tv[e]; }
                    ss += __shfl_xor(ss, 1); ss += __shfl_xor(ss, 2); ss += __shfl_xor(ss, 4);
                    const float rs = __builtin_amdgcn_rsqf(ss * (1.0f / 128.0f) + EPS);
                    const bf16x8 g0 = pg0, g1 = pg1;
                    float yv[16];
#pragma unroll
                    for (int e = 0; e < 8; ++e) { yv[e] = tv[e] * rs * nw[cg * 16 + e] * bf2f((u16)g0[e]); yv[8 + e] = tv[8 + e] * rs * nw[cg * 16 + 8 + e] * bf2f((u16)g1[e]); }
                    u32x4 w0, w1;
                    w0.x = cvtpk(yv[0], yv[1]); w0.y = cvtpk(yv[2], yv[3]); w0.z = cvtpk(yv[4], yv[5]); w0.w = cvtpk(yv[6], yv[7]);
                    w1.x = cvtpk(yv[8], yv[9]); w1.y = cvtpk(yv[10], yv[11]); w1.z = cvtpk(yv[12], yv[13]); w1.w = cvtpk(yv[14], yv[15]);
                    if (!DRY) { *(u32x4*)(Y + goff) = w0; *(u32x4*)(Y + goff + 8) = w1; } else asm volatile("" :: "v"(w0), "v"(w1));
                }
            }
            } else { asm volatile("" :: "v"(oacc), "v"(sacc[0]), "v"(sacc[1]), "v"(pf0), "v"(pg0)); __syncthreads(); }
        }
        __syncthreads();
    }
}
}
#define GAS __attribute__((address_space(1)))
#define LAS __attribute__((address_space(3)))
typedef unsigned short bf16;
typedef unsigned v4u __attribute__((ext_vector_type(4)));
typedef float f32x4 __attribute__((ext_vector_type(4)));
typedef short bf16x8 __attribute__((ext_vector_type(8)));
typedef GAS unsigned gu32;
typedef GAS unsigned long long gu64;
#define RLX_AGENT __ATOMIC_RELAXED, __HIP_MEMORY_SCOPE_AGENT
#define LDS_WAIT() asm volatile("s_waitcnt lgkmcnt(0)" ::: "memory")
#define VM_WAIT() asm volatile("s_waitcnt vmcnt(0)" ::: "memory")
__device__ __forceinline__ unsigned long long rt() { return __builtin_amdgcn_s_memrealtime(); }
__device__ __forceinline__ unsigned f2bf(float f) { unsigned u = __builtin_bit_cast(unsigned, f); return (u + 0x7fffu + ((u >> 16) & 1u)) >> 16; }
__device__ __forceinline__ unsigned pk2(float lo, float hi) { return f2bf(lo) | (f2bf(hi) << 16); }

#define XB_TMO      128
#define XB_XCNT(j)  (256  + 64 * (j))
#define XB_XSUB(j)  (1280 + 64 * (j))
#define XB_XGEN(j)  (2304 + 64 * (j))
#define XB_TOP      3328
#define XB_TOPGEN   3392
#define XCD_BAR_WORDS 3456
#define XB_SPIN_CAP (1u << 18)

__device__ __forceinline__ unsigned xb_ld(unsigned* p)              { return __hip_atomic_load(p, __ATOMIC_RELAXED, __HIP_MEMORY_SCOPE_AGENT); }
__device__ __forceinline__ unsigned xb_add(unsigned* p, unsigned v) { return __hip_atomic_fetch_add(p, v, __ATOMIC_RELAXED, __HIP_MEMORY_SCOPE_AGENT); }
__device__ __forceinline__ unsigned xb_xcc_id() { return (unsigned)__builtin_amdgcn_s_getreg((3 << 11) | 20) & 0xFu; }
#define XB_SPIN(cond, bar) do { unsigned _sp = 0; while (cond) { __builtin_amdgcn_s_sleep(1); \
    if ((++_sp & 255u) == 0u) { if (xb_ld(&(bar)[XB_TMO])) break; if (_sp > XB_SPIN_CAP) { atomicAdd(&(bar)[XB_TMO], 1u); break; } } } } while (0)

struct XcdBarrier {
    unsigned* bar; unsigned x;
    volatile LAS unsigned* st;
};

__device__ __forceinline__ XcdBarrier xcd_barrier_post(unsigned* bar, volatile LAS unsigned* st) {
    XcdBarrier b; b.bar = bar; b.x = xb_xcc_id(); b.st = st;
    if (threadIdx.x == 0) (void)xb_add(&bar[XB_XCNT(b.x)], 1u);
    return b;
}
__device__ __forceinline__ void xcd_barrier_complete(unsigned* bar, unsigned x, unsigned& nloc, unsigned& nx) {
    const unsigned G = gridDim.x * gridDim.y * gridDim.z;
    unsigned sum, cnt, mine, sp = 0u;
    for (;;) {
        sum = 0u; cnt = 0u; mine = 0u;
#pragma unroll
        for (unsigned j = 0; j < 16; ++j) { const unsigned c = xb_ld(&bar[XB_XCNT(j)]); sum += c; cnt += (c > 0u) ? 1u : 0u; mine = (j == x) ? c : mine; }
        if (sum == G) break;
        __builtin_amdgcn_s_sleep(1);
        if ((++sp & 255u) == 0u) { if (xb_ld(&bar[XB_TMO])) break; if (sp > XB_SPIN_CAP) { atomicAdd(&bar[XB_TMO], 1u); break; } }
    }
    nloc = mine > 0u ? mine : 1u; nx = cnt > 0u ? cnt : 1u;
}

__device__ __forceinline__ void xcd_barrier(const XcdBarrier& b) {
    asm volatile("s_waitcnt vmcnt(0)" ::: "memory");
    __syncthreads();
    if (threadIdx.x == 0) {
        unsigned* bar = b.bar; asm volatile("" : "+s"(bar)); unsigned bx = __builtin_amdgcn_readfirstlane(b.x); asm volatile("" : "+s"(bx));
        __builtin_amdgcn_s_waitcnt(0);
        unsigned nloc = b.st[0], nx = b.st[1];
        if (nloc == 0u) { xcd_barrier_complete(bar, bx, nloc, nx); b.st[0] = nloc; b.st[1] = nx; }
        const unsigned old = xb_add(&bar[XB_XSUB(bx)], 1u);
        const unsigned gen = old / nloc;
        if (old + 1u == (gen + 1u) * nloc) {
            __builtin_amdgcn_fence(__ATOMIC_RELEASE, "agent");
            asm volatile("s_waitcnt vmcnt(0)" ::: "memory");
            const unsigned og = xb_add(&bar[XB_TOP], 1u);
            const unsigned tg = og / nx;
            if (og + 1u == (tg + 1u) * nx) xb_add(&bar[XB_TOPGEN], 1u);
            else XB_SPIN(xb_ld(&bar[XB_TOPGEN]) == tg, bar);
            __builtin_amdgcn_fence(__ATOMIC_ACQUIRE, "agent");
            xb_add(&bar[XB_XGEN(bx)], 1u);
            asm volatile("s_waitcnt vmcnt(0)" ::: "memory");
        } else {
            XB_SPIN(xb_ld(&bar[XB_XGEN(bx)]) == gen, bar);
            __builtin_amdgcn_fence(__ATOMIC_ACQUIRE, "agent");
            asm volatile("s_waitcnt vmcnt(0)" ::: "memory");
        }
    }
    __syncthreads();
}
#ifndef DUP_MASK
#define DUP_MASK 0
#endif
#define DUP(kind) (((DUP_MASK) >> (kind)) & 1)
#ifndef DUPR_MASK
#define DUPR_MASK 0
#endif
#define DUPR(kind) (((DUPR_MASK) >> (kind)) & 1)
#ifndef DUPR_MODE
#define DUPR_MODE 0
#endif
#ifndef MK_PER_PHASE
#define MK_PER_PHASE 0
#endif

constexpr size_t MiB = 1u << 20;
constexpr size_t WS_CTL = 0, CTL_ZERO_BYTES = 1 * MiB;
constexpr size_t WS_ROPE = 1 * MiB;
constexpr size_t WS_LB = 1 * MiB + 256 * 1024;
constexpr size_t WS_DST = 1 * MiB + 512 * 1024;
constexpr size_t WS_SSQ = 2 * MiB;
constexpr size_t WS_WTE = 3 * MiB;
constexpr size_t WS_WTO = 25 * MiB;
constexpr size_t WS_XB = 38 * MiB;
constexpr size_t WS_R0 = 70 * MiB, RSZ = 32 * MiB;
constexpr size_t WS_END = WS_R0 + 6 * RSZ;
constexpr int CW_BAR = 4096;

constexpr int RING_BYTES = 139264;
constexpr int LDSCTL_OFF = RING_BYTES + 8 * pg8::EPI_STG_WAVE, MISC_OFF = LDSCTL_OFF + 320;
constexpr int LDS_BYTES = 163840;
constexpr int NWAVES = 8, GRID = 256;
constexpr int NPH = 20;

struct Frame {
    LAS unsigned char* lds; volatile LAS unsigned* MISC; gu32* ctl;
    int tid, lane, wave, vcu, G;
};

__device__ __forceinline__ void transpose_item(const float* W, const float* sc, int K, int N, bf16* WT, LAS float* scr, int item, int lane) {
    const int nblk = N / 32, kb = item / nblk, nb = item % nblk, k0 = 64 * kb, n0 = 32 * nb;
    const int c4 = lane & 7, rk = lane >> 3;
#pragma unroll
    for (int i = 0; i < 8; ++i) { const int kk = 8 * i + rk; const float s = sc ? sc[k0 + kk] : 1.0f;
        f32x4 v = *(const GAS f32x4*)(W + (size_t)(k0 + kk) * N + n0 + 4 * c4); v = v * s; *(LAS f32x4*)(scr + kk * 36 + 4 * c4) = v; }
    LDS_WAIT(); asm volatile("" ::: "memory");
    const int c = lane & 7;
#pragma unroll
    for (int j = 0; j < 4; ++j) { const int n = (lane >> 3) + 8 * j; const LAS float* s = scr + (8 * c) * 36 + n;
        v4u o; o.x = pk2(s[0 * 36], s[1 * 36]); o.y = pk2(s[2 * 36], s[3 * 36]); o.z = pk2(s[4 * 36], s[5 * 36]); o.w = pk2(s[6 * 36], s[7 * 36]);
        *(GAS v4u*)(WT + (size_t)(n0 + n) * K + k0 + 8 * c) = o; }
    LDS_WAIT(); asm volatile("" ::: "memory");
}
__device__ __forceinline__ void convert_layer(Frame& F, const float* Win, const float* nrm, int Nin, const float* Wout, bf16* dstbuf) {
    int lane = F.lane; asm volatile("" : "+v"(lane));
    LAS float* scr = (LAS float*)(F.lds + F.wave * 16384);
    const int gw = F.vcu * NWAVES + F.wave, NGW = F.G * NWAVES;
    const int I_in = (DM / 64) * (Nin / 32), I_out = (DIN / 64) * (DM / 32);
    bf16* wout_t = dstbuf + (size_t)Nin * DM;
    for (int it = gw; it < I_in + I_out; it += NGW) {
        if (it < I_in) transpose_item(Win, nrm, DM, Nin, dstbuf, scr, it, lane);
        else transpose_item(Wout, nullptr, DIN, DM, wout_t, scr, it - I_in, lane);
    }
}
__device__ __forceinline__ float wave_sum(float v) {
#pragma unroll
    for (int o = 1; o < 64; o <<= 1) v += __shfl_xor(v, o);
    return v;
}

__device__ __forceinline__ void stagger(int vcu, unsigned ticks) {
    if (vcu & 1) { const unsigned long long t0 = __builtin_amdgcn_s_memrealtime(); while (__builtin_amdgcn_s_memrealtime() - t0 < ticks) __builtin_amdgcn_s_sleep(8); }
}
#ifndef STAG_EVEN
#define STAG_EVEN 0
#endif
#ifndef STAG_ODD
#define STAG_ODD 0
#endif
struct Args { const float* in[13]; float* out; unsigned char* ws; int ph_lo, ph_hi; };

__global__ void __launch_bounds__(NWAVES * 64, 2) mk_fwd(Args args) {
    extern __shared__ __attribute__((aligned(16))) unsigned char lds[];
    Frame F;
    F.lds = (LAS unsigned char*)lds;
    F.MISC = (volatile LAS unsigned*)(F.lds + MISC_OFF);
    F.tid = threadIdx.x; F.lane = F.tid & 63; F.wave = __builtin_amdgcn_readfirstlane(F.tid >> 6);
    F.G = gridDim.x; { const int bx = blockIdx.x; F.vcu = (F.G % 8 == 0) ? (bx % 8) * (F.G / 8) + bx / 8 : bx; }
    unsigned char* ws = args.ws;
    F.ctl = (gu32*)(ws + WS_CTL);
    for (int u = F.tid; u < (LDS_BYTES - LDSCTL_OFF) / 4; u += NWAVES * 64) ((LAS unsigned*)(F.lds + LDSCTL_OFF))[u] = 0u;
    __syncthreads();
    const int lo = args.ph_lo, hi = args.ph_hi; (void)lo; (void)hi;
    const bool multi = MK_PER_PHASE ? ((hi - lo) > 1) : true;
    XcdBarrier bar; bar.bar = (unsigned*)(F.ctl + CW_BAR); bar.x = 0; bar.st = nullptr;
    if (multi) bar = xcd_barrier_post((unsigned*)(F.ctl + CW_BAR), F.MISC + 8);
#ifndef PHASE_MASK
#define PHASE_MASK 0xFFFF
#endif
#if MK_PER_PHASE
#define INK(kind, k) ((((PHASE_MASK) >> (kind)) & 1) && lo <= (k) && (k) < hi)
#define IN(k) (lo <= (k) && (k) < hi)
#else
#define INK(kind, k) (((PHASE_MASK) >> (kind)) & 1)
#define IN(k) true
#endif
#if MK_PER_PHASE
#define SEAM(k) do { if (IN(k) && IN((k) + 1)) xcd_barrier(bar); } while (0)
#else
#define SEAM(k) do { xcd_barrier(bar); if (DUP(9)) xcd_barrier(bar); } while (0)
#endif

#define PTRS() size_t wz_ = 0; asm volatile("" : "+s"(wz_)); unsigned char* wsl = args.ws + wz_; \
    const float* x_in = args.in[0]; float* xres = args.out; \
    float* rope = (float*)(wsl + WS_ROPE); float* lbt = (float*)(wsl + WS_LB); float* dstv = (float*)(wsl + WS_DST); float* ssq = (float*)(wsl + WS_SSQ); \
    bf16* wte = (bf16*)(wsl + WS_WTE); bf16* wto = (bf16*)(wsl + WS_WTO); bf16* xb = (bf16*)(wsl + WS_XB); float* ust = args.out;     \
    unsigned char* R0 = wsl + WS_R0; unsigned char* R1 = R0 + RSZ; unsigned char* R2 = R1 + RSZ; unsigned char* R3 = R2 + RSZ; unsigned char* R4 = R3 + RSZ; unsigned char* R5 = R4 + RSZ; \
    const int gw = F.vcu * NWAVES + F.wave, NGW = F.G * NWAVES; int tidl = threadIdx.x; asm volatile("" : "+v"(tidl)); const int lanel = tidl & 63; (void)lanel; \
    (void)x_in; (void)xres; (void)rope; (void)lbt; (void)dstv; (void)ssq; (void)wte; (void)wto; (void)xb; (void)ust; (void)R0; (void)R1; (void)R2; (void)R3; (void)R4; (void)R5; (void)gw; (void)NGW;

    for (int rep_ = 0; rep_ < (DUP(0) ? 2 : 1); ++rep_)
    if (INK(0, 0)) {
        PTRS();
        convert_layer(F, args.in[2], args.in[1], EVEN_IN, args.in[7], wte);
        convert_layer(F, args.in[9], args.in[8], ODD_IN, args.in[11], wto);
        {
            const int gt = F.vcu * (NWAVES * 64) + tidl, NGT = F.G * NWAVES * 64;
            for (int e = gt; e < SEQ * 8; e += NGT) { const int pos = e >> 3, i = e & 7; const double inv = pow(500000.0, -(double)i / 8.0); const double ang = (double)pos * inv;
                rope[e] = (float)cos(ang); rope[SEQ * 8 + e] = (float)sin(ang); }
            const float* lg = args.in[6];
            for (int e = gt; e < 2 * 1024; e += NGT) { const int dir = e >> 10, c = e & 1023; const float l0 = lg[(dir * 2 + 0) * 1024 + c], l1 = lg[(dir * 2 + 1) * 1024 + c];
                lbt[e] = 0.0f; lbt[2048 + e] = 1.0f / (1.0f + expf(l0 - l1)); }
        }
        for (int m = gw; m < T; m += NGW) {
            const GAS f32x4* xr = (const GAS f32x4*)(x_in + (size_t)m * DM) + lanel; f32x4 v[4]; float s = 0.f;
#pragma unroll
            for (int j = 0; j < 4; ++j) { v[j] = xr[64 * j]; s += (v[j].x * v[j].x + v[j].y * v[j].y) + (v[j].z * v[j].z + v[j].w * v[j].w); }
            s = wave_sum(s);
            GAS unsigned long long* o8 = (GAS unsigned long long*)(xb + (size_t)m * DM) + lanel;
#pragma unroll
            for (int j = 0; j < 4; ++j) o8[64 * j] = (unsigned long long)pk2(v[j].x, v[j].y) | ((unsigned long long)pk2(v[j].z, v[j].w) << 32);
            if (lanel < 16) ssq[(size_t)m * 16 + lanel] = (lanel == 0) ? s : 0.0f;
        }
    }
    SEAM(0);

#pragma unroll 1
    for (int layer = 0; layer < 4; ++layer) {
        const int j = layer >> 1; const bool even = (layer & 1) == 0;
        const int pb = 1 + (layer >> 1) * 9 + (even ? 0 : 6);
        if (even) {
            const float lam_init = (j == 0) ? 0.2f : 0.470713018f;
            if (INK(1, pb + 0)) {
        PTRS();
                pg8::Gemm g{xb, wte, T, 4096, DM, DM, 1 << 30, 0l}; pg8::StaticOrder S; S.init(T, 4096, F.G, (int)blockIdx.x);
                pg8::EpiIn<true> E{ssq, rope, lbt + j * 2048, R0, R1, R2, R3, R4, R5, 0};
                if (DUP(1)) { pg8::EpiDry ED; pg8::gemm_phase(F.lds, g, S, ED); }
                if (DUPR(1)) { pg8::EpiIn<true, DUPR_MODE> E2{ssq, rope, lbt + j * 2048, R0, R1, R2, R3, R4, R5, 0}; pg8::gemm_phase(F.lds, g, S, E2); }
                if (STAG_EVEN) stagger(F.vcu, STAG_EVEN);
                pg8::gemm_phase(F.lds, g, S, E);
            }
            SEAM(pb + 0);
            if (INK(2, pb + 1)) {
        PTRS();
                if (layer == 2) { convert_layer(F, args.in[9] + (size_t)DM * ODD_IN, args.in[8] + DM, ODD_IN, args.in[11] + (size_t)DIN * DM, wto); __syncthreads(); }
                const float* lq = args.in[3] + j * 256; float s1 = 0.f, s2 = 0.f;
                for (int i = 0; i < 64; ++i) { s1 += lq[i] * lq[64 + i]; s2 += lq[128 + i] * lq[192 + i]; }
                const float lam = expf(s1) - expf(s2) + lam_init;
                if (DUP(2)) for (int i = 0; i < 4; ++i) { const int bh = (F.vcu >> 5) * 4 + i, qb = F.vcu & 31;
                    att::diff_attn_unit<true, DUPR_MODE>(bh >> 3, bh & 7, qb, (const att::u16*)R0, (const att::u16*)R1, (const att::u16*)R2, (const att::u16*)R3, (att::u16*)R0,
                                        args.in[4] + j * 128, lam, 1.0f - lam_init, (char*)lds); }
                for (int i = 0; i < 4; ++i) { const int bh = (F.vcu >> 5) * 4 + i, qb = F.vcu & 31;
                    att::diff_attn_unit<false>(bh >> 3, bh & 7, qb, (const att::u16*)R0, (const att::u16*)R1, (const att::u16*)R2, (const att::u16*)R3, (att::u16*)R0,
                                        args.in[4] + j * 128, lam, 1.0f - lam_init, (char*)lds); }
            }
            SEAM(pb + 1);
            if (INK(1, pb + 2)) {
        PTRS();
                pg8::Gemm g{xb, wte + (size_t)4096 * DM, T, 5120, DM, DM, 1 << 30, 0l}; pg8::StaticOrder S; S.init(T, 5120, F.G, (int)blockIdx.x);
                pg8::EpiIn<true> E{ssq, rope, lbt + j * 2048, R0, R1, R2, R3, R4, R5, 16};
                if (DUP(1)) { pg8::EpiDry ED; pg8::gemm_phase(F.lds, g, S, ED); }
                if (DUPR(1)) { pg8::EpiIn<true, DUPR_MODE> E2{ssq, rope, lbt + j * 2048, R0, R1, R2, R3, R4, R5, 16}; pg8::gemm_phase(F.lds, g, S, E2); }
                if (STAG_EVEN) stagger(F.vcu, STAG_EVEN);
                pg8::gemm_phase(F.lds, g, S, E);
            }
            SEAM(pb + 2);
            if (INK(3, pb + 3)) {
        PTRS();
                if (DUP(3)) for (int it = F.vcu; it < 512; it += F.G) hg::hgrn_pass1(it, (const att::u16*)R2, (const att::u16*)R4, (const att::u16*)R5, ust, dstv, (char*)lds);
                for (int it = F.vcu; it < 512; it += F.G) hg::hgrn_pass1(it, (const att::u16*)R2, (const att::u16*)R4, (const att::u16*)R5, ust, dstv, (char*)lds);
            }
            SEAM(pb + 3);
            if (INK(4, pb + 4)) {
        PTRS();
                if (DUP(4)) for (int it = F.vcu; it < 256; it += F.G) hg::hgrn_pass2<true, DUPR_MODE>(it, (const att::u16*)R1, (const att::u16*)R2, (const att::u16*)R4, (const att::u16*)R5, (const att::u16*)R3,
                                                                        (att::u16*)R4, (att::u16*)R1, ust, dstv, args.in[5] + j * 128, (char*)lds);
                for (int it = F.vcu; it < 256; it += F.G) hg::hgrn_pass2<false>(it, (const att::u16*)R1, (const att::u16*)R2, (const att::u16*)R4, (const att::u16*)R5, (const att::u16*)R3,
                                                                        (att::u16*)R4, (att::u16*)R1, ust, dstv, args.in[5] + j * 128, (char*)lds);
            }
            SEAM(pb + 4);
            if (INK(5, pb + 5)) {
        PTRS();
                pg8::Gemm g{(const bf16*)R0, wte + (size_t)EVEN_IN * DM, T, DM, DIN, DM, 16, (long)RSZ - 2048l}; pg8::StaticOrder S; S.init(T, DM, F.G, (int)blockIdx.x);
                if (DUP(5)) { pg8::EpiDry ED; pg8::gemm_phase(F.lds, g, S, ED); }
                if (layer == 0) { pg8::EpiOut<true, false> E{x_in, xres, xb, ssq}; pg8::gemm_phase(F.lds, g, S, E); }
                else            { pg8::EpiOut<false, false> E{x_in, xres, xb, ssq}; pg8::gemm_phase(F.lds, g, S, E); }
            }
            SEAM(pb + 5);
        } else {
            if (INK(6, pb + 0)) {
        PTRS();
                pg8::Gemm g{xb, wto, T, ODD_IN, DM, DM, 1 << 30, 0l}; pg8::StaticOrder S; S.init(T, ODD_IN, F.G, (int)blockIdx.x);
                pg8::EpiIn<false> E{ssq, rope, nullptr, R0, R1, R2, R3, R4, R5, 0};
                if (DUP(6)) { pg8::EpiDry ED; pg8::gemm_phase(F.lds, g, S, ED); }
                if (DUPR(6)) pg8::gemm_phase(F.lds, g, S, E);
                if (STAG_ODD) stagger(F.vcu, STAG_ODD);
                pg8::gemm_phase(F.lds, g, S, E);
            }
            SEAM(pb + 0);
            if (INK(7, pb + 1)) {
        PTRS();
                if (layer == 1) { convert_layer(F, args.in[2] + (size_t)DM * EVEN_IN, args.in[1] + DM, EVEN_IN, args.in[7] + (size_t)DIN * DM, wte); __syncthreads(); }
                if (DUP(7)) att::swa_phase<true>(2 * F.vcu, (const att::u16*)R0, (const att::u16*)R2, (const att::u16*)(R2 + (size_t)T * 256 * 2), (const att::u16*)R3, (att::u16*)R0, args.in[10] + j * 32, (char*)lds);
                att::swa_phase<false>(2 * F.vcu, (const att::u16*)R0, (const att::u16*)R2, (const att::u16*)(R2 + (size_t)T * 256 * 2), (const att::u16*)R3, (att::u16*)R0, args.in[10] + j * 32, (char*)lds);
            }
            SEAM(pb + 1);
            if (INK(5, pb + 2)) {
        PTRS();
                pg8::Gemm g{(const bf16*)R0, wto + (size_t)ODD_IN * DM, T, DM, DIN, DIN, 1 << 30, 0l}; pg8::StaticOrder S; S.init(T, DM, F.G, (int)blockIdx.x);
                if (DUP(5)) { pg8::EpiDry ED; pg8::gemm_phase(F.lds, g, S, ED); }
                if (layer == 3) { pg8::EpiOut<false, true> E{x_in, xres, xb, ssq}; pg8::gemm_phase(F.lds, g, S, E); }
                else            { pg8::EpiOut<false, false> E{x_in, xres, xb, ssq}; pg8::gemm_phase(F.lds, g, S, E); }
            }
            SEAM(pb + 2);
        }
    }
    if (INK(8, 19)) {
        PTRS();
        const float* fw = args.in[12];
        for (int m = gw; m < T; m += NGW) {
            GAS f32x4* xr = (GAS f32x4*)(xres + (size_t)m * DM) + lanel; f32x4 v[4]; float s = 0.f;
#pragma unroll
            for (int jj = 0; jj < 4; ++jj) { v[jj] = xr[64 * jj]; s += (v[jj].x * v[jj].x + v[jj].y * v[jj].y) + (v[jj].z * v[jj].z + v[jj].w * v[jj].w); }
            s = wave_sum(s); const float rs = 1.0f / sqrtf(s * (1.0f / DM) + EPS);
#pragma unroll
            for (int jj = 0; jj < 4; ++jj) { const f32x4 w = *((const f32x4*)fw + lanel + 64 * jj); xr[64 * jj] = v[jj] * rs * w; }
        }
    }
#undef IN
#undef INK
#undef SEAM
}

extern "C" void kernel_launch(void* const* d_in, const int* in_sizes, int n_in, void* d_out, int out_size, void* d_ws, size_t ws_size, hipStream_t stream) {
    static int ok = 0;
    if (ok == 0) {
        if (n_in != 13 || in_sizes[0] != T * DM || out_size != T * DM || ws_size < WS_END) { fprintf(stderr, "kernel_launch: shape/workspace mismatch (n_in %d, ws %zu, need %zu)\n", n_in, ws_size, (size_t)WS_END); ok = -1; return; }
        if (hipFuncSetAttribute((const void*)mk_fwd, hipFuncAttributeMaxDynamicSharedMemorySize, LDS_BYTES) != hipSuccess) { fprintf(stderr, "kernel_launch: hipFuncSetAttribute failed\n"); ok = -1; return; }
        int per_cu = 0;
        if (hipOccupancyMaxActiveBlocksPerMultiprocessor(&per_cu, (const void*)mk_fwd, NWAVES * 64, LDS_BYTES) != hipSuccess || per_cu < 1) fprintf(stderr, "kernel_launch: occupancy query reports %d\n", per_cu);
        (void)hipGetLastError();
        ok = 1;
    }
    if (ok < 0) return;
    (void)hipMemsetAsync((char*)d_ws + WS_CTL, 0, CTL_ZERO_BYTES, stream);
    Args a{};
    for (int i = 0; i < 13; ++i) a.in[i] = (const float*)d_in[i];
    a.out = (float*)d_out; a.ws = (unsigned char*)d_ws;
#if MK_PER_PHASE
    for (int p = 0; p < NPH; ++p) { a.ph_lo = p; a.ph_hi = p + 1; hipLaunchKernelGGL(mk_fwd, dim3(GRID), dim3(NWAVES * 64), LDS_BYTES, stream, a); }
#else
    a.ph_lo = 0; a.ph_hi = NPH;
    hipLaunchKernelGGL(mk_fwd, dim3(GRID), dim3(NWAVES * 64), LDS_BYTES, stream, a);
#endif
    const hipError_t le = hipPeekAtLastError();
    if (le != hipSuccess) fprintf(stderr, "kernel_launch: launch failed: %s\n", hipGetErrorName(le));
}
```

```cpp
#include <hip/hip_runtime.h>
#include <hip/hip_bf16.h>
#include <cstdio>
#include <cstdint>

constexpr int NB = 4, SEQ = 4096, DM = 1024, T = NB * SEQ;
constexpr int EVEN_IN = 9216, ODD_IN = 4608, DIN = 2048;
constexpr float EPS = 1e-6f;
constexpr float C2 = 0.125f * 1.4426950408889634f;
constexpr float LOG2E = 1.4426950408889634f;

namespace pg8 {
#define PG8_LAS __attribute__((address_space(3)))
typedef unsigned short bf16_t;
typedef short bf16x8 __attribute__((ext_vector_type(8)));
typedef float f32x4 __attribute__((ext_vector_type(4)));
typedef unsigned u32x4 __attribute__((ext_vector_type(4)));
constexpr int BM = 256, BK = 64, HALF = 128, HTB = HALF * BK * 2, STAGE_BYTES = 8 * HTB, NXCD = 8, WGM = 8;
constexpr int EPI_STG_OFF = 139264, EPI_STG_RS = 144, EPI_STG_WAVE = 16 * EPI_STG_RS;

__host__ __device__ __forceinline__ int lds_byte(int r, int c) { const int st = (r >> 4) * 2 + (c >> 5), rr = r & 15, cc = c & 31, ob = rr * 64 + cc * 2; return st * 1024 + (ob ^ (((ob >> 9) & 1) << 5)); }
__host__ __device__ __forceinline__ void stage_rc(int b, int& R, int& C) { const int st = b / 1024, sb = b % 1024, swz = sb ^ (((sb >> 9) & 1) << 5); R = (st >> 1) * 16 + swz / 64; C = (st & 1) * 32 + (swz % 64) / 2; }
__host__ __device__ __forceinline__ int perm32(int rho) { const int n = rho >> 4, i = rho & 15; return 8 * (i >> 2) + 4 * n + (i & 3); }

struct Unit { int pm, pn; };
struct Gemm { const bf16_t* A; const bf16_t* Bt; int M, N, K, lda, ksplit; long jump; };

struct StaticOrder {
    int nM, nN, nwg, G, c;
    __host__ __device__ void init(int M, int N, int G_, int c_) { nM = M / BM; nN = N / BM; nwg = nM * nN; G = G_; c = c_; }
    __host__ __device__ bool next(int i, Unit& u) const {
        const long L = (long)i * G + c; if (L >= nwg) return false;
        int wgid = (int)L; { const int q = nwg / NXCD, r = nwg % NXCD, xcd = wgid % NXCD, off = wgid / NXCD; wgid = (xcd < r ? xcd * (q + 1) : r * (q + 1) + (xcd - r) * q) + off; }
        const int nig = WGM * nN, gid = wgid / nig, fm = gid * WGM, gsz = (nM - fm) < WGM ? (nM - fm) : WGM;
        u.pm = fm + ((wgid % nig) % gsz); u.pn = (wgid % nig) / gsz; return true;
    }
};

__device__ __forceinline__ unsigned cvt_pk_bf16(float lo, float hi) { unsigned r; asm volatile("v_cvt_pk_bf16_f32 %0, %1, %2" : "=v"(r) : "v"(lo), "v"(hi)); return r; }

template <class Epi>
__device__ __forceinline__ void gemm_phase(PG8_LAS unsigned char* lds, const Gemm g, const StaticOrder& S, const Epi& E) {
    int tid = threadIdx.x; asm volatile("" : "+v"(tid));
    const int wid = __builtin_amdgcn_readfirstlane(tid >> 6), lane = tid & 63, wr = wid >> 2, wc = wid & 3, fr = lane & 15, fq = lane >> 4;
    const int K = g.K, nt = K / BK, lda = g.lda;
    unsigned voffA[2], voffB[2];
#pragma unroll
    for (int i = 0; i < 2; ++i) { int R, C; stage_rc(tid * 16 + i * 8192, R, C); const int Rb = 64 * (R >> 5) + perm32(R & 31);
        voffA[i] = (unsigned)(R * lda + C) * 2u; voffB[i] = (unsigned)(Rb * K + C) * 2u; }
    const size_t kstep = (size_t)(BK * 2);
    const size_t hstepA = (size_t)HALF * lda * 2, tstepA = 2 * hstepA;
    const size_t hstepB = (size_t)32 * K * 2, tstepB = (size_t)BM * K * 2;
    const unsigned ldsw = (unsigned)wid * 1024u;
    const int aoff = lds_byte(wr * 64 + fr, fq * 8), boff = lds_byte(wc * 32 + fr, fq * 8);
    const int ksplit = g.ksplit; const long jump = g.jump;
#define PG8_AP(base, t) ((base) + (size_t)(t) * kstep + (((t) >= ksplit) ? jump : 0l))
#define PG8_SA(b, h) (((b) * 2 + (h)) * HTB)
#define PG8_SB(b, h) ((4 + (b) * 2 + (h)) * HTB)
#define PG8_STAGE(bufoff, gbase, voff) do { _Pragma("unroll") for (int _i = 0; _i < 2; ++_i) \
        __builtin_amdgcn_global_load_lds((const unsigned*)((const char*)(gbase) + (voff)[_i]), (PG8_LAS unsigned*)(lds + (bufoff) + ldsw + _i * 8192), 16, 0, 0); } while (0)
#define PG8_LDA(dst, b, h) do { _Pragma("unroll") for (int m = 0; m < 4; ++m) _Pragma("unroll") for (int k = 0; k < 2; ++k) dst[m][k] = *(const PG8_LAS bf16x8*)(lds + PG8_SA(b, h) + aoff + m * 2048 + k * 1024); } while (0)
#define PG8_LDB(dst, b, h) do { _Pragma("unroll") for (int n = 0; n < 2; ++n) _Pragma("unroll") for (int k = 0; k < 2; ++k) dst[n][k] = *(const PG8_LAS bf16x8*)(lds + PG8_SB(b, h) + boff + n * 2048 + k * 1024); } while (0)
#define PG8_MMA(ai, bj, At, Bt) do { __builtin_amdgcn_s_setprio(1); _Pragma("unroll") for (int m = 0; m < 4; ++m) _Pragma("unroll") for (int n = 0; n < 2; ++n) _Pragma("unroll") for (int k = 0; k < 2; ++k) \
        acc[ai][bj][m][n] = __builtin_amdgcn_mfma_f32_16x16x32_bf16(Bt[n][k], At[m][k], acc[ai][bj][m][n], 0, 0, 0); __builtin_amdgcn_s_setprio(0); } while (0)
#define PG8_WAIT_V(n) asm volatile("s_waitcnt vmcnt(" #n ")" ::: "memory")
#define PG8_WAIT_L(n) asm volatile("s_waitcnt lgkmcnt(" #n ")" ::: "memory")
#define PG8_BAR __builtin_amdgcn_s_barrier()
#define PG8_SCHED __builtin_amdgcn_sched_barrier(0)
    Unit cur, nxt; int ui = 0;
    if (!S.next(0, cur)) return;
    f32x4 acc[2][2][4][2];
#pragma unroll
    for (int a = 0; a < 2; ++a)
#pragma unroll
        for (int b = 0; b < 2; ++b)
#pragma unroll
            for (int m = 0; m < 4; ++m)
#pragma unroll
                for (int n = 0; n < 2; ++n) acc[a][b][m][n] = (f32x4){0.f, 0.f, 0.f, 0.f};
    bf16x8 At[4][2], B0[2][2], B1[2][2];
    const char* cA = (const char*)g.A + (size_t)cur.pm * tstepA; const char* cB = (const char*)g.Bt + (size_t)cur.pn * tstepB;
    {
        PG8_STAGE(PG8_SB(0, 0), cB, voffB); PG8_STAGE(PG8_SB(0, 1), cB + hstepB, voffB); PG8_STAGE(PG8_SA(0, 0), cA, voffA); PG8_STAGE(PG8_SA(0, 1), cA + hstepA, voffA);
        if (wr == 1) PG8_BAR;
        PG8_WAIT_V(2); PG8_BAR;
        PG8_STAGE(PG8_SB(1, 0), cB + kstep, voffB); PG8_STAGE(PG8_SA(1, 0), PG8_AP(cA, 1), voffA); PG8_STAGE(PG8_SB(1, 1), cB + hstepB + kstep, voffB);
        PG8_WAIT_V(6); PG8_BAR;
    }
    for (;;) {
        const bool has_next = S.next(ui + 1, nxt);
        const char* nA = has_next ? (const char*)g.A + (size_t)nxt.pm * tstepA : cA; const char* nB = has_next ? (const char*)g.Bt + (size_t)nxt.pn * tstepB : cB;
        for (int t = 0; t < nt; t += 2) {
            const bool last = (t == nt - 2);
            const char* a1 = PG8_AP(cA, t + 1);
            const char* a2 = last ? nA : PG8_AP(cA, t + 2); const char* b2 = last ? nB : cB + (size_t)(t + 2) * kstep;
            const char* a3 = a2 + kstep; const char* b3 = b2 + kstep;
            PG8_LDB(B0, 0, 0); PG8_LDB(B1, 0, 1); PG8_SCHED; PG8_LDA(At, 0, 0); PG8_STAGE(PG8_SA(1, 1), a1 + hstepA, voffA);
            PG8_WAIT_V(8); PG8_WAIT_L(0); PG8_BAR; PG8_MMA(0, 0, At, B0); PG8_MMA(0, 1, At, B1); PG8_BAR; PG8_SCHED;
            PG8_LDA(At, 0, 1); PG8_STAGE(PG8_SB(0, 0), b2, voffB); PG8_STAGE(PG8_SB(0, 1), b2 + hstepB, voffB); PG8_STAGE(PG8_SA(0, 0), a2, voffA);
            PG8_WAIT_V(8); PG8_WAIT_L(0); PG8_BAR; PG8_MMA(1, 0, At, B0); PG8_MMA(1, 1, At, B1); PG8_BAR; PG8_SCHED;
            PG8_LDB(B0, 1, 0); PG8_LDB(B1, 1, 1); PG8_SCHED; PG8_LDA(At, 1, 0); PG8_STAGE(PG8_SA(0, 1), a2 + hstepA, voffA);
            PG8_WAIT_V(8); PG8_WAIT_L(0); PG8_BAR; PG8_MMA(0, 0, At, B0); PG8_MMA(0, 1, At, B1); PG8_BAR; PG8_SCHED;
            PG8_LDA(At, 1, 1); PG8_STAGE(PG8_SB(1, 0), b3, voffB); PG8_STAGE(PG8_SB(1, 1), b3 + hstepB, voffB); PG8_STAGE(PG8_SA(1, 0), a3, voffA);
            PG8_WAIT_V(8); PG8_WAIT_L(0); PG8_BAR; PG8_MMA(1, 0, At, B0); PG8_MMA(1, 1, At, B1); PG8_BAR; PG8_SCHED;
        }
        if (wr == 0) PG8_BAR;
        E(acc, cur, wr, wc, fr, fq, lds + EPI_STG_OFF + wid * EPI_STG_WAVE, lane);
        if (!has_next) break;
#pragma unroll
        for (int a = 0; a < 2; ++a)
#pragma unroll
            for (int b = 0; b < 2; ++b)
#pragma unroll
                for (int m = 0; m < 4; ++m)
#pragma unroll
                    for (int n = 0; n < 2; ++n) acc[a][b][m][n] = (f32x4){0.f, 0.f, 0.f, 0.f};
        cur = nxt; cA = nA; cB = nB; ++ui;
        if (wr == 1) PG8_BAR;
    }
    PG8_WAIT_V(0);
    PG8_BAR;
#undef PG8_AP
#undef PG8_SA
#undef PG8_SB
#undef PG8_STAGE
#undef PG8_LDA
#undef PG8_LDB
#undef PG8_MMA
#undef PG8_WAIT_V
#undef PG8_WAIT_L
#undef PG8_BAR
#undef PG8_SCHED
}
}
namespace pg8 {
typedef unsigned short u16;
__device__ __forceinline__ float fsigmoid(float v) { return __builtin_amdgcn_rcpf(1.0f + __expf(-v)); }
__device__ __forceinline__ unsigned pk_f16(float lo, float hi) { _Float16 a = (_Float16)lo, b = (_Float16)hi; return (unsigned)__builtin_bit_cast(unsigned short, a) | ((unsigned)__builtin_bit_cast(unsigned short, b) << 16); }


__device__ __forceinline__ void store_rows128(PG8_LAS unsigned char* stg, u16* blk  , size_t pitch, u32x4 w0, u32x4 w1, int fr, int fq, int lane) {
    *(PG8_LAS u32x4*)(stg + fr * EPI_STG_RS + fq * 16) = w0; *(PG8_LAS u32x4*)(stg + fr * EPI_STG_RS + 64 + fq * 16) = w1;
    const int rr = lane >> 3, ch = lane & 7;
    const u32x4 a = *(const PG8_LAS u32x4*)(stg + rr * EPI_STG_RS + ch * 16), b = *(const PG8_LAS u32x4*)(stg + (8 + rr) * EPI_STG_RS + ch * 16);
    *(u32x4*)(blk + (size_t)rr * pitch + ch * 8) = a; *(u32x4*)(blk + (size_t)(8 + rr) * pitch + ch * 8) = b;
}

__device__ __forceinline__ float bf_lo(unsigned w) { return __uint_as_float(w << 16); }
__device__ __forceinline__ float bf_hi(unsigned w) { return __uint_as_float(w & 0xffff0000u); }
enum { K_PLAIN = 0, K_SILU = 1, K_ROPEQ = 2, K_ROPEK = 3, K_LOGF = 4 };

template <bool EVEN, int MODE = 0> struct EpiIn {
    static constexpr bool PERM = true;
    const float* ssq;
    const float* rope;
    const float* lb;
    unsigned char* r0; unsigned char* r1; unsigned char* r2; unsigned char* r3; unsigned char* r4; unsigned char* r5;
    int pn_off;
    unsigned* kmx = nullptr;
    __device__ __forceinline__ void operator()(const f32x4 (&acc)[2][2][4][2], const Unit& u, int wr, int wc, int fr, int fq, PG8_LAS unsigned char* stg, int lane) const {
        const int gpn = u.pn + pn_off;
        int kind, pitch, colt, dir = 0; u16* outp;
        if (EVEN) {
            const int grp = gpn >> 2; colt = (gpn & 3) * 256; pitch = 1024;
            switch (grp) {
                case 0: kind = K_ROPEQ; outp = (u16*)r0; break;
                case 1: kind = K_ROPEK; outp = (u16*)r1; break;
                case 2: kind = K_PLAIN; outp = (u16*)r2; break;
                case 3: kind = K_SILU;  outp = (u16*)r3; break;
                case 4: kind = K_SILU;  outp = (u16*)r1; break;
                case 5: kind = K_LOGF;  outp = (u16*)r4; dir = 0; break;
                case 6: kind = K_LOGF;  outp = (u16*)r5; dir = 1; break;
                case 7: kind = K_PLAIN; outp = (u16*)r2; break;
                default: kind = K_SILU; outp = (u16*)r3; break;
            }
        } else {
            if (gpn < 8)       { kind = K_ROPEQ; outp = (u16*)r0; pitch = 2048; colt = gpn * 256; }
            else if (gpn == 8) { kind = K_ROPEK; outp = (u16*)r2; pitch = 256;  colt = 0; }
            else if (gpn == 9) { kind = K_PLAIN; outp = (u16*)(r2 + (size_t)T * 256 * 2); pitch = 256; colt = 0; }
            else               { kind = K_SILU;  outp = (u16*)r3; pitch = 2048; colt = (gpn - 10) * 256; }
        }
        int row0 = u.pm * BM + wr * 64 + fr; asm volatile("" : "+v"(row0));
        if (MODE == 2) kind = K_PLAIN;
        float rsv[8];
#pragma unroll
        for (int hb = 0; hb < 2; ++hb) { f32x4 sq[4];
#pragma unroll
          for (int i = 0; i < 4; ++i) sq[i] = *((const f32x4*)(ssq + (size_t)(row0 + hb * HALF + i * 16) * 16) + fq);
#pragma unroll
          for (int i = 0; i < 4; ++i) { float tot = (sq[i][0] + sq[i][1]) + (sq[i][2] + sq[i][3]); tot += __shfl_xor(tot, 16); tot += __shfl_xor(tot, 32); rsv[hb * 4 + i] = __builtin_amdgcn_rsqf(tot * (1.0f / DM) + EPS); }
          asm volatile("" ::: "memory"); }
        u16* const blk0 = outp + (size_t)(row0 - fr) * pitch + colt + wc * 64;
        if (kind == K_LOGF)        rows<K_LOGF>(acc, rsv, blk0, pitch, colt + wc * 64, dir, row0, 1.0f, fr, fq, stg, lane);
        else if (kind == K_SILU)   rows<K_SILU>(acc, rsv, blk0, pitch, 0, 0, row0, 1.0f, fr, fq, stg, lane);
        else if (kind == K_PLAIN)  rows<K_PLAIN>(acc, rsv, blk0, pitch, 0, 0, row0, 1.0f, fr, fq, stg, lane);
        else if (EVEN && kind == K_ROPEK) rows<K_ROPEK>(acc, rsv, blk0, pitch, colt + wc * 64, 0, row0, 1.0f, fr, fq, stg, lane);
        else                       rows<K_ROPEQ>(acc, rsv, blk0, pitch, 0, 0, row0, (kind == K_ROPEQ) ? C2 : 1.0f, fr, fq, stg, lane);
    }
    template <int KIND>
    __device__ __forceinline__ void rows(const f32x4 (&acc)[2][2][4][2], const float (&rsv)[8], u16* blk0, int pitch, int ccol, int dir, int row0, float qs, int fr, int fq, PG8_LAS unsigned char* stg, int lane) const {
        f32x4 lbv[2][2];
        if (KIND == K_LOGF) {
#pragma unroll
            for (int bj = 0; bj < 2; ++bj) { const int c0 = ccol + bj * 32 + 8 * fq; lbv[bj][0] = *(const f32x4*)(lb + dir * 1024 + c0); lbv[bj][1] = *(const f32x4*)(lb + dir * 1024 + c0 + 4); }
        }
        f32x4 cs0, cs1, sn0, sn1, ncs0, ncs1, nsn0, nsn1;
        constexpr bool ROPE = (KIND == K_ROPEQ || KIND == K_ROPEK); float kn2 = 0.f;
        if (ROPE) { const int pos = row0 & (SEQ - 1); const f32x4* cp = (const f32x4*)(rope + (size_t)pos * 8); const f32x4* spn = (const f32x4*)(rope + (size_t)SEQ * 8 + (size_t)pos * 8);
            ncs0 = cp[0]; ncs1 = cp[1]; nsn0 = spn[0]; nsn1 = spn[1]; }
#pragma unroll
        for (int ai = 0; ai < 2; ++ai)
#pragma unroll
            for (int m = 0; m < 4; ++m) {
                const float rs = rsv[ai * 4 + m];
                if (ROPE) { cs0 = ncs0; cs1 = ncs1; sn0 = nsn0; sn1 = nsn1;
                    if (ai * 4 + m < 7) { const int i2 = ai * 4 + m + 1; const int pos = (row0 + (i2 >> 2) * HALF + (i2 & 3) * 16) & (SEQ - 1);
                        const f32x4* cp = (const f32x4*)(rope + (size_t)pos * 8); const f32x4* spn = (const f32x4*)(rope + (size_t)SEQ * 8 + (size_t)pos * 8);
                        ncs0 = cp[0]; ncs1 = cp[1]; nsn0 = spn[0]; nsn1 = spn[1]; } }
                u32x4 wst[2];
#pragma unroll
                for (int bj = 0; bj < 2; ++bj) {
                    f32x4 v0 = acc[ai][bj][m][0] * rs, v1 = acc[ai][bj][m][1] * rs;
                    u32x4 w;
                    if (KIND == K_LOGF) {
                        const f32x4 l0 = lbv[bj][0], l1 = lbv[bj][1];
                        float o[8];
#pragma unroll
                        for (int e = 0; e < 4; ++e) { const float f0 = l0[e] + (1.0f - l0[e]) * fsigmoid(v0[e]), f1 = l1[e] + (1.0f - l1[e]) * fsigmoid(v1[e]);
                            o[e] = fmaxf(__builtin_amdgcn_logf(f0) * 0.6931471805599453f, -30.0f); o[4 + e] = fmaxf(__builtin_amdgcn_logf(f1) * 0.6931471805599453f, -30.0f); }
                        w.x = pk_f16(o[0], o[1]); w.y = pk_f16(o[2], o[3]); w.z = pk_f16(o[4], o[5]); w.w = pk_f16(o[6], o[7]);
                    } else {
                        if (KIND == K_SILU) {
#pragma unroll
                            for (int e = 0; e < 4; ++e) { v0[e] = v0[e] * fsigmoid(v0[e]); v1[e] = v1[e] * fsigmoid(v1[e]); }
                        } else if (ROPE && bj == 0) {
                            f32x4 o0, o1;
#pragma unroll
                            for (int e = 0; e < 4; ++e) { o0[e] = __shfl_xor(v0[e], 16); o1[e] = __shfl_xor(v1[e], 16); }
                            if (fq < 2) {
                                const float sg = (fq == 0) ? -1.0f : 1.0f;
                                v0 = v0 * cs0 + (o0 * sn0) * sg; v1 = v1 * cs1 + (o1 * sn1) * sg;
                            }
                        }
                        if (KIND == K_ROPEQ) { v0 = v0 * qs; v1 = v1 * qs; }
                        w.x = cvt_pk_bf16(v0[0], v0[1]); w.y = cvt_pk_bf16(v0[2], v0[3]); w.z = cvt_pk_bf16(v1[0], v1[1]); w.w = cvt_pk_bf16(v1[2], v1[3]);
                    }
                    wst[bj] = w;
                }
                if (KIND == K_ROPEK) {
                    float n2 = 0.f;
#pragma unroll
                    for (int bj = 0; bj < 2; ++bj) { const u32x4 w = wst[bj]; const float a0 = bf_lo(w.x), a1 = bf_hi(w.x), a2 = bf_lo(w.y), a3 = bf_hi(w.y), a4 = bf_lo(w.z), a5 = bf_hi(w.z), a6 = bf_lo(w.w), a7 = bf_hi(w.w);
                        n2 += (a0 * a0 + a1 * a1) + (a2 * a2 + a3 * a3) + (a4 * a4 + a5 * a5) + (a6 * a6 + a7 * a7); }
                    n2 += __shfl_xor(n2, 16); n2 += __shfl_xor(n2, 32); kn2 = fmaxf(kn2, n2);
                }
                if (MODE != 1) store_rows128(stg, blk0 + (size_t)(ai * HALF + m * 16) * pitch, (size_t)pitch, wst[0], wst[1], fr, fq, lane); else asm volatile("" :: "v"(wst[0]), "v"(wst[1]));
            }
        if (KIND == K_ROPEK) {
            int ln; asm volatile("v_mbcnt_lo_u32_b32 %0, -1, 0\n\tv_mbcnt_hi_u32_b32 %0, -1, %0" : "=v"(ln));
#pragma unroll
            for (int o = 1; o < 16; o <<= 1) kn2 = fmaxf(kn2, __uint_as_float(__builtin_amdgcn_ds_bpermute((ln ^ o) << 2, __float_as_uint(kn2))));
            if (ln == 0) __hip_atomic_fetch_max(kmx + (row0 / SEQ) * 16 + (ccol >> 6), __float_as_uint(kn2), __ATOMIC_RELAXED, __HIP_MEMORY_SCOPE_AGENT);
        }
    }
};

template <bool FIRST, bool LAST> struct EpiOut {
    static constexpr bool PERM = true;
    const float* xin; float* xout; u16* xb; float* ssq;
    __device__ __forceinline__ void operator()(const f32x4 (&acc)[2][2][4][2], const Unit& u, int wr, int wc, int fr, int fq, PG8_LAS unsigned char* stg, int lane) const {
        int row0 = u.pm * BM + wr * 64 + fr; asm volatile("" : "+v"(row0));
        const int cb = u.pn * BM + wc * 64 + 8 * fq;
        f32x4 nx[2][2];
#define LOADX(dst, rw) do { _Pragma("unroll") for (int bj = 0; bj < 2; ++bj) { const size_t off = (size_t)(rw) * DM + cb + bj * 32; \
            if (FIRST) { dst[bj][0] = *(const f32x4*)(xin + off); dst[bj][1] = *(const f32x4*)(xin + off + 4); } \
            else { const u32x4 w = *(const u32x4*)(xb + off); dst[bj][0] = (f32x4){bf_lo(w.x), bf_hi(w.x), bf_lo(w.y), bf_hi(w.y)}; dst[bj][1] = (f32x4){bf_lo(w.z), bf_hi(w.z), bf_lo(w.w), bf_hi(w.w)}; } } } while (0)
        LOADX(nx, row0);
#pragma unroll
        for (int ai = 0; ai < 2; ++ai)
#pragma unroll
            for (int m = 0; m < 4; ++m) {
                const int row = row0 + ai * HALF + m * 16; float part = 0.f; u32x4 wst[2];
                f32x4 ox[2][2];
#pragma unroll
                for (int bj = 0; bj < 2; ++bj) { ox[bj][0] = nx[bj][0]; ox[bj][1] = nx[bj][1]; }
                if (ai * 4 + m < 7) { const int i2 = ai * 4 + m + 1; LOADX(nx, row0 + (i2 >> 2) * HALF + (i2 & 3) * 16); }
#pragma unroll
                for (int bj = 0; bj < 2; ++bj) {
                    const size_t off = (size_t)row * DM + cb + bj * 32;
                    const f32x4 n0 = ox[bj][0] + acc[ai][bj][m][0], n1 = ox[bj][1] + acc[ai][bj][m][1];
                    if (LAST) { *(f32x4*)(xout + off) = n0; *(f32x4*)(xout + off + 4) = n1; }
                    else {
                        u32x4 w; w.x = cvt_pk_bf16(n0[0], n0[1]); w.y = cvt_pk_bf16(n0[2], n0[3]); w.z = cvt_pk_bf16(n1[0], n1[1]); w.w = cvt_pk_bf16(n1[2], n1[3]);
                        wst[bj] = w;
                        const f32x4 r0 = (f32x4){bf_lo(w.x), bf_hi(w.x), bf_lo(w.y), bf_hi(w.y)}, r1 = (f32x4){bf_lo(w.z), bf_hi(w.z), bf_lo(w.w), bf_hi(w.w)};
                        part += (r0[0] * r0[0] + r0[1] * r0[1]) + (r0[2] * r0[2] + r0[3] * r0[3]) + (r1[0] * r1[0] + r1[1] * r1[1]) + (r1[2] * r1[2] + r1[3] * r1[3]);
                    }
                }
                if (!LAST) { part += __shfl_xor(part, 16); part += __shfl_xor(part, 32);
                    if (fq == 0) ssq[(size_t)row * 16 + u.pn * 4 + wc] = part;
                    store_rows128(stg, xb + (size_t)(row - fr) * DM + u.pn * BM + wc * 64, (size_t)DM, wst[0], wst[1], fr, fq, lane); }
            }
#undef LOADX
    }
};
struct EpiDry {
    static constexpr bool PERM = true;
    __device__ __forceinline__ void operator()(const f32x4 (&acc)[2][2][4][2], const Unit&, int, int, int, int, PG8_LAS unsigned char*, int) const {
#pragma unroll
        for (int a = 0; a < 2; ++a)
#pragma unroll
            for (int b = 0; b < 2; ++b)
#pragma unroll
                for (int m = 0; m < 4; ++m) asm volatile("" :: "v"(acc[a][b][m][0]), "v"(acc[a][b][m][1]));
    }
};
}
namespace att {
typedef unsigned short u16;
using bf16x8 = __attribute__((ext_vector_type(8))) short;
using s16x4  = __attribute__((ext_vector_type(4))) short;
using f32x16 = __attribute__((ext_vector_type(16))) float;
using f32x4  = __attribute__((ext_vector_type(4))) float;
using u32x4  = __attribute__((ext_vector_type(4))) unsigned;
#define KSWZ(row, colB) ((row) * 256 + ((colB) ^ (((row) & 7) << 4)))
#define KSWZ128(row, colB) ((row) * 128 + ((colB) ^ (((row) & 7) << 4)))
#define SBAR() __builtin_amdgcn_sched_barrier(0)
constexpr float THRL = 8.0f;
__device__ __forceinline__ int crow(int r, int hi) { return (r & 3) + 8 * (r >> 2) + 4 * hi; }
__device__ __forceinline__ unsigned cvtpk(float lo, float hi) { unsigned r; asm volatile("v_cvt_pk_bf16_f32 %0, %1, %2" : "=v"(r) : "v"(lo), "v"(hi)); return r; }
__device__ __forceinline__ bf16x8 ld8(const u16* p) { return *reinterpret_cast<const bf16x8*>(p); }
__device__ __forceinline__ float bf2f(unsigned short h) { return __uint_as_float((unsigned)h << 16); }

__device__ __forceinline__ void partialSM(f32x16& p0, f32x16& p1, float& m_reg, float& alpha) {
    float pmax = p0[0];
#pragma unroll
    for (int r = 1; r < 16; ++r) pmax = fmaxf(pmax, p0[r]);
#pragma unroll
    for (int r = 0; r < 16; ++r) pmax = fmaxf(pmax, p1[r]);
    { auto rr = __builtin_amdgcn_permlane32_swap(__float_as_uint(pmax), __float_as_uint(pmax), false, false);
      pmax = fmaxf(__uint_as_float(rr[0]), __uint_as_float(rr[1])); }
    float mn;
    if (__builtin_expect(__all(pmax - m_reg <= THRL), 1)) { mn = m_reg; alpha = 1.f; }
    else { mn = fmaxf(m_reg, pmax); alpha = __builtin_amdgcn_exp2f(m_reg - mn); m_reg = mn; }
#pragma unroll
    for (int r = 0; r < 16; ++r) { p0[r] -= mn; p1[r] -= mn; }
#pragma unroll
    for (int r = 0; r < 16; ++r) p0[r] = __builtin_amdgcn_exp2f(p0[r]);
}
__device__ __forceinline__ void finishSM(f32x16& p0, f32x16& p1, float alpha, float& l_reg, bf16x8& pa0, bf16x8& pa1, bf16x8& pa2, bf16x8& pa3) {
#pragma unroll
    for (int r = 0; r < 16; ++r) p1[r] = __builtin_amdgcn_exp2f(p1[r]);
    float ps = 0;
#pragma unroll
    for (int r = 0; r < 16; ++r) ps += p0[r];
#pragma unroll
    for (int r = 0; r < 16; ++r) ps += p1[r];
    { auto rr = __builtin_amdgcn_permlane32_swap(__float_as_uint(ps), __float_as_uint(ps), false, false);
      ps = __uint_as_float(rr[0]) + __uint_as_float(rr[1]); }
    l_reg = l_reg * alpha + ps;
#define PK4(P, BASE, OUT) do { unsigned a0 = cvtpk(P[BASE + 0], P[BASE + 1]), a1 = cvtpk(P[BASE + 2], P[BASE + 3]);   \
    unsigned b0 = cvtpk(P[BASE + 4], P[BASE + 5]), b1 = cvtpk(P[BASE + 6], P[BASE + 7]);                              \
    auto r0 = __builtin_amdgcn_permlane32_swap(a0, b0, false, false); auto r1 = __builtin_amdgcn_permlane32_swap(a1, b1, false, false); \
    u32x4 w = {r0[0], r1[0], r0[1], r1[1]}; OUT = *reinterpret_cast<bf16x8*>(&w); } while (0)
    PK4(p0, 0, pa0); PK4(p0, 8, pa1); PK4(p1, 0, pa2); PK4(p1, 8, pa3);
}
__device__ __forceinline__ void pack4(const f32x16& p0, const f32x16& p1, bf16x8& pa0, bf16x8& pa1, bf16x8& pa2, bf16x8& pa3) {
    PK4(p0, 0, pa0); PK4(p0, 8, pa1); PK4(p1, 0, pa2); PK4(p1, 8, pa3);
}
#undef PK4

template <int NCB> __device__ __forceinline__ int v_st(int k, int c) { const int kk = (k & ~0xC) | ((k & 4) << 1) | ((k & 8) >> 1); return ((kk >> 3) * NCB + (c >> 5)) * 512 + ((kk & 7) * 32 + (c & 31)) * 2; }
__device__ __forceinline__ int v_rd_base(int lane) { return ((lane & 3) << 3) | (((lane >> 2) & 3) << 6) | (((lane >> 4) & 1) << 5) | (((lane >> 5) & 1) << 8); }
template <int OFF> __device__ __forceinline__ s16x4 tr_read(int vb) { s16x4 r; asm volatile("ds_read_b64_tr_b16 %0, %1 offset:%2" : "=&v"(r) : "v"(vb), "i"(OFF) : "memory"); return r; }
#define PKF(L, H) (bf16x8){L[0], L[1], L[2], L[3], H[0], H[1], H[2], H[3]}
template <int NCB> __device__ __forceinline__ void pv_blk(f32x16& od, int vb, bf16x8 pa0, bf16x8 pa1, bf16x8 pa2, bf16x8 pa3) {
    constexpr int KS = NCB * 1024, HF = NCB * 512;
    const s16x4 l0 = tr_read<0 * KS>(vb), h0 = tr_read<0 * KS + HF>(vb), l1 = tr_read<1 * KS>(vb), h1 = tr_read<1 * KS + HF>(vb);
    const s16x4 l2 = tr_read<2 * KS>(vb), h2 = tr_read<2 * KS + HF>(vb), l3 = tr_read<3 * KS>(vb), h3 = tr_read<3 * KS + HF>(vb);
    asm volatile("s_waitcnt lgkmcnt(0)" ::: "memory"); SBAR();
    od = __builtin_amdgcn_mfma_f32_32x32x16_bf16(pa0, PKF(l0, h0), od, 0, 0, 0);
    od = __builtin_amdgcn_mfma_f32_32x32x16_bf16(pa1, PKF(l1, h1), od, 0, 0, 0);
    od = __builtin_amdgcn_mfma_f32_32x32x16_bf16(pa2, PKF(l2, h2), od, 0, 0, 0);
    od = __builtin_amdgcn_mfma_f32_32x32x16_bf16(pa3, PKF(l3, h3), od, 0, 0, 0);
}


template <int NCB> __device__ __forceinline__ int v_stn(int k, int c) { return ((k >> 3) * NCB + (c >> 5)) * 512 + ((k & 7) * 32 + (c & 31)) * 2; }
__device__ __forceinline__ float max3f(float a, float b, float c) { return fmaxf(fmaxf(a, b), c); }
__device__ __forceinline__ void fill16(f32x16& v, float x) {
#pragma unroll
    for (int r = 0; r < 16; ++r) v[r] = x;
}
template <bool FIRST>
__device__ __forceinline__ void partialSM_n(f32x16& p0, f32x16& p1, float& m_reg, f32x16& negm, float& alpha) {
    float a = max3f(p0[0], p0[1], p0[2]), b = max3f(p0[3], p0[4], p0[5]), c = max3f(p1[0], p1[1], p1[2]), d = max3f(p1[3], p1[4], p1[5]);
    a = max3f(a, p0[6], p0[7]); b = max3f(b, p0[8], p0[9]); c = max3f(c, p1[6], p1[7]); d = max3f(d, p1[8], p1[9]);
    a = max3f(a, p0[10], p0[11]); b = max3f(b, p0[12], p0[13]); c = max3f(c, p1[10], p1[11]); d = max3f(d, p1[12], p1[13]);
    a = max3f(a, p0[14], p0[15]); c = max3f(c, p1[14], p1[15]);
    float pmax = fmaxf(fmaxf(a, b), fmaxf(c, d));
    { auto rr = __builtin_amdgcn_permlane32_swap(__float_as_uint(pmax), __float_as_uint(pmax), false, false);
      pmax = fmaxf(__uint_as_float(rr[0]), __uint_as_float(rr[1])); }
    if (!FIRST && __builtin_expect(__all(pmax <= THRL), 1)) { alpha = 1.f; }
    else { const float dl = FIRST ? pmax : fmaxf(pmax, 0.f); m_reg += dl; alpha = FIRST ? 0.f : __builtin_amdgcn_exp2f(-dl);
#pragma unroll
        for (int r = 0; r < 16; ++r) { p0[r] -= dl; p1[r] -= dl; }
        fill16(negm, -m_reg); asm volatile("" : "+v"(negm)); }
#pragma unroll
    for (int r = 0; r < 16; ++r) p0[r] = __builtin_amdgcn_exp2f(p0[r]);
}
#define PKN(P, B) (u32x4){cvtpk(P[B + 0], P[B + 1]), cvtpk(P[B + 2], P[B + 3]), cvtpk(P[B + 4], P[B + 5]), cvtpk(P[B + 6], P[B + 7])}
template <bool SUM>
__device__ __forceinline__ void finishSM_n(f32x16& p0, f32x16& p1, float alpha, float& l_reg, bf16x8& pa0, bf16x8& pa1, bf16x8& pa2, bf16x8& pa3) {
#pragma unroll
    for (int r = 0; r < 16; ++r) p1[r] = __builtin_amdgcn_exp2f(p1[r]);
    if (SUM) {
        float s0 = (p0[0] + p0[1]) + (p0[2] + p0[3]), s1 = (p0[4] + p0[5]) + (p0[6] + p0[7]), s2 = (p0[8] + p0[9]) + (p0[10] + p0[11]), s3 = (p0[12] + p0[13]) + (p0[14] + p0[15]);
        float t0 = (p1[0] + p1[1]) + (p1[2] + p1[3]), t1 = (p1[4] + p1[5]) + (p1[6] + p1[7]), t2 = (p1[8] + p1[9]) + (p1[10] + p1[11]), t3 = (p1[12] + p1[13]) + (p1[14] + p1[15]);
        float ps = ((s0 + s1) + (s2 + s3)) + ((t0 + t1) + (t2 + t3));
        { auto rr = __builtin_amdgcn_permlane32_swap(__float_as_uint(ps), __float_as_uint(ps), false, false);
          ps = __uint_as_float(rr[0]) + __uint_as_float(rr[1]); }
        l_reg = l_reg * alpha + ps;
    }
    { u32x4 w = PKN(p0, 0); pa0 = *reinterpret_cast<bf16x8*>(&w); } { u32x4 w = PKN(p0, 8); pa1 = *reinterpret_cast<bf16x8*>(&w); }
    { u32x4 w = PKN(p1, 0); pa2 = *reinterpret_cast<bf16x8*>(&w); } { u32x4 w = PKN(p1, 8); pa3 = *reinterpret_cast<bf16x8*>(&w); }
}

__device__ __forceinline__ void qkt_da(f32x16& p0, f32x16& p1, const char* Ks, const bf16x8* qr, const f32x16& negm, int r32, int hi, int cb0) {
#pragma unroll
    for (int d0 = 0; d0 < 4; ++d0) { const int cb = cb0 + (d0 * 16 + hi * 8) * 2;
        const bf16x8 b0 = *reinterpret_cast<const bf16x8*>(Ks + KSWZ(r32, cb));
        const bf16x8 b1 = *reinterpret_cast<const bf16x8*>(Ks + KSWZ(32 + r32, cb));
        if (d0 == 0) { p0 = __builtin_amdgcn_mfma_f32_32x32x16_bf16(b0, qr[0], negm, 0, 0, 0); p1 = __builtin_amdgcn_mfma_f32_32x32x16_bf16(b1, qr[0], negm, 0, 0, 0); }
        else { p0 = __builtin_amdgcn_mfma_f32_32x32x16_bf16(b0, qr[d0], p0, 0, 0, 0); p1 = __builtin_amdgcn_mfma_f32_32x32x16_bf16(b1, qr[d0], p1, 0, 0, 0); } }
}
typedef short v4i16_t __attribute__((ext_vector_type(4)));
__device__ __forceinline__ s16x4 vtr(int addr) { return __builtin_bit_cast(s16x4, __builtin_amdgcn_ds_read_tr16_b64_v4i16((__attribute__((address_space(3))) v4i16_t*)(unsigned)addr)); }
__device__ __forceinline__ void pv_da(f32x16* o, int vb, bf16x8 pa0, bf16x8 pa1, bf16x8 pa2, bf16x8 pa3) {
    s16x4 lo[4], hi[4];
#define VADDR(i) (vb + ((i) & 3) * 512 + ((i) >> 2) * 4096)
#pragma unroll
    for (int i = 0; i < 4; ++i) { lo[i] = vtr(VADDR(i)); hi[i] = vtr(VADDR(i) + 2048); }
#pragma unroll
    for (int i = 0; i < 16; ++i) {
        const bf16x8 vf = PKF(lo[i & 3], hi[i & 3]);
        const bf16x8 pa = ((i >> 2) == 0) ? pa0 : ((i >> 2) == 1) ? pa1 : ((i >> 2) == 2) ? pa2 : pa3;
        o[i & 3] = __builtin_amdgcn_mfma_f32_32x32x16_bf16(pa, vf, o[i & 3], 0, 0, 0);
        if (i + 4 < 16) { lo[i & 3] = vtr(VADDR(i + 4)); hi[i & 3] = vtr(VADDR(i + 4) + 2048); }
    }
#undef VADDR
    __builtin_amdgcn_sched_group_barrier(0x100, 8, 0);
#pragma unroll
    for (int i = 0; i < 12; ++i) { __builtin_amdgcn_sched_group_barrier(0x008, 1, 0); __builtin_amdgcn_sched_group_barrier(0x100, 2, 0); __builtin_amdgcn_sched_group_barrier(0x002, 4, 0); }
#pragma unroll
    for (int i = 0; i < 4; ++i) { __builtin_amdgcn_sched_group_barrier(0x008, 1, 0); __builtin_amdgcn_sched_group_barrier(0x002, 4, 0); }
}
#define DA_PIN(x) asm volatile("" : "+v"(x))
#define DA_MFMA(a, b, c) __builtin_amdgcn_mfma_f32_32x32x16_bf16(a, b, c, 0, 0, 0)
#define DA_WAIT_BAR(N) asm volatile("s_waitcnt vmcnt(" #N ") lgkmcnt(0)\n\ts_barrier" ::: "memory")
__device__ __forceinline__ void glds16(const void* g, unsigned lds_base) {
    unsigned sv; asm volatile("s_mov_b32 %0, m0\n\ts_mov_b32 m0, %2\n\ts_nop 0\n\tglobal_load_lds_dwordx4 %1, off\n\ts_mov_b32 m0, %0" : "=&s"(sv) : "v"(g), "s"(lds_base) : "memory"); }
__device__ __forceinline__ bf16x8 kld(int addr) { return *(const __attribute__((address_space(3))) bf16x8*)(unsigned)addr; }
__device__ __forceinline__ float rowmax32(const f32x16& p0, const f32x16& p1) {
    float a = max3f(p0[0], p0[1], p0[2]), b = max3f(p0[3], p0[4], p0[5]), c = max3f(p1[0], p1[1], p1[2]), d = max3f(p1[3], p1[4], p1[5]);
    a = max3f(a, p0[6], p0[7]); b = max3f(b, p0[8], p0[9]); c = max3f(c, p1[6], p1[7]); d = max3f(d, p1[8], p1[9]);
    a = max3f(a, p0[10], p0[11]); b = max3f(b, p0[12], p0[13]); c = max3f(c, p1[10], p1[11]); d = max3f(d, p1[12], p1[13]);
    a = max3f(a, p0[14], p0[15]); c = max3f(c, p1[14], p1[15]);
    const float pmax = fmaxf(fmaxf(a, b), fmaxf(c, d));
    auto rr = __builtin_amdgcn_permlane32_swap(__float_as_uint(pmax), __float_as_uint(pmax), false, false);
    return fmaxf(__uint_as_float(rr[0]), __uint_as_float(rr[1]));
}
constexpr int DA_KSL = 16384, DA_VRING = 49152, DA_WS = 133120, DA_STG = 65536, DA_STG_LD = 132;
template <bool DRY, int PVAR = 0>
__device__ __forceinline__ void diff_attn_unit(int b, int h, int qb, const u16* Qa, const u16* __restrict__ Ka, const u16* __restrict__ Va, const u16* __restrict__ Ga,
                                               u16* Y, const float* __restrict__ subw, float lam, float one_m_li, const unsigned* __restrict__ kmx, char* lds) {
    int tid = threadIdx.x; asm volatile("" : "+v"(tid)); const int lane = tid & 63, r32 = lane & 31, hi = lane >> 5; const int wid = __builtin_amdgcn_readfirstlane(tid >> 6);
    const int map = wid >> 2, wq = wid & 3;
    const long rowbase = (long)b * SEQ; const int q0 = qb * 128;
    float* wsf = (float*)(lds + DA_WS) + wid * 64; float* li_l = wsf; float* al_l = wsf + 32;
    float m_reg = 0.f, l_reg = 0; f32x16 o[4] = {}; bf16x8 qr[4]; f32x16 negm = f32x16{}; asm volatile("" : "+v"(negm));
    const unsigned lds0 = (unsigned)(uintptr_t)lds;
    const u16* Kh = Ka + rowbase * DM + h * 128; const u16* Vh = Va + rowbase * DM + h * 128;
    const int cb0 = map * 128;
    unsigned kofs[2], vofs[2];
#pragma unroll
    for (int i = 0; i < 2; ++i) { const int pk = 2 * wid + i;
        const int row = 4 * pk + (lane >> 4), cp = lane & 15; kofs[i] = (unsigned)(row * DM + ((cp ^ (row & 7)) * 8)) * 2u;
        const int st = 2 * pk + (lane >> 5), kk = 8 * (st >> 2) + ((lane & 31) >> 2), cc = 32 * (st & 3) + 8 * (lane & 3); vofs[i] = (unsigned)(kk * DM + cc) * 2u; }
    const char* Kg = (const char*)Kh; const char* Vg = (const char*)Vh;
#define DMA_K(t, slot) do { _Pragma("unroll") for (int i_ = 0; i_ < 2; ++i_) glds16(Kg + (size_t)(t) * (64 * DM * 2) + kofs[i_], (unsigned)__builtin_amdgcn_readfirstlane(lds0 + (slot) + (2 * wid + i_) * 1024)); } while (0)
#define DMA_V(t, slot) do { _Pragma("unroll") for (int i_ = 0; i_ < 2; ++i_) glds16(Vg + (size_t)(t) * (64 * DM * 2) + vofs[i_], (unsigned)__builtin_amdgcn_readfirstlane(lds0 + DA_VRING + (slot) + (2 * wid + i_) * 1024)); } while (0)
    DMA_K(0, 0); DMA_V(0, 0); DMA_K(1, DA_KSL);
    const u16* Qw = Qa + (rowbase + q0 + wq * 32 + r32) * DM + h * 128 + map * 64 + hi * 8;
#pragma unroll
    for (int d0 = 0; d0 < 4; ++d0) qr[d0] = ld8(Qw + d0 * 16);
    DMA_K(2, 2 * DA_KSL);
    int ka[4];
#pragma unroll
    for (int d0 = 0; d0 < 4; ++d0) ka[d0] = (int)lds0 + KSWZ(r32, cb0 + (d0 * 16 + hi * 8) * 2);
    const int vb0 = (int)lds0 + DA_VRING + v_rd_base(lane);
    constexpr int NT = SEQ / 64;
    f32x16 pA0, pA1, pB0, pB1; bf16x8 kf[8]; s16x4 vlo[4], vhi[4]; u32x4 pw0, pw1, pw2, pw3; bool resc = false;
    int sl_prev = 0, sl_cur = 0, sl_next = DA_KSL;
#define ROT() do { sl_prev = sl_cur; sl_cur = sl_next; sl_next = (sl_next == 2 * DA_KSL) ? 0 : sl_next + DA_KSL; } while (0)
#define RESC() do { if (resc) { _Pragma("unroll") for (int d_ = 0; d_ < 4; ++d_) _Pragma("unroll") for (int r = 0; r < 16; ++r) o[d_][r] *= al_l[crow(r, hi)]; } } while (0)
#define KLOAD(slot) do { _Pragma("unroll") for (int d0 = 0; d0 < 4; ++d0) { kf[2 * d0] = kld(ka[d0] + (slot)); kf[2 * d0 + 1] = kld(ka[d0] + (slot) + 8192); } } while (0)
    float mb;
    { float q2 = 0.f;
#pragma unroll
      for (int d0 = 0; d0 < 4; ++d0)
#pragma unroll
          for (int e = 0; e < 8; ++e) { const float qv = bf2f((u16)qr[d0][e]); q2 += qv * qv; }
      { auto rr = __builtin_amdgcn_permlane32_swap(__float_as_uint(q2), __float_as_uint(q2), false, false); q2 = __uint_as_float(rr[0]) + __uint_as_float(rr[1]); }
      mb = __builtin_sqrtf(q2 * __uint_as_float(kmx[b * 16 + h * 2 + map])) * 1.0001f; }
    const bool fast = !__any(!(mb <= 60.0f));
    if (fast) { m_reg = mb; fill16(negm, -mb); asm volatile("" : "+v"(negm)); }
    DA_WAIT_BAR(6);
    KLOAD(0);
    pA0 = DA_MFMA(kf[0], qr[0], negm); pA1 = DA_MFMA(kf[1], qr[0], negm); pA0 = DA_MFMA(kf[2], qr[1], pA0); pA1 = DA_MFMA(kf[3], qr[1], pA1);
    pA0 = DA_MFMA(kf[4], qr[2], pA0); pA1 = DA_MFMA(kf[5], qr[2], pA1); pA0 = DA_MFMA(kf[6], qr[3], pA0); pA1 = DA_MFMA(kf[7], qr[3], pA1);
    if (fast) {
#pragma unroll
      for (int r = 0; r < 16; ++r) { pA0[r] = __builtin_amdgcn_exp2f(pA0[r]); pA1[r] = __builtin_amdgcn_exp2f(pA1[r]); }
    } else { const float rm = rowmax32(pA0, pA1); m_reg = rm;
#pragma unroll
      for (int r = 0; r < 16; ++r) { pA0[r] = __builtin_amdgcn_exp2f(pA0[r] - rm); pA1[r] = __builtin_amdgcn_exp2f(pA1[r] - rm); }
      fill16(negm, -m_reg); asm volatile("" : "+v"(negm)); }
    DA_WAIT_BAR(0);
    DMA_K(3, 0); DMA_V(1, DA_KSL); ROT();
    KLOAD(sl_cur);
    DA_WAIT_BAR(4);
#define PKW(P, i) cvtpk(P[i], P[(i) + 1])
#define PAF(w) __builtin_bit_cast(bf16x8, w)
#define VOFF(i) ((((i) & 3) * 512) + (((i) >> 2) * 4096))
#define VRD(s, i) do { vlo[s] = vtr(vp_ + VOFF(i)); vhi[s] = vtr(vp_ + VOFF(i) + 2048); } while (0)
#define VFR(s) PKF(vlo[s], vhi[s])
#define KRD(G, d0) do { if (G) { kf[2 * (d0)] = kld(ka[d0] + sl_next); kf[2 * (d0) + 1] = kld(ka[d0] + sl_next + 8192); SBAR(); } } while (0)
#define GAPA(CT, MF, a0, a1, a2, a3, W0, W1, PW) do { MF; DA_PIN(CT); sacc += a0; sacc += a1; sacc += a2; sacc += a3; W0; W1; DA_PIN(PW); DA_PIN(sacc); SBAR(); } while (0)
#define GAPB(MF, X, i, VR) do { MF; VR; X[i] = __builtin_amdgcn_exp2f(X[i]); X[(i) + 1] = __builtin_amdgcn_exp2f(X[(i) + 1]); DA_PIN(X); SBAR(); } while (0)
#define STEP(C0, C1, P0, P1, t, GK, GV, GL) do { SBAR(); \
    const int vp_ = vb0 + sl_prev; \
    float sacc = P0[0] + P0[1]; \
    GAPA(C0, C0 = DA_MFMA(kf[0], qr[0], negm), P0[2], P0[3], P0[4], P0[5],     pw0[0] = PKW(P0, 0),  pw0[1] = PKW(P0, 2),  pw0); \
    GAPA(C1, C1 = DA_MFMA(kf[1], qr[0], negm), P0[6], P0[7], P0[8], P0[9],     pw0[2] = PKW(P0, 4),  pw0[3] = PKW(P0, 6),  pw0); \
    GAPA(C0, C0 = DA_MFMA(kf[2], qr[1], C0),   P0[10], P0[11], P0[12], P0[13], pw1[0] = PKW(P0, 8),  pw1[1] = PKW(P0, 10), pw1); \
    GAPA(C1, C1 = DA_MFMA(kf[3], qr[1], C1),   P0[14], P0[15], P1[0], P1[1],   pw1[2] = PKW(P0, 12), pw1[3] = PKW(P0, 14), pw1); \
    VRD(0, 0); SBAR(); GAPA(C0, C0 = DA_MFMA(kf[4], qr[2], C0), P1[2], P1[3], P1[4], P1[5],     pw2[0] = PKW(P1, 0),  pw2[1] = PKW(P1, 2),  pw2); \
    VRD(1, 1); SBAR(); GAPA(C1, C1 = DA_MFMA(kf[5], qr[2], C1), P1[6], P1[7], P1[8], P1[9],     pw2[2] = PKW(P1, 4),  pw2[3] = PKW(P1, 6),  pw2); \
    VRD(2, 2); SBAR(); GAPA(C0, C0 = DA_MFMA(kf[6], qr[3], C0), P1[10], P1[11], P1[12], P1[13], pw3[0] = PKW(P1, 8),  pw3[1] = PKW(P1, 10), pw3); \
    VRD(3, 3); SBAR(); GAPA(C1, C1 = DA_MFMA(kf[7], qr[3], C1), P1[14], P1[15], 0.f, 0.f,       pw3[2] = PKW(P1, 12), pw3[3] = PKW(P1, 14), pw3); \
    l_reg += sacc; \
    if (GK) DMA_K((t) + 3, sl_cur); if (GV) DMA_V((t) + 1, sl_next);                            \
    resc = false; \
    if (__builtin_expect(!fast, 0)) { const float rm = rowmax32(C0, C1);                        \
      if (__builtin_expect(__any(rm > THRL), 0)) { const float dl = fmaxf(rm, 0.f); m_reg += dl;    \
          const float f_ = __builtin_amdgcn_exp2f(-dl); l_reg *= f_; if (hi == 0) al_l[r32] = f_; resc = true; \
          _Pragma("unroll") for (int r = 0; r < 16; ++r) { C0[r] -= dl; C1[r] -= dl; } \
          fill16(negm, -m_reg); asm volatile("" : "+v"(negm)); } } \
    SBAR(); \
    GAPB(o[0] = DA_MFMA(PAF(pw0), VFR(0), o[0]), C0, 0, VRD(0, 4));  GAPB(o[1] = DA_MFMA(PAF(pw0), VFR(1), o[1]), C0, 2, VRD(1, 5)); \
    KRD(GL, 0); GAPB(o[2] = DA_MFMA(PAF(pw0), VFR(2), o[2]), C0, 4, VRD(2, 6));  KRD(GL, 1); GAPB(o[3] = DA_MFMA(PAF(pw0), VFR(3), o[3]), C0, 6, VRD(3, 7)); \
    KRD(GL, 2); GAPB(o[0] = DA_MFMA(PAF(pw1), VFR(0), o[0]), C0, 8, VRD(0, 8));  KRD(GL, 3); GAPB(o[1] = DA_MFMA(PAF(pw1), VFR(1), o[1]), C0, 10, VRD(1, 9)); \
    GAPB(o[2] = DA_MFMA(PAF(pw1), VFR(2), o[2]), C0, 12, VRD(2, 10)); GAPB(o[3] = DA_MFMA(PAF(pw1), VFR(3), o[3]), C0, 14, VRD(3, 11)); \
    GAPB(o[0] = DA_MFMA(PAF(pw2), VFR(0), o[0]), C1, 0, VRD(0, 12));  GAPB(o[1] = DA_MFMA(PAF(pw2), VFR(1), o[1]), C1, 2, VRD(1, 13)); \
    GAPB(o[2] = DA_MFMA(PAF(pw2), VFR(2), o[2]), C1, 4, VRD(2, 14));  GAPB(o[3] = DA_MFMA(PAF(pw2), VFR(3), o[3]), C1, 6, VRD(3, 15)); \
    GAPB(o[0] = DA_MFMA(PAF(pw3), VFR(0), o[0]), C1, 8, (void)0);     GAPB(o[1] = DA_MFMA(PAF(pw3), VFR(1), o[1]), C1, 10, (void)0); \
    GAPB(o[2] = DA_MFMA(PAF(pw3), VFR(2), o[2]), C1, 12, (void)0);    GAPB(o[3] = DA_MFMA(PAF(pw3), VFR(3), o[3]), C1, 14, (void)0); \
    } while (0)
    int t = 1;
    for (; t + 5 < NT; t += 2) {
        STEP(pB0, pB1, pA0, pA1, t, true, true, true);     DA_WAIT_BAR(4); RESC(); ROT();
        STEP(pA0, pA1, pB0, pB1, t + 1, true, true, true); DA_WAIT_BAR(4); RESC(); ROT();
    }
#define ENDW(tt) do { if ((tt) + 3 < NT) { DA_WAIT_BAR(4); } else if ((tt) + 2 < NT) { DA_WAIT_BAR(2); } else { DA_WAIT_BAR(0); } } while (0)
    for (; t + 1 < NT; t += 2) {
        STEP(pB0, pB1, pA0, pA1, t, (t + 3 < NT), (t + 1 < NT), (t + 1 < NT));         ENDW(t);     RESC(); ROT();
        STEP(pA0, pA1, pB0, pB1, t + 1, (t + 4 < NT), (t + 2 < NT), (t + 2 < NT));     ENDW(t + 1); RESC(); ROT();
    }
    STEP(pB0, pB1, pA0, pA1, NT - 1, false, false, false); RESC();
    { float sacc = pB0[0] + pB0[1];
#pragma unroll
      for (int r = 2; r < 16; ++r) sacc += pB0[r];
#pragma unroll
      for (int r = 0; r < 16; ++r) sacc += pB1[r];
      l_reg += sacc;
      pw0 = (u32x4){PKW(pB0, 0), PKW(pB0, 2), PKW(pB0, 4), PKW(pB0, 6)}; pw1 = (u32x4){PKW(pB0, 8), PKW(pB0, 10), PKW(pB0, 12), PKW(pB0, 14)};
      pw2 = (u32x4){PKW(pB1, 0), PKW(pB1, 2), PKW(pB1, 4), PKW(pB1, 6)}; pw3 = (u32x4){PKW(pB1, 8), PKW(pB1, 10), PKW(pB1, 12), PKW(pB1, 14)};
      pv_da(o, vb0 + sl_cur, PAF(pw0), PAF(pw1), PAF(pw2), PAF(pw3)); }
    { auto rr = __builtin_amdgcn_permlane32_swap(__float_as_uint(l_reg), __float_as_uint(l_reg), false, false); l_reg = __uint_as_float(rr[0]) + __uint_as_float(rr[1]); }
#undef DMA_K
#undef DMA_V
#undef ROT
#undef RESC
#undef KLOAD
#undef PKW
#undef PAF
#undef VOFF
#undef VRD
#undef VFR
#undef KRD
#undef GAPA
#undef GAPB
#undef STEP
#undef ENDW
    if (hi == 0) li_l[r32] = l_reg; asm volatile("s_waitcnt lgkmcnt(0)" ::: "memory");
    float rli[16];
#pragma unroll
    for (int r = 0; r < 16; ++r) rli[r] = __builtin_amdgcn_rcpf(li_l[crow(r, hi)]) * (map ? lam : 1.0f);
    __syncthreads();
    float* xch = (float*)lds;
    if (map == 1) {
#pragma unroll
        for (int d0 = 0; d0 < 4; ++d0)
#pragma unroll
            for (int r = 0; r < 16; ++r) xch[((wq * 4 + d0) * 16 + r) * 64 + lane] = o[d0][r] * rli[r];
    }
    __syncthreads();
    float* stg = (float*)(lds + DA_STG);
    if (map == 0) {
#pragma unroll
        for (int d0 = 0; d0 < 4; ++d0)
#pragma unroll
            for (int r = 0; r < 16; ++r) { const float dv = o[d0][r] * rli[r] - xch[((wq * 4 + d0) * 16 + r) * 64 + lane];
                stg[(wq * 32 + crow(r, hi)) * DA_STG_LD + d0 * 32 + r32] = dv; }
    }
    __syncthreads();
    {
        const int row = tid >> 2, qt = tid & 3; const float* sp = stg + row * DA_STG_LD + qt * 32;
        f32x4 dv[8]; float ss = 0.f;
#pragma unroll
        for (int g = 0; g < 8; ++g) { dv[g] = *(const f32x4*)(sp + g * 4); ss += (dv[g][0] * dv[g][0] + dv[g][1] * dv[g][1]) + (dv[g][2] * dv[g][2] + dv[g][3] * dv[g][3]); }
        ss += __shfl_xor(ss, 1); ss += __shfl_xor(ss, 2);
        const float sc2 = __builtin_amdgcn_rsqf(ss * (1.0f / 128.0f) + EPS) * one_m_li;
        const size_t goff = (size_t)(rowbase + q0 + row) * DM + h * 128 + qt * 32;
#pragma unroll
        for (int g = 0; g < 4; ++g) {
            const bf16x8 gt = ld8(Ga + goff + g * 8);
            const f32x4 w0 = *(const f32x4*)(subw + qt * 32 + g * 8), w1 = *(const f32x4*)(subw + qt * 32 + g * 8 + 4);
            const f32x4 a = dv[2 * g], c = dv[2 * g + 1];
            u32x4 w;
            w.x = cvtpk(a[0] * sc2 * w0[0] * bf2f((u16)gt[0]), a[1] * sc2 * w0[1] * bf2f((u16)gt[1]));
            w.y = cvtpk(a[2] * sc2 * w0[2] * bf2f((u16)gt[2]), a[3] * sc2 * w0[3] * bf2f((u16)gt[3]));
            w.z = cvtpk(c[0] * sc2 * w1[0] * bf2f((u16)gt[4]), c[1] * sc2 * w1[1] * bf2f((u16)gt[5]));
            w.w = cvtpk(c[2] * sc2 * w1[2] * bf2f((u16)gt[6]), c[3] * sc2 * w1[3] * bf2f((u16)gt[7]));
            if (!DRY) *(u32x4*)(Y + goff + g * 8) = w; else asm volatile("" :: "v"(w));
        }
    }
    __syncthreads();
}

constexpr int SWB_K = 0, SWB_V = 49152, SWB_WS = 98304, SWB_STG = 100352, SWB_STG_LD = 36;
__device__ __forceinline__ void swa_block_geom(int qb, int& t_lo, int& t_hi) { const int q0 = qb * 128; t_lo = (q0 >= 128 ? q0 - 128 : 0) >> 6; t_hi = (q0 + 255 < SEQ ? q0 + 255 : SEQ - 1) >> 6; }
template <int N> struct SwaRegs { bf16x8 k[N], v[N]; };
template <int N> __device__ __forceinline__ void swa_tiles_load(SwaRegs<N>& R, int b, int kvh, int t0, int nt, const u16* __restrict__ Kb, const u16* __restrict__ Vb, int tid) {
    const int sr = tid >> 3, sc = (tid & 7) * 8; const long rowbase = (long)b * SEQ;
    const u16* Kh = Kb + (rowbase + t0 * 64 + sr) * 256 + kvh * 64 + sc; const u16* Vh = Vb + (rowbase + t0 * 64 + sr) * 256 + kvh * 64 + sc;
#pragma unroll
    for (int tt = 0; tt < N; ++tt) if (tt < nt) { R.k[tt] = ld8(Kh + (long)tt * 64 * 256); R.v[tt] = ld8(Vh + (long)tt * 64 * 256); }
}
template <int N> __device__ __forceinline__ void swa_tiles_store_lds(const SwaRegs<N>& R, int t0, int nt, char* lds, int tid) {
    const int sr = tid >> 3, sc = (tid & 7) * 8, vst0 = v_stn<2>(sr, sc), kst0 = KSWZ128(sr, sc * 2);
#pragma unroll
    for (int tt = 0; tt < N; ++tt) if (tt < nt) { const int sl = (t0 + tt) % 6; *(bf16x8*)(lds + SWB_K + sl * 8192 + kst0) = R.k[tt]; *(bf16x8*)(lds + SWB_V + sl * 8192 + vst0) = R.v[tt]; }
}
template <bool DRY>
__device__ __forceinline__ void swa_block_compute(int b, int kvh, int qb, const u16* Q, const u16* __restrict__ Gt, u16* Y, const float* __restrict__ sink, char* lds, int tid) {
    const int lane = tid & 63, r32 = lane & 31, hi = lane >> 5; const int wid = __builtin_amdgcn_readfirstlane(tid >> 6);
    const int hq = kvh * 8 + wid; const long rowbase = (long)b * SEQ; const int q0 = qb * 128;
    int t_lo, t_hib; swa_block_geom(qb, t_lo, t_hib); (void)t_hib;
    float* wsf = (float*)(lds + SWB_WS) + wid * 64; float* al_l = wsf + 32;
    float* stg = (float*)(lds + SWB_STG) + wid * (32 * SWB_STG_LD);
    const int vb0 = (int)(uintptr_t)(lds + SWB_V) + v_rd_base(lane);
    const float sink2 = sink[hq] * LOG2E;
    bf16x8 qn[4];
    { const u16* Qw = Q + (rowbase + q0 + r32) * DIN + hq * 64 + hi * 8;
#pragma unroll
      for (int d0 = 0; d0 < 4; ++d0) qn[d0] = ld8(Qw + d0 * 16); }
#pragma unroll 1
    for (int sub = 0; sub < 4; ++sub) {
        const int qs = q0 + 32 * sub;
        bf16x8 qr[4];
#pragma unroll
        for (int d0 = 0; d0 < 4; ++d0) qr[d0] = qn[d0];
        if (sub < 3) { const u16* Qw = Q + (rowbase + qs + 32 + r32) * DIN + hq * 64 + hi * 8;
#pragma unroll
            for (int d0 = 0; d0 < 4; ++d0) qn[d0] = ld8(Qw + d0 * 16); }
        const int ta = ((qs >= 128 ? qs - 128 : 0) >> 6) - t_lo, tb = ((qs + 159 < SEQ ? qs + 159 : SEQ - 1) >> 6) - t_lo;
        float m_reg = sink2, l_dummy = 0.f; f32x16 o[2] = {}; f32x16 lacc, negm; fill16(lacc, 1.0f); fill16(negm, -sink2);
        const bf16x8 ones = {0x3F80, 0x3F80, 0x3F80, 0x3F80, 0x3F80, 0x3F80, 0x3F80, 0x3F80};
        bf16x8 gpre[2][2];
        { const size_t gb = (size_t)(rowbase + qs + (lane >> 1)) * DIN + hq * 64 + (lane & 1) * 16;
#pragma unroll
          for (int cbk = 0; cbk < 2; ++cbk) { gpre[cbk][0] = ld8(Gt + gb + cbk * 32); gpre[cbk][1] = ld8(Gt + gb + cbk * 32 + 8); } }
        for (int tt = ta; tt <= tb; ++tt) {
            const int k0 = (t_lo + tt) * 64, sl = (t_lo + tt) % 6;
            f32x16 p0, p1;
            const char* Ks = lds + SWB_K + sl * 8192;
#pragma unroll
            for (int d0 = 0; d0 < 4; ++d0) { const int cb = (d0 * 16 + hi * 8) * 2;
                const bf16x8 b0 = *reinterpret_cast<const bf16x8*>(Ks + KSWZ128(r32, cb));
                const bf16x8 b1 = *reinterpret_cast<const bf16x8*>(Ks + KSWZ128(32 + r32, cb));
                if (d0 == 0) { p0 = __builtin_amdgcn_mfma_f32_32x32x16_bf16(b0, qr[0], negm, 0, 0, 0); p1 = __builtin_amdgcn_mfma_f32_32x32x16_bf16(b1, qr[0], negm, 0, 0, 0); }
                else { p0 = __builtin_amdgcn_mfma_f32_32x32x16_bf16(b0, qr[d0], p0, 0, 0, 0); p1 = __builtin_amdgcn_mfma_f32_32x32x16_bf16(b1, qr[d0], p1, 0, 0, 0); } }
            if (k0 < qs - 97 || k0 + 63 > qs + 128) {
                const int base = k0 - qs - r32 + 4 * hi + 128;
#pragma unroll
                for (int r = 0; r < 16; ++r) { const int c = (r & 3) + 8 * (r >> 2); if ((unsigned)(base + c) > 256u) p0[r] = -1e30f; if ((unsigned)(base + c + 32) > 256u) p1[r] = -1e30f; }
            }
            float alpha; bf16x8 pa0, pa1, pa2, pa3;
            partialSM_n<false>(p0, p1, m_reg, negm, alpha);
            if (__any(alpha < 1.f)) { if (hi == 0) al_l[r32] = alpha; asm volatile("s_waitcnt lgkmcnt(0)" ::: "memory");
#pragma unroll
                for (int r = 0; r < 16; ++r) { const float al = al_l[crow(r, hi)]; o[0][r] *= al; o[1][r] *= al; lacc[r] *= al; } }
            finishSM_n<false>(p0, p1, alpha, l_dummy, pa0, pa1, pa2, pa3);
            {
                const int vbt = vb0 + sl * 8192; s16x4 lo[4], hi4[4];
#define VADDR2(i) (vbt + ((i) & 1) * 512 + ((i) >> 1) * 2048)
#pragma unroll
                for (int i = 0; i < 4; ++i) { lo[i] = vtr(VADDR2(i)); hi4[i] = vtr(VADDR2(i) + 1024); }
#pragma unroll
                for (int i = 0; i < 8; ++i) {
                    const bf16x8 vf = PKF(lo[i & 3], hi4[i & 3]);
                    const bf16x8 pa = ((i >> 1) == 0) ? pa0 : ((i >> 1) == 1) ? pa1 : ((i >> 1) == 2) ? pa2 : pa3;
                    o[i & 1] = __builtin_amdgcn_mfma_f32_32x32x16_bf16(pa, vf, o[i & 1], 0, 0, 0);
                    if ((i & 1) == 1) lacc = __builtin_amdgcn_mfma_f32_32x32x16_bf16(pa, ones, lacc, 0, 0, 0);
                    if (i + 4 < 8) { lo[i & 3] = vtr(VADDR2(i + 4)); hi4[i & 3] = vtr(VADDR2(i + 4) + 1024); }
                }
#undef VADDR2
            }
        }
        float rl[16];
#pragma unroll
        for (int r = 0; r < 16; ++r) rl[r] = __builtin_amdgcn_rcpf(lacc[r]);
#pragma unroll
        for (int cbk = 0; cbk < 2; ++cbk) {
#pragma unroll
            for (int r = 0; r < 16; ++r) stg[crow(r, hi) * SWB_STG_LD + r32] = o[cbk][r] * rl[r];
            asm volatile("s_waitcnt lgkmcnt(0)" ::: "memory");
            const int row = lane >> 1, hf = lane & 1; const float* sp = stg + row * SWB_STG_LD + hf * 16;
            const f32x4 a0 = *(const f32x4*)(sp), a1 = *(const f32x4*)(sp + 4), a2 = *(const f32x4*)(sp + 8), a3 = *(const f32x4*)(sp + 12);
            const size_t goff = (size_t)(rowbase + qs + row) * DIN + hq * 64 + cbk * 32 + hf * 16;
            const bf16x8 g0 = gpre[cbk][0], g1 = gpre[cbk][1];
            u32x4 w0, w1;
            w0.x = cvtpk(a0[0] * bf2f((u16)g0[0]), a0[1] * bf2f((u16)g0[1])); w0.y = cvtpk(a0[2] * bf2f((u16)g0[2]), a0[3] * bf2f((u16)g0[3]));
            w0.z = cvtpk(a1[0] * bf2f((u16)g0[4]), a1[1] * bf2f((u16)g0[5])); w0.w = cvtpk(a1[2] * bf2f((u16)g0[6]), a1[3] * bf2f((u16)g0[7]));
            w1.x = cvtpk(a2[0] * bf2f((u16)g1[0]), a2[1] * bf2f((u16)g1[1])); w1.y = cvtpk(a2[2] * bf2f((u16)g1[2]), a2[3] * bf2f((u16)g1[3]));
            w1.z = cvtpk(a3[0] * bf2f((u16)g1[4]), a3[1] * bf2f((u16)g1[5])); w1.w = cvtpk(a3[2] * bf2f((u16)g1[6]), a3[3] * bf2f((u16)g1[7]));
            if (!DRY) { *(u32x4*)(Y + goff) = w0; *(u32x4*)(Y + goff + 8) = w1; } else asm volatile("" :: "v"(w0), "v"(w1));
            asm volatile("s_waitcnt lgkmcnt(0)" ::: "memory");
        }
    }
}
template <bool DRY>
__device__ __forceinline__ void swa_phase(int u0, const u16* Q, const u16* Kb, const u16* Vb, const u16* Gt, u16* Y, const float* sink, char* lds) {
    int tid = threadIdx.x; asm volatile("" : "+v"(tid));
    const int bk = u0 >> 5, b = bk >> 2, kvh = bk & 3, qbA = u0 & 31, qbB = qbA + 1;
    int tloA, thiA, tloB, thiB; swa_block_geom(qbA, tloA, thiA); swa_block_geom(qbB, tloB, thiB);
    { SwaRegs<6> R; swa_tiles_load<6>(R, b, kvh, tloA, thiA - tloA + 1, Kb, Vb, tid); swa_tiles_store_lds<6>(R, tloA, thiA - tloA + 1, lds, tid); }
    __syncthreads();
    SwaRegs<2> N; const int nnew = thiB - thiA;
    swa_tiles_load<2>(N, b, kvh, thiA + 1, nnew, Kb, Vb, tid);
    swa_block_compute<DRY>(b, kvh, qbA, Q, Gt, Y, sink, lds, tid);
    __syncthreads();
    swa_tiles_store_lds<2>(N, thiA + 1, nnew, lds, tid);
    __syncthreads();
    swa_block_compute<DRY>(b, kvh, qbB, Q, Gt, Y, sink, lds, tid);
    __syncthreads();
}
}
namespace hg {
using namespace att;
typedef _Float16 f16;
constexpr int L_QT = 0, L_KT = 16384, L_QIN = 32768, L_KDEC = 49152, L_V = 65536, L_S = 81920, L_CUM = 114688, L_EDEC = 118784, L_STG = 0, STG_LD = 132;

struct ChunkRegs { unsigned q[8], v[8], lf[8]; };

__device__ __forceinline__ int chunk_pos(int c, int i, int dir) { return dir ? (c * 64 + 63 - i) : (c * 64 + i); }

template <bool NEEDQ>
__device__ __forceinline__ void load_chunk(ChunkRegs& R, const u16* Qh, const u16* Vh, const u16* LF, long rowbase, int colbase, int c, int dir, int wid, int lane) {
#pragma unroll
    for (int i = 0; i < 8; ++i) {
        const long pos = rowbase + chunk_pos(c, wid * 8 + i, dir);
        const size_t off = (size_t)pos * DM + colbase + 2 * lane;
        if (NEEDQ) R.q[i] = *(const unsigned*)(Qh + off);
        R.v[i] = *(const unsigned*)(Vh + off);
        R.lf[i] = *(const unsigned*)(LF + off);
    }
}
__device__ __forceinline__ float h2f(unsigned short h) { return (float)__builtin_bit_cast(f16, h); }

template <bool FULL>
__device__ __forceinline__ void prep_chunk(const ChunkRegs& R, char* lds, int wid, int lane, float (&gtot)[2]) {
    float g[8][2]; float run0 = 0.f, run1 = 0.f;
#pragma unroll
    for (int i = 0; i < 8; ++i) { run0 += h2f((unsigned short)(R.lf[i] & 0xffff)); run1 += h2f((unsigned short)(R.lf[i] >> 16)); g[i][0] = run0; g[i][1] = run1; }
    float* cum = (float*)(lds + L_CUM);
    *(float2*)(cum + wid * 128 + 2 * lane) = make_float2(run0, run1);
    __syncthreads();
    float pre0 = 0.f, pre1 = 0.f, gm0 = 0.f, gm1 = 0.f, gl0 = 0.f, gl1 = 0.f;
#pragma unroll
    for (int w2 = 0; w2 < 8; ++w2) { const float2 t = *(const float2*)(cum + w2 * 128 + 2 * lane);
        if (w2 < wid) { pre0 += t.x; pre1 += t.y; } if (w2 < 4) { gm0 += t.x; gm1 += t.y; } gl0 += t.x; gl1 += t.y; }
    gtot[0] += gl0; gtot[1] += gl1;
    const float egm0 = __expf(gm0), egm1 = __expf(gm1), elm0 = __expf(gl0 - gm0), elm1 = __expf(gl1 - gm1);
    if (wid == 0) *(float2*)((float*)(lds + L_EDEC) + 2 * lane) = make_float2(__expf(gl0), __expf(gl1));
#pragma unroll
    for (int i = 0; i < 8; ++i) {
        const int row = wid * 8 + i;
        const float G0 = pre0 + g[i][0], G1 = pre1 + g[i][1];
        const float e0 = __expf(G0 - gm0), e1 = __expf(G1 - gm1);
        const float r0 = __builtin_amdgcn_rcpf(e0), r1 = __builtin_amdgcn_rcpf(e1);
        const float lf0 = h2f((unsigned short)(R.lf[i] & 0xffff)), lf1 = h2f((unsigned short)(R.lf[i] >> 16));
        const float k0 = 1.0f - __expf(lf0), k1 = 1.0f - __expf(lf1);
        const float kt0 = k0 * r0, kt1 = k1 * r1;
        const int vo = v_st<4>(row, 2 * lane);
        *(unsigned*)(lds + L_KDEC + vo) = cvtpk(kt0 * elm0, kt1 * elm1);
        *(unsigned*)(lds + L_V + vo) = R.v[i];
        if (FULL) {
            const float q0 = bf2f((u16)(R.q[i] & 0xffff)), q1 = bf2f((u16)(R.q[i] >> 16));
            const float qt0 = q0 * e0, qt1 = q1 * e1;
            const int ko = KSWZ(row, 4 * lane);
            *(unsigned*)(lds + L_QT + ko) = cvtpk(qt0, qt1);
            *(unsigned*)(lds + L_KT + ko) = cvtpk(kt0, kt1);
            *(unsigned*)(lds + L_QIN + ko) = cvtpk(qt0 * egm0, qt1 * egm1);
        }
    }
}

template <int KS> __device__ __forceinline__ bf16x8 tr_frag(int vb) {
    const s16x4 l = tr_read<KS * 4096>(vb), h = tr_read<KS * 4096 + 2048>(vb);
    asm volatile("s_waitcnt lgkmcnt(0)" ::: "memory"); SBAR();
    return PKF(l, h);
}

struct SuFrag { s16x4 lv, hv, l0, h0, l1, h1; };
__device__ __forceinline__ void su_read(SuFrag& f, int vbV, int vbK0, int vbK1, int off) {
    f.lv = vtr(vbV + off); f.hv = vtr(vbV + off + 2048); f.l0 = vtr(vbK0 + off); f.h0 = vtr(vbK0 + off + 2048); f.l1 = vtr(vbK1 + off); f.h1 = vtr(vbK1 + off + 2048);
}
__device__ __forceinline__ void su_mma(f32x16 (&sacc)[2], const SuFrag& f) {
    const bf16x8 bv = PKF(f.lv, f.hv), a0 = PKF(f.l0, f.h0), a1 = PKF(f.l1, f.h1);
    sacc[0] = __builtin_amdgcn_mfma_f32_32x32x16_bf16(a0, bv, sacc[0], 0, 0, 0); sacc[1] = __builtin_amdgcn_mfma_f32_32x32x16_bf16(a1, bv, sacc[1], 0, 0, 0);
}
template <int NIMG>
__device__ __forceinline__ void state_update_t(f32x16 (&sacc)[2], const char* lds, int ldsbase, int offK, int offV, int offE, int wid, int lane) {
    const int hi = lane >> 5, j = wid >> 1, ib = 2 * (wid & 1);
    const float* edec = (const float*)(lds + offE);
    const int vbV = ldsbase + offV + v_rd_base(lane) + j * 512;
    const int vbK0 = ldsbase + offK + v_rd_base(lane) + ib * 512, vbK1 = vbK0 + 512;
#pragma unroll
    for (int i2 = 0; i2 < 2; ++i2)
#pragma unroll
        for (int r = 0; r < 16; ++r) sacc[i2][r] *= edec[32 * (ib + i2) + crow(r, hi)];
    SBAR();
    SuFrag fa, fb; su_read(fa, vbV, vbK0, vbK1, 0);
#pragma unroll
    for (int s = 0; s < 4 * NIMG; s += 2) {
        su_read(fb, vbV, vbK0, vbK1, ((s + 1) >> 2) * 16384 + ((s + 1) & 3) * 4096);
        su_mma(sacc, fa);
        if (s + 2 < 4 * NIMG) su_read(fa, vbV, vbK0, vbK1, ((s + 2) >> 2) * 16384 + ((s + 2) & 3) * 4096);
        su_mma(sacc, fb);
    }
    __builtin_amdgcn_sched_group_barrier(0x100, 6, 0);
#pragma unroll
    for (int s = 0; s < 4 * NIMG - 1; ++s) { __builtin_amdgcn_sched_group_barrier(0x100, 6, 0); __builtin_amdgcn_sched_group_barrier(0x008, 2, 0); }
    __builtin_amdgcn_sched_group_barrier(0x008, 2, 0);
    SBAR();
}
__device__ __forceinline__ void state_update(f32x16 (&sacc)[2], const char* lds, int ldsbase, int wid, int lane) { state_update_t<1>(sacc, lds, ldsbase, L_KDEC, L_V, L_EDEC, wid, lane); }
__device__ __forceinline__ void write_simg(const f32x16 (&sacc)[2], char* lds, int wid, int lane) {
    const int r32 = lane & 31, hi = lane >> 5, j = wid >> 1, ib = 2 * (wid & 1);
#pragma unroll
    for (int i2 = 0; i2 < 2; ++i2)
#pragma unroll
        for (int r = 0; r < 16; ++r) { const int d = 32 * (ib + i2) + crow(r, hi);
            *(__hip_bfloat16*)(lds + L_S + (d >> 6) * 16384 + v_st<4>(d & 63, 32 * j + r32)) = __float2bfloat16(sacc[i2][r]); }
}
__device__ __forceinline__ f32x16 chunk_output(const char* lds, int ldsbase, int wid, int lane) {
    const int r32 = lane & 31, hi = lane >> 5, tb = wid & 1, j = wid >> 1;
    const char* QT = lds + L_QT; const char* KT = lds + L_KT; const char* QIN = lds + L_QIN;
    f32x16 p0 = f32x16{}, p1 = f32x16{};
#pragma unroll
    for (int d0 = 0; d0 < 8; ++d0) { const int cb = (d0 * 16 + hi * 8) * 2;
        const bf16x8 qf = *reinterpret_cast<const bf16x8*>(QT + KSWZ(32 * tb + r32, cb));
        const bf16x8 k0 = *reinterpret_cast<const bf16x8*>(KT + KSWZ(r32, cb));
        p0 = __builtin_amdgcn_mfma_f32_32x32x16_bf16(k0, qf, p0, 0, 0, 0);
        if (tb) { const bf16x8 k1 = *reinterpret_cast<const bf16x8*>(KT + KSWZ(32 + r32, cb)); p1 = __builtin_amdgcn_mfma_f32_32x32x16_bf16(k1, qf, p1, 0, 0, 0); } }
#pragma unroll
    for (int r = 0; r < 16; ++r) { const bool keep = crow(r, hi) <= r32; if (tb == 0) { p0[r] = keep ? p0[r] : 0.f; p1[r] = 0.f; } else { p1[r] = keep ? p1[r] : 0.f; } }
    bf16x8 pa0, pa1, pa2, pa3; pack4(p0, p1, pa0, pa1, pa2, pa3);
    f32x16 oacc = f32x16{};
    pv_blk<4>(oacc, ldsbase + L_V + v_rd_base(lane) + j * 512, pa0, pa1, pa2, pa3);
    const int vbS = ldsbase + L_S + v_rd_base(lane) + j * 512;
#define QINF(kd) (*reinterpret_cast<const bf16x8*>(QIN + KSWZ(32 * tb + r32, ((kd) * 16 + hi * 8) * 2)))
    {
        s16x4 lo[2], hh[2];
#define SADDR(kd) (vbS + ((kd) >> 2) * 16384 + ((kd) & 3) * 4096)
        lo[0] = vtr(SADDR(0)); hh[0] = vtr(SADDR(0) + 2048); lo[1] = vtr(SADDR(1)); hh[1] = vtr(SADDR(1) + 2048);
#pragma unroll
        for (int kd = 0; kd < 8; ++kd) {
            const bf16x8 b = PKF(lo[kd & 1], hh[kd & 1]); const bf16x8 q = QINF(kd);
            oacc = __builtin_amdgcn_mfma_f32_32x32x16_bf16(q, b, oacc, 0, 0, 0);
            if (kd + 2 < 8) { lo[kd & 1] = vtr(SADDR(kd + 2)); hh[kd & 1] = vtr(SADDR(kd + 2) + 2048); }
        }
#undef SADDR
    }
#undef QINF
    return oacc;
}

constexpr int P1_KDEC = 0, P1_V = 65536, P1_CUM = 131072, P1_EDEC = 135168;
struct BlockRegs { unsigned v[32], lf[32]; };
__device__ __forceinline__ void load_block(BlockRegs& R, const u16* Vh, const u16* LF, long rowbase, int colbase, int seg, int blk, int dir, int wid, int lane) {
    unsigned voff = (unsigned)lane * 4u; asm volatile("" : "+v"(voff));
#pragma unroll
    for (int i = 0; i < 32; ++i) {
        const int p = blk * 256 + wid * 32 + i;
        const long pos = rowbase + seg * 512 + (dir ? 511 - p : p);
        const size_t roff = ((size_t)pos * DM + colbase) * 2;
        R.v[i] = *(const unsigned*)((const char*)Vh + roff + voff); R.lf[i] = *(const unsigned*)((const char*)LF + roff + voff);
    }
}
__device__ __forceinline__ void prep_block(const BlockRegs& R, char* lds, int wid, int lane, float (&gtot)[2]) {
    float run0 = 0.f, run1 = 0.f;
#pragma unroll
    for (int i = 0; i < 32; ++i) { run0 += h2f((unsigned short)(R.lf[i] & 0xffff)); run1 += h2f((unsigned short)(R.lf[i] >> 16)); }
    float* cum = (float*)(lds + P1_CUM);
    *(float2*)(cum + wid * 128 + 2 * lane) = make_float2(run0, run1);
    __syncthreads();
    float pre0 = 0.f, pre1 = 0.f, gl0 = 0.f, gl1 = 0.f;
#pragma unroll
    for (int w2 = 0; w2 < 8; ++w2) { const float2 t = *(const float2*)(cum + w2 * 128 + 2 * lane); if (w2 < wid) { pre0 += t.x; pre1 += t.y; } gl0 += t.x; gl1 += t.y; }
    gtot[0] += gl0; gtot[1] += gl1;
    if (wid == 0) *(float2*)((float*)(lds + P1_EDEC) + 2 * lane) = make_float2(__expf(gl0), __expf(gl1));
    float G0 = pre0 - gl0, G1 = pre1 - gl1;
    char* base = lds + (wid >> 1) * 16384 + (wid & 1) * 8192 + v_st<4>(0, 2 * lane);
#pragma unroll
    for (int i = 0; i < 32; ++i) {
        const float lf0 = h2f((unsigned short)(R.lf[i] & 0xffff)), lf1 = h2f((unsigned short)(R.lf[i] >> 16));
        G0 += lf0; G1 += lf1;
        const float k0 = 1.0f - __expf(lf0), k1 = 1.0f - __expf(lf1);
        const int vo = v_st<4>(i, 0);
        *(unsigned*)(base + P1_KDEC + vo) = cvtpk(k0 * __expf(-G0), k1 * __expf(-G1));
        *(unsigned*)(base + P1_V + vo) = R.v[i];
    }
}
__device__ __forceinline__ void state_update_block(f32x16 (&sacc)[2], const char* lds, int ldsbase, int wid, int lane) { state_update_t<4>(sacc, lds, ldsbase, P1_KDEC, P1_V, P1_EDEC, wid, lane); }
__device__ __forceinline__ void hgrn_pass1(int item, const u16* Vt, const u16* LF0, const u16* LF1, float* ust, float* dst, char* lds) {
    int tid = threadIdx.x; asm volatile("" : "+v"(tid)); const int lane = tid & 63; const int wid = __builtin_amdgcn_readfirstlane(tid >> 6);
    const int seg = item & 7, dir = (item >> 3) & 1, bh = item >> 4, b = bh >> 3, h = bh & 7;
    const long rowbase = (long)b * SEQ; const int colbase = h * 128; const u16* LF = dir ? LF1 : LF0;
    const int ldsbase = (int)(uintptr_t)lds;
    f32x16 sacc[2] = {}; float gtot[2] = {0.f, 0.f};
    BlockRegs R;
    load_block(R, Vt, LF, rowbase, colbase, seg, 0, dir, wid, lane);
#pragma unroll 1
    for (int blk = 0; blk < 2; ++blk) {
        prep_block(R, lds, wid, lane, gtot);
        asm volatile("" ::: "memory");
        if (blk == 0) load_block(R, Vt, LF, rowbase, colbase, seg, 1, dir, wid, lane);
        __syncthreads();
        state_update_block(sacc, lds, ldsbase, wid, lane);
    }
    float* up = ust + (size_t)item * 16384 + wid * 2048;
#pragma unroll
    for (int i2 = 0; i2 < 2; ++i2)
#pragma unroll
        for (int r = 0; r < 16; ++r) up[(i2 * 16 + r) * 64 + lane] = sacc[i2][r];
    if (wid == 0) *(float2*)(dst + (size_t)item * 128 + 2 * lane) = make_float2(__expf(gtot[0]), __expf(gtot[1]));
    __syncthreads();
}

template <bool DRY, int PVAR = 0>
__device__ __forceinline__ void hgrn_pass2(int item, const u16* Qh, const u16* Vt, const u16* LF0, const u16* LF1, const u16* Gt, u16* OF, u16* Y,
                                           const float* ust, const float* dst, const float* __restrict__ nw, char* lds) {
    int tid = threadIdx.x; asm volatile("" : "+v"(tid)); const int lane = tid & 63, r32 = lane & 31, hi = lane >> 5; const int wid = __builtin_amdgcn_readfirstlane(tid >> 6);
    const int seg = item & 7, bh = item >> 3, b = bh >> 3, h = bh & 7;
    const long rowbase = (long)b * SEQ; const int colbase = h * 128;
    const int ldsbase = (int)(uintptr_t)lds; const int tb = wid & 1, j = wid >> 1, ib = 2 * (wid & 1);
    float* stg = (float*)(lds + L_STG);
    ChunkRegs R;
#pragma unroll 1
    for (int dir = 0; dir < 2; ++dir) {
        const u16* LF = dir ? LF1 : LF0;
        f32x16 sacc[2] = {}; float gtot[2] = {0.f, 0.f};
        const int nseg = dir ? (7 - seg) : seg;
        for (int n = 0; n < nseg; ++n) {
            const int sg = dir ? (7 - n) : n; const int it = ((bh * 2 + dir) * 8 + sg);
            const float* up = ust + (size_t)it * 16384 + wid * 2048; const float* dp = dst + (size_t)it * 128;
#pragma unroll
            for (int i2 = 0; i2 < 2; ++i2)
#pragma unroll
                for (int r = 0; r < 16; ++r) sacc[i2][r] = sacc[i2][r] * dp[32 * (ib + i2) + crow(r, hi)] + up[(i2 * 16 + r) * 64 + lane];
        }
        write_simg(sacc, lds, wid, lane);
        load_chunk<true>(R, Qh, Vt, LF, rowbase, colbase, dir ? (seg * 8 + 7) : (seg * 8), dir, wid, lane);
        for (int cc = 0; cc < 8; ++cc) {
            const int c = dir ? (seg * 8 + 7 - cc) : (seg * 8 + cc);
            const int ri = tid >> 3, rcg = tid & 7; const size_t goff = (size_t)(rowbase + chunk_pos(c, ri, dir)) * DM + colbase + rcg * 16;
            u32x4 pf0 = {}, pf1 = {}; bf16x8 pg0 = {}, pg1 = {};
            if (dir) { pf0 = *(const u32x4*)(OF + goff); pf1 = *(const u32x4*)(OF + goff + 8); pg0 = ld8(Gt + goff); pg1 = ld8(Gt + goff + 8); }
            if (PVAR != 1) prep_chunk<true>(R, lds, wid, lane, gtot); else { asm volatile("" :: "v"(R.q[0]), "v"(R.v[7]), "v"(R.lf[3])); __syncthreads(); }
            if (cc + 1 < 8) load_chunk<true>(R, Qh, Vt, LF, rowbase, colbase, dir ? (seg * 8 + 6 - cc) : (seg * 8 + cc + 1), dir, wid, lane);
            __syncthreads();
            f32x16 oacc = f32x16{};
            if (PVAR != 2) { oacc = chunk_output(lds, ldsbase, wid, lane); state_update(sacc, lds, ldsbase, wid, lane); }
            __syncthreads();
            if (PVAR != 3) {
            write_simg(sacc, lds, wid, lane);
#pragma unroll
            for (int r = 0; r < 16; ++r) stg[(32 * tb + crow(r, hi)) * STG_LD + 32 * j + r32] = oacc[r];
            __syncthreads();
            {
                const int i = ri, cg = rcg; const float* sp = stg + i * STG_LD + cg * 16;
                f32x4 ov[4];
#pragma unroll
                for (int g = 0; g < 4; ++g) ov[g] = *(const f32x4*)(sp + g * 4);
                if (dir == 0) {
                    u32x4 w0, w1;
                    w0.x = pg8::pk_f16(ov[0][0], ov[0][1]); w0.y = pg8::pk_f16(ov[0][2], ov[0][3]); w0.z = pg8::pk_f16(ov[1][0], ov[1][1]); w0.w = pg8::pk_f16(ov[1][2], ov[1][3]);
                    w1.x = pg8::pk_f16(ov[2][0], ov[2][1]); w1.y = pg8::pk_f16(ov[2][2], ov[2][3]); w1.z = pg8::pk_f16(ov[3][0], ov[3][1]); w1.w = pg8::pk_f16(ov[3][2], ov[3][3]);
                    if (!DRY) { *(u32x4*)(OF + goff) = w0; *(u32x4*)(OF + goff + 8) = w1; } else asm volatile("" :: "v"(w0), "v"(w1));
                } else {
                    const u32x4 f0 = pf0, f1 = pf1;
                    float tv[16];
#pragma unroll
                    for (int e = 0; e < 4; ++e) { tv[2 * e] = h2f((unsigned short)(f0[e] & 0xffff)); tv[2 * e + 1] = h2f((unsigned short)(f0[e] >> 16));
                                                  tv[8 + 2 * e] = h2f((unsigned short)(f1[e] & 0xffff)); tv[8 + 2 * e + 1] = h2f((unsigned short)(f1[e] >> 16)); }
                    float ss = 0.f;
#pragma unroll
                    for (int e = 0; e < 16; ++e) { tv[e] += ov[e >> 2][e & 3]; ss += tv[e] * tv[e]; }
                    ss += __shfl_xor(ss, 1); ss += __shfl_xor(ss, 2); ss += __shfl_xor(ss, 4);
                    const float rs = __builtin_amdgcn_rsqf(ss * (1.0f / 128.0f) + EPS);
                    const bf16x8 g0 = pg0, g1 = pg1;
                    float yv[16];
#pragma unroll
                    for (int e = 0; e < 8; ++e) { yv[e] = tv[e] * rs * nw[cg * 16 + e] * bf2f((u16)g0[e]); yv[8 + e] = tv[8 + e] * rs * nw[cg * 16 + 8 + e] * bf2f((u16)g1[e]); }
                    u32x4 w0, w1;
                    w0.x = cvtpk(yv[0], yv[1]); w0.y = cvtpk(yv[2], yv[3]); w0.z = cvtpk(yv[4], yv[5]); w0.w = cvtpk(yv[6], yv[7]);
                    w1.x = cvtpk(yv[8], yv[9]); w1.y = cvtpk(yv[10], yv[11]); w1.z = cvtpk(yv[12], yv[13]); w1.w = cvtpk(yv[14], yv[15]);
                    if (!DRY) { *(u32x4*)(Y + goff) = w0; *(u32x4*)(Y + goff + 8) = w1; } else asm volatile("" :: "v"(w0), "v"(w1));
                }
            }
            } else { asm volatile("" :: "v"(oacc), "v"(sacc[0]), "v"(sacc[1]), "v"(pf0), "v"(pg0)); __syncthreads(); }
        }
        __syncthreads();
    }
}
}
#define GAS __attribute__((address_space(1)))
#define LAS __attribute__((address_space(3)))
typedef unsigned short bf16;
typedef unsigned v4u __attribute__((ext_vector_type(4)));
typedef float f32x4 __attribute__((ext_vector_type(4)));
typedef short bf16x8 __attribute__((ext_vector_type(8)));
typedef GAS unsigned gu32;
typedef GAS unsigned long long gu64;
#define RLX_AGENT __ATOMIC_RELAXED, __HIP_MEMORY_SCOPE_AGENT
#define LDS_WAIT() asm volatile("s_waitcnt lgkmcnt(0)" ::: "memory")
#define VM_WAIT() asm volatile("s_waitcnt vmcnt(0)" ::: "memory")
__device__ __forceinline__ unsigned long long rt() { return __builtin_amdgcn_s_memrealtime(); }
__device__ __forceinline__ unsigned f2bf(float f) { unsigned u = __builtin_bit_cast(unsigned, f); return (u + 0x7fffu + ((u >> 16) & 1u)) >> 16; }
__device__ __forceinline__ unsigned pk2(float lo, float hi) { return f2bf(lo) | (f2bf(hi) << 16); }

#define XB_TMO      128
#define XB_XCNT(j)  (256  + 64 * (j))
#define XB_XSUB(j)  (1280 + 64 * (j))
#define XB_XGEN(j)  (2304 + 64 * (j))
#define XB_TOP      3328
#define XB_TOPGEN   3392
#define XCD_BAR_WORDS 3456
#define XB_SPIN_CAP (1u << 18)

__device__ __forceinline__ unsigned xb_ld(unsigned* p)              { return __hip_atomic_load(p, __ATOMIC_RELAXED, __HIP_MEMORY_SCOPE_AGENT); }
__device__ __forceinline__ unsigned xb_add(unsigned* p, unsigned v) { return __hip_atomic_fetch_add(p, v, __ATOMIC_RELAXED, __HIP_MEMORY_SCOPE_AGENT); }
__device__ __forceinline__ unsigned xb_xcc_id() { return (unsigned)__builtin_amdgcn_s_getreg((3 << 11) | 20) & 0xFu; }
#define XB_SPIN(cond, bar) do { unsigned _sp = 0; while (cond) { __builtin_amdgcn_s_sleep(1); \
    if ((++_sp & 255u) == 0u) { if (xb_ld(&(bar)[XB_TMO])) break; if (_sp > XB_SPIN_CAP) { atomicAdd(&(bar)[XB_TMO], 1u); break; } } } } while (0)

struct XcdBarrier {
    unsigned* bar; unsigned x;
    volatile LAS unsigned* st;
};

__device__ __forceinline__ XcdBarrier xcd_barrier_post(unsigned* bar, volatile LAS unsigned* st) {
    XcdBarrier b; b.bar = bar; b.x = xb_xcc_id(); b.st = st;
    if (threadIdx.x == 0) (void)xb_add(&bar[XB_XCNT(b.x)], 1u);
    return b;
}
__device__ __forceinline__ void xcd_barrier_complete(unsigned* bar, unsigned x, unsigned& nloc, unsigned& nx) {
    const unsigned G = gridDim.x * gridDim.y * gridDim.z;
    unsigned sum, cnt, mine, sp = 0u;
    for (;;) {
        sum = 0u; cnt = 0u; mine = 0u;
#pragma unroll
        for (unsigned j = 0; j < 16; ++j) { const unsigned c = xb_ld(&bar[XB_XCNT(j)]); sum += c; cnt += (c > 0u) ? 1u : 0u; mine = (j == x) ? c : mine; }
        if (sum == G) break;
        __builtin_amdgcn_s_sleep(1);
        if ((++sp & 255u) == 0u) { if (xb_ld(&bar[XB_TMO])) break; if (sp > XB_SPIN_CAP) { atomicAdd(&bar[XB_TMO], 1u); break; } }
    }
    nloc = mine > 0u ? mine : 1u; nx = cnt > 0u ? cnt : 1u;
}

__device__ __forceinline__ void xcd_barrier(const XcdBarrier& b) {
    asm volatile("s_waitcnt vmcnt(0)" ::: "memory");
    __syncthreads();
    if (threadIdx.x == 0) {
        unsigned* bar = b.bar; asm volatile("" : "+s"(bar)); unsigned bx = __builtin_amdgcn_readfirstlane(b.x); asm volatile("" : "+s"(bx));
        __builtin_amdgcn_s_waitcnt(0);
        unsigned nloc = b.st[0], nx = b.st[1];
        if (nloc == 0u) { xcd_barrier_complete(bar, bx, nloc, nx); b.st[0] = nloc; b.st[1] = nx; }
        const unsigned old = xb_add(&bar[XB_XSUB(bx)], 1u);
        const unsigned gen = old / nloc;
        if (old + 1u == (gen + 1u) * nloc) {
            __builtin_amdgcn_fence(__ATOMIC_RELEASE, "agent");
            asm volatile("s_waitcnt vmcnt(0)" ::: "memory");
            const unsigned og = xb_add(&bar[XB_TOP], 1u);
            const unsigned tg = og / nx;
            if (og + 1u == (tg + 1u) * nx) xb_add(&bar[XB_TOPGEN], 1u);
            else XB_SPIN(xb_ld(&bar[XB_TOPGEN]) == tg, bar);
            __builtin_amdgcn_fence(__ATOMIC_ACQUIRE, "agent");
            xb_add(&bar[XB_XGEN(bx)], 1u);
            asm volatile("s_waitcnt vmcnt(0)" ::: "memory");
        } else {
            XB_SPIN(xb_ld(&bar[XB_XGEN(bx)]) == gen, bar);
            __builtin_amdgcn_fence(__ATOMIC_ACQUIRE, "agent");
            asm volatile("s_waitcnt vmcnt(0)" ::: "memory");
        }
    }
    __syncthreads();
}
#ifndef DUP_MASK
#define DUP_MASK 0
#endif
#define DUP(kind) (((DUP_MASK) >> (kind)) & 1)
#ifndef DUPR_MASK
#define DUPR_MASK 0
#endif
#define DUPR(kind) (((DUPR_MASK) >> (kind)) & 1)
#ifndef DUPR_MODE
#define DUPR_MODE 0
#endif
#ifndef MK_PER_PHASE
#define MK_PER_PHASE 0
#endif

constexpr size_t MiB = 1u << 20;
constexpr size_t WS_CTL = 0, CTL_ZERO_BYTES = 1 * MiB;
constexpr size_t WS_ROPE = 1 * MiB;
constexpr size_t WS_LB = 1 * MiB + 256 * 1024;
constexpr size_t WS_KMX = 1 * MiB + 384 * 1024;
constexpr size_t WS_DST = 1 * MiB + 512 * 1024;
constexpr size_t WS_SSQ = 2 * MiB;
constexpr size_t WS_WTE = 3 * MiB;
constexpr size_t WS_WTO = 25 * MiB;
constexpr size_t WS_XB = 38 * MiB;
constexpr size_t WS_R0 = 70 * MiB, RSZ = 32 * MiB;
constexpr size_t WS_END = WS_R0 + 6 * RSZ;
constexpr int CW_BAR = 4096;

constexpr int RING_BYTES = 139264;
constexpr int LDSCTL_OFF = RING_BYTES + 8 * pg8::EPI_STG_WAVE, MISC_OFF = LDSCTL_OFF + 320;
constexpr int LDS_BYTES = 163840;
constexpr int NWAVES = 8, GRID = 256;
constexpr int NPH = 20;

struct Frame {
    LAS unsigned char* lds; volatile LAS unsigned* MISC; gu32* ctl;
    int tid, lane, wave, vcu, G;
};

__device__ __forceinline__ void transpose_item(const float* W, const float* sc, int K, int N, bf16* WT, LAS float* scr, int item, int lane) {
    const int nblk = N / 32, kb = item / nblk, nb = item % nblk, k0 = 64 * kb, n0 = 32 * nb;
    const int c4 = lane & 7, rk = lane >> 3;
#pragma unroll
    for (int i = 0; i < 8; ++i) { const int kk = 8 * i + rk; const float s = sc ? sc[k0 + kk] : 1.0f;
        f32x4 v = *(const GAS f32x4*)(W + (size_t)(k0 + kk) * N + n0 + 4 * c4); v = v * s; *(LAS f32x4*)(scr + kk * 36 + 4 * c4) = v; }
    LDS_WAIT(); asm volatile("" ::: "memory");
    const int c = lane & 7;
#pragma unroll
    for (int j = 0; j < 4; ++j) { const int n = (lane >> 3) + 8 * j; const LAS float* s = scr + (8 * c) * 36 + n;
        v4u o; o.x = pk2(s[0 * 36], s[1 * 36]); o.y = pk2(s[2 * 36], s[3 * 36]); o.z = pk2(s[4 * 36], s[5 * 36]); o.w = pk2(s[6 * 36], s[7 * 36]);
        *(GAS v4u*)(WT + (size_t)(n0 + n) * K + k0 + 8 * c) = o; }
    LDS_WAIT(); asm volatile("" ::: "memory");
}
__device__ __forceinline__ void convert_layer(Frame& F, const float* Win, const float* nrm, int Nin, const float* Wout, bf16* dstbuf, int wg = -1, int nwg = 0) {
    int lane = F.lane; asm volatile("" : "+v"(lane));
    LAS float* scr = (LAS float*)(F.lds + F.wave * 16384);
    const int gw = (wg < 0 ? F.vcu : wg) * NWAVES + F.wave, NGW = (wg < 0 ? F.G : nwg) * NWAVES;
    const int I_in = (DM / 64) * (Nin / 32), I_out = (DIN / 64) * (DM / 32);
    bf16* wout_t = dstbuf + (size_t)Nin * DM;
    for (int it = gw; it < I_in + I_out; it += NGW) {
        if (it < I_in) transpose_item(Win, nrm, DM, Nin, dstbuf, scr, it, lane);
        else transpose_item(Wout, nullptr, DIN, DM, wout_t, scr, it - I_in, lane);
    }
}
__device__ __forceinline__ float wave_sum(float v) {
#pragma unroll
    for (int o = 1; o < 64; o <<= 1) v += __shfl_xor(v, o);
    return v;
}

__device__ __forceinline__ void stagger(int vcu, unsigned ticks) {
    if (vcu & 1) { const unsigned long long t0 = __builtin_amdgcn_s_memrealtime(); while (__builtin_amdgcn_s_memrealtime() - t0 < ticks) __builtin_amdgcn_s_sleep(8); }
}
#ifndef STAG_EVEN
#define STAG_EVEN 0
#endif
#ifndef STAG_ODD
#define STAG_ODD 0
#endif
struct Args { const float* in[13]; float* out; unsigned char* ws; int ph_lo, ph_hi; };

__global__ void __launch_bounds__(NWAVES * 64, 2) mk_fwd(Args args) {
    extern __shared__ __attribute__((aligned(16))) unsigned char lds[];
    Frame F;
    F.lds = (LAS unsigned char*)lds;
    F.MISC = (volatile LAS unsigned*)(F.lds + MISC_OFF);
    F.tid = threadIdx.x; F.lane = F.tid & 63; F.wave = __builtin_amdgcn_readfirstlane(F.tid >> 6);
    F.G = gridDim.x; { const int bx = blockIdx.x; F.vcu = (F.G % 8 == 0) ? (bx % 8) * (F.G / 8) + bx / 8 : bx; }
    unsigned char* ws = args.ws;
    F.ctl = (gu32*)(ws + WS_CTL);
    for (int u = F.tid; u < (LDS_BYTES - LDSCTL_OFF) / 4; u += NWAVES * 64) ((LAS unsigned*)(F.lds + LDSCTL_OFF))[u] = 0u;
    __syncthreads();
    const int lo = args.ph_lo, hi = args.ph_hi; (void)lo; (void)hi;
    const bool multi = MK_PER_PHASE ? ((hi - lo) > 1) : true;
    XcdBarrier bar; bar.bar = (unsigned*)(F.ctl + CW_BAR); bar.x = 0; bar.st = nullptr;
    if (multi) bar = xcd_barrier_post((unsigned*)(F.ctl + CW_BAR), F.MISC + 8);
#ifndef PHASE_MASK
#define PHASE_MASK 0xFFFF
#endif
#if MK_PER_PHASE
#define INK(kind, k) ((((PHASE_MASK) >> (kind)) & 1) && lo <= (k) && (k) < hi)
#define IN(k) (lo <= (k) && (k) < hi)
#else
#define INK(kind, k) (((PHASE_MASK) >> (kind)) & 1)
#define IN(k) true
#endif
#if MK_PER_PHASE
#define SEAM(k) do { if (IN(k) && IN((k) + 1)) xcd_barrier(bar); } while (0)
#else
#define SEAM(k) do { xcd_barrier(bar); if (DUP(9)) xcd_barrier(bar); } while (0)
#endif

#define PTRS() size_t wz_ = 0; asm volatile("" : "+s"(wz_)); unsigned char* wsl = args.ws + wz_; \
    const float* x_in = args.in[0]; float* xres = args.out; \
    float* rope = (float*)(wsl + WS_ROPE); float* lbt = (float*)(wsl + WS_LB); float* dstv = (float*)(wsl + WS_DST); float* ssq = (float*)(wsl + WS_SSQ); unsigned* kmx = (unsigned*)(wsl + WS_KMX); (void)kmx; \
    bf16* wte = (bf16*)(wsl + WS_WTE); bf16* wto = (bf16*)(wsl + WS_WTO); bf16* xb = (bf16*)(wsl + WS_XB); float* ust = args.out;     \
    unsigned char* R0 = wsl + WS_R0; unsigned char* R1 = R0 + RSZ; unsigned char* R2 = R1 + RSZ; unsigned char* R3 = R2 + RSZ; unsigned char* R4 = R3 + RSZ; unsigned char* R5 = R4 + RSZ; \
    const int gw = F.vcu * NWAVES + F.wave, NGW = F.G * NWAVES; int tidl = threadIdx.x; asm volatile("" : "+v"(tidl)); const int lanel = tidl & 63; (void)lanel; \
    (void)x_in; (void)xres; (void)rope; (void)lbt; (void)dstv; (void)ssq; (void)wte; (void)wto; (void)xb; (void)ust; (void)R0; (void)R1; (void)R2; (void)R3; (void)R4; (void)R5; (void)gw; (void)NGW;

    for (int rep_ = 0; rep_ < (DUP(0) ? 2 : 1); ++rep_)
    if (INK(0, 0)) {
        PTRS();
        convert_layer(F, args.in[2], args.in[1], EVEN_IN, args.in[7], wte);
        convert_layer(F, args.in[9], args.in[8], ODD_IN, args.in[11], wto);
        {
            const int gt = F.vcu * (NWAVES * 64) + tidl, NGT = F.G * NWAVES * 64;
            for (int e = gt; e < SEQ * 8; e += NGT) { const int pos = e >> 3, i = e & 7; const double inv = pow(500000.0, -(double)i / 8.0); const double ang = (double)pos * inv;
                rope[e] = (float)cos(ang); rope[SEQ * 8 + e] = (float)sin(ang); }
            const float* lg = args.in[6];
            for (int e = gt; e < 2 * 1024; e += NGT) { const int dir = e >> 10, c = e & 1023; const float l0 = lg[(dir * 2 + 0) * 1024 + c], l1 = lg[(dir * 2 + 1) * 1024 + c];
                lbt[e] = 0.0f; lbt[2048 + e] = 1.0f / (1.0f + expf(l0 - l1)); }
            if (gt < 2 * NB * 16) kmx[gt] = 0u;
        }
        for (int m = gw; m < T; m += NGW) {
            const GAS f32x4* xr = (const GAS f32x4*)(x_in + (size_t)m * DM) + lanel; f32x4 v[4]; float s = 0.f;
#pragma unroll
            for (int j = 0; j < 4; ++j) { v[j] = xr[64 * j]; s += (v[j].x * v[j].x + v[j].y * v[j].y) + (v[j].z * v[j].z + v[j].w * v[j].w); }
            s = wave_sum(s);
            GAS unsigned long long* o8 = (GAS unsigned long long*)(xb + (size_t)m * DM) + lanel;
#pragma unroll
            for (int j = 0; j < 4; ++j) o8[64 * j] = (unsigned long long)pk2(v[j].x, v[j].y) | ((unsigned long long)pk2(v[j].z, v[j].w) << 32);
            if (lanel < 16) ssq[(size_t)m * 16 + lanel] = (lanel == 0) ? s : 0.0f;
        }
    }
    SEAM(0);

#pragma unroll 1
    for (int layer = 0; layer < 4; ++layer) {
        const int j = layer >> 1; const bool even = (layer & 1) == 0;
        const int pb = 1 + (layer >> 1) * 9 + (even ? 0 : 6);
        if (even) {
            const float lam_init = (j == 0) ? 0.2f : 0.470713018f;
            if (INK(1, pb + 0)) {
        PTRS();
                pg8::Gemm g{xb, wte, T, 4096, DM, DM, 1 << 30, 0l}; pg8::StaticOrder S; S.init(T, 4096, F.G, (int)blockIdx.x);
                pg8::EpiIn<true> E{ssq, rope, lbt + j * 2048, R0, R1, R2, R3, R4, R5, 0, kmx + j * (NB * 16)};
                if (DUP(1)) { pg8::EpiDry ED; pg8::gemm_phase(F.lds, g, S, ED); }
                if (DUPR(1)) { pg8::EpiIn<true, DUPR_MODE> E2{ssq, rope, lbt + j * 2048, R0, R1, R2, R3, R4, R5, 0, kmx + j * (NB * 16)}; pg8::gemm_phase(F.lds, g, S, E2); }
                if (STAG_EVEN) stagger(F.vcu, STAG_EVEN);
                pg8::gemm_phase(F.lds, g, S, E);
            }
            SEAM(pb + 0);
            if (INK(2, pb + 1)) {
        PTRS();
                if (layer == 2) { convert_layer(F, args.in[9] + (size_t)DM * ODD_IN, args.in[8] + DM, ODD_IN, args.in[11] + (size_t)DIN * DM, wto); __syncthreads(); }
                const float* lq = args.in[3] + j * 256; float s1 = 0.f, s2 = 0.f;
                for (int i = 0; i < 64; ++i) { s1 += lq[i] * lq[64 + i]; s2 += lq[128 + i] * lq[192 + i]; }
                const float lam = expf(s1) - expf(s2) + lam_init;
                if (DUP(2)) for (int i = 0; i < 4; ++i) { const int bh = (F.vcu >> 5) * 4 + i, qb = F.vcu & 31;
                    att::diff_attn_unit<true, DUPR_MODE>(bh >> 3, bh & 7, qb, (const att::u16*)R0, (const att::u16*)R1, (const att::u16*)R2, (const att::u16*)R3, (att::u16*)R0,
                                        args.in[4] + j * 128, lam, 1.0f - lam_init, kmx + j * (NB * 16), (char*)lds); }
                for (int i = 0; i < 4; ++i) { const int bh = (F.vcu >> 5) * 4 + i, qb = F.vcu & 31;
                    att::diff_attn_unit<false>(bh >> 3, bh & 7, qb, (const att::u16*)R0, (const att::u16*)R1, (const att::u16*)R2, (const att::u16*)R3, (att::u16*)R0,
                                        args.in[4] + j * 128, lam, 1.0f - lam_init, kmx + j * (NB * 16), (char*)lds); }
            }
            SEAM(pb + 1);
            if (INK(1, pb + 2)) {
        PTRS();
                pg8::Gemm g{xb, wte + (size_t)4096 * DM, T, 5120, DM, DM, 1 << 30, 0l}; pg8::StaticOrder S; S.init(T, 5120, F.G, (int)blockIdx.x);
                pg8::EpiIn<true> E{ssq, rope, lbt + j * 2048, R0, R1, R2, R3, R4, R5, 16};
                if (DUP(1)) { pg8::EpiDry ED; pg8::gemm_phase(F.lds, g, S, ED); }
                if (DUPR(1)) { pg8::EpiIn<true, DUPR_MODE> E2{ssq, rope, lbt + j * 2048, R0, R1, R2, R3, R4, R5, 16}; pg8::gemm_phase(F.lds, g, S, E2); }
                if (STAG_EVEN) stagger(F.vcu, STAG_EVEN);
                pg8::gemm_phase(F.lds, g, S, E);
            }
            SEAM(pb + 2);
            if (INK(3, pb + 3)) {
        PTRS();
                if (DUP(3)) for (int it = F.vcu; it < 512; it += F.G) hg::hgrn_pass1(it, (const att::u16*)R2, (const att::u16*)R4, (const att::u16*)R5, ust, dstv, (char*)lds);
                for (int it = F.vcu; it < 512; it += F.G) hg::hgrn_pass1(it, (const att::u16*)R2, (const att::u16*)R4, (const att::u16*)R5, ust, dstv, (char*)lds);
            }
            SEAM(pb + 3);
            if (INK(4, pb + 4)) {
        PTRS();
                if (DUP(4)) for (int it = F.vcu; it < 256; it += F.G) hg::hgrn_pass2<true, DUPR_MODE>(it, (const att::u16*)R1, (const att::u16*)R2, (const att::u16*)R4, (const att::u16*)R5, (const att::u16*)R3,
                                                                        (att::u16*)R4, (att::u16*)R1, ust, dstv, args.in[5] + j * 128, (char*)lds);
                for (int it = F.vcu; it < 256; it += F.G) hg::hgrn_pass2<false>(it, (const att::u16*)R1, (const att::u16*)R2, (const att::u16*)R4, (const att::u16*)R5, (const att::u16*)R3,
                                                                        (att::u16*)R4, (att::u16*)R1, ust, dstv, args.in[5] + j * 128, (char*)lds);
            }
            SEAM(pb + 4);
            if (INK(5, pb + 5)) {
        PTRS();
                pg8::Gemm g{(const bf16*)R0, wte + (size_t)EVEN_IN * DM, T, DM, DIN, DM, 16, (long)RSZ - 2048l}; pg8::StaticOrder S; S.init(T, DM, F.G, (int)blockIdx.x);
                if (DUP(5)) { pg8::EpiDry ED; pg8::gemm_phase(F.lds, g, S, ED); }
                if (layer == 0) { pg8::EpiOut<true, false> E{x_in, xres, xb, ssq}; pg8::gemm_phase(F.lds, g, S, E); }
                else            { pg8::EpiOut<false, false> E{x_in, xres, xb, ssq}; pg8::gemm_phase(F.lds, g, S, E); }
            }
            SEAM(pb + 5);
        } else {
            if (INK(6, pb + 0)) {
        PTRS();
                pg8::Gemm g{xb, wto, T, ODD_IN, DM, DM, 1 << 30, 0l}; pg8::StaticOrder S; S.init(T, ODD_IN, F.G, (int)blockIdx.x);
                pg8::EpiIn<false> E{ssq, rope, nullptr, R0, R1, R2, R3, R4, R5, 0};
                if (DUP(6)) { pg8::EpiDry ED; pg8::gemm_phase(F.lds, g, S, ED); }
                if (DUPR(6)) pg8::gemm_phase(F.lds, g, S, E);
                if (STAG_ODD) stagger(F.vcu, STAG_ODD);
                pg8::gemm_phase(F.lds, g, S, E);
                if (layer == 1 && (int)blockIdx.x >= 128 && F.G == 256)
                    convert_layer(F, args.in[2] + (size_t)DM * EVEN_IN, args.in[1] + DM, EVEN_IN, args.in[7] + (size_t)DIN * DM, wte, (int)blockIdx.x - 128, 128);
            }
            SEAM(pb + 0);
            if (INK(7, pb + 1)) {
        PTRS();
                if (DUP(7)) att::swa_phase<true>(2 * F.vcu, (const att::u16*)R0, (const att::u16*)R2, (const att::u16*)(R2 + (size_t)T * 256 * 2), (const att::u16*)R3, (att::u16*)R0, args.in[10] + j * 32, (char*)lds);
                att::swa_phase<false>(2 * F.vcu, (const att::u16*)R0, (const att::u16*)R2, (const att::u16*)(R2 + (size_t)T * 256 * 2), (const att::u16*)R3, (att::u16*)R0, args.in[10] + j * 32, (char*)lds);
            }
            SEAM(pb + 1);
            if (INK(5, pb + 2)) {
        PTRS();
                pg8::Gemm g{(const bf16*)R0, wto + (size_t)ODD_IN * DM, T, DM, DIN, DIN, 1 << 30, 0l}; pg8::StaticOrder S; S.init(T, DM, F.G, (int)blockIdx.x);
                if (DUP(5)) { pg8::EpiDry ED; pg8::gemm_phase(F.lds, g, S, ED); }
                if (layer == 3) { pg8::EpiOut<false, true> E{x_in, xres, xb, ssq}; pg8::gemm_phase(F.lds, g, S, E); }
                else            { pg8::EpiOut<false, false> E{x_in, xres, xb, ssq}; pg8::gemm_phase(F.lds, g, S, E); }
            }
            SEAM(pb + 2);
        }
    }
    if (INK(8, 19)) {
        PTRS();
        const float* fw = args.in[12];
        for (int m = gw; m < T; m += NGW) {
            GAS f32x4* xr = (GAS f32x4*)(xres + (size_t)m * DM) + lanel; f32x4 v[4]; float s = 0.f;
#pragma unroll
            for (int jj = 0; jj < 4; ++jj) { v[jj] = xr[64 * jj]; s += (v[jj].x * v[jj].x + v[jj].y * v[jj].y) + (v[jj].z * v[jj].z + v[jj].w * v[jj].w); }
            s = wave_sum(s); const float rs = 1.0f / sqrtf(s * (1.0f / DM) + EPS);
#pragma unroll
            for (int jj = 0; jj < 4; ++jj) { const f32x4 w = *((const f32x4*)fw + lanel + 64 * jj); xr[64 * jj] = v[jj] * rs * w; }
        }
    }
#undef IN
#undef INK
#undef SEAM
}

extern "C" void kernel_launch(void* const* d_in, const int* in_sizes, int n_in, void* d_out, int out_size, void* d_ws, size_t ws_size, hipStream_t stream) {
    static int ok = 0;
    if (ok == 0) {
        if (n_in != 13 || in_sizes[0] != T * DM || out_size != T * DM || ws_size < WS_END) { fprintf(stderr, "kernel_launch: shape/workspace mismatch (n_in %d, ws %zu, need %zu)\n", n_in, ws_size, (size_t)WS_END); ok = -1; return; }
        if (hipFuncSetAttribute((const void*)mk_fwd, hipFuncAttributeMaxDynamicSharedMemorySize, LDS_BYTES) != hipSuccess) { fprintf(stderr, "kernel_launch: hipFuncSetAttribute failed\n"); ok = -1; return; }
        int per_cu = 0;
        if (hipOccupancyMaxActiveBlocksPerMultiprocessor(&per_cu, (const void*)mk_fwd, NWAVES * 64, LDS_BYTES) != hipSuccess || per_cu < 1) fprintf(stderr, "kernel_launch: occupancy query reports %d\n", per_cu);
        (void)hipGetLastError();
        ok = 1;
    }
    if (ok < 0) return;
    (void)hipMemsetAsync((char*)d_ws + WS_CTL, 0, CTL_ZERO_BYTES, stream);
    Args a{};
    for (int i = 0; i < 13; ++i) a.in[i] = (const float*)d_in[i];
    a.out = (float*)d_out; a.ws = (unsigned char*)d_ws;
#if MK_PER_PHASE
    for (int p = 0; p < NPH; ++p) { a.ph_lo = p; a.ph_hi = p + 1; hipLaunchKernelGGL(mk_fwd, dim3(GRID), dim3(NWAVES * 64), LDS_BYTES, stream, a); }
#else
    a.ph_lo = 0; a.ph_hi = NPH;
    hipLaunchKernelGGL(mk_fwd, dim3(GRID), dim3(NWAVES * 64), LDS_BYTES, stream, a);
#endif
    const hipError_t le = hipPeekAtLastError();
    if (le != hipSuccess) fprintf(stderr, "kernel_launch: launch failed: %s\n", hipGetErrorName(le));
}
```

```cpp
#include <hip/hip_runtime.h>
#include <hip/hip_bf16.h>
#include <cstdio>
#include <cstdint>

constexpr int NB = 4, SEQ = 4096, DM = 1024, T = NB * SEQ;
constexpr int EVEN_IN = 9216, ODD_IN = 4608, DIN = 2048;
constexpr float EPS = 1e-6f;
constexpr float C2 = 0.125f * 1.4426950408889634f;
constexpr float LOG2E = 1.4426950408889634f;

namespace pg8 {
#define PG8_LAS __attribute__((address_space(3)))
typedef unsigned short bf16_t;
typedef short bf16x8 __attribute__((ext_vector_type(8)));
typedef float f32x4 __attribute__((ext_vector_type(4)));
typedef unsigned u32x4 __attribute__((ext_vector_type(4)));
constexpr int BM = 256, BK = 64, HALF = 128, HTB = HALF * BK * 2, STAGE_BYTES = 8 * HTB, NXCD = 8, WGM = 4;
constexpr int EPI_STG_OFF = 139264, EPI_STG_RS = 144, EPI_STG_WAVE = 16 * EPI_STG_RS;

__host__ __device__ __forceinline__ int lds_byte(int r, int c) { const int st = (r >> 4) * 2 + (c >> 5), rr = r & 15, cc = c & 31, ob = rr * 64 + cc * 2; return st * 1024 + (ob ^ (((ob >> 9) & 1) << 5)); }
__host__ __device__ __forceinline__ void stage_rc(int b, int& R, int& C) { const int st = b / 1024, sb = b % 1024, swz = sb ^ (((sb >> 9) & 1) << 5); R = (st >> 1) * 16 + swz / 64; C = (st & 1) * 32 + (swz % 64) / 2; }
__host__ __device__ __forceinline__ int perm32(int rho) { const int n = rho >> 4, i = rho & 15; return 8 * (i >> 2) + 4 * n + (i & 3); }

struct Unit { int pm, pn; };
struct Gemm { const bf16_t* A; const bf16_t* Bt; int M, N, K, lda, ksplit; long jump; };

struct StaticOrder {
    int nM, nN, nwg, G, c;
    __host__ __device__ void init(int M, int N, int G_, int c_) { nM = M / BM; nN = N / BM; nwg = nM * nN; G = G_; c = c_; }
    __host__ __device__ bool next(int i, Unit& u) const {
        const long L = (long)i * G + c; if (L >= nwg) return false;
        int wgid = (int)L; { const int q = nwg / NXCD, r = nwg % NXCD, xcd = wgid % NXCD, off = wgid / NXCD; wgid = (xcd < r ? xcd * (q + 1) : r * (q + 1) + (xcd - r) * q) + off; }
        const int nig = WGM * nN, gid = wgid / nig, fm = gid * WGM, gsz = (nM - fm) < WGM ? (nM - fm) : WGM;
        u.pm = fm + ((wgid % nig) % gsz); u.pn = (wgid % nig) / gsz; return true;
    }
};

__device__ __forceinline__ unsigned cvt_pk_bf16(float lo, float hi) { unsigned r; asm volatile("v_cvt_pk_bf16_f32 %0, %1, %2" : "=v"(r) : "v"(lo), "v"(hi)); return r; }

template <class Epi>
__device__ __forceinline__ void gemm_phase(PG8_LAS unsigned char* lds, const Gemm g, const StaticOrder& S, const Epi& E) {
    int tid = threadIdx.x; asm volatile("" : "+v"(tid));
    const int wid = __builtin_amdgcn_readfirstlane(tid >> 6), lane = tid & 63, wr = wid >> 2, wc = wid & 3, fr = lane & 15, fq = lane >> 4;
    const int K = g.K, nt = K / BK, lda = g.lda;
    unsigned voffA[2], voffB[2];
#pragma unroll
    for (int i = 0; i < 2; ++i) { int R, C; stage_rc(tid * 16 + i * 8192, R, C); const int Rb = 64 * (R >> 5) + perm32(R & 31);
        voffA[i] = (unsigned)(R * lda + C) * 2u; voffB[i] = (unsigned)(Rb * K + C) * 2u; }
    const size_t kstep = (size_t)(BK * 2);
    const size_t hstepA = (size_t)HALF * lda * 2, tstepA = 2 * hstepA;
    const size_t hstepB = (size_t)32 * K * 2, tstepB = (size_t)BM * K * 2;
    const unsigned ldsw = (unsigned)wid * 1024u;
    const int aoff = lds_byte(wr * 64 + fr, fq * 8), boff = lds_byte(wc * 32 + fr, fq * 8);
    const int ksplit = g.ksplit; const long jump = g.jump;
#define PG8_AP(base, t) ((base) + (size_t)(t) * kstep + (((t) >= ksplit) ? jump : 0l))
#define PG8_SA(b, h) (((b) * 2 + (h)) * HTB)
#define PG8_SB(b, h) ((4 + (b) * 2 + (h)) * HTB)
#define PG8_STAGE(bufoff, gbase, voff) do { _Pragma("unroll") for (int _i = 0; _i < 2; ++_i) \
        __builtin_amdgcn_global_load_lds((const unsigned*)((const char*)(gbase) + (voff)[_i]), (PG8_LAS unsigned*)(lds + (bufoff) + ldsw + _i * 8192), 16, 0, 0); } while (0)
#define PG8_LDA(dst, b, h) do { _Pragma("unroll") for (int m = 0; m < 4; ++m) _Pragma("unroll") for (int k = 0; k < 2; ++k) dst[m][k] = *(const PG8_LAS bf16x8*)(lds + PG8_SA(b, h) + aoff + m * 2048 + k * 1024); } while (0)
#define PG8_LDB(dst, b, h) do { _Pragma("unroll") for (int n = 0; n < 2; ++n) _Pragma("unroll") for (int k = 0; k < 2; ++k) dst[n][k] = *(const PG8_LAS bf16x8*)(lds + PG8_SB(b, h) + boff + n * 2048 + k * 1024); } while (0)
#define PG8_MMA(ai, bj, At, Bt) do { __builtin_amdgcn_s_setprio(1); _Pragma("unroll") for (int m = 0; m < 4; ++m) _Pragma("unroll") for (int n = 0; n < 2; ++n) _Pragma("unroll") for (int k = 0; k < 2; ++k) \
        acc[ai][bj][m][n] = __builtin_amdgcn_mfma_f32_16x16x32_bf16(Bt[n][k], At[m][k], acc[ai][bj][m][n], 0, 0, 0); __builtin_amdgcn_s_setprio(0); } while (0)
#define PG8_WAIT_V(n) asm volatile("s_waitcnt vmcnt(" #n ")" ::: "memory")
#define PG8_WAIT_L(n) asm volatile("s_waitcnt lgkmcnt(" #n ")" ::: "memory")
#define PG8_BAR __builtin_amdgcn_s_barrier()
#define PG8_SCHED __builtin_amdgcn_sched_barrier(0)
    Unit cur, nxt; int ui = 0;
    if (!S.next(0, cur)) return;
    f32x4 acc[2][2][4][2];
#pragma unroll
    for (int a = 0; a < 2; ++a)
#pragma unroll
        for (int b = 0; b < 2; ++b)
#pragma unroll
            for (int m = 0; m < 4; ++m)
#pragma unroll
                for (int n = 0; n < 2; ++n) acc[a][b][m][n] = (f32x4){0.f, 0.f, 0.f, 0.f};
    bf16x8 At[4][2], B0[2][2], B1[2][2];
    const char* cA = (const char*)g.A + (size_t)cur.pm * tstepA; const char* cB = (const char*)g.Bt + (size_t)cur.pn * tstepB;
    {
        PG8_STAGE(PG8_SB(0, 0), cB, voffB); PG8_STAGE(PG8_SB(0, 1), cB + hstepB, voffB); PG8_STAGE(PG8_SA(0, 0), cA, voffA); PG8_STAGE(PG8_SA(0, 1), cA + hstepA, voffA);
        if (wr == 1) PG8_BAR;
        PG8_WAIT_V(2); PG8_BAR;
        PG8_STAGE(PG8_SB(1, 0), cB + kstep, voffB); PG8_STAGE(PG8_SA(1, 0), PG8_AP(cA, 1), voffA); PG8_STAGE(PG8_SB(1, 1), cB + hstepB + kstep, voffB);
        PG8_WAIT_V(6); PG8_BAR;
    }
    for (;;) {
        const bool has_next = S.next(ui + 1, nxt);
        const char* nA = has_next ? (const char*)g.A + (size_t)nxt.pm * tstepA : cA; const char* nB = has_next ? (const char*)g.Bt + (size_t)nxt.pn * tstepB : cB;
        for (int t = 0; t < nt; t += 2) {
            const bool last = (t == nt - 2);
            const char* a1 = PG8_AP(cA, t + 1);
            const char* a2 = last ? nA : PG8_AP(cA, t + 2); const char* b2 = last ? nB : cB + (size_t)(t + 2) * kstep;
            const char* a3 = a2 + kstep; const char* b3 = b2 + kstep;
            PG8_LDB(B0, 0, 0); PG8_LDB(B1, 0, 1); PG8_SCHED; PG8_LDA(At, 0, 0); PG8_STAGE(PG8_SA(1, 1), a1 + hstepA, voffA);
            PG8_WAIT_V(8); PG8_WAIT_L(0); PG8_BAR; PG8_MMA(0, 0, At, B0); PG8_MMA(0, 1, At, B1); PG8_BAR; PG8_SCHED;
            PG8_LDA(At, 0, 1); PG8_STAGE(PG8_SB(0, 0), b2, voffB); PG8_STAGE(PG8_SB(0, 1), b2 + hstepB, voffB); PG8_STAGE(PG8_SA(0, 0), a2, voffA);
            PG8_WAIT_V(8); PG8_WAIT_L(0); PG8_BAR; PG8_MMA(1, 0, At, B0); PG8_MMA(1, 1, At, B1); PG8_BAR; PG8_SCHED;
            PG8_LDB(B0, 1, 0); PG8_LDB(B1, 1, 1); PG8_SCHED; PG8_LDA(At, 1, 0); PG8_STAGE(PG8_SA(0, 1), a2 + hstepA, voffA);
            PG8_WAIT_V(8); PG8_WAIT_L(0); PG8_BAR; PG8_MMA(0, 0, At, B0); PG8_MMA(0, 1, At, B1); PG8_BAR; PG8_SCHED;
            PG8_LDA(At, 1, 1); PG8_STAGE(PG8_SB(1, 0), b3, voffB); PG8_STAGE(PG8_SB(1, 1), b3 + hstepB, voffB); PG8_STAGE(PG8_SA(1, 0), a3, voffA);
            PG8_WAIT_V(8); PG8_WAIT_L(0); PG8_BAR; PG8_MMA(1, 0, At, B0); PG8_MMA(1, 1, At, B1); PG8_BAR; PG8_SCHED;
        }
        if (wr == 0) PG8_BAR;
        E(acc, cur, wr, wc, fr, fq, lds + EPI_STG_OFF + wid * EPI_STG_WAVE, lane);
        if (!has_next) break;
#pragma unroll
        for (int a = 0; a < 2; ++a)
#pragma unroll
            for (int b = 0; b < 2; ++b)
#pragma unroll
                for (int m = 0; m < 4; ++m)
#pragma unroll
                    for (int n = 0; n < 2; ++n) acc[a][b][m][n] = (f32x4){0.f, 0.f, 0.f, 0.f};
        cur = nxt; cA = nA; cB = nB; ++ui;
        if (wr == 1) PG8_BAR;
    }
    PG8_WAIT_V(0);
    PG8_BAR;
#undef PG8_AP
#undef PG8_SA
#undef PG8_SB
#undef PG8_STAGE
#undef PG8_LDA
#undef PG8_LDB
#undef PG8_MMA
#undef PG8_WAIT_V
#undef PG8_WAIT_L
#undef PG8_BAR
#undef PG8_SCHED
}
}
namespace pg8 {
typedef unsigned short u16;
__device__ __forceinline__ float fsigmoid(float v) { return __builtin_amdgcn_rcpf(1.0f + __expf(-v)); }
__device__ __forceinline__ unsigned pk_f16(float lo, float hi) { _Float16 a = (_Float16)lo, b = (_Float16)hi; return (unsigned)__builtin_bit_cast(unsigned short, a) | ((unsigned)__builtin_bit_cast(unsigned short, b) << 16); }


__device__ __forceinline__ void store_rows128(PG8_LAS unsigned char* stg, u16* blk  , size_t pitch, u32x4 w0, u32x4 w1, int fr, int fq, int lane) {
    *(PG8_LAS u32x4*)(stg + fr * EPI_STG_RS + fq * 16) = w0; *(PG8_LAS u32x4*)(stg + fr * EPI_STG_RS + 64 + fq * 16) = w1;
    const int rr = lane >> 3, ch = lane & 7;
    const u32x4 a = *(const PG8_LAS u32x4*)(stg + rr * EPI_STG_RS + ch * 16), b = *(const PG8_LAS u32x4*)(stg + (8 + rr) * EPI_STG_RS + ch * 16);
    *(u32x4*)(blk + (size_t)rr * pitch + ch * 8) = a; *(u32x4*)(blk + (size_t)(8 + rr) * pitch + ch * 8) = b;
}

__device__ __forceinline__ float bf_lo(unsigned w) { return __uint_as_float(w << 16); }
__device__ __forceinline__ float bf_hi(unsigned w) { return __uint_as_float(w & 0xffff0000u); }
enum { K_PLAIN = 0, K_SILU = 1, K_ROPEQ = 2, K_ROPEK = 3, K_LOGF = 4 };

template <bool EVEN, int MODE = 0> struct EpiIn {
    static constexpr bool PERM = true;
    const float* ssq;
    const float* rope;
    const float* lb;
    unsigned char* r0; unsigned char* r1; unsigned char* r2; unsigned char* r3; unsigned char* r4; unsigned char* r5;
    int pn_off;
    unsigned* kmx = nullptr;
    __device__ __forceinline__ void operator()(const f32x4 (&acc)[2][2][4][2], const Unit& u, int wr, int wc, int fr, int fq, PG8_LAS unsigned char* stg, int lane) const {
        const int gpn = u.pn + pn_off;
        int kind, pitch, colt, dir = 0; u16* outp;
        if (EVEN) {
            const int grp = gpn >> 2; colt = (gpn & 3) * 256; pitch = 1024;
            switch (grp) {
                case 0: kind = K_ROPEQ; outp = (u16*)r0; break;
                case 1: kind = K_ROPEK; outp = (u16*)r1; break;
                case 2: kind = K_PLAIN; outp = (u16*)r2; break;
                case 3: kind = K_SILU;  outp = (u16*)r3; break;
                case 4: kind = K_SILU;  outp = (u16*)r1; break;
                case 5: kind = K_LOGF;  outp = (u16*)r4; dir = 0; break;
                case 6: kind = K_LOGF;  outp = (u16*)r5; dir = 1; break;
                case 7: kind = K_PLAIN; outp = (u16*)r2; break;
                default: kind = K_SILU; outp = (u16*)r3; break;
            }
        } else {
            if (gpn < 8)       { kind = K_ROPEQ; outp = (u16*)r0; pitch = 2048; colt = gpn * 256; }
            else if (gpn == 8) { kind = K_ROPEK; outp = (u16*)r2; pitch = 256;  colt = 0; }
            else if (gpn == 9) { kind = K_PLAIN; outp = (u16*)(r2 + (size_t)T * 256 * 2); pitch = 256; colt = 0; }
            else               { kind = K_SILU;  outp = (u16*)r3; pitch = 2048; colt = (gpn - 10) * 256; }
        }
        int row0 = u.pm * BM + wr * 64 + fr; asm volatile("" : "+v"(row0));
        if (MODE == 2) kind = K_PLAIN;
        float rsv[8];
#pragma unroll
        for (int hb = 0; hb < 2; ++hb) { f32x4 sq[4];
#pragma unroll
          for (int i = 0; i < 4; ++i) sq[i] = *((const f32x4*)(ssq + (size_t)(row0 + hb * HALF + i * 16) * 16) + fq);
#pragma unroll
          for (int i = 0; i < 4; ++i) { float tot = (sq[i][0] + sq[i][1]) + (sq[i][2] + sq[i][3]); tot += __shfl_xor(tot, 16); tot += __shfl_xor(tot, 32); rsv[hb * 4 + i] = __builtin_amdgcn_rsqf(tot * (1.0f / DM) + EPS); }
          asm volatile("" ::: "memory"); }
        u16* const blk0 = outp + (size_t)(row0 - fr) * pitch + colt + wc * 64;
        if (kind == K_LOGF)        rows<K_LOGF>(acc, rsv, blk0, pitch, colt + wc * 64, dir, row0, 1.0f, fr, fq, stg, lane);
        else if (kind == K_SILU)   rows<K_SILU>(acc, rsv, blk0, pitch, 0, 0, row0, 1.0f, fr, fq, stg, lane);
        else if (kind == K_PLAIN)  rows<K_PLAIN>(acc, rsv, blk0, pitch, 0, 0, row0, 1.0f, fr, fq, stg, lane);
        else if (EVEN && kind == K_ROPEK) rows<K_ROPEK>(acc, rsv, blk0, pitch, colt + wc * 64, 0, row0, 1.0f, fr, fq, stg, lane);
        else                       rows<K_ROPEQ>(acc, rsv, blk0, pitch, 0, 0, row0, (kind == K_ROPEQ) ? C2 : 1.0f, fr, fq, stg, lane);
    }
    template <int KIND>
    __device__ __forceinline__ void rows(const f32x4 (&acc)[2][2][4][2], const float (&rsv)[8], u16* blk0, int pitch, int ccol, int dir, int row0, float qs, int fr, int fq, PG8_LAS unsigned char* stg, int lane) const {
        f32x4 lbv[2][2];
        if (KIND == K_LOGF) {
#pragma unroll
            for (int bj = 0; bj < 2; ++bj) { const int c0 = ccol + bj * 32 + 8 * fq; lbv[bj][0] = *(const f32x4*)(lb + dir * 1024 + c0); lbv[bj][1] = *(const f32x4*)(lb + dir * 1024 + c0 + 4); }
        }
        f32x4 cs0, cs1, sn0, sn1, ncs0, ncs1, nsn0, nsn1;
        constexpr bool ROPE = (KIND == K_ROPEQ || KIND == K_ROPEK); float kn2 = 0.f;
        if (ROPE) { const int pos = row0 & (SEQ - 1); const f32x4* cp = (const f32x4*)(rope + (size_t)pos * 8); const f32x4* spn = (const f32x4*)(rope + (size_t)SEQ * 8 + (size_t)pos * 8);
            ncs0 = cp[0]; ncs1 = cp[1]; nsn0 = spn[0]; nsn1 = spn[1]; }
#pragma unroll
        for (int ai = 0; ai < 2; ++ai)
#pragma unroll
            for (int m = 0; m < 4; ++m) {
                const float rs = rsv[ai * 4 + m];
                if (ROPE) { cs0 = ncs0; cs1 = ncs1; sn0 = nsn0; sn1 = nsn1;
                    if (ai * 4 + m < 7) { const int i2 = ai * 4 + m + 1; const int pos = (row0 + (i2 >> 2) * HALF + (i2 & 3) * 16) & (SEQ - 1);
                        const f32x4* cp = (const f32x4*)(rope + (size_t)pos * 8); const f32x4* spn = (const f32x4*)(rope + (size_t)SEQ * 8 + (size_t)pos * 8);
                        ncs0 = cp[0]; ncs1 = cp[1]; nsn0 = spn[0]; nsn1 = spn[1]; } }
                u32x4 wst[2];
#pragma unroll
                for (int bj = 0; bj < 2; ++bj) {
                    f32x4 v0 = acc[ai][bj][m][0] * rs, v1 = acc[ai][bj][m][1] * rs;
                    u32x4 w;
                    if (KIND == K_LOGF) {
                        const f32x4 l0 = lbv[bj][0], l1 = lbv[bj][1];
                        float o[8];
#pragma unroll
                        for (int e = 0; e < 4; ++e) { const float f0 = l0[e] + (1.0f - l0[e]) * fsigmoid(v0[e]), f1 = l1[e] + (1.0f - l1[e]) * fsigmoid(v1[e]);
                            o[e] = fmaxf(__builtin_amdgcn_logf(f0) * 0.6931471805599453f, -30.0f); o[4 + e] = fmaxf(__builtin_amdgcn_logf(f1) * 0.6931471805599453f, -30.0f); }
                        w.x = pk_f16(o[0], o[1]); w.y = pk_f16(o[2], o[3]); w.z = pk_f16(o[4], o[5]); w.w = pk_f16(o[6], o[7]);
                    } else {
                        if (KIND == K_SILU) {
#pragma unroll
                            for (int e = 0; e < 4; ++e) { v0[e] = v0[e] * fsigmoid(v0[e]); v1[e] = v1[e] * fsigmoid(v1[e]); }
                        } else if (ROPE && bj == 0) {
                            f32x4 o0, o1;
#pragma unroll
                            for (int e = 0; e < 4; ++e) { o0[e] = __shfl_xor(v0[e], 16); o1[e] = __shfl_xor(v1[e], 16); }
                            if (fq < 2) {
                                const float sg = (fq == 0) ? -1.0f : 1.0f;
                                v0 = v0 * cs0 + (o0 * sn0) * sg; v1 = v1 * cs1 + (o1 * sn1) * sg;
                            }
                        }
                        if (KIND == K_ROPEQ) { v0 = v0 * qs; v1 = v1 * qs; }
                        w.x = cvt_pk_bf16(v0[0], v0[1]); w.y = cvt_pk_bf16(v0[2], v0[3]); w.z = cvt_pk_bf16(v1[0], v1[1]); w.w = cvt_pk_bf16(v1[2], v1[3]);
                    }
                    wst[bj] = w;
                }
                if (KIND == K_ROPEK) {
                    float n2 = 0.f;
#pragma unroll
                    for (int bj = 0; bj < 2; ++bj) { const u32x4 w = wst[bj]; const float a0 = bf_lo(w.x), a1 = bf_hi(w.x), a2 = bf_lo(w.y), a3 = bf_hi(w.y), a4 = bf_lo(w.z), a5 = bf_hi(w.z), a6 = bf_lo(w.w), a7 = bf_hi(w.w);
                        n2 += (a0 * a0 + a1 * a1) + (a2 * a2 + a3 * a3) + (a4 * a4 + a5 * a5) + (a6 * a6 + a7 * a7); }
                    n2 += __shfl_xor(n2, 16); n2 += __shfl_xor(n2, 32); kn2 = fmaxf(kn2, n2);
                }
                if (MODE != 1) store_rows128(stg, blk0 + (size_t)(ai * HALF + m * 16) * pitch, (size_t)pitch, wst[0], wst[1], fr, fq, lane); else asm volatile("" :: "v"(wst[0]), "v"(wst[1]));
            }
        if (KIND == K_ROPEK) {
            int ln; asm volatile("v_mbcnt_lo_u32_b32 %0, -1, 0\n\tv_mbcnt_hi_u32_b32 %0, -1, %0" : "=v"(ln));
#pragma unroll
            for (int o = 1; o < 16; o <<= 1) kn2 = fmaxf(kn2, __uint_as_float(__builtin_amdgcn_ds_bpermute((ln ^ o) << 2, __float_as_uint(kn2))));
            if (ln == 0) __hip_atomic_fetch_max(kmx + (row0 / SEQ) * 16 + (ccol >> 6), __float_as_uint(kn2), __ATOMIC_RELAXED, __HIP_MEMORY_SCOPE_AGENT);
        }
    }
};

template <bool FIRST, bool LAST> struct EpiOut {
    static constexpr bool PERM = true;
    const float* xin; float* xout; u16* xb; float* ssq;
    __device__ __forceinline__ void operator()(const f32x4 (&acc)[2][2][4][2], const Unit& u, int wr, int wc, int fr, int fq, PG8_LAS unsigned char* stg, int lane) const {
        int row0 = u.pm * BM + wr * 64 + fr; asm volatile("" : "+v"(row0));
        const int cb = u.pn * BM + wc * 64 + 8 * fq;
        f32x4 nx[2][2];
#define LOADX(dst, rw) do { _Pragma("unroll") for (int bj = 0; bj < 2; ++bj) { const size_t off = (size_t)(rw) * DM + cb + bj * 32; \
            if (FIRST) { dst[bj][0] = *(const f32x4*)(xin + off); dst[bj][1] = *(const f32x4*)(xin + off + 4); } \
            else { const u32x4 w = *(const u32x4*)(xb + off); dst[bj][0] = (f32x4){bf_lo(w.x), bf_hi(w.x), bf_lo(w.y), bf_hi(w.y)}; dst[bj][1] = (f32x4){bf_lo(w.z), bf_hi(w.z), bf_lo(w.w), bf_hi(w.w)}; } } } while (0)
        LOADX(nx, row0);
#pragma unroll
        for (int ai = 0; ai < 2; ++ai)
#pragma unroll
            for (int m = 0; m < 4; ++m) {
                const int row = row0 + ai * HALF + m * 16; float part = 0.f; u32x4 wst[2];
                f32x4 ox[2][2];
#pragma unroll
                for (int bj = 0; bj < 2; ++bj) { ox[bj][0] = nx[bj][0]; ox[bj][1] = nx[bj][1]; }
                if (ai * 4 + m < 7) { const int i2 = ai * 4 + m + 1; LOADX(nx, row0 + (i2 >> 2) * HALF + (i2 & 3) * 16); }
#pragma unroll
                for (int bj = 0; bj < 2; ++bj) {
                    const size_t off = (size_t)row * DM + cb + bj * 32;
                    const f32x4 n0 = ox[bj][0] + acc[ai][bj][m][0], n1 = ox[bj][1] + acc[ai][bj][m][1];
                    if (LAST) { *(f32x4*)(xout + off) = n0; *(f32x4*)(xout + off + 4) = n1; }
                    else {
                        u32x4 w; w.x = cvt_pk_bf16(n0[0], n0[1]); w.y = cvt_pk_bf16(n0[2], n0[3]); w.z = cvt_pk_bf16(n1[0], n1[1]); w.w = cvt_pk_bf16(n1[2], n1[3]);
                        wst[bj] = w;
                        const f32x4 r0 = (f32x4){bf_lo(w.x), bf_hi(w.x), bf_lo(w.y), bf_hi(w.y)}, r1 = (f32x4){bf_lo(w.z), bf_hi(w.z), bf_lo(w.w), bf_hi(w.w)};
                        part += (r0[0] * r0[0] + r0[1] * r0[1]) + (r0[2] * r0[2] + r0[3] * r0[3]) + (r1[0] * r1[0] + r1[1] * r1[1]) + (r1[2] * r1[2] + r1[3] * r1[3]);
                    }
                }
                if (!LAST) { part += __shfl_xor(part, 16); part += __shfl_xor(part, 32);
                    if (fq == 0) ssq[(size_t)row * 16 + u.pn * 4 + wc] = part;
                    store_rows128(stg, xb + (size_t)(row - fr) * DM + u.pn * BM + wc * 64, (size_t)DM, wst[0], wst[1], fr, fq, lane); }
            }
#undef LOADX
    }
};
struct EpiDry {
    static constexpr bool PERM = true;
    __device__ __forceinline__ void operator()(const f32x4 (&acc)[2][2][4][2], const Unit&, int, int, int, int, PG8_LAS unsigned char*, int) const {
#pragma unroll
        for (int a = 0; a < 2; ++a)
#pragma unroll
            for (int b = 0; b < 2; ++b)
#pragma unroll
                for (int m = 0; m < 4; ++m) asm volatile("" :: "v"(acc[a][b][m][0]), "v"(acc[a][b][m][1]));
    }
};
}
namespace att {
typedef unsigned short u16;
using bf16x8 = __attribute__((ext_vector_type(8))) short;
using s16x4  = __attribute__((ext_vector_type(4))) short;
using f32x16 = __attribute__((ext_vector_type(16))) float;
using f32x4  = __attribute__((ext_vector_type(4))) float;
using u32x4  = __attribute__((ext_vector_type(4))) unsigned;
#define KSWZ(row, colB) ((row) * 256 + ((colB) ^ (((row) & 7) << 4)))
#define KSWZ128(row, colB) ((row) * 128 + ((colB) ^ (((row) & 7) << 4)))
#define SBAR() __builtin_amdgcn_sched_barrier(0)
constexpr float THRL = 8.0f;
__device__ __forceinline__ int crow(int r, int hi) { return (r & 3) + 8 * (r >> 2) + 4 * hi; }
__device__ __forceinline__ unsigned cvtpk(float lo, float hi) { unsigned r; asm volatile("v_cvt_pk_bf16_f32 %0, %1, %2" : "=v"(r) : "v"(lo), "v"(hi)); return r; }
__device__ __forceinline__ bf16x8 ld8(const u16* p) { return *reinterpret_cast<const bf16x8*>(p); }
__device__ __forceinline__ float bf2f(unsigned short h) { return __uint_as_float((unsigned)h << 16); }

__device__ __forceinline__ void partialSM(f32x16& p0, f32x16& p1, float& m_reg, float& alpha) {
    float pmax = p0[0];
#pragma unroll
    for (int r = 1; r < 16; ++r) pmax = fmaxf(pmax, p0[r]);
#pragma unroll
    for (int r = 0; r < 16; ++r) pmax = fmaxf(pmax, p1[r]);
    { auto rr = __builtin_amdgcn_permlane32_swap(__float_as_uint(pmax), __float_as_uint(pmax), false, false);
      pmax = fmaxf(__uint_as_float(rr[0]), __uint_as_float(rr[1])); }
    float mn;
    if (__builtin_expect(__all(pmax - m_reg <= THRL), 1)) { mn = m_reg; alpha = 1.f; }
    else { mn = fmaxf(m_reg, pmax); alpha = __builtin_amdgcn_exp2f(m_reg - mn); m_reg = mn; }
#pragma unroll
    for (int r = 0; r < 16; ++r) { p0[r] -= mn; p1[r] -= mn; }
#pragma unroll
    for (int r = 0; r < 16; ++r) p0[r] = __builtin_amdgcn_exp2f(p0[r]);
}
__device__ __forceinline__ void finishSM(f32x16& p0, f32x16& p1, float alpha, float& l_reg, bf16x8& pa0, bf16x8& pa1, bf16x8& pa2, bf16x8& pa3) {
#pragma unroll
    for (int r = 0; r < 16; ++r) p1[r] = __builtin_amdgcn_exp2f(p1[r]);
    float ps = 0;
#pragma unroll
    for (int r = 0; r < 16; ++r) ps += p0[r];
#pragma unroll
    for (int r = 0; r < 16; ++r) ps += p1[r];
    { auto rr = __builtin_amdgcn_permlane32_swap(__float_as_uint(ps), __float_as_uint(ps), false, false);
      ps = __uint_as_float(rr[0]) + __uint_as_float(rr[1]); }
    l_reg = l_reg * alpha + ps;
#define PK4(P, BASE, OUT) do { unsigned a0 = cvtpk(P[BASE + 0], P[BASE + 1]), a1 = cvtpk(P[BASE + 2], P[BASE + 3]);   \
    unsigned b0 = cvtpk(P[BASE + 4], P[BASE + 5]), b1 = cvtpk(P[BASE + 6], P[BASE + 7]);                              \
    auto r0 = __builtin_amdgcn_permlane32_swap(a0, b0, false, false); auto r1 = __builtin_amdgcn_permlane32_swap(a1, b1, false, false); \
    u32x4 w = {r0[0], r1[0], r0[1], r1[1]}; OUT = *reinterpret_cast<bf16x8*>(&w); } while (0)
    PK4(p0, 0, pa0); PK4(p0, 8, pa1); PK4(p1, 0, pa2); PK4(p1, 8, pa3);
}
__device__ __forceinline__ void pack4(const f32x16& p0, const f32x16& p1, bf16x8& pa0, bf16x8& pa1, bf16x8& pa2, bf16x8& pa3) {
    PK4(p0, 0, pa0); PK4(p0, 8, pa1); PK4(p1, 0, pa2); PK4(p1, 8, pa3);
}
#undef PK4

template <int NCB> __device__ __forceinline__ int v_st(int k, int c) { const int kk = (k & ~0xC) | ((k & 4) << 1) | ((k & 8) >> 1); return ((kk >> 3) * NCB + (c >> 5)) * 512 + ((kk & 7) * 32 + (c & 31)) * 2; }
__device__ __forceinline__ int v_rd_base(int lane) { return ((lane & 3) << 3) | (((lane >> 2) & 3) << 6) | (((lane >> 4) & 1) << 5) | (((lane >> 5) & 1) << 8); }
template <int OFF> __device__ __forceinline__ s16x4 tr_read(int vb) { s16x4 r; asm volatile("ds_read_b64_tr_b16 %0, %1 offset:%2" : "=&v"(r) : "v"(vb), "i"(OFF) : "memory"); return r; }
#define PKF(L, H) (bf16x8){L[0], L[1], L[2], L[3], H[0], H[1], H[2], H[3]}
template <int NCB> __device__ __forceinline__ void pv_blk(f32x16& od, int vb, bf16x8 pa0, bf16x8 pa1, bf16x8 pa2, bf16x8 pa3) {
    constexpr int KS = NCB * 1024, HF = NCB * 512;
    const s16x4 l0 = tr_read<0 * KS>(vb), h0 = tr_read<0 * KS + HF>(vb), l1 = tr_read<1 * KS>(vb), h1 = tr_read<1 * KS + HF>(vb);
    const s16x4 l2 = tr_read<2 * KS>(vb), h2 = tr_read<2 * KS + HF>(vb), l3 = tr_read<3 * KS>(vb), h3 = tr_read<3 * KS + HF>(vb);
    asm volatile("s_waitcnt lgkmcnt(0)" ::: "memory"); SBAR();
    od = __builtin_amdgcn_mfma_f32_32x32x16_bf16(pa0, PKF(l0, h0), od, 0, 0, 0);
    od = __builtin_amdgcn_mfma_f32_32x32x16_bf16(pa1, PKF(l1, h1), od, 0, 0, 0);
    od = __builtin_amdgcn_mfma_f32_32x32x16_bf16(pa2, PKF(l2, h2), od, 0, 0, 0);
    od = __builtin_amdgcn_mfma_f32_32x32x16_bf16(pa3, PKF(l3, h3), od, 0, 0, 0);
}


template <int NCB> __device__ __forceinline__ int v_stn(int k, int c) { return ((k >> 3) * NCB + (c >> 5)) * 512 + ((k & 7) * 32 + (c & 31)) * 2; }
__device__ __forceinline__ float max3f(float a, float b, float c) { return fmaxf(fmaxf(a, b), c); }
__device__ __forceinline__ void fill16(f32x16& v, float x) {
#pragma unroll
    for (int r = 0; r < 16; ++r) v[r] = x;
}
template <bool FIRST>
__device__ __forceinline__ void partialSM_n(f32x16& p0, f32x16& p1, float& m_reg, f32x16& negm, float& alpha) {
    float a = max3f(p0[0], p0[1], p0[2]), b = max3f(p0[3], p0[4], p0[5]), c = max3f(p1[0], p1[1], p1[2]), d = max3f(p1[3], p1[4], p1[5]);
    a = max3f(a, p0[6], p0[7]); b = max3f(b, p0[8], p0[9]); c = max3f(c, p1[6], p1[7]); d = max3f(d, p1[8], p1[9]);
    a = max3f(a, p0[10], p0[11]); b = max3f(b, p0[12], p0[13]); c = max3f(c, p1[10], p1[11]); d = max3f(d, p1[12], p1[13]);
    a = max3f(a, p0[14], p0[15]); c = max3f(c, p1[14], p1[15]);
    float pmax = fmaxf(fmaxf(a, b), fmaxf(c, d));
    { auto rr = __builtin_amdgcn_permlane32_swap(__float_as_uint(pmax), __float_as_uint(pmax), false, false);
      pmax = fmaxf(__uint_as_float(rr[0]), __uint_as_float(rr[1])); }
    if (!FIRST && __builtin_expect(__all(pmax <= THRL), 1)) { alpha = 1.f; }
    else { const float dl = FIRST ? pmax : fmaxf(pmax, 0.f); m_reg += dl; alpha = FIRST ? 0.f : __builtin_amdgcn_exp2f(-dl);
#pragma unroll
        for (int r = 0; r < 16; ++r) { p0[r] -= dl; p1[r] -= dl; }
        fill16(negm, -m_reg); asm volatile("" : "+v"(negm)); }
#pragma unroll
    for (int r = 0; r < 16; ++r) p0[r] = __builtin_amdgcn_exp2f(p0[r]);
}
#define PKN(P, B) (u32x4){cvtpk(P[B + 0], P[B + 1]), cvtpk(P[B + 2], P[B + 3]), cvtpk(P[B + 4], P[B + 5]), cvtpk(P[B + 6], P[B + 7])}
template <bool SUM>
__device__ __forceinline__ void finishSM_n(f32x16& p0, f32x16& p1, float alpha, float& l_reg, bf16x8& pa0, bf16x8& pa1, bf16x8& pa2, bf16x8& pa3) {
#pragma unroll
    for (int r = 0; r < 16; ++r) p1[r] = __builtin_amdgcn_exp2f(p1[r]);
    if (SUM) {
        float s0 = (p0[0] + p0[1]) + (p0[2] + p0[3]), s1 = (p0[4] + p0[5]) + (p0[6] + p0[7]), s2 = (p0[8] + p0[9]) + (p0[10] + p0[11]), s3 = (p0[12] + p0[13]) + (p0[14] + p0[15]);
        float t0 = (p1[0] + p1[1]) + (p1[2] + p1[3]), t1 = (p1[4] + p1[5]) + (p1[6] + p1[7]), t2 = (p1[8] + p1[9]) + (p1[10] + p1[11]), t3 = (p1[12] + p1[13]) + (p1[14] + p1[15]);
        float ps = ((s0 + s1) + (s2 + s3)) + ((t0 + t1) + (t2 + t3));
        { auto rr = __builtin_amdgcn_permlane32_swap(__float_as_uint(ps), __float_as_uint(ps), false, false);
          ps = __uint_as_float(rr[0]) + __uint_as_float(rr[1]); }
        l_reg = l_reg * alpha + ps;
    }
    { u32x4 w = PKN(p0, 0); pa0 = *reinterpret_cast<bf16x8*>(&w); } { u32x4 w = PKN(p0, 8); pa1 = *reinterpret_cast<bf16x8*>(&w); }
    { u32x4 w = PKN(p1, 0); pa2 = *reinterpret_cast<bf16x8*>(&w); } { u32x4 w = PKN(p1, 8); pa3 = *reinterpret_cast<bf16x8*>(&w); }
}

__device__ __forceinline__ void qkt_da(f32x16& p0, f32x16& p1, const char* Ks, const bf16x8* qr, const f32x16& negm, int r32, int hi, int cb0) {
#pragma unroll
    for (int d0 = 0; d0 < 4; ++d0) { const int cb = cb0 + (d0 * 16 + hi * 8) * 2;
        const bf16x8 b0 = *reinterpret_cast<const bf16x8*>(Ks + KSWZ(r32, cb));
        const bf16x8 b1 = *reinterpret_cast<const bf16x8*>(Ks + KSWZ(32 + r32, cb));
        if (d0 == 0) { p0 = __builtin_amdgcn_mfma_f32_32x32x16_bf16(b0, qr[0], negm, 0, 0, 0); p1 = __builtin_amdgcn_mfma_f32_32x32x16_bf16(b1, qr[0], negm, 0, 0, 0); }
        else { p0 = __builtin_amdgcn_mfma_f32_32x32x16_bf16(b0, qr[d0], p0, 0, 0, 0); p1 = __builtin_amdgcn_mfma_f32_32x32x16_bf16(b1, qr[d0], p1, 0, 0, 0); } }
}
typedef short v4i16_t __attribute__((ext_vector_type(4)));
__device__ __forceinline__ s16x4 vtr(int addr) { return __builtin_bit_cast(s16x4, __builtin_amdgcn_ds_read_tr16_b64_v4i16((__attribute__((address_space(3))) v4i16_t*)(unsigned)addr)); }
__device__ __forceinline__ void pv_da(f32x16* o, int vb, bf16x8 pa0, bf16x8 pa1, bf16x8 pa2, bf16x8 pa3) {
    s16x4 lo[4], hi[4];
#define VADDR(i) (vb + ((i) & 3) * 512 + ((i) >> 2) * 4096)
#pragma unroll
    for (int i = 0; i < 4; ++i) { lo[i] = vtr(VADDR(i)); hi[i] = vtr(VADDR(i) + 2048); }
#pragma unroll
    for (int i = 0; i < 16; ++i) {
        const bf16x8 vf = PKF(lo[i & 3], hi[i & 3]);
        const bf16x8 pa = ((i >> 2) == 0) ? pa0 : ((i >> 2) == 1) ? pa1 : ((i >> 2) == 2) ? pa2 : pa3;
        o[i & 3] = __builtin_amdgcn_mfma_f32_32x32x16_bf16(pa, vf, o[i & 3], 0, 0, 0);
        if (i + 4 < 16) { lo[i & 3] = vtr(VADDR(i + 4)); hi[i & 3] = vtr(VADDR(i + 4) + 2048); }
    }
#undef VADDR
    __builtin_amdgcn_sched_group_barrier(0x100, 8, 0);
#pragma unroll
    for (int i = 0; i < 12; ++i) { __builtin_amdgcn_sched_group_barrier(0x008, 1, 0); __builtin_amdgcn_sched_group_barrier(0x100, 2, 0); __builtin_amdgcn_sched_group_barrier(0x002, 4, 0); }
#pragma unroll
    for (int i = 0; i < 4; ++i) { __builtin_amdgcn_sched_group_barrier(0x008, 1, 0); __builtin_amdgcn_sched_group_barrier(0x002, 4, 0); }
}
#define DA_PIN(x) asm volatile("" : "+v"(x))
#define DA_MFMA(a, b, c) __builtin_amdgcn_mfma_f32_32x32x16_bf16(a, b, c, 0, 0, 0)
#define DA_WAIT_BAR(N) asm volatile("s_waitcnt vmcnt(" #N ") lgkmcnt(0)\n\ts_barrier" ::: "memory")
__device__ __forceinline__ void glds16(const void* g, unsigned lds_base) {
    unsigned sv; asm volatile("s_mov_b32 %0, m0\n\ts_mov_b32 m0, %2\n\ts_nop 0\n\tglobal_load_lds_dwordx4 %1, off\n\ts_mov_b32 m0, %0" : "=&s"(sv) : "v"(g), "s"(lds_base) : "memory"); }
__device__ __forceinline__ bf16x8 kld(int addr) { return *(const __attribute__((address_space(3))) bf16x8*)(unsigned)addr; }
__device__ __forceinline__ float rowmax32(const f32x16& p0, const f32x16& p1) {
    float a = max3f(p0[0], p0[1], p0[2]), b = max3f(p0[3], p0[4], p0[5]), c = max3f(p1[0], p1[1], p1[2]), d = max3f(p1[3], p1[4], p1[5]);
    a = max3f(a, p0[6], p0[7]); b = max3f(b, p0[8], p0[9]); c = max3f(c, p1[6], p1[7]); d = max3f(d, p1[8], p1[9]);
    a = max3f(a, p0[10], p0[11]); b = max3f(b, p0[12], p0[13]); c = max3f(c, p1[10], p1[11]); d = max3f(d, p1[12], p1[13]);
    a = max3f(a, p0[14], p0[15]); c = max3f(c, p1[14], p1[15]);
    const float pmax = fmaxf(fmaxf(a, b), fmaxf(c, d));
    auto rr = __builtin_amdgcn_permlane32_swap(__float_as_uint(pmax), __float_as_uint(pmax), false, false);
    return fmaxf(__uint_as_float(rr[0]), __uint_as_float(rr[1]));
}
constexpr int DA_KSL = 16384, DA_VRING = 49152, DA_WS = 133120, DA_STG = 65536, DA_STG_LD = 132;
template <bool DRY, int PVAR = 0>
__device__ __forceinline__ void diff_attn_unit(int b, int h, int qb, const u16* Qa, const u16* __restrict__ Ka, const u16* __restrict__ Va, const u16* __restrict__ Ga,
                                               u16* Y, const float* __restrict__ subw, float lam, float one_m_li, const unsigned* __restrict__ kmx, char* lds) {
    int tid = threadIdx.x; asm volatile("" : "+v"(tid)); const int lane = tid & 63, r32 = lane & 31, hi = lane >> 5; const int wid = __builtin_amdgcn_readfirstlane(tid >> 6);
    const int map = wid >> 2, wq = wid & 3;
    const long rowbase = (long)b * SEQ; const int q0 = qb * 128;
    float* wsf = (float*)(lds + DA_WS) + wid * 64; float* li_l = wsf; float* al_l = wsf + 32;
    float m_reg = 0.f, l_reg = 0; f32x16 o[4] = {}; bf16x8 qr[4]; f32x16 negm = f32x16{}; asm volatile("" : "+v"(negm));
    const unsigned lds0 = (unsigned)(uintptr_t)lds;
    const u16* Kh = Ka + rowbase * DM + h * 128; const u16* Vh = Va + rowbase * DM + h * 128;
    const int cb0 = map * 128;
    unsigned kofs[2], vofs[2];
#pragma unroll
    for (int i = 0; i < 2; ++i) { const int pk = 2 * wid + i;
        const int row = 4 * pk + (lane >> 4), cp = lane & 15; kofs[i] = (unsigned)(row * DM + ((cp ^ (row & 7)) * 8)) * 2u;
        const int st = 2 * pk + (lane >> 5), kk = 8 * (st >> 2) + ((lane & 31) >> 2), cc = 32 * (st & 3) + 8 * (lane & 3); vofs[i] = (unsigned)(kk * DM + cc) * 2u; }
    const char* Kg = (const char*)Kh; const char* Vg = (const char*)Vh;
#define DMA_K(t, slot) do { _Pragma("unroll") for (int i_ = 0; i_ < 2; ++i_) glds16(Kg + (size_t)(t) * (64 * DM * 2) + kofs[i_], (unsigned)__builtin_amdgcn_readfirstlane(lds0 + (slot) + (2 * wid + i_) * 1024)); } while (0)
#define DMA_V(t, slot) do { _Pragma("unroll") for (int i_ = 0; i_ < 2; ++i_) glds16(Vg + (size_t)(t) * (64 * DM * 2) + vofs[i_], (unsigned)__builtin_amdgcn_readfirstlane(lds0 + DA_VRING + (slot) + (2 * wid + i_) * 1024)); } while (0)
    DMA_K(0, 0); DMA_V(0, 0); DMA_K(1, DA_KSL);
    const u16* Qw = Qa + (rowbase + q0 + wq * 32 + r32) * DM + h * 128 + map * 64 + hi * 8;
#pragma unroll
    for (int d0 = 0; d0 < 4; ++d0) qr[d0] = ld8(Qw + d0 * 16);
    DMA_K(2, 2 * DA_KSL);
    int ka[4];
#pragma unroll
    for (int d0 = 0; d0 < 4; ++d0) ka[d0] = (int)lds0 + KSWZ(r32, cb0 + (d0 * 16 + hi * 8) * 2);
    const int vb0 = (int)lds0 + DA_VRING + v_rd_base(lane);
    constexpr int NT = SEQ / 64;
    f32x16 pA0, pA1, pB0, pB1; bf16x8 kf[8]; s16x4 vlo[4], vhi[4]; u32x4 pw0, pw1, pw2, pw3; bool resc = false;
    int sl_prev = 0, sl_cur = 0, sl_next = DA_KSL;
#define ROT() do { sl_prev = sl_cur; sl_cur = sl_next; sl_next = (sl_next == 2 * DA_KSL) ? 0 : sl_next + DA_KSL; } while (0)
#define RESC() do { if (resc) { _Pragma("unroll") for (int d_ = 0; d_ < 4; ++d_) _Pragma("unroll") for (int r = 0; r < 16; ++r) o[d_][r] *= al_l[crow(r, hi)]; } } while (0)
#define KLOAD(slot) do { _Pragma("unroll") for (int d0 = 0; d0 < 4; ++d0) { kf[2 * d0] = kld(ka[d0] + (slot)); kf[2 * d0 + 1] = kld(ka[d0] + (slot) + 8192); } } while (0)
    float mb;
    { float q2 = 0.f;
#pragma unroll
      for (int d0 = 0; d0 < 4; ++d0)
#pragma unroll
          for (int e = 0; e < 8; ++e) { const float qv = bf2f((u16)qr[d0][e]); q2 += qv * qv; }
      { auto rr = __builtin_amdgcn_permlane32_swap(__float_as_uint(q2), __float_as_uint(q2), false, false); q2 = __uint_as_float(rr[0]) + __uint_as_float(rr[1]); }
      mb = __builtin_sqrtf(q2 * __uint_as_float(kmx[b * 16 + h * 2 + map])) * 1.0001f; }
    const bool fast = !__any(!(mb <= 60.0f));
    if (fast) { m_reg = mb; fill16(negm, -mb); asm volatile("" : "+v"(negm)); }
    DA_WAIT_BAR(6);
    KLOAD(0);
    pA0 = DA_MFMA(kf[0], qr[0], negm); pA1 = DA_MFMA(kf[1], qr[0], negm); pA0 = DA_MFMA(kf[2], qr[1], pA0); pA1 = DA_MFMA(kf[3], qr[1], pA1);
    pA0 = DA_MFMA(kf[4], qr[2], pA0); pA1 = DA_MFMA(kf[5], qr[2], pA1); pA0 = DA_MFMA(kf[6], qr[3], pA0); pA1 = DA_MFMA(kf[7], qr[3], pA1);
    if (fast) {
#pragma unroll
      for (int r = 0; r < 16; ++r) { pA0[r] = __builtin_amdgcn_exp2f(pA0[r]); pA1[r] = __builtin_amdgcn_exp2f(pA1[r]); }
    } else { const float rm = rowmax32(pA0, pA1); m_reg = rm;
#pragma unroll
      for (int r = 0; r < 16; ++r) { pA0[r] = __builtin_amdgcn_exp2f(pA0[r] - rm); pA1[r] = __builtin_amdgcn_exp2f(pA1[r] - rm); }
      fill16(negm, -m_reg); asm volatile("" : "+v"(negm)); }
    DA_WAIT_BAR(0);
    DMA_K(3, 0); DMA_V(1, DA_KSL); ROT();
    KLOAD(sl_cur);
    DA_WAIT_BAR(4);
#define PKW(P, i) cvtpk(P[i], P[(i) + 1])
#define PAF(w) __builtin_bit_cast(bf16x8, w)
#define VOFF(i) ((((i) & 3) * 512) + (((i) >> 2) * 4096))
#define VRD(s, i) do { vlo[s] = vtr(vp_ + VOFF(i)); vhi[s] = vtr(vp_ + VOFF(i) + 2048); } while (0)
#define VFR(s) PKF(vlo[s], vhi[s])
#define KRD(G, d0) do { if (G) { kf[2 * (d0)] = kld(ka[d0] + sl_next); kf[2 * (d0) + 1] = kld(ka[d0] + sl_next + 8192); SBAR(); } } while (0)
#define GAPA(CT, MF, a0, a1, a2, a3, W0, W1, PW) do { MF; DA_PIN(CT); sacc += a0; sacc += a1; sacc += a2; sacc += a3; W0; W1; DA_PIN(PW); DA_PIN(sacc); SBAR(); } while (0)
#define GAPB(MF, X, i, VR) do { MF; VR; X[i] = __builtin_amdgcn_exp2f(X[i]); X[(i) + 1] = __builtin_amdgcn_exp2f(X[(i) + 1]); DA_PIN(X); SBAR(); } while (0)
#define STEP(C0, C1, P0, P1, t, GK, GV, GL) do { SBAR(); \
    const int vp_ = vb0 + sl_prev; \
    float sacc = P0[0] + P0[1]; \
    GAPA(C0, C0 = DA_MFMA(kf[0], qr[0], negm), P0[2], P0[3], P0[4], P0[5],     pw0[0] = PKW(P0, 0),  pw0[1] = PKW(P0, 2),  pw0); \
    GAPA(C1, C1 = DA_MFMA(kf[1], qr[0], negm), P0[6], P0[7], P0[8], P0[9],     pw0[2] = PKW(P0, 4),  pw0[3] = PKW(P0, 6),  pw0); \
    GAPA(C0, C0 = DA_MFMA(kf[2], qr[1], C0),   P0[10], P0[11], P0[12], P0[13], pw1[0] = PKW(P0, 8),  pw1[1] = PKW(P0, 10), pw1); \
    GAPA(C1, C1 = DA_MFMA(kf[3], qr[1], C1),   P0[14], P0[15], P1[0], P1[1],   pw1[2] = PKW(P0, 12), pw1[3] = PKW(P0, 14), pw1); \
    VRD(0, 0); SBAR(); GAPA(C0, C0 = DA_MFMA(kf[4], qr[2], C0), P1[2], P1[3], P1[4], P1[5],     pw2[0] = PKW(P1, 0),  pw2[1] = PKW(P1, 2),  pw2); \
    VRD(1, 1); SBAR(); GAPA(C1, C1 = DA_MFMA(kf[5], qr[2], C1), P1[6], P1[7], P1[8], P1[9],     pw2[2] = PKW(P1, 4),  pw2[3] = PKW(P1, 6),  pw2); \
    VRD(2, 2); SBAR(); GAPA(C0, C0 = DA_MFMA(kf[6], qr[3], C0), P1[10], P1[11], P1[12], P1[13], pw3[0] = PKW(P1, 8),  pw3[1] = PKW(P1, 10), pw3); \
    VRD(3, 3); SBAR(); GAPA(C1, C1 = DA_MFMA(kf[7], qr[3], C1), P1[14], P1[15], 0.f, 0.f,       pw3[2] = PKW(P1, 12), pw3[3] = PKW(P1, 14), pw3); \
    l_reg += sacc; \
    if (GK) DMA_K((t) + 3, sl_cur); if (GV) DMA_V((t) + 1, sl_next);                            \
    resc = false; \
    if (__builtin_expect(!fast, 0)) { const float rm = rowmax32(C0, C1);                        \
      if (__builtin_expect(__any(rm > THRL), 0)) { const float dl = fmaxf(rm, 0.f); m_reg += dl;    \
          const float f_ = __builtin_amdgcn_exp2f(-dl); l_reg *= f_; if (hi == 0) al_l[r32] = f_; resc = true; \
          _Pragma("unroll") for (int r = 0; r < 16; ++r) { C0[r] -= dl; C1[r] -= dl; } \
          fill16(negm, -m_reg); asm volatile("" : "+v"(negm)); } } \
    SBAR(); \
    GAPB(o[0] = DA_MFMA(PAF(pw0), VFR(0), o[0]), C0, 0, VRD(0, 4));  GAPB(o[1] = DA_MFMA(PAF(pw0), VFR(1), o[1]), C0, 2, VRD(1, 5)); \
    KRD(GL, 0); GAPB(o[2] = DA_MFMA(PAF(pw0), VFR(2), o[2]), C0, 4, VRD(2, 6));  KRD(GL, 1); GAPB(o[3] = DA_MFMA(PAF(pw0), VFR(3), o[3]), C0, 6, VRD(3, 7)); \
    KRD(GL, 2); GAPB(o[0] = DA_MFMA(PAF(pw1), VFR(0), o[0]), C0, 8, VRD(0, 8));  KRD(GL, 3); GAPB(o[1] = DA_MFMA(PAF(pw1), VFR(1), o[1]), C0, 10, VRD(1, 9)); \
    GAPB(o[2] = DA_MFMA(PAF(pw1), VFR(2), o[2]), C0, 12, VRD(2, 10)); GAPB(o[3] = DA_MFMA(PAF(pw1), VFR(3), o[3]), C0, 14, VRD(3, 11)); \
    GAPB(o[0] = DA_MFMA(PAF(pw2), VFR(0), o[0]), C1, 0, VRD(0, 12));  GAPB(o[1] = DA_MFMA(PAF(pw2), VFR(1), o[1]), C1, 2, VRD(1, 13)); \
    GAPB(o[2] = DA_MFMA(PAF(pw2), VFR(2), o[2]), C1, 4, VRD(2, 14));  GAPB(o[3] = DA_MFMA(PAF(pw2), VFR(3), o[3]), C1, 6, VRD(3, 15)); \
    GAPB(o[0] = DA_MFMA(PAF(pw3), VFR(0), o[0]), C1, 8, (void)0);     GAPB(o[1] = DA_MFMA(PAF(pw3), VFR(1), o[1]), C1, 10, (void)0); \
    GAPB(o[2] = DA_MFMA(PAF(pw3), VFR(2), o[2]), C1, 12, (void)0);    GAPB(o[3] = DA_MFMA(PAF(pw3), VFR(3), o[3]), C1, 14, (void)0); \
    } while (0)
    int t = 1;
    for (; t + 5 < NT; t += 2) {
        STEP(pB0, pB1, pA0, pA1, t, true, true, true);     DA_WAIT_BAR(4); RESC(); ROT();
        STEP(pA0, pA1, pB0, pB1, t + 1, true, true, true); DA_WAIT_BAR(4); RESC(); ROT();
    }
#define ENDW(tt) do { if ((tt) + 3 < NT) { DA_WAIT_BAR(4); } else if ((tt) + 2 < NT) { DA_WAIT_BAR(2); } else { DA_WAIT_BAR(0); } } while (0)
    for (; t + 1 < NT; t += 2) {
        STEP(pB0, pB1, pA0, pA1, t, (t + 3 < NT), (t + 1 < NT), (t + 1 < NT));         ENDW(t);     RESC(); ROT();
        STEP(pA0, pA1, pB0, pB1, t + 1, (t + 4 < NT), (t + 2 < NT), (t + 2 < NT));     ENDW(t + 1); RESC(); ROT();
    }
    STEP(pB0, pB1, pA0, pA1, NT - 1, false, false, false); RESC();
    { float sacc = pB0[0] + pB0[1];
#pragma unroll
      for (int r = 2; r < 16; ++r) sacc += pB0[r];
#pragma unroll
      for (int r = 0; r < 16; ++r) sacc += pB1[r];
      l_reg += sacc;
      pw0 = (u32x4){PKW(pB0, 0), PKW(pB0, 2), PKW(pB0, 4), PKW(pB0, 6)}; pw1 = (u32x4){PKW(pB0, 8), PKW(pB0, 10), PKW(pB0, 12), PKW(pB0, 14)};
      pw2 = (u32x4){PKW(pB1, 0), PKW(pB1, 2), PKW(pB1, 4), PKW(pB1, 6)}; pw3 = (u32x4){PKW(pB1, 8), PKW(pB1, 10), PKW(pB1, 12), PKW(pB1, 14)};
      pv_da(o, vb0 + sl_cur, PAF(pw0), PAF(pw1), PAF(pw2), PAF(pw3)); }
    { auto rr = __builtin_amdgcn_permlane32_swap(__float_as_uint(l_reg), __float_as_uint(l_reg), false, false); l_reg = __uint_as_float(rr[0]) + __uint_as_float(rr[1]); }
#undef DMA_K
#undef DMA_V
#undef ROT
#undef RESC
#undef KLOAD
#undef PKW
#undef PAF
#undef VOFF
#undef VRD
#undef VFR
#undef KRD
#undef GAPA
#undef GAPB
#undef STEP
#undef ENDW
    if (hi == 0) li_l[r32] = l_reg; asm volatile("s_waitcnt lgkmcnt(0)" ::: "memory");
    float rli[16];
#pragma unroll
    for (int r = 0; r < 16; ++r) rli[r] = __builtin_amdgcn_rcpf(li_l[crow(r, hi)]) * (map ? lam : 1.0f);
    __syncthreads();
    float* xch = (float*)lds;
    if (map == 1) {
#pragma unroll
        for (int d0 = 0; d0 < 4; ++d0)
#pragma unroll
            for (int r = 0; r < 16; ++r) xch[((wq * 4 + d0) * 16 + r) * 64 + lane] = o[d0][r] * rli[r];
    }
    __syncthreads();
    float* stg = (float*)(lds + DA_STG);
    if (map == 0) {
#pragma unroll
        for (int d0 = 0; d0 < 4; ++d0)
#pragma unroll
            for (int r = 0; r < 16; ++r) { const float dv = o[d0][r] * rli[r] - xch[((wq * 4 + d0) * 16 + r) * 64 + lane];
                stg[(wq * 32 + crow(r, hi)) * DA_STG_LD + d0 * 32 + r32] = dv; }
    }
    __syncthreads();
    {
        const int row = tid >> 2, qt = tid & 3; const float* sp = stg + row * DA_STG_LD + qt * 32;
        f32x4 dv[8]; float ss = 0.f;
#pragma unroll
        for (int g = 0; g < 8; ++g) { dv[g] = *(const f32x4*)(sp + g * 4); ss += (dv[g][0] * dv[g][0] + dv[g][1] * dv[g][1]) + (dv[g][2] * dv[g][2] + dv[g][3] * dv[g][3]); }
        ss += __shfl_xor(ss, 1); ss += __shfl_xor(ss, 2);
        const float sc2 = __builtin_amdgcn_rsqf(ss * (1.0f / 128.0f) + EPS) * one_m_li;
        const size_t goff = (size_t)(rowbase + q0 + row) * DM + h * 128 + qt * 32;
#pragma unroll
        for (int g = 0; g < 4; ++g) {
            const bf16x8 gt = ld8(Ga + goff + g * 8);
            const f32x4 w0 = *(const f32x4*)(subw + qt * 32 + g * 8), w1 = *(const f32x4*)(subw + qt * 32 + g * 8 + 4);
            const f32x4 a = dv[2 * g], c = dv[2 * g + 1];
            u32x4 w;
            w.x = cvtpk(a[0] * sc2 * w0[0] * bf2f((u16)gt[0]), a[1] * sc2 * w0[1] * bf2f((u16)gt[1]));
            w.y = cvtpk(a[2] * sc2 * w0[2] * bf2f((u16)gt[2]), a[3] * sc2 * w0[3] * bf2f((u16)gt[3]));
            w.z = cvtpk(c[0] * sc2 * w1[0] * bf2f((u16)gt[4]), c[1] * sc2 * w1[1] * bf2f((u16)gt[5]));
            w.w = cvtpk(c[2] * sc2 * w1[2] * bf2f((u16)gt[6]), c[3] * sc2 * w1[3] * bf2f((u16)gt[7]));
            if (!DRY) *(u32x4*)(Y + goff + g * 8) = w; else asm volatile("" :: "v"(w));
        }
    }
    __syncthreads();
}

constexpr int SWB_K = 0, SWB_V = 49152, SWB_WS = 98304, SWB_STG = 100352, SWB_STG_LD = 36;
__device__ __forceinline__ void swa_block_geom(int qb, int& t_lo, int& t_hi) { const int q0 = qb * 128; t_lo = (q0 >= 128 ? q0 - 128 : 0) >> 6; t_hi = (q0 + 255 < SEQ ? q0 + 255 : SEQ - 1) >> 6; }
template <int N> struct SwaRegs { bf16x8 k[N], v[N]; };
template <int N> __device__ __forceinline__ void swa_tiles_load(SwaRegs<N>& R, int b, int kvh, int t0, int nt, const u16* __restrict__ Kb, const u16* __restrict__ Vb, int tid) {
    const int sr = tid >> 3, sc = (tid & 7) * 8; const long rowbase = (long)b * SEQ;
    const u16* Kh = Kb + (rowbase + t0 * 64 + sr) * 256 + kvh * 64 + sc; const u16* Vh = Vb + (rowbase + t0 * 64 + sr) * 256 + kvh * 64 + sc;
#pragma unroll
    for (int tt = 0; tt < N; ++tt) if (tt < nt) { R.k[tt] = ld8(Kh + (long)tt * 64 * 256); R.v[tt] = ld8(Vh + (long)tt * 64 * 256); }
}
template <int N> __device__ __forceinline__ void swa_tiles_store_lds(const SwaRegs<N>& R, int t0, int nt, char* lds, int tid) {
    const int sr = tid >> 3, sc = (tid & 7) * 8, vst0 = v_stn<2>(sr, sc), kst0 = KSWZ128(sr, sc * 2);
#pragma unroll
    for (int tt = 0; tt < N; ++tt) if (tt < nt) { const int sl = (t0 + tt) % 6; *(bf16x8*)(lds + SWB_K + sl * 8192 + kst0) = R.k[tt]; *(bf16x8*)(lds + SWB_V + sl * 8192 + vst0) = R.v[tt]; }
}
template <bool DRY>
__device__ __forceinline__ void swa_block_compute(int b, int kvh, int qb, const u16* Q, const u16* __restrict__ Gt, u16* Y, const float* __restrict__ sink, char* lds, int tid) {
    const int lane = tid & 63, r32 = lane & 31, hi = lane >> 5; const int wid = __builtin_amdgcn_readfirstlane(tid >> 6);
    const int hq = kvh * 8 + wid; const long rowbase = (long)b * SEQ; const int q0 = qb * 128;
    int t_lo, t_hib; swa_block_geom(qb, t_lo, t_hib); (void)t_hib;
    float* wsf = (float*)(lds + SWB_WS) + wid * 64; float* al_l = wsf + 32;
    float* stg = (float*)(lds + SWB_STG) + wid * (32 * SWB_STG_LD);
    const int vb0 = (int)(uintptr_t)(lds + SWB_V) + v_rd_base(lane);
    const float sink2 = sink[hq] * LOG2E;
    bf16x8 qn[4];
    { const u16* Qw = Q + (rowbase + q0 + r32) * DIN + hq * 64 + hi * 8;
#pragma unroll
      for (int d0 = 0; d0 < 4; ++d0) qn[d0] = ld8(Qw + d0 * 16); }
#pragma unroll 1
    for (int sub = 0; sub < 4; ++sub) {
        const int qs = q0 + 32 * sub;
        bf16x8 qr[4];
#pragma unroll
        for (int d0 = 0; d0 < 4; ++d0) qr[d0] = qn[d0];
        if (sub < 3) { const u16* Qw = Q + (rowbase + qs + 32 + r32) * DIN + hq * 64 + hi * 8;
#pragma unroll
            for (int d0 = 0; d0 < 4; ++d0) qn[d0] = ld8(Qw + d0 * 16); }
        const int ta = ((qs >= 128 ? qs - 128 : 0) >> 6) - t_lo, tb = ((qs + 159 < SEQ ? qs + 159 : SEQ - 1) >> 6) - t_lo;
        float m_reg = sink2, l_dummy = 0.f; f32x16 o[2] = {}; f32x16 lacc, negm; fill16(lacc, 1.0f); fill16(negm, -sink2);
        const bf16x8 ones = {0x3F80, 0x3F80, 0x3F80, 0x3F80, 0x3F80, 0x3F80, 0x3F80, 0x3F80};
        bf16x8 gpre[2][2];
        { const size_t gb = (size_t)(rowbase + qs + (lane >> 1)) * DIN + hq * 64 + (lane & 1) * 16;
#pragma unroll
          for (int cbk = 0; cbk < 2; ++cbk) { gpre[cbk][0] = ld8(Gt + gb + cbk * 32); gpre[cbk][1] = ld8(Gt + gb + cbk * 32 + 8); } }
        for (int tt = ta; tt <= tb; ++tt) {
            const int k0 = (t_lo + tt) * 64, sl = (t_lo + tt) % 6;
            f32x16 p0, p1;
            const char* Ks = lds + SWB_K + sl * 8192;
#pragma unroll
            for (int d0 = 0; d0 < 4; ++d0) { const int cb = (d0 * 16 + hi * 8) * 2;
                const bf16x8 b0 = *reinterpret_cast<const bf16x8*>(Ks + KSWZ128(r32, cb));
                const bf16x8 b1 = *reinterpret_cast<const bf16x8*>(Ks + KSWZ128(32 + r32, cb));
                if (d0 == 0) { p0 = __builtin_amdgcn_mfma_f32_32x32x16_bf16(b0, qr[0], negm, 0, 0, 0); p1 = __builtin_amdgcn_mfma_f32_32x32x16_bf16(b1, qr[0], negm, 0, 0, 0); }
                else { p0 = __builtin_amdgcn_mfma_f32_32x32x16_bf16(b0, qr[d0], p0, 0, 0, 0); p1 = __builtin_amdgcn_mfma_f32_32x32x16_bf16(b1, qr[d0], p1, 0, 0, 0); } }
            if (k0 < qs - 97 || k0 + 63 > qs + 128) {
                const int base = k0 - qs - r32 + 4 * hi + 128;
#pragma unroll
                for (int r = 0; r < 16; ++r) { const int c = (r & 3) + 8 * (r >> 2); if ((unsigned)(base + c) > 256u) p0[r] = -1e30f; if ((unsigned)(base + c + 32) > 256u) p1[r] = -1e30f; }
            }
            float alpha; bf16x8 pa0, pa1, pa2, pa3;
            partialSM_n<false>(p0, p1, m_reg, negm, alpha);
            if (__any(alpha < 1.f)) { if (hi == 0) al_l[r32] = alpha; asm volatile("s_waitcnt lgkmcnt(0)" ::: "memory");
#pragma unroll
                for (int r = 0; r < 16; ++r) { const float al = al_l[crow(r, hi)]; o[0][r] *= al; o[1][r] *= al; lacc[r] *= al; } }
            finishSM_n<false>(p0, p1, alpha, l_dummy, pa0, pa1, pa2, pa3);
            {
                const int vbt = vb0 + sl * 8192; s16x4 lo[4], hi4[4];
#define VADDR2(i) (vbt + ((i) & 1) * 512 + ((i) >> 1) * 2048)
#pragma unroll
                for (int i = 0; i < 4; ++i) { lo[i] = vtr(VADDR2(i)); hi4[i] = vtr(VADDR2(i) + 1024); }
#pragma unroll
                for (int i = 0; i < 8; ++i) {
                    const bf16x8 vf = PKF(lo[i & 3], hi4[i & 3]);
                    const bf16x8 pa = ((i >> 1) == 0) ? pa0 : ((i >> 1) == 1) ? pa1 : ((i >> 1) == 2) ? pa2 : pa3;
                    o[i & 1] = __builtin_amdgcn_mfma_f32_32x32x16_bf16(pa, vf, o[i & 1], 0, 0, 0);
                    if ((i & 1) == 1) lacc = __builtin_amdgcn_mfma_f32_32x32x16_bf16(pa, ones, lacc, 0, 0, 0);
                    if (i + 4 < 8) { lo[i & 3] = vtr(VADDR2(i + 4)); hi4[i & 3] = vtr(VADDR2(i + 4) + 1024); }
                }
#undef VADDR2
            }
        }
        float rl[16];
#pragma unroll
        for (int r = 0; r < 16; ++r) rl[r] = __builtin_amdgcn_rcpf(lacc[r]);
#pragma unroll
        for (int cbk = 0; cbk < 2; ++cbk) {
#pragma unroll
            for (int r = 0; r < 16; ++r) stg[crow(r, hi) * SWB_STG_LD + r32] = o[cbk][r] * rl[r];
            asm volatile("s_waitcnt lgkmcnt(0)" ::: "memory");
            const int row = lane >> 1, hf = lane & 1; const float* sp = stg + row * SWB_STG_LD + hf * 16;
            const f32x4 a0 = *(const f32x4*)(sp), a1 = *(const f32x4*)(sp + 4), a2 = *(const f32x4*)(sp + 8), a3 = *(const f32x4*)(sp + 12);
            const size_t goff = (size_t)(rowbase + qs + row) * DIN + hq * 64 + cbk * 32 + hf * 16;
            const bf16x8 g0 = gpre[cbk][0], g1 = gpre[cbk][1];
            u32x4 w0, w1;
            w0.x = cvtpk(a0[0] * bf2f((u16)g0[0]), a0[1] * bf2f((u16)g0[1])); w0.y = cvtpk(a0[2] * bf2f((u16)g0[2]), a0[3] * bf2f((u16)g0[3]));
            w0.z = cvtpk(a1[0] * bf2f((u16)g0[4]), a1[1] * bf2f((u16)g0[5])); w0.w = cvtpk(a1[2] * bf2f((u16)g0[6]), a1[3] * bf2f((u16)g0[7]));
            w1.x = cvtpk(a2[0] * bf2f((u16)g1[0]), a2[1] * bf2f((u16)g1[1])); w1.y = cvtpk(a2[2] * bf2f((u16)g1[2]), a2[3] * bf2f((u16)g1[3]));
            w1.z = cvtpk(a3[0] * bf2f((u16)g1[4]), a3[1] * bf2f((u16)g1[5])); w1.w = cvtpk(a3[2] * bf2f((u16)g1[6]), a3[3] * bf2f((u16)g1[7]));
            if (!DRY) { *(u32x4*)(Y + goff) = w0; *(u32x4*)(Y + goff + 8) = w1; } else asm volatile("" :: "v"(w0), "v"(w1));
            asm volatile("s_waitcnt lgkmcnt(0)" ::: "memory");
        }
    }
}
template <bool DRY>
__device__ __forceinline__ void swa_phase(int u0, const u16* Q, const u16* Kb, const u16* Vb, const u16* Gt, u16* Y, const float* sink, char* lds) {
    int tid = threadIdx.x; asm volatile("" : "+v"(tid));
    const int bk = u0 >> 5, b = bk >> 2, kvh = bk & 3, qbA = u0 & 31, qbB = qbA + 1;
    int tloA, thiA, tloB, thiB; swa_block_geom(qbA, tloA, thiA); swa_block_geom(qbB, tloB, thiB);
    { SwaRegs<6> R; swa_tiles_load<6>(R, b, kvh, tloA, thiA - tloA + 1, Kb, Vb, tid); swa_tiles_store_lds<6>(R, tloA, thiA - tloA + 1, lds, tid); }
    __syncthreads();
    SwaRegs<2> N; const int nnew = thiB - thiA;
    swa_tiles_load<2>(N, b, kvh, thiA + 1, nnew, Kb, Vb, tid);
    swa_block_compute<DRY>(b, kvh, qbA, Q, Gt, Y, sink, lds, tid);
    __syncthreads();
    swa_tiles_store_lds<2>(N, thiA + 1, nnew, lds, tid);
    __syncthreads();
    swa_block_compute<DRY>(b, kvh, qbB, Q, Gt, Y, sink, lds, tid);
    __syncthreads();
}
}
namespace hg {
using namespace att;
typedef _Float16 f16;
constexpr int L_QT = 0, L_KT = 16384, L_QIN = 32768, L_KDEC = 49152, L_V = 65536, L_S = 81920, L_CUM = 114688, L_EDEC = 118784, L_STG = 0, STG_LD = 132;

struct ChunkRegs { unsigned q[8], v[8], lf[8]; };

__device__ __forceinline__ int chunk_pos(int c, int i, int dir) { return dir ? (c * 64 + 63 - i) : (c * 64 + i); }

template <bool NEEDQ>
__device__ __forceinline__ void load_chunk(ChunkRegs& R, const u16* Qh, const u16* Vh, const u16* LF, long rowbase, int colbase, int c, int dir, int wid, int lane) {
#pragma unroll
    for (int i = 0; i < 8; ++i) {
        const long pos = rowbase + chunk_pos(c, wid * 8 + i, dir);
        const size_t off = (size_t)pos * DM + colbase + 2 * lane;
        if (NEEDQ) R.q[i] = *(const unsigned*)(Qh + off);
        R.v[i] = *(const unsigned*)(Vh + off);
        R.lf[i] = *(const unsigned*)(LF + off);
    }
}
__device__ __forceinline__ float h2f(unsigned short h) { return (float)__builtin_bit_cast(f16, h); }

template <bool FULL>
__device__ __forceinline__ void prep_chunk(const ChunkRegs& R, char* lds, int wid, int lane, float (&gtot)[2]) {
    float g[8][2]; float run0 = 0.f, run1 = 0.f;
#pragma unroll
    for (int i = 0; i < 8; ++i) { run0 += h2f((unsigned short)(R.lf[i] & 0xffff)); run1 += h2f((unsigned short)(R.lf[i] >> 16)); g[i][0] = run0; g[i][1] = run1; }
    float* cum = (float*)(lds + L_CUM);
    *(float2*)(cum + wid * 128 + 2 * lane) = make_float2(run0, run1);
    __syncthreads();
    float pre0 = 0.f, pre1 = 0.f, gm0 = 0.f, gm1 = 0.f, gl0 = 0.f, gl1 = 0.f;
#pragma unroll
    for (int w2 = 0; w2 < 8; ++w2) { const float2 t = *(const float2*)(cum + w2 * 128 + 2 * lane);
        if (w2 < wid) { pre0 += t.x; pre1 += t.y; } if (w2 < 4) { gm0 += t.x; gm1 += t.y; } gl0 += t.x; gl1 += t.y; }
    gtot[0] += gl0; gtot[1] += gl1;
    const float egm0 = __expf(gm0), egm1 = __expf(gm1), elm0 = __expf(gl0 - gm0), elm1 = __expf(gl1 - gm1);
    if (wid == 0) *(float2*)((float*)(lds + L_EDEC) + 2 * lane) = make_float2(__expf(gl0), __expf(gl1));
#pragma unroll
    for (int i = 0; i < 8; ++i) {
        const int row = wid * 8 + i;
        const float G0 = pre0 + g[i][0], G1 = pre1 + g[i][1];
        const float e0 = __expf(G0 - gm0), e1 = __expf(G1 - gm1);
        const float r0 = __builtin_amdgcn_rcpf(e0), r1 = __builtin_amdgcn_rcpf(e1);
        const float lf0 = h2f((unsigned short)(R.lf[i] & 0xffff)), lf1 = h2f((unsigned short)(R.lf[i] >> 16));
        const float k0 = 1.0f - __expf(lf0), k1 = 1.0f - __expf(lf1);
        const float kt0 = k0 * r0, kt1 = k1 * r1;
        const int vo = v_st<4>(row, 2 * lane);
        *(unsigned*)(lds + L_KDEC + vo) = cvtpk(kt0 * elm0, kt1 * elm1);
        *(unsigned*)(lds + L_V + vo) = R.v[i];
        if (FULL) {
            const float q0 = bf2f((u16)(R.q[i] & 0xffff)), q1 = bf2f((u16)(R.q[i] >> 16));
            const float qt0 = q0 * e0, qt1 = q1 * e1;
            const int ko = KSWZ(row, 4 * lane);
            *(unsigned*)(lds + L_QT + ko) = cvtpk(qt0, qt1);
            *(unsigned*)(lds + L_KT + ko) = cvtpk(kt0, kt1);
            *(unsigned*)(lds + L_QIN + ko) = cvtpk(qt0 * egm0, qt1 * egm1);
        }
    }
}

template <int KS> __device__ __forceinline__ bf16x8 tr_frag(int vb) {
    const s16x4 l = tr_read<KS * 4096>(vb), h = tr_read<KS * 4096 + 2048>(vb);
    asm volatile("s_waitcnt lgkmcnt(0)" ::: "memory"); SBAR();
    return PKF(l, h);
}

struct SuFrag { s16x4 lv, hv, l0, h0, l1, h1; };
__device__ __forceinline__ void su_read(SuFrag& f, int vbV, int vbK0, int vbK1, int off) {
    f.lv = vtr(vbV + off); f.hv = vtr(vbV + off + 2048); f.l0 = vtr(vbK0 + off); f.h0 = vtr(vbK0 + off + 2048); f.l1 = vtr(vbK1 + off); f.h1 = vtr(vbK1 + off + 2048);
}
__device__ __forceinline__ void su_mma(f32x16 (&sacc)[2], const SuFrag& f) {
    const bf16x8 bv = PKF(f.lv, f.hv), a0 = PKF(f.l0, f.h0), a1 = PKF(f.l1, f.h1);
    sacc[0] = __builtin_amdgcn_mfma_f32_32x32x16_bf16(a0, bv, sacc[0], 0, 0, 0); sacc[1] = __builtin_amdgcn_mfma_f32_32x32x16_bf16(a1, bv, sacc[1], 0, 0, 0);
}
template <int NIMG>
__device__ __forceinline__ void state_update_t(f32x16 (&sacc)[2], const char* lds, int ldsbase, int offK, int offV, int offE, int wid, int lane) {
    const int hi = lane >> 5, j = wid >> 1, ib = 2 * (wid & 1);
    const float* edec = (const float*)(lds + offE);
    const int vbV = ldsbase + offV + v_rd_base(lane) + j * 512;
    const int vbK0 = ldsbase + offK + v_rd_base(lane) + ib * 512, vbK1 = vbK0 + 512;
#pragma unroll
    for (int i2 = 0; i2 < 2; ++i2)
#pragma unroll
        for (int r = 0; r < 16; ++r) sacc[i2][r] *= edec[32 * (ib + i2) + crow(r, hi)];
    SBAR();
    SuFrag fa, fb; su_read(fa, vbV, vbK0, vbK1, 0);
#pragma unroll
    for (int s = 0; s < 4 * NIMG; s += 2) {
        su_read(fb, vbV, vbK0, vbK1, ((s + 1) >> 2) * 16384 + ((s + 1) & 3) * 4096);
        su_mma(sacc, fa);
        if (s + 2 < 4 * NIMG) su_read(fa, vbV, vbK0, vbK1, ((s + 2) >> 2) * 16384 + ((s + 2) & 3) * 4096);
        su_mma(sacc, fb);
    }
    __builtin_amdgcn_sched_group_barrier(0x100, 6, 0);
#pragma unroll
    for (int s = 0; s < 4 * NIMG - 1; ++s) { __builtin_amdgcn_sched_group_barrier(0x100, 6, 0); __builtin_amdgcn_sched_group_barrier(0x008, 2, 0); }
    __builtin_amdgcn_sched_group_barrier(0x008, 2, 0);
    SBAR();
}
__device__ __forceinline__ void state_update(f32x16 (&sacc)[2], const char* lds, int ldsbase, int wid, int lane) { state_update_t<1>(sacc, lds, ldsbase, L_KDEC, L_V, L_EDEC, wid, lane); }
__device__ __forceinline__ void write_simg(const f32x16 (&sacc)[2], char* lds, int wid, int lane) {
    const int r32 = lane & 31, hi = lane >> 5, j = wid >> 1, ib = 2 * (wid & 1);
#pragma unroll
    for (int i2 = 0; i2 < 2; ++i2)
#pragma unroll
        for (int r = 0; r < 16; ++r) { const int d = 32 * (ib + i2) + crow(r, hi);
            *(__hip_bfloat16*)(lds + L_S + (d >> 6) * 16384 + v_st<4>(d & 63, 32 * j + r32)) = __float2bfloat16(sacc[i2][r]); }
}
__device__ __forceinline__ f32x16 chunk_output(const char* lds, int ldsbase, int wid, int lane) {
    const int r32 = lane & 31, hi = lane >> 5, tb = wid & 1, j = wid >> 1;
    const char* QT = lds + L_QT; const char* KT = lds + L_KT; const char* QIN = lds + L_QIN;
    f32x16 p0 = f32x16{}, p1 = f32x16{};
#pragma unroll
    for (int d0 = 0; d0 < 8; ++d0) { const int cb = (d0 * 16 + hi * 8) * 2;
        const bf16x8 qf = *reinterpret_cast<const bf16x8*>(QT + KSWZ(32 * tb + r32, cb));
        const bf16x8 k0 = *reinterpret_cast<const bf16x8*>(KT + KSWZ(r32, cb));
        p0 = __builtin_amdgcn_mfma_f32_32x32x16_bf16(k0, qf, p0, 0, 0, 0);
        if (tb) { const bf16x8 k1 = *reinterpret_cast<const bf16x8*>(KT + KSWZ(32 + r32, cb)); p1 = __builtin_amdgcn_mfma_f32_32x32x16_bf16(k1, qf, p1, 0, 0, 0); } }
#pragma unroll
    for (int r = 0; r < 16; ++r) { const bool keep = crow(r, hi) <= r32; if (tb == 0) { p0[r] = keep ? p0[r] : 0.f; p1[r] = 0.f; } else { p1[r] = keep ? p1[r] : 0.f; } }
    bf16x8 pa0, pa1, pa2, pa3; pack4(p0, p1, pa0, pa1, pa2, pa3);
    f32x16 oacc = f32x16{};
    pv_blk<4>(oacc, ldsbase + L_V + v_rd_base(lane) + j * 512, pa0, pa1, pa2, pa3);
    const int vbS = ldsbase + L_S + v_rd_base(lane) + j * 512;
#define QINF(kd) (*reinterpret_cast<const bf16x8*>(QIN + KSWZ(32 * tb + r32, ((kd) * 16 + hi * 8) * 2)))
    {
        s16x4 lo[2], hh[2];
#define SADDR(kd) (vbS + ((kd) >> 2) * 16384 + ((kd) & 3) * 4096)
        lo[0] = vtr(SADDR(0)); hh[0] = vtr(SADDR(0) + 2048); lo[1] = vtr(SADDR(1)); hh[1] = vtr(SADDR(1) + 2048);
#pragma unroll
        for (int kd = 0; kd < 8; ++kd) {
            const bf16x8 b = PKF(lo[kd & 1], hh[kd & 1]); const bf16x8 q = QINF(kd);
            oacc = __builtin_amdgcn_mfma_f32_32x32x16_bf16(q, b, oacc, 0, 0, 0);
            if (kd + 2 < 8) { lo[kd & 1] = vtr(SADDR(kd + 2)); hh[kd & 1] = vtr(SADDR(kd + 2) + 2048); }
        }
#undef SADDR
    }
#undef QINF
    return oacc;
}

constexpr int P1_KDEC = 0, P1_V = 65536, P1_CUM = 131072, P1_EDEC = 135168;
struct BlockRegs { unsigned v[32], lf[32]; };
__device__ __forceinline__ void load_block(BlockRegs& R, const u16* Vh, const u16* LF, long rowbase, int colbase, int seg, int blk, int dir, int wid, int lane) {
    unsigned voff = (unsigned)lane * 4u; asm volatile("" : "+v"(voff));
#pragma unroll
    for (int i = 0; i < 32; ++i) {
        const int p = blk * 256 + wid * 32 + i;
        const long pos = rowbase + seg * 512 + (dir ? 511 - p : p);
        const size_t roff = ((size_t)pos * DM + colbase) * 2;
        R.v[i] = *(const unsigned*)((const char*)Vh + roff + voff); R.lf[i] = *(const unsigned*)((const char*)LF + roff + voff);
    }
}
__device__ __forceinline__ void prep_block(const BlockRegs& R, char* lds, int wid, int lane, float (&gtot)[2]) {
    float run0 = 0.f, run1 = 0.f;
#pragma unroll
    for (int i = 0; i < 32; ++i) { run0 += h2f((unsigned short)(R.lf[i] & 0xffff)); run1 += h2f((unsigned short)(R.lf[i] >> 16)); }
    float* cum = (float*)(lds + P1_CUM);
    *(float2*)(cum + wid * 128 + 2 * lane) = make_float2(run0, run1);
    __syncthreads();
    float pre0 = 0.f, pre1 = 0.f, gl0 = 0.f, gl1 = 0.f;
#pragma unroll
    for (int w2 = 0; w2 < 8; ++w2) { const float2 t = *(const float2*)(cum + w2 * 128 + 2 * lane); if (w2 < wid) { pre0 += t.x; pre1 += t.y; } gl0 += t.x; gl1 += t.y; }
    gtot[0] += gl0; gtot[1] += gl1;
    if (wid == 0) *(float2*)((float*)(lds + P1_EDEC) + 2 * lane) = make_float2(__expf(gl0), __expf(gl1));
    float G0 = pre0 - gl0, G1 = pre1 - gl1;
    char* base = lds + (wid >> 1) * 16384 + (wid & 1) * 8192 + v_st<4>(0, 2 * lane);
#pragma unroll
    for (int i = 0; i < 32; ++i) {
        const float lf0 = h2f((unsigned short)(R.lf[i] & 0xffff)), lf1 = h2f((unsigned short)(R.lf[i] >> 16));
        G0 += lf0; G1 += lf1;
        const float k0 = 1.0f - __expf(lf0), k1 = 1.0f - __expf(lf1);
        const int vo = v_st<4>(i, 0);
        *(unsigned*)(base + P1_KDEC + vo) = cvtpk(k0 * __expf(-G0), k1 * __expf(-G1));
        *(unsigned*)(base + P1_V + vo) = R.v[i];
    }
}
__device__ __forceinline__ void state_update_block(f32x16 (&sacc)[2], const char* lds, int ldsbase, int wid, int lane) { state_update_t<4>(sacc, lds, ldsbase, P1_KDEC, P1_V, P1_EDEC, wid, lane); }
__device__ __forceinline__ void hgrn_pass1(int item, const u16* Vt, const u16* LF0, const u16* LF1, float* ust, float* dst, char* lds) {
    int tid = threadIdx.x; asm volatile("" : "+v"(tid)); const int lane = tid & 63; const int wid = __builtin_amdgcn_readfirstlane(tid >> 6);
    const int seg = item & 7, dir = (item >> 3) & 1, bh = item >> 4, b = bh >> 3, h = bh & 7;
    const long rowbase = (long)b * SEQ; const int colbase = h * 128; const u16* LF = dir ? LF1 : LF0;
    const int ldsbase = (int)(uintptr_t)lds;
    f32x16 sacc[2] = {}; float gtot[2] = {0.f, 0.f};
    BlockRegs R;
    load_block(R, Vt, LF, rowbase, colbase, seg, 0, dir, wid, lane);
#pragma unroll 1
    for (int blk = 0; blk < 2; ++blk) {
        prep_block(R, lds, wid, lane, gtot);
        asm volatile("" ::: "memory");
        if (blk == 0) load_block(R, Vt, LF, rowbase, colbase, seg, 1, dir, wid, lane);
        __syncthreads();
        state_update_block(sacc, lds, ldsbase, wid, lane);
    }
    float* up = ust + (size_t)item * 16384 + wid * 2048;
#pragma unroll
    for (int i2 = 0; i2 < 2; ++i2)
#pragma unroll
        for (int r = 0; r < 16; ++r) up[(i2 * 16 + r) * 64 + lane] = sacc[i2][r];
    if (wid == 0) *(float2*)(dst + (size_t)item * 128 + 2 * lane) = make_float2(__expf(gtot[0]), __expf(gtot[1]));
    __syncthreads();
}

template <bool DRY, int PVAR = 0>
__device__ __forceinline__ void hgrn_pass2(int item, const u16* Qh, const u16* Vt, const u16* LF0, const u16* LF1, const u16* Gt, u16* OF, u16* Y,
                                           const float* ust, const float* dst, const float* __restrict__ nw, char* lds) {
    int tid = threadIdx.x; asm volatile("" : "+v"(tid)); const int lane = tid & 63, r32 = lane & 31, hi = lane >> 5; const int wid = __builtin_amdgcn_readfirstlane(tid >> 6);
    const int seg = item & 7, bh = item >> 3, b = bh >> 3, h = bh & 7;
    const long rowbase = (long)b * SEQ; const int colbase = h * 128;
    const int ldsbase = (int)(uintptr_t)lds; const int tb = wid & 1, j = wid >> 1, ib = 2 * (wid & 1);
    float* stg = (float*)(lds + L_STG);
    ChunkRegs R;
#pragma unroll 1
    for (int dir = 0; dir < 2; ++dir) {
        const u16* LF = dir ? LF1 : LF0;
        f32x16 sacc[2] = {}; float gtot[2] = {0.f, 0.f};
        const int nseg = dir ? (7 - seg) : seg;
        for (int n = 0; n < nseg; ++n) {
            const int sg = dir ? (7 - n) : n; const int it = ((bh * 2 + dir) * 8 + sg);
            const float* up = ust + (size_t)it * 16384 + wid * 2048; const float* dp = dst + (size_t)it * 128;
#pragma unroll
            for (int i2 = 0; i2 < 2; ++i2)
#pragma unroll
                for (int r = 0; r < 16; ++r) sacc[i2][r] = sacc[i2][r] * dp[32 * (ib + i2) + crow(r, hi)] + up[(i2 * 16 + r) * 64 + lane];
        }
        write_simg(sacc, lds, wid, lane);
        load_chunk<true>(R, Qh, Vt, LF, rowbase, colbase, dir ? (seg * 8 + 7) : (seg * 8), dir, wid, lane);
        for (int cc = 0; cc < 8; ++cc) {
            const int c = dir ? (seg * 8 + 7 - cc) : (seg * 8 + cc);
            const int ri = tid >> 3, rcg = tid & 7; const size_t goff = (size_t)(rowbase + chunk_pos(c, ri, dir)) * DM + colbase + rcg * 16;
            u32x4 pf0 = {}, pf1 = {}; bf16x8 pg0 = {}, pg1 = {};
            if (dir) { pf0 = *(const u32x4*)(OF + goff); pf1 = *(const u32x4*)(OF + goff + 8); pg0 = ld8(Gt + goff); pg1 = ld8(Gt + goff + 8); }
            if (PVAR != 1) prep_chunk<true>(R, lds, wid, lane, gtot); else { asm volatile("" :: "v"(R.q[0]), "v"(R.v[7]), "v"(R.lf[3])); __syncthreads(); }
            if (cc + 1 < 8) load_chunk<true>(R, Qh, Vt, LF, rowbase, colbase, dir ? (seg * 8 + 6 - cc) : (seg * 8 + cc + 1), dir, wid, lane);
            __syncthreads();
            f32x16 oacc = f32x16{};
            if (PVAR != 2) { oacc = chunk_output(lds, ldsbase, wid, lane); state_update(sacc, lds, ldsbase, wid, lane); }
            __syncthreads();
            if (PVAR != 3) {
            write_simg(sacc, lds, wid, lane);
#pragma unroll
            for (int r = 0; r < 16; ++r) stg[(32 * tb + crow(r, hi)) * STG_LD + 32 * j + r32] = oacc[r];
            __syncthreads();
            {
                const int i = ri, cg = rcg; const float* sp = stg + i * STG_LD + cg * 16;
                f32x4 ov[4];
#pragma unroll
                for (int g = 0; g < 4; ++g) ov[g] = *(const f32x4*)(sp + g * 4);
                if (dir == 0) {
                    u32x4 w0, w1;
                    w0.x = pg8::pk_f16(ov[0][0], ov[0][1]); w0.y = pg8::pk_f16(ov[0][2], ov[0][3]); w0.z = pg8::pk_f16(ov[1][0], ov[1][1]); w0.w = pg8::pk_f16(ov[1][2], ov[1][3]);
                    w1.x = pg8::pk_f16(ov[2][0], ov[2][1]); w1.y = pg8::pk_f16(ov[2][2], ov[2][3]); w1.z = pg8::pk_f16(ov[3][0], ov[3][1]); w1.w = pg8::pk_f16(ov[3][2], ov[3][3]);
                    if (!DRY) { *(u32x4*)(OF + goff) = w0; *(u32x4*)(OF + goff + 8) = w1; } else asm volatile("" :: "v"(w0), "v"(w1));
                } else {
                    const u32x4 f0 = pf0, f1 = pf1;
                    float tv[16];
#pragma unroll
                    for (int e = 0; e < 4; ++e) { tv[2 * e] = h2f((unsigned short)(f0[e] & 0xffff)); tv[2 * e + 1] = h2f((unsigned short)(f0[e] >> 16));
                                                  tv[8 + 2 * e] = h2f((unsigned short)(f1[e] & 0xffff)); tv[8 + 2 * e + 1] = h2f((unsigned short)(f1[e] >> 16)); }
                    float ss = 0.f;
#pragma unroll
                    for (int e = 0; e < 16; ++e) { tv[e] += ov[e >> 2][e & 3]; ss += tv[e] * tv[e]; }
                    ss += __shfl_xor(ss, 1); ss += __shfl_xor(ss, 2); ss += __shfl_xor(ss, 4);
                    const float rs = __builtin_amdgcn_rsqf(ss * (1.0f / 128.0f) + EPS);
                    const bf16x8 g0 = pg0, g1 = pg1;
                    float yv[16];
#pragma unroll
                    for (int e = 0; e < 8; ++e) { yv[e] = tv[e] * rs * nw[cg * 16 + e] * bf2f((u16)g0[e]); yv[8 + e] = tv[8 + e] * rs * nw[cg * 16 + 8 + e] * bf2f((u16)g1[e]); }
                    u32x4 w0, w1;
                    w0.x = cvtpk(yv[0], yv[1]); w0.y = cvtpk(yv[2], yv[3]); w0.z = cvtpk(yv[4], yv[5]); w0.w = cvtpk(yv[6], yv[7]);
                    w1.x = cvtpk(yv[8], yv[9]); w1.y = cvtpk(yv[10], yv[11]); w1.z = cvtpk(yv[12], yv[13]); w1.w = cvtpk(yv[14], yv[15]);
                    if (!DRY) { *(u32x4*)(Y + goff) = w0; *(u32x4*)(Y + goff + 8) = w1; } else asm volatile("" :: "v"(w0), "v"(w1));
                }
            }
            } else { asm volatile("" :: "v"(oacc), "v"(sacc[0]), "v"(sacc[1]), "v"(pf0), "v"(pg0)); __syncthreads(); }
        }
        __syncthreads();
    }
}
}
#define GAS __attribute__((address_space(1)))
#define LAS __attribute__((address_space(3)))
typedef unsigned short bf16;
typedef unsigned v4u __attribute__((ext_vector_type(4)));
typedef float f32x4 __attribute__((ext_vector_type(4)));
typedef short bf16x8 __attribute__((ext_vector_type(8)));
typedef GAS unsigned gu32;
typedef GAS unsigned long long gu64;
#define RLX_AGENT __ATOMIC_RELAXED, __HIP_MEMORY_SCOPE_AGENT
#define LDS_WAIT() asm volatile("s_waitcnt lgkmcnt(0)" ::: "memory")
#define VM_WAIT() asm volatile("s_waitcnt vmcnt(0)" ::: "memory")
__device__ __forceinline__ unsigned long long rt() { return __builtin_amdgcn_s_memrealtime(); }
__device__ __forceinline__ unsigned f2bf(float f) { unsigned u = __builtin_bit_cast(unsigned, f); return (u + 0x7fffu + ((u >> 16) & 1u)) >> 16; }
__device__ __forceinline__ unsigned pk2(float lo, float hi) { return f2bf(lo) | (f2bf(hi) << 16); }

#define XB_TMO      128
#define XB_XCNT(j)  (256  + 64 * (j))
#define XB_XSUB(j)  (1280 + 64 * (j))
#define XB_XGEN(j)  (2304 + 64 * (j))
#define XB_TOP      3328
#define XB_TOPGEN   3392
#define XCD_BAR_WORDS 3456
#define XB_SPIN_CAP (1u << 18)

__device__ __forceinline__ unsigned xb_ld(unsigned* p)              { return __hip_atomic_load(p, __ATOMIC_RELAXED, __HIP_MEMORY_SCOPE_AGENT); }
__device__ __forceinline__ unsigned xb_add(unsigned* p, unsigned v) { return __hip_atomic_fetch_add(p, v, __ATOMIC_RELAXED, __HIP_MEMORY_SCOPE_AGENT); }
__device__ __forceinline__ unsigned xb_xcc_id() { return (unsigned)__builtin_amdgcn_s_getreg((3 << 11) | 20) & 0xFu; }
#define XB_SPIN(cond, bar) do { unsigned _sp = 0; while (cond) { __builtin_amdgcn_s_sleep(1); \
    if ((++_sp & 255u) == 0u) { if (xb_ld(&(bar)[XB_TMO])) break; if (_sp > XB_SPIN_CAP) { atomicAdd(&(bar)[XB_TMO], 1u); break; } } } } while (0)

struct XcdBarrier {
    unsigned* bar; unsigned x;
    volatile LAS unsigned* st;
};

__device__ __forceinline__ XcdBarrier xcd_barrier_post(unsigned* bar, volatile LAS unsigned* st) {
    XcdBarrier b; b.bar = bar; b.x = xb_xcc_id(); b.st = st;
    if (threadIdx.x == 0) (void)xb_add(&bar[XB_XCNT(b.x)], 1u);
    return b;
}
__device__ __forceinline__ void xcd_barrier_complete(unsigned* bar, unsigned x, unsigned& nloc, unsigned& nx) {
    const unsigned G = gridDim.x * gridDim.y * gridDim.z;
    unsigned sum, cnt, mine, sp = 0u;
    for (;;) {
        sum = 0u; cnt = 0u; mine = 0u;
#pragma unroll
        for (unsigned j = 0; j < 16; ++j) { const unsigned c = xb_ld(&bar[XB_XCNT(j)]); sum += c; cnt += (c > 0u) ? 1u : 0u; mine = (j == x) ? c : mine; }
        if (sum == G) break;
        __builtin_amdgcn_s_sleep(1);
        if ((++sp & 255u) == 0u) { if (xb_ld(&bar[XB_TMO])) break; if (sp > XB_SPIN_CAP) { atomicAdd(&bar[XB_TMO], 1u); break; } }
    }
    nloc = mine > 0u ? mine : 1u; nx = cnt > 0u ? cnt : 1u;
}

__device__ __forceinline__ void xcd_barrier(const XcdBarrier& b) {
    asm volatile("s_waitcnt vmcnt(0)" ::: "memory");
    __syncthreads();
    if (threadIdx.x == 0) {
        unsigned* bar = b.bar; asm volatile("" : "+s"(bar)); unsigned bx = __builtin_amdgcn_readfirstlane(b.x); asm volatile("" : "+s"(bx));
        __builtin_amdgcn_s_waitcnt(0);
        unsigned nloc = b.st[0], nx = b.st[1];
        if (nloc == 0u) { xcd_barrier_complete(bar, bx, nloc, nx); b.st[0] = nloc; b.st[1] = nx; }
        const unsigned old = xb_add(&bar[XB_XSUB(bx)], 1u);
        const unsigned gen = old / nloc;
        if (old + 1u == (gen + 1u) * nloc) {
            __builtin_amdgcn_fence(__ATOMIC_RELEASE, "agent");
            asm volatile("s_waitcnt vmcnt(0)" ::: "memory");
            const unsigned og = xb_add(&bar[XB_TOP], 1u);
            const unsigned tg = og / nx;
            if (og + 1u == (tg + 1u) * nx) xb_add(&bar[XB_TOPGEN], 1u);
            else XB_SPIN(xb_ld(&bar[XB_TOPGEN]) == tg, bar);
            __builtin_amdgcn_fence(__ATOMIC_ACQUIRE, "agent");
            xb_add(&bar[XB_XGEN(bx)], 1u);
            asm volatile("s_waitcnt vmcnt(0)" ::: "memory");
        } else {
            XB_SPIN(xb_ld(&bar[XB_XGEN(bx)]) == gen, bar);
            __builtin_amdgcn_fence(__ATOMIC_ACQUIRE, "agent");
            asm volatile("s_waitcnt vmcnt(0)" ::: "memory");
        }
    }
    __syncthreads();
}
#ifndef DUP_MASK
#define DUP_MASK 0
#endif
#define DUP(kind) (((DUP_MASK) >> (kind)) & 1)
#ifndef DUPR_MASK
#define DUPR_MASK 0
#endif
#define DUPR(kind) (((DUPR_MASK) >> (kind)) & 1)
#ifndef DUPR_MODE
#define DUPR_MODE 0
#endif
#ifndef MK_PER_PHASE
#define MK_PER_PHASE 0
#endif

constexpr size_t MiB = 1u << 20;
constexpr size_t WS_CTL = 0, CTL_ZERO_BYTES = 1 * MiB;
constexpr size_t WS_ROPE = 1 * MiB;
constexpr size_t WS_LB = 1 * MiB + 256 * 1024;
constexpr size_t WS_KMX = 1 * MiB + 384 * 1024;
constexpr size_t WS_DST = 1 * MiB + 512 * 1024;
constexpr size_t WS_SSQ = 2 * MiB;
constexpr size_t WS_WTE = 3 * MiB;
constexpr size_t WS_WTO = 25 * MiB;
constexpr size_t WS_XB = 38 * MiB;
constexpr size_t WS_R0 = 70 * MiB, RSZ = 32 * MiB;
constexpr size_t WS_END = WS_R0 + 6 * RSZ;
constexpr int CW_BAR = 4096;

constexpr int RING_BYTES = 139264;
constexpr int LDSCTL_OFF = RING_BYTES + 8 * pg8::EPI_STG_WAVE, MISC_OFF = LDSCTL_OFF + 320;
constexpr int LDS_BYTES = 163840;
constexpr int NWAVES = 8, GRID = 256;
constexpr int NPH = 20;

struct Frame {
    LAS unsigned char* lds; volatile LAS unsigned* MISC; gu32* ctl;
    int tid, lane, wave, vcu, G;
};

__device__ __forceinline__ void transpose_item(const float* W, const float* sc, int K, int N, bf16* WT, LAS float* scr, int item, int lane) {
    const int nblk = N / 32, kb = item / nblk, nb = item % nblk, k0 = 64 * kb, n0 = 32 * nb;
    const int c4 = lane & 7, rk = lane >> 3;
#pragma unroll
    for (int i = 0; i < 8; ++i) { const int kk = 8 * i + rk; const float s = sc ? sc[k0 + kk] : 1.0f;
        f32x4 v = *(const GAS f32x4*)(W + (size_t)(k0 + kk) * N + n0 + 4 * c4); v = v * s; *(LAS f32x4*)(scr + kk * 36 + 4 * c4) = v; }
    LDS_WAIT(); asm volatile("" ::: "memory");
    const int c = lane & 7;
#pragma unroll
    for (int j = 0; j < 4; ++j) { const int n = (lane >> 3) + 8 * j; const LAS float* s = scr + (8 * c) * 36 + n;
        v4u o; o.x = pk2(s[0 * 36], s[1 * 36]); o.y = pk2(s[2 * 36], s[3 * 36]); o.z = pk2(s[4 * 36], s[5 * 36]); o.w = pk2(s[6 * 36], s[7 * 36]);
        *(GAS v4u*)(WT + (size_t)(n0 + n) * K + k0 + 8 * c) = o; }
    LDS_WAIT(); asm volatile("" ::: "memory");
}
__device__ __forceinline__ void convert_layer(Frame& F, const float* Win, const float* nrm, int Nin, const float* Wout, bf16* dstbuf, int wg = -1, int nwg = 0) {
    int lane = F.lane; asm volatile("" : "+v"(lane));
    LAS float* scr = (LAS float*)(F.lds + F.wave * 16384);
    const int gw = (wg < 0 ? F.vcu : wg) * NWAVES + F.wave, NGW = (wg < 0 ? F.G : nwg) * NWAVES;
    const int I_in = (DM / 64) * (Nin / 32), I_out = (DIN / 64) * (DM / 32);
    bf16* wout_t = dstbuf + (size_t)Nin * DM;
    for (int it = gw; it < I_in + I_out; it += NGW) {
        if (it < I_in) transpose_item(Win, nrm, DM, Nin, dstbuf, scr, it, lane);
        else transpose_item(Wout, nullptr, DIN, DM, wout_t, scr, it - I_in, lane);
    }
}
__device__ __forceinline__ float wave_sum(float v) {
#pragma unroll
    for (int o = 1; o < 64; o <<= 1) v += __shfl_xor(v, o);
    return v;
}

__device__ __forceinline__ void stagger(int vcu, unsigned ticks) {
    if (vcu & 1) { const unsigned long long t0 = __builtin_amdgcn_s_memrealtime(); while (__builtin_amdgcn_s_memrealtime() - t0 < ticks) __builtin_amdgcn_s_sleep(8); }
}
#ifndef STAG_EVEN
#define STAG_EVEN 0
#endif
#ifndef STAG_ODD
#define STAG_ODD 0
#endif
struct Args { const float* in[13]; float* out; unsigned char* ws; int ph_lo, ph_hi; };

__global__ void __launch_bounds__(NWAVES * 64, 2) mk_fwd(Args args) {
    extern __shared__ __attribute__((aligned(16))) unsigned char lds[];
    Frame F;
    F.lds = (LAS unsigned char*)lds;
    F.MISC = (volatile LAS unsigned*)(F.lds + MISC_OFF);
    F.tid = threadIdx.x; F.lane = F.tid & 63; F.wave = __builtin_amdgcn_readfirstlane(F.tid >> 6);
    F.G = gridDim.x; { const int bx = blockIdx.x; F.vcu = (F.G % 8 == 0) ? (bx % 8) * (F.G / 8) + bx / 8 : bx; }
    unsigned char* ws = args.ws;
    F.ctl = (gu32*)(ws + WS_CTL);
    for (int u = F.tid; u < (LDS_BYTES - LDSCTL_OFF) / 4; u += NWAVES * 64) ((LAS unsigned*)(F.lds + LDSCTL_OFF))[u] = 0u;
    __syncthreads();
    const int lo = args.ph_lo, hi = args.ph_hi; (void)lo; (void)hi;
    const bool multi = MK_PER_PHASE ? ((hi - lo) > 1) : true;
    XcdBarrier bar; bar.bar = (unsigned*)(F.ctl + CW_BAR); bar.x = 0; bar.st = nullptr;
    if (multi) bar = xcd_barrier_post((unsigned*)(F.ctl + CW_BAR), F.MISC + 8);
#ifndef PHASE_MASK
#define PHASE_MASK 0xFFFF
#endif
#if MK_PER_PHASE
#define INK(kind, k) ((((PHASE_MASK) >> (kind)) & 1) && lo <= (k) && (k) < hi)
#define IN(k) (lo <= (k) && (k) < hi)
#else
#define INK(kind, k) (((PHASE_MASK) >> (kind)) & 1)
#define IN(k) true
#endif
#if MK_PER_PHASE
#define SEAM(k) do { if (IN(k) && IN((k) + 1)) xcd_barrier(bar); } while (0)
#else
#define SEAM(k) do { xcd_barrier(bar); if (DUP(9)) xcd_barrier(bar); } while (0)
#endif

#define PTRS() size_t wz_ = 0; asm volatile("" : "+s"(wz_)); unsigned char* wsl = args.ws + wz_; \
    const float* x_in = args.in[0]; float* xres = args.out; \
    float* rope = (float*)(wsl + WS_ROPE); float* lbt = (float*)(wsl + WS_LB); float* dstv = (float*)(wsl + WS_DST); float* ssq = (float*)(wsl + WS_SSQ); unsigned* kmx = (unsigned*)(wsl + WS_KMX); (void)kmx; \
    bf16* wte = (bf16*)(wsl + WS_WTE); bf16* wto = (bf16*)(wsl + WS_WTO); bf16* xb = (bf16*)(wsl + WS_XB); float* ust = args.out;     \
    unsigned char* R0 = wsl + WS_R0; unsigned char* R1 = R0 + RSZ; unsigned char* R2 = R1 + RSZ; unsigned char* R3 = R2 + RSZ; unsigned char* R4 = R3 + RSZ; unsigned char* R5 = R4 + RSZ; \
    const int gw = F.vcu * NWAVES + F.wave, NGW = F.G * NWAVES; int tidl = threadIdx.x; asm volatile("" : "+v"(tidl)); const int lanel = tidl & 63; (void)lanel; \
    (void)x_in; (void)xres; (void)rope; (void)lbt; (void)dstv; (void)ssq; (void)wte; (void)wto; (void)xb; (void)ust; (void)R0; (void)R1; (void)R2; (void)R3; (void)R4; (void)R5; (void)gw; (void)NGW;

    for (int rep_ = 0; rep_ < (DUP(0) ? 2 : 1); ++rep_)
    if (INK(0, 0)) {
        PTRS();
        convert_layer(F, args.in[2], args.in[1], EVEN_IN, args.in[7], wte);
        convert_layer(F, args.in[9], args.in[8], ODD_IN, args.in[11], wto);
        {
            const int gt = F.vcu * (NWAVES * 64) + tidl, NGT = F.G * NWAVES * 64;
            for (int e = gt; e < SEQ * 8; e += NGT) { const int pos = e >> 3, i = e & 7; const double inv = pow(500000.0, -(double)i / 8.0); const double ang = (double)pos * inv;
                rope[e] = (float)cos(ang); rope[SEQ * 8 + e] = (float)sin(ang); }
            const float* lg = args.in[6];
            for (int e = gt; e < 2 * 1024; e += NGT) { const int dir = e >> 10, c = e & 1023; const float l0 = lg[(dir * 2 + 0) * 1024 + c], l1 = lg[(dir * 2 + 1) * 1024 + c];
                lbt[e] = 0.0f; lbt[2048 + e] = 1.0f / (1.0f + expf(l0 - l1)); }
            if (gt < 2 * NB * 16) kmx[gt] = 0u;
        }
        for (int m = gw; m < T; m += NGW) {
            const GAS f32x4* xr = (const GAS f32x4*)(x_in + (size_t)m * DM) + lanel; f32x4 v[4]; float s = 0.f;
#pragma unroll
            for (int j = 0; j < 4; ++j) { v[j] = xr[64 * j]; s += (v[j].x * v[j].x + v[j].y * v[j].y) + (v[j].z * v[j].z + v[j].w * v[j].w); }
            s = wave_sum(s);
            GAS unsigned long long* o8 = (GAS unsigned long long*)(xb + (size_t)m * DM) + lanel;
#pragma unroll
            for (int j = 0; j < 4; ++j) o8[64 * j] = (unsigned long long)pk2(v[j].x, v[j].y) | ((unsigned long long)pk2(v[j].z, v[j].w) << 32);
            if (lanel < 16) ssq[(size_t)m * 16 + lanel] = (lanel == 0) ? s : 0.0f;
        }
    }
    SEAM(0);

#pragma unroll 1
    for (int layer = 0; layer < 4; ++layer) {
        const int j = layer >> 1; const bool even = (layer & 1) == 0;
        const int pb = 1 + (layer >> 1) * 9 + (even ? 0 : 6);
        if (even) {
            const float lam_init = (j == 0) ? 0.2f : 0.470713018f;
            if (INK(1, pb + 0)) {
        PTRS();
                pg8::Gemm g{xb, wte, T, 4096, DM, DM, 1 << 30, 0l}; pg8::StaticOrder S; S.init(T, 4096, F.G, (int)blockIdx.x);
                pg8::EpiIn<true> E{ssq, rope, lbt + j * 2048, R0, R1, R2, R3, R4, R5, 0, kmx + j * (NB * 16)};
                if (DUP(1)) { pg8::EpiDry ED; pg8::gemm_phase(F.lds, g, S, ED); }
                if (DUPR(1)) { pg8::EpiIn<true, DUPR_MODE> E2{ssq, rope, lbt + j * 2048, R0, R1, R2, R3, R4, R5, 0, kmx + j * (NB * 16)}; pg8::gemm_phase(F.lds, g, S, E2); }
                if (STAG_EVEN) stagger(F.vcu, STAG_EVEN);
                pg8::gemm_phase(F.lds, g, S, E);
            }
            SEAM(pb + 0);
            if (INK(2, pb + 1)) {
        PTRS();
                if (layer == 2) { convert_layer(F, args.in[9] + (size_t)DM * ODD_IN, args.in[8] + DM, ODD_IN, args.in[11] + (size_t)DIN * DM, wto); __syncthreads(); }
                const float* lq = args.in[3] + j * 256; float s1 = 0.f, s2 = 0.f;
                for (int i = 0; i < 64; ++i) { s1 += lq[i] * lq[64 + i]; s2 += lq[128 + i] * lq[192 + i]; }
                const float lam = expf(s1) - expf(s2) + lam_init;
                if (DUP(2)) for (int i = 0; i < 4; ++i) { const int bh = (F.vcu >> 5) * 4 + i, qb = F.vcu & 31;
                    att::diff_attn_unit<true, DUPR_MODE>(bh >> 3, bh & 7, qb, (const att::u16*)R0, (const att::u16*)R1, (const att::u16*)R2, (const att::u16*)R3, (att::u16*)R0,
                                        args.in[4] + j * 128, lam, 1.0f - lam_init, kmx + j * (NB * 16), (char*)lds); }
                for (int i = 0; i < 4; ++i) { const int bh = (F.vcu >> 5) * 4 + i, qb = F.vcu & 31;
                    att::diff_attn_unit<false>(bh >> 3, bh & 7, qb, (const att::u16*)R0, (const att::u16*)R1, (const att::u16*)R2, (const att::u16*)R3, (att::u16*)R0,
                                        args.in[4] + j * 128, lam, 1.0f - lam_init, kmx + j * (NB * 16), (char*)lds); }
            }
            SEAM(pb + 1);
            if (INK(1, pb + 2)) {
        PTRS();
                pg8::Gemm g{xb, wte + (size_t)4096 * DM, T, 5120, DM, DM, 1 << 30, 0l}; pg8::StaticOrder S; S.init(T, 5120, F.G, (int)blockIdx.x);
                pg8::EpiIn<true> E{ssq, rope, lbt + j * 2048, R0, R1, R2, R3, R4, R5, 16};
                if (DUP(1)) { pg8::EpiDry ED; pg8::gemm_phase(F.lds, g, S, ED); }
                if (DUPR(1)) { pg8::EpiIn<true, DUPR_MODE> E2{ssq, rope, lbt + j * 2048, R0, R1, R2, R3, R4, R5, 16}; pg8::gemm_phase(F.lds, g, S, E2); }
                if (STAG_EVEN) stagger(F.vcu, STAG_EVEN);
                pg8::gemm_phase(F.lds, g, S, E);
            }
            SEAM(pb + 2);
            if (INK(3, pb + 3)) {
        PTRS();
                if (DUP(3)) for (int it = F.vcu; it < 512; it += F.G) hg::hgrn_pass1(it, (const att::u16*)R2, (const att::u16*)R4, (const att::u16*)R5, ust, dstv, (char*)lds);
                for (int it = F.vcu; it < 512; it += F.G) hg::hgrn_pass1(it, (const att::u16*)R2, (const att::u16*)R4, (const att::u16*)R5, ust, dstv, (char*)lds);
            }
            SEAM(pb + 3);
            if (INK(4, pb + 4)) {
        PTRS();
                if (DUP(4)) for (int it = F.vcu; it < 256; it += F.G) hg::hgrn_pass2<true, DUPR_MODE>(it, (const att::u16*)R1, (const att::u16*)R2, (const att::u16*)R4, (const att::u16*)R5, (const att::u16*)R3,
                                                                        (att::u16*)R4, (att::u16*)R1, ust, dstv, args.in[5] + j * 128, (char*)lds);
                for (int it = F.vcu; it < 256; it += F.G) hg::hgrn_pass2<false>(it, (const att::u16*)R1, (const att::u16*)R2, (const att::u16*)R4, (const att::u16*)R5, (const att::u16*)R3,
                                                                        (att::u16*)R4, (att::u16*)R1, ust, dstv, args.in[5] + j * 128, (char*)lds);
            }
            SEAM(pb + 4);
            if (INK(5, pb + 5)) {
        PTRS();
                pg8::Gemm g{(const bf16*)R0, wte + (size_t)EVEN_IN * DM, T, DM, DIN, DM, 16, (long)RSZ - 2048l}; pg8::StaticOrder S; S.init(T, DM, F.G, (int)blockIdx.x);
                if (DUP(5)) { pg8::EpiDry ED; pg8::gemm_phase(F.lds, g, S, ED); }
                if (layer == 0) { pg8::EpiOut<true, false> E{x_in, xres, xb, ssq}; pg8::gemm_phase(F.lds, g, S, E); }
                else            { pg8::EpiOut<false, false> E{x_in, xres, xb, ssq}; pg8::gemm_phase(F.lds, g, S, E); }
            }
            SEAM(pb + 5);
        } else {
            if (INK(6, pb + 0)) {
        PTRS();
                pg8::Gemm g{xb, wto, T, ODD_IN, DM, DM, 1 << 30, 0l}; pg8::StaticOrder S; S.init(T, ODD_IN, F.G, (int)blockIdx.x);
                pg8::EpiIn<false> E{ssq, rope, nullptr, R0, R1, R2, R3, R4, R5, 0};
                if (DUP(6)) { pg8::EpiDry ED; pg8::gemm_phase(F.lds, g, S, ED); }
                if (DUPR(6)) pg8::gemm_phase(F.lds, g, S, E);
                if (STAG_ODD) stagger(F.vcu, STAG_ODD);
                pg8::gemm_phase(F.lds, g, S, E);
                if (layer == 1 && (int)blockIdx.x >= 128 && F.G == 256)
                    convert_layer(F, args.in[2] + (size_t)DM * EVEN_IN, args.in[1] + DM, EVEN_IN, args.in[7] + (size_t)DIN * DM, wte, (int)blockIdx.x - 128, 128);
            }
            SEAM(pb + 0);
            if (INK(7, pb + 1)) {
        PTRS();
                if (DUP(7)) att::swa_phase<true>(2 * F.vcu, (const att::u16*)R0, (const att::u16*)R2, (const att::u16*)(R2 + (size_t)T * 256 * 2), (const att::u16*)R3, (att::u16*)R0, args.in[10] + j * 32, (char*)lds);
                att::swa_phase<false>(2 * F.vcu, (const att::u16*)R0, (const att::u16*)R2, (const att::u16*)(R2 + (size_t)T * 256 * 2), (const att::u16*)R3, (att::u16*)R0, args.in[10] + j * 32, (char*)lds);
            }
            SEAM(pb + 1);
            if (INK(5, pb + 2)) {
        PTRS();
                pg8::Gemm g{(const bf16*)R0, wto + (size_t)ODD_IN * DM, T, DM, DIN, DIN, 1 << 30, 0l}; pg8::StaticOrder S; S.init(T, DM, F.G, (int)blockIdx.x);
                if (DUP(5)) { pg8::EpiDry ED; pg8::gemm_phase(F.lds, g, S, ED); }
                if (layer == 3) { pg8::EpiOut<false, true> E{x_in, xres, xb, ssq}; pg8::gemm_phase(F.lds, g, S, E); }
                else            { pg8::EpiOut<false, false> E{x_in, xres, xb, ssq}; pg8::gemm_phase(F.lds, g, S, E); }
            }
            SEAM(pb + 2);
        }
    }
    if (INK(8, 19)) {
        PTRS();
        const float* fw = args.in[12];
        for (int m = gw; m < T; m += NGW) {
            GAS f32x4* xr = (GAS f32x4*)(xres + (size_t)m * DM) + lanel; f32x4 v[4]; float s = 0.f;
#pragma unroll
            for (int jj = 0; jj < 4; ++jj) { v[jj] = xr[64 * jj]; s += (v[jj].x * v[jj].x + v[jj].y * v[jj].y) + (v[jj].z * v[jj].z + v[jj].w * v[jj].w); }
            s = wave_sum(s); const float rs = 1.0f / sqrtf(s * (1.0f / DM) + EPS);
#pragma unroll
            for (int jj = 0; jj < 4; ++jj) { const f32x4 w = *((const f32x4*)fw + lanel + 64 * jj); xr[64 * jj] = v[jj] * rs * w; }
        }
    }
#undef IN
#undef INK
#undef SEAM
}

extern "C" void kernel_launch(void* const* d_in, const int* in_sizes, int n_in, void* d_out, int out_size, void* d_ws, size_t ws_size, hipStream_t stream) {
    static int ok = 0;
    if (ok == 0) {
        if (n_in != 13 || in_sizes[0] != T * DM || out_size != T * DM || ws_size < WS_END) { fprintf(stderr, "kernel_launch: shape/workspace mismatch (n_in %d, ws %zu, need %zu)\n", n_in, ws_size, (size_t)WS_END); ok = -1; return; }
        if (hipFuncSetAttribute((const void*)mk_fwd, hipFuncAttributeMaxDynamicSharedMemorySize, LDS_BYTES) != hipSuccess) { fprintf(stderr, "kernel_launch: hipFuncSetAttribute failed\n"); ok = -1; return; }
        int per_cu = 0;
        if (hipOccupancyMaxActiveBlocksPerMultiprocessor(&per_cu, (const void*)mk_fwd, NWAVES * 64, LDS_BYTES) != hipSuccess || per_cu < 1) fprintf(stderr, "kernel_launch: occupancy query reports %d\n", per_cu);
        (void)hipGetLastError();
        ok = 1;
    }
    if (ok < 0) return;
    (void)hipMemsetAsync((char*)d_ws + WS_CTL, 0, CTL_ZERO_BYTES, stream);
    Args a{};
    for (int i = 0; i < 13; ++i) a.in[i] = (const float*)d_in[i];
    a.out = (float*)d_out; a.ws = (unsigned char*)d_ws;
#if MK_PER_PHASE
    for (int p = 0; p < NPH; ++p) { a.ph_lo = p; a.ph_hi = p + 1; hipLaunchKernelGGL(mk_fwd, dim3(GRID), dim3(NWAVES * 64), LDS_BYTES, stream, a); }
#else
    a.ph_lo = 0; a.ph_hi = NPH;
    hipLaunchKernelGGL(mk_fwd, dim3(GRID), dim3(NWAVES * 64), LDS_BYTES, stream, a);
#endif
    const hipError_t le = hipPeekAtLastError();
    if (le != hipSuccess) fprintf(stderr, "kernel_launch: launch failed: %s\n", hipGetErrorName(le));
}
```

```cpp
#include <hip/hip_runtime.h>
#include <hip/hip_bf16.h>
#include <cstdio>
#include <cstdint>

constexpr int NB = 4, SEQ = 4096, DM = 1024, T = NB * SEQ;
constexpr int EVEN_IN = 9216, ODD_IN = 4608, DIN = 2048;
constexpr float EPS = 1e-6f;
constexpr float C2 = 0.125f * 1.4426950408889634f;
constexpr float LOG2E = 1.4426950408889634f;

namespace pg8 {
#define PG8_LAS __attribute__((address_space(3)))
typedef unsigned short bf16_t;
typedef short bf16x8 __attribute__((ext_vector_type(8)));
typedef float f32x4 __attribute__((ext_vector_type(4)));
typedef unsigned u32x4 __attribute__((ext_vector_type(4)));
constexpr int BM = 256, BK = 64, HALF = 128, HTB = HALF * BK * 2, STAGE_BYTES = 8 * HTB, NXCD = 8, WGM = 4;
constexpr int EPI_STG_OFF = 139264, EPI_STG_RS = 144, EPI_STG_WAVE = 16 * EPI_STG_RS;

__host__ __device__ __forceinline__ int lds_byte(int r, int c) { const int st = (r >> 4) * 2 + (c >> 5), rr = r & 15, cc = c & 31, ob = rr * 64 + cc * 2; return st * 1024 + (ob ^ (((ob >> 9) & 1) << 5)); }
__host__ __device__ __forceinline__ void stage_rc(int b, int& R, int& C) { const int st = b / 1024, sb = b % 1024, swz = sb ^ (((sb >> 9) & 1) << 5); R = (st >> 1) * 16 + swz / 64; C = (st & 1) * 32 + (swz % 64) / 2; }
__host__ __device__ __forceinline__ int perm32(int rho) { const int n = rho >> 4, i = rho & 15; return 8 * (i >> 2) + 4 * n + (i & 3); }

struct Unit { int pm, pn; };
struct Gemm { const bf16_t* A; const bf16_t* Bt; int M, N, K, lda, ksplit; long jump; };

struct StaticOrder {
    int nM, nN, nwg, G, c;
    __host__ __device__ void init(int M, int N, int G_, int c_) { nM = M / BM; nN = N / BM; nwg = nM * nN; G = G_; c = c_; }
    __host__ __device__ bool next(int i, Unit& u) const {
        const long L = (long)i * G + c; if (L >= nwg) return false;
        int wgid = (int)L; { const int q = nwg / NXCD, r = nwg % NXCD, xcd = wgid % NXCD, off = wgid / NXCD; wgid = (xcd < r ? xcd * (q + 1) : r * (q + 1) + (xcd - r) * q) + off; }
        const int nig = WGM * nN, gid = wgid / nig, fm = gid * WGM, gsz = (nM - fm) < WGM ? (nM - fm) : WGM;
        u.pm = fm + ((wgid % nig) % gsz); u.pn = (wgid % nig) / gsz; return true;
    }
};

__device__ __forceinline__ unsigned cvt_pk_bf16(float lo, float hi) { unsigned r; asm volatile("v_cvt_pk_bf16_f32 %0, %1, %2" : "=v"(r) : "v"(lo), "v"(hi)); return r; }

template <class Epi>
__device__ __forceinline__ void gemm_phase(PG8_LAS unsigned char* lds, const Gemm g, const StaticOrder& S, const Epi& E) {
    int tid = threadIdx.x; asm volatile("" : "+v"(tid));
    const int wid = __builtin_amdgcn_readfirstlane(tid >> 6), lane = tid & 63, wr = wid >> 2, wc = wid & 3, fr = lane & 15, fq = lane >> 4;
    const int K = g.K, nt = K / BK, lda = g.lda;
    unsigned voffA[2], voffB[2];
#pragma unroll
    for (int i = 0; i < 2; ++i) { int R, C; stage_rc(tid * 16 + i * 8192, R, C); const int Rb = 64 * (R >> 5) + perm32(R & 31);
        voffA[i] = (unsigned)(R * lda + C) * 2u; voffB[i] = (unsigned)(Rb * K + C) * 2u; }
    const size_t kstep = (size_t)(BK * 2);
    const size_t hstepA = (size_t)HALF * lda * 2, tstepA = 2 * hstepA;
    const size_t hstepB = (size_t)32 * K * 2, tstepB = (size_t)BM * K * 2;
    const unsigned ldsw = (unsigned)wid * 1024u;
    const int aoff = lds_byte(wr * 64 + fr, fq * 8), boff = lds_byte(wc * 32 + fr, fq * 8);
    const int ksplit = g.ksplit; const long jump = g.jump;
#define PG8_AP(base, t) ((base) + (size_t)(t) * kstep + (((t) >= ksplit) ? jump : 0l))
#define PG8_SA(b, h) (((b) * 2 + (h)) * HTB)
#define PG8_SB(b, h) ((4 + (b) * 2 + (h)) * HTB)
#define PG8_STAGE(bufoff, gbase, voff) do { _Pragma("unroll") for (int _i = 0; _i < 2; ++_i) \
        __builtin_amdgcn_global_load_lds((const unsigned*)((const char*)(gbase) + (voff)[_i]), (PG8_LAS unsigned*)(lds + (bufoff) + ldsw + _i * 8192), 16, 0, 0); } while (0)
#define PG8_LDA(dst, b, h) do { _Pragma("unroll") for (int m = 0; m < 4; ++m) _Pragma("unroll") for (int k = 0; k < 2; ++k) dst[m][k] = *(const PG8_LAS bf16x8*)(lds + PG8_SA(b, h) + aoff + m * 2048 + k * 1024); } while (0)
#define PG8_LDB(dst, b, h) do { _Pragma("unroll") for (int n = 0; n < 2; ++n) _Pragma("unroll") for (int k = 0; k < 2; ++k) dst[n][k] = *(const PG8_LAS bf16x8*)(lds + PG8_SB(b, h) + boff + n * 2048 + k * 1024); } while (0)
#define PG8_MMA(ai, bj, At, Bt) do { __builtin_amdgcn_s_setprio(1); _Pragma("unroll") for (int m = 0; m < 4; ++m) _Pragma("unroll") for (int n = 0; n < 2; ++n) _Pragma("unroll") for (int k = 0; k < 2; ++k) \
        acc[ai][bj][m][n] = __builtin_amdgcn_mfma_f32_16x16x32_bf16(Bt[n][k], At[m][k], acc[ai][bj][m][n], 0, 0, 0); __builtin_amdgcn_s_setprio(0); } while (0)
#define PG8_WAIT_V(n) asm volatile("s_waitcnt vmcnt(" #n ")" ::: "memory")
#define PG8_WAIT_L(n) asm volatile("s_waitcnt lgkmcnt(" #n ")" ::: "memory")
#define PG8_BAR __builtin_amdgcn_s_barrier()
#define PG8_SCHED __builtin_amdgcn_sched_barrier(0)
    Unit cur, nxt; int ui = 0;
    if (!S.next(0, cur)) return;
    f32x4 acc[2][2][4][2];
#pragma unroll
    for (int a = 0; a < 2; ++a)
#pragma unroll
        for (int b = 0; b < 2; ++b)
#pragma unroll
            for (int m = 0; m < 4; ++m)
#pragma unroll
                for (int n = 0; n < 2; ++n) acc[a][b][m][n] = (f32x4){0.f, 0.f, 0.f, 0.f};
    bf16x8 At[4][2], B0[2][2], B1[2][2];
    const char* cA = (const char*)g.A + (size_t)cur.pm * tstepA; const char* cB = (const char*)g.Bt + (size_t)cur.pn * tstepB;
    {
        PG8_STAGE(PG8_SB(0, 0), cB, voffB); PG8_STAGE(PG8_SB(0, 1), cB + hstepB, voffB); PG8_STAGE(PG8_SA(0, 0), cA, voffA); PG8_STAGE(PG8_SA(0, 1), cA + hstepA, voffA);
        if (wr == 1) PG8_BAR;
        PG8_WAIT_V(2); PG8_BAR;
        PG8_STAGE(PG8_SB(1, 0), cB + kstep, voffB); PG8_STAGE(PG8_SA(1, 0), PG8_AP(cA, 1), voffA); PG8_STAGE(PG8_SB(1, 1), cB + hstepB + kstep, voffB);
        PG8_WAIT_V(6); PG8_BAR;
    }
    for (;;) {
        const bool has_next = S.next(ui + 1, nxt);
        const char* nA = has_next ? (const char*)g.A + (size_t)nxt.pm * tstepA : cA; const char* nB = has_next ? (const char*)g.Bt + (size_t)nxt.pn * tstepB : cB;
        for (int t = 0; t < nt; t += 2) {
            const bool last = (t == nt - 2);
            const char* a1 = PG8_AP(cA, t + 1);
            const char* a2 = last ? nA : PG8_AP(cA, t + 2); const char* b2 = last ? nB : cB + (size_t)(t + 2) * kstep;
            const char* a3 = a2 + kstep; const char* b3 = b2 + kstep;
            PG8_LDB(B0, 0, 0); PG8_LDB(B1, 0, 1); PG8_SCHED; PG8_LDA(At, 0, 0); PG8_STAGE(PG8_SA(1, 1), a1 + hstepA, voffA);
            PG8_WAIT_V(8); PG8_WAIT_L(0); PG8_BAR; PG8_MMA(0, 0, At, B0); PG8_MMA(0, 1, At, B1); PG8_BAR; PG8_SCHED;
            PG8_LDA(At, 0, 1); PG8_STAGE(PG8_SB(0, 0), b2, voffB); PG8_STAGE(PG8_SB(0, 1), b2 + hstepB, voffB); PG8_STAGE(PG8_SA(0, 0), a2, voffA);
            PG8_WAIT_V(8); PG8_WAIT_L(0); PG8_BAR; PG8_MMA(1, 0, At, B0); PG8_MMA(1, 1, At, B1); PG8_BAR; PG8_SCHED;
            PG8_LDB(B0, 1, 0); PG8_LDB(B1, 1, 1); PG8_SCHED; PG8_LDA(At, 1, 0); PG8_STAGE(PG8_SA(0, 1), a2 + hstepA, voffA);
            PG8_WAIT_V(8); PG8_WAIT_L(0); PG8_BAR; PG8_MMA(0, 0, At, B0); PG8_MMA(0, 1, At, B1); PG8_BAR; PG8_SCHED;
            PG8_LDA(At, 1, 1); PG8_STAGE(PG8_SB(1, 0), b3, voffB); PG8_STAGE(PG8_SB(1, 1), b3 + hstepB, voffB); PG8_STAGE(PG8_SA(1, 0), a3, voffA);
            PG8_WAIT_V(8); PG8_WAIT_L(0); PG8_BAR; PG8_MMA(1, 0, At, B0); PG8_MMA(1, 1, At, B1); PG8_BAR; PG8_SCHED;
        }
        if (wr == 0) PG8_BAR;
        E(acc, cur, wr, wc, fr, fq, lds + EPI_STG_OFF + wid * EPI_STG_WAVE, lane);
        if (!has_next) break;
#pragma unroll
        for (int a = 0; a < 2; ++a)
#pragma unroll
            for (int b = 0; b < 2; ++b)
#pragma unroll
                for (int m = 0; m < 4; ++m)
#pragma unroll
                    for (int n = 0; n < 2; ++n) acc[a][b][m][n] = (f32x4){0.f, 0.f, 0.f, 0.f};
        cur = nxt; cA = nA; cB = nB; ++ui;
        if (wr == 1) PG8_BAR;
    }
    PG8_WAIT_V(0);
    PG8_BAR;
#undef PG8_AP
#undef PG8_SA
#undef PG8_SB
#undef PG8_STAGE
#undef PG8_LDA
#undef PG8_LDB
#undef PG8_MMA
#undef PG8_WAIT_V
#undef PG8_WAIT_L
#undef PG8_BAR
#undef PG8_SCHED
}
}
namespace pg8 {
typedef unsigned short u16;
__device__ __forceinline__ float fsigmoid(float v) { return __builtin_amdgcn_rcpf(1.0f + __expf(-v)); }
__device__ __forceinline__ unsigned pk_f16(float lo, float hi) { _Float16 a = (_Float16)lo, b = (_Float16)hi; return (unsigned)__builtin_bit_cast(unsigned short, a) | ((unsigned)__builtin_bit_cast(unsigned short, b) << 16); }


__device__ __forceinline__ void store_rows128(PG8_LAS unsigned char* stg, u16* blk  , size_t pitch, u32x4 w0, u32x4 w1, int fr, int fq, int lane) {
    *(PG8_LAS u32x4*)(stg + fr * EPI_STG_RS + fq * 16) = w0; *(PG8_LAS u32x4*)(stg + fr * EPI_STG_RS + 64 + fq * 16) = w1;
    const int rr = lane >> 3, ch = lane & 7;
    const u32x4 a = *(const PG8_LAS u32x4*)(stg + rr * EPI_STG_RS + ch * 16), b = *(const PG8_LAS u32x4*)(stg + (8 + rr) * EPI_STG_RS + ch * 16);
    *(u32x4*)(blk + (size_t)rr * pitch + ch * 8) = a; *(u32x4*)(blk + (size_t)(8 + rr) * pitch + ch * 8) = b;
}

__device__ __forceinline__ float bf_lo(unsigned w) { return __uint_as_float(w << 16); }
__device__ __forceinline__ float bf_hi(unsigned w) { return __uint_as_float(w & 0xffff0000u); }
enum { K_PLAIN = 0, K_SILU = 1, K_ROPEQ = 2, K_ROPEK = 3, K_LOGF = 4, K_ROPEQN = 5 };

template <bool EVEN, int MODE = 0> struct EpiIn {
    static constexpr bool PERM = true;
    const float* ssq;
    const float* rope;
    const float* lb;
    unsigned char* r0; unsigned char* r1; unsigned char* r2; unsigned char* r3; unsigned char* r4; unsigned char* r5;
    int pn_off;
    unsigned* qmx = nullptr;
    unsigned* kmx = nullptr;
    __device__ __forceinline__ void operator()(const f32x4 (&acc)[2][2][4][2], const Unit& u, int wr, int wc, int fr, int fq, PG8_LAS unsigned char* stg, int lane) const {
        const int gpn = u.pn + pn_off;
        int kind, pitch, colt, dir = 0; u16* outp;
        if (EVEN) {
            const int grp = gpn >> 2; colt = (gpn & 3) * 256; pitch = 1024;
            switch (grp) {
                case 0: kind = K_ROPEQ; outp = (u16*)r0; break;
                case 1: kind = K_ROPEK; outp = (u16*)r1; break;
                case 2: kind = K_PLAIN; outp = (u16*)r2; break;
                case 3: kind = K_SILU;  outp = (u16*)r3; break;
                case 4: kind = K_SILU;  outp = (u16*)r1; break;
                case 5: kind = K_LOGF;  outp = (u16*)r4; dir = 0; break;
                case 6: kind = K_LOGF;  outp = (u16*)r5; dir = 1; break;
                case 7: kind = K_PLAIN; outp = (u16*)r2; break;
                default: kind = K_SILU; outp = (u16*)r3; break;
            }
        } else {
            if (gpn < 8)       { kind = K_ROPEQN; outp = (u16*)r0; pitch = 2048; colt = gpn * 256; }
            else if (gpn == 8) { kind = K_ROPEK; outp = (u16*)r2; pitch = 256;  colt = 0; }
            else if (gpn == 9) { kind = K_PLAIN; outp = (u16*)(r2 + (size_t)T * 256 * 2); pitch = 256; colt = 0; }
            else               { kind = K_SILU;  outp = (u16*)r3; pitch = 2048; colt = (gpn - 10) * 256; }
        }
        int row0 = u.pm * BM + wr * 64 + fr; asm volatile("" : "+v"(row0));
        if (MODE == 2) kind = K_PLAIN;
        float rsv[8];
#pragma unroll
        for (int hb = 0; hb < 2; ++hb) { f32x4 sq[4];
#pragma unroll
          for (int i = 0; i < 4; ++i) sq[i] = *((const f32x4*)(ssq + (size_t)(row0 + hb * HALF + i * 16) * 16) + fq);
#pragma unroll
          for (int i = 0; i < 4; ++i) { float tot = (sq[i][0] + sq[i][1]) + (sq[i][2] + sq[i][3]); tot += __shfl_xor(tot, 16); tot += __shfl_xor(tot, 32); rsv[hb * 4 + i] = __builtin_amdgcn_rsqf(tot * (1.0f / DM) + EPS); }
          asm volatile("" ::: "memory"); }
        u16* const blk0 = outp + (size_t)(row0 - fr) * pitch + colt + wc * 64;
        if (kind == K_LOGF)        rows<K_LOGF>(acc, rsv, blk0, pitch, colt + wc * 64, dir, row0, 1.0f, fr, fq, stg, lane);
        else if (kind == K_SILU)   rows<K_SILU>(acc, rsv, blk0, pitch, 0, 0, row0, 1.0f, fr, fq, stg, lane);
        else if (kind == K_PLAIN)  rows<K_PLAIN>(acc, rsv, blk0, pitch, 0, 0, row0, 1.0f, fr, fq, stg, lane);
        else if (kind == K_ROPEK)  rows<K_ROPEK>(acc, rsv, blk0, pitch, colt + wc * 64, 0, row0, 1.0f, fr, fq, stg, lane);
        else if (kind == K_ROPEQN) rows<K_ROPEQN>(acc, rsv, blk0, pitch, colt + wc * 64, 0, row0, C2, fr, fq, stg, lane);
        else                       rows<K_ROPEQ>(acc, rsv, blk0, pitch, 0, 0, row0, (kind == K_ROPEQ) ? C2 : 1.0f, fr, fq, stg, lane);
    }
    template <int KIND>
    __device__ __forceinline__ void rows(const f32x4 (&acc)[2][2][4][2], const float (&rsv)[8], u16* blk0, int pitch, int ccol, int dir, int row0, float qs, int fr, int fq, PG8_LAS unsigned char* stg, int lane) const {
        f32x4 lbv[2][2];
        if (KIND == K_LOGF) {
#pragma unroll
            for (int bj = 0; bj < 2; ++bj) { const int c0 = ccol + bj * 32 + 8 * fq; lbv[bj][0] = *(const f32x4*)(lb + dir * 1024 + c0); lbv[bj][1] = *(const f32x4*)(lb + dir * 1024 + c0 + 4); }
        }
        f32x4 cs0, cs1, sn0, sn1, ncs0, ncs1, nsn0, nsn1;
        constexpr bool ROPE = (KIND == K_ROPEQ || KIND == K_ROPEK || KIND == K_ROPEQN), NORMX = (KIND == K_ROPEK || KIND == K_ROPEQN); float kn2 = 0.f;
        if (ROPE) { const int pos = row0 & (SEQ - 1); const f32x4* cp = (const f32x4*)(rope + (size_t)pos * 8); const f32x4* spn = (const f32x4*)(rope + (size_t)SEQ * 8 + (size_t)pos * 8);
            ncs0 = cp[0]; ncs1 = cp[1]; nsn0 = spn[0]; nsn1 = spn[1]; }
#pragma unroll
        for (int ai = 0; ai < 2; ++ai)
#pragma unroll
            for (int m = 0; m < 4; ++m) {
                const float rs = rsv[ai * 4 + m];
                if (ROPE) { cs0 = ncs0; cs1 = ncs1; sn0 = nsn0; sn1 = nsn1;
                    if (ai * 4 + m < 7) { const int i2 = ai * 4 + m + 1; const int pos = (row0 + (i2 >> 2) * HALF + (i2 & 3) * 16) & (SEQ - 1);
                        const f32x4* cp = (const f32x4*)(rope + (size_t)pos * 8); const f32x4* spn = (const f32x4*)(rope + (size_t)SEQ * 8 + (size_t)pos * 8);
                        ncs0 = cp[0]; ncs1 = cp[1]; nsn0 = spn[0]; nsn1 = spn[1]; } }
                u32x4 wst[2];
#pragma unroll
                for (int bj = 0; bj < 2; ++bj) {
                    f32x4 v0 = acc[ai][bj][m][0] * rs, v1 = acc[ai][bj][m][1] * rs;
                    u32x4 w;
                    if (KIND == K_LOGF) {
                        const f32x4 l0 = lbv[bj][0], l1 = lbv[bj][1];
                        float o[8];
#pragma unroll
                        for (int e = 0; e < 4; ++e) { const float f0 = l0[e] + (1.0f - l0[e]) * fsigmoid(v0[e]), f1 = l1[e] + (1.0f - l1[e]) * fsigmoid(v1[e]);
                            o[e] = fmaxf(__builtin_amdgcn_logf(f0), -43.2808512f); o[4 + e] = fmaxf(__builtin_amdgcn_logf(f1), -43.2808512f); }
                        w.x = pk_f16(o[0], o[1]); w.y = pk_f16(o[2], o[3]); w.z = pk_f16(o[4], o[5]); w.w = pk_f16(o[6], o[7]);
                    } else {
                        if (KIND == K_SILU) {
#pragma unroll
                            for (int e = 0; e < 4; ++e) { v0[e] = v0[e] * fsigmoid(v0[e]); v1[e] = v1[e] * fsigmoid(v1[e]); }
                        } else if (ROPE && bj == 0) {
                            f32x4 o0, o1;
#pragma unroll
                            for (int e = 0; e < 4; ++e) { o0[e] = __shfl_xor(v0[e], 16); o1[e] = __shfl_xor(v1[e], 16); }
                            if (fq < 2) {
                                const float sg = (fq == 0) ? -1.0f : 1.0f;
                                v0 = v0 * cs0 + (o0 * sn0) * sg; v1 = v1 * cs1 + (o1 * sn1) * sg;
                            }
                        }
                        if (KIND == K_ROPEQ || KIND == K_ROPEQN) { v0 = v0 * qs; v1 = v1 * qs; }
                        w.x = cvt_pk_bf16(v0[0], v0[1]); w.y = cvt_pk_bf16(v0[2], v0[3]); w.z = cvt_pk_bf16(v1[0], v1[1]); w.w = cvt_pk_bf16(v1[2], v1[3]);
                    }
                    wst[bj] = w;
                }
                if (NORMX) {
                    float n2 = 0.f;
#pragma unroll
                    for (int bj = 0; bj < 2; ++bj) { const u32x4 w = wst[bj]; const float a0 = bf_lo(w.x), a1 = bf_hi(w.x), a2 = bf_lo(w.y), a3 = bf_hi(w.y), a4 = bf_lo(w.z), a5 = bf_hi(w.z), a6 = bf_lo(w.w), a7 = bf_hi(w.w);
                        n2 += (a0 * a0 + a1 * a1) + (a2 * a2 + a3 * a3) + (a4 * a4 + a5 * a5) + (a6 * a6 + a7 * a7); }
                    n2 += __shfl_xor(n2, 16); n2 += __shfl_xor(n2, 32); kn2 = fmaxf(kn2, n2);
                }
                if (MODE != 1) store_rows128(stg, blk0 + (size_t)(ai * HALF + m * 16) * pitch, (size_t)pitch, wst[0], wst[1], fr, fq, lane); else asm volatile("" :: "v"(wst[0]), "v"(wst[1]));
            }
        if (NORMX) {
            int ln; asm volatile("v_mbcnt_lo_u32_b32 %0, -1, 0\n\tv_mbcnt_hi_u32_b32 %0, -1, %0" : "=v"(ln));
#pragma unroll
            for (int o = 1; o < 16; o <<= 1) kn2 = fmaxf(kn2, __uint_as_float(__builtin_amdgcn_ds_bpermute((ln ^ o) << 2, __float_as_uint(kn2))));
            if (ln == 0) __hip_atomic_fetch_max((KIND == K_ROPEK) ? kmx + (row0 / SEQ) * 16 + (ccol >> 6) : qmx + (row0 / SEQ) * 32 + (ccol >> 6), __float_as_uint(kn2), __ATOMIC_RELAXED, __HIP_MEMORY_SCOPE_AGENT);
        }
    }
};

template <bool FIRST, bool LAST> struct EpiOut {
    static constexpr bool PERM = true;
    const float* xin; float* xout; u16* xb; float* ssq;
    __device__ __forceinline__ void operator()(const f32x4 (&acc)[2][2][4][2], const Unit& u, int wr, int wc, int fr, int fq, PG8_LAS unsigned char* stg, int lane) const {
        int row0 = u.pm * BM + wr * 64 + fr; asm volatile("" : "+v"(row0));
        const int cb = u.pn * BM + wc * 64 + 8 * fq;
        f32x4 nx[2][2];
#define LOADX(dst, rw) do { _Pragma("unroll") for (int bj = 0; bj < 2; ++bj) { const size_t off = (size_t)(rw) * DM + cb + bj * 32; \
            if (FIRST) { dst[bj][0] = *(const f32x4*)(xin + off); dst[bj][1] = *(const f32x4*)(xin + off + 4); } \
            else { const u32x4 w = *(const u32x4*)(xb + off); dst[bj][0] = (f32x4){bf_lo(w.x), bf_hi(w.x), bf_lo(w.y), bf_hi(w.y)}; dst[bj][1] = (f32x4){bf_lo(w.z), bf_hi(w.z), bf_lo(w.w), bf_hi(w.w)}; } } } while (0)
        LOADX(nx, row0);
#pragma unroll
        for (int ai = 0; ai < 2; ++ai)
#pragma unroll
            for (int m = 0; m < 4; ++m) {
                const int row = row0 + ai * HALF + m * 16; float part = 0.f; u32x4 wst[2];
                f32x4 ox[2][2];
#pragma unroll
                for (int bj = 0; bj < 2; ++bj) { ox[bj][0] = nx[bj][0]; ox[bj][1] = nx[bj][1]; }
                if (ai * 4 + m < 7) { const int i2 = ai * 4 + m + 1; LOADX(nx, row0 + (i2 >> 2) * HALF + (i2 & 3) * 16); }
#pragma unroll
                for (int bj = 0; bj < 2; ++bj) {
                    const size_t off = (size_t)row * DM + cb + bj * 32;
                    const f32x4 n0 = ox[bj][0] + acc[ai][bj][m][0], n1 = ox[bj][1] + acc[ai][bj][m][1];
                    if (LAST) { *(f32x4*)(xout + off) = n0; *(f32x4*)(xout + off + 4) = n1; }
                    else {
                        u32x4 w; w.x = cvt_pk_bf16(n0[0], n0[1]); w.y = cvt_pk_bf16(n0[2], n0[3]); w.z = cvt_pk_bf16(n1[0], n1[1]); w.w = cvt_pk_bf16(n1[2], n1[3]);
                        wst[bj] = w;
                        const f32x4 r0 = (f32x4){bf_lo(w.x), bf_hi(w.x), bf_lo(w.y), bf_hi(w.y)}, r1 = (f32x4){bf_lo(w.z), bf_hi(w.z), bf_lo(w.w), bf_hi(w.w)};
                        part += (r0[0] * r0[0] + r0[1] * r0[1]) + (r0[2] * r0[2] + r0[3] * r0[3]) + (r1[0] * r1[0] + r1[1] * r1[1]) + (r1[2] * r1[2] + r1[3] * r1[3]);
                    }
                }
                if (!LAST) { part += __shfl_xor(part, 16); part += __shfl_xor(part, 32);
                    if (fq == 0) ssq[(size_t)row * 16 + u.pn * 4 + wc] = part;
                    store_rows128(stg, xb + (size_t)(row - fr) * DM + u.pn * BM + wc * 64, (size_t)DM, wst[0], wst[1], fr, fq, lane); }
            }
#undef LOADX
    }
};
struct EpiDry {
    static constexpr bool PERM = true;
    __device__ __forceinline__ void operator()(const f32x4 (&acc)[2][2][4][2], const Unit&, int, int, int, int, PG8_LAS unsigned char*, int) const {
#pragma unroll
        for (int a = 0; a < 2; ++a)
#pragma unroll
            for (int b = 0; b < 2; ++b)
#pragma unroll
                for (int m = 0; m < 4; ++m) asm volatile("" :: "v"(acc[a][b][m][0]), "v"(acc[a][b][m][1]));
    }
};
}
namespace att {
typedef unsigned short u16;
using bf16x8 = __attribute__((ext_vector_type(8))) short;
using s16x4  = __attribute__((ext_vector_type(4))) short;
using f32x16 = __attribute__((ext_vector_type(16))) float;
using f32x4  = __attribute__((ext_vector_type(4))) float;
using u32x4  = __attribute__((ext_vector_type(4))) unsigned;
#define KSWZ(row, colB) ((row) * 256 + ((colB) ^ (((row) & 7) << 4)))
#define KSWZ128(row, colB) ((row) * 128 + ((colB) ^ (((row) & 7) << 4)))
#define SBAR() __builtin_amdgcn_sched_barrier(0)
constexpr float THRL = 8.0f;
__device__ __forceinline__ int crow(int r, int hi) { return (r & 3) + 8 * (r >> 2) + 4 * hi; }
__device__ __forceinline__ unsigned cvtpk(float lo, float hi) { unsigned r; asm volatile("v_cvt_pk_bf16_f32 %0, %1, %2" : "=v"(r) : "v"(lo), "v"(hi)); return r; }
__device__ __forceinline__ bf16x8 ld8(const u16* p) { return *reinterpret_cast<const bf16x8*>(p); }
__device__ __forceinline__ float bf2f(unsigned short h) { return __uint_as_float((unsigned)h << 16); }

__device__ __forceinline__ void partialSM(f32x16& p0, f32x16& p1, float& m_reg, float& alpha) {
    float pmax = p0[0];
#pragma unroll
    for (int r = 1; r < 16; ++r) pmax = fmaxf(pmax, p0[r]);
#pragma unroll
    for (int r = 0; r < 16; ++r) pmax = fmaxf(pmax, p1[r]);
    { auto rr = __builtin_amdgcn_permlane32_swap(__float_as_uint(pmax), __float_as_uint(pmax), false, false);
      pmax = fmaxf(__uint_as_float(rr[0]), __uint_as_float(rr[1])); }
    float mn;
    if (__builtin_expect(__all(pmax - m_reg <= THRL), 1)) { mn = m_reg; alpha = 1.f; }
    else { mn = fmaxf(m_reg, pmax); alpha = __builtin_amdgcn_exp2f(m_reg - mn); m_reg = mn; }
#pragma unroll
    for (int r = 0; r < 16; ++r) { p0[r] -= mn; p1[r] -= mn; }
#pragma unroll
    for (int r = 0; r < 16; ++r) p0[r] = __builtin_amdgcn_exp2f(p0[r]);
}
__device__ __forceinline__ void finishSM(f32x16& p0, f32x16& p1, float alpha, float& l_reg, bf16x8& pa0, bf16x8& pa1, bf16x8& pa2, bf16x8& pa3) {
#pragma unroll
    for (int r = 0; r < 16; ++r) p1[r] = __builtin_amdgcn_exp2f(p1[r]);
    float ps = 0;
#pragma unroll
    for (int r = 0; r < 16; ++r) ps += p0[r];
#pragma unroll
    for (int r = 0; r < 16; ++r) ps += p1[r];
    { auto rr = __builtin_amdgcn_permlane32_swap(__float_as_uint(ps), __float_as_uint(ps), false, false);
      ps = __uint_as_float(rr[0]) + __uint_as_float(rr[1]); }
    l_reg = l_reg * alpha + ps;
#define PK4(P, BASE, OUT) do { unsigned a0 = cvtpk(P[BASE + 0], P[BASE + 1]), a1 = cvtpk(P[BASE + 2], P[BASE + 3]);   \
    unsigned b0 = cvtpk(P[BASE + 4], P[BASE + 5]), b1 = cvtpk(P[BASE + 6], P[BASE + 7]);                              \
    auto r0 = __builtin_amdgcn_permlane32_swap(a0, b0, false, false); auto r1 = __builtin_amdgcn_permlane32_swap(a1, b1, false, false); \
    u32x4 w = {r0[0], r1[0], r0[1], r1[1]}; OUT = *reinterpret_cast<bf16x8*>(&w); } while (0)
    PK4(p0, 0, pa0); PK4(p0, 8, pa1); PK4(p1, 0, pa2); PK4(p1, 8, pa3);
}
__device__ __forceinline__ void pack4(const f32x16& p0, const f32x16& p1, bf16x8& pa0, bf16x8& pa1, bf16x8& pa2, bf16x8& pa3) {
    PK4(p0, 0, pa0); PK4(p0, 8, pa1); PK4(p1, 0, pa2); PK4(p1, 8, pa3);
}
#undef PK4

template <int NCB> __device__ __forceinline__ int v_st(int k, int c) { const int kk = (k & ~0xC) | ((k & 4) << 1) | ((k & 8) >> 1); return ((kk >> 3) * NCB + (c >> 5)) * 512 + ((kk & 7) * 32 + (c & 31)) * 2; }
__device__ __forceinline__ int v_rd_base(int lane) { return ((lane & 3) << 3) | (((lane >> 2) & 3) << 6) | (((lane >> 4) & 1) << 5) | (((lane >> 5) & 1) << 8); }
template <int OFF> __device__ __forceinline__ s16x4 tr_read(int vb) { s16x4 r; asm volatile("ds_read_b64_tr_b16 %0, %1 offset:%2" : "=&v"(r) : "v"(vb), "i"(OFF) : "memory"); return r; }
#define PKF(L, H) (bf16x8){L[0], L[1], L[2], L[3], H[0], H[1], H[2], H[3]}
template <int NCB> __device__ __forceinline__ void pv_blk(f32x16& od, int vb, bf16x8 pa0, bf16x8 pa1, bf16x8 pa2, bf16x8 pa3) {
    constexpr int KS = NCB * 1024, HF = NCB * 512;
    const s16x4 l0 = tr_read<0 * KS>(vb), h0 = tr_read<0 * KS + HF>(vb), l1 = tr_read<1 * KS>(vb), h1 = tr_read<1 * KS + HF>(vb);
    const s16x4 l2 = tr_read<2 * KS>(vb), h2 = tr_read<2 * KS + HF>(vb), l3 = tr_read<3 * KS>(vb), h3 = tr_read<3 * KS + HF>(vb);
    asm volatile("s_waitcnt lgkmcnt(0)" ::: "memory"); SBAR();
    od = __builtin_amdgcn_mfma_f32_32x32x16_bf16(pa0, PKF(l0, h0), od, 0, 0, 0);
    od = __builtin_amdgcn_mfma_f32_32x32x16_bf16(pa1, PKF(l1, h1), od, 0, 0, 0);
    od = __builtin_amdgcn_mfma_f32_32x32x16_bf16(pa2, PKF(l2, h2), od, 0, 0, 0);
    od = __builtin_amdgcn_mfma_f32_32x32x16_bf16(pa3, PKF(l3, h3), od, 0, 0, 0);
}


template <int NCB> __device__ __forceinline__ int v_stn(int k, int c) { return ((k >> 3) * NCB + (c >> 5)) * 512 + ((k & 7) * 32 + (c & 31)) * 2; }
__device__ __forceinline__ float max3f(float a, float b, float c) { return fmaxf(fmaxf(a, b), c); }
__device__ __forceinline__ void fill16(f32x16& v, float x) {
#pragma unroll
    for (int r = 0; r < 16; ++r) v[r] = x;
}
template <bool FIRST>
__device__ __forceinline__ void partialSM_n(f32x16& p0, f32x16& p1, float& m_reg, f32x16& negm, float& alpha) {
    float a = max3f(p0[0], p0[1], p0[2]), b = max3f(p0[3], p0[4], p0[5]), c = max3f(p1[0], p1[1], p1[2]), d = max3f(p1[3], p1[4], p1[5]);
    a = max3f(a, p0[6], p0[7]); b = max3f(b, p0[8], p0[9]); c = max3f(c, p1[6], p1[7]); d = max3f(d, p1[8], p1[9]);
    a = max3f(a, p0[10], p0[11]); b = max3f(b, p0[12], p0[13]); c = max3f(c, p1[10], p1[11]); d = max3f(d, p1[12], p1[13]);
    a = max3f(a, p0[14], p0[15]); c = max3f(c, p1[14], p1[15]);
    float pmax = fmaxf(fmaxf(a, b), fmaxf(c, d));
    { auto rr = __builtin_amdgcn_permlane32_swap(__float_as_uint(pmax), __float_as_uint(pmax), false, false);
      pmax = fmaxf(__uint_as_float(rr[0]), __uint_as_float(rr[1])); }
    if (!FIRST && __builtin_expect(__all(pmax <= THRL), 1)) { alpha = 1.f; }
    else { const float dl = FIRST ? pmax : fmaxf(pmax, 0.f); m_reg += dl; alpha = FIRST ? 0.f : __builtin_amdgcn_exp2f(-dl);
#pragma unroll
        for (int r = 0; r < 16; ++r) { p0[r] -= dl; p1[r] -= dl; }
        fill16(negm, -m_reg); asm volatile("" : "+v"(negm)); }
#pragma unroll
    for (int r = 0; r < 16; ++r) p0[r] = __builtin_amdgcn_exp2f(p0[r]);
}
#define PKN(P, B) (u32x4){cvtpk(P[B + 0], P[B + 1]), cvtpk(P[B + 2], P[B + 3]), cvtpk(P[B + 4], P[B + 5]), cvtpk(P[B + 6], P[B + 7])}
template <bool SUM>
__device__ __forceinline__ void finishSM_n(f32x16& p0, f32x16& p1, float alpha, float& l_reg, bf16x8& pa0, bf16x8& pa1, bf16x8& pa2, bf16x8& pa3) {
#pragma unroll
    for (int r = 0; r < 16; ++r) p1[r] = __builtin_amdgcn_exp2f(p1[r]);
    if (SUM) {
        float s0 = (p0[0] + p0[1]) + (p0[2] + p0[3]), s1 = (p0[4] + p0[5]) + (p0[6] + p0[7]), s2 = (p0[8] + p0[9]) + (p0[10] + p0[11]), s3 = (p0[12] + p0[13]) + (p0[14] + p0[15]);
        float t0 = (p1[0] + p1[1]) + (p1[2] + p1[3]), t1 = (p1[4] + p1[5]) + (p1[6] + p1[7]), t2 = (p1[8] + p1[9]) + (p1[10] + p1[11]), t3 = (p1[12] + p1[13]) + (p1[14] + p1[15]);
        float ps = ((s0 + s1) + (s2 + s3)) + ((t0 + t1) + (t2 + t3));
        { auto rr = __builtin_amdgcn_permlane32_swap(__float_as_uint(ps), __float_as_uint(ps), false, false);
          ps = __uint_as_float(rr[0]) + __uint_as_float(rr[1]); }
        l_reg = l_reg * alpha + ps;
    }
    { u32x4 w = PKN(p0, 0); pa0 = *reinterpret_cast<bf16x8*>(&w); } { u32x4 w = PKN(p0, 8); pa1 = *reinterpret_cast<bf16x8*>(&w); }
    { u32x4 w = PKN(p1, 0); pa2 = *reinterpret_cast<bf16x8*>(&w); } { u32x4 w = PKN(p1, 8); pa3 = *reinterpret_cast<bf16x8*>(&w); }
}

__device__ __forceinline__ void qkt_da(f32x16& p0, f32x16& p1, const char* Ks, const bf16x8* qr, const f32x16& negm, int r32, int hi, int cb0) {
#pragma unroll
    for (int d0 = 0; d0 < 4; ++d0) { const int cb = cb0 + (d0 * 16 + hi * 8) * 2;
        const bf16x8 b0 = *reinterpret_cast<const bf16x8*>(Ks + KSWZ(r32, cb));
        const bf16x8 b1 = *reinterpret_cast<const bf16x8*>(Ks + KSWZ(32 + r32, cb));
        if (d0 == 0) { p0 = __builtin_amdgcn_mfma_f32_32x32x16_bf16(b0, qr[0], negm, 0, 0, 0); p1 = __builtin_amdgcn_mfma_f32_32x32x16_bf16(b1, qr[0], negm, 0, 0, 0); }
        else { p0 = __builtin_amdgcn_mfma_f32_32x32x16_bf16(b0, qr[d0], p0, 0, 0, 0); p1 = __builtin_amdgcn_mfma_f32_32x32x16_bf16(b1, qr[d0], p1, 0, 0, 0); } }
}
typedef short v4i16_t __attribute__((ext_vector_type(4)));
__device__ __forceinline__ s16x4 vtr(int addr) { return __builtin_bit_cast(s16x4, __builtin_amdgcn_ds_read_tr16_b64_v4i16((__attribute__((address_space(3))) v4i16_t*)(unsigned)addr)); }
__device__ __forceinline__ void pv_da(f32x16* o, int vb, bf16x8 pa0, bf16x8 pa1, bf16x8 pa2, bf16x8 pa3) {
    s16x4 lo[4], hi[4];
#define VADDR(i) (vb + ((i) & 3) * 512 + ((i) >> 2) * 4096)
#pragma unroll
    for (int i = 0; i < 4; ++i) { lo[i] = vtr(VADDR(i)); hi[i] = vtr(VADDR(i) + 2048); }
#pragma unroll
    for (int i = 0; i < 16; ++i) {
        const bf16x8 vf = PKF(lo[i & 3], hi[i & 3]);
        const bf16x8 pa = ((i >> 2) == 0) ? pa0 : ((i >> 2) == 1) ? pa1 : ((i >> 2) == 2) ? pa2 : pa3;
        o[i & 3] = __builtin_amdgcn_mfma_f32_32x32x16_bf16(pa, vf, o[i & 3], 0, 0, 0);
        if (i + 4 < 16) { lo[i & 3] = vtr(VADDR(i + 4)); hi[i & 3] = vtr(VADDR(i + 4) + 2048); }
    }
#undef VADDR
    __builtin_amdgcn_sched_group_barrier(0x100, 8, 0);
#pragma unroll
    for (int i = 0; i < 12; ++i) { __builtin_amdgcn_sched_group_barrier(0x008, 1, 0); __builtin_amdgcn_sched_group_barrier(0x100, 2, 0); __builtin_amdgcn_sched_group_barrier(0x002, 4, 0); }
#pragma unroll
    for (int i = 0; i < 4; ++i) { __builtin_amdgcn_sched_group_barrier(0x008, 1, 0); __builtin_amdgcn_sched_group_barrier(0x002, 4, 0); }
}
#define DA_PIN(x) asm volatile("" : "+v"(x))
#define DA_MFMA(a, b, c) __builtin_amdgcn_mfma_f32_32x32x16_bf16(a, b, c, 0, 0, 0)
#define DA_WAIT_BAR(N) asm volatile("s_waitcnt vmcnt(" #N ") lgkmcnt(0)\n\ts_barrier" ::: "memory")
__device__ __forceinline__ void glds16(const void* g, unsigned lds_base) {
    unsigned sv; asm volatile("s_mov_b32 %0, m0\n\ts_mov_b32 m0, %2\n\ts_nop 0\n\tglobal_load_lds_dwordx4 %1, off\n\ts_mov_b32 m0, %0" : "=&s"(sv) : "v"(g), "s"(lds_base) : "memory"); }
__device__ __forceinline__ bf16x8 kld(int addr) { return *(const __attribute__((address_space(3))) bf16x8*)(unsigned)addr; }
__device__ __forceinline__ float rowmax32(const f32x16& p0, const f32x16& p1) {
    float a = max3f(p0[0], p0[1], p0[2]), b = max3f(p0[3], p0[4], p0[5]), c = max3f(p1[0], p1[1], p1[2]), d = max3f(p1[3], p1[4], p1[5]);
    a = max3f(a, p0[6], p0[7]); b = max3f(b, p0[8], p0[9]); c = max3f(c, p1[6], p1[7]); d = max3f(d, p1[8], p1[9]);
    a = max3f(a, p0[10], p0[11]); b = max3f(b, p0[12], p0[13]); c = max3f(c, p1[10], p1[11]); d = max3f(d, p1[12], p1[13]);
    a = max3f(a, p0[14], p0[15]); c = max3f(c, p1[14], p1[15]);
    const float pmax = fmaxf(fmaxf(a, b), fmaxf(c, d));
    auto rr = __builtin_amdgcn_permlane32_swap(__float_as_uint(pmax), __float_as_uint(pmax), false, false);
    return fmaxf(__uint_as_float(rr[0]), __uint_as_float(rr[1]));
}
constexpr int DA_KSL = 16384, DA_VRING = 49152, DA_WS = 133120, DA_STG = 65536, DA_STG_LD = 132;
template <bool DRY, int PVAR = 0>
__device__ __forceinline__ void diff_attn_unit(int b, int h, int qb, const u16* Qa, const u16* __restrict__ Ka, const u16* __restrict__ Va, const u16* __restrict__ Ga,
                                               u16* Y, const float* __restrict__ subw, float lam, float one_m_li, const unsigned* __restrict__ kmx, char* lds) {
    int tid = threadIdx.x; asm volatile("" : "+v"(tid)); const int lane = tid & 63, r32 = lane & 31, hi = lane >> 5; const int wid = __builtin_amdgcn_readfirstlane(tid >> 6);
    const int map = wid >> 2, wq = wid & 3;
    const long rowbase = (long)b * SEQ; const int q0 = qb * 128;
    float* wsf = (float*)(lds + DA_WS) + wid * 64; float* li_l = wsf; float* al_l = wsf + 32;
    float m_reg = 0.f, l_reg = 0; f32x16 o[4] = {}; bf16x8 qr[4]; f32x16 negm = f32x16{}; asm volatile("" : "+v"(negm));
    const unsigned lds0 = (unsigned)(uintptr_t)lds;
    const u16* Kh = Ka + rowbase * DM + h * 128; const u16* Vh = Va + rowbase * DM + h * 128;
    const int cb0 = map * 128;
    unsigned kofs[2], vofs[2];
#pragma unroll
    for (int i = 0; i < 2; ++i) { const int pk = 2 * wid + i;
        const int row = 4 * pk + (lane >> 4), cp = lane & 15; kofs[i] = (unsigned)(row * DM + ((cp ^ (row & 7)) * 8)) * 2u;
        const int st = 2 * pk + (lane >> 5), kk = 8 * (st >> 2) + ((lane & 31) >> 2), cc = 32 * (st & 3) + 8 * (lane & 3); vofs[i] = (unsigned)(kk * DM + cc) * 2u; }
    const char* Kg = (const char*)Kh; const char* Vg = (const char*)Vh;
#define DMA_K(t, slot) do { _Pragma("unroll") for (int i_ = 0; i_ < 2; ++i_) glds16(Kg + (size_t)(t) * (64 * DM * 2) + kofs[i_], (unsigned)__builtin_amdgcn_readfirstlane(lds0 + (slot) + (2 * wid + i_) * 1024)); } while (0)
#define DMA_V(t, slot) do { _Pragma("unroll") for (int i_ = 0; i_ < 2; ++i_) glds16(Vg + (size_t)(t) * (64 * DM * 2) + vofs[i_], (unsigned)__builtin_amdgcn_readfirstlane(lds0 + DA_VRING + (slot) + (2 * wid + i_) * 1024)); } while (0)
    DMA_K(0, 0); DMA_V(0, 0); DMA_K(1, DA_KSL);
    const u16* Qw = Qa + (rowbase + q0 + wq * 32 + r32) * DM + h * 128 + map * 64 + hi * 8;
#pragma unroll
    for (int d0 = 0; d0 < 4; ++d0) qr[d0] = ld8(Qw + d0 * 16);
    DMA_K(2, 2 * DA_KSL);
    int ka[4];
#pragma unroll
    for (int d0 = 0; d0 < 4; ++d0) ka[d0] = (int)lds0 + KSWZ(r32, cb0 + (d0 * 16 + hi * 8) * 2);
    const int vb0 = (int)lds0 + DA_VRING + v_rd_base(lane);
    constexpr int NT = SEQ / 64;
    f32x16 pA0, pA1, pB0, pB1; bf16x8 kf[8]; s16x4 vlo[4], vhi[4]; u32x4 pw0, pw1, pw2, pw3; bool resc = false;
    int sl_prev = 0, sl_cur = 0, sl_next = DA_KSL;
#define ROT() do { sl_prev = sl_cur; sl_cur = sl_next; sl_next = (sl_next == 2 * DA_KSL) ? 0 : sl_next + DA_KSL; } while (0)
#define RESC() do { if (resc) { _Pragma("unroll") for (int d_ = 0; d_ < 4; ++d_) _Pragma("unroll") for (int r = 0; r < 16; ++r) o[d_][r] *= al_l[crow(r, hi)]; } } while (0)
#define KLOAD(slot) do { _Pragma("unroll") for (int d0 = 0; d0 < 4; ++d0) { kf[2 * d0] = kld(ka[d0] + (slot)); kf[2 * d0 + 1] = kld(ka[d0] + (slot) + 8192); } } while (0)
    float mb;
    { float q2 = 0.f;
#pragma unroll
      for (int d0 = 0; d0 < 4; ++d0)
#pragma unroll
          for (int e = 0; e < 8; ++e) { const float qv = bf2f((u16)qr[d0][e]); q2 += qv * qv; }
      { auto rr = __builtin_amdgcn_permlane32_swap(__float_as_uint(q2), __float_as_uint(q2), false, false); q2 = __uint_as_float(rr[0]) + __uint_as_float(rr[1]); }
      mb = __builtin_sqrtf(q2 * __uint_as_float(kmx[b * 16 + h * 2 + map])) * 1.0001f; }
    const bool fast = !__any(!(mb <= 60.0f));
    if (fast) { m_reg = mb; fill16(negm, -mb); asm volatile("" : "+v"(negm)); }
    DA_WAIT_BAR(6);
    KLOAD(0);
    pA0 = DA_MFMA(kf[0], qr[0], negm); pA1 = DA_MFMA(kf[1], qr[0], negm); pA0 = DA_MFMA(kf[2], qr[1], pA0); pA1 = DA_MFMA(kf[3], qr[1], pA1);
    pA0 = DA_MFMA(kf[4], qr[2], pA0); pA1 = DA_MFMA(kf[5], qr[2], pA1); pA0 = DA_MFMA(kf[6], qr[3], pA0); pA1 = DA_MFMA(kf[7], qr[3], pA1);
    if (fast) {
#pragma unroll
      for (int r = 0; r < 16; ++r) { pA0[r] = __builtin_amdgcn_exp2f(pA0[r]); pA1[r] = __builtin_amdgcn_exp2f(pA1[r]); }
    } else { const float rm = rowmax32(pA0, pA1); m_reg = rm;
#pragma unroll
      for (int r = 0; r < 16; ++r) { pA0[r] = __builtin_amdgcn_exp2f(pA0[r] - rm); pA1[r] = __builtin_amdgcn_exp2f(pA1[r] - rm); }
      fill16(negm, -m_reg); asm volatile("" : "+v"(negm)); }
    DA_WAIT_BAR(0);
    DMA_K(3, 0); DMA_V(1, DA_KSL); ROT();
    KLOAD(sl_cur);
    DA_WAIT_BAR(4);
#define PKW(P, i) cvtpk(P[i], P[(i) + 1])
#define PAF(w) __builtin_bit_cast(bf16x8, w)
#define VOFF(i) ((((i) & 3) * 512) + (((i) >> 2) * 4096))
#define VRD(s, i) do { vlo[s] = vtr(vp_ + VOFF(i)); vhi[s] = vtr(vp_ + VOFF(i) + 2048); } while (0)
#define VFR(s) PKF(vlo[s], vhi[s])
#define KRD(G, d0) do { if (G) { kf[2 * (d0)] = kld(ka[d0] + sl_next); kf[2 * (d0) + 1] = kld(ka[d0] + sl_next + 8192); SBAR(); } } while (0)
#define GAPA(CT, MF, a0, a1, a2, a3, W0, W1, PW) do { MF; DA_PIN(CT); sacc += a0; sacc += a1; sacc += a2; sacc += a3; W0; W1; DA_PIN(PW); DA_PIN(sacc); SBAR(); } while (0)
#define GAPB(MF, X, i, VR) do { MF; VR; X[i] = __builtin_amdgcn_exp2f(X[i]); X[(i) + 1] = __builtin_amdgcn_exp2f(X[(i) + 1]); DA_PIN(X); SBAR(); } while (0)
#define STEP(C0, C1, P0, P1, t, GK, GV, GL) do { SBAR(); \
    const int vp_ = vb0 + sl_prev; \
    float sacc = P0[0] + P0[1]; \
    GAPA(C0, C0 = DA_MFMA(kf[0], qr[0], negm), P0[2], P0[3], P0[4], P0[5],     pw0[0] = PKW(P0, 0),  pw0[1] = PKW(P0, 2),  pw0); \
    GAPA(C1, C1 = DA_MFMA(kf[1], qr[0], negm), P0[6], P0[7], P0[8], P0[9],     pw0[2] = PKW(P0, 4),  pw0[3] = PKW(P0, 6),  pw0); \
    GAPA(C0, C0 = DA_MFMA(kf[2], qr[1], C0),   P0[10], P0[11], P0[12], P0[13], pw1[0] = PKW(P0, 8),  pw1[1] = PKW(P0, 10), pw1); \
    GAPA(C1, C1 = DA_MFMA(kf[3], qr[1], C1),   P0[14], P0[15], P1[0], P1[1],   pw1[2] = PKW(P0, 12), pw1[3] = PKW(P0, 14), pw1); \
    VRD(0, 0); SBAR(); GAPA(C0, C0 = DA_MFMA(kf[4], qr[2], C0), P1[2], P1[3], P1[4], P1[5],     pw2[0] = PKW(P1, 0),  pw2[1] = PKW(P1, 2),  pw2); \
    VRD(1, 1); SBAR(); GAPA(C1, C1 = DA_MFMA(kf[5], qr[2], C1), P1[6], P1[7], P1[8], P1[9],     pw2[2] = PKW(P1, 4),  pw2[3] = PKW(P1, 6),  pw2); \
    VRD(2, 2); SBAR(); GAPA(C0, C0 = DA_MFMA(kf[6], qr[3], C0), P1[10], P1[11], P1[12], P1[13], pw3[0] = PKW(P1, 8),  pw3[1] = PKW(P1, 10), pw3); \
    VRD(3, 3); SBAR(); GAPA(C1, C1 = DA_MFMA(kf[7], qr[3], C1), P1[14], P1[15], 0.f, 0.f,       pw3[2] = PKW(P1, 12), pw3[3] = PKW(P1, 14), pw3); \
    l_reg += sacc; \
    if (GK) DMA_K((t) + 3, sl_cur); if (GV) DMA_V((t) + 1, sl_next);                            \
    resc = false; \
    if (__builtin_expect(!fast, 0)) { const float rm = rowmax32(C0, C1);                        \
      if (__builtin_expect(__any(rm > THRL), 0)) { const float dl = fmaxf(rm, 0.f); m_reg += dl;    \
          const float f_ = __builtin_amdgcn_exp2f(-dl); l_reg *= f_; if (hi == 0) al_l[r32] = f_; resc = true; \
          _Pragma("unroll") for (int r = 0; r < 16; ++r) { C0[r] -= dl; C1[r] -= dl; } \
          fill16(negm, -m_reg); asm volatile("" : "+v"(negm)); } } \
    SBAR(); \
    GAPB(o[0] = DA_MFMA(PAF(pw0), VFR(0), o[0]), C0, 0, VRD(0, 4));  GAPB(o[1] = DA_MFMA(PAF(pw0), VFR(1), o[1]), C0, 2, VRD(1, 5)); \
    KRD(GL, 0); GAPB(o[2] = DA_MFMA(PAF(pw0), VFR(2), o[2]), C0, 4, VRD(2, 6));  KRD(GL, 1); GAPB(o[3] = DA_MFMA(PAF(pw0), VFR(3), o[3]), C0, 6, VRD(3, 7)); \
    KRD(GL, 2); GAPB(o[0] = DA_MFMA(PAF(pw1), VFR(0), o[0]), C0, 8, VRD(0, 8));  KRD(GL, 3); GAPB(o[1] = DA_MFMA(PAF(pw1), VFR(1), o[1]), C0, 10, VRD(1, 9)); \
    GAPB(o[2] = DA_MFMA(PAF(pw1), VFR(2), o[2]), C0, 12, VRD(2, 10)); GAPB(o[3] = DA_MFMA(PAF(pw1), VFR(3), o[3]), C0, 14, VRD(3, 11)); \
    GAPB(o[0] = DA_MFMA(PAF(pw2), VFR(0), o[0]), C1, 0, VRD(0, 12));  GAPB(o[1] = DA_MFMA(PAF(pw2), VFR(1), o[1]), C1, 2, VRD(1, 13)); \
    GAPB(o[2] = DA_MFMA(PAF(pw2), VFR(2), o[2]), C1, 4, VRD(2, 14));  GAPB(o[3] = DA_MFMA(PAF(pw2), VFR(3), o[3]), C1, 6, VRD(3, 15)); \
    GAPB(o[0] = DA_MFMA(PAF(pw3), VFR(0), o[0]), C1, 8, (void)0);     GAPB(o[1] = DA_MFMA(PAF(pw3), VFR(1), o[1]), C1, 10, (void)0); \
    GAPB(o[2] = DA_MFMA(PAF(pw3), VFR(2), o[2]), C1, 12, (void)0);    GAPB(o[3] = DA_MFMA(PAF(pw3), VFR(3), o[3]), C1, 14, (void)0); \
    } while (0)
    int t = 1;
    for (; t + 5 < NT; t += 2) {
        STEP(pB0, pB1, pA0, pA1, t, true, true, true);     DA_WAIT_BAR(4); RESC(); ROT();
        STEP(pA0, pA1, pB0, pB1, t + 1, true, true, true); DA_WAIT_BAR(4); RESC(); ROT();
    }
#define ENDW(tt) do { if ((tt) + 3 < NT) { DA_WAIT_BAR(4); } else if ((tt) + 2 < NT) { DA_WAIT_BAR(2); } else { DA_WAIT_BAR(0); } } while (0)
    for (; t + 1 < NT; t += 2) {
        STEP(pB0, pB1, pA0, pA1, t, (t + 3 < NT), (t + 1 < NT), (t + 1 < NT));         ENDW(t);     RESC(); ROT();
        STEP(pA0, pA1, pB0, pB1, t + 1, (t + 4 < NT), (t + 2 < NT), (t + 2 < NT));     ENDW(t + 1); RESC(); ROT();
    }
    STEP(pB0, pB1, pA0, pA1, NT - 1, false, false, false); RESC();
    { float sacc = pB0[0] + pB0[1];
#pragma unroll
      for (int r = 2; r < 16; ++r) sacc += pB0[r];
#pragma unroll
      for (int r = 0; r < 16; ++r) sacc += pB1[r];
      l_reg += sacc;
      pw0 = (u32x4){PKW(pB0, 0), PKW(pB0, 2), PKW(pB0, 4), PKW(pB0, 6)}; pw1 = (u32x4){PKW(pB0, 8), PKW(pB0, 10), PKW(pB0, 12), PKW(pB0, 14)};
      pw2 = (u32x4){PKW(pB1, 0), PKW(pB1, 2), PKW(pB1, 4), PKW(pB1, 6)}; pw3 = (u32x4){PKW(pB1, 8), PKW(pB1, 10), PKW(pB1, 12), PKW(pB1, 14)};
      pv_da(o, vb0 + sl_cur, PAF(pw0), PAF(pw1), PAF(pw2), PAF(pw3)); }
    { auto rr = __builtin_amdgcn_permlane32_swap(__float_as_uint(l_reg), __float_as_uint(l_reg), false, false); l_reg = __uint_as_float(rr[0]) + __uint_as_float(rr[1]); }
#undef DMA_K
#undef DMA_V
#undef ROT
#undef RESC
#undef KLOAD
#undef PKW
#undef PAF
#undef VOFF
#undef VRD
#undef VFR
#undef KRD
#undef GAPA
#undef GAPB
#undef STEP
#undef ENDW
    if (hi == 0) li_l[r32] = l_reg; asm volatile("s_waitcnt lgkmcnt(0)" ::: "memory");
    float rli[16];
#pragma unroll
    for (int r = 0; r < 16; ++r) rli[r] = __builtin_amdgcn_rcpf(li_l[crow(r, hi)]) * (map ? lam : 1.0f);
    __syncthreads();
    float* xch = (float*)lds;
    if (map == 1) {
#pragma unroll
        for (int d0 = 0; d0 < 4; ++d0)
#pragma unroll
            for (int r = 0; r < 16; ++r) xch[((wq * 4 + d0) * 16 + r) * 64 + lane] = o[d0][r] * rli[r];
    }
    __syncthreads();
    float* stg = (float*)(lds + DA_STG);
    if (map == 0) {
#pragma unroll
        for (int d0 = 0; d0 < 4; ++d0)
#pragma unroll
            for (int r = 0; r < 16; ++r) { const float dv = o[d0][r] * rli[r] - xch[((wq * 4 + d0) * 16 + r) * 64 + lane];
                stg[(wq * 32 + crow(r, hi)) * DA_STG_LD + d0 * 32 + r32] = dv; }
    }
    __syncthreads();
    {
        const int row = tid >> 2, qt = tid & 3; const float* sp = stg + row * DA_STG_LD + qt * 32;
        f32x4 dv[8]; float ss = 0.f;
#pragma unroll
        for (int g = 0; g < 8; ++g) { dv[g] = *(const f32x4*)(sp + g * 4); ss += (dv[g][0] * dv[g][0] + dv[g][1] * dv[g][1]) + (dv[g][2] * dv[g][2] + dv[g][3] * dv[g][3]); }
        ss += __shfl_xor(ss, 1); ss += __shfl_xor(ss, 2);
        const float sc2 = __builtin_amdgcn_rsqf(ss * (1.0f / 128.0f) + EPS) * one_m_li;
        const size_t goff = (size_t)(rowbase + q0 + row) * DM + h * 128 + qt * 32;
#pragma unroll
        for (int g = 0; g < 4; ++g) {
            const bf16x8 gt = ld8(Ga + goff + g * 8);
            const f32x4 w0 = *(const f32x4*)(subw + qt * 32 + g * 8), w1 = *(const f32x4*)(subw + qt * 32 + g * 8 + 4);
            const f32x4 a = dv[2 * g], c = dv[2 * g + 1];
            u32x4 w;
            w.x = cvtpk(a[0] * sc2 * w0[0] * bf2f((u16)gt[0]), a[1] * sc2 * w0[1] * bf2f((u16)gt[1]));
            w.y = cvtpk(a[2] * sc2 * w0[2] * bf2f((u16)gt[2]), a[3] * sc2 * w0[3] * bf2f((u16)gt[3]));
            w.z = cvtpk(c[0] * sc2 * w1[0] * bf2f((u16)gt[4]), c[1] * sc2 * w1[1] * bf2f((u16)gt[5]));
            w.w = cvtpk(c[2] * sc2 * w1[2] * bf2f((u16)gt[6]), c[3] * sc2 * w1[3] * bf2f((u16)gt[7]));
            if (!DRY) *(u32x4*)(Y + goff + g * 8) = w; else asm volatile("" :: "v"(w));
        }
    }
    __syncthreads();
}

constexpr int SWB_K = 0, SWB_V = 49152, SWB_WS = 98304, SWB_STG = 100352, SWB_STG_LD = 36;
__device__ __forceinline__ void swa_block_geom(int qb, int& t_lo, int& t_hi) { const int q0 = qb * 128; t_lo = (q0 >= 128 ? q0 - 128 : 0) >> 6; t_hi = (q0 + 255 < SEQ ? q0 + 255 : SEQ - 1) >> 6; }
template <int N> struct SwaRegs { bf16x8 k[N], v[N]; };
template <int N> __device__ __forceinline__ void swa_tiles_load(SwaRegs<N>& R, int b, int kvh, int t0, int nt, const u16* __restrict__ Kb, const u16* __restrict__ Vb, int tid) {
    const int sr = tid >> 3, sc = (tid & 7) * 8; const long rowbase = (long)b * SEQ;
    const u16* Kh = Kb + (rowbase + t0 * 64 + sr) * 256 + kvh * 64 + sc; const u16* Vh = Vb + (rowbase + t0 * 64 + sr) * 256 + kvh * 64 + sc;
#pragma unroll
    for (int tt = 0; tt < N; ++tt) if (tt < nt) { R.k[tt] = ld8(Kh + (long)tt * 64 * 256); R.v[tt] = ld8(Vh + (long)tt * 64 * 256); }
}
template <int N> __device__ __forceinline__ void swa_tiles_store_lds(const SwaRegs<N>& R, int t0, int nt, char* lds, int tid) {
    const int sr = tid >> 3, sc = (tid & 7) * 8, vst0 = v_stn<2>(sr, sc), kst0 = KSWZ128(sr, sc * 2);
#pragma unroll
    for (int tt = 0; tt < N; ++tt) if (tt < nt) { const int sl = (t0 + tt) % 6; *(bf16x8*)(lds + SWB_K + sl * 8192 + kst0) = R.k[tt]; *(bf16x8*)(lds + SWB_V + sl * 8192 + vst0) = R.v[tt]; }
}
template <bool DRY>
__device__ __forceinline__ void swa_block_compute(int b, int kvh, int qb, const u16* Q, const u16* __restrict__ Gt, u16* Y, const float* __restrict__ sink, char* lds, int tid) {
    const int lane = tid & 63, r32 = lane & 31, hi = lane >> 5; const int wid = __builtin_amdgcn_readfirstlane(tid >> 6);
    const int hq = kvh * 8 + wid; const long rowbase = (long)b * SEQ; const int q0 = qb * 128;
    int t_lo, t_hib; swa_block_geom(qb, t_lo, t_hib); (void)t_hib;
    float* wsf = (float*)(lds + SWB_WS) + wid * 64; float* al_l = wsf + 32;
    float* stg = (float*)(lds + SWB_STG) + wid * (32 * SWB_STG_LD);
    const int vb0 = (int)(uintptr_t)(lds + SWB_V) + v_rd_base(lane);
    const float sink2 = sink[hq] * LOG2E;
    bf16x8 qn[4];
    { const u16* Qw = Q + (rowbase + q0 + r32) * DIN + hq * 64 + hi * 8;
#pragma unroll
      for (int d0 = 0; d0 < 4; ++d0) qn[d0] = ld8(Qw + d0 * 16); }
#pragma unroll 1
    for (int sub = 0; sub < 4; ++sub) {
        const int qs = q0 + 32 * sub;
        bf16x8 qr[4];
#pragma unroll
        for (int d0 = 0; d0 < 4; ++d0) qr[d0] = qn[d0];
        if (sub < 3) { const u16* Qw = Q + (rowbase + qs + 32 + r32) * DIN + hq * 64 + hi * 8;
#pragma unroll
            for (int d0 = 0; d0 < 4; ++d0) qn[d0] = ld8(Qw + d0 * 16); }
        const int ta = ((qs >= 128 ? qs - 128 : 0) >> 6) - t_lo, tb = ((qs + 159 < SEQ ? qs + 159 : SEQ - 1) >> 6) - t_lo;
        float m_reg = sink2, l_dummy = 0.f; f32x16 o[2] = {}; f32x16 lacc, negm; fill16(lacc, 1.0f); fill16(negm, -sink2);
        const bf16x8 ones = {0x3F80, 0x3F80, 0x3F80, 0x3F80, 0x3F80, 0x3F80, 0x3F80, 0x3F80};
        bf16x8 gpre[2][2];
        { const size_t gb = (size_t)(rowbase + qs + (lane >> 1)) * DIN + hq * 64 + (lane & 1) * 16;
#pragma unroll
          for (int cbk = 0; cbk < 2; ++cbk) { gpre[cbk][0] = ld8(Gt + gb + cbk * 32); gpre[cbk][1] = ld8(Gt + gb + cbk * 32 + 8); } }
        for (int tt = ta; tt <= tb; ++tt) {
            const int k0 = (t_lo + tt) * 64, sl = (t_lo + tt) % 6;
            f32x16 p0, p1;
            const char* Ks = lds + SWB_K + sl * 8192;
#pragma unroll
            for (int d0 = 0; d0 < 4; ++d0) { const int cb = (d0 * 16 + hi * 8) * 2;
                const bf16x8 b0 = *reinterpret_cast<const bf16x8*>(Ks + KSWZ128(r32, cb));
                const bf16x8 b1 = *reinterpret_cast<const bf16x8*>(Ks + KSWZ128(32 + r32, cb));
                if (d0 == 0) { p0 = __builtin_amdgcn_mfma_f32_32x32x16_bf16(b0, qr[0], negm, 0, 0, 0); p1 = __builtin_amdgcn_mfma_f32_32x32x16_bf16(b1, qr[0], negm, 0, 0, 0); }
                else { p0 = __builtin_amdgcn_mfma_f32_32x32x16_bf16(b0, qr[d0], p0, 0, 0, 0); p1 = __builtin_amdgcn_mfma_f32_32x32x16_bf16(b1, qr[d0], p1, 0, 0, 0); } }
            if (k0 < qs - 97 || k0 + 63 > qs + 128) {
                const int base = k0 - qs - r32 + 4 * hi + 128;
#pragma unroll
                for (int r = 0; r < 16; ++r) { const int c = (r & 3) + 8 * (r >> 2); if ((unsigned)(base + c) > 256u) p0[r] = -1e30f; if ((unsigned)(base + c + 32) > 256u) p1[r] = -1e30f; }
            }
            float alpha; bf16x8 pa0, pa1, pa2, pa3;
            partialSM_n<false>(p0, p1, m_reg, negm, alpha);
            if (__any(alpha < 1.f)) { if (hi == 0) al_l[r32] = alpha; asm volatile("s_waitcnt lgkmcnt(0)" ::: "memory");
#pragma unroll
                for (int r = 0; r < 16; ++r) { const float al = al_l[crow(r, hi)]; o[0][r] *= al; o[1][r] *= al; lacc[r] *= al; } }
            finishSM_n<false>(p0, p1, alpha, l_dummy, pa0, pa1, pa2, pa3);
            {
                const int vbt = vb0 + sl * 8192; s16x4 lo[4], hi4[4];
#define VADDR2(i) (vbt + ((i) & 1) * 512 + ((i) >> 1) * 2048)
#pragma unroll
                for (int i = 0; i < 4; ++i) { lo[i] = vtr(VADDR2(i)); hi4[i] = vtr(VADDR2(i) + 1024); }
#pragma unroll
                for (int i = 0; i < 8; ++i) {
                    const bf16x8 vf = PKF(lo[i & 3], hi4[i & 3]);
                    const bf16x8 pa = ((i >> 1) == 0) ? pa0 : ((i >> 1) == 1) ? pa1 : ((i >> 1) == 2) ? pa2 : pa3;
                    o[i & 1] = __builtin_amdgcn_mfma_f32_32x32x16_bf16(pa, vf, o[i & 1], 0, 0, 0);
                    if ((i & 1) == 1) lacc = __builtin_amdgcn_mfma_f32_32x32x16_bf16(pa, ones, lacc, 0, 0, 0);
                    if (i + 4 < 8) { lo[i & 3] = vtr(VADDR2(i + 4)); hi4[i & 3] = vtr(VADDR2(i + 4) + 1024); }
                }
#undef VADDR2
            }
        }
        float rl[16];
#pragma unroll
        for (int r = 0; r < 16; ++r) rl[r] = __builtin_amdgcn_rcpf(lacc[r]);
#pragma unroll
        for (int cbk = 0; cbk < 2; ++cbk) {
#pragma unroll
            for (int r = 0; r < 16; ++r) stg[crow(r, hi) * SWB_STG_LD + r32] = o[cbk][r] * rl[r];
            asm volatile("s_waitcnt lgkmcnt(0)" ::: "memory");
            const int row = lane >> 1, hf = lane & 1; const float* sp = stg + row * SWB_STG_LD + hf * 16;
            const f32x4 a0 = *(const f32x4*)(sp), a1 = *(const f32x4*)(sp + 4), a2 = *(const f32x4*)(sp + 8), a3 = *(const f32x4*)(sp + 12);
            const size_t goff = (size_t)(rowbase + qs + row) * DIN + hq * 64 + cbk * 32 + hf * 16;
            const bf16x8 g0 = gpre[cbk][0], g1 = gpre[cbk][1];
            u32x4 w0, w1;
            w0.x = cvtpk(a0[0] * bf2f((u16)g0[0]), a0[1] * bf2f((u16)g0[1])); w0.y = cvtpk(a0[2] * bf2f((u16)g0[2]), a0[3] * bf2f((u16)g0[3]));
            w0.z = cvtpk(a1[0] * bf2f((u16)g0[4]), a1[1] * bf2f((u16)g0[5])); w0.w = cvtpk(a1[2] * bf2f((u16)g0[6]), a1[3] * bf2f((u16)g0[7]));
            w1.x = cvtpk(a2[0] * bf2f((u16)g1[0]), a2[1] * bf2f((u16)g1[1])); w1.y = cvtpk(a2[2] * bf2f((u16)g1[2]), a2[3] * bf2f((u16)g1[3]));
            w1.z = cvtpk(a3[0] * bf2f((u16)g1[4]), a3[1] * bf2f((u16)g1[5])); w1.w = cvtpk(a3[2] * bf2f((u16)g1[6]), a3[3] * bf2f((u16)g1[7]));
            if (!DRY) { *(u32x4*)(Y + goff) = w0; *(u32x4*)(Y + goff + 8) = w1; } else asm volatile("" :: "v"(w0), "v"(w1));
            asm volatile("s_waitcnt lgkmcnt(0)" ::: "memory");
        }
    }
}
template <bool DRY>
__device__ __forceinline__ void swa_block_compute_fast(int b, int kvh, int qb, const u16* Q, const u16* __restrict__ Gt, u16* Y, const float* __restrict__ sink, float mref, char* lds, int tid) {
    const int lane = tid & 63, r32 = lane & 31, hi = lane >> 5; const int wid = __builtin_amdgcn_readfirstlane(tid >> 6);
    const int hq = kvh * 8 + wid; const long rowbase = (long)b * SEQ; const int q0 = qb * 128;
    int t_lo, t_hib; swa_block_geom(qb, t_lo, t_hib); (void)t_hib;
    float* wsf = (float*)(lds + SWB_WS) + wid * 64;
    float* stg = (float*)(lds + SWB_STG) + wid * (32 * SWB_STG_LD);
    const int vb0 = (int)(uintptr_t)(lds + SWB_V) + v_rd_base(lane);
    const float psink = __builtin_amdgcn_exp2f(sink[hq] * LOG2E - mref);
    f32x16 negm; fill16(negm, -mref);
    bf16x8 qn[4];
    { const u16* Qw = Q + (rowbase + q0 + r32) * DIN + hq * 64 + hi * 8;
#pragma unroll
      for (int d0 = 0; d0 < 4; ++d0) qn[d0] = ld8(Qw + d0 * 16); }
#pragma unroll 1
    for (int sub = 0; sub < 4; ++sub) {
        const int qs = q0 + 32 * sub;
        bf16x8 qr[4];
#pragma unroll
        for (int d0 = 0; d0 < 4; ++d0) qr[d0] = qn[d0];
        if (sub < 3) { const u16* Qw = Q + (rowbase + qs + 32 + r32) * DIN + hq * 64 + hi * 8;
#pragma unroll
            for (int d0 = 0; d0 < 4; ++d0) qn[d0] = ld8(Qw + d0 * 16); }
        const int ta = ((qs >= 128 ? qs - 128 : 0) >> 6) - t_lo, tb = ((qs + 159 < SEQ ? qs + 159 : SEQ - 1) >> 6) - t_lo;
        float lsum = hi ? 0.f : psink; f32x16 o[2] = {};
        bf16x8 gpre[2][2];
        { const size_t gb = (size_t)(rowbase + qs + (lane >> 1)) * DIN + hq * 64 + (lane & 1) * 16;
#pragma unroll
          for (int cbk = 0; cbk < 2; ++cbk) { gpre[cbk][0] = ld8(Gt + gb + cbk * 32); gpre[cbk][1] = ld8(Gt + gb + cbk * 32 + 8); } }
        bf16x8 kf0, kf1, kf2, kf3, kf4, kf5, kf6, kf7;
#define SWA_KLOAD(tile) do { const char* Kn_ = lds + SWB_K + ((t_lo + (tile)) % 6) * 8192; \
            kf0 = *reinterpret_cast<const bf16x8*>(Kn_ + KSWZ128(r32, (0 * 16 + hi * 8) * 2)); kf1 = *reinterpret_cast<const bf16x8*>(Kn_ + KSWZ128(32 + r32, (0 * 16 + hi * 8) * 2)); \
            kf2 = *reinterpret_cast<const bf16x8*>(Kn_ + KSWZ128(r32, (1 * 16 + hi * 8) * 2)); kf3 = *reinterpret_cast<const bf16x8*>(Kn_ + KSWZ128(32 + r32, (1 * 16 + hi * 8) * 2)); \
            kf4 = *reinterpret_cast<const bf16x8*>(Kn_ + KSWZ128(r32, (2 * 16 + hi * 8) * 2)); kf5 = *reinterpret_cast<const bf16x8*>(Kn_ + KSWZ128(32 + r32, (2 * 16 + hi * 8) * 2)); \
            kf6 = *reinterpret_cast<const bf16x8*>(Kn_ + KSWZ128(r32, (3 * 16 + hi * 8) * 2)); kf7 = *reinterpret_cast<const bf16x8*>(Kn_ + KSWZ128(32 + r32, (3 * 16 + hi * 8) * 2)); } while (0)
        SWA_KLOAD(ta);
#pragma unroll 1
        for (int tt = ta; tt <= tb; ++tt) {
            const int k0 = (t_lo + tt) * 64, sl = (t_lo + tt) % 6;
            f32x16 p0, p1;
            p0 = __builtin_amdgcn_mfma_f32_32x32x16_bf16(kf0, qr[0], negm, 0, 0, 0); p1 = __builtin_amdgcn_mfma_f32_32x32x16_bf16(kf1, qr[0], negm, 0, 0, 0);
            p0 = __builtin_amdgcn_mfma_f32_32x32x16_bf16(kf2, qr[1], p0, 0, 0, 0);   p1 = __builtin_amdgcn_mfma_f32_32x32x16_bf16(kf3, qr[1], p1, 0, 0, 0);
            p0 = __builtin_amdgcn_mfma_f32_32x32x16_bf16(kf4, qr[2], p0, 0, 0, 0);   p1 = __builtin_amdgcn_mfma_f32_32x32x16_bf16(kf5, qr[2], p1, 0, 0, 0);
            p0 = __builtin_amdgcn_mfma_f32_32x32x16_bf16(kf6, qr[3], p0, 0, 0, 0);   p1 = __builtin_amdgcn_mfma_f32_32x32x16_bf16(kf7, qr[3], p1, 0, 0, 0);
            SWA_KLOAD(tt < tb ? tt + 1 : tt);
            if (k0 < qs - 97 || k0 + 63 > qs + 128) {
                const int base = k0 - qs - r32 + 4 * hi + 128;
#pragma unroll
                for (int r = 0; r < 16; ++r) { const int c = (r & 3) + 8 * (r >> 2); if ((unsigned)(base + c) > 256u) p0[r] = -1e30f; if ((unsigned)(base + c + 32) > 256u) p1[r] = -1e30f; }
            }
#pragma unroll
            for (int r = 0; r < 16; ++r) { p0[r] = __builtin_amdgcn_exp2f(p0[r]); p1[r] = __builtin_amdgcn_exp2f(p1[r]); }
            { float s0 = (p0[0] + p0[1]) + (p0[2] + p0[3]), s1 = (p0[4] + p0[5]) + (p0[6] + p0[7]), s2 = (p0[8] + p0[9]) + (p0[10] + p0[11]), s3 = (p0[12] + p0[13]) + (p0[14] + p0[15]);
              float t0 = (p1[0] + p1[1]) + (p1[2] + p1[3]), t1 = (p1[4] + p1[5]) + (p1[6] + p1[7]), t2 = (p1[8] + p1[9]) + (p1[10] + p1[11]), t3 = (p1[12] + p1[13]) + (p1[14] + p1[15]);
              lsum += ((s0 + s1) + (s2 + s3)) + ((t0 + t1) + (t2 + t3)); }
            bf16x8 pa0, pa1, pa2, pa3;
            { u32x4 w = PKN(p0, 0); pa0 = *reinterpret_cast<bf16x8*>(&w); } { u32x4 w = PKN(p0, 8); pa1 = *reinterpret_cast<bf16x8*>(&w); }
            { u32x4 w = PKN(p1, 0); pa2 = *reinterpret_cast<bf16x8*>(&w); } { u32x4 w = PKN(p1, 8); pa3 = *reinterpret_cast<bf16x8*>(&w); }
            {
                const int vbt = vb0 + sl * 8192; s16x4 lo[4], hi4[4];
#define VADDR2(i) (vbt + ((i) & 1) * 512 + ((i) >> 1) * 2048)
#pragma unroll
                for (int i = 0; i < 4; ++i) { lo[i] = vtr(VADDR2(i)); hi4[i] = vtr(VADDR2(i) + 1024); }
#pragma unroll
                for (int i = 0; i < 8; ++i) {
                    const bf16x8 vf = PKF(lo[i & 3], hi4[i & 3]);
                    const bf16x8 pa = ((i >> 1) == 0) ? pa0 : ((i >> 1) == 1) ? pa1 : ((i >> 1) == 2) ? pa2 : pa3;
                    o[i & 1] = __builtin_amdgcn_mfma_f32_32x32x16_bf16(pa, vf, o[i & 1], 0, 0, 0);
                    if (i + 4 < 8) { lo[i & 3] = vtr(VADDR2(i + 4)); hi4[i & 3] = vtr(VADDR2(i + 4) + 1024); }
                }
#undef VADDR2
            }
        }
#undef SWA_KLOAD
        { auto rr = __builtin_amdgcn_permlane32_swap(__float_as_uint(lsum), __float_as_uint(lsum), false, false); lsum = __uint_as_float(rr[0]) + __uint_as_float(rr[1]); }
        if (hi == 0) wsf[r32] = lsum; asm volatile("s_waitcnt lgkmcnt(0)" ::: "memory");
        float rl[16];
#pragma unroll
        for (int r = 0; r < 16; ++r) rl[r] = __builtin_amdgcn_rcpf(wsf[crow(r, hi)]);
#pragma unroll
        for (int cbk = 0; cbk < 2; ++cbk) {
#pragma unroll
            for (int r = 0; r < 16; ++r) stg[crow(r, hi) * SWB_STG_LD + r32] = o[cbk][r] * rl[r];
            asm volatile("s_waitcnt lgkmcnt(0)" ::: "memory");
            const int row = lane >> 1, hf = lane & 1; const float* sp = stg + row * SWB_STG_LD + hf * 16;
            const f32x4 a0 = *(const f32x4*)(sp), a1 = *(const f32x4*)(sp + 4), a2 = *(const f32x4*)(sp + 8), a3 = *(const f32x4*)(sp + 12);
            const size_t goff = (size_t)(rowbase + qs + row) * DIN + hq * 64 + cbk * 32 + hf * 16;
            const bf16x8 g0 = gpre[cbk][0], g1 = gpre[cbk][1];
            u32x4 w0, w1;
            w0.x = cvtpk(a0[0] * bf2f((u16)g0[0]), a0[1] * bf2f((u16)g0[1])); w0.y = cvtpk(a0[2] * bf2f((u16)g0[2]), a0[3] * bf2f((u16)g0[3]));
            w0.z = cvtpk(a1[0] * bf2f((u16)g0[4]), a1[1] * bf2f((u16)g0[5])); w0.w = cvtpk(a1[2] * bf2f((u16)g0[6]), a1[3] * bf2f((u16)g0[7]));
            w1.x = cvtpk(a2[0] * bf2f((u16)g1[0]), a2[1] * bf2f((u16)g1[1])); w1.y = cvtpk(a2[2] * bf2f((u16)g1[2]), a2[3] * bf2f((u16)g1[3]));
            w1.z = cvtpk(a3[0] * bf2f((u16)g1[4]), a3[1] * bf2f((u16)g1[5])); w1.w = cvtpk(a3[2] * bf2f((u16)g1[6]), a3[3] * bf2f((u16)g1[7]));
            if (!DRY) { *(u32x4*)(Y + goff) = w0; *(u32x4*)(Y + goff + 8) = w1; } else asm volatile("" :: "v"(w0), "v"(w1));
            asm volatile("s_waitcnt lgkmcnt(0)" ::: "memory");
        }
    }
}
template <bool DRY, bool FAST>
__device__ __forceinline__ void swa_phase_tail(int b, int kvh, int qbA, int qbB, const SwaRegs<2>& N, int tnew, int nnew, const u16* Q, const u16* Gt, u16* Y, const float* sink, float mref, char* lds, int tid) {
    if (FAST) swa_block_compute_fast<DRY>(b, kvh, qbA, Q, Gt, Y, sink, mref, lds, tid); else swa_block_compute<DRY>(b, kvh, qbA, Q, Gt, Y, sink, lds, tid);
    __syncthreads();
    swa_tiles_store_lds<2>(N, tnew, nnew, lds, tid);
    __syncthreads();
    if (FAST) swa_block_compute_fast<DRY>(b, kvh, qbB, Q, Gt, Y, sink, mref, lds, tid); else swa_block_compute<DRY>(b, kvh, qbB, Q, Gt, Y, sink, lds, tid);
    __syncthreads();
}
template <bool DRY>
__device__ __forceinline__ void swa_phase(int u0, const u16* Q, const u16* Kb, const u16* Vb, const u16* Gt, u16* Y, const float* sink, const unsigned* __restrict__ qmx, const unsigned* __restrict__ kmx, char* lds) {
    int tid = threadIdx.x; asm volatile("" : "+v"(tid));
    const int bk = u0 >> 5, b = bk >> 2, kvh = bk & 3, qbA = u0 & 31, qbB = qbA + 1;
    int tloA, thiA, tloB, thiB; swa_block_geom(qbA, tloA, thiA); swa_block_geom(qbB, tloB, thiB);
    { SwaRegs<6> R; swa_tiles_load<6>(R, b, kvh, tloA, thiA - tloA + 1, Kb, Vb, tid); swa_tiles_store_lds<6>(R, tloA, thiA - tloA + 1, lds, tid); }
    __syncthreads();
    SwaRegs<2> N; const int nnew = thiB - thiA;
    swa_tiles_load<2>(N, b, kvh, thiA + 1, nnew, Kb, Vb, tid);
    const int hq_ = kvh * 8 + __builtin_amdgcn_readfirstlane(tid >> 6);
    const float mref = fmaxf(__builtin_sqrtf(__uint_as_float(qmx[b * 32 + hq_]) * __uint_as_float(kmx[b * 16 + kvh])) * 1.0001f, sink[hq_] * LOG2E);
    if (mref <= 60.0f) swa_phase_tail<DRY, true>(b, kvh, qbA, qbB, N, thiA + 1, nnew, Q, Gt, Y, sink, mref, lds, tid);
    else               swa_phase_tail<DRY, false>(b, kvh, qbA, qbB, N, thiA + 1, nnew, Q, Gt, Y, sink, mref, lds, tid);
}
}
namespace hg {
using namespace att;
typedef _Float16 f16;
constexpr int L_QT = 0, L_KT = 16384, L_QIN = 32768, L_KDEC = 49152, L_V = 65536, L_S = 81920, L_CUM = 114688, L_EDEC = 118784, L_STG = 122880, STG_LD = 132;

struct ChunkRegs { unsigned q[8], v[8], lf[8]; };

__device__ __forceinline__ int chunk_pos(int c, int i, int dir) { return dir ? (c * 64 + 63 - i) : (c * 64 + i); }

template <bool NEEDQ>
__device__ __forceinline__ void load_chunk(ChunkRegs& R, const u16* Qh, const u16* Vh, const u16* LF, long rowbase, int colbase, int c, int dir, int wid, int lane) {
#pragma unroll
    for (int i = 0; i < 8; ++i) {
        const long pos = rowbase + chunk_pos(c, wid * 8 + i, dir);
        const size_t off = (size_t)pos * DM + colbase + 2 * lane;
        if (NEEDQ) R.q[i] = *(const unsigned*)(Qh + off);
        R.v[i] = *(const unsigned*)(Vh + off);
        R.lf[i] = *(const unsigned*)(LF + off);
    }
}
__device__ __forceinline__ float h2f(unsigned short h) { return (float)__builtin_bit_cast(f16, h); }

template <bool FULL>
__device__ __forceinline__ void prep_chunk(const ChunkRegs& R, char* lds, int wid, int lane, float (&gtot)[2]) {
    float g[8][2]; float run0 = 0.f, run1 = 0.f;
#pragma unroll
    for (int i = 0; i < 8; ++i) { run0 += h2f((unsigned short)(R.lf[i] & 0xffff)); run1 += h2f((unsigned short)(R.lf[i] >> 16)); g[i][0] = run0; g[i][1] = run1; }
    float* cum = (float*)(lds + L_CUM);
    *(float2*)(cum + wid * 128 + 2 * lane) = make_float2(run0, run1);
    __syncthreads();
    float pre0 = 0.f, pre1 = 0.f, gm0 = 0.f, gm1 = 0.f, gl0 = 0.f, gl1 = 0.f;
#pragma unroll
    for (int w2 = 0; w2 < 8; ++w2) { const float2 t = *(const float2*)(cum + w2 * 128 + 2 * lane);
        if (w2 < wid) { pre0 += t.x; pre1 += t.y; } if (w2 < 4) { gm0 += t.x; gm1 += t.y; } gl0 += t.x; gl1 += t.y; }
    gtot[0] += gl0; gtot[1] += gl1;
    const float egm0 = __builtin_amdgcn_exp2f(gm0), egm1 = __builtin_amdgcn_exp2f(gm1), elm0 = __builtin_amdgcn_exp2f(gl0 - gm0), elm1 = __builtin_amdgcn_exp2f(gl1 - gm1);
    if (wid == 0) *(float2*)((float*)(lds + L_EDEC) + 2 * lane) = make_float2(__builtin_amdgcn_exp2f(gl0), __builtin_amdgcn_exp2f(gl1));
    typedef float f32x2 __attribute__((ext_vector_type(2)));
    const f32x2 prev = {pre0, pre1}, gmv = {gm0, gm1}, elmv = {elm0, elm1}, egmv = {egm0, egm1}, one2 = {1.0f, 1.0f};
#pragma unroll
    for (int i = 0; i < 8; ++i) {
        const int row = wid * 8 + i;
        const f32x2 a = (prev + (f32x2){g[i][0], g[i][1]}) - gmv;
        const f32x2 e = {__builtin_amdgcn_exp2f(a.x), __builtin_amdgcn_exp2f(a.y)};
        const f32x2 r = {__builtin_amdgcn_rcpf(e.x), __builtin_amdgcn_rcpf(e.y)};
        const float lf0 = h2f((unsigned short)(R.lf[i] & 0xffff)), lf1 = h2f((unsigned short)(R.lf[i] >> 16));
        const f32x2 k = one2 - (f32x2){__builtin_amdgcn_exp2f(lf0), __builtin_amdgcn_exp2f(lf1)};
        const f32x2 kt = k * r, kd = kt * elmv;
        const int vo = v_st<4>(row, 2 * lane);
        *(unsigned*)(lds + L_KDEC + vo) = cvtpk(kd.x, kd.y);
        *(unsigned*)(lds + L_V + vo) = R.v[i];
        if (FULL) {
            const f32x2 q = {bf2f((u16)(R.q[i] & 0xffff)), bf2f((u16)(R.q[i] >> 16))};
            const f32x2 qt = q * e, qi = qt * egmv;
            const int ko = KSWZ(row, 4 * lane);
            *(unsigned*)(lds + L_QT + ko) = cvtpk(qt.x, qt.y);
            *(unsigned*)(lds + L_KT + ko) = cvtpk(kt.x, kt.y);
            *(unsigned*)(lds + L_QIN + ko) = cvtpk(qi.x, qi.y);
        }
    }
}

template <int KS> __device__ __forceinline__ bf16x8 tr_frag(int vb) {
    const s16x4 l = tr_read<KS * 4096>(vb), h = tr_read<KS * 4096 + 2048>(vb);
    asm volatile("s_waitcnt lgkmcnt(0)" ::: "memory"); SBAR();
    return PKF(l, h);
}

struct SuFrag { s16x4 lv, hv, l0, h0, l1, h1; };
__device__ __forceinline__ void su_read(SuFrag& f, int vbV, int vbK0, int vbK1, int off) {
    f.lv = vtr(vbV + off); f.hv = vtr(vbV + off + 2048); f.l0 = vtr(vbK0 + off); f.h0 = vtr(vbK0 + off + 2048); f.l1 = vtr(vbK1 + off); f.h1 = vtr(vbK1 + off + 2048);
}
__device__ __forceinline__ void su_mma(f32x16 (&sacc)[2], const SuFrag& f) {
    const bf16x8 bv = PKF(f.lv, f.hv), a0 = PKF(f.l0, f.h0), a1 = PKF(f.l1, f.h1);
    sacc[0] = __builtin_amdgcn_mfma_f32_32x32x16_bf16(a0, bv, sacc[0], 0, 0, 0); sacc[1] = __builtin_amdgcn_mfma_f32_32x32x16_bf16(a1, bv, sacc[1], 0, 0, 0);
}
template <int NIMG>
__device__ __forceinline__ void state_update_t(f32x16 (&sacc)[2], const char* lds, int ldsbase, int offK, int offV, int offE, int wid, int lane) {
    const int hi = lane >> 5, j = wid >> 1, ib = 2 * (wid & 1);
    const float* edec = (const float*)(lds + offE);
    const int vbV = ldsbase + offV + v_rd_base(lane) + j * 512;
    const int vbK0 = ldsbase + offK + v_rd_base(lane) + ib * 512, vbK1 = vbK0 + 512;
#pragma unroll
    for (int i2 = 0; i2 < 2; ++i2)
#pragma unroll
        for (int r = 0; r < 16; ++r) sacc[i2][r] *= edec[32 * (ib + i2) + crow(r, hi)];
    SBAR();
    SuFrag fa, fb; su_read(fa, vbV, vbK0, vbK1, 0);
#pragma unroll
    for (int s = 0; s < 4 * NIMG; s += 2) {
        su_read(fb, vbV, vbK0, vbK1, ((s + 1) >> 2) * 16384 + ((s + 1) & 3) * 4096);
        su_mma(sacc, fa);
        if (s + 2 < 4 * NIMG) su_read(fa, vbV, vbK0, vbK1, ((s + 2) >> 2) * 16384 + ((s + 2) & 3) * 4096);
        su_mma(sacc, fb);
    }
    __builtin_amdgcn_sched_group_barrier(0x100, 6, 0);
#pragma unroll
    for (int s = 0; s < 4 * NIMG - 1; ++s) { __builtin_amdgcn_sched_group_barrier(0x100, 6, 0); __builtin_amdgcn_sched_group_barrier(0x008, 2, 0); }
    __builtin_amdgcn_sched_group_barrier(0x008, 2, 0);
    SBAR();
}
__device__ __forceinline__ void state_update(f32x16 (&sacc)[2], const char* lds, int ldsbase, int wid, int lane) { state_update_t<1>(sacc, lds, ldsbase, L_KDEC, L_V, L_EDEC, wid, lane); }
__device__ __forceinline__ void write_simg(const f32x16 (&sacc)[2], char* lds, int wid, int lane) {
    const int r32 = lane & 31, hi = lane >> 5, j = wid >> 1, ib = 2 * (wid & 1);
#pragma unroll
    for (int i2 = 0; i2 < 2; ++i2)
#pragma unroll
        for (int r = 0; r < 16; ++r) { const int d = 32 * (ib + i2) + crow(r, hi);
            *(__hip_bfloat16*)(lds + L_S + (d >> 6) * 16384 + v_st<4>(d & 63, 32 * j + r32)) = __float2bfloat16(sacc[i2][r]); }
}
__device__ __forceinline__ f32x16 chunk_output(const char* lds, int ldsbase, int wid, int lane) {
    const int r32 = lane & 31, hi = lane >> 5, tb = wid & 1, j = wid >> 1;
    const char* QT = lds + L_QT; const char* KT = lds + L_KT; const char* QIN = lds + L_QIN;
    f32x16 p0 = f32x16{}, p1 = f32x16{};
#pragma unroll
    for (int d0 = 0; d0 < 8; ++d0) { const int cb = (d0 * 16 + hi * 8) * 2;
        const bf16x8 qf = *reinterpret_cast<const bf16x8*>(QT + KSWZ(32 * tb + r32, cb));
        const bf16x8 k0 = *reinterpret_cast<const bf16x8*>(KT + KSWZ(r32, cb));
        p0 = __builtin_amdgcn_mfma_f32_32x32x16_bf16(k0, qf, p0, 0, 0, 0);
        if (tb) { const bf16x8 k1 = *reinterpret_cast<const bf16x8*>(KT + KSWZ(32 + r32, cb)); p1 = __builtin_amdgcn_mfma_f32_32x32x16_bf16(k1, qf, p1, 0, 0, 0); } }
#pragma unroll
    for (int r = 0; r < 16; ++r) { const bool keep = crow(r, hi) <= r32; if (tb == 0) { p0[r] = keep ? p0[r] : 0.f; p1[r] = 0.f; } else { p1[r] = keep ? p1[r] : 0.f; } }
    bf16x8 pa0, pa1, pa2, pa3; pack4(p0, p1, pa0, pa1, pa2, pa3);
    f32x16 oacc = f32x16{};
    pv_blk<4>(oacc, ldsbase + L_V + v_rd_base(lane) + j * 512, pa0, pa1, pa2, pa3);
    const int vbS = ldsbase + L_S + v_rd_base(lane) + j * 512;
#define QINF(kd) (*reinterpret_cast<const bf16x8*>(QIN + KSWZ(32 * tb + r32, ((kd) * 16 + hi * 8) * 2)))
    {
        s16x4 lo[2], hh[2];
#define SADDR(kd) (vbS + ((kd) >> 2) * 16384 + ((kd) & 3) * 4096)
        lo[0] = vtr(SADDR(0)); hh[0] = vtr(SADDR(0) + 2048); lo[1] = vtr(SADDR(1)); hh[1] = vtr(SADDR(1) + 2048);
#pragma unroll
        for (int kd = 0; kd < 8; ++kd) {
            const bf16x8 b = PKF(lo[kd & 1], hh[kd & 1]); const bf16x8 q = QINF(kd);
            oacc = __builtin_amdgcn_mfma_f32_32x32x16_bf16(q, b, oacc, 0, 0, 0);
            if (kd + 2 < 8) { lo[kd & 1] = vtr(SADDR(kd + 2)); hh[kd & 1] = vtr(SADDR(kd + 2) + 2048); }
        }
#undef SADDR
    }
#undef QINF
    return oacc;
}

constexpr int P1_KDEC = 0, P1_V = 65536, P1_CUM = 131072, P1_EDEC = 135168;
struct BlockRegs { unsigned v[32], lf[32]; };
__device__ __forceinline__ void load_block(BlockRegs& R, const u16* Vh, const u16* LF, long rowbase, int colbase, int seg, int blk, int dir, int wid, int lane) {
    unsigned voff = (unsigned)lane * 4u; asm volatile("" : "+v"(voff));
#pragma unroll
    for (int i = 0; i < 32; ++i) {
        const int p = blk * 256 + wid * 32 + i;
        const long pos = rowbase + seg * 512 + (dir ? 511 - p : p);
        const size_t roff = ((size_t)pos * DM + colbase) * 2;
        R.v[i] = *(const unsigned*)((const char*)Vh + roff + voff); R.lf[i] = *(const unsigned*)((const char*)LF + roff + voff);
    }
}
__device__ __forceinline__ void prep_block(const BlockRegs& R, char* lds, int wid, int lane, float (&gtot)[2]) {
    float run0 = 0.f, run1 = 0.f;
#pragma unroll
    for (int i = 0; i < 32; ++i) { run0 += h2f((unsigned short)(R.lf[i] & 0xffff)); run1 += h2f((unsigned short)(R.lf[i] >> 16)); }
    float* cum = (float*)(lds + P1_CUM);
    *(float2*)(cum + wid * 128 + 2 * lane) = make_float2(run0, run1);
    __syncthreads();
    float pre0 = 0.f, pre1 = 0.f, gl0 = 0.f, gl1 = 0.f;
#pragma unroll
    for (int w2 = 0; w2 < 8; ++w2) { const float2 t = *(const float2*)(cum + w2 * 128 + 2 * lane); if (w2 < wid) { pre0 += t.x; pre1 += t.y; } gl0 += t.x; gl1 += t.y; }
    gtot[0] += gl0; gtot[1] += gl1;
    if (wid == 0) *(float2*)((float*)(lds + P1_EDEC) + 2 * lane) = make_float2(__builtin_amdgcn_exp2f(gl0), __builtin_amdgcn_exp2f(gl1));
    float G0 = pre0 - gl0, G1 = pre1 - gl1;
    char* base = lds + (wid >> 1) * 16384 + (wid & 1) * 8192 + v_st<4>(0, 2 * lane);
#pragma unroll
    for (int i = 0; i < 32; ++i) {
        const float lf0 = h2f((unsigned short)(R.lf[i] & 0xffff)), lf1 = h2f((unsigned short)(R.lf[i] >> 16));
        G0 += lf0; G1 += lf1;
        const float k0 = 1.0f - __builtin_amdgcn_exp2f(lf0), k1 = 1.0f - __builtin_amdgcn_exp2f(lf1);
        const int vo = v_st<4>(i, 0);
        *(unsigned*)(base + P1_KDEC + vo) = cvtpk(k0 * __builtin_amdgcn_exp2f(-G0), k1 * __builtin_amdgcn_exp2f(-G1));
        *(unsigned*)(base + P1_V + vo) = R.v[i];
    }
}
__device__ __forceinline__ void state_update_block(f32x16 (&sacc)[2], const char* lds, int ldsbase, int wid, int lane) { state_update_t<4>(sacc, lds, ldsbase, P1_KDEC, P1_V, P1_EDEC, wid, lane); }
__device__ __forceinline__ void hgrn_pass1(int item, const u16* Vt, const u16* LF0, const u16* LF1, float* ust, float* dst, char* lds) {
    int tid = threadIdx.x; asm volatile("" : "+v"(tid)); const int lane = tid & 63; const int wid = __builtin_amdgcn_readfirstlane(tid >> 6);
    const int seg = item & 7, dir = (item >> 3) & 1, bh = item >> 4, b = bh >> 3, h = bh & 7;
    const long rowbase = (long)b * SEQ; const int colbase = h * 128; const u16* LF = dir ? LF1 : LF0;
    const int ldsbase = (int)(uintptr_t)lds;
    f32x16 sacc[2] = {}; float gtot[2] = {0.f, 0.f};
    BlockRegs R;
    load_block(R, Vt, LF, rowbase, colbase, seg, 0, dir, wid, lane);
#pragma unroll 1
    for (int blk = 0; blk < 2; ++blk) {
        prep_block(R, lds, wid, lane, gtot);
        asm volatile("" ::: "memory");
        if (blk == 0) load_block(R, Vt, LF, rowbase, colbase, seg, 1, dir, wid, lane);
        __syncthreads();
        state_update_block(sacc, lds, ldsbase, wid, lane);
    }
    float* up = ust + (size_t)item * 16384 + wid * 2048;
#pragma unroll
    for (int i2 = 0; i2 < 2; ++i2)
#pragma unroll
        for (int r = 0; r < 16; ++r) up[(i2 * 16 + r) * 64 + lane] = sacc[i2][r];
    if (wid == 0) *(float2*)(dst + (size_t)item * 128 + 2 * lane) = make_float2(__builtin_amdgcn_exp2f(gtot[0]), __builtin_amdgcn_exp2f(gtot[1]));
    __syncthreads();
}

template <bool DRY, int PVAR = 0>
__device__ __forceinline__ void hgrn_pass2(int item, const u16* Qh, const u16* Vt, const u16* LF0, const u16* LF1, const u16* Gt, u16* OF, u16* Y,
                                           const float* ust, const float* dst, const float* __restrict__ nw, char* lds) {
    int tid = threadIdx.x; asm volatile("" : "+v"(tid)); const int lane = tid & 63, r32 = lane & 31, hi = lane >> 5; const int wid = __builtin_amdgcn_readfirstlane(tid >> 6);
    const int seg = item & 7, bh = item >> 3, b = bh >> 3, h = bh & 7;
    const long rowbase = (long)b * SEQ; const int colbase = h * 128;
    const int vw = ((wid & 3) << 1) | (wid >> 2);
    const int ldsbase = (int)(uintptr_t)lds; const int tb = vw & 1, j = vw >> 1, ib = 2 * (vw & 1);
    float* stg = (float*)(lds + L_STG);
    ChunkRegs R;
#pragma unroll 1
    for (int dir = 0; dir < 2; ++dir) {
        const u16* LF = dir ? LF1 : LF0;
        f32x16 sacc[2] = {}; float gtot[2] = {0.f, 0.f};
        const int nseg = dir ? (7 - seg) : seg;
        for (int n = 0; n < nseg; ++n) {
            const int sg = dir ? (7 - n) : n; const int it = ((bh * 2 + dir) * 8 + sg);
            const float* up = ust + (size_t)it * 16384 + vw * 2048; const float* dp = dst + (size_t)it * 128;
#pragma unroll
            for (int i2 = 0; i2 < 2; ++i2)
#pragma unroll
                for (int r = 0; r < 16; ++r) sacc[i2][r] = sacc[i2][r] * dp[32 * (ib + i2) + crow(r, hi)] + up[(i2 * 16 + r) * 64 + lane];
        }
        write_simg(sacc, lds, vw, lane);
        load_chunk<true>(R, Qh, Vt, LF, rowbase, colbase, dir ? (seg * 8 + 7) : (seg * 8), dir, wid, lane);
        for (int cc = 0; cc < 8; ++cc) {
            const int c = dir ? (seg * 8 + 7 - cc) : (seg * 8 + cc);
            const int ri = tid >> 3, rcg = tid & 7; const size_t goff = (size_t)(rowbase + chunk_pos(c, ri, dir)) * DM + colbase + rcg * 16;
            u32x4 pf0 = {}, pf1 = {}; bf16x8 pg0 = {}, pg1 = {};
            if (dir) { pf0 = *(const u32x4*)(OF + goff); pf1 = *(const u32x4*)(OF + goff + 8); pg0 = ld8(Gt + goff); pg1 = ld8(Gt + goff + 8); }
            if (PVAR != 1) prep_chunk<true>(R, lds, wid, lane, gtot); else { asm volatile("" :: "v"(R.q[0]), "v"(R.v[7]), "v"(R.lf[3])); __syncthreads(); }
            if (cc + 1 < 8) load_chunk<true>(R, Qh, Vt, LF, rowbase, colbase, dir ? (seg * 8 + 6 - cc) : (seg * 8 + cc + 1), dir, wid, lane);
            __syncthreads();
            f32x16 oacc = f32x16{};
            if (PVAR != 2) { oacc = chunk_output(lds, ldsbase, vw, lane); state_update(sacc, lds, ldsbase, vw, lane); }
            if (PVAR != 3) {
#pragma unroll
            for (int r = 0; r < 16; ++r) stg[(32 * tb + crow(r, hi)) * STG_LD + 32 * j + r32] = oacc[r];
            __syncthreads();
            write_simg(sacc, lds, vw, lane);
            {
                const int i = ri, cg = rcg; const float* sp = stg + i * STG_LD + cg * 16;
                f32x4 ov[4];
#pragma unroll
                for (int g = 0; g < 4; ++g) ov[g] = *(const f32x4*)(sp + g * 4);
                if (dir == 0) {
                    u32x4 w0, w1;
                    w0.x = pg8::pk_f16(ov[0][0], ov[0][1]); w0.y = pg8::pk_f16(ov[0][2], ov[0][3]); w0.z = pg8::pk_f16(ov[1][0], ov[1][1]); w0.w = pg8::pk_f16(ov[1][2], ov[1][3]);
                    w1.x = pg8::pk_f16(ov[2][0], ov[2][1]); w1.y = pg8::pk_f16(ov[2][2], ov[2][3]); w1.z = pg8::pk_f16(ov[3][0], ov[3][1]); w1.w = pg8::pk_f16(ov[3][2], ov[3][3]);
                    if (!DRY) { *(u32x4*)(OF + goff) = w0; *(u32x4*)(OF + goff + 8) = w1; } else asm volatile("" :: "v"(w0), "v"(w1));
                } else {
                    const u32x4 f0 = pf0, f1 = pf1;
                    float tv[16];
#pragma unroll
                    for (int e = 0; e < 4; ++e) { tv[2 * e] = h2f((unsigned short)(f0[e] & 0xffff)); tv[2 * e + 1] = h2f((unsigned short)(f0[e] >> 16));
                                                  tv[8 + 2 * e] = h2f((unsigned short)(f1[e] & 0xffff)); tv[8 + 2 * e + 1] = h2f((unsigned short)(f1[e] >> 16)); }
                    float ss = 0.f;
#pragma unroll
                    for (int e = 0; e < 16; ++e) { tv[e] += ov[e >> 2][e & 3]; ss += tv[e] * tv[e]; }
                    ss += __shfl_xor(ss, 1); ss += __shfl_xor(ss, 2); ss += __shfl_xor(ss, 4);
                    const float rs = __builtin_amdgcn_rsqf(ss * (1.0f / 128.0f) + EPS);
                    const bf16x8 g0 = pg0, g1 = pg1;
                    float yv[16];
#pragma unroll
                    for (int e = 0; e < 8; ++e) { yv[e] = tv[e] * rs * nw[cg * 16 + e] * bf2f((u16)g0[e]); yv[8 + e] = tv[8 + e] * rs * nw[cg * 16 + 8 + e] * bf2f((u16)g1[e]); }
                    u32x4 w0, w1;
                    w0.x = cvtpk(yv[0], yv[1]); w0.y = cvtpk(yv[2], yv[3]); w0.z = cvtpk(yv[4], yv[5]); w0.w = cvtpk(yv[6], yv[7]);
                    w1.x = cvtpk(yv[8], yv[9]); w1.y = cvtpk(yv[10], yv[11]); w1.z = cvtpk(yv[12], yv[13]); w1.w = cvtpk(yv[14], yv[15]);
                    if (!DRY) { *(u32x4*)(Y + goff) = w0; *(u32x4*)(Y + goff + 8) = w1; } else asm volatile("" :: "v"(w0), "v"(w1));
                }
            }
            } else { asm volatile("" :: "v"(oacc), "v"(sacc[0]), "v"(sacc[1]), "v"(pf0), "v"(pg0)); __syncthreads(); }
        }
        __syncthreads();
    }
}
}
#define GAS __attribute__((address_space(1)))
#define LAS __attribute__((address_space(3)))
typedef unsigned short bf16;
typedef unsigned v4u __attribute__((ext_vector_type(4)));
typedef float f32x4 __attribute__((ext_vector_type(4)));
typedef short bf16x8 __attribute__((ext_vector_type(8)));
typedef GAS unsigned gu32;
typedef GAS unsigned long long gu64;
#define RLX_AGENT __ATOMIC_RELAXED, __HIP_MEMORY_SCOPE_AGENT
#define LDS_WAIT() asm volatile("s_waitcnt lgkmcnt(0)" ::: "memory")
#define VM_WAIT() asm volatile("s_waitcnt vmcnt(0)" ::: "memory")
__device__ __forceinline__ unsigned long long rt() { return __builtin_amdgcn_s_memrealtime(); }
__device__ __forceinline__ unsigned f2bf(float f) { unsigned u = __builtin_bit_cast(unsigned, f); return (u + 0x7fffu + ((u >> 16) & 1u)) >> 16; }
__device__ __forceinline__ unsigned pk2(float lo, float hi) { return f2bf(lo) | (f2bf(hi) << 16); }

#define XB_TMO      128
#define XB_XCNT(j)  (256  + 64 * (j))
#define XB_XSUB(j)  (1280 + 64 * (j))
#define XB_XGEN(j)  (2304 + 64 * (j))
#define XB_TOP      3328
#define XB_TOPGEN   3392
#define XCD_BAR_WORDS 3456
#define XB_SPIN_CAP (1u << 18)

__device__ __forceinline__ unsigned xb_ld(unsigned* p)              { return __hip_atomic_load(p, __ATOMIC_RELAXED, __HIP_MEMORY_SCOPE_AGENT); }
__device__ __forceinline__ unsigned xb_add(unsigned* p, unsigned v) { return __hip_atomic_fetch_add(p, v, __ATOMIC_RELAXED, __HIP_MEMORY_SCOPE_AGENT); }
__device__ __forceinline__ unsigned xb_xcc_id() { return (unsigned)__builtin_amdgcn_s_getreg((3 << 11) | 20) & 0xFu; }
#define XB_SPIN(cond, bar) do { unsigned _sp = 0; while (cond) { __builtin_amdgcn_s_sleep(1); \
    if ((++_sp & 255u) == 0u) { if (xb_ld(&(bar)[XB_TMO])) break; if (_sp > XB_SPIN_CAP) { atomicAdd(&(bar)[XB_TMO], 1u); break; } } } } while (0)

struct XcdBarrier {
    unsigned* bar; unsigned x;
    volatile LAS unsigned* st;
};

__device__ __forceinline__ XcdBarrier xcd_barrier_post(unsigned* bar, volatile LAS unsigned* st) {
    XcdBarrier b; b.bar = bar; b.x = xb_xcc_id(); b.st = st;
    if (threadIdx.x == 0) (void)xb_add(&bar[XB_XCNT(b.x)], 1u);
    return b;
}
__device__ __forceinline__ void xcd_barrier_complete(unsigned* bar, unsigned x, unsigned& nloc, unsigned& nx) {
    const unsigned G = gridDim.x * gridDim.y * gridDim.z;
    unsigned sum, cnt, mine, sp = 0u;
    for (;;) {
        sum = 0u; cnt = 0u; mine = 0u;
#pragma unroll
        for (unsigned j = 0; j < 16; ++j) { const unsigned c = xb_ld(&bar[XB_XCNT(j)]); sum += c; cnt += (c > 0u) ? 1u : 0u; mine = (j == x) ? c : mine; }
        if (sum == G) break;
        __builtin_amdgcn_s_sleep(1);
        if ((++sp & 255u) == 0u) { if (xb_ld(&bar[XB_TMO])) break; if (sp > XB_SPIN_CAP) { atomicAdd(&bar[XB_TMO], 1u); break; } }
    }
    nloc = mine > 0u ? mine : 1u; nx = cnt > 0u ? cnt : 1u;
}

__device__ __forceinline__ void xcd_barrier(const XcdBarrier& b) {
    asm volatile("s_waitcnt vmcnt(0)" ::: "memory");
    __syncthreads();
    if (threadIdx.x == 0) {
        unsigned* bar = b.bar; asm volatile("" : "+s"(bar)); unsigned bx = __builtin_amdgcn_readfirstlane(b.x); asm volatile("" : "+s"(bx));
        __builtin_amdgcn_s_waitcnt(0);
        unsigned nloc = b.st[0], nx = b.st[1];
        if (nloc == 0u) { xcd_barrier_complete(bar, bx, nloc, nx); b.st[0] = nloc; b.st[1] = nx; }
        const unsigned old = xb_add(&bar[XB_XSUB(bx)], 1u);
        const unsigned gen = old / nloc;
        if (old + 1u == (gen + 1u) * nloc) {
            __builtin_amdgcn_fence(__ATOMIC_RELEASE, "agent");
            asm volatile("s_waitcnt vmcnt(0)" ::: "memory");
            const unsigned og = xb_add(&bar[XB_TOP], 1u);
            const unsigned tg = og / nx;
            if (og + 1u == (tg + 1u) * nx) xb_add(&bar[XB_TOPGEN], 1u);
            else XB_SPIN(xb_ld(&bar[XB_TOPGEN]) == tg, bar);
            __builtin_amdgcn_fence(__ATOMIC_ACQUIRE, "agent");
            xb_add(&bar[XB_XGEN(bx)], 1u);
            asm volatile("s_waitcnt vmcnt(0)" ::: "memory");
        } else {
            XB_SPIN(xb_ld(&bar[XB_XGEN(bx)]) == gen, bar);
            __builtin_amdgcn_fence(__ATOMIC_ACQUIRE, "agent");
            asm volatile("s_waitcnt vmcnt(0)" ::: "memory");
        }
    }
    __syncthreads();
}
#ifndef DUP_MASK
#define DUP_MASK 0
#endif
#define DUP(kind) (((DUP_MASK) >> (kind)) & 1)
#ifndef DUPR_MASK
#define DUPR_MASK 0
#endif
#define DUPR(kind) (((DUPR_MASK) >> (kind)) & 1)
#ifndef DUPR_MODE
#define DUPR_MODE 0
#endif
#ifndef MK_PER_PHASE
#define MK_PER_PHASE 0
#endif

constexpr size_t MiB = 1u << 20;
constexpr size_t WS_CTL = 0, CTL_ZERO_BYTES = 1 * MiB;
constexpr size_t WS_ROPE = 1 * MiB;
constexpr size_t WS_LB = 1 * MiB + 256 * 1024;
constexpr size_t WS_KMX = 1 * MiB + 384 * 1024;
constexpr size_t WS_DST = 1 * MiB + 512 * 1024;
constexpr size_t WS_SSQ = 2 * MiB;
constexpr size_t WS_WTE = 3 * MiB;
constexpr size_t WS_WTO = 25 * MiB;
constexpr size_t WS_XB = 38 * MiB;
constexpr size_t WS_R0 = 70 * MiB, RSZ = 32 * MiB;
constexpr size_t WS_END = WS_R0 + 6 * RSZ;
constexpr int CW_BAR = 4096;

constexpr int RING_BYTES = 139264;
constexpr int LDSCTL_OFF = RING_BYTES + 8 * pg8::EPI_STG_WAVE, MISC_OFF = LDSCTL_OFF + 320;
constexpr int LDS_BYTES = 163840;
constexpr int NWAVES = 8, GRID = 256;
constexpr int NPH = 20;

struct Frame {
    LAS unsigned char* lds; volatile LAS unsigned* MISC; gu32* ctl;
    int tid, lane, wave, vcu, G;
};

__device__ __forceinline__ void transpose_item(const float* W, const float* sc, int K, int N, bf16* WT, LAS float* scr, int item, int lane) {
    const int nblk = N / 32, kb = item / nblk, nb = item % nblk, k0 = 64 * kb, n0 = 32 * nb;
    const int c4 = lane & 7, rk = lane >> 3;
#pragma unroll
    for (int i = 0; i < 8; ++i) { const int kk = 8 * i + rk; const float s = sc ? sc[k0 + kk] : 1.0f;
        f32x4 v = *(const GAS f32x4*)(W + (size_t)(k0 + kk) * N + n0 + 4 * c4); v = v * s; *(LAS f32x4*)(scr + kk * 36 + 4 * c4) = v; }
    LDS_WAIT(); asm volatile("" ::: "memory");
    const int c = lane & 7;
#pragma unroll
    for (int j = 0; j < 4; ++j) { const int n = (lane >> 3) + 8 * j; const LAS float* s = scr + (8 * c) * 36 + n;
        v4u o; o.x = pk2(s[0 * 36], s[1 * 36]); o.y = pk2(s[2 * 36], s[3 * 36]); o.z = pk2(s[4 * 36], s[5 * 36]); o.w = pk2(s[6 * 36], s[7 * 36]);
        *(GAS v4u*)(WT + (size_t)(n0 + n) * K + k0 + 8 * c) = o; }
    LDS_WAIT(); asm volatile("" ::: "memory");
}
__device__ __forceinline__ void convert_layer(Frame& F, const float* Win, const float* nrm, int Nin, const float* Wout, bf16* dstbuf, int wg = -1, int nwg = 0) {
    int lane = F.lane; asm volatile("" : "+v"(lane));
    LAS float* scr = (LAS float*)(F.lds + F.wave * 16384);
    const int gw = (wg < 0 ? F.vcu : wg) * NWAVES + F.wave, NGW = (wg < 0 ? F.G : nwg) * NWAVES;
    const int I_in = (DM / 64) * (Nin / 32), I_out = (DIN / 64) * (DM / 32);
    bf16* wout_t = dstbuf + (size_t)Nin * DM;
    for (int it = gw; it < I_in + I_out; it += NGW) {
        if (it < I_in) transpose_item(Win, nrm, DM, Nin, dstbuf, scr, it, lane);
        else transpose_item(Wout, nullptr, DIN, DM, wout_t, scr, it - I_in, lane);
    }
}
__device__ __forceinline__ float wave_sum(float v) {
#pragma unroll
    for (int o = 1; o < 64; o <<= 1) v += __shfl_xor(v, o);
    return v;
}

__device__ __forceinline__ void stagger(int vcu, unsigned ticks) {
    if (vcu & 1) { const unsigned long long t0 = __builtin_amdgcn_s_memrealtime(); while (__builtin_amdgcn_s_memrealtime() - t0 < ticks) __builtin_amdgcn_s_sleep(8); }
}
#ifndef STAG_EVEN
#define STAG_EVEN 0
#endif
#ifndef STAG_ODD
#define STAG_ODD 0
#endif
struct Args { const float* in[13]; float* out; unsigned char* ws; int ph_lo, ph_hi; };

__global__ void __launch_bounds__(NWAVES * 64, 2) mk_fwd(Args args) {
    extern __shared__ __attribute__((aligned(16))) unsigned char lds[];
    Frame F;
    F.lds = (LAS unsigned char*)lds;
    F.MISC = (volatile LAS unsigned*)(F.lds + MISC_OFF);
    F.tid = threadIdx.x; F.lane = F.tid & 63; F.wave = __builtin_amdgcn_readfirstlane(F.tid >> 6);
    F.G = gridDim.x; { const int bx = blockIdx.x; F.vcu = (F.G % 8 == 0) ? (bx % 8) * (F.G / 8) + bx / 8 : bx; }
    unsigned char* ws = args.ws;
    F.ctl = (gu32*)(ws + WS_CTL);
    for (int u = F.tid; u < (LDS_BYTES - LDSCTL_OFF) / 4; u += NWAVES * 64) ((LAS unsigned*)(F.lds + LDSCTL_OFF))[u] = 0u;
    __syncthreads();
    const int lo = args.ph_lo, hi = args.ph_hi; (void)lo; (void)hi;
    const bool multi = MK_PER_PHASE ? ((hi - lo) > 1) : true;
    XcdBarrier bar; bar.bar = (unsigned*)(F.ctl + CW_BAR); bar.x = 0; bar.st = nullptr;
    if (multi) bar = xcd_barrier_post((unsigned*)(F.ctl + CW_BAR), F.MISC + 8);
#ifndef PHASE_MASK
#define PHASE_MASK 0xFFFF
#endif
#if MK_PER_PHASE
#define INK(kind, k) ((((PHASE_MASK) >> (kind)) & 1) && lo <= (k) && (k) < hi)
#define IN(k) (lo <= (k) && (k) < hi)
#else
#define INK(kind, k) (((PHASE_MASK) >> (kind)) & 1)
#define IN(k) true
#endif
#if MK_PER_PHASE
#define SEAM(k) do { if (IN(k) && IN((k) + 1)) xcd_barrier(bar); } while (0)
#else
#define SEAM(k) do { xcd_barrier(bar); if (DUP(9)) xcd_barrier(bar); } while (0)
#endif

#define PTRS() size_t wz_ = 0; asm volatile("" : "+s"(wz_)); unsigned char* wsl = args.ws + wz_; \
    const float* x_in = args.in[0]; float* xres = args.out; \
    float* rope = (float*)(wsl + WS_ROPE); float* lbt = (float*)(wsl + WS_LB); float* dstv = (float*)(wsl + WS_DST); float* ssq = (float*)(wsl + WS_SSQ); unsigned* kmx = (unsigned*)(wsl + WS_KMX); (void)kmx; \
    bf16* wte = (bf16*)(wsl + WS_WTE); bf16* wto = (bf16*)(wsl + WS_WTO); bf16* xb = (bf16*)(wsl + WS_XB); float* ust = args.out;     \
    unsigned char* R0 = wsl + WS_R0; unsigned char* R1 = R0 + RSZ; unsigned char* R2 = R1 + RSZ; unsigned char* R3 = R2 + RSZ; unsigned char* R4 = R3 + RSZ; unsigned char* R5 = R4 + RSZ; \
    const int gw = F.vcu * NWAVES + F.wave, NGW = F.G * NWAVES; int tidl = threadIdx.x; asm volatile("" : "+v"(tidl)); const int lanel = tidl & 63; (void)lanel; \
    (void)x_in; (void)xres; (void)rope; (void)lbt; (void)dstv; (void)ssq; (void)wte; (void)wto; (void)xb; (void)ust; (void)R0; (void)R1; (void)R2; (void)R3; (void)R4; (void)R5; (void)gw; (void)NGW;

    for (int rep_ = 0; rep_ < (DUP(0) ? 2 : 1); ++rep_)
    if (INK(0, 0)) {
        PTRS();
        convert_layer(F, args.in[2], args.in[1], EVEN_IN, args.in[7], wte);
        convert_layer(F, args.in[9], args.in[8], ODD_IN, args.in[11], wto);
        {
            const int gt = F.vcu * (NWAVES * 64) + tidl, NGT = F.G * NWAVES * 64;
            for (int e = gt; e < SEQ * 8; e += NGT) { const int pos = e >> 3, i = e & 7; const double inv = pow(500000.0, -(double)i / 8.0); const double ang = (double)pos * inv;
                rope[e] = (float)cos(ang); rope[SEQ * 8 + e] = (float)sin(ang); }
            const float* lg = args.in[6];
            for (int e = gt; e < 2 * 1024; e += NGT) { const int dir = e >> 10, c = e & 1023; const float l0 = lg[(dir * 2 + 0) * 1024 + c], l1 = lg[(dir * 2 + 1) * 1024 + c];
                lbt[e] = 0.0f; lbt[2048 + e] = 1.0f / (1.0f + expf(l0 - l1)); }
            if (gt < 4 * NB * 16 + 2 * NB * 32) kmx[gt] = 0u;
        }
        for (int m = gw; m < T; m += NGW) {
            const GAS f32x4* xr = (const GAS f32x4*)(x_in + (size_t)m * DM) + lanel; f32x4 v[4]; float s = 0.f;
#pragma unroll
            for (int j = 0; j < 4; ++j) { v[j] = xr[64 * j]; s += (v[j].x * v[j].x + v[j].y * v[j].y) + (v[j].z * v[j].z + v[j].w * v[j].w); }
            s = wave_sum(s);
            GAS unsigned long long* o8 = (GAS unsigned long long*)(xb + (size_t)m * DM) + lanel;
#pragma unroll
            for (int j = 0; j < 4; ++j) o8[64 * j] = (unsigned long long)pk2(v[j].x, v[j].y) | ((unsigned long long)pk2(v[j].z, v[j].w) << 32);
            if (lanel < 16) ssq[(size_t)m * 16 + lanel] = (lanel == 0) ? s : 0.0f;
        }
    }
    SEAM(0);

#pragma unroll 1
    for (int layer = 0; layer < 4; ++layer) {
        const int j = layer >> 1; const bool even = (layer & 1) == 0;
        const int pb = 1 + (layer >> 1) * 9 + (even ? 0 : 6);
        if (even) {
            const float lam_init = (j == 0) ? 0.2f : 0.470713018f;
            if (INK(1, pb + 0)) {
        PTRS();
                pg8::Gemm g{xb, wte, T, 4096, DM, DM, 1 << 30, 0l}; pg8::StaticOrder S; S.init(T, 4096, F.G, (int)blockIdx.x);
                pg8::EpiIn<true> E{ssq, rope, lbt + j * 2048, R0, R1, R2, R3, R4, R5, 0, nullptr, kmx + j * (NB * 16)};
                if (DUP(1)) { pg8::EpiDry ED; pg8::gemm_phase(F.lds, g, S, ED); }
                if (DUPR(1)) { pg8::EpiIn<true, DUPR_MODE> E2{ssq, rope, lbt + j * 2048, R0, R1, R2, R3, R4, R5, 0, nullptr, kmx + j * (NB * 16)}; pg8::gemm_phase(F.lds, g, S, E2); }
                if (STAG_EVEN) stagger(F.vcu, STAG_EVEN);
                pg8::gemm_phase(F.lds, g, S, E);
            }
            SEAM(pb + 0);
            if (INK(2, pb + 1)) {
        PTRS();
                if (layer == 2) { convert_layer(F, args.in[9] + (size_t)DM * ODD_IN, args.in[8] + DM, ODD_IN, args.in[11] + (size_t)DIN * DM, wto); __syncthreads(); }
                const float* lq = args.in[3] + j * 256; float s1 = 0.f, s2 = 0.f;
                for (int i = 0; i < 64; ++i) { s1 += lq[i] * lq[64 + i]; s2 += lq[128 + i] * lq[192 + i]; }
                const float lam = expf(s1) - expf(s2) + lam_init;
                if (DUP(2)) for (int i = 0; i < 4; ++i) { const int bh = (F.vcu >> 5) * 4 + i, qb = F.vcu & 31;
                    att::diff_attn_unit<true, DUPR_MODE>(bh >> 3, bh & 7, qb, (const att::u16*)R0, (const att::u16*)R1, (const att::u16*)R2, (const att::u16*)R3, (att::u16*)R0,
                                        args.in[4] + j * 128, lam, 1.0f - lam_init, kmx + j * (NB * 16), (char*)lds); }
                for (int i = 0; i < 4; ++i) { const int bh = (F.vcu >> 5) * 4 + i, qb = F.vcu & 31;
                    att::diff_attn_unit<false>(bh >> 3, bh & 7, qb, (const att::u16*)R0, (const att::u16*)R1, (const att::u16*)R2, (const att::u16*)R3, (att::u16*)R0,
                                        args.in[4] + j * 128, lam, 1.0f - lam_init, kmx + j * (NB * 16), (char*)lds); }
            }
            SEAM(pb + 1);
            if (INK(1, pb + 2)) {
        PTRS();
                pg8::Gemm g{xb, wte + (size_t)4096 * DM, T, 5120, DM, DM, 1 << 30, 0l}; pg8::StaticOrder S; S.init(T, 5120, F.G, (int)blockIdx.x);
                pg8::EpiIn<true> E{ssq, rope, lbt + j * 2048, R0, R1, R2, R3, R4, R5, 16};
                if (DUP(1)) { pg8::EpiDry ED; pg8::gemm_phase(F.lds, g, S, ED); }
                if (DUPR(1)) { pg8::EpiIn<true, DUPR_MODE> E2{ssq, rope, lbt + j * 2048, R0, R1, R2, R3, R4, R5, 16}; pg8::gemm_phase(F.lds, g, S, E2); }
                if (STAG_EVEN) stagger(F.vcu, STAG_EVEN);
                pg8::gemm_phase(F.lds, g, S, E);
            }
            SEAM(pb + 2);
            if (INK(3, pb + 3)) {
        PTRS();
                if (DUP(3)) for (int it = F.vcu; it < 512; it += F.G) hg::hgrn_pass1(it, (const att::u16*)R2, (const att::u16*)R4, (const att::u16*)R5, ust, dstv, (char*)lds);
                for (int it = F.vcu; it < 512; it += F.G) hg::hgrn_pass1(it, (const att::u16*)R2, (const att::u16*)R4, (const att::u16*)R5, ust, dstv, (char*)lds);
            }
            SEAM(pb + 3);
            if (INK(4, pb + 4)) {
        PTRS();
                if (DUP(4)) for (int it = F.vcu; it < 256; it += F.G) hg::hgrn_pass2<true, DUPR_MODE>(it, (const att::u16*)R1, (const att::u16*)R2, (const att::u16*)R4, (const att::u16*)R5, (const att::u16*)R3,
                                                                        (att::u16*)R4, (att::u16*)R1, ust, dstv, args.in[5] + j * 128, (char*)lds);
                for (int it = F.vcu; it < 256; it += F.G) hg::hgrn_pass2<false>(it, (const att::u16*)R1, (const att::u16*)R2, (const att::u16*)R4, (const att::u16*)R5, (const att::u16*)R3,
                                                                        (att::u16*)R4, (att::u16*)R1, ust, dstv, args.in[5] + j * 128, (char*)lds);
            }
            SEAM(pb + 4);
            if (INK(5, pb + 5)) {
        PTRS();
                pg8::Gemm g{(const bf16*)R0, wte + (size_t)EVEN_IN * DM, T, DM, DIN, DM, 16, (long)RSZ - 2048l}; pg8::StaticOrder S; S.init(T, DM, F.G, (int)blockIdx.x);
                if (DUP(5)) { pg8::EpiDry ED; pg8::gemm_phase(F.lds, g, S, ED); }
                if (layer == 0) { pg8::EpiOut<true, false> E{x_in, xres, xb, ssq}; pg8::gemm_phase(F.lds, g, S, E); }
                else            { pg8::EpiOut<false, false> E{x_in, xres, xb, ssq}; pg8::gemm_phase(F.lds, g, S, E); }
            }
            SEAM(pb + 5);
        } else {
            if (INK(6, pb + 0)) {
        PTRS();
                pg8::Gemm g{xb, wto, T, ODD_IN, DM, DM, 1 << 30, 0l}; pg8::StaticOrder S; S.init(T, ODD_IN, F.G, (int)blockIdx.x);
                pg8::EpiIn<false> E{ssq, rope, nullptr, R0, R1, R2, R3, R4, R5, 0, kmx + 4 * NB * 16 + j * (NB * 32), kmx + (2 + j) * (NB * 16)};
                if (DUP(6)) { pg8::EpiDry ED; pg8::gemm_phase(F.lds, g, S, ED); }
                if (DUPR(6)) pg8::gemm_phase(F.lds, g, S, E);
                if (STAG_ODD) stagger(F.vcu, STAG_ODD);
                pg8::gemm_phase(F.lds, g, S, E);
                if (layer == 1 && (int)blockIdx.x >= 128 && F.G == 256)
                    convert_layer(F, args.in[2] + (size_t)DM * EVEN_IN, args.in[1] + DM, EVEN_IN, args.in[7] + (size_t)DIN * DM, wte, (int)blockIdx.x - 128, 128);
            }
            SEAM(pb + 0);
            if (INK(7, pb + 1)) {
        PTRS();
                if (DUP(7)) att::swa_phase<true>(2 * F.vcu, (const att::u16*)R0, (const att::u16*)R2, (const att::u16*)(R2 + (size_t)T * 256 * 2), (const att::u16*)R3, (att::u16*)R0, args.in[10] + j * 32, kmx + 4 * NB * 16 + j * (NB * 32), kmx + (2 + j) * (NB * 16), (char*)lds);
                att::swa_phase<false>(2 * F.vcu, (const att::u16*)R0, (const att::u16*)R2, (const att::u16*)(R2 + (size_t)T * 256 * 2), (const att::u16*)R3, (att::u16*)R0, args.in[10] + j * 32, kmx + 4 * NB * 16 + j * (NB * 32), kmx + (2 + j) * (NB * 16), (char*)lds);
            }
            SEAM(pb + 1);
            if (INK(5, pb + 2)) {
        PTRS();
                pg8::Gemm g{(const bf16*)R0, wto + (size_t)ODD_IN * DM, T, DM, DIN, DIN, 1 << 30, 0l}; pg8::StaticOrder S; S.init(T, DM, F.G, (int)blockIdx.x);
                if (DUP(5)) { pg8::EpiDry ED; pg8::gemm_phase(F.lds, g, S, ED); }
                if (layer == 3) { pg8::EpiOut<false, true> E{x_in, xres, xb, ssq}; pg8::gemm_phase(F.lds, g, S, E); }
                else            { pg8::EpiOut<false, false> E{x_in, xres, xb, ssq}; pg8::gemm_phase(F.lds, g, S, E); }
            }
            SEAM(pb + 2);
        }
    }
    if (INK(8, 19)) {
        PTRS();
        const float* fw = args.in[12];
        for (int m = gw; m < T; m += NGW) {
            GAS f32x4* xr = (GAS f32x4*)(xres + (size_t)m * DM) + lanel; f32x4 v[4]; float s = 0.f;
#pragma unroll
            for (int jj = 0; jj < 4; ++jj) { v[jj] = xr[64 * jj]; s += (v[jj].x * v[jj].x + v[jj].y * v[jj].y) + (v[jj].z * v[jj].z + v[jj].w * v[jj].w); }
            s = wave_sum(s); const float rs = 1.0f / sqrtf(s * (1.0f / DM) + EPS);
#pragma unroll
            for (int jj = 0; jj < 4; ++jj) { const f32x4 w = *((const f32x4*)fw + lanel + 64 * jj); xr[64 * jj] = v[jj] * rs * w; }
        }
    }
#undef IN
#undef INK
#undef SEAM
}

extern "C" void kernel_launch(void* const* d_in, const int* in_sizes, int n_in, void* d_out, int out_size, void* d_ws, size_t ws_size, hipStream_t stream) {
    static int ok = 0;
    if (ok == 0) {
        if (n_in != 13 || in_sizes[0] != T * DM || out_size != T * DM || ws_size < WS_END) { fprintf(stderr, "kernel_launch: shape/workspace mismatch (n_in %d, ws %zu, need %zu)\n", n_in, ws_size, (size_t)WS_END); ok = -1; return; }
        if (hipFuncSetAttribute((const void*)mk_fwd, hipFuncAttributeMaxDynamicSharedMemorySize, LDS_BYTES) != hipSuccess) { fprintf(stderr, "kernel_launch: hipFuncSetAttribute failed\n"); ok = -1; return; }
        int per_cu = 0;
        if (hipOccupancyMaxActiveBlocksPerMultiprocessor(&per_cu, (const void*)mk_fwd, NWAVES * 64, LDS_BYTES) != hipSuccess || per_cu < 1) fprintf(stderr, "kernel_launch: occupancy query reports %d\n", per_cu);
        (void)hipGetLastError();
        ok = 1;
    }
    if (ok < 0) return;
    (void)hipMemsetAsync((char*)d_ws + WS_CTL, 0, CTL_ZERO_BYTES, stream);
    Args a{};
    for (int i = 0; i < 13; ++i) a.in[i] = (const float*)d_in[i];
    a.out = (float*)d_out; a.ws = (unsigned char*)d_ws;
#if MK_PER_PHASE
    for (int p = 0; p < NPH; ++p) { a.ph_lo = p; a.ph_hi = p + 1; hipLaunchKernelGGL(mk_fwd, dim3(GRID), dim3(NWAVES * 64), LDS_BYTES, stream, a); }
#else
    a.ph_lo = 0; a.ph_hi = NPH;
    hipLaunchKernelGGL(mk_fwd, dim3(GRID), dim3(NWAVES * 64), LDS_BYTES, stream, a);
#endif
    const hipError_t le = hipPeekAtLastError();
    if (le != hipSuccess) fprintf(stderr, "kernel_launch: launch failed: %s\n", hipGetErrorName(le));
}
```

```cpp
#include <hip/hip_runtime.h>
#include <hip/hip_bf16.h>
#include <cstdio>
#include <cstdint>

constexpr int NB = 4, SEQ = 4096, DM = 1024, T = NB * SEQ;
constexpr int EVEN_IN = 9216, ODD_IN = 4608, DIN = 2048;
constexpr float EPS = 1e-6f;
constexpr float C2 = 0.125f * 1.4426950408889634f;
constexpr float LOG2E = 1.4426950408889634f;

namespace pg8 {
#define PG8_LAS __attribute__((address_space(3)))
typedef unsigned short bf16_t;
typedef short bf16x8 __attribute__((ext_vector_type(8)));
typedef float f32x4 __attribute__((ext_vector_type(4)));
typedef unsigned u32x4 __attribute__((ext_vector_type(4)));
constexpr int BM = 256, BK = 64, HALF = 128, HTB = HALF * BK * 2, STAGE_BYTES = 8 * HTB, NXCD = 8, WGM = 4;
constexpr int EPI_STG_OFF = 139264, EPI_STG_RS = 144, EPI_STG_WAVE = 16 * EPI_STG_RS;

__host__ __device__ __forceinline__ int lds_byte(int r, int c) { const int st = (r >> 4) * 2 + (c >> 5), rr = r & 15, cc = c & 31, ob = rr * 64 + cc * 2; return st * 1024 + (ob ^ (((ob >> 9) & 1) << 5)); }
__host__ __device__ __forceinline__ void stage_rc(int b, int& R, int& C) { const int st = b / 1024, sb = b % 1024, swz = sb ^ (((sb >> 9) & 1) << 5); R = (st >> 1) * 16 + swz / 64; C = (st & 1) * 32 + (swz % 64) / 2; }
__host__ __device__ __forceinline__ int perm32(int rho) { const int n = rho >> 4, i = rho & 15; return 8 * (i >> 2) + 4 * n + (i & 3); }

struct Unit { int pm, pn; };
struct Gemm { const bf16_t* A; const bf16_t* Bt; int M, N, K, lda, ksplit; long jump; };

struct StaticOrder {
    int nM, nN, nwg, G, c;
    __host__ __device__ void init(int M, int N, int G_, int c_) { nM = M / BM; nN = N / BM; nwg = nM * nN; G = G_; c = c_; }
    __host__ __device__ bool next(int i, Unit& u) const {
        const long L = (long)i * G + c; if (L >= nwg) return false;
        int wgid = (int)L; { const int q = nwg / NXCD, r = nwg % NXCD, xcd = wgid % NXCD, off = wgid / NXCD; wgid = (xcd < r ? xcd * (q + 1) : r * (q + 1) + (xcd - r) * q) + off; }
        const int nig = WGM * nN, gid = wgid / nig, fm = gid * WGM, gsz = (nM - fm) < WGM ? (nM - fm) : WGM;
        u.pm = fm + ((wgid % nig) % gsz); u.pn = (wgid % nig) / gsz; return true;
    }
};

__device__ __forceinline__ unsigned cvt_pk_bf16(float lo, float hi) { unsigned r; asm volatile("v_cvt_pk_bf16_f32 %0, %1, %2" : "=v"(r) : "v"(lo), "v"(hi)); return r; }

template <class Epi>
__device__ __forceinline__ void gemm_phase(PG8_LAS unsigned char* lds, const Gemm g, const StaticOrder& S, const Epi& E) {
    int tid = threadIdx.x; asm volatile("" : "+v"(tid));
    const int wid = __builtin_amdgcn_readfirstlane(tid >> 6), lane = tid & 63, wr = wid >> 2, wc = wid & 3, fr = lane & 15, fq = lane >> 4;
    const int K = g.K, nt = K / BK, lda = g.lda;
    unsigned voffA[2], voffB[2];
#pragma unroll
    for (int i = 0; i < 2; ++i) { int R, C; stage_rc(tid * 16 + i * 8192, R, C); const int Rb = 64 * (R >> 5) + perm32(R & 31);
        voffA[i] = (unsigned)(R * lda + C) * 2u; voffB[i] = (unsigned)(Rb * K + C) * 2u; }
    const size_t kstep = (size_t)(BK * 2);
    const size_t hstepA = (size_t)HALF * lda * 2, tstepA = 2 * hstepA;
    const size_t hstepB = (size_t)32 * K * 2, tstepB = (size_t)BM * K * 2;
    const unsigned ldsw = (unsigned)wid * 1024u;
    const int aoff = lds_byte(wr * 64 + fr, fq * 8), boff = lds_byte(wc * 32 + fr, fq * 8);
    const int ksplit = g.ksplit; const long jump = g.jump;
#define PG8_AP(base, t) ((base) + (size_t)(t) * kstep + (((t) >= ksplit) ? jump : 0l))
#define PG8_SA(b, h) (((b) * 2 + (h)) * HTB)
#define PG8_SB(b, h) ((4 + (b) * 2 + (h)) * HTB)
#define PG8_STAGE(bufoff, gbase, voff) do { _Pragma("unroll") for (int _i = 0; _i < 2; ++_i) \
        __builtin_amdgcn_global_load_lds((const unsigned*)((const char*)(gbase) + (voff)[_i]), (PG8_LAS unsigned*)(lds + (bufoff) + ldsw + _i * 8192), 16, 0, 0); } while (0)
#define PG8_LDA(dst, b, h) do { _Pragma("unroll") for (int m = 0; m < 4; ++m) _Pragma("unroll") for (int k = 0; k < 2; ++k) dst[m][k] = *(const PG8_LAS bf16x8*)(lds + PG8_SA(b, h) + aoff + m * 2048 + k * 1024); } while (0)
#define PG8_LDB(dst, b, h) do { _Pragma("unroll") for (int n = 0; n < 2; ++n) _Pragma("unroll") for (int k = 0; k < 2; ++k) dst[n][k] = *(const PG8_LAS bf16x8*)(lds + PG8_SB(b, h) + boff + n * 2048 + k * 1024); } while (0)
#define PG8_MMA(ai, bj, At, Bt) do { __builtin_amdgcn_s_setprio(1); _Pragma("unroll") for (int m = 0; m < 4; ++m) _Pragma("unroll") for (int n = 0; n < 2; ++n) _Pragma("unroll") for (int k = 0; k < 2; ++k) \
        acc[ai][bj][m][n] = __builtin_amdgcn_mfma_f32_16x16x32_bf16(Bt[n][k], At[m][k], acc[ai][bj][m][n], 0, 0, 0); __builtin_amdgcn_s_setprio(0); } while (0)
#define PG8_WAIT_V(n) asm volatile("s_waitcnt vmcnt(" #n ")" ::: "memory")
#define PG8_WAIT_L(n) asm volatile("s_waitcnt lgkmcnt(" #n ")" ::: "memory")
#define PG8_BAR __builtin_amdgcn_s_barrier()
#define PG8_SCHED __builtin_amdgcn_sched_barrier(0)
    Unit cur, nxt; int ui = 0;
    if (!S.next(0, cur)) return;
    f32x4 acc[2][2][4][2];
#pragma unroll
    for (int a = 0; a < 2; ++a)
#pragma unroll
        for (int b = 0; b < 2; ++b)
#pragma unroll
            for (int m = 0; m < 4; ++m)
#pragma unroll
                for (int n = 0; n < 2; ++n) acc[a][b][m][n] = (f32x4){0.f, 0.f, 0.f, 0.f};
    bf16x8 At[4][2], B0[2][2], B1[2][2];
    const char* cA = (const char*)g.A + (size_t)cur.pm * tstepA; const char* cB = (const char*)g.Bt + (size_t)cur.pn * tstepB;
    {
        PG8_STAGE(PG8_SB(0, 0), cB, voffB); PG8_STAGE(PG8_SB(0, 1), cB + hstepB, voffB); PG8_STAGE(PG8_SA(0, 0), cA, voffA); PG8_STAGE(PG8_SA(0, 1), cA + hstepA, voffA);
        if (wr == 1) PG8_BAR;
        PG8_WAIT_V(2); PG8_BAR;
        PG8_STAGE(PG8_SB(1, 0), cB + kstep, voffB); PG8_STAGE(PG8_SA(1, 0), PG8_AP(cA, 1), voffA); PG8_STAGE(PG8_SB(1, 1), cB + hstepB + kstep, voffB);
        PG8_WAIT_V(6); PG8_BAR;
    }
    for (;;) {
        const bool has_next = S.next(ui + 1, nxt);
        const char* nA = has_next ? (const char*)g.A + (size_t)nxt.pm * tstepA : cA; const char* nB = has_next ? (const char*)g.Bt + (size_t)nxt.pn * tstepB : cB;
        for (int t = 0; t < nt; t += 2) {
            const bool last = (t == nt - 2);
            const char* a1 = PG8_AP(cA, t + 1);
            const char* a2 = last ? nA : PG8_AP(cA, t + 2); const char* b2 = last ? nB : cB + (size_t)(t + 2) * kstep;
            const char* a3 = a2 + kstep; const char* b3 = b2 + kstep;
            PG8_LDB(B0, 0, 0); PG8_LDB(B1, 0, 1); PG8_SCHED; PG8_LDA(At, 0, 0); PG8_STAGE(PG8_SA(1, 1), a1 + hstepA, voffA);
            PG8_WAIT_V(8); PG8_WAIT_L(0); PG8_BAR; PG8_MMA(0, 0, At, B0); PG8_MMA(0, 1, At, B1); PG8_BAR; PG8_SCHED;
            PG8_LDA(At, 0, 1); PG8_STAGE(PG8_SB(0, 0), b2, voffB); PG8_STAGE(PG8_SB(0, 1), b2 + hstepB, voffB); PG8_STAGE(PG8_SA(0, 0), a2, voffA);
            PG8_WAIT_V(8); PG8_WAIT_L(0); PG8_BAR; PG8_MMA(1, 0, At, B0); PG8_MMA(1, 1, At, B1); PG8_BAR; PG8_SCHED;
            PG8_LDB(B0, 1, 0); PG8_LDB(B1, 1, 1); PG8_SCHED; PG8_LDA(At, 1, 0); PG8_STAGE(PG8_SA(0, 1), a2 + hstepA, voffA);
            PG8_WAIT_V(8); PG8_WAIT_L(0); PG8_BAR; PG8_MMA(0, 0, At, B0); PG8_MMA(0, 1, At, B1); PG8_BAR; PG8_SCHED;
            PG8_LDA(At, 1, 1); PG8_STAGE(PG8_SB(1, 0), b3, voffB); PG8_STAGE(PG8_SB(1, 1), b3 + hstepB, voffB); PG8_STAGE(PG8_SA(1, 0), a3, voffA);
            PG8_WAIT_V(8); PG8_WAIT_L(0); PG8_BAR; PG8_MMA(1, 0, At, B0); PG8_MMA(1, 1, At, B1); PG8_BAR; PG8_SCHED;
        }
        if (wr == 0) PG8_BAR;
        E(acc, cur, wr, wc, fr, fq, lds + EPI_STG_OFF + wid * EPI_STG_WAVE, lane);
        if (!has_next) break;
#pragma unroll
        for (int a = 0; a < 2; ++a)
#pragma unroll
            for (int b = 0; b < 2; ++b)
#pragma unroll
                for (int m = 0; m < 4; ++m)
#pragma unroll
                    for (int n = 0; n < 2; ++n) acc[a][b][m][n] = (f32x4){0.f, 0.f, 0.f, 0.f};
        cur = nxt; cA = nA; cB = nB; ++ui;
        if (wr == 1) PG8_BAR;
    }
    PG8_WAIT_V(0);
    PG8_BAR;
#undef PG8_AP
#undef PG8_SA
#undef PG8_SB
#undef PG8_STAGE
#undef PG8_LDA
#undef PG8_LDB
#undef PG8_MMA
#undef PG8_WAIT_V
#undef PG8_WAIT_L
#undef PG8_BAR
#undef PG8_SCHED
}
}
namespace pg8 {
typedef unsigned short u16;
__device__ __forceinline__ float fsigmoid(float v) { return __builtin_amdgcn_rcpf(1.0f + __expf(-v)); }
__device__ __forceinline__ unsigned pk_f16(float lo, float hi) { _Float16 a = (_Float16)lo, b = (_Float16)hi; return (unsigned)__builtin_bit_cast(unsigned short, a) | ((unsigned)__builtin_bit_cast(unsigned short, b) << 16); }


__device__ __forceinline__ void store_rows128(PG8_LAS unsigned char* stg, u16* blk  , size_t pitch, u32x4 w0, u32x4 w1, int fr, int fq, int lane) {
    *(PG8_LAS u32x4*)(stg + fr * EPI_STG_RS + fq * 16) = w0; *(PG8_LAS u32x4*)(stg + fr * EPI_STG_RS + 64 + fq * 16) = w1;
    const int rr = lane >> 3, ch = lane & 7;
    const u32x4 a = *(const PG8_LAS u32x4*)(stg + rr * EPI_STG_RS + ch * 16), b = *(const PG8_LAS u32x4*)(stg + (8 + rr) * EPI_STG_RS + ch * 16);
    *(u32x4*)(blk + (size_t)rr * pitch + ch * 8) = a; *(u32x4*)(blk + (size_t)(8 + rr) * pitch + ch * 8) = b;
}

__device__ __forceinline__ float bf_lo(unsigned w) { return __uint_as_float(w << 16); }
__device__ __forceinline__ float bf_hi(unsigned w) { return __uint_as_float(w & 0xffff0000u); }
enum { K_PLAIN = 0, K_SILU = 1, K_ROPEQ = 2, K_ROPEK = 3, K_LOGF = 4, K_ROPEQN = 5 };

template <bool EVEN, int MODE = 0> struct EpiIn {
    static constexpr bool PERM = true;
    const float* ssq;
    const float* rope;
    const float* lb;
    unsigned char* r0; unsigned char* r1; unsigned char* r2; unsigned char* r3; unsigned char* r4; unsigned char* r5;
    int pn_off;
    unsigned* qmx = nullptr;
    unsigned* kmx = nullptr;
    __device__ __forceinline__ void operator()(const f32x4 (&acc)[2][2][4][2], const Unit& u, int wr, int wc, int fr, int fq, PG8_LAS unsigned char* stg, int lane) const {
        const int gpn = u.pn + pn_off;
        int kind, pitch, colt, dir = 0; u16* outp;
        if (EVEN) {
            const int grp = gpn >> 2; colt = (gpn & 3) * 256; pitch = 1024;
            switch (grp) {
                case 0: kind = K_ROPEQ; outp = (u16*)r0; break;
                case 1: kind = K_ROPEK; outp = (u16*)r1; break;
                case 2: kind = K_PLAIN; outp = (u16*)r2; break;
                case 3: kind = K_SILU;  outp = (u16*)r3; break;
                case 4: kind = K_SILU;  outp = (u16*)r1; break;
                case 5: kind = K_LOGF;  outp = (u16*)r4; dir = 0; break;
                case 6: kind = K_LOGF;  outp = (u16*)r5; dir = 1; break;
                case 7: kind = K_PLAIN; outp = (u16*)r2; break;
                default: kind = K_SILU; outp = (u16*)r3; break;
            }
        } else {
            if (gpn < 8)       { kind = K_ROPEQN; outp = (u16*)r0; pitch = 2048; colt = gpn * 256; }
            else if (gpn == 8) { kind = K_ROPEK; outp = (u16*)r2; pitch = 256;  colt = 0; }
            else if (gpn == 9) { kind = K_PLAIN; outp = (u16*)(r2 + (size_t)T * 256 * 2); pitch = 256; colt = 0; }
            else               { kind = K_SILU;  outp = (u16*)r3; pitch = 2048; colt = (gpn - 10) * 256; }
        }
        int row0 = u.pm * BM + wr * 64 + fr; asm volatile("" : "+v"(row0));
        if (MODE == 2) kind = K_PLAIN;
        float rsv[8];
#pragma unroll
        for (int hb = 0; hb < 2; ++hb) { f32x4 sq[4];
#pragma unroll
          for (int i = 0; i < 4; ++i) sq[i] = *((const f32x4*)(ssq + (size_t)(row0 + hb * HALF + i * 16) * 16) + fq);
#pragma unroll
          for (int i = 0; i < 4; ++i) { float tot = (sq[i][0] + sq[i][1]) + (sq[i][2] + sq[i][3]); tot += __shfl_xor(tot, 16); tot += __shfl_xor(tot, 32); rsv[hb * 4 + i] = __builtin_amdgcn_rsqf(tot * (1.0f / DM) + EPS); }
          asm volatile("" ::: "memory"); }
        u16* const blk0 = outp + (size_t)(row0 - fr) * pitch + colt + wc * 64;
        if (kind == K_LOGF)        rows<K_LOGF>(acc, rsv, blk0, pitch, colt + wc * 64, dir, row0, 1.0f, fr, fq, stg, lane);
        else if (kind == K_SILU)   rows<K_SILU>(acc, rsv, blk0, pitch, 0, 0, row0, 1.0f, fr, fq, stg, lane);
        else if (kind == K_PLAIN)  rows<K_PLAIN>(acc, rsv, blk0, pitch, 0, 0, row0, 1.0f, fr, fq, stg, lane);
        else if (kind == K_ROPEK)  rows<K_ROPEK>(acc, rsv, blk0, pitch, colt + wc * 64, 0, row0, 1.0f, fr, fq, stg, lane);
        else if (kind == K_ROPEQN) rows<K_ROPEQN>(acc, rsv, blk0, pitch, colt + wc * 64, 0, row0, C2, fr, fq, stg, lane);
        else                       rows<K_ROPEQ>(acc, rsv, blk0, pitch, 0, 0, row0, (kind == K_ROPEQ) ? C2 : 1.0f, fr, fq, stg, lane);
    }
    template <int KIND>
    __device__ __forceinline__ void rows(const f32x4 (&acc)[2][2][4][2], const float (&rsv)[8], u16* blk0, int pitch, int ccol, int dir, int row0, float qs, int fr, int fq, PG8_LAS unsigned char* stg, int lane) const {
        f32x4 lbv[2][2];
        if (KIND == K_LOGF) {
#pragma unroll
            for (int bj = 0; bj < 2; ++bj) { const int c0 = ccol + bj * 32 + 8 * fq; lbv[bj][0] = *(const f32x4*)(lb + dir * 1024 + c0); lbv[bj][1] = *(const f32x4*)(lb + dir * 1024 + c0 + 4); }
        }
        f32x4 cs0, cs1, sn0, sn1, ncs0, ncs1, nsn0, nsn1;
        constexpr bool ROPE = (KIND == K_ROPEQ || KIND == K_ROPEK || KIND == K_ROPEQN), NORMX = (KIND == K_ROPEK || KIND == K_ROPEQN); float kn2 = 0.f;
        if (ROPE) { const int pos = row0 & (SEQ - 1); const f32x4* cp = (const f32x4*)(rope + (size_t)pos * 8); const f32x4* spn = (const f32x4*)(rope + (size_t)SEQ * 8 + (size_t)pos * 8);
            ncs0 = cp[0]; ncs1 = cp[1]; nsn0 = spn[0]; nsn1 = spn[1]; }
#pragma unroll
        for (int ai = 0; ai < 2; ++ai)
#pragma unroll
            for (int m = 0; m < 4; ++m) {
                const float rs = rsv[ai * 4 + m];
                if (ROPE) { cs0 = ncs0; cs1 = ncs1; sn0 = nsn0; sn1 = nsn1;
                    if (ai * 4 + m < 7) { const int i2 = ai * 4 + m + 1; const int pos = (row0 + (i2 >> 2) * HALF + (i2 & 3) * 16) & (SEQ - 1);
                        const f32x4* cp = (const f32x4*)(rope + (size_t)pos * 8); const f32x4* spn = (const f32x4*)(rope + (size_t)SEQ * 8 + (size_t)pos * 8);
                        ncs0 = cp[0]; ncs1 = cp[1]; nsn0 = spn[0]; nsn1 = spn[1]; } }
                u32x4 wst[2];
#pragma unroll
                for (int bj = 0; bj < 2; ++bj) {
                    f32x4 v0 = acc[ai][bj][m][0] * rs, v1 = acc[ai][bj][m][1] * rs;
                    u32x4 w;
                    if (KIND == K_LOGF) {
                        const f32x4 l0 = lbv[bj][0], l1 = lbv[bj][1];
                        float o[8];
#pragma unroll
                        for (int e = 0; e < 4; ++e) { const float f0 = l0[e] + (1.0f - l0[e]) * fsigmoid(v0[e]), f1 = l1[e] + (1.0f - l1[e]) * fsigmoid(v1[e]);
                            o[e] = fmaxf(__builtin_amdgcn_logf(f0), -43.2808512f); o[4 + e] = fmaxf(__builtin_amdgcn_logf(f1), -43.2808512f); }
                        w.x = pk_f16(o[0], o[1]); w.y = pk_f16(o[2], o[3]); w.z = pk_f16(o[4], o[5]); w.w = pk_f16(o[6], o[7]);
                    } else {
                        if (KIND == K_SILU) {
#pragma unroll
                            for (int e = 0; e < 4; ++e) { v0[e] = v0[e] * fsigmoid(v0[e]); v1[e] = v1[e] * fsigmoid(v1[e]); }
                        } else if (ROPE && bj == 0) {
                            f32x4 o0, o1;
#pragma unroll
                            for (int e = 0; e < 4; ++e) { o0[e] = __shfl_xor(v0[e], 16); o1[e] = __shfl_xor(v1[e], 16); }
                            if (fq < 2) {
                                const float sg = (fq == 0) ? -1.0f : 1.0f;
                                v0 = v0 * cs0 + (o0 * sn0) * sg; v1 = v1 * cs1 + (o1 * sn1) * sg;
                            }
                        }
                        if (KIND == K_ROPEQ || KIND == K_ROPEQN) { v0 = v0 * qs; v1 = v1 * qs; }
                        w.x = cvt_pk_bf16(v0[0], v0[1]); w.y = cvt_pk_bf16(v0[2], v0[3]); w.z = cvt_pk_bf16(v1[0], v1[1]); w.w = cvt_pk_bf16(v1[2], v1[3]);
                    }
                    wst[bj] = w;
                }
                if (NORMX) {
                    float n2 = 0.f;
#pragma unroll
                    for (int bj = 0; bj < 2; ++bj) { const u32x4 w = wst[bj]; const float a0 = bf_lo(w.x), a1 = bf_hi(w.x), a2 = bf_lo(w.y), a3 = bf_hi(w.y), a4 = bf_lo(w.z), a5 = bf_hi(w.z), a6 = bf_lo(w.w), a7 = bf_hi(w.w);
                        n2 += (a0 * a0 + a1 * a1) + (a2 * a2 + a3 * a3) + (a4 * a4 + a5 * a5) + (a6 * a6 + a7 * a7); }
                    n2 += __shfl_xor(n2, 16); n2 += __shfl_xor(n2, 32); kn2 = fmaxf(kn2, n2);
                }
                if (MODE != 1) store_rows128(stg, blk0 + (size_t)(ai * HALF + m * 16) * pitch, (size_t)pitch, wst[0], wst[1], fr, fq, lane); else asm volatile("" :: "v"(wst[0]), "v"(wst[1]));
            }
        if (NORMX) {
            int ln; asm volatile("v_mbcnt_lo_u32_b32 %0, -1, 0\n\tv_mbcnt_hi_u32_b32 %0, -1, %0" : "=v"(ln));
#pragma unroll
            for (int o = 1; o < 16; o <<= 1) kn2 = fmaxf(kn2, __uint_as_float(__builtin_amdgcn_ds_bpermute((ln ^ o) << 2, __float_as_uint(kn2))));
            if (ln == 0) __hip_atomic_fetch_max((KIND == K_ROPEK) ? kmx + (row0 / SEQ) * 16 + (ccol >> 6) : qmx + (row0 / SEQ) * 32 + (ccol >> 6), __float_as_uint(kn2), __ATOMIC_RELAXED, __HIP_MEMORY_SCOPE_AGENT);
        }
    }
};

template <bool FIRST, bool LAST> struct EpiOut {
    static constexpr bool PERM = true;
    const float* xin; float* xout; u16* xb; float* ssq;
    __device__ __forceinline__ void operator()(const f32x4 (&acc)[2][2][4][2], const Unit& u, int wr, int wc, int fr, int fq, PG8_LAS unsigned char* stg, int lane) const {
        int row0 = u.pm * BM + wr * 64 + fr; asm volatile("" : "+v"(row0));
        const int cb = u.pn * BM + wc * 64 + 8 * fq;
        f32x4 nx[2][2];
#define LOADX(dst, rw) do { _Pragma("unroll") for (int bj = 0; bj < 2; ++bj) { const size_t off = (size_t)(rw) * DM + cb + bj * 32; \
            if (FIRST) { dst[bj][0] = *(const f32x4*)(xin + off); dst[bj][1] = *(const f32x4*)(xin + off + 4); } \
            else { const u32x4 w = *(const u32x4*)(xb + off); dst[bj][0] = (f32x4){bf_lo(w.x), bf_hi(w.x), bf_lo(w.y), bf_hi(w.y)}; dst[bj][1] = (f32x4){bf_lo(w.z), bf_hi(w.z), bf_lo(w.w), bf_hi(w.w)}; } } } while (0)
        LOADX(nx, row0);
#pragma unroll
        for (int ai = 0; ai < 2; ++ai)
#pragma unroll
            for (int m = 0; m < 4; ++m) {
                const int row = row0 + ai * HALF + m * 16; float part = 0.f; u32x4 wst[2];
                f32x4 ox[2][2];
#pragma unroll
                for (int bj = 0; bj < 2; ++bj) { ox[bj][0] = nx[bj][0]; ox[bj][1] = nx[bj][1]; }
                if (ai * 4 + m < 7) { const int i2 = ai * 4 + m + 1; LOADX(nx, row0 + (i2 >> 2) * HALF + (i2 & 3) * 16); }
#pragma unroll
                for (int bj = 0; bj < 2; ++bj) {
                    const size_t off = (size_t)row * DM + cb + bj * 32;
                    const f32x4 n0 = ox[bj][0] + acc[ai][bj][m][0], n1 = ox[bj][1] + acc[ai][bj][m][1];
                    if (LAST) { *(f32x4*)(xout + off) = n0; *(f32x4*)(xout + off + 4) = n1; }
                    else {
                        u32x4 w; w.x = cvt_pk_bf16(n0[0], n0[1]); w.y = cvt_pk_bf16(n0[2], n0[3]); w.z = cvt_pk_bf16(n1[0], n1[1]); w.w = cvt_pk_bf16(n1[2], n1[3]);
                        wst[bj] = w;
                        const f32x4 r0 = (f32x4){bf_lo(w.x), bf_hi(w.x), bf_lo(w.y), bf_hi(w.y)}, r1 = (f32x4){bf_lo(w.z), bf_hi(w.z), bf_lo(w.w), bf_hi(w.w)};
                        part += (r0[0] * r0[0] + r0[1] * r0[1]) + (r0[2] * r0[2] + r0[3] * r0[3]) + (r1[0] * r1[0] + r1[1] * r1[1]) + (r1[2] * r1[2] + r1[3] * r1[3]);
                    }
                }
                if (!LAST) { part += __shfl_xor(part, 16); part += __shfl_xor(part, 32);
                    if (fq == 0) ssq[(size_t)row * 16 + u.pn * 4 + wc] = part;
                    store_rows128(stg, xb + (size_t)(row - fr) * DM + u.pn * BM + wc * 64, (size_t)DM, wst[0], wst[1], fr, fq, lane); }
            }
#undef LOADX
    }
};
struct EpiDry {
    static constexpr bool PERM = true;
    __device__ __forceinline__ void operator()(const f32x4 (&acc)[2][2][4][2], const Unit&, int, int, int, int, PG8_LAS unsigned char*, int) const {
#pragma unroll
        for (int a = 0; a < 2; ++a)
#pragma unroll
            for (int b = 0; b < 2; ++b)
#pragma unroll
                for (int m = 0; m < 4; ++m) asm volatile("" :: "v"(acc[a][b][m][0]), "v"(acc[a][b][m][1]));
    }
};
}
namespace att {
typedef unsigned short u16;
using bf16x8 = __attribute__((ext_vector_type(8))) short;
using s16x4  = __attribute__((ext_vector_type(4))) short;
using f32x16 = __attribute__((ext_vector_type(16))) float;
using f32x4  = __attribute__((ext_vector_type(4))) float;
using u32x4  = __attribute__((ext_vector_type(4))) unsigned;
#define KSWZ(row, colB) ((row) * 256 + ((colB) ^ (((row) & 7) << 4)))
#define KSWZ128(row, colB) ((row) * 128 + ((colB) ^ (((row) & 7) << 4)))
#define SBAR() __builtin_amdgcn_sched_barrier(0)
constexpr float THRL = 8.0f;
__device__ __forceinline__ int crow(int r, int hi) { return (r & 3) + 8 * (r >> 2) + 4 * hi; }
__device__ __forceinline__ unsigned cvtpk(float lo, float hi) { unsigned r; asm volatile("v_cvt_pk_bf16_f32 %0, %1, %2" : "=v"(r) : "v"(lo), "v"(hi)); return r; }
__device__ __forceinline__ bf16x8 ld8(const u16* p) { return *reinterpret_cast<const bf16x8*>(p); }
__device__ __forceinline__ float bf2f(unsigned short h) { return __uint_as_float((unsigned)h << 16); }

__device__ __forceinline__ void partialSM(f32x16& p0, f32x16& p1, float& m_reg, float& alpha) {
    float pmax = p0[0];
#pragma unroll
    for (int r = 1; r < 16; ++r) pmax = fmaxf(pmax, p0[r]);
#pragma unroll
    for (int r = 0; r < 16; ++r) pmax = fmaxf(pmax, p1[r]);
    { auto rr = __builtin_amdgcn_permlane32_swap(__float_as_uint(pmax), __float_as_uint(pmax), false, false);
      pmax = fmaxf(__uint_as_float(rr[0]), __uint_as_float(rr[1])); }
    float mn;
    if (__builtin_expect(__all(pmax - m_reg <= THRL), 1)) { mn = m_reg; alpha = 1.f; }
    else { mn = fmaxf(m_reg, pmax); alpha = __builtin_amdgcn_exp2f(m_reg - mn); m_reg = mn; }
#pragma unroll
    for (int r = 0; r < 16; ++r) { p0[r] -= mn; p1[r] -= mn; }
#pragma unroll
    for (int r = 0; r < 16; ++r) p0[r] = __builtin_amdgcn_exp2f(p0[r]);
}
__device__ __forceinline__ void finishSM(f32x16& p0, f32x16& p1, float alpha, float& l_reg, bf16x8& pa0, bf16x8& pa1, bf16x8& pa2, bf16x8& pa3) {
#pragma unroll
    for (int r = 0; r < 16; ++r) p1[r] = __builtin_amdgcn_exp2f(p1[r]);
    float ps = 0;
#pragma unroll
    for (int r = 0; r < 16; ++r) ps += p0[r];
#pragma unroll
    for (int r = 0; r < 16; ++r) ps += p1[r];
    { auto rr = __builtin_amdgcn_permlane32_swap(__float_as_uint(ps), __float_as_uint(ps), false, false);
      ps = __uint_as_float(rr[0]) + __uint_as_float(rr[1]); }
    l_reg = l_reg * alpha + ps;
#define PK4(P, BASE, OUT) do { unsigned a0 = cvtpk(P[BASE + 0], P[BASE + 1]), a1 = cvtpk(P[BASE + 2], P[BASE + 3]);   \
    unsigned b0 = cvtpk(P[BASE + 4], P[BASE + 5]), b1 = cvtpk(P[BASE + 6], P[BASE + 7]);                              \
    auto r0 = __builtin_amdgcn_permlane32_swap(a0, b0, false, false); auto r1 = __builtin_amdgcn_permlane32_swap(a1, b1, false, false); \
    u32x4 w = {r0[0], r1[0], r0[1], r1[1]}; OUT = *reinterpret_cast<bf16x8*>(&w); } while (0)
    PK4(p0, 0, pa0); PK4(p0, 8, pa1); PK4(p1, 0, pa2); PK4(p1, 8, pa3);
}
__device__ __forceinline__ void pack4(const f32x16& p0, const f32x16& p1, bf16x8& pa0, bf16x8& pa1, bf16x8& pa2, bf16x8& pa3) {
    PK4(p0, 0, pa0); PK4(p0, 8, pa1); PK4(p1, 0, pa2); PK4(p1, 8, pa3);
}
#undef PK4

template <int NCB> __device__ __forceinline__ int v_st(int k, int c) { const int kk = (k & ~0xC) | ((k & 4) << 1) | ((k & 8) >> 1); return ((kk >> 3) * NCB + (c >> 5)) * 512 + ((kk & 7) * 32 + (c & 31)) * 2; }
__device__ __forceinline__ int v_rd_base(int lane) { return ((lane & 3) << 3) | (((lane >> 2) & 3) << 6) | (((lane >> 4) & 1) << 5) | (((lane >> 5) & 1) << 8); }
template <int OFF> __device__ __forceinline__ s16x4 tr_read(int vb) { s16x4 r; asm volatile("ds_read_b64_tr_b16 %0, %1 offset:%2" : "=&v"(r) : "v"(vb), "i"(OFF) : "memory"); return r; }
#define PKF(L, H) (bf16x8){L[0], L[1], L[2], L[3], H[0], H[1], H[2], H[3]}
template <int NCB> __device__ __forceinline__ void pv_blk(f32x16& od, int vb, bf16x8 pa0, bf16x8 pa1, bf16x8 pa2, bf16x8 pa3) {
    constexpr int KS = NCB * 1024, HF = NCB * 512;
    const s16x4 l0 = tr_read<0 * KS>(vb), h0 = tr_read<0 * KS + HF>(vb), l1 = tr_read<1 * KS>(vb), h1 = tr_read<1 * KS + HF>(vb);
    const s16x4 l2 = tr_read<2 * KS>(vb), h2 = tr_read<2 * KS + HF>(vb), l3 = tr_read<3 * KS>(vb), h3 = tr_read<3 * KS + HF>(vb);
    asm volatile("s_waitcnt lgkmcnt(0)" ::: "memory"); SBAR();
    od = __builtin_amdgcn_mfma_f32_32x32x16_bf16(pa0, PKF(l0, h0), od, 0, 0, 0);
    od = __builtin_amdgcn_mfma_f32_32x32x16_bf16(pa1, PKF(l1, h1), od, 0, 0, 0);
    od = __builtin_amdgcn_mfma_f32_32x32x16_bf16(pa2, PKF(l2, h2), od, 0, 0, 0);
    od = __builtin_amdgcn_mfma_f32_32x32x16_bf16(pa3, PKF(l3, h3), od, 0, 0, 0);
}


template <int NCB> __device__ __forceinline__ int v_stn(int k, int c) { return ((k >> 3) * NCB + (c >> 5)) * 512 + ((k & 7) * 32 + (c & 31)) * 2; }
__device__ __forceinline__ float max3f(float a, float b, float c) { return fmaxf(fmaxf(a, b), c); }
__device__ __forceinline__ void fill16(f32x16& v, float x) {
#pragma unroll
    for (int r = 0; r < 16; ++r) v[r] = x;
}
template <bool FIRST>
__device__ __forceinline__ void partialSM_n(f32x16& p0, f32x16& p1, float& m_reg, f32x16& negm, float& alpha) {
    float a = max3f(p0[0], p0[1], p0[2]), b = max3f(p0[3], p0[4], p0[5]), c = max3f(p1[0], p1[1], p1[2]), d = max3f(p1[3], p1[4], p1[5]);
    a = max3f(a, p0[6], p0[7]); b = max3f(b, p0[8], p0[9]); c = max3f(c, p1[6], p1[7]); d = max3f(d, p1[8], p1[9]);
    a = max3f(a, p0[10], p0[11]); b = max3f(b, p0[12], p0[13]); c = max3f(c, p1[10], p1[11]); d = max3f(d, p1[12], p1[13]);
    a = max3f(a, p0[14], p0[15]); c = max3f(c, p1[14], p1[15]);
    float pmax = fmaxf(fmaxf(a, b), fmaxf(c, d));
    { auto rr = __builtin_amdgcn_permlane32_swap(__float_as_uint(pmax), __float_as_uint(pmax), false, false);
      pmax = fmaxf(__uint_as_float(rr[0]), __uint_as_float(rr[1])); }
    if (!FIRST && __builtin_expect(__all(pmax <= THRL), 1)) { alpha = 1.f; }
    else { const float dl = FIRST ? pmax : fmaxf(pmax, 0.f); m_reg += dl; alpha = FIRST ? 0.f : __builtin_amdgcn_exp2f(-dl);
#pragma unroll
        for (int r = 0; r < 16; ++r) { p0[r] -= dl; p1[r] -= dl; }
        fill16(negm, -m_reg); asm volatile("" : "+v"(negm)); }
#pragma unroll
    for (int r = 0; r < 16; ++r) p0[r] = __builtin_amdgcn_exp2f(p0[r]);
}
#define PKN(P, B) (u32x4){cvtpk(P[B + 0], P[B + 1]), cvtpk(P[B + 2], P[B + 3]), cvtpk(P[B + 4], P[B + 5]), cvtpk(P[B + 6], P[B + 7])}
template <bool SUM>
__device__ __forceinline__ void finishSM_n(f32x16& p0, f32x16& p1, float alpha, float& l_reg, bf16x8& pa0, bf16x8& pa1, bf16x8& pa2, bf16x8& pa3) {
#pragma unroll
    for (int r = 0; r < 16; ++r) p1[r] = __builtin_amdgcn_exp2f(p1[r]);
    if (SUM) {
        float s0 = (p0[0] + p0[1]) + (p0[2] + p0[3]), s1 = (p0[4] + p0[5]) + (p0[6] + p0[7]), s2 = (p0[8] + p0[9]) + (p0[10] + p0[11]), s3 = (p0[12] + p0[13]) + (p0[14] + p0[15]);
        float t0 = (p1[0] + p1[1]) + (p1[2] + p1[3]), t1 = (p1[4] + p1[5]) + (p1[6] + p1[7]), t2 = (p1[8] + p1[9]) + (p1[10] + p1[11]), t3 = (p1[12] + p1[13]) + (p1[14] + p1[15]);
        float ps = ((s0 + s1) + (s2 + s3)) + ((t0 + t1) + (t2 + t3));
        { auto rr = __builtin_amdgcn_permlane32_swap(__float_as_uint(ps), __float_as_uint(ps), false, false);
          ps = __uint_as_float(rr[0]) + __uint_as_float(rr[1]); }
        l_reg = l_reg * alpha + ps;
    }
    { u32x4 w = PKN(p0, 0); pa0 = *reinterpret_cast<bf16x8*>(&w); } { u32x4 w = PKN(p0, 8); pa1 = *reinterpret_cast<bf16x8*>(&w); }
    { u32x4 w = PKN(p1, 0); pa2 = *reinterpret_cast<bf16x8*>(&w); } { u32x4 w = PKN(p1, 8); pa3 = *reinterpret_cast<bf16x8*>(&w); }
}

__device__ __forceinline__ void qkt_da(f32x16& p0, f32x16& p1, const char* Ks, const bf16x8* qr, const f32x16& negm, int r32, int hi, int cb0) {
#pragma unroll
    for (int d0 = 0; d0 < 4; ++d0) { const int cb = cb0 + (d0 * 16 + hi * 8) * 2;
        const bf16x8 b0 = *reinterpret_cast<const bf16x8*>(Ks + KSWZ(r32, cb));
        const bf16x8 b1 = *reinterpret_cast<const bf16x8*>(Ks + KSWZ(32 + r32, cb));
        if (d0 == 0) { p0 = __builtin_amdgcn_mfma_f32_32x32x16_bf16(b0, qr[0], negm, 0, 0, 0); p1 = __builtin_amdgcn_mfma_f32_32x32x16_bf16(b1, qr[0], negm, 0, 0, 0); }
        else { p0 = __builtin_amdgcn_mfma_f32_32x32x16_bf16(b0, qr[d0], p0, 0, 0, 0); p1 = __builtin_amdgcn_mfma_f32_32x32x16_bf16(b1, qr[d0], p1, 0, 0, 0); } }
}
typedef short v4i16_t __attribute__((ext_vector_type(4)));
__device__ __forceinline__ s16x4 vtr(int addr) { return __builtin_bit_cast(s16x4, __builtin_amdgcn_ds_read_tr16_b64_v4i16((__attribute__((address_space(3))) v4i16_t*)(unsigned)addr)); }
__device__ __forceinline__ void pv_da(f32x16* o, int vb, bf16x8 pa0, bf16x8 pa1, bf16x8 pa2, bf16x8 pa3) {
    s16x4 lo[4], hi[4];
#define VADDR(i) (vb + ((i) & 3) * 512 + ((i) >> 2) * 4096)
#pragma unroll
    for (int i = 0; i < 4; ++i) { lo[i] = vtr(VADDR(i)); hi[i] = vtr(VADDR(i) + 2048); }
#pragma unroll
    for (int i = 0; i < 16; ++i) {
        const bf16x8 vf = PKF(lo[i & 3], hi[i & 3]);
        const bf16x8 pa = ((i >> 2) == 0) ? pa0 : ((i >> 2) == 1) ? pa1 : ((i >> 2) == 2) ? pa2 : pa3;
        o[i & 3] = __builtin_amdgcn_mfma_f32_32x32x16_bf16(pa, vf, o[i & 3], 0, 0, 0);
        if (i + 4 < 16) { lo[i & 3] = vtr(VADDR(i + 4)); hi[i & 3] = vtr(VADDR(i + 4) + 2048); }
    }
#undef VADDR
    __builtin_amdgcn_sched_group_barrier(0x100, 8, 0);
#pragma unroll
    for (int i = 0; i < 12; ++i) { __builtin_amdgcn_sched_group_barrier(0x008, 1, 0); __builtin_amdgcn_sched_group_barrier(0x100, 2, 0); __builtin_amdgcn_sched_group_barrier(0x002, 4, 0); }
#pragma unroll
    for (int i = 0; i < 4; ++i) { __builtin_amdgcn_sched_group_barrier(0x008, 1, 0); __builtin_amdgcn_sched_group_barrier(0x002, 4, 0); }
}
#define DA_PIN(x) asm volatile("" : "+v"(x))
#define DA_MFMA(a, b, c) __builtin_amdgcn_mfma_f32_32x32x16_bf16(a, b, c, 0, 0, 0)
#define DA_WAIT_BAR(N) asm volatile("s_waitcnt vmcnt(" #N ") lgkmcnt(0)\n\ts_barrier" ::: "memory")
__device__ __forceinline__ void glds16(const void* g, unsigned lds_base) {
    unsigned sv; asm volatile("s_mov_b32 %0, m0\n\ts_mov_b32 m0, %2\n\ts_nop 0\n\tglobal_load_lds_dwordx4 %1, off\n\ts_mov_b32 m0, %0" : "=&s"(sv) : "v"(g), "s"(lds_base) : "memory"); }
__device__ __forceinline__ bf16x8 kld(int addr) { return *(const __attribute__((address_space(3))) bf16x8*)(unsigned)addr; }
__device__ __forceinline__ float rowmax32(const f32x16& p0, const f32x16& p1) {
    float a = max3f(p0[0], p0[1], p0[2]), b = max3f(p0[3], p0[4], p0[5]), c = max3f(p1[0], p1[1], p1[2]), d = max3f(p1[3], p1[4], p1[5]);
    a = max3f(a, p0[6], p0[7]); b = max3f(b, p0[8], p0[9]); c = max3f(c, p1[6], p1[7]); d = max3f(d, p1[8], p1[9]);
    a = max3f(a, p0[10], p0[11]); b = max3f(b, p0[12], p0[13]); c = max3f(c, p1[10], p1[11]); d = max3f(d, p1[12], p1[13]);
    a = max3f(a, p0[14], p0[15]); c = max3f(c, p1[14], p1[15]);
    const float pmax = fmaxf(fmaxf(a, b), fmaxf(c, d));
    auto rr = __builtin_amdgcn_permlane32_swap(__float_as_uint(pmax), __float_as_uint(pmax), false, false);
    return fmaxf(__uint_as_float(rr[0]), __uint_as_float(rr[1]));
}
constexpr int DA_KSL = 16384, DA_VRING = 49152, DA_WS = 133120, DA_STG = 65536, DA_STG_LD = 132;
template <bool DRY, int PVAR = 0>
__device__ __forceinline__ void diff_attn_unit(int b, int h, int qb, const u16* Qa, const u16* __restrict__ Ka, const u16* __restrict__ Va, const u16* __restrict__ Ga,
                                               u16* Y, const float* __restrict__ subw, float lam, float one_m_li, const unsigned* __restrict__ kmx, char* lds) {
    int tid = threadIdx.x; asm volatile("" : "+v"(tid)); const int lane = tid & 63, r32 = lane & 31, hi = lane >> 5; const int wid = __builtin_amdgcn_readfirstlane(tid >> 6);
    const int map = wid >> 2, wq = wid & 3;
    const long rowbase = (long)b * SEQ; const int q0 = qb * 128;
    float* wsf = (float*)(lds + DA_WS) + wid * 64; float* li_l = wsf; float* al_l = wsf + 32;
    float m_reg = 0.f, l_reg = 0; f32x16 o[4] = {}; bf16x8 qr[4]; f32x16 negm = f32x16{}; asm volatile("" : "+v"(negm));
    const unsigned lds0 = (unsigned)(uintptr_t)lds;
    const u16* Kh = Ka + rowbase * DM + h * 128; const u16* Vh = Va + rowbase * DM + h * 128;
    const int cb0 = map * 128;
    unsigned kofs[2], vofs[2];
#pragma unroll
    for (int i = 0; i < 2; ++i) { const int pk = 2 * wid + i;
        const int row = 4 * pk + (lane >> 4), cp = lane & 15; kofs[i] = (unsigned)(row * DM + ((cp ^ (row & 7)) * 8)) * 2u;
        const int st = 2 * pk + (lane >> 5), kk = 8 * (st >> 2) + ((lane & 31) >> 2), cc = 32 * (st & 3) + 8 * (lane & 3); vofs[i] = (unsigned)(kk * DM + cc) * 2u; }
    const char* Kg = (const char*)Kh; const char* Vg = (const char*)Vh;
#define DMA_K(t, slot) do { _Pragma("unroll") for (int i_ = 0; i_ < 2; ++i_) glds16(Kg + (size_t)(t) * (64 * DM * 2) + kofs[i_], (unsigned)__builtin_amdgcn_readfirstlane(lds0 + (slot) + (2 * wid + i_) * 1024)); } while (0)
#define DMA_V(t, slot) do { _Pragma("unroll") for (int i_ = 0; i_ < 2; ++i_) glds16(Vg + (size_t)(t) * (64 * DM * 2) + vofs[i_], (unsigned)__builtin_amdgcn_readfirstlane(lds0 + DA_VRING + (slot) + (2 * wid + i_) * 1024)); } while (0)
    DMA_K(0, 0); DMA_V(0, 0); DMA_K(1, DA_KSL);
    const u16* Qw = Qa + (rowbase + q0 + wq * 32 + r32) * DM + h * 128 + map * 64 + hi * 8;
#pragma unroll
    for (int d0 = 0; d0 < 4; ++d0) qr[d0] = ld8(Qw + d0 * 16);
    DMA_K(2, 2 * DA_KSL);
    int ka[4];
#pragma unroll
    for (int d0 = 0; d0 < 4; ++d0) ka[d0] = (int)lds0 + KSWZ(r32, cb0 + (d0 * 16 + hi * 8) * 2);
    const int vb0 = (int)lds0 + DA_VRING + v_rd_base(lane);
    constexpr int NT = SEQ / 64;
    f32x16 pA0, pA1, pB0, pB1; bf16x8 kf[8]; s16x4 vlo[4], vhi[4]; u32x4 pw0, pw1, pw2, pw3; bool resc = false;
    int sl_prev = 0, sl_cur = 0, sl_next = DA_KSL;
#define ROT() do { sl_prev = sl_cur; sl_cur = sl_next; sl_next = (sl_next == 2 * DA_KSL) ? 0 : sl_next + DA_KSL; } while (0)
#define RESC() do { if (resc) { _Pragma("unroll") for (int d_ = 0; d_ < 4; ++d_) _Pragma("unroll") for (int r = 0; r < 16; ++r) o[d_][r] *= al_l[crow(r, hi)]; } } while (0)
#define KLOAD(slot) do { _Pragma("unroll") for (int d0 = 0; d0 < 4; ++d0) { kf[2 * d0] = kld(ka[d0] + (slot)); kf[2 * d0 + 1] = kld(ka[d0] + (slot) + 8192); } } while (0)
    float mb;
    { float q2 = 0.f;
#pragma unroll
      for (int d0 = 0; d0 < 4; ++d0)
#pragma unroll
          for (int e = 0; e < 8; ++e) { const float qv = bf2f((u16)qr[d0][e]); q2 += qv * qv; }
      { auto rr = __builtin_amdgcn_permlane32_swap(__float_as_uint(q2), __float_as_uint(q2), false, false); q2 = __uint_as_float(rr[0]) + __uint_as_float(rr[1]); }
      mb = __builtin_sqrtf(q2 * __uint_as_float(kmx[b * 16 + h * 2 + map])) * 1.0001f; }
    const bool fast = !__any(!(mb <= 60.0f));
    if (fast) { m_reg = mb; fill16(negm, -mb); asm volatile("" : "+v"(negm)); }
    DA_WAIT_BAR(6);
    KLOAD(0);
    pA0 = DA_MFMA(kf[0], qr[0], negm); pA1 = DA_MFMA(kf[1], qr[0], negm); pA0 = DA_MFMA(kf[2], qr[1], pA0); pA1 = DA_MFMA(kf[3], qr[1], pA1);
    pA0 = DA_MFMA(kf[4], qr[2], pA0); pA1 = DA_MFMA(kf[5], qr[2], pA1); pA0 = DA_MFMA(kf[6], qr[3], pA0); pA1 = DA_MFMA(kf[7], qr[3], pA1);
    if (fast) {
#pragma unroll
      for (int r = 0; r < 16; ++r) { pA0[r] = __builtin_amdgcn_exp2f(pA0[r]); pA1[r] = __builtin_amdgcn_exp2f(pA1[r]); }
    } else { const float rm = rowmax32(pA0, pA1); m_reg = rm;
#pragma unroll
      for (int r = 0; r < 16; ++r) { pA0[r] = __builtin_amdgcn_exp2f(pA0[r] - rm); pA1[r] = __builtin_amdgcn_exp2f(pA1[r] - rm); }
      fill16(negm, -m_reg); asm volatile("" : "+v"(negm)); }
    DA_WAIT_BAR(0);
    DMA_K(3, 0); DMA_V(1, DA_KSL); ROT();
    KLOAD(sl_cur);
    DA_WAIT_BAR(4);
#define PKW(P, i) cvtpk(P[i], P[(i) + 1])
#define PAF(w) __builtin_bit_cast(bf16x8, w)
#define VOFF(i) ((((i) & 3) * 512) + (((i) >> 2) * 4096))
#define VRD(s, i) do { vlo[s] = vtr(vp_ + VOFF(i)); vhi[s] = vtr(vp_ + VOFF(i) + 2048); } while (0)
#define VFR(s) PKF(vlo[s], vhi[s])
#define KRD(G, d0) do { if (G) { kf[2 * (d0)] = kld(ka[d0] + sl_next); kf[2 * (d0) + 1] = kld(ka[d0] + sl_next + 8192); SBAR(); } } while (0)
#define GAPA(CT, MF, a0, a1, a2, a3, W0, W1, PW) do { MF; DA_PIN(CT); sacc += a0; sacc += a1; sacc += a2; sacc += a3; W0; W1; DA_PIN(PW); DA_PIN(sacc); SBAR(); } while (0)
#define GAPB(MF, X, i, VR) do { MF; VR; X[i] = __builtin_amdgcn_exp2f(X[i]); X[(i) + 1] = __builtin_amdgcn_exp2f(X[(i) + 1]); DA_PIN(X); SBAR(); } while (0)
#define STEP(C0, C1, P0, P1, t, GK, GV, GL) do { SBAR(); \
    const int vp_ = vb0 + sl_prev; \
    float sacc = P0[0] + P0[1]; \
    GAPA(C0, C0 = DA_MFMA(kf[0], qr[0], negm), P0[2], P0[3], P0[4], P0[5],     pw0[0] = PKW(P0, 0),  pw0[1] = PKW(P0, 2),  pw0); \
    GAPA(C1, C1 = DA_MFMA(kf[1], qr[0], negm), P0[6], P0[7], P0[8], P0[9],     pw0[2] = PKW(P0, 4),  pw0[3] = PKW(P0, 6),  pw0); \
    GAPA(C0, C0 = DA_MFMA(kf[2], qr[1], C0),   P0[10], P0[11], P0[12], P0[13], pw1[0] = PKW(P0, 8),  pw1[1] = PKW(P0, 10), pw1); \
    GAPA(C1, C1 = DA_MFMA(kf[3], qr[1], C1),   P0[14], P0[15], P1[0], P1[1],   pw1[2] = PKW(P0, 12), pw1[3] = PKW(P0, 14), pw1); \
    VRD(0, 0); SBAR(); GAPA(C0, C0 = DA_MFMA(kf[4], qr[2], C0), P1[2], P1[3], P1[4], P1[5],     pw2[0] = PKW(P1, 0),  pw2[1] = PKW(P1, 2),  pw2); \
    VRD(1, 1); SBAR(); GAPA(C1, C1 = DA_MFMA(kf[5], qr[2], C1), P1[6], P1[7], P1[8], P1[9],     pw2[2] = PKW(P1, 4),  pw2[3] = PKW(P1, 6),  pw2); \
    VRD(2, 2); SBAR(); GAPA(C0, C0 = DA_MFMA(kf[6], qr[3], C0), P1[10], P1[11], P1[12], P1[13], pw3[0] = PKW(P1, 8),  pw3[1] = PKW(P1, 10), pw3); \
    VRD(3, 3); SBAR(); GAPA(C1, C1 = DA_MFMA(kf[7], qr[3], C1), P1[14], P1[15], 0.f, 0.f,       pw3[2] = PKW(P1, 12), pw3[3] = PKW(P1, 14), pw3); \
    l_reg += sacc; \
    if (GK) DMA_K((t) + 3, sl_cur); if (GV) DMA_V((t) + 1, sl_next);                            \
    resc = false; \
    if (__builtin_expect(!fast, 0)) { const float rm = rowmax32(C0, C1);                        \
      if (__builtin_expect(__any(rm > THRL), 0)) { const float dl = fmaxf(rm, 0.f); m_reg += dl;    \
          const float f_ = __builtin_amdgcn_exp2f(-dl); l_reg *= f_; if (hi == 0) al_l[r32] = f_; resc = true; \
          _Pragma("unroll") for (int r = 0; r < 16; ++r) { C0[r] -= dl; C1[r] -= dl; } \
          fill16(negm, -m_reg); asm volatile("" : "+v"(negm)); } } \
    SBAR(); \
    GAPB(o[0] = DA_MFMA(PAF(pw0), VFR(0), o[0]), C0, 0, VRD(0, 4));  GAPB(o[1] = DA_MFMA(PAF(pw0), VFR(1), o[1]), C0, 2, VRD(1, 5)); \
    KRD(GL, 0); GAPB(o[2] = DA_MFMA(PAF(pw0), VFR(2), o[2]), C0, 4, VRD(2, 6));  KRD(GL, 1); GAPB(o[3] = DA_MFMA(PAF(pw0), VFR(3), o[3]), C0, 6, VRD(3, 7)); \
    KRD(GL, 2); GAPB(o[0] = DA_MFMA(PAF(pw1), VFR(0), o[0]), C0, 8, VRD(0, 8));  KRD(GL, 3); GAPB(o[1] = DA_MFMA(PAF(pw1), VFR(1), o[1]), C0, 10, VRD(1, 9)); \
    GAPB(o[2] = DA_MFMA(PAF(pw1), VFR(2), o[2]), C0, 12, VRD(2, 10)); GAPB(o[3] = DA_MFMA(PAF(pw1), VFR(3), o[3]), C0, 14, VRD(3, 11)); \
    GAPB(o[0] = DA_MFMA(PAF(pw2), VFR(0), o[0]), C1, 0, VRD(0, 12));  GAPB(o[1] = DA_MFMA(PAF(pw2), VFR(1), o[1]), C1, 2, VRD(1, 13)); \
    GAPB(o[2] = DA_MFMA(PAF(pw2), VFR(2), o[2]), C1, 4, VRD(2, 14));  GAPB(o[3] = DA_MFMA(PAF(pw2), VFR(3), o[3]), C1, 6, VRD(3, 15)); \
    GAPB(o[0] = DA_MFMA(PAF(pw3), VFR(0), o[0]), C1, 8, (void)0);     GAPB(o[1] = DA_MFMA(PAF(pw3), VFR(1), o[1]), C1, 10, (void)0); \
    GAPB(o[2] = DA_MFMA(PAF(pw3), VFR(2), o[2]), C1, 12, (void)0);    GAPB(o[3] = DA_MFMA(PAF(pw3), VFR(3), o[3]), C1, 14, (void)0); \
    } while (0)
    int t = 1;
    for (; t + 5 < NT; t += 2) {
        STEP(pB0, pB1, pA0, pA1, t, true, true, true);     DA_WAIT_BAR(4); RESC(); ROT();
        STEP(pA0, pA1, pB0, pB1, t + 1, true, true, true); DA_WAIT_BAR(4); RESC(); ROT();
    }
#define ENDW(tt) do { if ((tt) + 3 < NT) { DA_WAIT_BAR(4); } else if ((tt) + 2 < NT) { DA_WAIT_BAR(2); } else { DA_WAIT_BAR(0); } } while (0)
    for (; t + 1 < NT; t += 2) {
        STEP(pB0, pB1, pA0, pA1, t, (t + 3 < NT), (t + 1 < NT), (t + 1 < NT));         ENDW(t);     RESC(); ROT();
        STEP(pA0, pA1, pB0, pB1, t + 1, (t + 4 < NT), (t + 2 < NT), (t + 2 < NT));     ENDW(t + 1); RESC(); ROT();
    }
    STEP(pB0, pB1, pA0, pA1, NT - 1, false, false, false); RESC();
    { float sacc = pB0[0] + pB0[1];
#pragma unroll
      for (int r = 2; r < 16; ++r) sacc += pB0[r];
#pragma unroll
      for (int r = 0; r < 16; ++r) sacc += pB1[r];
      l_reg += sacc;
      pw0 = (u32x4){PKW(pB0, 0), PKW(pB0, 2), PKW(pB0, 4), PKW(pB0, 6)}; pw1 = (u32x4){PKW(pB0, 8), PKW(pB0, 10), PKW(pB0, 12), PKW(pB0, 14)};
      pw2 = (u32x4){PKW(pB1, 0), PKW(pB1, 2), PKW(pB1, 4), PKW(pB1, 6)}; pw3 = (u32x4){PKW(pB1, 8), PKW(pB1, 10), PKW(pB1, 12), PKW(pB1, 14)};
      pv_da(o, vb0 + sl_cur, PAF(pw0), PAF(pw1), PAF(pw2), PAF(pw3)); }
    { auto rr = __builtin_amdgcn_permlane32_swap(__float_as_uint(l_reg), __float_as_uint(l_reg), false, false); l_reg = __uint_as_float(rr[0]) + __uint_as_float(rr[1]); }
#undef DMA_K
#undef DMA_V
#undef ROT
#undef RESC
#undef KLOAD
#undef PKW
#undef PAF
#undef VOFF
#undef VRD
#undef VFR
#undef KRD
#undef GAPA
#undef GAPB
#undef STEP
#undef ENDW
    if (hi == 0) li_l[r32] = l_reg; asm volatile("s_waitcnt lgkmcnt(0)" ::: "memory");
    float rli[16];
#pragma unroll
    for (int r = 0; r < 16; ++r) rli[r] = __builtin_amdgcn_rcpf(li_l[crow(r, hi)]) * (map ? lam : 1.0f);
    __syncthreads();
    float* xch = (float*)lds;
    if (map == 1) {
#pragma unroll
        for (int d0 = 0; d0 < 4; ++d0)
#pragma unroll
            for (int r = 0; r < 16; ++r) xch[((wq * 4 + d0) * 16 + r) * 64 + lane] = o[d0][r] * rli[r];
    }
    __syncthreads();
    float* stg = (float*)(lds + DA_STG);
    if (map == 0) {
#pragma unroll
        for (int d0 = 0; d0 < 4; ++d0)
#pragma unroll
            for (int r = 0; r < 16; ++r) { const float dv = o[d0][r] * rli[r] - xch[((wq * 4 + d0) * 16 + r) * 64 + lane];
                stg[(wq * 32 + crow(r, hi)) * DA_STG_LD + d0 * 32 + r32] = dv; }
    }
    __syncthreads();
    {
        const int row = tid >> 2, qt = tid & 3; const float* sp = stg + row * DA_STG_LD + qt * 32;
        f32x4 dv[8]; float ss = 0.f;
#pragma unroll
        for (int g = 0; g < 8; ++g) { dv[g] = *(const f32x4*)(sp + g * 4); ss += (dv[g][0] * dv[g][0] + dv[g][1] * dv[g][1]) + (dv[g][2] * dv[g][2] + dv[g][3] * dv[g][3]); }
        ss += __shfl_xor(ss, 1); ss += __shfl_xor(ss, 2);
        const float sc2 = __builtin_amdgcn_rsqf(ss * (1.0f / 128.0f) + EPS) * one_m_li;
        const size_t goff = (size_t)(rowbase + q0 + row) * DM + h * 128 + qt * 32;
#pragma unroll
        for (int g = 0; g < 4; ++g) {
            const bf16x8 gt = ld8(Ga + goff + g * 8);
            const f32x4 w0 = *(const f32x4*)(subw + qt * 32 + g * 8), w1 = *(const f32x4*)(subw + qt * 32 + g * 8 + 4);
            const f32x4 a = dv[2 * g], c = dv[2 * g + 1];
            u32x4 w;
            w.x = cvtpk(a[0] * sc2 * w0[0] * bf2f((u16)gt[0]), a[1] * sc2 * w0[1] * bf2f((u16)gt[1]));
            w.y = cvtpk(a[2] * sc2 * w0[2] * bf2f((u16)gt[2]), a[3] * sc2 * w0[3] * bf2f((u16)gt[3]));
            w.z = cvtpk(c[0] * sc2 * w1[0] * bf2f((u16)gt[4]), c[1] * sc2 * w1[1] * bf2f((u16)gt[5]));
            w.w = cvtpk(c[2] * sc2 * w1[2] * bf2f((u16)gt[6]), c[3] * sc2 * w1[3] * bf2f((u16)gt[7]));
            if (!DRY) *(u32x4*)(Y + goff + g * 8) = w; else asm volatile("" :: "v"(w));
        }
    }
    __syncthreads();
}

constexpr int SWB_K = 0, SWB_V = 49152, SWB_WS = 98304, SWB_STG = 100352, SWB_STG_LD = 36;
__device__ __forceinline__ void swa_block_geom(int qb, int& t_lo, int& t_hi) { const int q0 = qb * 128; t_lo = (q0 >= 128 ? q0 - 128 : 0) >> 6; t_hi = (q0 + 255 < SEQ ? q0 + 255 : SEQ - 1) >> 6; }
template <int N> struct SwaRegs { bf16x8 k[N], v[N]; };
template <int N> __device__ __forceinline__ void swa_tiles_load(SwaRegs<N>& R, int b, int kvh, int t0, int nt, const u16* __restrict__ Kb, const u16* __restrict__ Vb, int tid) {
    const int sr = tid >> 3, sc = (tid & 7) * 8; const long rowbase = (long)b * SEQ;
    const u16* Kh = Kb + (rowbase + t0 * 64 + sr) * 256 + kvh * 64 + sc; const u16* Vh = Vb + (rowbase + t0 * 64 + sr) * 256 + kvh * 64 + sc;
#pragma unroll
    for (int tt = 0; tt < N; ++tt) if (tt < nt) { R.k[tt] = ld8(Kh + (long)tt * 64 * 256); R.v[tt] = ld8(Vh + (long)tt * 64 * 256); }
}
template <int N> __device__ __forceinline__ void swa_tiles_store_lds(const SwaRegs<N>& R, int t0, int nt, char* lds, int tid) {
    const int sr = tid >> 3, sc = (tid & 7) * 8, vst0 = v_stn<2>(sr, sc), kst0 = KSWZ128(sr, sc * 2);
#pragma unroll
    for (int tt = 0; tt < N; ++tt) if (tt < nt) { const int sl = (t0 + tt) % 6; *(bf16x8*)(lds + SWB_K + sl * 8192 + kst0) = R.k[tt]; *(bf16x8*)(lds + SWB_V + sl * 8192 + vst0) = R.v[tt]; }
}
template <bool DRY>
__device__ __forceinline__ void swa_block_compute(int b, int kvh, int qb, const u16* Q, const u16* __restrict__ Gt, u16* Y, const float* __restrict__ sink, char* lds, int tid) {
    const int lane = tid & 63, r32 = lane & 31, hi = lane >> 5; const int wid = __builtin_amdgcn_readfirstlane(tid >> 6);
    const int hq = kvh * 8 + wid; const long rowbase = (long)b * SEQ; const int q0 = qb * 128;
    int t_lo, t_hib; swa_block_geom(qb, t_lo, t_hib); (void)t_hib;
    float* wsf = (float*)(lds + SWB_WS) + wid * 64; float* al_l = wsf + 32;
    float* stg = (float*)(lds + SWB_STG) + wid * (32 * SWB_STG_LD);
    const int vb0 = (int)(uintptr_t)(lds + SWB_V) + v_rd_base(lane);
    const float sink2 = sink[hq] * LOG2E;
    bf16x8 qn[4];
    { const u16* Qw = Q + (rowbase + q0 + r32) * DIN + hq * 64 + hi * 8;
#pragma unroll
      for (int d0 = 0; d0 < 4; ++d0) qn[d0] = ld8(Qw + d0 * 16); }
#pragma unroll 1
    for (int sub = 0; sub < 4; ++sub) {
        const int qs = q0 + 32 * sub;
        bf16x8 qr[4];
#pragma unroll
        for (int d0 = 0; d0 < 4; ++d0) qr[d0] = qn[d0];
        if (sub < 3) { const u16* Qw = Q + (rowbase + qs + 32 + r32) * DIN + hq * 64 + hi * 8;
#pragma unroll
            for (int d0 = 0; d0 < 4; ++d0) qn[d0] = ld8(Qw + d0 * 16); }
        const int ta = ((qs >= 128 ? qs - 128 : 0) >> 6) - t_lo, tb = ((qs + 159 < SEQ ? qs + 159 : SEQ - 1) >> 6) - t_lo;
        float m_reg = sink2, l_dummy = 0.f; f32x16 o[2] = {}; f32x16 lacc, negm; fill16(lacc, 1.0f); fill16(negm, -sink2);
        const bf16x8 ones = {0x3F80, 0x3F80, 0x3F80, 0x3F80, 0x3F80, 0x3F80, 0x3F80, 0x3F80};
        bf16x8 gpre[2][2];
        { const size_t gb = (size_t)(rowbase + qs + (lane >> 1)) * DIN + hq * 64 + (lane & 1) * 16;
#pragma unroll
          for (int cbk = 0; cbk < 2; ++cbk) { gpre[cbk][0] = ld8(Gt + gb + cbk * 32); gpre[cbk][1] = ld8(Gt + gb + cbk * 32 + 8); } }
        for (int tt = ta; tt <= tb; ++tt) {
            const int k0 = (t_lo + tt) * 64, sl = (t_lo + tt) % 6;
            f32x16 p0, p1;
            const char* Ks = lds + SWB_K + sl * 8192;
#pragma unroll
            for (int d0 = 0; d0 < 4; ++d0) { const int cb = (d0 * 16 + hi * 8) * 2;
                const bf16x8 b0 = *reinterpret_cast<const bf16x8*>(Ks + KSWZ128(r32, cb));
                const bf16x8 b1 = *reinterpret_cast<const bf16x8*>(Ks + KSWZ128(32 + r32, cb));
                if (d0 == 0) { p0 = __builtin_amdgcn_mfma_f32_32x32x16_bf16(b0, qr[0], negm, 0, 0, 0); p1 = __builtin_amdgcn_mfma_f32_32x32x16_bf16(b1, qr[0], negm, 0, 0, 0); }
                else { p0 = __builtin_amdgcn_mfma_f32_32x32x16_bf16(b0, qr[d0], p0, 0, 0, 0); p1 = __builtin_amdgcn_mfma_f32_32x32x16_bf16(b1, qr[d0], p1, 0, 0, 0); } }
            if (k0 < qs - 97 || k0 + 63 > qs + 128) {
                const int base = k0 - qs - r32 + 4 * hi + 128;
#pragma unroll
                for (int r = 0; r < 16; ++r) { const int c = (r & 3) + 8 * (r >> 2); if ((unsigned)(base + c) > 256u) p0[r] = -1e30f; if ((unsigned)(base + c + 32) > 256u) p1[r] = -1e30f; }
            }
            float alpha; bf16x8 pa0, pa1, pa2, pa3;
            partialSM_n<false>(p0, p1, m_reg, negm, alpha);
            if (__any(alpha < 1.f)) { if (hi == 0) al_l[r32] = alpha; asm volatile("s_waitcnt lgkmcnt(0)" ::: "memory");
#pragma unroll
                for (int r = 0; r < 16; ++r) { const float al = al_l[crow(r, hi)]; o[0][r] *= al; o[1][r] *= al; lacc[r] *= al; } }
            finishSM_n<false>(p0, p1, alpha, l_dummy, pa0, pa1, pa2, pa3);
            {
                const int vbt = vb0 + sl * 8192; s16x4 lo[4], hi4[4];
#define VADDR2(i) (vbt + ((i) & 1) * 512 + ((i) >> 1) * 2048)
#pragma unroll
                for (int i = 0; i < 4; ++i) { lo[i] = vtr(VADDR2(i)); hi4[i] = vtr(VADDR2(i) + 1024); }
#pragma unroll
                for (int i = 0; i < 8; ++i) {
                    const bf16x8 vf = PKF(lo[i & 3], hi4[i & 3]);
                    const bf16x8 pa = ((i >> 1) == 0) ? pa0 : ((i >> 1) == 1) ? pa1 : ((i >> 1) == 2) ? pa2 : pa3;
                    o[i & 1] = __builtin_amdgcn_mfma_f32_32x32x16_bf16(pa, vf, o[i & 1], 0, 0, 0);
                    if ((i & 1) == 1) lacc = __builtin_amdgcn_mfma_f32_32x32x16_bf16(pa, ones, lacc, 0, 0, 0);
                    if (i + 4 < 8) { lo[i & 3] = vtr(VADDR2(i + 4)); hi4[i & 3] = vtr(VADDR2(i + 4) + 1024); }
                }
#undef VADDR2
            }
        }
        float rl[16];
#pragma unroll
        for (int r = 0; r < 16; ++r) rl[r] = __builtin_amdgcn_rcpf(lacc[r]);
#pragma unroll
        for (int cbk = 0; cbk < 2; ++cbk) {
#pragma unroll
            for (int r = 0; r < 16; ++r) stg[crow(r, hi) * SWB_STG_LD + r32] = o[cbk][r] * rl[r];
            asm volatile("s_waitcnt lgkmcnt(0)" ::: "memory");
            const int row = lane >> 1, hf = lane & 1; const float* sp = stg + row * SWB_STG_LD + hf * 16;
            const f32x4 a0 = *(const f32x4*)(sp), a1 = *(const f32x4*)(sp + 4), a2 = *(const f32x4*)(sp + 8), a3 = *(const f32x4*)(sp + 12);
            const size_t goff = (size_t)(rowbase + qs + row) * DIN + hq * 64 + cbk * 32 + hf * 16;
            const bf16x8 g0 = gpre[cbk][0], g1 = gpre[cbk][1];
            u32x4 w0, w1;
            w0.x = cvtpk(a0[0] * bf2f((u16)g0[0]), a0[1] * bf2f((u16)g0[1])); w0.y = cvtpk(a0[2] * bf2f((u16)g0[2]), a0[3] * bf2f((u16)g0[3]));
            w0.z = cvtpk(a1[0] * bf2f((u16)g0[4]), a1[1] * bf2f((u16)g0[5])); w0.w = cvtpk(a1[2] * bf2f((u16)g0[6]), a1[3] * bf2f((u16)g0[7]));
            w1.x = cvtpk(a2[0] * bf2f((u16)g1[0]), a2[1] * bf2f((u16)g1[1])); w1.y = cvtpk(a2[2] * bf2f((u16)g1[2]), a2[3] * bf2f((u16)g1[3]));
            w1.z = cvtpk(a3[0] * bf2f((u16)g1[4]), a3[1] * bf2f((u16)g1[5])); w1.w = cvtpk(a3[2] * bf2f((u16)g1[6]), a3[3] * bf2f((u16)g1[7]));
            if (!DRY) { *(u32x4*)(Y + goff) = w0; *(u32x4*)(Y + goff + 8) = w1; } else asm volatile("" :: "v"(w0), "v"(w1));
            asm volatile("s_waitcnt lgkmcnt(0)" ::: "memory");
        }
    }
}
template <bool DRY>
__device__ __forceinline__ void swa_block_compute_fast(int b, int kvh, int qb, const u16* Q, const u16* __restrict__ Gt, u16* Y, const float* __restrict__ sink, float mref, char* lds, int tid) {
    const int lane = tid & 63, r32 = lane & 31, hi = lane >> 5; const int wid = __builtin_amdgcn_readfirstlane(tid >> 6);
    const int hq = kvh * 8 + wid; const long rowbase = (long)b * SEQ; const int q0 = qb * 128;
    int t_lo, t_hib; swa_block_geom(qb, t_lo, t_hib); (void)t_hib;
    float* wsf = (float*)(lds + SWB_WS) + wid * 64;
    float* stg = (float*)(lds + SWB_STG) + wid * (32 * SWB_STG_LD);
    const int vb0 = (int)(uintptr_t)(lds + SWB_V) + v_rd_base(lane);
    const float psink = __builtin_amdgcn_exp2f(sink[hq] * LOG2E - mref);
    f32x16 negm; fill16(negm, -mref);
    bf16x8 qn[4];
    { const u16* Qw = Q + (rowbase + q0 + r32) * DIN + hq * 64 + hi * 8;
#pragma unroll
      for (int d0 = 0; d0 < 4; ++d0) qn[d0] = ld8(Qw + d0 * 16); }
#pragma unroll 1
    for (int sub = 0; sub < 4; ++sub) {
        const int qs = q0 + 32 * sub;
        bf16x8 qr[4];
#pragma unroll
        for (int d0 = 0; d0 < 4; ++d0) qr[d0] = qn[d0];
        if (sub < 3) { const u16* Qw = Q + (rowbase + qs + 32 + r32) * DIN + hq * 64 + hi * 8;
#pragma unroll
            for (int d0 = 0; d0 < 4; ++d0) qn[d0] = ld8(Qw + d0 * 16); }
        const int ta = ((qs >= 128 ? qs - 128 : 0) >> 6) - t_lo, tb = ((qs + 159 < SEQ ? qs + 159 : SEQ - 1) >> 6) - t_lo;
        float lsum = hi ? 0.f : psink; f32x16 o[2] = {};
        bf16x8 gpre[2][2];
        { const size_t gb = (size_t)(rowbase + qs + (lane >> 1)) * DIN + hq * 64 + (lane & 1) * 16;
#pragma unroll
          for (int cbk = 0; cbk < 2; ++cbk) { gpre[cbk][0] = ld8(Gt + gb + cbk * 32); gpre[cbk][1] = ld8(Gt + gb + cbk * 32 + 8); } }
        bf16x8 kf0, kf1, kf2, kf3, kf4, kf5, kf6, kf7;
#define SWA_KLOAD(tile) do { const char* Kn_ = lds + SWB_K + ((t_lo + (tile)) % 6) * 8192; \
            kf0 = *reinterpret_cast<const bf16x8*>(Kn_ + KSWZ128(r32, (0 * 16 + hi * 8) * 2)); kf1 = *reinterpret_cast<const bf16x8*>(Kn_ + KSWZ128(32 + r32, (0 * 16 + hi * 8) * 2)); \
            kf2 = *reinterpret_cast<const bf16x8*>(Kn_ + KSWZ128(r32, (1 * 16 + hi * 8) * 2)); kf3 = *reinterpret_cast<const bf16x8*>(Kn_ + KSWZ128(32 + r32, (1 * 16 + hi * 8) * 2)); \
            kf4 = *reinterpret_cast<const bf16x8*>(Kn_ + KSWZ128(r32, (2 * 16 + hi * 8) * 2)); kf5 = *reinterpret_cast<const bf16x8*>(Kn_ + KSWZ128(32 + r32, (2 * 16 + hi * 8) * 2)); \
            kf6 = *reinterpret_cast<const bf16x8*>(Kn_ + KSWZ128(r32, (3 * 16 + hi * 8) * 2)); kf7 = *reinterpret_cast<const bf16x8*>(Kn_ + KSWZ128(32 + r32, (3 * 16 + hi * 8) * 2)); } while (0)
        SWA_KLOAD(ta);
#pragma unroll 1
        for (int tt = ta; tt <= tb; ++tt) {
            const int k0 = (t_lo + tt) * 64, sl = (t_lo + tt) % 6;
            f32x16 p0, p1;
            p0 = __builtin_amdgcn_mfma_f32_32x32x16_bf16(kf0, qr[0], negm, 0, 0, 0); p1 = __builtin_amdgcn_mfma_f32_32x32x16_bf16(kf1, qr[0], negm, 0, 0, 0);
            p0 = __builtin_amdgcn_mfma_f32_32x32x16_bf16(kf2, qr[1], p0, 0, 0, 0);   p1 = __builtin_amdgcn_mfma_f32_32x32x16_bf16(kf3, qr[1], p1, 0, 0, 0);
            p0 = __builtin_amdgcn_mfma_f32_32x32x16_bf16(kf4, qr[2], p0, 0, 0, 0);   p1 = __builtin_amdgcn_mfma_f32_32x32x16_bf16(kf5, qr[2], p1, 0, 0, 0);
            p0 = __builtin_amdgcn_mfma_f32_32x32x16_bf16(kf6, qr[3], p0, 0, 0, 0);   p1 = __builtin_amdgcn_mfma_f32_32x32x16_bf16(kf7, qr[3], p1, 0, 0, 0);
            SWA_KLOAD(tt < tb ? tt + 1 : tt);
            if (k0 < qs - 97 || k0 + 63 > qs + 128) {
                const int base = k0 - qs - r32 + 4 * hi + 128;
#pragma unroll
                for (int r = 0; r < 16; ++r) { const int c = (r & 3) + 8 * (r >> 2); if ((unsigned)(base + c) > 256u) p0[r] = -1e30f; if ((unsigned)(base + c + 32) > 256u) p1[r] = -1e30f; }
            }
#pragma unroll
            for (int r = 0; r < 16; ++r) { p0[r] = __builtin_amdgcn_exp2f(p0[r]); p1[r] = __builtin_amdgcn_exp2f(p1[r]); }
            { float s0 = (p0[0] + p0[1]) + (p0[2] + p0[3]), s1 = (p0[4] + p0[5]) + (p0[6] + p0[7]), s2 = (p0[8] + p0[9]) + (p0[10] + p0[11]), s3 = (p0[12] + p0[13]) + (p0[14] + p0[15]);
              float t0 = (p1[0] + p1[1]) + (p1[2] + p1[3]), t1 = (p1[4] + p1[5]) + (p1[6] + p1[7]), t2 = (p1[8] + p1[9]) + (p1[10] + p1[11]), t3 = (p1[12] + p1[13]) + (p1[14] + p1[15]);
              lsum += ((s0 + s1) + (s2 + s3)) + ((t0 + t1) + (t2 + t3)); }
            bf16x8 pa0, pa1, pa2, pa3;
            { u32x4 w = PKN(p0, 0); pa0 = *reinterpret_cast<bf16x8*>(&w); } { u32x4 w = PKN(p0, 8); pa1 = *reinterpret_cast<bf16x8*>(&w); }
            { u32x4 w = PKN(p1, 0); pa2 = *reinterpret_cast<bf16x8*>(&w); } { u32x4 w = PKN(p1, 8); pa3 = *reinterpret_cast<bf16x8*>(&w); }
            {
                const int vbt = vb0 + sl * 8192; s16x4 lo[4], hi4[4];
#define VADDR2(i) (vbt + ((i) & 1) * 512 + ((i) >> 1) * 2048)
#pragma unroll
                for (int i = 0; i < 4; ++i) { lo[i] = vtr(VADDR2(i)); hi4[i] = vtr(VADDR2(i) + 1024); }
#pragma unroll
                for (int i = 0; i < 8; ++i) {
                    const bf16x8 vf = PKF(lo[i & 3], hi4[i & 3]);
                    const bf16x8 pa = ((i >> 1) == 0) ? pa0 : ((i >> 1) == 1) ? pa1 : ((i >> 1) == 2) ? pa2 : pa3;
                    o[i & 1] = __builtin_amdgcn_mfma_f32_32x32x16_bf16(pa, vf, o[i & 1], 0, 0, 0);
                    if (i + 4 < 8) { lo[i & 3] = vtr(VADDR2(i + 4)); hi4[i & 3] = vtr(VADDR2(i + 4) + 1024); }
                }
#undef VADDR2
            }
        }
#undef SWA_KLOAD
        { auto rr = __builtin_amdgcn_permlane32_swap(__float_as_uint(lsum), __float_as_uint(lsum), false, false); lsum = __uint_as_float(rr[0]) + __uint_as_float(rr[1]); }
        if (hi == 0) wsf[r32] = lsum; asm volatile("s_waitcnt lgkmcnt(0)" ::: "memory");
        float rl[16];
#pragma unroll
        for (int r = 0; r < 16; ++r) rl[r] = __builtin_amdgcn_rcpf(wsf[crow(r, hi)]);
#pragma unroll
        for (int cbk = 0; cbk < 2; ++cbk) {
#pragma unroll
            for (int r = 0; r < 16; ++r) stg[crow(r, hi) * SWB_STG_LD + r32] = o[cbk][r] * rl[r];
            asm volatile("s_waitcnt lgkmcnt(0)" ::: "memory");
            const int row = lane >> 1, hf = lane & 1; const float* sp = stg + row * SWB_STG_LD + hf * 16;
            const f32x4 a0 = *(const f32x4*)(sp), a1 = *(const f32x4*)(sp + 4), a2 = *(const f32x4*)(sp + 8), a3 = *(const f32x4*)(sp + 12);
            const size_t goff = (size_t)(rowbase + qs + row) * DIN + hq * 64 + cbk * 32 + hf * 16;
            const bf16x8 g0 = gpre[cbk][0], g1 = gpre[cbk][1];
            u32x4 w0, w1;
            w0.x = cvtpk(a0[0] * bf2f((u16)g0[0]), a0[1] * bf2f((u16)g0[1])); w0.y = cvtpk(a0[2] * bf2f((u16)g0[2]), a0[3] * bf2f((u16)g0[3]));
            w0.z = cvtpk(a1[0] * bf2f((u16)g0[4]), a1[1] * bf2f((u16)g0[5])); w0.w = cvtpk(a1[2] * bf2f((u16)g0[6]), a1[3] * bf2f((u16)g0[7]));
            w1.x = cvtpk(a2[0] * bf2f((u16)g1[0]), a2[1] * bf2f((u16)g1[1])); w1.y = cvtpk(a2[2] * bf2f((u16)g1[2]), a2[3] * bf2f((u16)g1[3]));
            w1.z = cvtpk(a3[0] * bf2f((u16)g1[4]), a3[1] * bf2f((u16)g1[5])); w1.w = cvtpk(a3[2] * bf2f((u16)g1[6]), a3[3] * bf2f((u16)g1[7]));
            if (!DRY) { *(u32x4*)(Y + goff) = w0; *(u32x4*)(Y + goff + 8) = w1; } else asm volatile("" :: "v"(w0), "v"(w1));
            asm volatile("s_waitcnt lgkmcnt(0)" ::: "memory");
        }
    }
}
template <bool DRY, bool FAST>
__device__ __forceinline__ void swa_phase_tail(int b, int kvh, int qbA, int qbB, const SwaRegs<2>& N, int tnew, int nnew, const u16* Q, const u16* Gt, u16* Y, const float* sink, float mref, char* lds, int tid) {
    if (FAST) swa_block_compute_fast<DRY>(b, kvh, qbA, Q, Gt, Y, sink, mref, lds, tid); else swa_block_compute<DRY>(b, kvh, qbA, Q, Gt, Y, sink, lds, tid);
    __syncthreads();
    swa_tiles_store_lds<2>(N, tnew, nnew, lds, tid);
    __syncthreads();
    if (FAST) swa_block_compute_fast<DRY>(b, kvh, qbB, Q, Gt, Y, sink, mref, lds, tid); else swa_block_compute<DRY>(b, kvh, qbB, Q, Gt, Y, sink, lds, tid);
    __syncthreads();
}
template <bool DRY>
__device__ __forceinline__ void swa_phase(int u0, const u16* Q, const u16* Kb, const u16* Vb, const u16* Gt, u16* Y, const float* sink, const unsigned* __restrict__ qmx, const unsigned* __restrict__ kmx, char* lds) {
    int tid = threadIdx.x; asm volatile("" : "+v"(tid));
    const int bk = u0 >> 5, b = bk >> 2, kvh = bk & 3, qbA = u0 & 31, qbB = qbA + 1;
    int tloA, thiA, tloB, thiB; swa_block_geom(qbA, tloA, thiA); swa_block_geom(qbB, tloB, thiB);
    { SwaRegs<6> R; swa_tiles_load<6>(R, b, kvh, tloA, thiA - tloA + 1, Kb, Vb, tid); swa_tiles_store_lds<6>(R, tloA, thiA - tloA + 1, lds, tid); }
    __syncthreads();
    SwaRegs<2> N; const int nnew = thiB - thiA;
    swa_tiles_load<2>(N, b, kvh, thiA + 1, nnew, Kb, Vb, tid);
    const int hq_ = kvh * 8 + __builtin_amdgcn_readfirstlane(tid >> 6);
    const float mref = fmaxf(__builtin_sqrtf(__uint_as_float(qmx[b * 32 + hq_]) * __uint_as_float(kmx[b * 16 + kvh])) * 1.0001f, sink[hq_] * LOG2E);
    if (mref <= 60.0f) swa_phase_tail<DRY, true>(b, kvh, qbA, qbB, N, thiA + 1, nnew, Q, Gt, Y, sink, mref, lds, tid);
    else               swa_phase_tail<DRY, false>(b, kvh, qbA, qbB, N, thiA + 1, nnew, Q, Gt, Y, sink, mref, lds, tid);
}
}
namespace hg {
using namespace att;
typedef _Float16 f16;
constexpr int L_QT = 0, L_KT = 16384, L_QIN = 32768, L_KDEC = 49152, L_V = 65536, L_S = 81920, L_CUM = 114688, L_EDEC = 118784, L_STG = 122880, STG_LD = 132;

struct ChunkRegs { unsigned q[8], v[8], lf[8]; };

__device__ __forceinline__ int chunk_pos(int c, int i, int dir) { return dir ? (c * 64 + 63 - i) : (c * 64 + i); }

template <bool NEEDQ>
__device__ __forceinline__ void load_chunk(ChunkRegs& R, const u16* Qh, const u16* Vh, const u16* LF, long rowbase, int colbase, int c, int dir, int wid, int lane) {
#pragma unroll
    for (int i = 0; i < 8; ++i) {
        const long pos = rowbase + chunk_pos(c, wid * 8 + i, dir);
        const size_t off = (size_t)pos * DM + colbase + 2 * lane;
        if (NEEDQ) R.q[i] = *(const unsigned*)(Qh + off);
        R.v[i] = *(const unsigned*)(Vh + off);
        R.lf[i] = *(const unsigned*)(LF + off);
    }
}
__device__ __forceinline__ float h2f(unsigned short h) { return (float)__builtin_bit_cast(f16, h); }

template <bool FULL>
__device__ __forceinline__ void prep_chunk(const ChunkRegs& R, char* lds, int wid, int lane, float (&gtot)[2]) {
    float g[8][2]; float run0 = 0.f, run1 = 0.f;
#pragma unroll
    for (int i = 0; i < 8; ++i) { run0 += h2f((unsigned short)(R.lf[i] & 0xffff)); run1 += h2f((unsigned short)(R.lf[i] >> 16)); g[i][0] = run0; g[i][1] = run1; }
    float* cum = (float*)(lds + L_CUM);
    *(float2*)(cum + wid * 128 + 2 * lane) = make_float2(run0, run1);
    __syncthreads();
    float pre0 = 0.f, pre1 = 0.f, gm0 = 0.f, gm1 = 0.f, gl0 = 0.f, gl1 = 0.f;
#pragma unroll
    for (int w2 = 0; w2 < 8; ++w2) { const float2 t = *(const float2*)(cum + w2 * 128 + 2 * lane);
        if (w2 < wid) { pre0 += t.x; pre1 += t.y; } if (w2 < 4) { gm0 += t.x; gm1 += t.y; } gl0 += t.x; gl1 += t.y; }
    gtot[0] += gl0; gtot[1] += gl1;
    const float egm0 = __builtin_amdgcn_exp2f(gm0), egm1 = __builtin_amdgcn_exp2f(gm1), elm0 = __builtin_amdgcn_exp2f(gl0 - gm0), elm1 = __builtin_amdgcn_exp2f(gl1 - gm1);
    if (wid == 0) *(float2*)((float*)(lds + L_EDEC) + 2 * lane) = make_float2(__builtin_amdgcn_exp2f(gl0), __builtin_amdgcn_exp2f(gl1));
    typedef float f32x2 __attribute__((ext_vector_type(2)));
    const f32x2 prev = {pre0, pre1}, gmv = {gm0, gm1}, elmv = {elm0, elm1}, egmv = {egm0, egm1}, one2 = {1.0f, 1.0f};
#pragma unroll
    for (int i = 0; i < 8; ++i) {
        const int row = wid * 8 + i;
        const f32x2 a = (prev + (f32x2){g[i][0], g[i][1]}) - gmv;
        const f32x2 e = {__builtin_amdgcn_exp2f(a.x), __builtin_amdgcn_exp2f(a.y)};
        const f32x2 r = {__builtin_amdgcn_rcpf(e.x), __builtin_amdgcn_rcpf(e.y)};
        const float lf0 = h2f((unsigned short)(R.lf[i] & 0xffff)), lf1 = h2f((unsigned short)(R.lf[i] >> 16));
        const f32x2 k = one2 - (f32x2){__builtin_amdgcn_exp2f(lf0), __builtin_amdgcn_exp2f(lf1)};
        const f32x2 kt = k * r, kd = kt * elmv;
        const int vo = v_st<4>(row, 2 * lane);
        *(unsigned*)(lds + L_KDEC + vo) = cvtpk(kd.x, kd.y);
        *(unsigned*)(lds + L_V + vo) = R.v[i];
        if (FULL) {
            const f32x2 q = {bf2f((u16)(R.q[i] & 0xffff)), bf2f((u16)(R.q[i] >> 16))};
            const f32x2 qt = q * e, qi = qt * egmv;
            const int ko = KSWZ(row, 4 * lane);
            *(unsigned*)(lds + L_QT + ko) = cvtpk(qt.x, qt.y);
            *(unsigned*)(lds + L_KT + ko) = cvtpk(kt.x, kt.y);
            *(unsigned*)(lds + L_QIN + ko) = cvtpk(qi.x, qi.y);
        }
    }
}

template <int KS> __device__ __forceinline__ bf16x8 tr_frag(int vb) {
    const s16x4 l = tr_read<KS * 4096>(vb), h = tr_read<KS * 4096 + 2048>(vb);
    asm volatile("s_waitcnt lgkmcnt(0)" ::: "memory"); SBAR();
    return PKF(l, h);
}

struct SuFrag { s16x4 lv, hv, l0, h0, l1, h1; };
__device__ __forceinline__ void su_read(SuFrag& f, int vbV, int vbK0, int vbK1, int off) {
    f.lv = vtr(vbV + off); f.hv = vtr(vbV + off + 2048); f.l0 = vtr(vbK0 + off); f.h0 = vtr(vbK0 + off + 2048); f.l1 = vtr(vbK1 + off); f.h1 = vtr(vbK1 + off + 2048);
}
__device__ __forceinline__ void su_mma(f32x16 (&sacc)[2], const SuFrag& f) {
    const bf16x8 bv = PKF(f.lv, f.hv), a0 = PKF(f.l0, f.h0), a1 = PKF(f.l1, f.h1);
    sacc[0] = __builtin_amdgcn_mfma_f32_32x32x16_bf16(a0, bv, sacc[0], 0, 0, 0); sacc[1] = __builtin_amdgcn_mfma_f32_32x32x16_bf16(a1, bv, sacc[1], 0, 0, 0);
}
template <int NIMG>
__device__ __forceinline__ void state_update_t(f32x16 (&sacc)[2], const char* lds, int ldsbase, int offK, int offV, int offE, int wid, int lane) {
    const int hi = lane >> 5, j = wid >> 1, ib = 2 * (wid & 1);
    const float* edec = (const float*)(lds + offE);
    const int vbV = ldsbase + offV + v_rd_base(lane) + j * 512;
    const int vbK0 = ldsbase + offK + v_rd_base(lane) + ib * 512, vbK1 = vbK0 + 512;
#pragma unroll
    for (int i2 = 0; i2 < 2; ++i2)
#pragma unroll
        for (int r = 0; r < 16; ++r) sacc[i2][r] *= edec[32 * (ib + i2) + crow(r, hi)];
    SBAR();
    SuFrag fa, fb; su_read(fa, vbV, vbK0, vbK1, 0);
#pragma unroll
    for (int s = 0; s < 4 * NIMG; s += 2) {
        su_read(fb, vbV, vbK0, vbK1, ((s + 1) >> 2) * 16384 + ((s + 1) & 3) * 4096);
        su_mma(sacc, fa);
        if (s + 2 < 4 * NIMG) su_read(fa, vbV, vbK0, vbK1, ((s + 2) >> 2) * 16384 + ((s + 2) & 3) * 4096);
        su_mma(sacc, fb);
    }
    __builtin_amdgcn_sched_group_barrier(0x100, 6, 0);
#pragma unroll
    for (int s = 0; s < 4 * NIMG - 1; ++s) { __builtin_amdgcn_sched_group_barrier(0x100, 6, 0); __builtin_amdgcn_sched_group_barrier(0x008, 2, 0); }
    __builtin_amdgcn_sched_group_barrier(0x008, 2, 0);
    SBAR();
}
__device__ __forceinline__ void state_update(f32x16 (&sacc)[2], const char* lds, int ldsbase, int wid, int lane) { state_update_t<1>(sacc, lds, ldsbase, L_KDEC, L_V, L_EDEC, wid, lane); }
__device__ __forceinline__ void write_simg(const f32x16 (&sacc)[2], char* lds, int wid, int lane) {
    const int r32 = lane & 31, hi = lane >> 5, j = wid >> 1, ib = 2 * (wid & 1);
#pragma unroll
    for (int i2 = 0; i2 < 2; ++i2)
#pragma unroll
        for (int r = 0; r < 16; ++r) { const int d = 32 * (ib + i2) + crow(r, hi);
            *(__hip_bfloat16*)(lds + L_S + (d >> 6) * 16384 + v_st<4>(d & 63, 32 * j + r32)) = __float2bfloat16(sacc[i2][r]); }
}
__device__ __forceinline__ f32x16 chunk_output(const char* lds, int ldsbase, int wid, int lane) {
    const int r32 = lane & 31, hi = lane >> 5, tb = wid & 1, j = wid >> 1;
    const char* QT = lds + L_QT; const char* KT = lds + L_KT; const char* QIN = lds + L_QIN;
    f32x16 p0 = f32x16{}, p1 = f32x16{};
#define FRA(img, row, d0) kld(ldsbase + (img) + KSWZ(row, ((d0) * 16 + hi * 8) * 2))
    if (tb) {
        bf16x8 q_[2], a_[2], b_[2];
        q_[0] = FRA(L_QT, 32 + r32, 0); a_[0] = FRA(L_KT, r32, 0); b_[0] = FRA(L_KT, 32 + r32, 0);
#pragma unroll
        for (int d0 = 0; d0 < 8; ++d0) {
            if (d0 + 1 < 8) { q_[(d0 + 1) & 1] = FRA(L_QT, 32 + r32, d0 + 1); a_[(d0 + 1) & 1] = FRA(L_KT, r32, d0 + 1); b_[(d0 + 1) & 1] = FRA(L_KT, 32 + r32, d0 + 1); }
            SBAR();
            p0 = __builtin_amdgcn_mfma_f32_32x32x16_bf16(a_[d0 & 1], q_[d0 & 1], p0, 0, 0, 0);
            p1 = __builtin_amdgcn_mfma_f32_32x32x16_bf16(b_[d0 & 1], q_[d0 & 1], p1, 0, 0, 0);
            SBAR();
        }
    } else {
        bf16x8 q_[2], a_[2];
        q_[0] = FRA(L_QT, r32, 0); a_[0] = FRA(L_KT, r32, 0);
#pragma unroll
        for (int d0 = 0; d0 < 8; ++d0) {
            if (d0 + 1 < 8) { q_[(d0 + 1) & 1] = FRA(L_QT, r32, d0 + 1); a_[(d0 + 1) & 1] = FRA(L_KT, r32, d0 + 1); }
            SBAR();
            p0 = __builtin_amdgcn_mfma_f32_32x32x16_bf16(a_[d0 & 1], q_[d0 & 1], p0, 0, 0, 0);
            SBAR();
        }
    }
#undef FRA
#pragma unroll
    for (int r = 0; r < 16; ++r) { const bool keep = crow(r, hi) <= r32; if (tb == 0) { p0[r] = keep ? p0[r] : 0.f; p1[r] = 0.f; } else { p1[r] = keep ? p1[r] : 0.f; } }
    bf16x8 pa0, pa1, pa2, pa3; pack4(p0, p1, pa0, pa1, pa2, pa3);
    f32x16 oacc = f32x16{};
    pv_blk<4>(oacc, ldsbase + L_V + v_rd_base(lane) + j * 512, pa0, pa1, pa2, pa3);
    const int vbS = ldsbase + L_S + v_rd_base(lane) + j * 512;
#define QINF(kd) (*reinterpret_cast<const bf16x8*>(QIN + KSWZ(32 * tb + r32, ((kd) * 16 + hi * 8) * 2)))
    {
        s16x4 lo[2], hh[2];
#define SADDR(kd) (vbS + ((kd) >> 2) * 16384 + ((kd) & 3) * 4096)
        lo[0] = vtr(SADDR(0)); hh[0] = vtr(SADDR(0) + 2048); lo[1] = vtr(SADDR(1)); hh[1] = vtr(SADDR(1) + 2048);
#pragma unroll
        for (int kd = 0; kd < 8; ++kd) {
            const bf16x8 b = PKF(lo[kd & 1], hh[kd & 1]); const bf16x8 q = QINF(kd);
            oacc = __builtin_amdgcn_mfma_f32_32x32x16_bf16(q, b, oacc, 0, 0, 0);
            if (kd + 2 < 8) { lo[kd & 1] = vtr(SADDR(kd + 2)); hh[kd & 1] = vtr(SADDR(kd + 2) + 2048); }
        }
#undef SADDR
    }
#undef QINF
    return oacc;
}

constexpr int P1_KDEC = 0, P1_V = 65536, P1_CUM = 131072, P1_EDEC = 135168;
struct BlockRegs { unsigned v[32], lf[32]; };
__device__ __forceinline__ void load_block(BlockRegs& R, const u16* Vh, const u16* LF, long rowbase, int colbase, int seg, int blk, int dir, int wid, int lane) {
    unsigned voff = (unsigned)lane * 4u; asm volatile("" : "+v"(voff));
#pragma unroll
    for (int i = 0; i < 32; ++i) {
        const int p = blk * 256 + wid * 32 + i;
        const long pos = rowbase + seg * 512 + (dir ? 511 - p : p);
        const size_t roff = ((size_t)pos * DM + colbase) * 2;
        R.v[i] = *(const unsigned*)((const char*)Vh + roff + voff); R.lf[i] = *(const unsigned*)((const char*)LF + roff + voff);
    }
}
__device__ __forceinline__ void prep_block(const BlockRegs& R, char* lds, int wid, int lane, float (&gtot)[2]) {
    float run0 = 0.f, run1 = 0.f;
#pragma unroll
    for (int i = 0; i < 32; ++i) { run0 += h2f((unsigned short)(R.lf[i] & 0xffff)); run1 += h2f((unsigned short)(R.lf[i] >> 16)); }
    float* cum = (float*)(lds + P1_CUM);
    *(float2*)(cum + wid * 128 + 2 * lane) = make_float2(run0, run1);
    __syncthreads();
    float pre0 = 0.f, pre1 = 0.f, gl0 = 0.f, gl1 = 0.f;
#pragma unroll
    for (int w2 = 0; w2 < 8; ++w2) { const float2 t = *(const float2*)(cum + w2 * 128 + 2 * lane); if (w2 < wid) { pre0 += t.x; pre1 += t.y; } gl0 += t.x; gl1 += t.y; }
    gtot[0] += gl0; gtot[1] += gl1;
    if (wid == 0) *(float2*)((float*)(lds + P1_EDEC) + 2 * lane) = make_float2(__builtin_amdgcn_exp2f(gl0), __builtin_amdgcn_exp2f(gl1));
    float G0 = pre0 - gl0, G1 = pre1 - gl1;
    char* base = lds + (wid >> 1) * 16384 + (wid & 1) * 8192 + v_st<4>(0, 2 * lane);
    typedef float f32x2 __attribute__((ext_vector_type(2)));
    f32x2 Gv = {G0, G1}; const f32x2 one2 = {1.0f, 1.0f};
#pragma unroll
    for (int i = 0; i < 32; ++i) {
        const f32x2 lf = {h2f((unsigned short)(R.lf[i] & 0xffff)), h2f((unsigned short)(R.lf[i] >> 16))};
        Gv += lf;
        const f32x2 k = one2 - (f32x2){__builtin_amdgcn_exp2f(lf.x), __builtin_amdgcn_exp2f(lf.y)};
        const f32x2 kd = k * (f32x2){__builtin_amdgcn_exp2f(-Gv.x), __builtin_amdgcn_exp2f(-Gv.y)};
        const int vo = v_st<4>(i, 0);
        *(unsigned*)(base + P1_KDEC + vo) = cvtpk(kd.x, kd.y);
        *(unsigned*)(base + P1_V + vo) = R.v[i];
    }
}
__device__ __forceinline__ void state_update_block(f32x16 (&sacc)[2], const char* lds, int ldsbase, int wid, int lane) { state_update_t<4>(sacc, lds, ldsbase, P1_KDEC, P1_V, P1_EDEC, wid, lane); }
__device__ __forceinline__ void hgrn_pass1(int item, const u16* Vt, const u16* LF0, const u16* LF1, float* ust, float* dst, char* lds) {
    int tid = threadIdx.x; asm volatile("" : "+v"(tid)); const int lane = tid & 63; const int wid = __builtin_amdgcn_readfirstlane(tid >> 6);
    const int seg = item & 7, dir = (item >> 3) & 1, bh = item >> 4, b = bh >> 3, h = bh & 7;
    const long rowbase = (long)b * SEQ; const int colbase = h * 128; const u16* LF = dir ? LF1 : LF0;
    const int ldsbase = (int)(uintptr_t)lds;
    f32x16 sacc[2] = {}; float gtot[2] = {0.f, 0.f};
    BlockRegs R;
    load_block(R, Vt, LF, rowbase, colbase, seg, 0, dir, wid, lane);
#pragma unroll 1
    for (int blk = 0; blk < 2; ++blk) {
        prep_block(R, lds, wid, lane, gtot);
        asm volatile("" ::: "memory");
        if (blk == 0) load_block(R, Vt, LF, rowbase, colbase, seg, 1, dir, wid, lane);
        __syncthreads();
        state_update_block(sacc, lds, ldsbase, wid, lane);
    }
    float* up = ust + (size_t)item * 16384 + wid * 2048;
#pragma unroll
    for (int i2 = 0; i2 < 2; ++i2)
#pragma unroll
        for (int r = 0; r < 16; ++r) up[(i2 * 16 + r) * 64 + lane] = sacc[i2][r];
    if (wid == 0) *(float2*)(dst + (size_t)item * 128 + 2 * lane) = make_float2(__builtin_amdgcn_exp2f(gtot[0]), __builtin_amdgcn_exp2f(gtot[1]));
    __syncthreads();
}

template <bool DRY, int PVAR = 0>
__device__ __forceinline__ void hgrn_pass2(int item, const u16* Qh, const u16* Vt, const u16* LF0, const u16* LF1, const u16* Gt, u16* OF, u16* Y,
                                           const float* ust, const float* dst, const float* __restrict__ nw, char* lds) {
    int tid = threadIdx.x; asm volatile("" : "+v"(tid)); const int lane = tid & 63, r32 = lane & 31, hi = lane >> 5; const int wid = __builtin_amdgcn_readfirstlane(tid >> 6);
    const int seg = item & 7, bh = item >> 3, b = bh >> 3, h = bh & 7;
    const long rowbase = (long)b * SEQ; const int colbase = h * 128;
    const int vw = ((wid & 3) << 1) | (wid >> 2);
    const int ldsbase = (int)(uintptr_t)lds; const int tb = vw & 1, j = vw >> 1, ib = 2 * (vw & 1);
    float* stg = (float*)(lds + L_STG);
    ChunkRegs R;
#pragma unroll 1
    for (int dir = 0; dir < 2; ++dir) {
        const u16* LF = dir ? LF1 : LF0;
        f32x16 sacc[2] = {}; float gtot[2] = {0.f, 0.f};
        const int nseg = dir ? (7 - seg) : seg;
        for (int n = 0; n < nseg; ++n) {
            const int sg = dir ? (7 - n) : n; const int it = ((bh * 2 + dir) * 8 + sg);
            const float* up = ust + (size_t)it * 16384 + vw * 2048; const float* dp = dst + (size_t)it * 128;
#pragma unroll
            for (int i2 = 0; i2 < 2; ++i2)
#pragma unroll
                for (int r = 0; r < 16; ++r) sacc[i2][r] = sacc[i2][r] * dp[32 * (ib + i2) + crow(r, hi)] + up[(i2 * 16 + r) * 64 + lane];
        }
        write_simg(sacc, lds, vw, lane);
        load_chunk<true>(R, Qh, Vt, LF, rowbase, colbase, dir ? (seg * 8 + 7) : (seg * 8), dir, wid, lane);
        for (int cc = 0; cc < 8; ++cc) {
            const int c = dir ? (seg * 8 + 7 - cc) : (seg * 8 + cc);
            const int ri = tid >> 3, rcg = tid & 7; const size_t goff = (size_t)(rowbase + chunk_pos(c, ri, dir)) * DM + colbase + rcg * 16;
            u32x4 pf0 = {}, pf1 = {}; bf16x8 pg0 = {}, pg1 = {};
            if (dir) { pf0 = *(const u32x4*)(OF + goff); pf1 = *(const u32x4*)(OF + goff + 8); pg0 = ld8(Gt + goff); pg1 = ld8(Gt + goff + 8); }
            if (PVAR != 1) prep_chunk<true>(R, lds, wid, lane, gtot); else { asm volatile("" :: "v"(R.q[0]), "v"(R.v[7]), "v"(R.lf[3])); __syncthreads(); }
            if (cc + 1 < 8) load_chunk<true>(R, Qh, Vt, LF, rowbase, colbase, dir ? (seg * 8 + 6 - cc) : (seg * 8 + cc + 1), dir, wid, lane);
            __syncthreads();
            f32x16 oacc = f32x16{};
            if (PVAR != 2) { oacc = chunk_output(lds, ldsbase, vw, lane); state_update(sacc, lds, ldsbase, vw, lane); }
            if (PVAR != 3) {
#pragma unroll
            for (int r = 0; r < 16; ++r) stg[(32 * tb + crow(r, hi)) * STG_LD + 32 * j + r32] = oacc[r];
            __syncthreads();
            write_simg(sacc, lds, vw, lane);
            {
                const int i = ri, cg = rcg; const float* sp = stg + i * STG_LD + cg * 16;
                f32x4 ov[4];
#pragma unroll
                for (int g = 0; g < 4; ++g) ov[g] = *(const f32x4*)(sp + g * 4);
                if (dir == 0) {
                    u32x4 w0, w1;
                    w0.x = pg8::pk_f16(ov[0][0], ov[0][1]); w0.y = pg8::pk_f16(ov[0][2], ov[0][3]); w0.z = pg8::pk_f16(ov[1][0], ov[1][1]); w0.w = pg8::pk_f16(ov[1][2], ov[1][3]);
                    w1.x = pg8::pk_f16(ov[2][0], ov[2][1]); w1.y = pg8::pk_f16(ov[2][2], ov[2][3]); w1.z = pg8::pk_f16(ov[3][0], ov[3][1]); w1.w = pg8::pk_f16(ov[3][2], ov[3][3]);
                    if (!DRY) { *(u32x4*)(OF + goff) = w0; *(u32x4*)(OF + goff + 8) = w1; } else asm volatile("" :: "v"(w0), "v"(w1));
                } else {
                    const u32x4 f0 = pf0, f1 = pf1;
                    float tv[16];
#pragma unroll
                    for (int e = 0; e < 4; ++e) { tv[2 * e] = h2f((unsigned short)(f0[e] & 0xffff)); tv[2 * e + 1] = h2f((unsigned short)(f0[e] >> 16));
                                                  tv[8 + 2 * e] = h2f((unsigned short)(f1[e] & 0xffff)); tv[8 + 2 * e + 1] = h2f((unsigned short)(f1[e] >> 16)); }
                    float ss = 0.f;
#pragma unroll
                    for (int e = 0; e < 16; ++e) { tv[e] += ov[e >> 2][e & 3]; ss += tv[e] * tv[e]; }
                    ss += __shfl_xor(ss, 1); ss += __shfl_xor(ss, 2); ss += __shfl_xor(ss, 4);
                    const float rs = __builtin_amdgcn_rsqf(ss * (1.0f / 128.0f) + EPS);
                    const bf16x8 g0 = pg0, g1 = pg1;
                    float yv[16];
#pragma unroll
                    for (int e = 0; e < 8; ++e) { yv[e] = tv[e] * rs * nw[cg * 16 + e] * bf2f((u16)g0[e]); yv[8 + e] = tv[8 + e] * rs * nw[cg * 16 + 8 + e] * bf2f((u16)g1[e]); }
                    u32x4 w0, w1;
                    w0.x = cvtpk(yv[0], yv[1]); w0.y = cvtpk(yv[2], yv[3]); w0.z = cvtpk(yv[4], yv[5]); w0.w = cvtpk(yv[6], yv[7]);
                    w1.x = cvtpk(yv[8], yv[9]); w1.y = cvtpk(yv[10], yv[11]); w1.z = cvtpk(yv[12], yv[13]); w1.w = cvtpk(yv[14], yv[15]);
                    if (!DRY) { *(u32x4*)(Y + goff) = w0; *(u32x4*)(Y + goff + 8) = w1; } else asm volatile("" :: "v"(w0), "v"(w1));
                }
            }
            } else { asm volatile("" :: "v"(oacc), "v"(sacc[0]), "v"(sacc[1]), "v"(pf0), "v"(pg0)); __syncthreads(); }
        }
        __syncthreads();
    }
}
}
#define GAS __attribute__((address_space(1)))
#define LAS __attribute__((address_space(3)))
typedef unsigned short bf16;
typedef unsigned v4u __attribute__((ext_vector_type(4)));
typedef float f32x4 __attribute__((ext_vector_type(4)));
typedef short bf16x8 __attribute__((ext_vector_type(8)));
typedef GAS unsigned gu32;
typedef GAS unsigned long long gu64;
#define RLX_AGENT __ATOMIC_RELAXED, __HIP_MEMORY_SCOPE_AGENT
#define LDS_WAIT() asm volatile("s_waitcnt lgkmcnt(0)" ::: "memory")
#define VM_WAIT() asm volatile("s_waitcnt vmcnt(0)" ::: "memory")
__device__ __forceinline__ unsigned long long rt() { return __builtin_amdgcn_s_memrealtime(); }
__device__ __forceinline__ unsigned f2bf(float f) { unsigned u = __builtin_bit_cast(unsigned, f); return (u + 0x7fffu + ((u >> 16) & 1u)) >> 16; }
__device__ __forceinline__ unsigned pk2(float lo, float hi) { return f2bf(lo) | (f2bf(hi) << 16); }

#define XB_TMO      128
#define XB_XCNT(j)  (256  + 64 * (j))
#define XB_XSUB(j)  (1280 + 64 * (j))
#define XB_XGEN(j)  (2304 + 64 * (j))
#define XB_TOP      3328
#define XB_TOPGEN   3392
#define XCD_BAR_WORDS 3456
#define XB_SPIN_CAP (1u << 18)

__device__ __forceinline__ unsigned xb_ld(unsigned* p)              { return __hip_atomic_load(p, __ATOMIC_RELAXED, __HIP_MEMORY_SCOPE_AGENT); }
__device__ __forceinline__ unsigned xb_add(unsigned* p, unsigned v) { return __hip_atomic_fetch_add(p, v, __ATOMIC_RELAXED, __HIP_MEMORY_SCOPE_AGENT); }
__device__ __forceinline__ unsigned xb_xcc_id() { return (unsigned)__builtin_amdgcn_s_getreg((3 << 11) | 20) & 0xFu; }
#define XB_SPIN(cond, bar) do { unsigned _sp = 0; while (cond) { __builtin_amdgcn_s_sleep(1); \
    if ((++_sp & 255u) == 0u) { if (xb_ld(&(bar)[XB_TMO])) break; if (_sp > XB_SPIN_CAP) { atomicAdd(&(bar)[XB_TMO], 1u); break; } } } } while (0)

struct XcdBarrier {
    unsigned* bar; unsigned x;
    volatile LAS unsigned* st;
};

__device__ __forceinline__ XcdBarrier xcd_barrier_post(unsigned* bar, volatile LAS unsigned* st) {
    XcdBarrier b; b.bar = bar; b.x = xb_xcc_id(); b.st = st;
    if (threadIdx.x == 0) (void)xb_add(&bar[XB_XCNT(b.x)], 1u);
    return b;
}
__device__ __forceinline__ void xcd_barrier_complete(unsigned* bar, unsigned x, unsigned& nloc, unsigned& nx) {
    const unsigned G = gridDim.x * gridDim.y * gridDim.z;
    unsigned sum, cnt, mine, sp = 0u;
    for (;;) {
        sum = 0u; cnt = 0u; mine = 0u;
#pragma unroll
        for (unsigned j = 0; j < 16; ++j) { const unsigned c = xb_ld(&bar[XB_XCNT(j)]); sum += c; cnt += (c > 0u) ? 1u : 0u; mine = (j == x) ? c : mine; }
        if (sum == G) break;
        __builtin_amdgcn_s_sleep(1);
        if ((++sp & 255u) == 0u) { if (xb_ld(&bar[XB_TMO])) break; if (sp > XB_SPIN_CAP) { atomicAdd(&bar[XB_TMO], 1u); break; } }
    }
    nloc = mine > 0u ? mine : 1u; nx = cnt > 0u ? cnt : 1u;
}

__device__ __forceinline__ void xcd_barrier(const XcdBarrier& b) {
    asm volatile("s_waitcnt vmcnt(0)" ::: "memory");
    __syncthreads();
    if (threadIdx.x == 0) {
        unsigned* bar = b.bar; asm volatile("" : "+s"(bar)); unsigned bx = __builtin_amdgcn_readfirstlane(b.x); asm volatile("" : "+s"(bx));
        __builtin_amdgcn_s_waitcnt(0);
        unsigned nloc = b.st[0], nx = b.st[1];
        if (nloc == 0u) { xcd_barrier_complete(bar, bx, nloc, nx); b.st[0] = nloc; b.st[1] = nx; }
        const unsigned old = xb_add(&bar[XB_XSUB(bx)], 1u);
        const unsigned gen = old / nloc;
        if (old + 1u == (gen + 1u) * nloc) {
            __builtin_amdgcn_fence(__ATOMIC_RELEASE, "agent");
            asm volatile("s_waitcnt vmcnt(0)" ::: "memory");
            const unsigned og = xb_add(&bar[XB_TOP], 1u);
            const unsigned tg = og / nx;
            if (og + 1u == (tg + 1u) * nx) xb_add(&bar[XB_TOPGEN], 1u);
            else XB_SPIN(xb_ld(&bar[XB_TOPGEN]) == tg, bar);
            __builtin_amdgcn_fence(__ATOMIC_ACQUIRE, "agent");
            xb_add(&bar[XB_XGEN(bx)], 1u);
            asm volatile("s_waitcnt vmcnt(0)" ::: "memory");
        } else {
            XB_SPIN(xb_ld(&bar[XB_XGEN(bx)]) == gen, bar);
            __builtin_amdgcn_fence(__ATOMIC_ACQUIRE, "agent");
            asm volatile("s_waitcnt vmcnt(0)" ::: "memory");
        }
    }
    __syncthreads();
}
#ifndef DUP_MASK
#define DUP_MASK 0
#endif
#define DUP(kind) (((DUP_MASK) >> (kind)) & 1)
#ifndef DUPR_MASK
#define DUPR_MASK 0
#endif
#define DUPR(kind) (((DUPR_MASK) >> (kind)) & 1)
#ifndef DUPR_MODE
#define DUPR_MODE 0
#endif
#ifndef MK_PER_PHASE
#define MK_PER_PHASE 0
#endif

constexpr size_t MiB = 1u << 20;
constexpr size_t WS_CTL = 0, CTL_ZERO_BYTES = 1 * MiB;
constexpr size_t WS_ROPE = 1 * MiB;
constexpr size_t WS_LB = 1 * MiB + 256 * 1024;
constexpr size_t WS_KMX = 1 * MiB + 384 * 1024;
constexpr size_t WS_DST = 1 * MiB + 512 * 1024;
constexpr size_t WS_SSQ = 2 * MiB;
constexpr size_t WS_WTE = 3 * MiB;
constexpr size_t WS_WTO = 25 * MiB;
constexpr size_t WS_XB = 38 * MiB;
constexpr size_t WS_R0 = 70 * MiB, RSZ = 32 * MiB;
constexpr size_t WS_END = WS_R0 + 6 * RSZ;
constexpr int CW_BAR = 4096;

constexpr int RING_BYTES = 139264;
constexpr int LDSCTL_OFF = RING_BYTES + 8 * pg8::EPI_STG_WAVE, MISC_OFF = LDSCTL_OFF + 320;
constexpr int LDS_BYTES = 163840;
constexpr int NWAVES = 8, GRID = 256;
constexpr int NPH = 20;

struct Frame {
    LAS unsigned char* lds; volatile LAS unsigned* MISC; gu32* ctl;
    int tid, lane, wave, vcu, G;
};

__device__ __forceinline__ void transpose_item(const float* W, const float* sc, int K, int N, bf16* WT, LAS float* scr, int item, int lane) {
    const int nblk = N / 32, kb = item / nblk, nb = item % nblk, k0 = 64 * kb, n0 = 32 * nb;
    const int c4 = lane & 7, rk = lane >> 3;
#pragma unroll
    for (int i = 0; i < 8; ++i) { const int kk = 8 * i + rk; const float s = sc ? sc[k0 + kk] : 1.0f;
        f32x4 v = *(const GAS f32x4*)(W + (size_t)(k0 + kk) * N + n0 + 4 * c4); v = v * s; *(LAS f32x4*)(scr + kk * 36 + 4 * c4) = v; }
    LDS_WAIT(); asm volatile("" ::: "memory");
    const int c = lane & 7;
#pragma unroll
    for (int j = 0; j < 4; ++j) { const int n = (lane >> 3) + 8 * j; const LAS float* s = scr + (8 * c) * 36 + n;
        v4u o; o.x = pk2(s[0 * 36], s[1 * 36]); o.y = pk2(s[2 * 36], s[3 * 36]); o.z = pk2(s[4 * 36], s[5 * 36]); o.w = pk2(s[6 * 36], s[7 * 36]);
        *(GAS v4u*)(WT + (size_t)(n0 + n) * K + k0 + 8 * c) = o; }
    LDS_WAIT(); asm volatile("" ::: "memory");
}
__device__ __forceinline__ void convert_layer(Frame& F, const float* Win, const float* nrm, int Nin, const float* Wout, bf16* dstbuf, int wg = -1, int nwg = 0) {
    int lane = F.lane; asm volatile("" : "+v"(lane));
    LAS float* scr = (LAS float*)(F.lds + F.wave * 16384);
    const int gw = (wg < 0 ? F.vcu : wg) * NWAVES + F.wave, NGW = (wg < 0 ? F.G : nwg) * NWAVES;
    const int I_in = (DM / 64) * (Nin / 32), I_out = (DIN / 64) * (DM / 32);
    bf16* wout_t = dstbuf + (size_t)Nin * DM;
    for (int it = gw; it < I_in + I_out; it += NGW) {
        if (it < I_in) transpose_item(Win, nrm, DM, Nin, dstbuf, scr, it, lane);
        else transpose_item(Wout, nullptr, DIN, DM, wout_t, scr, it - I_in, lane);
    }
}
__device__ __forceinline__ float wave_sum(float v) {
#pragma unroll
    for (int o = 1; o < 64; o <<= 1) v += __shfl_xor(v, o);
    return v;
}

__device__ __forceinline__ void stagger(int vcu, unsigned ticks) {
    if (vcu & 1) { const unsigned long long t0 = __builtin_amdgcn_s_memrealtime(); while (__builtin_amdgcn_s_memrealtime() - t0 < ticks) __builtin_amdgcn_s_sleep(8); }
}
#ifndef STAG_EVEN
#define STAG_EVEN 0
#endif
#ifndef STAG_ODD
#define STAG_ODD 0
#endif
struct Args { const float* in[13]; float* out; unsigned char* ws; int ph_lo, ph_hi; };

__global__ void __launch_bounds__(NWAVES * 64, 2) mk_fwd(Args args) {
    extern __shared__ __attribute__((aligned(16))) unsigned char lds[];
    Frame F;
    F.lds = (LAS unsigned char*)lds;
    F.MISC = (volatile LAS unsigned*)(F.lds + MISC_OFF);
    F.tid = threadIdx.x; F.lane = F.tid & 63; F.wave = __builtin_amdgcn_readfirstlane(F.tid >> 6);
    F.G = gridDim.x; { const int bx = blockIdx.x; F.vcu = (F.G % 8 == 0) ? (bx % 8) * (F.G / 8) + bx / 8 : bx; }
    unsigned char* ws = args.ws;
    F.ctl = (gu32*)(ws + WS_CTL);
    for (int u = F.tid; u < (LDS_BYTES - LDSCTL_OFF) / 4; u += NWAVES * 64) ((LAS unsigned*)(F.lds + LDSCTL_OFF))[u] = 0u;
    __syncthreads();
    const int lo = args.ph_lo, hi = args.ph_hi; (void)lo; (void)hi;
    const bool multi = MK_PER_PHASE ? ((hi - lo) > 1) : true;
    XcdBarrier bar; bar.bar = (unsigned*)(F.ctl + CW_BAR); bar.x = 0; bar.st = nullptr;
    if (multi) bar = xcd_barrier_post((unsigned*)(F.ctl + CW_BAR), F.MISC + 8);
#ifndef PHASE_MASK
#define PHASE_MASK 0xFFFF
#endif
#if MK_PER_PHASE
#define INK(kind, k) ((((PHASE_MASK) >> (kind)) & 1) && lo <= (k) && (k) < hi)
#define IN(k) (lo <= (k) && (k) < hi)
#else
#define INK(kind, k) (((PHASE_MASK) >> (kind)) & 1)
#define IN(k) true
#endif
#if MK_PER_PHASE
#define SEAM(k) do { if (IN(k) && IN((k) + 1)) xcd_barrier(bar); } while (0)
#else
#define SEAM(k) do { xcd_barrier(bar); if (DUP(9)) xcd_barrier(bar); } while (0)
#endif

#define PTRS() size_t wz_ = 0; asm volatile("" : "+s"(wz_)); unsigned char* wsl = args.ws + wz_; \
    const float* x_in = args.in[0]; float* xres = args.out; \
    float* rope = (float*)(wsl + WS_ROPE); float* lbt = (float*)(wsl + WS_LB); float* dstv = (float*)(wsl + WS_DST); float* ssq = (float*)(wsl + WS_SSQ); unsigned* kmx = (unsigned*)(wsl + WS_KMX); (void)kmx; \
    bf16* wte = (bf16*)(wsl + WS_WTE); bf16* wto = (bf16*)(wsl + WS_WTO); bf16* xb = (bf16*)(wsl + WS_XB); float* ust = args.out;     \
    unsigned char* R0 = wsl + WS_R0; unsigned char* R1 = R0 + RSZ; unsigned char* R2 = R1 + RSZ; unsigned char* R3 = R2 + RSZ; unsigned char* R4 = R3 + RSZ; unsigned char* R5 = R4 + RSZ; \
    const int gw = F.vcu * NWAVES + F.wave, NGW = F.G * NWAVES; int tidl = threadIdx.x; asm volatile("" : "+v"(tidl)); const int lanel = tidl & 63; (void)lanel; \
    (void)x_in; (void)xres; (void)rope; (void)lbt; (void)dstv; (void)ssq; (void)wte; (void)wto; (void)xb; (void)ust; (void)R0; (void)R1; (void)R2; (void)R3; (void)R4; (void)R5; (void)gw; (void)NGW;

    for (int rep_ = 0; rep_ < (DUP(0) ? 2 : 1); ++rep_)
    if (INK(0, 0)) {
        PTRS();
        convert_layer(F, args.in[2], args.in[1], EVEN_IN, args.in[7], wte);
        convert_layer(F, args.in[9], args.in[8], ODD_IN, args.in[11], wto);
        {
            const int gt = F.vcu * (NWAVES * 64) + tidl, NGT = F.G * NWAVES * 64;
            for (int e = gt; e < SEQ * 8; e += NGT) { const int pos = e >> 3, i = e & 7; const double inv = pow(500000.0, -(double)i / 8.0); const double ang = (double)pos * inv;
                rope[e] = (float)cos(ang); rope[SEQ * 8 + e] = (float)sin(ang); }
            const float* lg = args.in[6];
            for (int e = gt; e < 2 * 1024; e += NGT) { const int dir = e >> 10, c = e & 1023; const float l0 = lg[(dir * 2 + 0) * 1024 + c], l1 = lg[(dir * 2 + 1) * 1024 + c];
                lbt[e] = 0.0f; lbt[2048 + e] = 1.0f / (1.0f + expf(l0 - l1)); }
            if (gt < 4 * NB * 16 + 2 * NB * 32) kmx[gt] = 0u;
        }
        for (int m = gw; m < T; m += NGW) {
            const GAS f32x4* xr = (const GAS f32x4*)(x_in + (size_t)m * DM) + lanel; f32x4 v[4]; float s = 0.f;
#pragma unroll
            for (int j = 0; j < 4; ++j) { v[j] = xr[64 * j]; s += (v[j].x * v[j].x + v[j].y * v[j].y) + (v[j].z * v[j].z + v[j].w * v[j].w); }
            s = wave_sum(s);
            GAS unsigned long long* o8 = (GAS unsigned long long*)(xb + (size_t)m * DM) + lanel;
#pragma unroll
            for (int j = 0; j < 4; ++j) o8[64 * j] = (unsigned long long)pk2(v[j].x, v[j].y) | ((unsigned long long)pk2(v[j].z, v[j].w) << 32);
            if (lanel < 16) ssq[(size_t)m * 16 + lanel] = (lanel == 0) ? s : 0.0f;
        }
    }
    SEAM(0);

#pragma unroll 1
    for (int layer = 0; layer < 4; ++layer) {
        const int j = layer >> 1; const bool even = (layer & 1) == 0;
        const int pb = 1 + (layer >> 1) * 9 + (even ? 0 : 6);
        if (even) {
            const float lam_init = (j == 0) ? 0.2f : 0.470713018f;
            if (INK(1, pb + 0)) {
        PTRS();
                pg8::Gemm g{xb, wte, T, 4096, DM, DM, 1 << 30, 0l}; pg8::StaticOrder S; S.init(T, 4096, F.G, (int)blockIdx.x);
                pg8::EpiIn<true> E{ssq, rope, lbt + j * 2048, R0, R1, R2, R3, R4, R5, 0, nullptr, kmx + j * (NB * 16)};
                if (DUP(1)) { pg8::EpiDry ED; pg8::gemm_phase(F.lds, g, S, ED); }
                if (DUPR(1)) { pg8::EpiIn<true, DUPR_MODE> E2{ssq, rope, lbt + j * 2048, R0, R1, R2, R3, R4, R5, 0, nullptr, kmx + j * (NB * 16)}; pg8::gemm_phase(F.lds, g, S, E2); }
                if (STAG_EVEN) stagger(F.vcu, STAG_EVEN);
                pg8::gemm_phase(F.lds, g, S, E);
            }
            SEAM(pb + 0);
            if (INK(2, pb + 1)) {
        PTRS();
                if (layer == 2) { convert_layer(F, args.in[9] + (size_t)DM * ODD_IN, args.in[8] + DM, ODD_IN, args.in[11] + (size_t)DIN * DM, wto); __syncthreads(); }
                const float* lq = args.in[3] + j * 256; float s1 = 0.f, s2 = 0.f;
                for (int i = 0; i < 64; ++i) { s1 += lq[i] * lq[64 + i]; s2 += lq[128 + i] * lq[192 + i]; }
                const float lam = expf(s1) - expf(s2) + lam_init;
                if (DUP(2)) for (int i = 0; i < 4; ++i) { const int bh = (F.vcu >> 5) * 4 + i, qb = F.vcu & 31;
                    att::diff_attn_unit<true, DUPR_MODE>(bh >> 3, bh & 7, qb, (const att::u16*)R0, (const att::u16*)R1, (const att::u16*)R2, (const att::u16*)R3, (att::u16*)R0,
                                        args.in[4] + j * 128, lam, 1.0f - lam_init, kmx + j * (NB * 16), (char*)lds); }
                for (int i = 0; i < 4; ++i) { const int bh = (F.vcu >> 5) * 4 + i, qb = F.vcu & 31;
                    att::diff_attn_unit<false>(bh >> 3, bh & 7, qb, (const att::u16*)R0, (const att::u16*)R1, (const att::u16*)R2, (const att::u16*)R3, (att::u16*)R0,
                                        args.in[4] + j * 128, lam, 1.0f - lam_init, kmx + j * (NB * 16), (char*)lds); }
            }
            SEAM(pb + 1);
            if (INK(1, pb + 2)) {
        PTRS();
                pg8::Gemm g{xb, wte + (size_t)4096 * DM, T, 5120, DM, DM, 1 << 30, 0l}; pg8::StaticOrder S; S.init(T, 5120, F.G, (int)blockIdx.x);
                pg8::EpiIn<true> E{ssq, rope, lbt + j * 2048, R0, R1, R2, R3, R4, R5, 16};
                if (DUP(1)) { pg8::EpiDry ED; pg8::gemm_phase(F.lds, g, S, ED); }
                if (DUPR(1)) { pg8::EpiIn<true, DUPR_MODE> E2{ssq, rope, lbt + j * 2048, R0, R1, R2, R3, R4, R5, 16}; pg8::gemm_phase(F.lds, g, S, E2); }
                if (STAG_EVEN) stagger(F.vcu, STAG_EVEN);
                pg8::gemm_phase(F.lds, g, S, E);
            }
            SEAM(pb + 2);
            if (INK(3, pb + 3)) {
        PTRS();
                if (DUP(3)) for (int it = F.vcu; it < 512; it += F.G) hg::hgrn_pass1(it, (const att::u16*)R2, (const att::u16*)R4, (const att::u16*)R5, ust, dstv, (char*)lds);
                for (int it = F.vcu; it < 512; it += F.G) hg::hgrn_pass1(it, (const att::u16*)R2, (const att::u16*)R4, (const att::u16*)R5, ust, dstv, (char*)lds);
            }
            SEAM(pb + 3);
            if (INK(4, pb + 4)) {
        PTRS();
                if (DUP(4)) for (int it = F.vcu; it < 256; it += F.G) hg::hgrn_pass2<true, DUPR_MODE>(it, (const att::u16*)R1, (const att::u16*)R2, (const att::u16*)R4, (const att::u16*)R5, (const att::u16*)R3,
                                                                        (att::u16*)R4, (att::u16*)R1, ust, dstv, args.in[5] + j * 128, (char*)lds);
                for (int it = F.vcu; it < 256; it += F.G) hg::hgrn_pass2<false>(it, (const att::u16*)R1, (const att::u16*)R2, (const att::u16*)R4, (const att::u16*)R5, (const att::u16*)R3,
                                                                        (att::u16*)R4, (att::u16*)R1, ust, dstv, args.in[5] + j * 128, (char*)lds);
            }
            SEAM(pb + 4);
            if (INK(5, pb + 5)) {
        PTRS();
                pg8::Gemm g{(const bf16*)R0, wte + (size_t)EVEN_IN * DM, T, DM, DIN, DM, 16, (long)RSZ - 2048l}; pg8::StaticOrder S; S.init(T, DM, F.G, (int)blockIdx.x);
                if (DUP(5)) { pg8::EpiDry ED; pg8::gemm_phase(F.lds, g, S, ED); }
                if (layer == 0) { pg8::EpiOut<true, false> E{x_in, xres, xb, ssq}; pg8::gemm_phase(F.lds, g, S, E); }
                else            { pg8::EpiOut<false, false> E{x_in, xres, xb, ssq}; pg8::gemm_phase(F.lds, g, S, E); }
            }
            SEAM(pb + 5);
        } else {
            if (INK(6, pb + 0)) {
        PTRS();
                pg8::Gemm g{xb, wto, T, ODD_IN, DM, DM, 1 << 30, 0l}; pg8::StaticOrder S; S.init(T, ODD_IN, F.G, (int)blockIdx.x);
                pg8::EpiIn<false> E{ssq, rope, nullptr, R0, R1, R2, R3, R4, R5, 0, kmx + 4 * NB * 16 + j * (NB * 32), kmx + (2 + j) * (NB * 16)};
                if (DUP(6)) { pg8::EpiDry ED; pg8::gemm_phase(F.lds, g, S, ED); }
                if (DUPR(6)) pg8::gemm_phase(F.lds, g, S, E);
                if (STAG_ODD) stagger(F.vcu, STAG_ODD);
                pg8::gemm_phase(F.lds, g, S, E);
                if (layer == 1 && (int)blockIdx.x >= 128 && F.G == 256)
                    convert_layer(F, args.in[2] + (size_t)DM * EVEN_IN, args.in[1] + DM, EVEN_IN, args.in[7] + (size_t)DIN * DM, wte, (int)blockIdx.x - 128, 128);
            }
            SEAM(pb + 0);
            if (INK(7, pb + 1)) {
        PTRS();
                if (DUP(7)) att::swa_phase<true>(2 * F.vcu, (const att::u16*)R0, (const att::u16*)R2, (const att::u16*)(R2 + (size_t)T * 256 * 2), (const att::u16*)R3, (att::u16*)R0, args.in[10] + j * 32, kmx + 4 * NB * 16 + j * (NB * 32), kmx + (2 + j) * (NB * 16), (char*)lds);
                att::swa_phase<false>(2 * F.vcu, (const att::u16*)R0, (const att::u16*)R2, (const att::u16*)(R2 + (size_t)T * 256 * 2), (const att::u16*)R3, (att::u16*)R0, args.in[10] + j * 32, kmx + 4 * NB * 16 + j * (NB * 32), kmx + (2 + j) * (NB * 16), (char*)lds);
            }
            SEAM(pb + 1);
            if (INK(5, pb + 2)) {
        PTRS();
                pg8::Gemm g{(const bf16*)R0, wto + (size_t)ODD_IN * DM, T, DM, DIN, DIN, 1 << 30, 0l}; pg8::StaticOrder S; S.init(T, DM, F.G, (int)blockIdx.x);
                if (DUP(5)) { pg8::EpiDry ED; pg8::gemm_phase(F.lds, g, S, ED); }
                if (layer == 3) { pg8::EpiOut<false, true> E{x_in, xres, xb, ssq}; pg8::gemm_phase(F.lds, g, S, E); }
                else            { pg8::EpiOut<false, false> E{x_in, xres, xb, ssq}; pg8::gemm_phase(F.lds, g, S, E); }
            }
            SEAM(pb + 2);
        }
    }
    if (INK(8, 19)) {
        PTRS();
        const float* fw = args.in[12];
        for (int m = gw; m < T; m += NGW) {
            GAS f32x4* xr = (GAS f32x4*)(xres + (size_t)m * DM) + lanel; f32x4 v[4]; float s = 0.f;
#pragma unroll
            for (int jj = 0; jj < 4; ++jj) { v[jj] = xr[64 * jj]; s += (v[jj].x * v[jj].x + v[jj].y * v[jj].y) + (v[jj].z * v[jj].z + v[jj].w * v[jj].w); }
            s = wave_sum(s); const float rs = 1.0f / sqrtf(s * (1.0f / DM) + EPS);
#pragma unroll
            for (int jj = 0; jj < 4; ++jj) { const f32x4 w = *((const f32x4*)fw + lanel + 64 * jj); xr[64 * jj] = v[jj] * rs * w; }
        }
    }
#undef IN
#undef INK
#undef SEAM
}

extern "C" void kernel_launch(void* const* d_in, const int* in_sizes, int n_in, void* d_out, int out_size, void* d_ws, size_t ws_size, hipStream_t stream) {
    static int ok = 0;
    if (ok == 0) {
        if (n_in != 13 || in_sizes[0] != T * DM || out_size != T * DM || ws_size < WS_END) { fprintf(stderr, "kernel_launch: shape/workspace mismatch (n_in %d, ws %zu, need %zu)\n", n_in, ws_size, (size_t)WS_END); ok = -1; return; }
        if (hipFuncSetAttribute((const void*)mk_fwd, hipFuncAttributeMaxDynamicSharedMemorySize, LDS_BYTES) != hipSuccess) { fprintf(stderr, "kernel_launch: hipFuncSetAttribute failed\n"); ok = -1; return; }
        int per_cu = 0;
        if (hipOccupancyMaxActiveBlocksPerMultiprocessor(&per_cu, (const void*)mk_fwd, NWAVES * 64, LDS_BYTES) != hipSuccess || per_cu < 1) fprintf(stderr, "kernel_launch: occupancy query reports %d\n", per_cu);
        (void)hipGetLastError();
        ok = 1;
    }
    if (ok < 0) return;
    (void)hipMemsetAsync((char*)d_ws + WS_CTL, 0, CTL_ZERO_BYTES, stream);
    Args a{};
    for (int i = 0; i < 13; ++i) a.in[i] = (const float*)d_in[i];
    a.out = (float*)d_out; a.ws = (unsigned char*)d_ws;
#if MK_PER_PHASE
    for (int p = 0; p < NPH; ++p) { a.ph_lo = p; a.ph_hi = p + 1; hipLaunchKernelGGL(mk_fwd, dim3(GRID), dim3(NWAVES * 64), LDS_BYTES, stream, a); }
#else
    a.ph_lo = 0; a.ph_hi = NPH;
    hipLaunchKernelGGL(mk_fwd, dim3(GRID), dim3(NWAVES * 64), LDS_BYTES, stream, a);
#endif
    const hipError_t le = hipPeekAtLastError();
    if (le != hipSuccess) fprintf(stderr, "kernel_launch: launch failed: %s\n", hipGetErrorName(le));
}
```

```cpp
#include <hip/hip_runtime.h>
#include <hip/hip_bf16.h>
#include <cstdio>
#include <cstdint>

constexpr int NB = 4, SEQ = 4096, DM = 1024, T = NB * SEQ;
constexpr int EVEN_IN = 9216, ODD_IN = 4608, DIN = 2048;
constexpr float EPS = 1e-6f;
constexpr float C2 = 0.125f * 1.4426950408889634f;
constexpr float LOG2E = 1.4426950408889634f;

namespace pg8 {
#define PG8_LAS __attribute__((address_space(3)))
typedef unsigned short bf16_t;
typedef short bf16x8 __attribute__((ext_vector_type(8)));
typedef float f32x4 __attribute__((ext_vector_type(4)));
typedef unsigned u32x4 __attribute__((ext_vector_type(4)));
constexpr int BM = 256, BK = 64, HALF = 128, HTB = HALF * BK * 2, STAGE_BYTES = 8 * HTB, NXCD = 8, WGM = 4;
constexpr int EPI_STG_OFF = 139264, EPI_STG_RS = 144, EPI_STG_WAVE = 16 * EPI_STG_RS;

__host__ __device__ __forceinline__ int lds_byte(int r, int c) { const int st = (r >> 4) * 2 + (c >> 5), rr = r & 15, cc = c & 31, ob = rr * 64 + cc * 2; return st * 1024 + (ob ^ (((ob >> 9) & 1) << 5)); }
__host__ __device__ __forceinline__ void stage_rc(int b, int& R, int& C) { const int st = b / 1024, sb = b % 1024, swz = sb ^ (((sb >> 9) & 1) << 5); R = (st >> 1) * 16 + swz / 64; C = (st & 1) * 32 + (swz % 64) / 2; }
__host__ __device__ __forceinline__ int perm32(int rho) { const int n = rho >> 4, i = rho & 15; return 8 * (i >> 2) + 4 * n + (i & 3); }

struct Unit { int pm, pn; };
struct Gemm { const bf16_t* A; const bf16_t* Bt; int M, N, K, lda, ksplit; long jump; };

struct StaticOrder {
    int nM, nN, nwg, G, c;
    __host__ __device__ void init(int M, int N, int G_, int c_) { nM = M / BM; nN = N / BM; nwg = nM * nN; G = G_; c = c_; }
    __host__ __device__ bool next(int i, Unit& u) const {
        const long L = (long)i * G + c; if (L >= nwg) return false;
        int wgid = (int)L; { const int q = nwg / NXCD, r = nwg % NXCD, xcd = wgid % NXCD, off = wgid / NXCD; wgid = (xcd < r ? xcd * (q + 1) : r * (q + 1) + (xcd - r) * q) + off; }
        const int nig = WGM * nN, gid = wgid / nig, fm = gid * WGM, gsz = (nM - fm) < WGM ? (nM - fm) : WGM;
        u.pm = fm + ((wgid % nig) % gsz); u.pn = (wgid % nig) / gsz; return true;
    }
};

__device__ __forceinline__ unsigned cvt_pk_bf16(float lo, float hi) { unsigned r; asm volatile("v_cvt_pk_bf16_f32 %0, %1, %2" : "=v"(r) : "v"(lo), "v"(hi)); return r; }

template <class Epi>
__device__ __forceinline__ void gemm_phase(PG8_LAS unsigned char* lds, const Gemm g, const StaticOrder& S, const Epi& E) {
    int tid = threadIdx.x; asm volatile("" : "+v"(tid));
    const int wid = __builtin_amdgcn_readfirstlane(tid >> 6), lane = tid & 63, wr = wid >> 2, wc = wid & 3, fr = lane & 15, fq = lane >> 4;
    const int K = g.K, nt = K / BK, lda = g.lda;
    unsigned voffA[2], voffB[2];
#pragma unroll
    for (int i = 0; i < 2; ++i) { int R, C; stage_rc(tid * 16 + i * 8192, R, C); const int Rb = 64 * (R >> 5) + perm32(R & 31);
        voffA[i] = (unsigned)(R * lda + C) * 2u; voffB[i] = (unsigned)(Rb * K + C) * 2u; }
    const size_t kstep = (size_t)(BK * 2);
    const size_t hstepA = (size_t)HALF * lda * 2, tstepA = 2 * hstepA;
    const size_t hstepB = (size_t)32 * K * 2, tstepB = (size_t)BM * K * 2;
    const unsigned ldsw = (unsigned)wid * 1024u;
    const int aoff = lds_byte(wr * 64 + fr, fq * 8), boff = lds_byte(wc * 32 + fr, fq * 8);
    const int ksplit = g.ksplit; const long jump = g.jump;
#define PG8_AP(base, t) ((base) + (size_t)(t) * kstep + (((t) >= ksplit) ? jump : 0l))
#define PG8_SA(b, h) (((b) * 2 + (h)) * HTB)
#define PG8_SB(b, h) ((4 + (b) * 2 + (h)) * HTB)
#define PG8_STAGE(bufoff, gbase, voff) do { _Pragma("unroll") for (int _i = 0; _i < 2; ++_i) \
        __builtin_amdgcn_global_load_lds((const unsigned*)((const char*)(gbase) + (voff)[_i]), (PG8_LAS unsigned*)(lds + (bufoff) + ldsw + _i * 8192), 16, 0, 0); } while (0)
#define PG8_LDA(dst, b, h) do { _Pragma("unroll") for (int m = 0; m < 4; ++m) _Pragma("unroll") for (int k = 0; k < 2; ++k) dst[m][k] = *(const PG8_LAS bf16x8*)(lds + PG8_SA(b, h) + aoff + m * 2048 + k * 1024); } while (0)
#define PG8_LDB(dst, b, h) do { _Pragma("unroll") for (int n = 0; n < 2; ++n) _Pragma("unroll") for (int k = 0; k < 2; ++k) dst[n][k] = *(const PG8_LAS bf16x8*)(lds + PG8_SB(b, h) + boff + n * 2048 + k * 1024); } while (0)
#define PG8_MMA(ai, bj, At, Bt) do { __builtin_amdgcn_s_setprio(1); _Pragma("unroll") for (int m = 0; m < 4; ++m) _Pragma("unroll") for (int n = 0; n < 2; ++n) _Pragma("unroll") for (int k = 0; k < 2; ++k) \
        acc[ai][bj][m][n] = __builtin_amdgcn_mfma_f32_16x16x32_bf16(Bt[n][k], At[m][k], acc[ai][bj][m][n], 0, 0, 0); __builtin_amdgcn_s_setprio(0); } while (0)
#define PG8_WAIT_V(n) asm volatile("s_waitcnt vmcnt(" #n ")" ::: "memory")
#define PG8_WAIT_L(n) asm volatile("s_waitcnt lgkmcnt(" #n ")" ::: "memory")
#define PG8_BAR __builtin_amdgcn_s_barrier()
#define PG8_SCHED __builtin_amdgcn_sched_barrier(0)
    Unit cur, nxt; int ui = 0;
    if (!S.next(0, cur)) return;
    f32x4 acc[2][2][4][2];
#pragma unroll
    for (int a = 0; a < 2; ++a)
#pragma unroll
        for (int b = 0; b < 2; ++b)
#pragma unroll
            for (int m = 0; m < 4; ++m)
#pragma unroll
                for (int n = 0; n < 2; ++n) acc[a][b][m][n] = (f32x4){0.f, 0.f, 0.f, 0.f};
    bf16x8 At[4][2], B0[2][2], B1[2][2];
    const char* cA = (const char*)g.A + (size_t)cur.pm * tstepA; const char* cB = (const char*)g.Bt + (size_t)cur.pn * tstepB;
    {
        PG8_STAGE(PG8_SB(0, 0), cB, voffB); PG8_STAGE(PG8_SB(0, 1), cB + hstepB, voffB); PG8_STAGE(PG8_SA(0, 0), cA, voffA); PG8_STAGE(PG8_SA(0, 1), cA + hstepA, voffA);
        if (wr == 1) PG8_BAR;
        PG8_WAIT_V(2); PG8_BAR;
        PG8_STAGE(PG8_SB(1, 0), cB + kstep, voffB); PG8_STAGE(PG8_SA(1, 0), PG8_AP(cA, 1), voffA); PG8_STAGE(PG8_SB(1, 1), cB + hstepB + kstep, voffB);
        PG8_WAIT_V(6); PG8_BAR;
    }
    for (;;) {
        const bool has_next = S.next(ui + 1, nxt);
        const char* nA = has_next ? (const char*)g.A + (size_t)nxt.pm * tstepA : cA; const char* nB = has_next ? (const char*)g.Bt + (size_t)nxt.pn * tstepB : cB;
        for (int t = 0; t < nt; t += 2) {
            const bool last = (t == nt - 2);
            const char* a1 = PG8_AP(cA, t + 1);
            const char* a2 = last ? nA : PG8_AP(cA, t + 2); const char* b2 = last ? nB : cB + (size_t)(t + 2) * kstep;
            const char* a3 = a2 + kstep; const char* b3 = b2 + kstep;
            PG8_LDB(B0, 0, 0); PG8_LDB(B1, 0, 1); PG8_SCHED; PG8_LDA(At, 0, 0); PG8_STAGE(PG8_SA(1, 1), a1 + hstepA, voffA);
            PG8_WAIT_V(8); PG8_WAIT_L(0); PG8_BAR; PG8_MMA(0, 0, At, B0); PG8_MMA(0, 1, At, B1); PG8_BAR; PG8_SCHED;
            PG8_LDA(At, 0, 1); PG8_STAGE(PG8_SB(0, 0), b2, voffB); PG8_STAGE(PG8_SB(0, 1), b2 + hstepB, voffB); PG8_STAGE(PG8_SA(0, 0), a2, voffA);
            PG8_WAIT_V(8); PG8_WAIT_L(0); PG8_BAR; PG8_MMA(1, 0, At, B0); PG8_MMA(1, 1, At, B1); PG8_BAR; PG8_SCHED;
            PG8_LDB(B0, 1, 0); PG8_LDB(B1, 1, 1); PG8_SCHED; PG8_LDA(At, 1, 0); PG8_STAGE(PG8_SA(0, 1), a2 + hstepA, voffA);
            PG8_WAIT_V(8); PG8_WAIT_L(0); PG8_BAR; PG8_MMA(0, 0, At, B0); PG8_MMA(0, 1, At, B1); PG8_BAR; PG8_SCHED;
            PG8_LDA(At, 1, 1); PG8_STAGE(PG8_SB(1, 0), b3, voffB); PG8_STAGE(PG8_SB(1, 1), b3 + hstepB, voffB); PG8_STAGE(PG8_SA(1, 0), a3, voffA);
            PG8_WAIT_V(8); PG8_WAIT_L(0); PG8_BAR; PG8_MMA(1, 0, At, B0); PG8_MMA(1, 1, At, B1); PG8_BAR; PG8_SCHED;
        }
        if (!Epi::OWN_ALIGN_BAR && wr == 0) PG8_BAR;
        E(acc, cur, wr, wc, fr, fq, lds + EPI_STG_OFF + wid * EPI_STG_WAVE, lane);
        if (!has_next) break;
#pragma unroll
        for (int a = 0; a < 2; ++a)
#pragma unroll
            for (int b = 0; b < 2; ++b)
#pragma unroll
                for (int m = 0; m < 4; ++m)
#pragma unroll
                    for (int n = 0; n < 2; ++n) acc[a][b][m][n] = (f32x4){0.f, 0.f, 0.f, 0.f};
        cur = nxt; cA = nA; cB = nB; ++ui;
        if (wr == 1) PG8_BAR;
    }
    PG8_WAIT_V(0);
    PG8_BAR;
#undef PG8_AP
#undef PG8_SA
#undef PG8_SB
#undef PG8_STAGE
#undef PG8_LDA
#undef PG8_LDB
#undef PG8_MMA
#undef PG8_WAIT_V
#undef PG8_WAIT_L
#undef PG8_BAR
#undef PG8_SCHED
}
}
namespace pg8 {
typedef unsigned short u16;
__device__ __forceinline__ float fsigmoid(float v) { return __builtin_amdgcn_rcpf(1.0f + __expf(-v)); }
__device__ __forceinline__ unsigned pk_f16(float lo, float hi) { _Float16 a = (_Float16)lo, b = (_Float16)hi; return (unsigned)__builtin_bit_cast(unsigned short, a) | ((unsigned)__builtin_bit_cast(unsigned short, b) << 16); }


__device__ __forceinline__ void store_rows128(PG8_LAS unsigned char* stg, u16* blk  , size_t pitch, u32x4 w0, u32x4 w1, int fr, int fq, int lane) {
    *(PG8_LAS u32x4*)(stg + fr * EPI_STG_RS + fq * 16) = w0; *(PG8_LAS u32x4*)(stg + fr * EPI_STG_RS + 64 + fq * 16) = w1;
    const int rr = lane >> 3, ch = lane & 7;
    const u32x4 a = *(const PG8_LAS u32x4*)(stg + rr * EPI_STG_RS + ch * 16), b = *(const PG8_LAS u32x4*)(stg + (8 + rr) * EPI_STG_RS + ch * 16);
    *(u32x4*)(blk + (size_t)rr * pitch + ch * 8) = a; *(u32x4*)(blk + (size_t)(8 + rr) * pitch + ch * 8) = b;
}

__device__ __forceinline__ float bf_lo(unsigned w) { return __uint_as_float(w << 16); }
__device__ __forceinline__ float bf_hi(unsigned w) { return __uint_as_float(w & 0xffff0000u); }
enum { K_PLAIN = 0, K_SILU = 1, K_ROPEQ = 2, K_ROPEK = 3, K_LOGF = 4, K_ROPEQN = 5 };

template <bool EVEN, int MODE = 0> struct EpiIn {
    static constexpr bool PERM = true;
    static constexpr bool OWN_ALIGN_BAR = true;
    const float* ssq;
    const float* rope;
    const float* lb;
    unsigned char* r0; unsigned char* r1; unsigned char* r2; unsigned char* r3; unsigned char* r4; unsigned char* r5;
    int pn_off;
    unsigned* qmx = nullptr;
    unsigned* kmx = nullptr;
    __device__ __forceinline__ void operator()(const f32x4 (&acc)[2][2][4][2], const Unit& u, int wr, int wc, int fr, int fq, PG8_LAS unsigned char* stg, int lane) const {
        const int gpn = u.pn + pn_off;
        int kind, pitch, colt, dir = 0; u16* outp;
        if (EVEN) {
            const int grp = gpn >> 2; colt = (gpn & 3) * 256; pitch = 1024;
            switch (grp) {
                case 0: kind = K_ROPEQ; outp = (u16*)r0; break;
                case 1: kind = K_ROPEK; outp = (u16*)r1; break;
                case 2: kind = K_PLAIN; outp = (u16*)r2; break;
                case 3: kind = K_SILU;  outp = (u16*)r3; break;
                case 4: kind = K_SILU;  outp = (u16*)r1; break;
                case 5: kind = K_LOGF;  outp = (u16*)r4; dir = 0; break;
                case 6: kind = K_LOGF;  outp = (u16*)r5; dir = 1; break;
                case 7: kind = K_PLAIN; outp = (u16*)r2; break;
                default: kind = K_SILU; outp = (u16*)r3; break;
            }
        } else {
            if (gpn < 8)       { kind = K_ROPEQN; outp = (u16*)r0; pitch = 2048; colt = gpn * 256; }
            else if (gpn == 8) { kind = K_ROPEK; outp = (u16*)r2; pitch = 256;  colt = 0; }
            else if (gpn == 9) { kind = K_PLAIN; outp = (u16*)(r2 + (size_t)T * 256 * 2); pitch = 256; colt = 0; }
            else               { kind = K_SILU;  outp = (u16*)r3; pitch = 2048; colt = (gpn - 10) * 256; }
        }
        int row0 = u.pm * BM + wr * 64 + fr; asm volatile("" : "+v"(row0));
        if (MODE == 2) kind = K_PLAIN;
        float rsv[8];
        {
            f32x4 sq[8];
#pragma unroll
            for (int i = 0; i < 8; ++i) sq[i] = *((const f32x4*)(ssq + (size_t)(row0 + (i >> 2) * HALF + (i & 3) * 16) * 16) + fq);
            if (wr == 0) __builtin_amdgcn_s_barrier();
#pragma unroll
            for (int i = 0; i < 8; ++i) { float tot = (sq[i][0] + sq[i][1]) + (sq[i][2] + sq[i][3]); tot += __shfl_xor(tot, 16); tot += __shfl_xor(tot, 32); rsv[i] = __builtin_amdgcn_rsqf(tot * (1.0f / DM) + EPS); }
            asm volatile("" ::: "memory");
        }
        u16* const blk0 = outp + (size_t)(row0 - fr) * pitch + colt + wc * 64;
        if (kind == K_LOGF)        rows<K_LOGF>(acc, rsv, blk0, pitch, colt + wc * 64, dir, row0, 1.0f, fr, fq, stg, lane);
        else if (kind == K_SILU)   rows<K_SILU>(acc, rsv, blk0, pitch, 0, 0, row0, 1.0f, fr, fq, stg, lane);
        else if (kind == K_PLAIN)  rows<K_PLAIN>(acc, rsv, blk0, pitch, 0, 0, row0, 1.0f, fr, fq, stg, lane);
        else if (kind == K_ROPEK)  rows<K_ROPEK>(acc, rsv, blk0, pitch, colt + wc * 64, 0, row0, 1.0f, fr, fq, stg, lane);
        else if (kind == K_ROPEQN) rows<K_ROPEQN>(acc, rsv, blk0, pitch, colt + wc * 64, 0, row0, C2, fr, fq, stg, lane);
        else                       rows<K_ROPEQ>(acc, rsv, blk0, pitch, 0, 0, row0, (kind == K_ROPEQ) ? C2 : 1.0f, fr, fq, stg, lane);
    }
    template <int KIND>
    __device__ __forceinline__ void rows(const f32x4 (&acc)[2][2][4][2], const float (&rsv)[8], u16* blk0, int pitch, int ccol, int dir, int row0, float qs, int fr, int fq, PG8_LAS unsigned char* stg, int lane) const {
        f32x4 lbv[2][2];
        if (KIND == K_LOGF) {
#pragma unroll
            for (int bj = 0; bj < 2; ++bj) { const int c0 = ccol + bj * 32 + 8 * fq; lbv[bj][0] = *(const f32x4*)(lb + dir * 1024 + c0); lbv[bj][1] = *(const f32x4*)(lb + dir * 1024 + c0 + 4); }
        }
        f32x4 cs0, cs1, sn0, sn1, ncs0, ncs1, nsn0, nsn1;
        constexpr bool ROPE = (KIND == K_ROPEQ || KIND == K_ROPEK || KIND == K_ROPEQN), NORMX = (KIND == K_ROPEK || KIND == K_ROPEQN); float kn2 = 0.f;
        if (ROPE) { const int pos = row0 & (SEQ - 1); const f32x4* cp = (const f32x4*)(rope + (size_t)pos * 8); const f32x4* spn = (const f32x4*)(rope + (size_t)SEQ * 8 + (size_t)pos * 8);
            ncs0 = cp[0]; ncs1 = cp[1]; nsn0 = spn[0]; nsn1 = spn[1]; }
#pragma unroll
        for (int ai = 0; ai < 2; ++ai)
#pragma unroll
            for (int m = 0; m < 4; ++m) {
                const float rs = rsv[ai * 4 + m];
                if (ROPE) { cs0 = ncs0; cs1 = ncs1; sn0 = nsn0; sn1 = nsn1;
                    if (ai * 4 + m < 7) { const int i2 = ai * 4 + m + 1; const int pos = (row0 + (i2 >> 2) * HALF + (i2 & 3) * 16) & (SEQ - 1);
                        const f32x4* cp = (const f32x4*)(rope + (size_t)pos * 8); const f32x4* spn = (const f32x4*)(rope + (size_t)SEQ * 8 + (size_t)pos * 8);
                        ncs0 = cp[0]; ncs1 = cp[1]; nsn0 = spn[0]; nsn1 = spn[1]; } }
                u32x4 wst[2];
#pragma unroll
                for (int bj = 0; bj < 2; ++bj) {
                    f32x4 v0 = acc[ai][bj][m][0] * rs, v1 = acc[ai][bj][m][1] * rs;
                    u32x4 w;
                    if (KIND == K_LOGF) {
                        const f32x4 l0 = lbv[bj][0], l1 = lbv[bj][1];
                        float o[8];
#pragma unroll
                        for (int e = 0; e < 4; ++e) { const float f0 = l0[e] + (1.0f - l0[e]) * fsigmoid(v0[e]), f1 = l1[e] + (1.0f - l1[e]) * fsigmoid(v1[e]);
                            o[e] = fmaxf(__builtin_amdgcn_logf(f0), -43.2808512f); o[4 + e] = fmaxf(__builtin_amdgcn_logf(f1), -43.2808512f); }
                        w.x = pk_f16(o[0], o[1]); w.y = pk_f16(o[2], o[3]); w.z = pk_f16(o[4], o[5]); w.w = pk_f16(o[6], o[7]);
                    } else {
                        if (KIND == K_SILU) {
#pragma unroll
                            for (int e = 0; e < 4; ++e) { v0[e] = v0[e] * fsigmoid(v0[e]); v1[e] = v1[e] * fsigmoid(v1[e]); }
                        } else if (ROPE && bj == 0) {
                            f32x4 o0, o1;
#pragma unroll
                            for (int e = 0; e < 4; ++e) { o0[e] = __shfl_xor(v0[e], 16); o1[e] = __shfl_xor(v1[e], 16); }
                            if (fq < 2) {
                                const float sg = (fq == 0) ? -1.0f : 1.0f;
                                v0 = v0 * cs0 + (o0 * sn0) * sg; v1 = v1 * cs1 + (o1 * sn1) * sg;
                            }
                        }
                        if (KIND == K_ROPEQ || KIND == K_ROPEQN) { v0 = v0 * qs; v1 = v1 * qs; }
                        w.x = cvt_pk_bf16(v0[0], v0[1]); w.y = cvt_pk_bf16(v0[2], v0[3]); w.z = cvt_pk_bf16(v1[0], v1[1]); w.w = cvt_pk_bf16(v1[2], v1[3]);
                    }
                    wst[bj] = w;
                }
                if (NORMX) {
                    float n2 = 0.f;
#pragma unroll
                    for (int bj = 0; bj < 2; ++bj) { const u32x4 w = wst[bj]; const float a0 = bf_lo(w.x), a1 = bf_hi(w.x), a2 = bf_lo(w.y), a3 = bf_hi(w.y), a4 = bf_lo(w.z), a5 = bf_hi(w.z), a6 = bf_lo(w.w), a7 = bf_hi(w.w);
                        n2 += (a0 * a0 + a1 * a1) + (a2 * a2 + a3 * a3) + (a4 * a4 + a5 * a5) + (a6 * a6 + a7 * a7); }
                    n2 += __shfl_xor(n2, 16); n2 += __shfl_xor(n2, 32); kn2 = fmaxf(kn2, n2);
                }
                if (MODE != 1) store_rows128(stg, blk0 + (size_t)(ai * HALF + m * 16) * pitch, (size_t)pitch, wst[0], wst[1], fr, fq, lane); else asm volatile("" :: "v"(wst[0]), "v"(wst[1]));
            }
        if (NORMX) {
            int ln; asm volatile("v_mbcnt_lo_u32_b32 %0, -1, 0\n\tv_mbcnt_hi_u32_b32 %0, -1, %0" : "=v"(ln));
#pragma unroll
            for (int o = 1; o < 16; o <<= 1) kn2 = fmaxf(kn2, __uint_as_float(__builtin_amdgcn_ds_bpermute((ln ^ o) << 2, __float_as_uint(kn2))));
            if (ln == 0) __hip_atomic_fetch_max((KIND == K_ROPEK) ? kmx + (row0 / SEQ) * 16 + (ccol >> 6) : qmx + (row0 / SEQ) * 32 + (ccol >> 6), __float_as_uint(kn2), __ATOMIC_RELAXED, __HIP_MEMORY_SCOPE_AGENT);
        }
    }
};

template <bool FIRST, bool LAST> struct EpiOut {
    static constexpr bool PERM = true;
    static constexpr bool OWN_ALIGN_BAR = true;
    const float* xin; float* xout; u16* xb; float* ssq;
    __device__ __forceinline__ void operator()(const f32x4 (&acc)[2][2][4][2], const Unit& u, int wr, int wc, int fr, int fq, PG8_LAS unsigned char* stg, int lane) const {
        int row0 = u.pm * BM + wr * 64 + fr; asm volatile("" : "+v"(row0));
        const int cb = u.pn * BM + wc * 64 + 8 * fq;
        f32x4 nx[2][2];
#define LOADX(dst, rw) do { _Pragma("unroll") for (int bj = 0; bj < 2; ++bj) { const size_t off = (size_t)(rw) * DM + cb + bj * 32; \
            if (FIRST) { dst[bj][0] = *(const f32x4*)(xin + off); dst[bj][1] = *(const f32x4*)(xin + off + 4); } \
            else { const u32x4 w = *(const u32x4*)(xb + off); dst[bj][0] = (f32x4){bf_lo(w.x), bf_hi(w.x), bf_lo(w.y), bf_hi(w.y)}; dst[bj][1] = (f32x4){bf_lo(w.z), bf_hi(w.z), bf_lo(w.w), bf_hi(w.w)}; } } } while (0)
        if (FIRST) { LOADX(nx, row0); if (wr == 0) __builtin_amdgcn_s_barrier(); }
        else { u32x4 wr_[2];
#pragma unroll
            for (int bj = 0; bj < 2; ++bj) wr_[bj] = *(const u32x4*)(xb + (size_t)row0 * DM + cb + bj * 32);
            if (wr == 0) __builtin_amdgcn_s_barrier();
#pragma unroll
            for (int bj = 0; bj < 2; ++bj) { const u32x4 w = wr_[bj]; nx[bj][0] = (f32x4){bf_lo(w.x), bf_hi(w.x), bf_lo(w.y), bf_hi(w.y)}; nx[bj][1] = (f32x4){bf_lo(w.z), bf_hi(w.z), bf_lo(w.w), bf_hi(w.w)}; } }
#pragma unroll
        for (int ai = 0; ai < 2; ++ai)
#pragma unroll
            for (int m = 0; m < 4; ++m) {
                const int row = row0 + ai * HALF + m * 16; float part = 0.f; u32x4 wst[2];
                f32x4 ox[2][2];
#pragma unroll
                for (int bj = 0; bj < 2; ++bj) { ox[bj][0] = nx[bj][0]; ox[bj][1] = nx[bj][1]; }
                if (ai * 4 + m < 7) { const int i2 = ai * 4 + m + 1; LOADX(nx, row0 + (i2 >> 2) * HALF + (i2 & 3) * 16); }
#pragma unroll
                for (int bj = 0; bj < 2; ++bj) {
                    const size_t off = (size_t)row * DM + cb + bj * 32;
                    const f32x4 n0 = ox[bj][0] + acc[ai][bj][m][0], n1 = ox[bj][1] + acc[ai][bj][m][1];
                    if (LAST) { *(f32x4*)(xout + off) = n0; *(f32x4*)(xout + off + 4) = n1; }
                    else {
                        u32x4 w; w.x = cvt_pk_bf16(n0[0], n0[1]); w.y = cvt_pk_bf16(n0[2], n0[3]); w.z = cvt_pk_bf16(n1[0], n1[1]); w.w = cvt_pk_bf16(n1[2], n1[3]);
                        wst[bj] = w;
                        const f32x4 r0 = (f32x4){bf_lo(w.x), bf_hi(w.x), bf_lo(w.y), bf_hi(w.y)}, r1 = (f32x4){bf_lo(w.z), bf_hi(w.z), bf_lo(w.w), bf_hi(w.w)};
                        part += (r0[0] * r0[0] + r0[1] * r0[1]) + (r0[2] * r0[2] + r0[3] * r0[3]) + (r1[0] * r1[0] + r1[1] * r1[1]) + (r1[2] * r1[2] + r1[3] * r1[3]);
                    }
                }
                if (!LAST) { part += __shfl_xor(part, 16); part += __shfl_xor(part, 32);
                    if (fq == 0) ssq[(size_t)row * 16 + u.pn * 4 + wc] = part;
                    store_rows128(stg, xb + (size_t)(row - fr) * DM + u.pn * BM + wc * 64, (size_t)DM, wst[0], wst[1], fr, fq, lane); }
            }
#undef LOADX
    }
};
struct EpiDry {
    static constexpr bool PERM = true;
    static constexpr bool OWN_ALIGN_BAR = false;
    __device__ __forceinline__ void operator()(const f32x4 (&acc)[2][2][4][2], const Unit&, int, int, int, int, PG8_LAS unsigned char*, int) const {
#pragma unroll
        for (int a = 0; a < 2; ++a)
#pragma unroll
            for (int b = 0; b < 2; ++b)
#pragma unroll
                for (int m = 0; m < 4; ++m) asm volatile("" :: "v"(acc[a][b][m][0]), "v"(acc[a][b][m][1]));
    }
};
}
namespace att {
typedef unsigned short u16;
using bf16x8 = __attribute__((ext_vector_type(8))) short;
using s16x4  = __attribute__((ext_vector_type(4))) short;
using f32x16 = __attribute__((ext_vector_type(16))) float;
using f32x4  = __attribute__((ext_vector_type(4))) float;
using u32x4  = __attribute__((ext_vector_type(4))) unsigned;
#define KSWZ(row, colB) ((row) * 256 + ((colB) ^ (((row) & 15) << 4)))
#define KSWZ16(row, colB) ((row) * 256 + ((colB) ^ (((row) & 15) << 4)))
#define KSWZ128(row, colB) ((row) * 128 + ((colB) ^ ((((row) >> 1) & 7) << 4)))
#define SBAR() __builtin_amdgcn_sched_barrier(0)
constexpr float THRL = 8.0f;
__device__ __forceinline__ int crow(int r, int hi) { return (r & 3) + 8 * (r >> 2) + 4 * hi; }
__device__ __forceinline__ unsigned cvtpk(float lo, float hi) { unsigned r; asm volatile("v_cvt_pk_bf16_f32 %0, %1, %2" : "=v"(r) : "v"(lo), "v"(hi)); return r; }
typedef __bf16 bf16x2_t __attribute__((ext_vector_type(2))); typedef float f32x2_t __attribute__((ext_vector_type(2)));
__device__ __forceinline__ unsigned cvtpk_b(float lo, float hi) { const f32x2_t v = {lo, hi}; return __builtin_bit_cast(unsigned, __builtin_convertvector(v, bf16x2_t)); }
__device__ __forceinline__ bf16x8 ld8(const u16* p) { return *reinterpret_cast<const bf16x8*>(p); }
__device__ __forceinline__ float bf2f(unsigned short h) { return __uint_as_float((unsigned)h << 16); }

__device__ __forceinline__ void partialSM(f32x16& p0, f32x16& p1, float& m_reg, float& alpha) {
    float pmax = p0[0];
#pragma unroll
    for (int r = 1; r < 16; ++r) pmax = fmaxf(pmax, p0[r]);
#pragma unroll
    for (int r = 0; r < 16; ++r) pmax = fmaxf(pmax, p1[r]);
    { auto rr = __builtin_amdgcn_permlane32_swap(__float_as_uint(pmax), __float_as_uint(pmax), false, false);
      pmax = fmaxf(__uint_as_float(rr[0]), __uint_as_float(rr[1])); }
    float mn;
    if (__builtin_expect(__all(pmax - m_reg <= THRL), 1)) { mn = m_reg; alpha = 1.f; }
    else { mn = fmaxf(m_reg, pmax); alpha = __builtin_amdgcn_exp2f(m_reg - mn); m_reg = mn; }
#pragma unroll
    for (int r = 0; r < 16; ++r) { p0[r] -= mn; p1[r] -= mn; }
#pragma unroll
    for (int r = 0; r < 16; ++r) p0[r] = __builtin_amdgcn_exp2f(p0[r]);
}
__device__ __forceinline__ void finishSM(f32x16& p0, f32x16& p1, float alpha, float& l_reg, bf16x8& pa0, bf16x8& pa1, bf16x8& pa2, bf16x8& pa3) {
#pragma unroll
    for (int r = 0; r < 16; ++r) p1[r] = __builtin_amdgcn_exp2f(p1[r]);
    float ps = 0;
#pragma unroll
    for (int r = 0; r < 16; ++r) ps += p0[r];
#pragma unroll
    for (int r = 0; r < 16; ++r) ps += p1[r];
    { auto rr = __builtin_amdgcn_permlane32_swap(__float_as_uint(ps), __float_as_uint(ps), false, false);
      ps = __uint_as_float(rr[0]) + __uint_as_float(rr[1]); }
    l_reg = l_reg * alpha + ps;
#define PK4(P, BASE, OUT) do { unsigned a0 = cvtpk(P[BASE + 0], P[BASE + 1]), a1 = cvtpk(P[BASE + 2], P[BASE + 3]);   \
    unsigned b0 = cvtpk(P[BASE + 4], P[BASE + 5]), b1 = cvtpk(P[BASE + 6], P[BASE + 7]);                              \
    auto r0 = __builtin_amdgcn_permlane32_swap(a0, b0, false, false); auto r1 = __builtin_amdgcn_permlane32_swap(a1, b1, false, false); \
    u32x4 w = {r0[0], r1[0], r0[1], r1[1]}; OUT = *reinterpret_cast<bf16x8*>(&w); } while (0)
    PK4(p0, 0, pa0); PK4(p0, 8, pa1); PK4(p1, 0, pa2); PK4(p1, 8, pa3);
}
__device__ __forceinline__ void pack4(const f32x16& p0, const f32x16& p1, bf16x8& pa0, bf16x8& pa1, bf16x8& pa2, bf16x8& pa3) {
    PK4(p0, 0, pa0); PK4(p0, 8, pa1); PK4(p1, 0, pa2); PK4(p1, 8, pa3);
}
#undef PK4

template <int NCB> __device__ __forceinline__ int v_st(int k, int c) { const int kk = (k & ~0xC) | ((k & 4) << 1) | ((k & 8) >> 1); return ((kk >> 3) * NCB + (c >> 5)) * 512 + ((kk & 7) * 32 + (c & 31)) * 2; }
__device__ __forceinline__ int v_rd_base(int lane) { return ((lane & 3) << 3) | (((lane >> 2) & 3) << 6) | (((lane >> 4) & 1) << 5) | (((lane >> 5) & 1) << 8); }
template <int OFF> __device__ __forceinline__ s16x4 tr_read(int vb) { s16x4 r; asm volatile("ds_read_b64_tr_b16 %0, %1 offset:%2" : "=&v"(r) : "v"(vb), "i"(OFF) : "memory"); return r; }
#define PKF(L, H) (bf16x8){L[0], L[1], L[2], L[3], H[0], H[1], H[2], H[3]}
template <int NCB> __device__ __forceinline__ void pv_blk(f32x16& od, int vb, bf16x8 pa0, bf16x8 pa1, bf16x8 pa2, bf16x8 pa3) {
    constexpr int KS = NCB * 1024, HF = NCB * 512;
    const s16x4 l0 = tr_read<0 * KS>(vb), h0 = tr_read<0 * KS + HF>(vb), l1 = tr_read<1 * KS>(vb), h1 = tr_read<1 * KS + HF>(vb);
    const s16x4 l2 = tr_read<2 * KS>(vb), h2 = tr_read<2 * KS + HF>(vb), l3 = tr_read<3 * KS>(vb), h3 = tr_read<3 * KS + HF>(vb);
    asm volatile("s_waitcnt lgkmcnt(0)" ::: "memory"); SBAR();
    od = __builtin_amdgcn_mfma_f32_32x32x16_bf16(pa0, PKF(l0, h0), od, 0, 0, 0);
    od = __builtin_amdgcn_mfma_f32_32x32x16_bf16(pa1, PKF(l1, h1), od, 0, 0, 0);
    od = __builtin_amdgcn_mfma_f32_32x32x16_bf16(pa2, PKF(l2, h2), od, 0, 0, 0);
    od = __builtin_amdgcn_mfma_f32_32x32x16_bf16(pa3, PKF(l3, h3), od, 0, 0, 0);
}


template <int NCB> __device__ __forceinline__ int v_stn(int k, int c) { return ((k >> 3) * NCB + (c >> 5)) * 512 + ((k & 7) * 32 + (c & 31)) * 2; }
__device__ __forceinline__ float max3f(float a, float b, float c) { return fmaxf(fmaxf(a, b), c); }
__device__ __forceinline__ void fill16(f32x16& v, float x) {
#pragma unroll
    for (int r = 0; r < 16; ++r) v[r] = x;
}
template <bool FIRST>
__device__ __forceinline__ void partialSM_n(f32x16& p0, f32x16& p1, float& m_reg, f32x16& negm, float& alpha) {
    float a = max3f(p0[0], p0[1], p0[2]), b = max3f(p0[3], p0[4], p0[5]), c = max3f(p1[0], p1[1], p1[2]), d = max3f(p1[3], p1[4], p1[5]);
    a = max3f(a, p0[6], p0[7]); b = max3f(b, p0[8], p0[9]); c = max3f(c, p1[6], p1[7]); d = max3f(d, p1[8], p1[9]);
    a = max3f(a, p0[10], p0[11]); b = max3f(b, p0[12], p0[13]); c = max3f(c, p1[10], p1[11]); d = max3f(d, p1[12], p1[13]);
    a = max3f(a, p0[14], p0[15]); c = max3f(c, p1[14], p1[15]);
    float pmax = fmaxf(fmaxf(a, b), fmaxf(c, d));
    { auto rr = __builtin_amdgcn_permlane32_swap(__float_as_uint(pmax), __float_as_uint(pmax), false, false);
      pmax = fmaxf(__uint_as_float(rr[0]), __uint_as_float(rr[1])); }
    if (!FIRST && __builtin_expect(__all(pmax <= THRL), 1)) { alpha = 1.f; }
    else { const float dl = FIRST ? pmax : fmaxf(pmax, 0.f); m_reg += dl; alpha = FIRST ? 0.f : __builtin_amdgcn_exp2f(-dl);
#pragma unroll
        for (int r = 0; r < 16; ++r) { p0[r] -= dl; p1[r] -= dl; }
        fill16(negm, -m_reg); asm volatile("" : "+v"(negm)); }
#pragma unroll
    for (int r = 0; r < 16; ++r) p0[r] = __builtin_amdgcn_exp2f(p0[r]);
}
#define PKN(P, B) (u32x4){cvtpk(P[B + 0], P[B + 1]), cvtpk(P[B + 2], P[B + 3]), cvtpk(P[B + 4], P[B + 5]), cvtpk(P[B + 6], P[B + 7])}
template <bool SUM>
__device__ __forceinline__ void finishSM_n(f32x16& p0, f32x16& p1, float alpha, float& l_reg, bf16x8& pa0, bf16x8& pa1, bf16x8& pa2, bf16x8& pa3) {
#pragma unroll
    for (int r = 0; r < 16; ++r) p1[r] = __builtin_amdgcn_exp2f(p1[r]);
    if (SUM) {
        float s0 = (p0[0] + p0[1]) + (p0[2] + p0[3]), s1 = (p0[4] + p0[5]) + (p0[6] + p0[7]), s2 = (p0[8] + p0[9]) + (p0[10] + p0[11]), s3 = (p0[12] + p0[13]) + (p0[14] + p0[15]);
        float t0 = (p1[0] + p1[1]) + (p1[2] + p1[3]), t1 = (p1[4] + p1[5]) + (p1[6] + p1[7]), t2 = (p1[8] + p1[9]) + (p1[10] + p1[11]), t3 = (p1[12] + p1[13]) + (p1[14] + p1[15]);
        float ps = ((s0 + s1) + (s2 + s3)) + ((t0 + t1) + (t2 + t3));
        { auto rr = __builtin_amdgcn_permlane32_swap(__float_as_uint(ps), __float_as_uint(ps), false, false);
          ps = __uint_as_float(rr[0]) + __uint_as_float(rr[1]); }
        l_reg = l_reg * alpha + ps;
    }
    { u32x4 w = PKN(p0, 0); pa0 = *reinterpret_cast<bf16x8*>(&w); } { u32x4 w = PKN(p0, 8); pa1 = *reinterpret_cast<bf16x8*>(&w); }
    { u32x4 w = PKN(p1, 0); pa2 = *reinterpret_cast<bf16x8*>(&w); } { u32x4 w = PKN(p1, 8); pa3 = *reinterpret_cast<bf16x8*>(&w); }
}

__device__ __forceinline__ void qkt_da(f32x16& p0, f32x16& p1, const char* Ks, const bf16x8* qr, const f32x16& negm, int r32, int hi, int cb0) {
#pragma unroll
    for (int d0 = 0; d0 < 4; ++d0) { const int cb = cb0 + (d0 * 16 + hi * 8) * 2;
        const bf16x8 b0 = *reinterpret_cast<const bf16x8*>(Ks + KSWZ(r32, cb));
        const bf16x8 b1 = *reinterpret_cast<const bf16x8*>(Ks + KSWZ(32 + r32, cb));
        if (d0 == 0) { p0 = __builtin_amdgcn_mfma_f32_32x32x16_bf16(b0, qr[0], negm, 0, 0, 0); p1 = __builtin_amdgcn_mfma_f32_32x32x16_bf16(b1, qr[0], negm, 0, 0, 0); }
        else { p0 = __builtin_amdgcn_mfma_f32_32x32x16_bf16(b0, qr[d0], p0, 0, 0, 0); p1 = __builtin_amdgcn_mfma_f32_32x32x16_bf16(b1, qr[d0], p1, 0, 0, 0); } }
}
typedef short v4i16_t __attribute__((ext_vector_type(4)));
__device__ __forceinline__ s16x4 vtr(int addr) { return __builtin_bit_cast(s16x4, __builtin_amdgcn_ds_read_tr16_b64_v4i16((__attribute__((address_space(3))) v4i16_t*)(unsigned)addr)); }
__device__ __forceinline__ void pv_da(f32x16* o, int vb, bf16x8 pa0, bf16x8 pa1, bf16x8 pa2, bf16x8 pa3) {
    s16x4 lo[4], hi[4];
#define VADDR(i) (vb + ((i) & 3) * 512 + ((i) >> 2) * 4096)
#pragma unroll
    for (int i = 0; i < 4; ++i) { lo[i] = vtr(VADDR(i)); hi[i] = vtr(VADDR(i) + 2048); }
#pragma unroll
    for (int i = 0; i < 16; ++i) {
        const bf16x8 vf = PKF(lo[i & 3], hi[i & 3]);
        const bf16x8 pa = ((i >> 2) == 0) ? pa0 : ((i >> 2) == 1) ? pa1 : ((i >> 2) == 2) ? pa2 : pa3;
        o[i & 3] = __builtin_amdgcn_mfma_f32_32x32x16_bf16(pa, vf, o[i & 3], 0, 0, 0);
        if (i + 4 < 16) { lo[i & 3] = vtr(VADDR(i + 4)); hi[i & 3] = vtr(VADDR(i + 4) + 2048); }
    }
#undef VADDR
    __builtin_amdgcn_sched_group_barrier(0x100, 8, 0);
#pragma unroll
    for (int i = 0; i < 12; ++i) { __builtin_amdgcn_sched_group_barrier(0x008, 1, 0); __builtin_amdgcn_sched_group_barrier(0x100, 2, 0); __builtin_amdgcn_sched_group_barrier(0x002, 4, 0); }
#pragma unroll
    for (int i = 0; i < 4; ++i) { __builtin_amdgcn_sched_group_barrier(0x008, 1, 0); __builtin_amdgcn_sched_group_barrier(0x002, 4, 0); }
}
#define DA_PIN(x) asm volatile("" : "+v"(x))
#define DA_MFMA(a, b, c) __builtin_amdgcn_mfma_f32_32x32x16_bf16(a, b, c, 0, 0, 0)
#define DA_WAIT_BAR(N) asm volatile("s_waitcnt vmcnt(" #N ") lgkmcnt(0)\n\ts_barrier" ::: "memory")
__device__ __forceinline__ void glds16(const void* g, unsigned lds_base) {
    unsigned sv; asm volatile("s_mov_b32 %0, m0\n\ts_mov_b32 m0, %2\n\ts_nop 0\n\tglobal_load_lds_dwordx4 %1, off\n\ts_mov_b32 m0, %0" : "=&s"(sv) : "v"(g), "s"(lds_base) : "memory"); }
__device__ __forceinline__ void glds16s(const void* sbase, unsigned voff, unsigned lds_base) {
    unsigned sv; asm volatile("s_mov_b32 %0, m0\n\ts_mov_b32 m0, %3\n\ts_nop 0\n\tglobal_load_lds_dwordx4 %1, %2\n\ts_mov_b32 m0, %0" : "=&s"(sv) : "v"(voff), "s"(sbase), "s"(lds_base) : "memory"); }
__device__ __forceinline__ bf16x8 kld(int addr) { return *(const __attribute__((address_space(3))) bf16x8*)(unsigned)addr; }
__device__ __forceinline__ float rowmax32(const f32x16& p0, const f32x16& p1) {
    float a = max3f(p0[0], p0[1], p0[2]), b = max3f(p0[3], p0[4], p0[5]), c = max3f(p1[0], p1[1], p1[2]), d = max3f(p1[3], p1[4], p1[5]);
    a = max3f(a, p0[6], p0[7]); b = max3f(b, p0[8], p0[9]); c = max3f(c, p1[6], p1[7]); d = max3f(d, p1[8], p1[9]);
    a = max3f(a, p0[10], p0[11]); b = max3f(b, p0[12], p0[13]); c = max3f(c, p1[10], p1[11]); d = max3f(d, p1[12], p1[13]);
    a = max3f(a, p0[14], p0[15]); c = max3f(c, p1[14], p1[15]);
    const float pmax = fmaxf(fmaxf(a, b), fmaxf(c, d));
    auto rr = __builtin_amdgcn_permlane32_swap(__float_as_uint(pmax), __float_as_uint(pmax), false, false);
    return fmaxf(__uint_as_float(rr[0]), __uint_as_float(rr[1]));
}
constexpr int DA_KSL = 16384, DA_VRING = 49152, DA_WS = 133120, DA_STG = 65536, DA_STG_LD = 132;
template <bool DRY, int PVAR = 0>
__device__ __forceinline__ void diff_attn_unit(int b, int h, int qb, const u16* Qa, const u16* __restrict__ Ka, const u16* __restrict__ Va, const u16* __restrict__ Ga,
                                               u16* Y, const float* __restrict__ subw, float lam, float one_m_li, const unsigned* __restrict__ kmx, char* lds) {
    int tid = threadIdx.x; asm volatile("" : "+v"(tid)); const int lane = tid & 63, r32 = lane & 31, hi = lane >> 5; const int wid = __builtin_amdgcn_readfirstlane(tid >> 6);
    const int map = wid >> 2, wq = wid & 3;
    const long rowbase = (long)b * SEQ; const int q0 = qb * 128;
    float* wsf = (float*)(lds + DA_WS) + wid * 64; float* li_l = wsf; float* al_l = wsf + 32;
    float m_reg = 0.f, l_reg = 0; f32x16 o[4] = {}; bf16x8 qr[4]; f32x16 negm = f32x16{}; asm volatile("" : "+v"(negm));
    const unsigned lds0 = (unsigned)(uintptr_t)lds;
    const u16* Kh = Ka + rowbase * DM + h * 128; const u16* Vh = Va + rowbase * DM + h * 128;
    const int cb0 = map * 128;
    unsigned kofs[2], vofs[2];
#pragma unroll
    for (int i = 0; i < 2; ++i) { const int pk = 2 * wid + i;
        const int row = 4 * pk + (lane >> 4), cp = lane & 15; kofs[i] = (unsigned)(row * DM + ((cp ^ (row & 15)) * 8)) * 2u;
        const int st = 2 * pk + (lane >> 5), kk = 8 * (st >> 2) + ((lane & 31) >> 2), cc = 32 * (st & 3) + 8 * (lane & 3); vofs[i] = (unsigned)(kk * DM + cc) * 2u; }
    const char* Kg = (const char*)Kh; const char* Vg = (const char*)Vh;
#define DMA_K(t, slot) do { _Pragma("unroll") for (int i_ = 0; i_ < 2; ++i_) glds16s(Kg + (size_t)(t) * (64 * DM * 2), kofs[i_], (unsigned)__builtin_amdgcn_readfirstlane(lds0 + (slot) + (2 * wid + i_) * 1024)); } while (0)
#define DMA_V(t, slot) do { _Pragma("unroll") for (int i_ = 0; i_ < 2; ++i_) glds16s(Vg + (size_t)(t) * (64 * DM * 2), vofs[i_], (unsigned)__builtin_amdgcn_readfirstlane(lds0 + DA_VRING + (slot) + (2 * wid + i_) * 1024)); } while (0)
    DMA_K(0, 0);
    const u16* Qw = Qa + (rowbase + q0 + wq * 32 + r32) * DM + h * 128 + map * 64 + hi * 8;
#pragma unroll
    for (int d0 = 0; d0 < 4; ++d0) qr[d0] = ld8(Qw + d0 * 16);
    DMA_V(0, 0); DMA_K(1, DA_KSL); DMA_K(2, 2 * DA_KSL);
    int ka[4];
#pragma unroll
    for (int d0 = 0; d0 < 4; ++d0) ka[d0] = (int)lds0 + KSWZ16(r32, cb0 + (d0 * 16 + hi * 8) * 2);
    const int vb0 = (int)lds0 + DA_VRING + v_rd_base(lane);
    constexpr int NT = SEQ / 64;
    f32x16 pA0, pA1, pB0, pB1; bf16x8 kf[8]; s16x4 vlo[4], vhi[4]; u32x4 pw0, pw1, pw2, pw3; bool resc = false;
    int sl_prev = 0, sl_cur = 0, sl_next = DA_KSL;
#define ROT() do { sl_prev = sl_cur; sl_cur = sl_next; sl_next = (sl_next == 2 * DA_KSL) ? 0 : sl_next + DA_KSL; } while (0)
#define RESC() do { if (resc) { _Pragma("unroll") for (int d_ = 0; d_ < 4; ++d_) _Pragma("unroll") for (int r = 0; r < 16; ++r) o[d_][r] *= al_l[crow(r, hi)]; } } while (0)
#define KLOAD(slot) do { _Pragma("unroll") for (int d0 = 0; d0 < 4; ++d0) { kf[2 * d0] = kld(ka[d0] + (slot)); kf[2 * d0 + 1] = kld(ka[d0] + (slot) + 8192); } } while (0)
    float mb;
    { float q2 = 0.f;
#pragma unroll
      for (int d0 = 0; d0 < 4; ++d0)
#pragma unroll
          for (int e = 0; e < 8; ++e) { const float qv = bf2f((u16)qr[d0][e]); q2 += qv * qv; }
      { auto rr = __builtin_amdgcn_permlane32_swap(__float_as_uint(q2), __float_as_uint(q2), false, false); q2 = __uint_as_float(rr[0]) + __uint_as_float(rr[1]); }
      mb = __builtin_sqrtf(q2 * __uint_as_float(kmx[b * 16 + h * 2 + map])) * 1.0001f; }
    const bool fast = !__any(!(mb <= 60.0f));
    if (fast) { m_reg = mb; fill16(negm, -mb); asm volatile("" : "+v"(negm)); }
    DA_WAIT_BAR(6);
    KLOAD(0);
    pA0 = DA_MFMA(kf[0], qr[0], negm); pA1 = DA_MFMA(kf[1], qr[0], negm); pA0 = DA_MFMA(kf[2], qr[1], pA0); pA1 = DA_MFMA(kf[3], qr[1], pA1);
    pA0 = DA_MFMA(kf[4], qr[2], pA0); pA1 = DA_MFMA(kf[5], qr[2], pA1); pA0 = DA_MFMA(kf[6], qr[3], pA0); pA1 = DA_MFMA(kf[7], qr[3], pA1);
    if (fast) {
#pragma unroll
      for (int r = 0; r < 16; ++r) { pA0[r] = __builtin_amdgcn_exp2f(pA0[r]); pA1[r] = __builtin_amdgcn_exp2f(pA1[r]); }
    } else { const float rm = rowmax32(pA0, pA1); m_reg = rm;
#pragma unroll
      for (int r = 0; r < 16; ++r) { pA0[r] = __builtin_amdgcn_exp2f(pA0[r] - rm); pA1[r] = __builtin_amdgcn_exp2f(pA1[r] - rm); }
      fill16(negm, -m_reg); asm volatile("" : "+v"(negm)); }
    DA_WAIT_BAR(0);
    DMA_K(3, 0); DMA_V(1, DA_KSL); ROT();
    KLOAD(sl_cur);
    DA_WAIT_BAR(4);
#define PKW(P, i) cvtpk_b(P[i], P[(i) + 1])
#define PAF(w) __builtin_bit_cast(bf16x8, w)
#define VOFF(i) ((((i) & 3) * 512) + (((i) >> 2) * 4096))
#define VRD(s, i) do { vlo[s] = vtr(vp_ + VOFF(i)); vhi[s] = vtr(vp_ + VOFF(i) + 2048); } while (0)
#define VFR(s) PKF(vlo[s], vhi[s])
#define KRD(G, d0) do { if (G) { kf[2 * (d0)] = kld(ka[d0] + sl_next); kf[2 * (d0) + 1] = kld(ka[d0] + sl_next + 8192); SBAR(); } } while (0)
#define GAPA(CT, MF, a0, a1, a2, a3, W0, W1, PW) do { MF; DA_PIN(CT); sacc += a0; sacc += a1; sacc += a2; sacc += a3; W0; W1; DA_PIN(PW); DA_PIN(sacc); SBAR(); } while (0)
#define GAPB(MF, X, i, VR) do { MF; VR; X[i] = __builtin_amdgcn_exp2f(X[i]); X[(i) + 1] = __builtin_amdgcn_exp2f(X[(i) + 1]); DA_PIN(X); SBAR(); } while (0)
#define STEP(C0, C1, P0, P1, t, GK, GV, GL) do { SBAR(); \
    const int vp_ = vb0 + sl_prev; \
    float sacc = P0[0] + P0[1]; \
    GAPA(C0, C0 = DA_MFMA(kf[0], qr[0], negm), P0[2], P0[3], P0[4], P0[5],     pw0[0] = PKW(P0, 0),  pw0[1] = PKW(P0, 2),  pw0); \
    GAPA(C1, C1 = DA_MFMA(kf[1], qr[0], negm), P0[6], P0[7], P0[8], P0[9],     pw0[2] = PKW(P0, 4),  pw0[3] = PKW(P0, 6),  pw0); \
    GAPA(C0, C0 = DA_MFMA(kf[2], qr[1], C0),   P0[10], P0[11], P0[12], P0[13], pw1[0] = PKW(P0, 8),  pw1[1] = PKW(P0, 10), pw1); \
    GAPA(C1, C1 = DA_MFMA(kf[3], qr[1], C1),   P0[14], P0[15], P1[0], P1[1],   pw1[2] = PKW(P0, 12), pw1[3] = PKW(P0, 14), pw1); \
    VRD(0, 0); SBAR(); GAPA(C0, C0 = DA_MFMA(kf[4], qr[2], C0), P1[2], P1[3], P1[4], P1[5],     pw2[0] = PKW(P1, 0),  pw2[1] = PKW(P1, 2),  pw2); \
    VRD(1, 1); SBAR(); GAPA(C1, C1 = DA_MFMA(kf[5], qr[2], C1), P1[6], P1[7], P1[8], P1[9],     pw2[2] = PKW(P1, 4),  pw2[3] = PKW(P1, 6),  pw2); \
    VRD(2, 2); SBAR(); GAPA(C0, C0 = DA_MFMA(kf[6], qr[3], C0), P1[10], P1[11], P1[12], P1[13], pw3[0] = PKW(P1, 8),  pw3[1] = PKW(P1, 10), pw3); \
    VRD(3, 3); SBAR(); GAPA(C1, C1 = DA_MFMA(kf[7], qr[3], C1), P1[14], P1[15], 0.f, 0.f,       pw3[2] = PKW(P1, 12), pw3[3] = PKW(P1, 14), pw3); \
    l_reg += sacc; \
    if (GK) DMA_K((t) + 3, sl_cur); if (GV) DMA_V((t) + 1, sl_next);                            \
    resc = false; \
    if (__builtin_expect(!fast, 0)) { const float rm = rowmax32(C0, C1);                        \
      if (__builtin_expect(__any(rm > THRL), 0)) { const float dl = fmaxf(rm, 0.f); m_reg += dl;    \
          const float f_ = __builtin_amdgcn_exp2f(-dl); l_reg *= f_; if (hi == 0) al_l[r32] = f_; resc = true; \
          _Pragma("unroll") for (int r = 0; r < 16; ++r) { C0[r] -= dl; C1[r] -= dl; } \
          fill16(negm, -m_reg); asm volatile("" : "+v"(negm)); } } \
    SBAR(); \
    GAPB(o[0] = DA_MFMA(PAF(pw0), VFR(0), o[0]), C0, 0, VRD(0, 4));  GAPB(o[1] = DA_MFMA(PAF(pw0), VFR(1), o[1]), C0, 2, VRD(1, 5)); \
    KRD(GL, 0); GAPB(o[2] = DA_MFMA(PAF(pw0), VFR(2), o[2]), C0, 4, VRD(2, 6));  KRD(GL, 1); GAPB(o[3] = DA_MFMA(PAF(pw0), VFR(3), o[3]), C0, 6, VRD(3, 7)); \
    KRD(GL, 2); GAPB(o[0] = DA_MFMA(PAF(pw1), VFR(0), o[0]), C0, 8, VRD(0, 8));  KRD(GL, 3); GAPB(o[1] = DA_MFMA(PAF(pw1), VFR(1), o[1]), C0, 10, VRD(1, 9)); \
    GAPB(o[2] = DA_MFMA(PAF(pw1), VFR(2), o[2]), C0, 12, VRD(2, 10)); GAPB(o[3] = DA_MFMA(PAF(pw1), VFR(3), o[3]), C0, 14, VRD(3, 11)); \
    GAPB(o[0] = DA_MFMA(PAF(pw2), VFR(0), o[0]), C1, 0, VRD(0, 12));  GAPB(o[1] = DA_MFMA(PAF(pw2), VFR(1), o[1]), C1, 2, VRD(1, 13)); \
    GAPB(o[2] = DA_MFMA(PAF(pw2), VFR(2), o[2]), C1, 4, VRD(2, 14));  GAPB(o[3] = DA_MFMA(PAF(pw2), VFR(3), o[3]), C1, 6, VRD(3, 15)); \
    GAPB(o[0] = DA_MFMA(PAF(pw3), VFR(0), o[0]), C1, 8, (void)0);     GAPB(o[1] = DA_MFMA(PAF(pw3), VFR(1), o[1]), C1, 10, (void)0); \
    GAPB(o[2] = DA_MFMA(PAF(pw3), VFR(2), o[2]), C1, 12, (void)0);    GAPB(o[3] = DA_MFMA(PAF(pw3), VFR(3), o[3]), C1, 14, (void)0); \
    } while (0)
    int t = 1;
    for (; t + 5 < NT; t += 2) {
        STEP(pB0, pB1, pA0, pA1, t, true, true, true);     DA_WAIT_BAR(4); RESC(); ROT();
        STEP(pA0, pA1, pB0, pB1, t + 1, true, true, true); DA_WAIT_BAR(4); RESC(); ROT();
    }
#define ENDW(tt) do { if ((tt) + 3 < NT) { DA_WAIT_BAR(4); } else if ((tt) + 2 < NT) { DA_WAIT_BAR(2); } else { DA_WAIT_BAR(0); } } while (0)
    for (; t + 1 < NT; t += 2) {
        STEP(pB0, pB1, pA0, pA1, t, (t + 3 < NT), (t + 1 < NT), (t + 1 < NT));         ENDW(t);     RESC(); ROT();
        STEP(pA0, pA1, pB0, pB1, t + 1, (t + 4 < NT), (t + 2 < NT), (t + 2 < NT));     ENDW(t + 1); RESC(); ROT();
    }
    STEP(pB0, pB1, pA0, pA1, NT - 1, false, false, false); RESC();
    { float sacc = pB0[0] + pB0[1];
#pragma unroll
      for (int r = 2; r < 16; ++r) sacc += pB0[r];
#pragma unroll
      for (int r = 0; r < 16; ++r) sacc += pB1[r];
      l_reg += sacc;
      pw0 = (u32x4){PKW(pB0, 0), PKW(pB0, 2), PKW(pB0, 4), PKW(pB0, 6)}; pw1 = (u32x4){PKW(pB0, 8), PKW(pB0, 10), PKW(pB0, 12), PKW(pB0, 14)};
      pw2 = (u32x4){PKW(pB1, 0), PKW(pB1, 2), PKW(pB1, 4), PKW(pB1, 6)}; pw3 = (u32x4){PKW(pB1, 8), PKW(pB1, 10), PKW(pB1, 12), PKW(pB1, 14)};
      pv_da(o, vb0 + sl_cur, PAF(pw0), PAF(pw1), PAF(pw2), PAF(pw3)); }
    { auto rr = __builtin_amdgcn_permlane32_swap(__float_as_uint(l_reg), __float_as_uint(l_reg), false, false); l_reg = __uint_as_float(rr[0]) + __uint_as_float(rr[1]); }
#undef DMA_K
#undef DMA_V
#undef ROT
#undef RESC
#undef KLOAD
#undef PKW
#undef PAF
#undef VOFF
#undef VRD
#undef VFR
#undef KRD
#undef GAPA
#undef GAPB
#undef STEP
#undef ENDW
    const int crow_ = tid >> 2, cqt_ = tid & 3; const size_t goff = (size_t)(rowbase + q0 + crow_) * DM + h * 128 + cqt_ * 32;
    bf16x8 gte[4];
#pragma unroll
    for (int g = 0; g < 4; ++g) gte[g] = ld8(Ga + goff + g * 8);
    if (hi == 0) li_l[r32] = l_reg; asm volatile("s_waitcnt lgkmcnt(0)" ::: "memory");
    float rli[16];
#pragma unroll
    for (int r = 0; r < 16; ++r) rli[r] = __builtin_amdgcn_rcpf(li_l[crow(r, hi)]) * (map ? lam : 1.0f);
    __syncthreads();
    float* xch = (float*)lds;
    if (map == 1) {
#pragma unroll
        for (int d0 = 0; d0 < 4; ++d0)
#pragma unroll
            for (int r = 0; r < 16; ++r) xch[((wq * 4 + d0) * 16 + r) * 64 + lane] = o[d0][r] * rli[r];
    }
    __syncthreads();
    float* stg = (float*)(lds + DA_STG);
    if (map == 0) {
#pragma unroll
        for (int d0 = 0; d0 < 4; ++d0)
#pragma unroll
            for (int r = 0; r < 16; ++r) { const float dv = o[d0][r] * rli[r] - xch[((wq * 4 + d0) * 16 + r) * 64 + lane];
                stg[(wq * 32 + crow(r, hi)) * DA_STG_LD + d0 * 32 + r32] = dv; }
    }
    __syncthreads();
    {
        const int row = crow_, qt = cqt_; const float* sp = stg + row * DA_STG_LD + qt * 32;
        f32x4 dv[8]; float ss = 0.f;
#pragma unroll
        for (int g = 0; g < 8; ++g) { dv[g] = *(const f32x4*)(sp + g * 4); ss += (dv[g][0] * dv[g][0] + dv[g][1] * dv[g][1]) + (dv[g][2] * dv[g][2] + dv[g][3] * dv[g][3]); }
        ss += __shfl_xor(ss, 1); ss += __shfl_xor(ss, 2);
        const float sc2 = __builtin_amdgcn_rsqf(ss * (1.0f / 128.0f) + EPS) * one_m_li;
#pragma unroll
        for (int g = 0; g < 4; ++g) {
            const bf16x8 gt = gte[g];
            const f32x4 w0 = *(const f32x4*)(subw + qt * 32 + g * 8), w1 = *(const f32x4*)(subw + qt * 32 + g * 8 + 4);
            const f32x4 a = dv[2 * g], c = dv[2 * g + 1];
            u32x4 w;
            w.x = cvtpk(a[0] * sc2 * w0[0] * bf2f((u16)gt[0]), a[1] * sc2 * w0[1] * bf2f((u16)gt[1]));
            w.y = cvtpk(a[2] * sc2 * w0[2] * bf2f((u16)gt[2]), a[3] * sc2 * w0[3] * bf2f((u16)gt[3]));
            w.z = cvtpk(c[0] * sc2 * w1[0] * bf2f((u16)gt[4]), c[1] * sc2 * w1[1] * bf2f((u16)gt[5]));
            w.w = cvtpk(c[2] * sc2 * w1[2] * bf2f((u16)gt[6]), c[3] * sc2 * w1[3] * bf2f((u16)gt[7]));
            if (!DRY) *(u32x4*)(Y + goff + g * 8) = w; else asm volatile("" :: "v"(w));
        }
    }
    __syncthreads();
}

constexpr int SWB_K = 0, SWB_V = 49152, SWB_WS = 98304, SWB_STG = 100352, SWB_STG_LD = 36;
__device__ __forceinline__ void swa_block_geom(int qb, int& t_lo, int& t_hi) { const int q0 = qb * 128; t_lo = (q0 >= 128 ? q0 - 128 : 0) >> 6; t_hi = (q0 + 255 < SEQ ? q0 + 255 : SEQ - 1) >> 6; }
template <int N> struct SwaRegs { bf16x8 k[N], v[N]; };
template <int N> __device__ __forceinline__ void swa_tiles_load(SwaRegs<N>& R, int b, int kvh, int t0, int nt, const u16* __restrict__ Kb, const u16* __restrict__ Vb, int tid) {
    const int sr = tid >> 3, sc = (tid & 7) * 8; const long rowbase = (long)b * SEQ;
    const u16* Kh = Kb + (rowbase + t0 * 64 + sr) * 256 + kvh * 64 + sc; const u16* Vh = Vb + (rowbase + t0 * 64 + sr) * 256 + kvh * 64 + sc;
#pragma unroll
    for (int tt = 0; tt < N; ++tt) if (tt < nt) { R.k[tt] = ld8(Kh + (long)tt * 64 * 256); R.v[tt] = ld8(Vh + (long)tt * 64 * 256); }
}
template <int N> __device__ __forceinline__ void swa_tiles_store_lds(const SwaRegs<N>& R, int t0, int nt, char* lds, int tid) {
    const int sr = tid >> 3, sc = (tid & 7) * 8, vst0 = v_stn<2>(sr, sc), kst0 = KSWZ128(sr, sc * 2);
#pragma unroll
    for (int tt = 0; tt < N; ++tt) if (tt < nt) { const int sl = (t0 + tt) % 6; *(bf16x8*)(lds + SWB_K + sl * 8192 + kst0) = R.k[tt]; *(bf16x8*)(lds + SWB_V + sl * 8192 + vst0) = R.v[tt]; }
}
template <bool DRY>
__device__ __forceinline__ void swa_block_compute(int b, int kvh, int qb, const u16* Q, const u16* __restrict__ Gt, u16* Y, const float* __restrict__ sink, char* lds, int tid) {
    const int lane = tid & 63, r32 = lane & 31, hi = lane >> 5; const int wid = __builtin_amdgcn_readfirstlane(tid >> 6);
    const int hq = kvh * 8 + wid; const long rowbase = (long)b * SEQ; const int q0 = qb * 128;
    int t_lo, t_hib; swa_block_geom(qb, t_lo, t_hib); (void)t_hib;
    float* wsf = (float*)(lds + SWB_WS) + wid * 64; float* al_l = wsf + 32;
    float* stg = (float*)(lds + SWB_STG) + wid * (32 * SWB_STG_LD);
    const int vb0 = (int)(uintptr_t)(lds + SWB_V) + v_rd_base(lane);
    const float sink2 = sink[hq] * LOG2E;
    bf16x8 qn[4];
    { const u16* Qw = Q + (rowbase + q0 + r32) * DIN + hq * 64 + hi * 8;
#pragma unroll
      for (int d0 = 0; d0 < 4; ++d0) qn[d0] = ld8(Qw + d0 * 16); }
#pragma unroll 1
    for (int sub = 0; sub < 4; ++sub) {
        const int qs = q0 + 32 * sub;
        bf16x8 qr[4];
#pragma unroll
        for (int d0 = 0; d0 < 4; ++d0) qr[d0] = qn[d0];
        if (sub < 3) { const u16* Qw = Q + (rowbase + qs + 32 + r32) * DIN + hq * 64 + hi * 8;
#pragma unroll
            for (int d0 = 0; d0 < 4; ++d0) qn[d0] = ld8(Qw + d0 * 16); }
        const int ta = ((qs >= 128 ? qs - 128 : 0) >> 6) - t_lo, tb = ((qs + 159 < SEQ ? qs + 159 : SEQ - 1) >> 6) - t_lo;
        float m_reg = sink2, l_dummy = 0.f; f32x16 o[2] = {}; f32x16 lacc, negm; fill16(lacc, 1.0f); fill16(negm, -sink2);
        const bf16x8 ones = {0x3F80, 0x3F80, 0x3F80, 0x3F80, 0x3F80, 0x3F80, 0x3F80, 0x3F80};
        bf16x8 gpre[2][2];
        { const size_t gb = (size_t)(rowbase + qs + (lane >> 1)) * DIN + hq * 64 + (lane & 1) * 16;
#pragma unroll
          for (int cbk = 0; cbk < 2; ++cbk) { gpre[cbk][0] = ld8(Gt + gb + cbk * 32); gpre[cbk][1] = ld8(Gt + gb + cbk * 32 + 8); } }
        for (int tt = ta; tt <= tb; ++tt) {
            const int k0 = (t_lo + tt) * 64, sl = (t_lo + tt) % 6;
            f32x16 p0, p1;
            const char* Ks = lds + SWB_K + sl * 8192;
#pragma unroll
            for (int d0 = 0; d0 < 4; ++d0) { const int cb = (d0 * 16 + hi * 8) * 2;
                const bf16x8 b0 = *reinterpret_cast<const bf16x8*>(Ks + KSWZ128(r32, cb));
                const bf16x8 b1 = *reinterpret_cast<const bf16x8*>(Ks + KSWZ128(32 + r32, cb));
                if (d0 == 0) { p0 = __builtin_amdgcn_mfma_f32_32x32x16_bf16(b0, qr[0], negm, 0, 0, 0); p1 = __builtin_amdgcn_mfma_f32_32x32x16_bf16(b1, qr[0], negm, 0, 0, 0); }
                else { p0 = __builtin_amdgcn_mfma_f32_32x32x16_bf16(b0, qr[d0], p0, 0, 0, 0); p1 = __builtin_amdgcn_mfma_f32_32x32x16_bf16(b1, qr[d0], p1, 0, 0, 0); } }
            if (k0 < qs - 97 || k0 + 63 > qs + 128) {
                const int base = k0 - qs - r32 + 4 * hi + 128;
#pragma unroll
                for (int r = 0; r < 16; ++r) { const int c = (r & 3) + 8 * (r >> 2); if ((unsigned)(base + c) > 256u) p0[r] = -1e30f; if ((unsigned)(base + c + 32) > 256u) p1[r] = -1e30f; }
            }
            float alpha; bf16x8 pa0, pa1, pa2, pa3;
            partialSM_n<false>(p0, p1, m_reg, negm, alpha);
            if (__any(alpha < 1.f)) { if (hi == 0) al_l[r32] = alpha; asm volatile("s_waitcnt lgkmcnt(0)" ::: "memory");
#pragma unroll
                for (int r = 0; r < 16; ++r) { const float al = al_l[crow(r, hi)]; o[0][r] *= al; o[1][r] *= al; lacc[r] *= al; } }
            finishSM_n<false>(p0, p1, alpha, l_dummy, pa0, pa1, pa2, pa3);
            {
                const int vbt = vb0 + sl * 8192; s16x4 lo[4], hi4[4];
#define VADDR2(i) (vbt + ((i) & 1) * 512 + ((i) >> 1) * 2048)
#pragma unroll
                for (int i = 0; i < 4; ++i) { lo[i] = vtr(VADDR2(i)); hi4[i] = vtr(VADDR2(i) + 1024); }
#pragma unroll
                for (int i = 0; i < 8; ++i) {
                    const bf16x8 vf = PKF(lo[i & 3], hi4[i & 3]);
                    const bf16x8 pa = ((i >> 1) == 0) ? pa0 : ((i >> 1) == 1) ? pa1 : ((i >> 1) == 2) ? pa2 : pa3;
                    o[i & 1] = __builtin_amdgcn_mfma_f32_32x32x16_bf16(pa, vf, o[i & 1], 0, 0, 0);
                    if ((i & 1) == 1) lacc = __builtin_amdgcn_mfma_f32_32x32x16_bf16(pa, ones, lacc, 0, 0, 0);
                    if (i + 4 < 8) { lo[i & 3] = vtr(VADDR2(i + 4)); hi4[i & 3] = vtr(VADDR2(i + 4) + 1024); }
                }
#undef VADDR2
            }
        }
        float rl[16];
#pragma unroll
        for (int r = 0; r < 16; ++r) rl[r] = __builtin_amdgcn_rcpf(lacc[r]);
#pragma unroll
        for (int cbk = 0; cbk < 2; ++cbk) {
#pragma unroll
            for (int r = 0; r < 16; ++r) stg[crow(r, hi) * SWB_STG_LD + r32] = o[cbk][r] * rl[r];
            asm volatile("s_waitcnt lgkmcnt(0)" ::: "memory");
            const int row = lane >> 1, hf = lane & 1; const float* sp = stg + row * SWB_STG_LD + hf * 16;
            const f32x4 a0 = *(const f32x4*)(sp), a1 = *(const f32x4*)(sp + 4), a2 = *(const f32x4*)(sp + 8), a3 = *(const f32x4*)(sp + 12);
            const size_t goff = (size_t)(rowbase + qs + row) * DIN + hq * 64 + cbk * 32 + hf * 16;
            const bf16x8 g0 = gpre[cbk][0], g1 = gpre[cbk][1];
            u32x4 w0, w1;
            w0.x = cvtpk(a0[0] * bf2f((u16)g0[0]), a0[1] * bf2f((u16)g0[1])); w0.y = cvtpk(a0[2] * bf2f((u16)g0[2]), a0[3] * bf2f((u16)g0[3]));
            w0.z = cvtpk(a1[0] * bf2f((u16)g0[4]), a1[1] * bf2f((u16)g0[5])); w0.w = cvtpk(a1[2] * bf2f((u16)g0[6]), a1[3] * bf2f((u16)g0[7]));
            w1.x = cvtpk(a2[0] * bf2f((u16)g1[0]), a2[1] * bf2f((u16)g1[1])); w1.y = cvtpk(a2[2] * bf2f((u16)g1[2]), a2[3] * bf2f((u16)g1[3]));
            w1.z = cvtpk(a3[0] * bf2f((u16)g1[4]), a3[1] * bf2f((u16)g1[5])); w1.w = cvtpk(a3[2] * bf2f((u16)g1[6]), a3[3] * bf2f((u16)g1[7]));
            if (!DRY) { *(u32x4*)(Y + goff) = w0; *(u32x4*)(Y + goff + 8) = w1; } else asm volatile("" :: "v"(w0), "v"(w1));
            asm volatile("s_waitcnt lgkmcnt(0)" ::: "memory");
        }
    }
}
template <bool DRY>
__device__ __forceinline__ void swa_block_compute_fast(int b, int kvh, int qb, const u16* Q, const u16* __restrict__ Gt, u16* Y, const float* __restrict__ sink, float mref, char* lds, int tid) {
    const int lane = tid & 63, r32 = lane & 31, hi = lane >> 5; const int wid = __builtin_amdgcn_readfirstlane(tid >> 6);
    const int hq = kvh * 8 + wid; const long rowbase = (long)b * SEQ; const int q0 = qb * 128;
    int t_lo, t_hib; swa_block_geom(qb, t_lo, t_hib); (void)t_hib;
    float* wsf = (float*)(lds + SWB_WS) + wid * 64;
    float* stg = (float*)(lds + SWB_STG) + wid * (32 * SWB_STG_LD);
    const int vb0 = (int)(uintptr_t)(lds + SWB_V) + v_rd_base(lane);
    const float psink = __builtin_amdgcn_exp2f(sink[hq] * LOG2E - mref);
    f32x16 negm; fill16(negm, -mref);
    bf16x8 qn[4];
    { const u16* Qw = Q + (rowbase + q0 + r32) * DIN + hq * 64 + hi * 8;
#pragma unroll
      for (int d0 = 0; d0 < 4; ++d0) qn[d0] = ld8(Qw + d0 * 16); }
#pragma unroll 1
    for (int sub = 0; sub < 4; ++sub) {
        const int qs = q0 + 32 * sub;
        bf16x8 qr[4];
#pragma unroll
        for (int d0 = 0; d0 < 4; ++d0) qr[d0] = qn[d0];
        if (sub < 3) { const u16* Qw = Q + (rowbase + qs + 32 + r32) * DIN + hq * 64 + hi * 8;
#pragma unroll
            for (int d0 = 0; d0 < 4; ++d0) qn[d0] = ld8(Qw + d0 * 16); }
        const int hA = (qs >= 128 ? qs - 128 : 0) >> 5, hE = (qs + 159 < SEQ ? qs + 159 : SEQ - 1) >> 5;
        const int tS = (hA + 1) >> 1, tE = (hE + 1) >> 1, tLast = hE >> 1;
        float lsum = hi ? 0.f : psink; f32x16 o[2] = {};
        bf16x8 gpre[2][2];
        { const size_t gb = (size_t)(rowbase + qs + (lane >> 1)) * DIN + hq * 64 + (lane & 1) * 16;
#pragma unroll
          for (int cbk = 0; cbk < 2; ++cbk) { gpre[cbk][0] = ld8(Gt + gb + cbk * 32); gpre[cbk][1] = ld8(Gt + gb + cbk * 32 + 8); } }
        bf16x8 kf0, kf1, kf2, kf3, kf4, kf5, kf6, kf7;
#define SWA_KLOAD(tile) do { const char* Kn_ = lds + SWB_K + ((tile) % 6) * 8192; \
            kf0 = *reinterpret_cast<const bf16x8*>(Kn_ + KSWZ128(r32, (0 * 16 + hi * 8) * 2)); kf1 = *reinterpret_cast<const bf16x8*>(Kn_ + KSWZ128(32 + r32, (0 * 16 + hi * 8) * 2)); \
            kf2 = *reinterpret_cast<const bf16x8*>(Kn_ + KSWZ128(r32, (1 * 16 + hi * 8) * 2)); kf3 = *reinterpret_cast<const bf16x8*>(Kn_ + KSWZ128(32 + r32, (1 * 16 + hi * 8) * 2)); \
            kf4 = *reinterpret_cast<const bf16x8*>(Kn_ + KSWZ128(r32, (2 * 16 + hi * 8) * 2)); kf5 = *reinterpret_cast<const bf16x8*>(Kn_ + KSWZ128(32 + r32, (2 * 16 + hi * 8) * 2)); \
            kf6 = *reinterpret_cast<const bf16x8*>(Kn_ + KSWZ128(r32, (3 * 16 + hi * 8) * 2)); kf7 = *reinterpret_cast<const bf16x8*>(Kn_ + KSWZ128(32 + r32, (3 * 16 + hi * 8) * 2)); } while (0)
#define PKNH(P, B) (u32x4){cvtpk_b(P[B + 0], P[B + 1]), cvtpk_b(P[B + 2], P[B + 3]), cvtpk_b(P[B + 4], P[B + 5]), cvtpk_b(P[B + 6], P[B + 7])}
#define SWA_HALF(KA, KB, KC, KD, VB, K0H) do { \
            f32x16 ph = __builtin_amdgcn_mfma_f32_32x32x16_bf16(KA, qr[0], negm, 0, 0, 0); ph = __builtin_amdgcn_mfma_f32_32x32x16_bf16(KB, qr[1], ph, 0, 0, 0); \
            ph = __builtin_amdgcn_mfma_f32_32x32x16_bf16(KC, qr[2], ph, 0, 0, 0); ph = __builtin_amdgcn_mfma_f32_32x32x16_bf16(KD, qr[3], ph, 0, 0, 0); \
            const int vh_ = (VB); s16x4 lo_[4], hi_[4]; \
            _Pragma("unroll") for (int i = 0; i < 4; ++i) { lo_[i] = vtr(vh_ + (i >> 1) * 2048 + (i & 1) * 512); hi_[i] = vtr(vh_ + (i >> 1) * 2048 + (i & 1) * 512 + 1024); } \
            if ((K0H) < qs - 97 || (K0H) + 31 > qs + 128) { const int base = (K0H) - qs - r32 + 4 * hi + 128; \
                _Pragma("unroll") for (int r = 0; r < 16; ++r) { const int c = (r & 3) + 8 * (r >> 2); if ((unsigned)(base + c) > 256u) ph[r] = -1e30f; } } \
            _Pragma("unroll") for (int r = 0; r < 16; ++r) ph[r] = __builtin_amdgcn_exp2f(ph[r]); \
            { float s0 = (ph[0] + ph[1]) + (ph[2] + ph[3]), s1 = (ph[4] + ph[5]) + (ph[6] + ph[7]), s2 = (ph[8] + ph[9]) + (ph[10] + ph[11]), s3 = (ph[12] + ph[13]) + (ph[14] + ph[15]); lsum += (s0 + s1) + (s2 + s3); } \
            bf16x8 pb0, pb1; { u32x4 w = PKNH(ph, 0); pb0 = *reinterpret_cast<bf16x8*>(&w); } { u32x4 w = PKNH(ph, 8); pb1 = *reinterpret_cast<bf16x8*>(&w); } \
            _Pragma("unroll") for (int i = 0; i < 4; ++i) o[i & 1] = __builtin_amdgcn_mfma_f32_32x32x16_bf16((i >> 1) == 0 ? pb0 : pb1, PKF(lo_[i], hi_[i]), o[i & 1], 0, 0, 0); } while (0)
        SWA_KLOAD(hA >> 1);
        if (hA & 1) { SWA_HALF(kf1, kf3, kf5, kf7, vb0 + ((hA >> 1) % 6) * 8192 + 4096, hA * 32); SWA_KLOAD(tS); }
#pragma unroll 1
        for (int tt = tS; tt < tE; ++tt) {
            const int k0 = tt * 64, sl = tt % 6;
            f32x16 p0, p1;
            p0 = __builtin_amdgcn_mfma_f32_32x32x16_bf16(kf0, qr[0], negm, 0, 0, 0); p1 = __builtin_amdgcn_mfma_f32_32x32x16_bf16(kf1, qr[0], negm, 0, 0, 0);
            p0 = __builtin_amdgcn_mfma_f32_32x32x16_bf16(kf2, qr[1], p0, 0, 0, 0);   p1 = __builtin_amdgcn_mfma_f32_32x32x16_bf16(kf3, qr[1], p1, 0, 0, 0);
            p0 = __builtin_amdgcn_mfma_f32_32x32x16_bf16(kf4, qr[2], p0, 0, 0, 0);   p1 = __builtin_amdgcn_mfma_f32_32x32x16_bf16(kf5, qr[2], p1, 0, 0, 0);
            p0 = __builtin_amdgcn_mfma_f32_32x32x16_bf16(kf6, qr[3], p0, 0, 0, 0);   p1 = __builtin_amdgcn_mfma_f32_32x32x16_bf16(kf7, qr[3], p1, 0, 0, 0);
            SWA_KLOAD(tt < tLast ? tt + 1 : tt);
            { const int base = k0 - qs - r32 + 4 * hi + 128;
              if (k0 < qs - 97) {
#pragma unroll
                for (int r = 0; r < 16; ++r) { const int c = (r & 3) + 8 * (r >> 2); if ((unsigned)(base + c) > 256u) p0[r] = -1e30f; } }
              if (k0 + 63 > qs + 128) {
#pragma unroll
                for (int r = 0; r < 16; ++r) { const int c = (r & 3) + 8 * (r >> 2); if ((unsigned)(base + c + 32) > 256u) p1[r] = -1e30f; } } }
#pragma unroll
            for (int r = 0; r < 16; ++r) { p0[r] = __builtin_amdgcn_exp2f(p0[r]); p1[r] = __builtin_amdgcn_exp2f(p1[r]); }
            { float s0 = (p0[0] + p0[1]) + (p0[2] + p0[3]), s1 = (p0[4] + p0[5]) + (p0[6] + p0[7]), s2 = (p0[8] + p0[9]) + (p0[10] + p0[11]), s3 = (p0[12] + p0[13]) + (p0[14] + p0[15]);
              float t0 = (p1[0] + p1[1]) + (p1[2] + p1[3]), t1 = (p1[4] + p1[5]) + (p1[6] + p1[7]), t2 = (p1[8] + p1[9]) + (p1[10] + p1[11]), t3 = (p1[12] + p1[13]) + (p1[14] + p1[15]);
              lsum += ((s0 + s1) + (s2 + s3)) + ((t0 + t1) + (t2 + t3)); }
            bf16x8 pa0, pa1, pa2, pa3;
            { u32x4 w = PKN(p0, 0); pa0 = *reinterpret_cast<bf16x8*>(&w); } { u32x4 w = PKN(p0, 8); pa1 = *reinterpret_cast<bf16x8*>(&w); }
            { u32x4 w = PKN(p1, 0); pa2 = *reinterpret_cast<bf16x8*>(&w); } { u32x4 w = PKN(p1, 8); pa3 = *reinterpret_cast<bf16x8*>(&w); }
            {
                const int vbt = vb0 + sl * 8192; s16x4 lo[4], hi4[4];
#define VADDR2(i) (vbt + ((i) & 1) * 512 + ((i) >> 1) * 2048)
#pragma unroll
                for (int i = 0; i < 4; ++i) { lo[i] = vtr(VADDR2(i)); hi4[i] = vtr(VADDR2(i) + 1024); }
#pragma unroll
                for (int i = 0; i < 8; ++i) {
                    const bf16x8 vf = PKF(lo[i & 3], hi4[i & 3]);
                    const bf16x8 pa = ((i >> 1) == 0) ? pa0 : ((i >> 1) == 1) ? pa1 : ((i >> 1) == 2) ? pa2 : pa3;
                    o[i & 1] = __builtin_amdgcn_mfma_f32_32x32x16_bf16(pa, vf, o[i & 1], 0, 0, 0);
                    if (i + 4 < 8) { lo[i & 3] = vtr(VADDR2(i + 4)); hi4[i & 3] = vtr(VADDR2(i + 4) + 1024); }
                }
#undef VADDR2
            }
        }
        if (!(hE & 1)) SWA_HALF(kf0, kf2, kf4, kf6, vb0 + (tLast % 6) * 8192, hE * 32);
#undef SWA_HALF
#undef PKNH
#undef SWA_KLOAD
        { auto rr = __builtin_amdgcn_permlane32_swap(__float_as_uint(lsum), __float_as_uint(lsum), false, false); lsum = __uint_as_float(rr[0]) + __uint_as_float(rr[1]); }
        if (hi == 0) wsf[r32] = lsum; asm volatile("s_waitcnt lgkmcnt(0)" ::: "memory");
        float rl[16];
#pragma unroll
        for (int r = 0; r < 16; ++r) rl[r] = __builtin_amdgcn_rcpf(wsf[crow(r, hi)]);
#pragma unroll
        for (int cbk = 0; cbk < 2; ++cbk) {
#pragma unroll
            for (int r = 0; r < 16; ++r) stg[crow(r, hi) * SWB_STG_LD + r32] = o[cbk][r] * rl[r];
            asm volatile("s_waitcnt lgkmcnt(0)" ::: "memory");
            const int row = lane >> 1, hf = lane & 1; const float* sp = stg + row * SWB_STG_LD + hf * 16;
            const f32x4 a0 = *(const f32x4*)(sp), a1 = *(const f32x4*)(sp + 4), a2 = *(const f32x4*)(sp + 8), a3 = *(const f32x4*)(sp + 12);
            const size_t goff = (size_t)(rowbase + qs + row) * DIN + hq * 64 + cbk * 32 + hf * 16;
            const bf16x8 g0 = gpre[cbk][0], g1 = gpre[cbk][1];
            u32x4 w0, w1;
            w0.x = cvtpk(a0[0] * bf2f((u16)g0[0]), a0[1] * bf2f((u16)g0[1])); w0.y = cvtpk(a0[2] * bf2f((u16)g0[2]), a0[3] * bf2f((u16)g0[3]));
            w0.z = cvtpk(a1[0] * bf2f((u16)g0[4]), a1[1] * bf2f((u16)g0[5])); w0.w = cvtpk(a1[2] * bf2f((u16)g0[6]), a1[3] * bf2f((u16)g0[7]));
            w1.x = cvtpk(a2[0] * bf2f((u16)g1[0]), a2[1] * bf2f((u16)g1[1])); w1.y = cvtpk(a2[2] * bf2f((u16)g1[2]), a2[3] * bf2f((u16)g1[3]));
            w1.z = cvtpk(a3[0] * bf2f((u16)g1[4]), a3[1] * bf2f((u16)g1[5])); w1.w = cvtpk(a3[2] * bf2f((u16)g1[6]), a3[3] * bf2f((u16)g1[7]));
            if (!DRY) { *(u32x4*)(Y + goff) = w0; *(u32x4*)(Y + goff + 8) = w1; } else asm volatile("" :: "v"(w0), "v"(w1));
            asm volatile("s_waitcnt lgkmcnt(0)" ::: "memory");
        }
    }
}
template <bool DRY, bool FAST>
__device__ __forceinline__ void swa_phase_tail(int b, int kvh, int qbA, int qbB, const SwaRegs<2>& N, int tnew, int nnew, const u16* Q, const u16* Gt, u16* Y, const float* sink, float mref, char* lds, int tid) {
    if (FAST) swa_block_compute_fast<DRY>(b, kvh, qbA, Q, Gt, Y, sink, mref, lds, tid); else swa_block_compute<DRY>(b, kvh, qbA, Q, Gt, Y, sink, lds, tid);
    __syncthreads();
    swa_tiles_store_lds<2>(N, tnew, nnew, lds, tid);
    __syncthreads();
    if (FAST) swa_block_compute_fast<DRY>(b, kvh, qbB, Q, Gt, Y, sink, mref, lds, tid); else swa_block_compute<DRY>(b, kvh, qbB, Q, Gt, Y, sink, lds, tid);
    __syncthreads();
}
template <bool DRY>
__device__ __forceinline__ void swa_phase(int u0, const u16* Q, const u16* Kb, const u16* Vb, const u16* Gt, u16* Y, const float* sink, const unsigned* __restrict__ qmx, const unsigned* __restrict__ kmx, char* lds) {
    int tid = threadIdx.x; asm volatile("" : "+v"(tid));
    const int bk = u0 >> 5, b = bk >> 2, kvh = bk & 3, qbA = u0 & 31, qbB = qbA + 1;
    int tloA, thiA, tloB, thiB; swa_block_geom(qbA, tloA, thiA); swa_block_geom(qbB, tloB, thiB);
    { SwaRegs<6> R; swa_tiles_load<6>(R, b, kvh, tloA, thiA - tloA + 1, Kb, Vb, tid); swa_tiles_store_lds<6>(R, tloA, thiA - tloA + 1, lds, tid); }
    __syncthreads();
    SwaRegs<2> N; const int nnew = thiB - thiA;
    swa_tiles_load<2>(N, b, kvh, thiA + 1, nnew, Kb, Vb, tid);
    const int hq_ = kvh * 8 + __builtin_amdgcn_readfirstlane(tid >> 6);
    const float mref = fmaxf(__builtin_sqrtf(__uint_as_float(qmx[b * 32 + hq_]) * __uint_as_float(kmx[b * 16 + kvh])) * 1.0001f, sink[hq_] * LOG2E);
    if (mref <= 60.0f) swa_phase_tail<DRY, true>(b, kvh, qbA, qbB, N, thiA + 1, nnew, Q, Gt, Y, sink, mref, lds, tid);
    else               swa_phase_tail<DRY, false>(b, kvh, qbA, qbB, N, thiA + 1, nnew, Q, Gt, Y, sink, mref, lds, tid);
}
}
namespace hg {
using namespace att;
typedef _Float16 f16;
typedef __bf16 bf16x2_cv __attribute__((ext_vector_type(2))); typedef float f32x2_cv __attribute__((ext_vector_type(2)));
__device__ __forceinline__ unsigned cvtpk_h(float lo, float hi) { const f32x2_cv v = {lo, hi}; return __builtin_bit_cast(unsigned, __builtin_convertvector(v, bf16x2_cv)); }
constexpr int L_QT = 0, L_KT = 16384, L_QIN = 32768, L_KDEC = 49152, L_V = 65536, L_S = 81920, L_CUM = 114688, L_EDEC = 118784, L_STG = 122880, STG_LD = 132;

struct ChunkRegs { unsigned q[8], v[8], lf[8]; };

__device__ __forceinline__ int chunk_pos(int c, int i, int dir) { return dir ? (c * 64 + 63 - i) : (c * 64 + i); }

template <bool NEEDQ>
__device__ __forceinline__ void load_chunk(ChunkRegs& R, const u16* Qh, const u16* Vh, const u16* LF, long rowbase, int colbase, int c, int dir, int wid, int lane) {
#pragma unroll
    for (int i = 0; i < 8; ++i) {
        const long pos = rowbase + chunk_pos(c, wid * 8 + i, dir);
        const size_t off = (size_t)pos * DM + colbase + 2 * lane;
        if (NEEDQ) R.q[i] = *(const unsigned*)(Qh + off);
        R.v[i] = *(const unsigned*)(Vh + off);
        R.lf[i] = *(const unsigned*)(LF + off);
    }
}
__device__ __forceinline__ float h2f(unsigned short h) { return (float)__builtin_bit_cast(f16, h); }

template <bool FULL>
__device__ __forceinline__ void prep_chunk(const ChunkRegs& R, char* lds, int wid, int lane, float (&gtot)[2]) {
    float g[8][2]; float run0 = 0.f, run1 = 0.f;
#pragma unroll
    for (int i = 0; i < 8; ++i) { run0 += h2f((unsigned short)(R.lf[i] & 0xffff)); run1 += h2f((unsigned short)(R.lf[i] >> 16)); g[i][0] = run0; g[i][1] = run1; }
    float* cum = (float*)(lds + L_CUM);
    *(float2*)(cum + wid * 128 + 2 * lane) = make_float2(run0, run1);
    __syncthreads();
    float pre0 = 0.f, pre1 = 0.f, gm0 = 0.f, gm1 = 0.f, gl0 = 0.f, gl1 = 0.f;
#pragma unroll
    for (int w2 = 0; w2 < 8; ++w2) { const float2 t = *(const float2*)(cum + w2 * 128 + 2 * lane);
        if (w2 < wid) { pre0 += t.x; pre1 += t.y; } if (w2 < 4) { gm0 += t.x; gm1 += t.y; } gl0 += t.x; gl1 += t.y; }
    gtot[0] += gl0; gtot[1] += gl1;
    const float egm0 = __builtin_amdgcn_exp2f(gm0), egm1 = __builtin_amdgcn_exp2f(gm1), elm0 = __builtin_amdgcn_exp2f(gl0 - gm0), elm1 = __builtin_amdgcn_exp2f(gl1 - gm1);
    if (wid == 0) *(float2*)((float*)(lds + L_EDEC) + 2 * lane) = make_float2(__builtin_amdgcn_exp2f(gl0), __builtin_amdgcn_exp2f(gl1));
    typedef float f32x2 __attribute__((ext_vector_type(2)));
    const f32x2 prev = {pre0, pre1}, gmv = {gm0, gm1}, elmv = {elm0, elm1}, egmv = {egm0, egm1}, one2 = {1.0f, 1.0f};
#pragma unroll
    for (int i = 0; i < 8; ++i) {
        const int row = wid * 8 + i;
        const f32x2 a = (prev + (f32x2){g[i][0], g[i][1]}) - gmv;
        const f32x2 e = {__builtin_amdgcn_exp2f(a.x), __builtin_amdgcn_exp2f(a.y)};
        const f32x2 r = {__builtin_amdgcn_rcpf(e.x), __builtin_amdgcn_rcpf(e.y)};
        const float lf0 = h2f((unsigned short)(R.lf[i] & 0xffff)), lf1 = h2f((unsigned short)(R.lf[i] >> 16));
        const f32x2 k = one2 - (f32x2){__builtin_amdgcn_exp2f(lf0), __builtin_amdgcn_exp2f(lf1)};
        const f32x2 kt = k * r, kd = kt * elmv;
        const int vo = v_stn<4>(row, 2 * lane);
        *(unsigned*)(lds + L_KDEC + vo) = cvtpk_h(kd.x, kd.y);
        *(unsigned*)(lds + L_V + vo) = R.v[i];
        if (FULL) {
            const f32x2 q = {bf2f((u16)(R.q[i] & 0xffff)), bf2f((u16)(R.q[i] >> 16))};
            const f32x2 qt = q * e, qi = qt * egmv;
            const int ko = KSWZ(row, 4 * lane);
            *(unsigned*)(lds + L_QT + ko) = cvtpk_h(qt.x, qt.y);
            *(unsigned*)(lds + L_KT + ko) = cvtpk_h(kt.x, kt.y);
            *(unsigned*)(lds + L_QIN + ko) = cvtpk_h(qi.x, qi.y);
        }
    }
}

template <int KS> __device__ __forceinline__ bf16x8 tr_frag(int vb) {
    const s16x4 l = tr_read<KS * 4096>(vb), h = tr_read<KS * 4096 + 2048>(vb);
    asm volatile("s_waitcnt lgkmcnt(0)" ::: "memory"); SBAR();
    return PKF(l, h);
}

struct SuFrag { s16x4 lv, hv, l0, h0, l1, h1; };
__device__ __forceinline__ void su_read(SuFrag& f, int vbV, int vbK0, int vbK1, int off) {
    f.lv = vtr(vbV + off); f.hv = vtr(vbV + off + 2048); f.l0 = vtr(vbK0 + off); f.h0 = vtr(vbK0 + off + 2048); f.l1 = vtr(vbK1 + off); f.h1 = vtr(vbK1 + off + 2048);
}
__device__ __forceinline__ void su_mma(f32x16 (&sacc)[2], const SuFrag& f) {
    const bf16x8 bv = PKF(f.lv, f.hv), a0 = PKF(f.l0, f.h0), a1 = PKF(f.l1, f.h1);
    sacc[0] = __builtin_amdgcn_mfma_f32_32x32x16_bf16(a0, bv, sacc[0], 0, 0, 0); sacc[1] = __builtin_amdgcn_mfma_f32_32x32x16_bf16(a1, bv, sacc[1], 0, 0, 0);
}
template <int NIMG>
__device__ __forceinline__ void state_update_t(f32x16 (&sacc)[2], const char* lds, int ldsbase, int offK, int offV, int offE, int wid, int lane) {
    const int hi = lane >> 5, j = wid >> 1, ib = 2 * (wid & 1);
    const float* edec = (const float*)(lds + offE);
    const int vbV = ldsbase + offV + v_rd_base(lane) + j * 512;
    const int vbK0 = ldsbase + offK + v_rd_base(lane) + ib * 512, vbK1 = vbK0 + 512;
#pragma unroll
    for (int i2 = 0; i2 < 2; ++i2)
#pragma unroll
        for (int r = 0; r < 16; ++r) sacc[i2][r] *= edec[32 * (ib + i2) + crow(r, hi)];
    SBAR();
    SuFrag fa, fb; su_read(fa, vbV, vbK0, vbK1, 0);
#pragma unroll
    for (int s = 0; s < 4 * NIMG; s += 2) {
        su_read(fb, vbV, vbK0, vbK1, ((s + 1) >> 2) * 16384 + ((s + 1) & 3) * 4096);
        su_mma(sacc, fa);
        if (s + 2 < 4 * NIMG) su_read(fa, vbV, vbK0, vbK1, ((s + 2) >> 2) * 16384 + ((s + 2) & 3) * 4096);
        su_mma(sacc, fb);
    }
    __builtin_amdgcn_sched_group_barrier(0x100, 6, 0);
#pragma unroll
    for (int s = 0; s < 4 * NIMG - 1; ++s) { __builtin_amdgcn_sched_group_barrier(0x100, 6, 0); __builtin_amdgcn_sched_group_barrier(0x008, 2, 0); }
    __builtin_amdgcn_sched_group_barrier(0x008, 2, 0);
    SBAR();
}
__device__ __forceinline__ void state_update(f32x16 (&sacc)[2], const char* lds, int ldsbase, int wid, int lane) { state_update_t<1>(sacc, lds, ldsbase, L_KDEC, L_V, L_EDEC, wid, lane); }
__device__ __forceinline__ void state_update_vf(f32x16 (&sacc)[2], const char* lds, int ldsbase, int wid, int lane, const bf16x8 (&vfr)[4]) {
    const int hi = lane >> 5, ib = 2 * (wid & 1);
    const float* edec = (const float*)(lds + L_EDEC);
    const int vbK0 = ldsbase + L_KDEC + v_rd_base(lane) + ib * 512, vbK1 = vbK0 + 512;
#pragma unroll
    for (int i2 = 0; i2 < 2; ++i2)
#pragma unroll
        for (int r = 0; r < 16; ++r) sacc[i2][r] *= edec[32 * (ib + i2) + crow(r, hi)];
    SBAR();
    s16x4 l0[2], h0[2], l1[2], h1[2];
    l0[0] = vtr(vbK0); h0[0] = vtr(vbK0 + 2048); l1[0] = vtr(vbK1); h1[0] = vtr(vbK1 + 2048);
#pragma unroll
    for (int ks = 0; ks < 4; ++ks) {
        if (ks + 1 < 4) { const int off = (ks + 1) * 4096; l0[(ks + 1) & 1] = vtr(vbK0 + off); h0[(ks + 1) & 1] = vtr(vbK0 + off + 2048); l1[(ks + 1) & 1] = vtr(vbK1 + off); h1[(ks + 1) & 1] = vtr(vbK1 + off + 2048); }
        SBAR();
        sacc[0] = __builtin_amdgcn_mfma_f32_32x32x16_bf16(PKF(l0[ks & 1], h0[ks & 1]), vfr[ks], sacc[0], 0, 0, 0);
        sacc[1] = __builtin_amdgcn_mfma_f32_32x32x16_bf16(PKF(l1[ks & 1], h1[ks & 1]), vfr[ks], sacc[1], 0, 0, 0);
        SBAR();
    }
}
__device__ __forceinline__ void write_simg(const f32x16 (&sacc)[2], char* lds, int wid, int lane) {
    const int r32 = lane & 31, hi = lane >> 5, j = wid >> 1, ib = 2 * (wid & 1);
#pragma unroll
    for (int i2 = 0; i2 < 2; ++i2)
#pragma unroll
        for (int r = 0; r < 16; r += 2) { const int d0 = 32 * (ib + i2) + crow(r, hi), d1 = 32 * (ib + i2) + crow(r + 1, hi);
            const unsigned w = cvtpk_h(sacc[i2][r], sacc[i2][r + 1]);
            *(u16*)(lds + L_S + (d0 >> 6) * 16384 + v_st<4>(d0 & 63, 32 * j + r32)) = (u16)(w & 0xffffu);
            *(u16*)(lds + L_S + (d1 >> 6) * 16384 + v_st<4>(d1 & 63, 32 * j + r32)) = (u16)(w >> 16); }
}
#define PKNB(P, B) (u32x4){cvtpk_h(P[B + 0], P[B + 1]), cvtpk_h(P[B + 2], P[B + 3]), cvtpk_h(P[B + 4], P[B + 5]), cvtpk_h(P[B + 6], P[B + 7])}
__device__ __forceinline__ f32x16 chunk_output(const char* lds, int ldsbase, int wid, int lane, bf16x8 (&vfr)[4]) {
    const int r32 = lane & 31, hi = lane >> 5, tb = wid & 1, j = wid >> 1;
    const char* QT = lds + L_QT; const char* KT = lds + L_KT; const char* QIN = lds + L_QIN;
    f32x16 p0 = f32x16{}, p1 = f32x16{};
#define FRA(img, row, d0) kld(ldsbase + (img) + KSWZ(row, ((d0) * 16 + hi * 8) * 2))
    if (tb) {
        bf16x8 q_[2], a_[2], b_[2];
        q_[0] = FRA(L_QT, 32 + r32, 0); a_[0] = FRA(L_KT, r32, 0); b_[0] = FRA(L_KT, 32 + r32, 0);
#pragma unroll
        for (int d0 = 0; d0 < 8; ++d0) {
            if (d0 + 1 < 8) { q_[(d0 + 1) & 1] = FRA(L_QT, 32 + r32, d0 + 1); a_[(d0 + 1) & 1] = FRA(L_KT, r32, d0 + 1); b_[(d0 + 1) & 1] = FRA(L_KT, 32 + r32, d0 + 1); }
            SBAR();
            p0 = __builtin_amdgcn_mfma_f32_32x32x16_bf16(a_[d0 & 1], q_[d0 & 1], p0, 0, 0, 0);
            p1 = __builtin_amdgcn_mfma_f32_32x32x16_bf16(b_[d0 & 1], q_[d0 & 1], p1, 0, 0, 0);
            SBAR();
        }
    } else {
        bf16x8 q_[2], a_[2];
        q_[0] = FRA(L_QT, r32, 0); a_[0] = FRA(L_KT, r32, 0);
#pragma unroll
        for (int d0 = 0; d0 < 8; ++d0) {
            if (d0 + 1 < 8) { q_[(d0 + 1) & 1] = FRA(L_QT, r32, d0 + 1); a_[(d0 + 1) & 1] = FRA(L_KT, r32, d0 + 1); }
            SBAR();
            p0 = __builtin_amdgcn_mfma_f32_32x32x16_bf16(a_[d0 & 1], q_[d0 & 1], p0, 0, 0, 0);
            SBAR();
        }
    }
#undef FRA
#pragma unroll
    for (int r = 0; r < 16; ++r) { const bool keep = crow(r, hi) <= r32; if (tb == 0) { p0[r] = keep ? p0[r] : 0.f; p1[r] = 0.f; } else { p1[r] = keep ? p1[r] : 0.f; } }
    bf16x8 pa0, pa1, pa2, pa3;
    { u32x4 w = PKNB(p0, 0); pa0 = *reinterpret_cast<bf16x8*>(&w); } { u32x4 w = PKNB(p0, 8); pa1 = *reinterpret_cast<bf16x8*>(&w); }
    { u32x4 w = PKNB(p1, 0); pa2 = *reinterpret_cast<bf16x8*>(&w); } { u32x4 w = PKNB(p1, 8); pa3 = *reinterpret_cast<bf16x8*>(&w); }
    f32x16 oacc = f32x16{};
    {
        const int vb = ldsbase + L_V + v_rd_base(lane) + j * 512;
#pragma unroll
        for (int ks = 0; ks < 4; ++ks) { const s16x4 l = vtr(vb + ks * 4096), h = vtr(vb + ks * 4096 + 2048); vfr[ks] = PKF(l, h); }
        oacc = __builtin_amdgcn_mfma_f32_32x32x16_bf16(pa0, vfr[0], oacc, 0, 0, 0); oacc = __builtin_amdgcn_mfma_f32_32x32x16_bf16(pa1, vfr[1], oacc, 0, 0, 0);
        oacc = __builtin_amdgcn_mfma_f32_32x32x16_bf16(pa2, vfr[2], oacc, 0, 0, 0); oacc = __builtin_amdgcn_mfma_f32_32x32x16_bf16(pa3, vfr[3], oacc, 0, 0, 0);
    }
    const int vbS = ldsbase + L_S + v_rd_base(lane) + j * 512;
#define QINF(kd) (*reinterpret_cast<const bf16x8*>(QIN + KSWZ(32 * tb + r32, ((kd) * 16 + hi * 8) * 2)))
    {
        s16x4 lo[2], hh[2];
#define SADDR(kd) (vbS + ((kd) >> 2) * 16384 + ((kd) & 3) * 4096)
        lo[0] = vtr(SADDR(0)); hh[0] = vtr(SADDR(0) + 2048); lo[1] = vtr(SADDR(1)); hh[1] = vtr(SADDR(1) + 2048);
#pragma unroll
        for (int kd = 0; kd < 8; ++kd) {
            const bf16x8 b = PKF(lo[kd & 1], hh[kd & 1]); const bf16x8 q = QINF(kd);
            oacc = __builtin_amdgcn_mfma_f32_32x32x16_bf16(q, b, oacc, 0, 0, 0);
            if (kd + 2 < 8) { lo[kd & 1] = vtr(SADDR(kd + 2)); hh[kd & 1] = vtr(SADDR(kd + 2) + 2048); }
        }
#undef SADDR
    }
#undef QINF
    return oacc;
}

constexpr int P1_KDEC = 0, P1_V = 65536, P1_CUM = 131072, P1_EDEC = 135168;
struct BlockRegs { unsigned v[32], lf[32]; };
__device__ __forceinline__ void load_block(BlockRegs& R, const u16* Vh, const u16* LF, long rowbase, int colbase, int seg, int blk, int dir, int wid, int lane) {
    unsigned voff = (unsigned)lane * 4u; asm volatile("" : "+v"(voff));
#pragma unroll
    for (int i = 0; i < 32; ++i) {
        const int p = blk * 256 + wid * 32 + i;
        const long pos = rowbase + seg * 512 + (dir ? 511 - p : p);
        const size_t roff = ((size_t)pos * DM + colbase) * 2;
        R.v[i] = *(const unsigned*)((const char*)Vh + roff + voff); R.lf[i] = *(const unsigned*)((const char*)LF + roff + voff);
    }
}
__device__ __forceinline__ void prep_block(const BlockRegs& R, char* lds, int wid, int lane, float (&gtot)[2]) {
    float run0 = 0.f, run1 = 0.f;
#pragma unroll
    for (int i = 0; i < 32; ++i) { run0 += h2f((unsigned short)(R.lf[i] & 0xffff)); run1 += h2f((unsigned short)(R.lf[i] >> 16)); }
    float* cum = (float*)(lds + P1_CUM);
    *(float2*)(cum + wid * 128 + 2 * lane) = make_float2(run0, run1);
    __syncthreads();
    float pre0 = 0.f, pre1 = 0.f, gl0 = 0.f, gl1 = 0.f;
#pragma unroll
    for (int w2 = 0; w2 < 8; ++w2) { const float2 t = *(const float2*)(cum + w2 * 128 + 2 * lane); if (w2 < wid) { pre0 += t.x; pre1 += t.y; } gl0 += t.x; gl1 += t.y; }
    gtot[0] += gl0; gtot[1] += gl1;
    if (wid == 0) *(float2*)((float*)(lds + P1_EDEC) + 2 * lane) = make_float2(__builtin_amdgcn_exp2f(gl0), __builtin_amdgcn_exp2f(gl1));
    float G0 = pre0 - gl0, G1 = pre1 - gl1;
    char* base = lds + (wid >> 1) * 16384 + (wid & 1) * 8192 + v_st<4>(0, 2 * lane);
    typedef float f32x2 __attribute__((ext_vector_type(2)));
    f32x2 Gv = {G0, G1}; const f32x2 one2 = {1.0f, 1.0f};
#pragma unroll
    for (int i = 0; i < 32; ++i) {
        const f32x2 lf = {h2f((unsigned short)(R.lf[i] & 0xffff)), h2f((unsigned short)(R.lf[i] >> 16))};
        Gv += lf;
        const f32x2 k = one2 - (f32x2){__builtin_amdgcn_exp2f(lf.x), __builtin_amdgcn_exp2f(lf.y)};
        const f32x2 kd = k * (f32x2){__builtin_amdgcn_exp2f(-Gv.x), __builtin_amdgcn_exp2f(-Gv.y)};
        const int vo = v_st<4>(i, 0);
        *(unsigned*)(base + P1_KDEC + vo) = cvtpk_h(kd.x, kd.y);
        *(unsigned*)(base + P1_V + vo) = R.v[i];
    }
}
__device__ __forceinline__ void state_update_block(f32x16 (&sacc)[2], const char* lds, int ldsbase, int wid, int lane) { state_update_t<4>(sacc, lds, ldsbase, P1_KDEC, P1_V, P1_EDEC, wid, lane); }
__device__ __forceinline__ void hgrn_pass1(int item, const u16* Vt, const u16* LF0, const u16* LF1, float* ust, float* dst, char* lds) {
    int tid = threadIdx.x; asm volatile("" : "+v"(tid)); const int lane = tid & 63; const int wid = __builtin_amdgcn_readfirstlane(tid >> 6);
    const int seg = item & 7, dir = (item >> 3) & 1, bh = item >> 4, b = bh >> 3, h = bh & 7;
    const long rowbase = (long)b * SEQ; const int colbase = h * 128; const u16* LF = dir ? LF1 : LF0;
    const int ldsbase = (int)(uintptr_t)lds;
    f32x16 sacc[2] = {}; float gtot[2] = {0.f, 0.f};
    BlockRegs R;
    load_block(R, Vt, LF, rowbase, colbase, seg, 0, dir, wid, lane);
#pragma unroll 1
    for (int blk = 0; blk < 2; ++blk) {
        prep_block(R, lds, wid, lane, gtot);
        asm volatile("" ::: "memory");
        if (blk == 0) load_block(R, Vt, LF, rowbase, colbase, seg, 1, dir, wid, lane);
        __syncthreads();
        state_update_block(sacc, lds, ldsbase, wid, lane);
    }
    float* up = ust + (size_t)item * 16384 + wid * 2048;
#pragma unroll
    for (int i2 = 0; i2 < 2; ++i2)
#pragma unroll
        for (int r = 0; r < 16; ++r) up[(i2 * 16 + r) * 64 + lane] = sacc[i2][r];
    if (wid == 0) *(float2*)(dst + (size_t)item * 128 + 2 * lane) = make_float2(__builtin_amdgcn_exp2f(gtot[0]), __builtin_amdgcn_exp2f(gtot[1]));
    __syncthreads();
}

template <bool DRY, int PVAR = 0>
__device__ __forceinline__ void hgrn_pass2(int item, const u16* Qh, const u16* Vt, const u16* LF0, const u16* LF1, const u16* Gt, u16* OF, u16* Y,
                                           const float* ust, const float* dst, const float* __restrict__ nw, char* lds) {
    int tid = threadIdx.x; asm volatile("" : "+v"(tid)); const int lane = tid & 63, r32 = lane & 31, hi = lane >> 5; const int wid = __builtin_amdgcn_readfirstlane(tid >> 6);
    const int seg = item & 7, bh = item >> 3, b = bh >> 3, h = bh & 7;
    const long rowbase = (long)b * SEQ; const int colbase = h * 128;
    const int vw = ((wid & 3) << 1) | (wid >> 2);
    const int ldsbase = (int)(uintptr_t)lds; const int tb = vw & 1, j = vw >> 1, ib = 2 * (vw & 1);
    float* stg = (float*)(lds + L_STG);
    ChunkRegs R;
#pragma unroll 1
    for (int dir = 0; dir < 2; ++dir) {
        const u16* LF = dir ? LF1 : LF0;
        f32x16 sacc[2] = {}; float gtot[2] = {0.f, 0.f};
        const int nseg = dir ? (7 - seg) : seg;
        load_chunk<true>(R, Qh, Vt, LF, rowbase, colbase, dir ? (seg * 8 + 7) : (seg * 8), dir, wid, lane);
        for (int n = 0; n < nseg; ++n) {
            const int sg = dir ? (7 - n) : n; const int it = ((bh * 2 + dir) * 8 + sg);
            const float* up = ust + (size_t)it * 16384 + vw * 2048; const float* dp = dst + (size_t)it * 128;
#pragma unroll
            for (int i2 = 0; i2 < 2; ++i2)
#pragma unroll
                for (int r = 0; r < 16; ++r) sacc[i2][r] = sacc[i2][r] * dp[32 * (ib + i2) + crow(r, hi)] + up[(i2 * 16 + r) * 64 + lane];
        }
        write_simg(sacc, lds, vw, lane);
        for (int cc = 0; cc < 8; ++cc) {
            const int c = dir ? (seg * 8 + 7 - cc) : (seg * 8 + cc);
            const int ri = tid >> 3, rcg = tid & 7; const size_t goff = (size_t)(rowbase + chunk_pos(c, ri, dir)) * DM + colbase + rcg * 16;
            u32x4 pf0 = {}, pf1 = {}; bf16x8 pg0 = {}, pg1 = {};
            if (dir) { pf0 = *(const u32x4*)(OF + goff); pf1 = *(const u32x4*)(OF + goff + 8); pg0 = ld8(Gt + goff); pg1 = ld8(Gt + goff + 8); }
            if (PVAR != 1) prep_chunk<true>(R, lds, wid, lane, gtot); else { asm volatile("" :: "v"(R.q[0]), "v"(R.v[7]), "v"(R.lf[3])); __syncthreads(); }
            if (cc + 1 < 8) load_chunk<true>(R, Qh, Vt, LF, rowbase, colbase, dir ? (seg * 8 + 6 - cc) : (seg * 8 + cc + 1), dir, wid, lane);
            __syncthreads();
            f32x16 oacc = f32x16{};
            if (PVAR != 2) { bf16x8 vfr[4]; oacc = chunk_output(lds, ldsbase, vw, lane, vfr); state_update_vf(sacc, lds, ldsbase, vw, lane, vfr); }
            if (PVAR != 3) {
#pragma unroll
            for (int r = 0; r < 16; ++r) stg[(32 * tb + crow(r, hi)) * STG_LD + 32 * j + r32] = oacc[r];
            __syncthreads();
            write_simg(sacc, lds, vw, lane);
            {
                const int i = ri, cg = rcg; const float* sp = stg + i * STG_LD + cg * 16;
                f32x4 ov[4];
#pragma unroll
                for (int g = 0; g < 4; ++g) ov[g] = *(const f32x4*)(sp + g * 4);
                if (dir == 0) {
                    u32x4 w0, w1;
                    w0.x = pg8::pk_f16(ov[0][0], ov[0][1]); w0.y = pg8::pk_f16(ov[0][2], ov[0][3]); w0.z = pg8::pk_f16(ov[1][0], ov[1][1]); w0.w = pg8::pk_f16(ov[1][2], ov[1][3]);
                    w1.x = pg8::pk_f16(ov[2][0], ov[2][1]); w1.y = pg8::pk_f16(ov[2][2], ov[2][3]); w1.z = pg8::pk_f16(ov[3][0], ov[3][1]); w1.w = pg8::pk_f16(ov[3][2], ov[3][3]);
                    if (!DRY) { *(u32x4*)(OF + goff) = w0; *(u32x4*)(OF + goff + 8) = w1; } else asm volatile("" :: "v"(w0), "v"(w1));
                } else {
                    const u32x4 f0 = pf0, f1 = pf1;
                    float tv[16];
#pragma unroll
                    for (int e = 0; e < 4; ++e) { tv[2 * e] = h2f((unsigned short)(f0[e] & 0xffff)); tv[2 * e + 1] = h2f((unsigned short)(f0[e] >> 16));
                                                  tv[8 + 2 * e] = h2f((unsigned short)(f1[e] & 0xffff)); tv[8 + 2 * e + 1] = h2f((unsigned short)(f1[e] >> 16)); }
                    float ss = 0.f;
#pragma unroll
                    for (int e = 0; e < 16; ++e) { tv[e] += ov[e >> 2][e & 3]; ss += tv[e] * tv[e]; }
                    ss += __shfl_xor(ss, 1); ss += __shfl_xor(ss, 2); ss += __shfl_xor(ss, 4);
                    const float rs = __builtin_amdgcn_rsqf(ss * (1.0f / 128.0f) + EPS);
                    const bf16x8 g0 = pg0, g1 = pg1;
                    float yv[16];
#pragma unroll
                    for (int e = 0; e < 8; ++e) { yv[e] = tv[e] * rs * nw[cg * 16 + e] * bf2f((u16)g0[e]); yv[8 + e] = tv[8 + e] * rs * nw[cg * 16 + 8 + e] * bf2f((u16)g1[e]); }
                    u32x4 w0, w1;
                    w0.x = cvtpk_h(yv[0], yv[1]); w0.y = cvtpk_h(yv[2], yv[3]); w0.z = cvtpk_h(yv[4], yv[5]); w0.w = cvtpk_h(yv[6], yv[7]);
                    w1.x = cvtpk_h(yv[8], yv[9]); w1.y = cvtpk_h(yv[10], yv[11]); w1.z = cvtpk_h(yv[12], yv[13]); w1.w = cvtpk_h(yv[14], yv[15]);
                    if (!DRY) { *(u32x4*)(Y + goff) = w0; *(u32x4*)(Y + goff + 8) = w1; } else asm volatile("" :: "v"(w0), "v"(w1));
                }
            }
            } else { asm volatile("" :: "v"(oacc), "v"(sacc[0]), "v"(sacc[1]), "v"(pf0), "v"(pg0)); __syncthreads(); }
        }
        __syncthreads();
    }
}
}
#define GAS __attribute__((address_space(1)))
#define LAS __attribute__((address_space(3)))
typedef unsigned short bf16;
typedef unsigned v4u __attribute__((ext_vector_type(4)));
typedef float f32x4 __attribute__((ext_vector_type(4)));
typedef short bf16x8 __attribute__((ext_vector_type(8)));
typedef GAS unsigned gu32;
typedef GAS unsigned long long gu64;
#define RLX_AGENT __ATOMIC_RELAXED, __HIP_MEMORY_SCOPE_AGENT
#define LDS_WAIT() asm volatile("s_waitcnt lgkmcnt(0)" ::: "memory")
#define VM_WAIT() asm volatile("s_waitcnt vmcnt(0)" ::: "memory")
__device__ __forceinline__ unsigned long long rt() { return __builtin_amdgcn_s_memrealtime(); }
__device__ __forceinline__ unsigned f2bf(float f) { unsigned u = __builtin_bit_cast(unsigned, f); return (u + 0x7fffu + ((u >> 16) & 1u)) >> 16; }
__device__ __forceinline__ unsigned pk2(float lo, float hi) { return f2bf(lo) | (f2bf(hi) << 16); }

#define XB_TMO      128
#define XB_XCNT(j)  (256  + 64 * (j))
#define XB_XSUB(j)  (1280 + 64 * (j))
#define XB_XGEN(j)  (2304 + 64 * (j))
#define XB_TOP      3328
#define XB_TOPGEN   3392
#define XCD_BAR_WORDS 3456
#define XB_SPIN_CAP (1u << 18)

__device__ __forceinline__ unsigned xb_ld(unsigned* p)              { return __hip_atomic_load(p, __ATOMIC_RELAXED, __HIP_MEMORY_SCOPE_AGENT); }
__device__ __forceinline__ unsigned xb_add(unsigned* p, unsigned v) { return __hip_atomic_fetch_add(p, v, __ATOMIC_RELAXED, __HIP_MEMORY_SCOPE_AGENT); }
__device__ __forceinline__ unsigned xb_xcc_id() { return (unsigned)__builtin_amdgcn_s_getreg((3 << 11) | 20) & 0xFu; }
#define XB_SPIN(cond, bar) do { unsigned _sp = 0; while (cond) { __builtin_amdgcn_s_sleep(1); \
    if ((++_sp & 255u) == 0u) { if (xb_ld(&(bar)[XB_TMO])) break; if (_sp > XB_SPIN_CAP) { atomicAdd(&(bar)[XB_TMO], 1u); break; } } } } while (0)

struct XcdBarrier {
    unsigned* bar; unsigned x;
    volatile LAS unsigned* st;
};

__device__ __forceinline__ XcdBarrier xcd_barrier_post(unsigned* bar, volatile LAS unsigned* st) {
    XcdBarrier b; b.bar = bar; b.x = xb_xcc_id(); b.st = st;
    if (threadIdx.x == 0) (void)xb_add(&bar[XB_XCNT(b.x)], 1u);
    return b;
}
__device__ __forceinline__ void xcd_barrier_complete(unsigned* bar, unsigned x, unsigned& nloc, unsigned& nx) {
    const unsigned G = gridDim.x * gridDim.y * gridDim.z;
    unsigned sum, cnt, mine, sp = 0u;
    for (;;) {
        sum = 0u; cnt = 0u; mine = 0u;
#pragma unroll
        for (unsigned j = 0; j < 16; ++j) { const unsigned c = xb_ld(&bar[XB_XCNT(j)]); sum += c; cnt += (c > 0u) ? 1u : 0u; mine = (j == x) ? c : mine; }
        if (sum == G) break;
        __builtin_amdgcn_s_sleep(1);
        if ((++sp & 255u) == 0u) { if (xb_ld(&bar[XB_TMO])) break; if (sp > XB_SPIN_CAP) { atomicAdd(&bar[XB_TMO], 1u); break; } }
    }
    nloc = mine > 0u ? mine : 1u; nx = cnt > 0u ? cnt : 1u;
}

__device__ __forceinline__ void xcd_barrier(const XcdBarrier& b) {
    asm volatile("s_waitcnt vmcnt(0)" ::: "memory");
    __syncthreads();
    if (threadIdx.x == 0) {
        unsigned* bar = b.bar; asm volatile("" : "+s"(bar)); unsigned bx = __builtin_amdgcn_readfirstlane(b.x); asm volatile("" : "+s"(bx));
        __builtin_amdgcn_s_waitcnt(0);
        unsigned nloc = b.st[0], nx = b.st[1];
        if (nloc == 0u) { xcd_barrier_complete(bar, bx, nloc, nx); b.st[0] = nloc; b.st[1] = nx; }
        const unsigned old = xb_add(&bar[XB_XSUB(bx)], 1u);
        const unsigned gen = old / nloc;
        if (old + 1u == (gen + 1u) * nloc) {
            __builtin_amdgcn_fence(__ATOMIC_RELEASE, "agent");
            asm volatile("s_waitcnt vmcnt(0)" ::: "memory");
            const unsigned og = xb_add(&bar[XB_TOP], 1u);
            const unsigned tg = og / nx;
            if (og + 1u == (tg + 1u) * nx) xb_add(&bar[XB_TOPGEN], 1u);
            else XB_SPIN(xb_ld(&bar[XB_TOPGEN]) == tg, bar);
            __builtin_amdgcn_fence(__ATOMIC_ACQUIRE, "agent");
            xb_add(&bar[XB_XGEN(bx)], 1u);
            asm volatile("s_waitcnt vmcnt(0)" ::: "memory");
        } else {
            XB_SPIN(xb_ld(&bar[XB_XGEN(bx)]) == gen, bar);
            __builtin_amdgcn_fence(__ATOMIC_ACQUIRE, "agent");
            asm volatile("s_waitcnt vmcnt(0)" ::: "memory");
        }
    }
    __syncthreads();
}
#ifndef DUP_MASK
#define DUP_MASK 0
#endif
#define DUP(kind) (((DUP_MASK) >> (kind)) & 1)
#ifndef DUPR_MASK
#define DUPR_MASK 0
#endif
#define DUPR(kind) (((DUPR_MASK) >> (kind)) & 1)
#ifndef DUPR_MODE
#define DUPR_MODE 0
#endif
#ifndef MK_PER_PHASE
#define MK_PER_PHASE 0
#endif

constexpr size_t MiB = 1u << 20;
constexpr size_t WS_CTL = 0, CTL_ZERO_BYTES = 64 * 1024;
constexpr size_t WS_ROPE = 1 * MiB;
constexpr size_t WS_LB = 1 * MiB + 256 * 1024;
constexpr size_t WS_KMX = 1 * MiB + 384 * 1024;
constexpr size_t WS_DST = 1 * MiB + 512 * 1024;
constexpr size_t WS_SSQ = 2 * MiB;
constexpr size_t WS_WTE = 3 * MiB;
constexpr size_t WS_WTO = 25 * MiB;
constexpr size_t WS_XB = 38 * MiB;
constexpr size_t WS_R0 = 70 * MiB, RSZ = 32 * MiB;
constexpr size_t WS_END = WS_R0 + 6 * RSZ;
constexpr size_t WS_WTO2 = WS_END, WS_END2 = WS_WTO2 + 13 * MiB;
constexpr int CW_BAR = 4096;

constexpr int RING_BYTES = 139264;
constexpr int LDSCTL_OFF = RING_BYTES + 8 * pg8::EPI_STG_WAVE, MISC_OFF = LDSCTL_OFF + 320;
constexpr int LDS_BYTES = 163840;
constexpr int NWAVES = 8, GRID = 256;
constexpr int NPH = 20;

struct Frame {
    LAS unsigned char* lds; volatile LAS unsigned* MISC; gu32* ctl;
    int tid, lane, wave, vcu, G;
};

__device__ __forceinline__ void transpose_item(const float* W, const float* sc, int K, int N, bf16* WT, LAS float* scr, int item, int lane) {
    const int nblk = N / 32, kb = item / nblk, nb = item % nblk, k0 = 64 * kb, n0 = 32 * nb;
    const int c4 = lane & 7, rk = lane >> 3;
#pragma unroll
    for (int i = 0; i < 8; ++i) { const int kk = 8 * i + rk; const float s = sc ? sc[k0 + kk] : 1.0f;
        f32x4 v = __builtin_nontemporal_load((const GAS f32x4*)(W + (size_t)(k0 + kk) * N + n0 + 4 * c4)); v = v * s; *(LAS f32x4*)(scr + kk * 36 + 4 * c4) = v; }
    LDS_WAIT(); asm volatile("" ::: "memory");
    const int c = lane & 7;
#pragma unroll
    for (int j = 0; j < 4; ++j) { const int n = (lane >> 3) + 8 * j; const LAS float* s = scr + (8 * c) * 36 + n;
        v4u o; o.x = pk2(s[0 * 36], s[1 * 36]); o.y = pk2(s[2 * 36], s[3 * 36]); o.z = pk2(s[4 * 36], s[5 * 36]); o.w = pk2(s[6 * 36], s[7 * 36]);
        *(GAS v4u*)(WT + (size_t)(n0 + n) * K + k0 + 8 * c) = o; }
    LDS_WAIT(); asm volatile("" ::: "memory");
}
__device__ __forceinline__ void convert_layer(Frame& F, const float* Win, const float* nrm, int Nin, const float* Wout, bf16* dstbuf, int wg = -1, int nwg = 0) {
    int lane = F.lane; asm volatile("" : "+v"(lane));
    LAS float* scr = (LAS float*)(F.lds + F.wave * 16384);
    const int gw = (wg < 0 ? F.vcu : wg) * NWAVES + F.wave, NGW = (wg < 0 ? F.G : nwg) * NWAVES;
    const int I_in = (DM / 64) * (Nin / 32), I_out = (DIN / 64) * (DM / 32);
    bf16* wout_t = dstbuf + (size_t)Nin * DM;
    for (int it = gw; it < I_in + I_out; it += NGW) {
        if (it < I_in) transpose_item(Win, nrm, DM, Nin, dstbuf, scr, it, lane);
        else transpose_item(Wout, nullptr, DIN, DM, wout_t, scr, it - I_in, lane);
    }
}
__device__ __forceinline__ float wave_sum(float v) {
#pragma unroll
    for (int o = 1; o < 64; o <<= 1) v += __shfl_xor(v, o);
    return v;
}

__device__ __forceinline__ void stagger(int vcu, unsigned ticks) {
    if (vcu & 1) { const unsigned long long t0 = __builtin_amdgcn_s_memrealtime(); while (__builtin_amdgcn_s_memrealtime() - t0 < ticks) __builtin_amdgcn_s_sleep(8); }
}
#ifndef STAG_EVEN
#define STAG_EVEN 0
#endif
#ifndef STAG_ODD
#define STAG_ODD 0
#endif
struct Args { const float* in[13]; float* out; unsigned char* ws; int ph_lo, ph_hi, wto2; };

__global__ void __launch_bounds__(NWAVES * 64, 2) mk_fwd(Args args) {
    extern __shared__ __attribute__((aligned(16))) unsigned char lds[];
    Frame F;
    F.lds = (LAS unsigned char*)lds;
    F.MISC = (volatile LAS unsigned*)(F.lds + MISC_OFF);
    F.tid = threadIdx.x; F.lane = F.tid & 63; F.wave = __builtin_amdgcn_readfirstlane(F.tid >> 6);
    F.G = gridDim.x; { const int bx = blockIdx.x; F.vcu = (F.G % 8 == 0) ? (bx % 8) * (F.G / 8) + bx / 8 : bx; }
    unsigned char* ws = args.ws;
    F.ctl = (gu32*)(ws + WS_CTL);
    for (int u = F.tid; u < (LDS_BYTES - LDSCTL_OFF) / 4; u += NWAVES * 64) ((LAS unsigned*)(F.lds + LDSCTL_OFF))[u] = 0u;
    __syncthreads();
    const int lo = args.ph_lo, hi = args.ph_hi; (void)lo; (void)hi;
    const bool multi = MK_PER_PHASE ? ((hi - lo) > 1) : true;
    XcdBarrier bar; bar.bar = (unsigned*)(F.ctl + CW_BAR); bar.x = 0; bar.st = nullptr;
    if (multi) bar = xcd_barrier_post((unsigned*)(F.ctl + CW_BAR), F.MISC + 8);
#ifndef PHASE_MASK
#define PHASE_MASK 0xFFFF
#endif
#if MK_PER_PHASE
#define INK(kind, k) ((((PHASE_MASK) >> (kind)) & 1) && lo <= (k) && (k) < hi)
#define IN(k) (lo <= (k) && (k) < hi)
#else
#define INK(kind, k) (((PHASE_MASK) >> (kind)) & 1)
#define IN(k) true
#endif
#if MK_PER_PHASE
#define SEAM(k) do { if (IN(k) && IN((k) + 1)) xcd_barrier(bar); } while (0)
#else
#define SEAM(k) do { xcd_barrier(bar); if (DUP(9)) xcd_barrier(bar); } while (0)
#endif

#define PTRS() size_t wz_ = 0; asm volatile("" : "+s"(wz_)); unsigned char* wsl = args.ws + wz_; \
    const float* x_in = args.in[0]; float* xres = args.out; \
    float* rope = (float*)(wsl + WS_ROPE); float* lbt = (float*)(wsl + WS_LB); float* dstv = (float*)(wsl + WS_DST); float* ssq = (float*)(wsl + WS_SSQ); unsigned* kmx = (unsigned*)(wsl + WS_KMX); (void)kmx; \
    bf16* wte = (bf16*)(wsl + WS_WTE); bf16* wto = (bf16*)(wsl + WS_WTO); bf16* xb = (bf16*)(wsl + WS_XB); float* ust = args.out;     \
    unsigned char* R0 = wsl + WS_R0; unsigned char* R1 = R0 + RSZ; unsigned char* R2 = R1 + RSZ; unsigned char* R3 = R2 + RSZ; unsigned char* R4 = R3 + RSZ; unsigned char* R5 = R4 + RSZ; \
    const int gw = F.vcu * NWAVES + F.wave, NGW = F.G * NWAVES; int tidl = threadIdx.x; asm volatile("" : "+v"(tidl)); const int lanel = tidl & 63; (void)lanel; \
    (void)x_in; (void)xres; (void)rope; (void)lbt; (void)dstv; (void)ssq; (void)wte; (void)wto; (void)xb; (void)ust; (void)R0; (void)R1; (void)R2; (void)R3; (void)R4; (void)R5; (void)gw; (void)NGW;

    for (int rep_ = 0; rep_ < (DUP(0) ? 2 : 1); ++rep_)
    if (INK(0, 0)) {
        PTRS();
        convert_layer(F, args.in[2], args.in[1], EVEN_IN, args.in[7], wte);
        convert_layer(F, args.in[9], args.in[8], ODD_IN, args.in[11], wto);
        {
            const int gt = F.vcu * (NWAVES * 64) + tidl, NGT = F.G * NWAVES * 64;
            for (int e = gt; e < SEQ * 8; e += NGT) { const int pos = e >> 3, i = e & 7; const double inv = pow(500000.0, -(double)i / 8.0); const double ang = (double)pos * inv;
                rope[e] = (float)cos(ang); rope[SEQ * 8 + e] = (float)sin(ang); }
            const float* lg = args.in[6];
            for (int e = gt; e < 2 * 1024; e += NGT) { const int dir = e >> 10, c = e & 1023; const float l0 = lg[(dir * 2 + 0) * 1024 + c], l1 = lg[(dir * 2 + 1) * 1024 + c];
                lbt[e] = 0.0f; lbt[2048 + e] = 1.0f / (1.0f + expf(l0 - l1)); }
            if (gt < 4 * NB * 16 + 2 * NB * 32) kmx[gt] = 0u;
        }
        for (int m = gw; m < T; m += NGW) {
            const GAS f32x4* xr = (const GAS f32x4*)(x_in + (size_t)m * DM) + lanel; f32x4 v[4]; float s = 0.f;
#pragma unroll
            for (int j = 0; j < 4; ++j) { v[j] = __builtin_nontemporal_load(xr + 64 * j); s += (v[j].x * v[j].x + v[j].y * v[j].y) + (v[j].z * v[j].z + v[j].w * v[j].w); }
            s = wave_sum(s);
            GAS unsigned long long* o8 = (GAS unsigned long long*)(xb + (size_t)m * DM) + lanel;
#pragma unroll
            for (int j = 0; j < 4; ++j) o8[64 * j] = (unsigned long long)pk2(v[j].x, v[j].y) | ((unsigned long long)pk2(v[j].z, v[j].w) << 32);
            if (lanel < 16) ssq[(size_t)m * 16 + lanel] = (lanel == 0) ? s : 0.0f;
        }
    }
    SEAM(0);

#pragma unroll 1
    for (int layer = 0; layer < 4; ++layer) {
        const int j = layer >> 1; const bool even = (layer & 1) == 0;
        const int pb = 1 + (layer >> 1) * 9 + (even ? 0 : 6);
        if (even) {
            const float lam_init = (j == 0) ? 0.2f : 0.470713018f;
            if (INK(1, pb + 0)) {
        PTRS();
                pg8::Gemm g{xb, wte, T, 4096, DM, DM, 1 << 30, 0l}; pg8::StaticOrder S; S.init(T, 4096, F.G, (int)blockIdx.x);
                pg8::EpiIn<true> E{ssq, rope, lbt + j * 2048, R0, R1, R2, R3, R4, R5, 0, nullptr, kmx + j * (NB * 16)};
                if (DUP(1)) { pg8::EpiDry ED; pg8::gemm_phase(F.lds, g, S, ED); }
                if (DUPR(1)) { pg8::EpiIn<true, DUPR_MODE> E2{ssq, rope, lbt + j * 2048, R0, R1, R2, R3, R4, R5, 0, nullptr, kmx + j * (NB * 16)}; pg8::gemm_phase(F.lds, g, S, E2); }
                if (STAG_EVEN) stagger(F.vcu, STAG_EVEN);
                pg8::gemm_phase(F.lds, g, S, E);
            }
            SEAM(pb + 0);
            if (INK(2, pb + 1)) {
        PTRS();
                if (layer == 2 && !args.wto2) { convert_layer(F, args.in[9] + (size_t)DM * ODD_IN, args.in[8] + DM, ODD_IN, args.in[11] + (size_t)DIN * DM, wto); __syncthreads(); }
                const float* lq = args.in[3] + j * 256; float s1 = 0.f, s2 = 0.f;
                for (int i = 0; i < 64; ++i) { s1 += lq[i] * lq[64 + i]; s2 += lq[128 + i] * lq[192 + i]; }
                const float lam = expf(s1) - expf(s2) + lam_init;
                if (DUP(2)) for (int i = 0; i < 4; ++i) { const int bh = (F.vcu >> 5) * 4 + i, qb = F.vcu & 31;
                    att::diff_attn_unit<true, DUPR_MODE>(bh >> 3, bh & 7, qb, (const att::u16*)R0, (const att::u16*)R1, (const att::u16*)R2, (const att::u16*)R3, (att::u16*)R0,
                                        args.in[4] + j * 128, lam, 1.0f - lam_init, kmx + j * (NB * 16), (char*)lds); }
                for (int i = 0; i < 4; ++i) { const int bh = (F.vcu >> 5) * 4 + i, qb = F.vcu & 31;
                    att::diff_attn_unit<false>(bh >> 3, bh & 7, qb, (const att::u16*)R0, (const att::u16*)R1, (const att::u16*)R2, (const att::u16*)R3, (att::u16*)R0,
                                        args.in[4] + j * 128, lam, 1.0f - lam_init, kmx + j * (NB * 16), (char*)lds); }
            }
            SEAM(pb + 1);
            if (INK(1, pb + 2)) {
        PTRS();
                pg8::Gemm g{xb, wte + (size_t)4096 * DM, T, 5120, DM, DM, 1 << 30, 0l}; pg8::StaticOrder S; S.init(T, 5120, F.G, (int)blockIdx.x);
                pg8::EpiIn<true> E{ssq, rope, lbt + j * 2048, R0, R1, R2, R3, R4, R5, 16};
                if (DUP(1)) { pg8::EpiDry ED; pg8::gemm_phase(F.lds, g, S, ED); }
                if (DUPR(1)) { pg8::EpiIn<true, DUPR_MODE> E2{ssq, rope, lbt + j * 2048, R0, R1, R2, R3, R4, R5, 16}; pg8::gemm_phase(F.lds, g, S, E2); }
                if (STAG_EVEN) stagger(F.vcu, STAG_EVEN);
                pg8::gemm_phase(F.lds, g, S, E);
            }
            SEAM(pb + 2);
            if (INK(3, pb + 3)) {
        PTRS();
                if (DUP(3)) for (int it = F.vcu; it < 512; it += F.G) hg::hgrn_pass1(it, (const att::u16*)R2, (const att::u16*)R4, (const att::u16*)R5, ust, dstv, (char*)lds);
                for (int it = F.vcu; it < 512; it += F.G) hg::hgrn_pass1(it, (const att::u16*)R2, (const att::u16*)R4, (const att::u16*)R5, ust, dstv, (char*)lds);
            }
            SEAM(pb + 3);
            if (INK(4, pb + 4)) {
        PTRS();
                if (DUP(4)) for (int it = F.vcu; it < 256; it += F.G) hg::hgrn_pass2<true, DUPR_MODE>(it, (const att::u16*)R1, (const att::u16*)R2, (const att::u16*)R4, (const att::u16*)R5, (const att::u16*)R3,
                                                                        (att::u16*)R4, (att::u16*)R1, ust, dstv, args.in[5] + j * 128, (char*)lds);
                for (int it = F.vcu; it < 256; it += F.G) hg::hgrn_pass2<false>(it, (const att::u16*)R1, (const att::u16*)R2, (const att::u16*)R4, (const att::u16*)R5, (const att::u16*)R3,
                                                                        (att::u16*)R4, (att::u16*)R1, ust, dstv, args.in[5] + j * 128, (char*)lds);
            }
            SEAM(pb + 4);
            if (INK(5, pb + 5)) {
        PTRS();
                pg8::Gemm g{(const bf16*)R0, wte + (size_t)EVEN_IN * DM, T, DM, DIN, DM, 16, (long)RSZ - 2048l}; pg8::StaticOrder S; S.init(T, DM, F.G, (int)blockIdx.x);
                if (DUP(5)) { pg8::EpiDry ED; pg8::gemm_phase(F.lds, g, S, ED); }
                if (layer == 0) { pg8::EpiOut<true, false> E{x_in, xres, xb, ssq}; pg8::gemm_phase(F.lds, g, S, E); }
                else            { pg8::EpiOut<false, false> E{x_in, xres, xb, ssq}; pg8::gemm_phase(F.lds, g, S, E); }
            }
            SEAM(pb + 5);
        } else {
            if (INK(6, pb + 0)) {
        PTRS();
                const bf16* wtoL = (layer == 3 && args.wto2) ? (const bf16*)(wsl + WS_WTO2) : wto;
                pg8::Gemm g{xb, wtoL, T, ODD_IN, DM, DM, 1 << 30, 0l}; pg8::StaticOrder S; S.init(T, ODD_IN, F.G, (int)blockIdx.x);
                pg8::EpiIn<false> E{ssq, rope, nullptr, R0, R1, R2, R3, R4, R5, 0, kmx + 4 * NB * 16 + j * (NB * 32), kmx + (2 + j) * (NB * 16)};
                if (DUP(6)) { pg8::EpiDry ED; pg8::gemm_phase(F.lds, g, S, ED); }
                if (DUPR(6)) pg8::gemm_phase(F.lds, g, S, E);
                if (STAG_ODD) stagger(F.vcu, STAG_ODD);
                pg8::gemm_phase(F.lds, g, S, E);
                if (layer == 1 && (int)blockIdx.x >= 128 && F.G == 256)
                { convert_layer(F, args.in[2] + (size_t)DM * EVEN_IN, args.in[1] + DM, EVEN_IN, args.in[7] + (size_t)DIN * DM, wte, (int)blockIdx.x - 128, 128);
                  if (args.wto2) convert_layer(F, args.in[9] + (size_t)DM * ODD_IN, args.in[8] + DM, ODD_IN, args.in[11] + (size_t)DIN * DM, (bf16*)(wsl + WS_WTO2), (int)blockIdx.x - 128, 128); }
            }
            SEAM(pb + 0);
            if (INK(7, pb + 1)) {
        PTRS();
                if (DUP(7)) att::swa_phase<true>(2 * F.vcu, (const att::u16*)R0, (const att::u16*)R2, (const att::u16*)(R2 + (size_t)T * 256 * 2), (const att::u16*)R3, (att::u16*)R0, args.in[10] + j * 32, kmx + 4 * NB * 16 + j * (NB * 32), kmx + (2 + j) * (NB * 16), (char*)lds);
                att::swa_phase<false>(2 * F.vcu, (const att::u16*)R0, (const att::u16*)R2, (const att::u16*)(R2 + (size_t)T * 256 * 2), (const att::u16*)R3, (att::u16*)R0, args.in[10] + j * 32, kmx + 4 * NB * 16 + j * (NB * 32), kmx + (2 + j) * (NB * 16), (char*)lds);
            }
            SEAM(pb + 1);
            if (INK(5, pb + 2)) {
        PTRS();
                const bf16* wtoL = (layer == 3 && args.wto2) ? (const bf16*)(wsl + WS_WTO2) : wto;
                pg8::Gemm g{(const bf16*)R0, wtoL + (size_t)ODD_IN * DM, T, DM, DIN, DIN, 1 << 30, 0l}; pg8::StaticOrder S; S.init(T, DM, F.G, (int)blockIdx.x);
                if (DUP(5)) { pg8::EpiDry ED; pg8::gemm_phase(F.lds, g, S, ED); }
                if (layer == 3) { pg8::EpiOut<false, true> E{x_in, xres, xb, ssq}; pg8::gemm_phase(F.lds, g, S, E); }
                else            { pg8::EpiOut<false, false> E{x_in, xres, xb, ssq}; pg8::gemm_phase(F.lds, g, S, E); }
            }
            SEAM(pb + 2);
        }
    }
    if (INK(8, 19)) {
        PTRS();
        const float* fw = args.in[12];
        for (int m = gw; m < T; m += NGW) {
            GAS f32x4* xr = (GAS f32x4*)(xres + (size_t)m * DM) + lanel; f32x4 v[4]; float s = 0.f;
#pragma unroll
            for (int jj = 0; jj < 4; ++jj) { v[jj] = xr[64 * jj]; s += (v[jj].x * v[jj].x + v[jj].y * v[jj].y) + (v[jj].z * v[jj].z + v[jj].w * v[jj].w); }
            s = wave_sum(s); const float rs = 1.0f / sqrtf(s * (1.0f / DM) + EPS);
#pragma unroll
            for (int jj = 0; jj < 4; ++jj) { const f32x4 w = *((const f32x4*)fw + lanel + 64 * jj); xr[64 * jj] = v[jj] * rs * w; }
        }
    }
#undef IN
#undef INK
#undef SEAM
}

extern "C" void kernel_launch(void* const* d_in, const int* in_sizes, int n_in, void* d_out, int out_size, void* d_ws, size_t ws_size, hipStream_t stream) {
    static int ok = 0;
    if (ok == 0) {
        if (n_in != 13 || in_sizes[0] != T * DM || out_size != T * DM || ws_size < WS_END) { fprintf(stderr, "kernel_launch: shape/workspace mismatch (n_in %d, ws %zu, need %zu)\n", n_in, ws_size, (size_t)WS_END); ok = -1; return; }
        if (hipFuncSetAttribute((const void*)mk_fwd, hipFuncAttributeMaxDynamicSharedMemorySize, LDS_BYTES) != hipSuccess) { fprintf(stderr, "kernel_launch: hipFuncSetAttribute failed\n"); ok = -1; return; }
        int per_cu = 0;
        if (hipOccupancyMaxActiveBlocksPerMultiprocessor(&per_cu, (const void*)mk_fwd, NWAVES * 64, LDS_BYTES) != hipSuccess || per_cu < 1) fprintf(stderr, "kernel_launch: occupancy query reports %d\n", per_cu);
        (void)hipGetLastError();
        ok = 1;
    }
    if (ok < 0) return;
    (void)hipMemsetAsync((char*)d_ws + WS_CTL, 0, CTL_ZERO_BYTES, stream);
    Args a{};
    for (int i = 0; i < 13; ++i) a.in[i] = (const float*)d_in[i];
    a.out = (float*)d_out; a.ws = (unsigned char*)d_ws; a.wto2 = (ws_size >= WS_END2) ? 1 : 0;
#if MK_PER_PHASE
    for (int p = 0; p < NPH; ++p) { a.ph_lo = p; a.ph_hi = p + 1; hipLaunchKernelGGL(mk_fwd, dim3(GRID), dim3(NWAVES * 64), LDS_BYTES, stream, a); }
#else
    a.ph_lo = 0; a.ph_hi = NPH;
    hipLaunchKernelGGL(mk_fwd, dim3(GRID), dim3(NWAVES * 64), LDS_BYTES, stream, a);
#endif
    const hipError_t le = hipPeekAtLastError();
    if (le != hipSuccess) fprintf(stderr, "kernel_launch: launch failed: %s\n", hipGetErrorName(le));
}
```
